# Optimizing an MI355X kernel written in HIP

```python
import jax, jax.numpy as jnp
from jax import lax
import numpy as np

D_MODEL = 1024
BATCH = 16
SEQ = 2048
DEPTH = 1

CHUNK = 64
Q_BLOCK = 128
EPS = 1e-6

CONV_WIDTH = D_MODEL
CONV_K = 3

N_HEADS = D_MODEL // 128
QK_NOPE = 128
QK_ROPE = 64
QK_HEAD = QK_NOPE + QK_ROPE
V_HEAD = D_MODEL // N_HEADS
Q_LORA = (3 * D_MODEL) // 8
KV_LORA = D_MODEL // 4
ROPE_BASE = 10000.0

COL_SIZES = (CONV_WIDTH, CONV_WIDTH, CONV_WIDTH, Q_LORA, KV_LORA, QK_ROPE, D_MODEL, D_MODEL)
D_IN_ALL = sum(COL_SIZES)
COL_SPLITS = tuple(int(v) for v in np.cumsum(COL_SIZES)[:-1])

N_GROUPS = 4
EXPERTS_PER_GROUP = 8
N_EXPERTS = N_GROUPS * EXPERTS_PER_GROUP
TOP_K = 2
D_EXPERT = D_MODEL // 4

kernel_name = 'hybrid_conv_mla_hmoe_block'


def rms_norm(x, g):
    xf = x.astype(jnp.float32)
    y = xf * lax.rsqrt(jnp.mean(xf * xf, axis=-1, keepdims=True) + EPS)
    return (y * g.astype(jnp.float32)).astype(x.dtype)


def rope_tables(positions):
    inv = ROPE_BASE ** (-jnp.arange(0, QK_ROPE, 2, dtype=jnp.float32) / QK_ROPE)
    ang = positions.astype(jnp.float32)[..., None] * inv
    return jnp.cos(ang)[:, :, None, :], jnp.sin(ang)[:, :, None, :]


def apply_rope(x, cos, sin):
    xf = x.astype(jnp.float32)
    x1, x2 = xf[..., :QK_ROPE // 2], xf[..., QK_ROPE // 2:]
    out = jnp.concatenate([x1 * cos - x2 * sin, x2 * cos + x1 * sin], axis=-1)
    return out.astype(x.dtype)


def short_causal_conv(u, w):
    S = u.shape[1]
    up = jnp.pad(u, ((0, 0), (CONV_K - 1, 0), (0, 0)))
    y = up[:, 0:S] * w[0]
    for k in range(1, CONV_K):
        y = y + up[:, k:k + S] * w[k]
    return y


def chunk_causal_attention(q, k, v):
    S = q.shape[1]
    scale = QK_HEAD ** -0.5
    outs = []
    for i in range(S // Q_BLOCK):
        q0 = i * Q_BLOCK
        kend = q0 + Q_BLOCK
        qb = q[:, q0:kend]
        kb = k[:, :kend]
        vb = v[:, :kend]
        s = jnp.einsum('bqhd,bkhd->bhqk', qb, kb).astype(jnp.float32) * scale
        q_chunk = (q0 + jnp.arange(Q_BLOCK)) // CHUNK
        k_chunk = jnp.arange(kend) // CHUNK
        mask = k_chunk[None, :] <= q_chunk[:, None]
        s = jnp.where(mask, s, jnp.finfo(jnp.float32).min)
        p = jax.nn.softmax(s, axis=-1).astype(v.dtype)
        outs.append(jnp.einsum('bhqk,bkhd->bqhd', p, vb))
    return jnp.concatenate(outs, axis=1)


def mla_branch(q_lat, kv_lat, k_rope_raw, cos, sin, q_a_norm_g, w_q_b, kv_a_norm_g, w_kv_b, q_norm_g, k_norm_g):
    B, S = q_lat.shape[0], q_lat.shape[1]
    q = (rms_norm(q_lat, q_a_norm_g) @ w_q_b).reshape(B, S, N_HEADS, QK_HEAD)
    q = rms_norm(q, q_norm_g)
    q = jnp.concatenate([q[..., :QK_NOPE], apply_rope(q[..., QK_NOPE:], cos, sin)], axis=-1)
    kv = (rms_norm(kv_lat, kv_a_norm_g) @ w_kv_b).reshape(B, S, N_HEADS, QK_NOPE + V_HEAD)
    k_nope, v = kv[..., :QK_NOPE], kv[..., QK_NOPE:]
    k_rope = jnp.broadcast_to(k_rope_raw[:, :, None, :], (B, S, N_HEADS, QK_ROPE))
    k = rms_norm(jnp.concatenate([k_nope, k_rope], axis=-1), k_norm_g)
    k = jnp.concatenate([k[..., :QK_NOPE], apply_rope(k[..., QK_NOPE:], cos, sin)], axis=-1)
    o = chunk_causal_attention(q, k, v)
    return o.reshape(B, S, N_HEADS * V_HEAD)


def hierarchical_moe(h, w_rg, b_rg, w_re, b_re, w_gate, w_up, w_down):
    B, S = h.shape[0], h.shape[1]
    g_logits = (h @ w_rg).astype(jnp.float32) + b_rg.astype(jnp.float32)
    g_prob = jax.nn.softmax(g_logits, axis=-1)
    g_onehot = jax.nn.one_hot(jnp.argmax(g_logits, axis=-1), N_GROUPS, dtype=jnp.float32)
    p_group = jnp.sum(g_prob * g_onehot, axis=-1)
    e_logits = ((h @ w_re).astype(jnp.float32) + b_re.astype(jnp.float32)).reshape(B, S, N_GROUPS, EXPERTS_PER_GROUP)
    e_sel = jnp.sum(e_logits * g_onehot[..., None], axis=-2)
    e_prob = jax.nn.softmax(e_sel, axis=-1)
    top_v, top_i = lax.top_k(e_prob, TOP_K)
    top_v = top_v / jnp.sum(top_v, axis=-1, keepdims=True)
    w_local = jnp.sum(jax.nn.one_hot(top_i, EXPERTS_PER_GROUP, dtype=jnp.float32) * top_v[..., None], axis=-2)
    comb = (g_onehot[..., :, None] * w_local[..., None, :] * p_group[..., None, None]).astype(h.dtype)
    out = jnp.zeros_like(h)
    for g in range(N_GROUPS):
        a = jax.nn.silu(jnp.einsum('bsd,edf->bsef', h, w_gate[g])) * jnp.einsum('bsd,edf->bsef', h, w_up[g])
        a = a * comb[:, :, g, :, None]
        out = out + jnp.einsum('bsef,efd->bsd', a, w_down[g])
    return out


def setup_inputs(seed: int = 0) -> dict:
    key = jax.random.key(seed)
    ks = jax.random.split(key, 24)
    f32 = jnp.float32
    nrm = lambda k, shape, s: jax.random.normal(k, shape, f32) * s
    L = DEPTH
    x = jax.random.normal(ks[0], (BATCH, SEQ, D_MODEL), f32)
    c = jax.random.normal(ks[1], (BATCH, D_MODEL), f32)
    offsets = jax.random.randint(ks[2], (BATCH, 1), 0, 4096, dtype=jnp.int32)
    positions = (offsets + jnp.arange(SEQ, dtype=jnp.int32)[None, :]).astype(jnp.int32)
    return {
        'x': x,
        'c': c,
        'positions': positions,
        'w_ada': nrm(ks[3], (L, D_MODEL, 6 * D_MODEL), D_MODEL ** -0.5),
        'b_ada': nrm(ks[4], (L, 6 * D_MODEL), 0.01),
        'norm1_g': 1.0 + nrm(ks[5], (L, D_MODEL), 0.02),
        'w_in': nrm(ks[6], (L, D_MODEL, D_IN_ALL), D_MODEL ** -0.5),
        'conv_w': nrm(ks[7], (L, CONV_K, CONV_WIDTH), CONV_K ** -0.5),
        'q_a_norm_g': 1.0 + nrm(ks[8], (L, Q_LORA), 0.02),
        'w_q_b': nrm(ks[9], (L, Q_LORA, N_HEADS * QK_HEAD), Q_LORA ** -0.5),
        'kv_a_norm_g': 1.0 + nrm(ks[10], (L, KV_LORA), 0.02),
        'w_kv_b': nrm(ks[11], (L, KV_LORA, N_HEADS * (QK_NOPE + V_HEAD)), KV_LORA ** -0.5),
        'q_norm_g': 1.0 + nrm(ks[12], (L, QK_HEAD), 0.02),
        'k_norm_g': 1.0 + nrm(ks[13], (L, QK_HEAD), 0.02),
        'w_o': nrm(ks[14], (L, D_MODEL, D_MODEL), D_MODEL ** -0.5),
        'norm2_g': 1.0 + nrm(ks[15], (L, D_MODEL), 0.02),
        'w_router_group': nrm(ks[16], (L, D_MODEL, N_GROUPS), D_MODEL ** -0.5),
        'b_router_group': nrm(ks[17], (L, N_GROUPS), 0.01),
        'w_router_expert': nrm(ks[18], (L, D_MODEL, N_EXPERTS), D_MODEL ** -0.5),
        'b_router_expert': nrm(ks[19], (L, N_EXPERTS), 0.01),
        'w_exp_gate': nrm(ks[20], (L, N_GROUPS, EXPERTS_PER_GROUP, D_MODEL, D_EXPERT), D_MODEL ** -0.5),
        'w_exp_up': nrm(ks[21], (L, N_GROUPS, EXPERTS_PER_GROUP, D_MODEL, D_EXPERT), D_MODEL ** -0.5),
        'w_exp_down': nrm(ks[22], (L, N_GROUPS, EXPERTS_PER_GROUP, D_EXPERT, D_MODEL), D_EXPERT ** -0.5),
    }


def reference(x, c, positions, w_ada, b_ada, norm1_g, w_in, conv_w, q_a_norm_g, w_q_b, kv_a_norm_g, w_kv_b,
              q_norm_g, k_norm_g, w_o, norm2_g, w_router_group, b_router_group, w_router_expert, b_router_expert,
              w_exp_gate, w_exp_up, w_exp_down):
    cos, sin = rope_tables(positions)
    c_act = jax.nn.silu(c)
    for l in range(DEPTH):
        mod = (c_act @ w_ada[l] + b_ada[l])[:, None, :]
        shift1, scale1, gate1, shift2, scale2, gate2 = jnp.split(mod, 6, axis=-1)

        h = rms_norm(x, norm1_g[l]) * (1.0 + scale1) + shift1
        z = h @ w_in[l]
        zx, zb, zc, q_lat, kv_lat, k_rope_raw, zg_conv, zg_mla = jnp.split(z, COL_SPLITS, axis=-1)
        y_conv = zb * short_causal_conv(zc * zx, conv_w[l])
        y_mla = mla_branch(q_lat, kv_lat, k_rope_raw, cos, sin, q_a_norm_g[l], w_q_b[l], kv_a_norm_g[l],
                           w_kv_b[l], q_norm_g[l], k_norm_g[l])
        merged = jax.nn.sigmoid(zg_conv) * y_conv + jax.nn.sigmoid(zg_mla) * y_mla
        x = x + gate1 * (merged @ w_o[l])

        h2 = rms_norm(x, norm2_g[l]) * (1.0 + scale2) + shift2
        y_moe = hierarchical_moe(h2, w_router_group[l], b_router_group[l], w_router_expert[l], b_router_expert[l],
                                 w_exp_gate[l], w_exp_up[l], w_exp_down[l])
        x = x + gate2 * y_moe
    return x
```

```cpp
#include <hip/hip_runtime.h>
#include <cstdio>
#include <cstdint>
#include <cmath>

constexpr int BATCH = 16, SEQ = 2048, DM = 1024, M = BATCH * SEQ;
constexpr int NH = 8, QKN = 128, QKR = 64, QKH = 192, VH = 128, QL = 384, KVL = 256;
constexpr int DIN = 5824, NEXP = 32, DEXP = 256;
constexpr int C_ZX = 0, C_ZB = 1024, C_ZC = 2048, C_QL = 3072, C_KVL = 3456, C_KR = 3712, C_GC = 3776, C_GM = 4800;
constexpr float EPS = 1e-6f;
constexpr int LATW = 768;
constexpr int NSLOT = 16;

typedef unsigned short bf16_t;
typedef float f32x4 __attribute__((ext_vector_type(4)));

constexpr size_t MiB = 1u << 20;
constexpr size_t WS_CTL = 0;
constexpr size_t WS_MOD = 1 * MiB;
constexpr size_t WS_CS = 2 * MiB;
constexpr size_t WS_SSP = 10 * MiB;
constexpr size_t WS_RT = 12 * MiB;
constexpr size_t WS_WSMALL = 14 * MiB;
constexpr size_t WS_A = 32 * MiB;
constexpr size_t WS_B = 96 * MiB;
constexpr size_t WS_C = 288 * MiB;
constexpr size_t WS_D = 336 * MiB;
constexpr size_t WS_END = 496 * MiB;

__device__ __forceinline__ float bf2f(bf16_t v) { return __uint_as_float(((unsigned)v) << 16); }
__device__ __forceinline__ bf16_t f2bf(float f) { unsigned u = __float_as_uint(f); return (bf16_t)((u + 0x7fffu + ((u >> 16) & 1u)) >> 16); }
__device__ __forceinline__ float sigmoidf_(float x) { return 1.f / (1.f + __expf(-x)); }
__device__ __forceinline__ float ldf(const float* p) { return *p; }
__device__ __forceinline__ float ldf(const bf16_t* p) { return bf2f(*p); }

struct Ptrs {
    const float *x, *c; const int* pos;
    const float *w_ada, *b_ada, *norm1_g, *w_in, *conv_w, *q_a_g, *w_q_b, *kv_a_g, *w_kv_b, *q_g, *k_g, *w_o, *norm2_g;
    const float *w_rg, *b_rg, *w_re, *b_re, *w_gate, *w_up, *w_down;
    float* out; unsigned char* ws;
};

__global__ void __launch_bounds__(256) nv_mod(Ptrs P) {
    const int n = blockIdx.x * 256 + threadIdx.x, b = blockIdx.y;
    float acc = P.b_ada[n];
    for (int k = 0; k < DM; ++k) { const float cv = P.c[b * DM + k]; const float s = cv / (1.f + expf(-cv)); acc += s * P.w_ada[(size_t)k * 6144 + n]; }
    ((float*)(P.ws + WS_MOD))[b * 6144 + n] = acc;
}
__global__ void __launch_bounds__(256) nv_rope_table(Ptrs P) {
    const int idx = blockIdx.x * 256 + threadIdx.x;
    const int m = idx >> 5, i = idx & 31;
    const double inv = pow(10000.0, -(double)(2 * i) / 64.0);
    const double ang = (double)P.pos[m] * inv;
    float2 cs; cs.x = (float)cos(ang); cs.y = (float)sin(ang);
    ((float2*)(P.ws + WS_CS))[idx] = cs;
}
__device__ __forceinline__ float block_sum_256(float v, float* red) {
    for (int o = 32; o > 0; o >>= 1) v += __shfl_xor(v, o);
    if ((threadIdx.x & 63) == 0) red[threadIdx.x >> 6] = v;
    __syncthreads();
    const float r = red[0] + red[1] + red[2] + red[3];
    __syncthreads();
    return r;
}
__global__ void __launch_bounds__(256) nv_norm1(Ptrs P) {
    __shared__ float red[4];
    const int m = blockIdx.x, b = m / SEQ, t = threadIdx.x;
    const float* mod = (const float*)(P.ws + WS_MOD) + b * 6144;
    float v[4]; float ss = 0.f;
#pragma unroll
    for (int j = 0; j < 4; ++j) { v[j] = P.x[(size_t)m * DM + t + 256 * j]; ss += v[j] * v[j]; }
    ss = block_sum_256(ss, red);
    const float rstd = 1.f / sqrtf(ss / DM + EPS);
    bf16_t* h = (bf16_t*)(P.ws + WS_A);
#pragma unroll
    for (int j = 0; j < 4; ++j) { const int d = t + 256 * j; h[(size_t)m * DM + d] = f2bf(v[j] * rstd * P.norm1_g[d] * (1.f + mod[1024 + d]) + mod[d]); }
}
template <typename TA>
__global__ void __launch_bounds__(256) nv_gemm(const TA* A, int lda, const float* Bm, int ldb, const float* bscale, float* C, int ldc, int K) {
    __shared__ float As[16][65]; __shared__ float Bs[16][64];
    const int tx = threadIdx.x & 15, ty = threadIdx.x >> 4, m0 = blockIdx.y * 64, n0 = blockIdx.x * 64;
    float acc[4][4];
#pragma unroll
    for (int i = 0; i < 4; ++i)
#pragma unroll
        for (int j = 0; j < 4; ++j) acc[i][j] = 0.f;
    for (int k0 = 0; k0 < K; k0 += 16) {
#pragma unroll
        for (int q = 0; q < 4; ++q) { const int i = threadIdx.x + 256 * q; const int r = i >> 4, c = i & 15; As[c][r] = ldf(A + (size_t)(m0 + r) * lda + k0 + c); }
#pragma unroll
        for (int q = 0; q < 4; ++q) { const int i = threadIdx.x + 256 * q; const int r = i >> 6, c = i & 63; const float s = bscale ? bscale[k0 + r] : 1.f; Bs[r][c] = Bm[(size_t)(k0 + r) * ldb + n0 + c] * s; }
        __syncthreads();
#pragma unroll
        for (int k = 0; k < 16; ++k) {
            float a0 = As[k][ty * 4 + 0], a1 = As[k][ty * 4 + 1], a2 = As[k][ty * 4 + 2], a3 = As[k][ty * 4 + 3];
            float b0 = Bs[k][tx * 4 + 0], b1 = Bs[k][tx * 4 + 1], b2 = Bs[k][tx * 4 + 2], b3 = Bs[k][tx * 4 + 3];
            acc[0][0] += a0 * b0; acc[0][1] += a0 * b1; acc[0][2] += a0 * b2; acc[0][3] += a0 * b3;
            acc[1][0] += a1 * b0; acc[1][1] += a1 * b1; acc[1][2] += a1 * b2; acc[1][3] += a1 * b3;
            acc[2][0] += a2 * b0; acc[2][1] += a2 * b1; acc[2][2] += a2 * b2; acc[2][3] += a2 * b3;
            acc[3][0] += a3 * b0; acc[3][1] += a3 * b1; acc[3][2] += a3 * b2; acc[3][3] += a3 * b3;
        }
        __syncthreads();
    }
#pragma unroll
    for (int i = 0; i < 4; ++i)
#pragma unroll
        for (int j = 0; j < 4; ++j) C[(size_t)(m0 + ty * 4 + i) * ldc + n0 + tx * 4 + j] = acc[i][j];
}
__global__ void __launch_bounds__(256) nv_z_post(Ptrs P, const float* z, int b, int wmask) {
    const int s = blockIdx.x, m = b * SEQ + s, t = threadIdx.x;
    const float* zr = z + (size_t)s * DIN;
    bf16_t* u = (bf16_t*)(P.ws + WS_B); bf16_t* gb = u + (size_t)M * DM; bf16_t* sg = gb + (size_t)M * DM;
    bf16_t* lat = (bf16_t*)(P.ws + WS_C); float* ssp = (float*)(P.ws + WS_SSP);
#pragma unroll
    for (int j = 0; j < 4; ++j) { const int c = t + 256 * j;
        if (wmask & 1) { u[(size_t)m * DM + c] = f2bf(zr[C_ZX + c] * zr[C_ZC + c]);
        gb[(size_t)m * DM + c] = f2bf(zr[C_ZB + c] * sigmoidf_(zr[C_GC + c])); }
        if (wmask & 2) sg[(size_t)m * DM + c] = f2bf(sigmoidf_(zr[C_GM + c])); }
    if (wmask & 4) for (int c = t; c < LATW; c += 256) {
        float v = 0.f;
        if (c < 384) v = zr[C_QL + c]; else if (c < 448) v = zr[C_KR + c - 384]; else if (c >= 512) v = zr[C_KVL + c - 512];
        lat[(size_t)m * LATW + c] = f2bf(v); }
    if ((wmask & 8) && t < NSLOT) {
        float ss = 0.f;
        if (t == 0) for (int c = 0; c < QL; ++c) ss += zr[C_QL + c] * zr[C_QL + c];
        if (t == 8) for (int c = 0; c < KVL; ++c) ss += zr[C_KVL + c] * zr[C_KVL + c];
        if (t == 12) for (int c = 0; c < QKR; ++c) ss += zr[C_KR + c] * zr[C_KR + c];
        ssp[(size_t)t * M + m] = ss; }
}
__global__ void __launch_bounds__(256) nv_q_post(Ptrs P, const float* qraw, int b) {
    const size_t i = (size_t)blockIdx.x * 256 + threadIdx.x;
    ((bf16_t*)P.out)[(size_t)b * SEQ * 1536 + i] = f2bf(qraw[i]);
}
__global__ void __launch_bounds__(64) nv_kv_post(Ptrs P, const float* kvraw, int b) {
    const int s = blockIdx.x, h = blockIdx.y, m = b * SEQ + s, l = threadIdx.x;
    const float* ssp = (const float*)(P.ws + WS_SSP);
    const float sskv = ssp[(size_t)8 * M + m] + ssp[(size_t)9 * M + m] + ssp[(size_t)10 * M + m] + ssp[(size_t)11 * M + m];
    const float sskr = ssp[(size_t)12 * M + m] + ssp[(size_t)13 * M + m] + ssp[(size_t)14 * M + m] + ssp[(size_t)15 * M + m];
    const float rkv = 1.f / sqrtf(sskv / KVL + EPS);
    const float* r = kvraw + (size_t)s * 2048 + h * 256;
    const float kn0 = rkv * r[l], kn1 = rkv * r[l + 64], v0 = rkv * r[128 + l], v1 = rkv * r[192 + l];
    float ss = kn0 * kn0 + kn1 * kn1;
    for (int o = 32; o > 0; o >>= 1) ss += __shfl_xor(ss, o);
    const float rk = 1.f / sqrtf((ss + sskr) / QKH + EPS);
    bf16_t* Kp = (bf16_t*)(P.ws + WS_D) + ((size_t)(b * NH + h) * SEQ + s) * QKH;
    bf16_t* Vp = (bf16_t*)(P.ws + WS_D + 96 * MiB) + ((size_t)(b * NH + h) * SEQ + s) * VH;
    Kp[l] = f2bf(kn0 * rk * P.k_g[l]); Kp[l + 64] = f2bf(kn1 * rk * P.k_g[l + 64]);
    Vp[l] = f2bf(v0); Vp[l + 64] = f2bf(v1);
    if (l < 32) {
        const bf16_t* lat = (const bf16_t*)(P.ws + WS_C) + (size_t)m * LATW + 384;
        const float2 cs = ((const float2*)(P.ws + WS_CS))[(size_t)m * 32 + l];
        const float x1 = bf2f(lat[l]) * rk * P.k_g[128 + l], x2 = bf2f(lat[l + 32]) * rk * P.k_g[160 + l];
        Kp[128 + l] = f2bf(x1 * cs.x - x2 * cs.y); Kp[160 + l] = f2bf(x2 * cs.x + x1 * cs.y); }
}
__global__ void __launch_bounds__(64) nv_attn(Ptrs P) {
    __shared__ float sq[QKH]; __shared__ float sc[SEQ];
    const int t = blockIdx.x, h = blockIdx.y, b = blockIdx.z, m = b * SEQ + t, l = threadIdx.x;
    const float* ssp = (const float*)(P.ws + WS_SSP);
    float ssq = 0.f; for (int j = 0; j < 8; ++j) ssq += ssp[(size_t)j * M + m];
    const float rq = 1.f / sqrtf(ssq / QL + EPS);
    const bf16_t* qr = (const bf16_t*)P.out + (size_t)m * 1536 + h * QKH;
    const float q0 = rq * bf2f(qr[l]), q1 = rq * bf2f(qr[l + 64]), q2 = rq * bf2f(qr[l + 128]);
    float ss = q0 * q0 + q1 * q1 + q2 * q2;
    for (int o = 32; o > 0; o >>= 1) ss += __shfl_xor(ss, o);
    const float rn = 1.f / sqrtf(ss / QKH + EPS);
    sq[l] = q0 * rn * P.q_g[l]; sq[l + 64] = q1 * rn * P.q_g[l + 64]; sq[l + 128] = q2 * rn * P.q_g[l + 128];
    __syncthreads();
    if (l < 32) {
        const float2 cs = ((const float2*)(P.ws + WS_CS))[(size_t)m * 32 + l];
        const float x1 = sq[128 + l], x2 = sq[160 + l];
        sq[128 + l] = x1 * cs.x - x2 * cs.y; sq[160 + l] = x2 * cs.x + x1 * cs.y; }
    __syncthreads();
    const int kend = ((t >> 6) + 1) << 6;
    const bf16_t* Kb = (const bf16_t*)(P.ws + WS_D) + (size_t)(b * NH + h) * SEQ * QKH;
    const bf16_t* Vb = (const bf16_t*)(P.ws + WS_D + 96 * MiB) + (size_t)(b * NH + h) * SEQ * VH;
    const float scale = 0.07216878364870322f;
    float mx = -1e30f;
    for (int j = l; j < kend; j += 64) { const uint4* kr = (const uint4*)(Kb + (size_t)j * QKH); float d = 0.f;
        for (int e = 0; e < QKH / 8; ++e) { const uint4 w = kr[e]; const float* q8 = sq + e * 8;
            d += q8[0] * __uint_as_float(w.x << 16) + q8[1] * __uint_as_float(w.x & 0xffff0000u) + q8[2] * __uint_as_float(w.y << 16) + q8[3] * __uint_as_float(w.y & 0xffff0000u)
               + q8[4] * __uint_as_float(w.z << 16) + q8[5] * __uint_as_float(w.z & 0xffff0000u) + q8[6] * __uint_as_float(w.w << 16) + q8[7] * __uint_as_float(w.w & 0xffff0000u); }
        d *= scale; sc[j] = d; mx = fmaxf(mx, d); }
    for (int o = 32; o > 0; o >>= 1) mx = fmaxf(mx, __shfl_xor(mx, o));
    float sum = 0.f;
    for (int j = l; j < kend; j += 64) { const float p = expf(sc[j] - mx); sc[j] = p; sum += p; }
    for (int o = 32; o > 0; o >>= 1) sum += __shfl_xor(sum, o);
    __syncthreads();
    float o0 = 0.f, o1 = 0.f;
    for (int j = 0; j < kend; ++j) { const float p = sc[j]; o0 += p * bf2f(Vb[(size_t)j * VH + l]); o1 += p * bf2f(Vb[(size_t)j * VH + l + 64]); }
    const float inv = 1.f / sum; o0 *= inv; o1 *= inv;
    const bf16_t* u = (const bf16_t*)(P.ws + WS_B); const bf16_t* gb = u + (size_t)M * DM; const bf16_t* sg = gb + (size_t)M * DM;
    bf16_t* mg = (bf16_t*)(P.ws + WS_A);
#pragma unroll
    for (int j = 0; j < 2; ++j) { const int c = h * VH + l + 64 * j; const size_t e = (size_t)m * DM + c;
        const float u0 = bf2f(u[e]), um1 = t >= 1 ? bf2f(u[e - DM]) : 0.f, um2 = t >= 2 ? bf2f(u[e - 2 * DM]) : 0.f;
        const float cv = P.conv_w[c] * um2 + P.conv_w[DM + c] * um1 + P.conv_w[2 * DM + c] * u0;
        mg[e] = f2bf(bf2f(gb[e]) * cv + bf2f(sg[e]) * (j ? o1 : o0)); }
}
__global__ void __launch_bounds__(256) nv_resid(Ptrs P, const float* y, int b) {
    const size_t i = (size_t)blockIdx.x * 256 + threadIdx.x;
    const int d = (int)(i & (DM - 1)); const size_t e = (size_t)b * SEQ * DM + i;
    P.out[e] = P.x[e] + ((const float*)(P.ws + WS_MOD))[b * 6144 + 2048 + d] * y[i];
}
__global__ void __launch_bounds__(256) nv_norm2_router(Ptrs P) {
    __shared__ float red[4]; __shared__ float hs[DM]; __shared__ float lg[36];
    const int m = blockIdx.x, b = m / SEQ, t = threadIdx.x;
    const float* mod = (const float*)(P.ws + WS_MOD) + b * 6144;
    float v[4]; float ss = 0.f;
#pragma unroll
    for (int j = 0; j < 4; ++j) { v[j] = P.out[(size_t)m * DM + t + 256 * j]; ss += v[j] * v[j]; }
    ss = block_sum_256(ss, red);
    const float rstd = 1.f / sqrtf(ss / DM + EPS);
    bf16_t* h2 = (bf16_t*)(P.ws + WS_B);
#pragma unroll
    for (int j = 0; j < 4; ++j) { const int d = t + 256 * j; const float hv = v[j] * rstd * P.norm2_g[d] * (1.f + mod[4096 + d]) + mod[3072 + d]; hs[d] = hv; h2[(size_t)m * DM + d] = f2bf(hv); }
    __syncthreads();
    if (t < 36) { float a = 0.f;
        if (t < 4) { for (int k = 0; k < DM; ++k) a += hs[k] * P.w_rg[k * 4 + t]; a += P.b_rg[t]; }
        else { for (int k = 0; k < DM; ++k) a += hs[k] * P.w_re[k * 32 + t - 4]; a += P.b_re[t - 4]; }
        lg[t] = a; }
    __syncthreads();
    if (t == 0) {
        int g = 0; for (int i = 1; i < 4; ++i) if (lg[i] > lg[g]) g = i;
        float se = 0.f; for (int i = 0; i < 4; ++i) se += expf(lg[i] - lg[g]);
        const float pg = 1.f / se;
        const float* el = lg + 4 + g * 8;
        int i0 = 0; for (int i = 1; i < 8; ++i) if (el[i] > el[i0]) i0 = i;
        int i1 = (i0 == 0) ? 1 : 0; for (int i = 0; i < 8; ++i) if (i != i0 && el[i] > el[i1]) i1 = i;
        const float p1 = expf(el[i1] - el[i0]);
        const float w0 = 1.f / (1.f + p1), w1 = p1 / (1.f + p1);
        int2 e; e.x = g * 8 + i0; e.y = g * 8 + i1; float2 w; w.x = w0 * pg; w.y = w1 * pg;
        ((int2*)(P.ws + WS_RT))[m] = e; ((float2*)(P.ws + WS_RT + 256 * 1024))[m] = w; }
}
__global__ void __launch_bounds__(256) nv_moe(Ptrs P) {
    __shared__ float hs[DM]; __shared__ float act[DEXP];
    const int m = blockIdx.x, b = m / SEQ, t = threadIdx.x;
    const bf16_t* h2 = (const bf16_t*)(P.ws + WS_B) + (size_t)m * DM;
#pragma unroll
    for (int j = 0; j < 4; ++j) hs[t + 256 * j] = bf2f(h2[t + 256 * j]);
    const int2 e = ((const int2*)(P.ws + WS_RT))[m]; const float2 w = ((const float2*)(P.ws + WS_RT + 256 * 1024))[m];
    float o[4] = {0.f, 0.f, 0.f, 0.f};
    for (int j = 0; j < 2; ++j) {
        const int ex = j ? e.y : e.x; const float wj = j ? w.y : w.x;
        const float* wg = P.w_gate + (size_t)ex * DM * DEXP; const float* wu = P.w_up + (size_t)ex * DM * DEXP; const float* wd = P.w_down + (size_t)ex * DEXP * DM;
        __syncthreads();
        float g = 0.f, uu = 0.f;
        for (int k = 0; k < DM; ++k) { const float hv = hs[k]; g += hv * wg[(size_t)k * DEXP + t]; uu += hv * wu[(size_t)k * DEXP + t]; }
        act[t] = (g / (1.f + expf(-g))) * uu * wj;
        __syncthreads();
        for (int f = 0; f < DEXP; ++f) { const float a = act[f];
#pragma unroll
            for (int q = 0; q < 4; ++q) o[q] += a * wd[(size_t)f * DM + t + 256 * q]; }
    }
    const float* mod = (const float*)(P.ws + WS_MOD) + b * 6144 + 5120;
#pragma unroll
    for (int q = 0; q < 4; ++q) { const int d = t + 256 * q; P.out[(size_t)m * DM + d] += mod[d] * o[q]; }
}

namespace fk {
#define LAS __attribute__((address_space(3)))
#define GAS __attribute__((address_space(1)))
typedef short bf16x8 __attribute__((ext_vector_type(8)));
typedef short s16x4 __attribute__((ext_vector_type(4)));
typedef unsigned u32x4 __attribute__((ext_vector_type(4)));
typedef unsigned u32x2 __attribute__((ext_vector_type(2)));
typedef float f32x2 __attribute__((ext_vector_type(2)));
typedef float f32x16 __attribute__((ext_vector_type(16)));
typedef GAS unsigned gu32;
#define RLX_AGENT __ATOMIC_RELAXED, __HIP_MEMORY_SCOPE_AGENT
constexpr int NWAVES = 8;
constexpr int BM = 256, BK = 64, HALF = 128, HTB = HALF * BK * 2, STAGE_BYTES = 8 * HTB, NXCD = 8, WGM = 8;
constexpr int RING_OFF = 0, RING_BYTES = 131072, XCH_OFF = 131072, XCH_BYTES = 8192, LDSCTL_OFF = XCH_OFF + XCH_BYTES, MISC_OFF = LDSCTL_OFF + 320, LDS_BYTES = 147456;
constexpr int CW_TMO = 0, CW_BAR = 4096;
constexpr int CW_HIST = 16384;
constexpr int CW_TILES = 40960;

typedef __bf16 bf16x2_t __attribute__((ext_vector_type(2)));
__device__ __forceinline__ unsigned cvt_pk_bf16(float lo, float hi) { f32x2 v = {lo, hi}; bf16x2_t b = __builtin_convertvector(v, bf16x2_t); return __builtin_bit_cast(unsigned, b); }
__device__ __forceinline__ float fsigmoid(float x) { return __builtin_amdgcn_rcpf(1.f + __expf(-x)); }

__host__ __device__ __forceinline__ int lds_byte(int r, int c) { const int st = (r >> 4) * 2 + (c >> 5), rr = r & 15, cc = c & 31, ob = rr * 64 + cc * 2; return st * 1024 + (ob ^ (((ob >> 9) & 1) << 5)); }
__host__ __device__ __forceinline__ void stage_rc(int b, int& R, int& C) { const int st = b / 1024, sb = b % 1024, swz = sb ^ (((sb >> 9) & 1) << 5); R = (st >> 1) * 16 + swz / 64; C = (st & 1) * 32 + (swz % 64) / 2; }
__host__ __device__ __forceinline__ int permL(int L) { return (L & 0xE0) | (((L >> 2) & 1) << 4) | (((L >> 3) & 3) << 2) | (L & 3); }

#define XB_TMO      128
#define XB_XCNT(j)  (256  + 64 * (j))
#define XB_XSUB(j)  (1280 + 64 * (j))
#define XB_XGEN(j)  (2304 + 64 * (j))
#define XB_TOP      3328
#define XB_TOPGEN   3392
#define XCD_BAR_WORDS 3456
#define XB_SPIN_CAP (1u << 18)
__device__ __forceinline__ unsigned xb_ld(unsigned* p)              { return __hip_atomic_load(p, __ATOMIC_RELAXED, __HIP_MEMORY_SCOPE_AGENT); }
__device__ __forceinline__ unsigned xb_add(unsigned* p, unsigned v) { return __hip_atomic_fetch_add(p, v, __ATOMIC_RELAXED, __HIP_MEMORY_SCOPE_AGENT); }
__device__ __forceinline__ unsigned xb_xcc_id() { return (unsigned)__builtin_amdgcn_s_getreg((3 << 11) | 20) & 0xFu; }
#define XB_SPIN(cond, bar) do { unsigned _sp = 0; while (cond) { __builtin_amdgcn_s_sleep(1); \
    if ((++_sp & 255u) == 0u) { if (xb_ld(&(bar)[XB_TMO])) break; if (_sp > XB_SPIN_CAP) { atomicAdd(&(bar)[XB_TMO], 1u); break; } } } } while (0)
struct XcdBarrier { unsigned* bar; unsigned x; volatile LAS unsigned* st; };
__device__ __forceinline__ XcdBarrier xcd_barrier_post(unsigned* bar, volatile LAS unsigned* st) {
    XcdBarrier b; b.bar = bar; b.x = xb_xcc_id(); b.st = st;
    if (threadIdx.x == 0) (void)xb_add(&bar[XB_XCNT(b.x)], 1u);
    return b;
}
__device__ __forceinline__ void xcd_barrier_complete(unsigned* bar, unsigned x, unsigned& nloc, unsigned& nx) {
    const unsigned G = gridDim.x * gridDim.y * gridDim.z;
    unsigned sum, cnt, mine, sp = 0u;
    for (;;) {
        sum = 0u; cnt = 0u; mine = 0u;
#pragma unroll
        for (unsigned j = 0; j < 16; ++j) { const unsigned c = xb_ld(&bar[XB_XCNT(j)]); sum += c; cnt += (c > 0u) ? 1u : 0u; mine = (j == x) ? c : mine; }
        if (sum == G) break;
        __builtin_amdgcn_s_sleep(1);
        if ((++sp & 255u) == 0u) { if (xb_ld(&bar[XB_TMO])) break; if (sp > XB_SPIN_CAP) { atomicAdd(&bar[XB_TMO], 1u); break; } }
    }
    nloc = mine > 0u ? mine : 1u; nx = cnt > 0u ? cnt : 1u;
}
__device__ __forceinline__ void xcd_barrier(const XcdBarrier& b) {
    asm volatile("s_waitcnt vmcnt(0)" ::: "memory");
    __syncthreads();
    if (threadIdx.x == 0) {
        unsigned* bar = b.bar;
        __builtin_amdgcn_s_waitcnt(0);
        unsigned nloc = b.st[0], nx = b.st[1];
        if (nloc == 0u) { xcd_barrier_complete(bar, b.x, nloc, nx); b.st[0] = nloc; b.st[1] = nx; }
        const unsigned old = xb_add(&bar[XB_XSUB(b.x)], 1u);
        const unsigned gen = old / nloc;
        if (old + 1u == (gen + 1u) * nloc) {
            __builtin_amdgcn_fence(__ATOMIC_RELEASE, "agent");
            asm volatile("s_waitcnt vmcnt(0)" ::: "memory");
            const unsigned og = xb_add(&bar[XB_TOP], 1u);
            const unsigned tg = og / nx;
            if (og + 1u == (tg + 1u) * nx) xb_add(&bar[XB_TOPGEN], 1u);
            else XB_SPIN(xb_ld(&bar[XB_TOPGEN]) == tg, bar);
            __builtin_amdgcn_fence(__ATOMIC_ACQUIRE, "agent");
            xb_add(&bar[XB_XGEN(b.x)], 1u);
            asm volatile("s_waitcnt vmcnt(0)" ::: "memory");
        } else {
            XB_SPIN(xb_ld(&bar[XB_XGEN(b.x)]) == gen, bar);
            __builtin_amdgcn_fence(__ATOMIC_ACQUIRE, "agent");
            asm volatile("s_waitcnt vmcnt(0)" ::: "memory");
        }
    }
    __syncthreads();
}

struct Unit { int pm, pn, aux; };
struct DenseSched {
    const bf16_t* A; const bf16_t* Bt; int lda, ldb; int nM, nN, nwg, G, c;
    __device__ void init(const bf16_t* A_, int lda_, const bf16_t* Bt_, int ldb_, int M_, int N_, int G_, int c_) { A = A_; Bt = Bt_; lda = lda_; ldb = ldb_; nM = M_ / BM; nN = N_ / BM; nwg = nM * nN; G = G_; c = c_; }
    __device__ bool next(int i, Unit& u) const {
        const long L = (long)i * G + c; if (L >= nwg) return false;
        int wgid = (int)L; { const int q = nwg / NXCD, r = nwg % NXCD, xcd = wgid % NXCD, off = wgid / NXCD; wgid = (xcd < r ? xcd * (q + 1) : r * (q + 1) + (xcd - r) * q) + off; }
        const int nig = WGM * nN, gid = wgid / nig, fm = gid * WGM, gsz = (nM - fm) < WGM ? (nM - fm) : WGM;
        u.pm = fm + ((wgid % nig) % gsz); u.pn = (wgid % nig) / gsz; u.aux = 0; return true;
    }
    __device__ __forceinline__ const char* abase(const Unit& u) const { return (const char*)A + (size_t)u.pm * BM * lda * 2; }
    __device__ __forceinline__ const char* bbase(const Unit& u) const { return (const char*)Bt + (size_t)u.pn * BM * ldb * 2; }
    __device__ __forceinline__ void avoff(const Unit&, int R0, int C0, int R1, int C1, unsigned (&v0)[2], unsigned (&v1)[2]) const {
        v0[0] = (unsigned)(R0 * lda + C0) * 2u; v0[1] = (unsigned)(R1 * lda + C1) * 2u;
        v1[0] = v0[0] + (unsigned)(HALF * lda * 2); v1[1] = v0[1] + (unsigned)(HALF * lda * 2); }
};

template <bool GATHER, class Epi, class Sched>
__device__ __forceinline__ void gemm_phase(LAS unsigned char* lds, const int K, const Sched& S, const Epi& E) {
    const int tid = threadIdx.x, wid = __builtin_amdgcn_readfirstlane(tid >> 6), lane = tid & 63, wr = wid >> 2, wc = wid & 3, fr = lane & 15, fq = lane >> 4;
    const int nt = K / BK;
    int R0, C0, R1, C1; stage_rc(tid * 16, R0, C0); stage_rc(tid * 16 + 8192, R1, C1);
    unsigned voffB[2]; voffB[0] = (unsigned)(R0 * S.ldb + C0) * 2u; voffB[1] = (unsigned)(R1 * S.ldb + C1) * 2u;
    const size_t kstep = (size_t)(BK * 2);
    const size_t hstepB = (size_t)HALF * S.ldb * 2;
    const unsigned ldsw = (unsigned)wid * 1024u;
    const int aoff = lds_byte(wr * 64 + fr, fq * 8), boff = lds_byte(wc * 32 + fr, fq * 8);
#define PG8_SA(b, h) (((b) * 2 + (h)) * HTB)
#define PG8_SB(b, h) ((4 + (b) * 2 + (h)) * HTB)
#define PG8_STAGE(bufoff, gbase, voff) do { _Pragma("unroll") for (int _i = 0; _i < 2; ++_i) \
        __builtin_amdgcn_global_load_lds((const unsigned*)((const char*)(gbase) + (voff)[_i]), (LAS unsigned*)(lds + (bufoff) + ldsw + _i * 8192), 16, 0, 0); } while (0)
#define PG8_LDA(dst, b, h) do { _Pragma("unroll") for (int m = 0; m < 4; ++m) _Pragma("unroll") for (int k = 0; k < 2; ++k) dst[m][k] = *(const LAS bf16x8*)(lds + PG8_SA(b, h) + aoff + m * 2048 + k * 1024); } while (0)
#define PG8_LDB(dst, b, h) do { _Pragma("unroll") for (int n = 0; n < 2; ++n) _Pragma("unroll") for (int k = 0; k < 2; ++k) dst[n][k] = *(const LAS bf16x8*)(lds + PG8_SB(b, h) + boff + n * 2048 + k * 1024); } while (0)
#define PG8_MMA(ai, bj, At, Bt) do { __builtin_amdgcn_s_setprio(1); _Pragma("unroll") for (int m = 0; m < 4; ++m) _Pragma("unroll") for (int n = 0; n < 2; ++n) _Pragma("unroll") for (int k = 0; k < 2; ++k) \
        acc[ai][bj][m][n] = __builtin_amdgcn_mfma_f32_16x16x32_bf16(Bt[n][k], At[m][k], acc[ai][bj][m][n], 0, 0, 0); __builtin_amdgcn_s_setprio(0); } while (0)
#define PG8_WAIT_V(n) asm volatile("s_waitcnt vmcnt(" #n ")" ::: "memory")
#define PG8_WAIT_L(n) asm volatile("s_waitcnt lgkmcnt(" #n ")" ::: "memory")
#define PG8_BAR __builtin_amdgcn_s_barrier()
#define PG8_SCHED __builtin_amdgcn_sched_barrier(0)
    Unit cur, nxt; int ui = 0;
    if (!S.next(0, cur)) return;
    f32x4 acc[2][2][4][2];
#pragma unroll
    for (int a = 0; a < 2; ++a)
#pragma unroll
        for (int b = 0; b < 2; ++b)
#pragma unroll
            for (int m = 0; m < 4; ++m)
#pragma unroll
                for (int n = 0; n < 2; ++n) acc[a][b][m][n] = (f32x4){0.f, 0.f, 0.f, 0.f};
    bf16x8 At[4][2], B0[2][2], B1[2][2];
    unsigned va0[2], va1[2], na0[2], na1[2];
    S.avoff(cur, R0, C0, R1, C1, va0, va1);
    na0[0] = va0[0]; na0[1] = va0[1]; na1[0] = va1[0]; na1[1] = va1[1];
    const char* cA = S.abase(cur); const char* cB = S.bbase(cur);
    PG8_STAGE(PG8_SB(0, 0), cB, voffB); PG8_STAGE(PG8_SB(0, 1), cB + hstepB, voffB); PG8_STAGE(PG8_SA(0, 0), cA, va0); PG8_STAGE(PG8_SA(0, 1), cA, va1);
    if (wr == 1) PG8_BAR;
    PG8_WAIT_V(2); PG8_BAR;
    PG8_STAGE(PG8_SB(1, 0), cB + kstep, voffB); PG8_STAGE(PG8_SA(1, 0), cA + kstep, va0); PG8_STAGE(PG8_SB(1, 1), cB + hstepB + kstep, voffB);
    PG8_WAIT_V(6); PG8_BAR;
    for (;;) {
        const bool has_next = S.next(ui + 1, nxt);
        const char* nA = has_next ? S.abase(nxt) : cA; const char* nB = has_next ? S.bbase(nxt) : cB;
        if constexpr (GATHER) { if (has_next) S.avoff(nxt, R0, C0, R1, C1, na0, na1); }
#pragma unroll 1
        for (int t = 0; t < nt; t += 2) {
            const bool last = (t == nt - 2);
            const char* a1 = cA + (size_t)(t + 1) * kstep;
            const char* a2 = last ? nA : cA + (size_t)(t + 2) * kstep; const char* b2 = last ? nB : cB + (size_t)(t + 2) * kstep;
            const char* a3 = a2 + kstep; const char* b3 = b2 + kstep;
            unsigned x0[2], x1[2];
            if constexpr (GATHER) { x0[0] = last ? na0[0] : va0[0]; x0[1] = last ? na0[1] : va0[1]; x1[0] = last ? na1[0] : va1[0]; x1[1] = last ? na1[1] : va1[1]; }
            else { x0[0] = va0[0]; x0[1] = va0[1]; x1[0] = va1[0]; x1[1] = va1[1]; }
            PG8_LDB(B0, 0, 0); PG8_LDB(B1, 0, 1); PG8_SCHED; PG8_LDA(At, 0, 0); PG8_STAGE(PG8_SA(1, 1), a1, va1);
            PG8_WAIT_V(8); PG8_WAIT_L(0); PG8_BAR; PG8_MMA(0, 0, At, B0); PG8_MMA(0, 1, At, B1); PG8_BAR; PG8_SCHED;
            PG8_LDA(At, 0, 1); PG8_STAGE(PG8_SB(0, 0), b2, voffB); PG8_STAGE(PG8_SB(0, 1), b2 + hstepB, voffB); PG8_STAGE(PG8_SA(0, 0), a2, x0);
            PG8_WAIT_V(8); PG8_WAIT_L(0); PG8_BAR; PG8_MMA(1, 0, At, B0); PG8_MMA(1, 1, At, B1); PG8_BAR; PG8_SCHED;
            PG8_LDB(B0, 1, 0); PG8_LDB(B1, 1, 1); PG8_SCHED; PG8_LDA(At, 1, 0); PG8_STAGE(PG8_SA(0, 1), a2, x1);
            PG8_WAIT_V(8); PG8_WAIT_L(0); PG8_BAR; PG8_MMA(0, 0, At, B0); PG8_MMA(0, 1, At, B1); PG8_BAR; PG8_SCHED;
            PG8_LDA(At, 1, 1); PG8_STAGE(PG8_SB(1, 0), b3, voffB); PG8_STAGE(PG8_SB(1, 1), b3 + hstepB, voffB); PG8_STAGE(PG8_SA(1, 0), a3, x0);
            PG8_WAIT_V(8); PG8_WAIT_L(0); PG8_BAR; PG8_MMA(1, 0, At, B0); PG8_MMA(1, 1, At, B1); PG8_BAR; PG8_SCHED;
        }
        if (wr == 0) PG8_BAR;
        E(acc, cur, wr, wc, fr, fq);
        if (!has_next) break;
#pragma unroll
        for (int a = 0; a < 2; ++a)
#pragma unroll
            for (int b = 0; b < 2; ++b)
#pragma unroll
                for (int m = 0; m < 4; ++m)
#pragma unroll
                    for (int n = 0; n < 2; ++n) acc[a][b][m][n] = (f32x4){0.f, 0.f, 0.f, 0.f};
        cur = nxt; cA = nA; cB = nB; ++ui;
        if constexpr (GATHER) { va0[0] = na0[0]; va0[1] = na0[1]; va1[0] = na1[0]; va1[1] = na1[1]; }
        if (wr == 1) PG8_BAR;
    }
    PG8_WAIT_V(0);
    PG8_BAR;
#undef PG8_SA
#undef PG8_SB
#undef PG8_STAGE
#undef PG8_LDA
#undef PG8_LDB
#undef PG8_MMA
#undef PG8_WAIT_V
#undef PG8_WAIT_L
#undef PG8_BAR
#undef PG8_SCHED
}

__device__ __forceinline__ u32x4 pack8(const f32x4 a, const f32x4 b) { u32x4 w; w.x = cvt_pk_bf16(a[0], a[1]); w.y = cvt_pk_bf16(a[2], a[3]); w.z = cvt_pk_bf16(b[0], b[1]); w.w = cvt_pk_bf16(b[2], b[3]); return w; }

struct EpiIn {
    bf16_t *u, *gb, *sg, *lat; float* ssp;
    __device__ __forceinline__ void operator()(const f32x4 (&acc)[2][2][4][2], const Unit& un, int wr, int wc, int fr, int fq) const {
        const int row0 = un.pm * BM + wr * 64 + fr, pn = un.pn;
        if (pn < 16) {
            const int ch = 64 * pn + 16 * wc + 4 * fq;
#pragma unroll
            for (int ai = 0; ai < 2; ++ai)
#pragma unroll
                for (int m = 0; m < 4; ++m) { const size_t off = (size_t)(row0 + ai * HALF + m * 16) * DM + ch;
                    const f32x4 zx = acc[ai][0][m][0], zc = acc[ai][0][m][1], zb = acc[ai][1][m][0], zg = acc[ai][1][m][1];
                    const f32x4 uu = zx * zc; f32x4 g; g[0] = zb[0] * fsigmoid(zg[0]); g[1] = zb[1] * fsigmoid(zg[1]); g[2] = zb[2] * fsigmoid(zg[2]); g[3] = zb[3] * fsigmoid(zg[3]);
                    u32x2 w0, w1; w0.x = cvt_pk_bf16(uu[0], uu[1]); w0.y = cvt_pk_bf16(uu[2], uu[3]); w1.x = cvt_pk_bf16(g[0], g[1]); w1.y = cvt_pk_bf16(g[2], g[3]);
                    *(u32x2*)(u + off) = w0; *(u32x2*)(gb + off) = w1; }
        } else if (pn < 20) {
            const int c0 = 256 * (pn - 16) + 32 * wc + 8 * fq;
#pragma unroll
            for (int ai = 0; ai < 2; ++ai)
#pragma unroll
                for (int m = 0; m < 4; ++m)
#pragma unroll
                    for (int bj = 0; bj < 2; ++bj) { f32x4 a = acc[ai][bj][m][0], b = acc[ai][bj][m][1];
#pragma unroll
                        for (int i = 0; i < 4; ++i) { a[i] = fsigmoid(a[i]); b[i] = fsigmoid(b[i]); }
                        *(u32x4*)(sg + (size_t)(row0 + ai * HALF + m * 16) * DM + c0 + bj * HALF) = pack8(a, b); }
        } else {
            const int c0 = 256 * (pn - 20) + 32 * wc + 8 * fq;
#pragma unroll
            for (int ai = 0; ai < 2; ++ai)
#pragma unroll
                for (int m = 0; m < 4; ++m) { const int row = row0 + ai * HALF + m * 16; float s0, s1;
                    { const f32x4 a = acc[ai][0][m][0], b = acc[ai][0][m][1]; *(u32x4*)(lat + (size_t)row * LATW + c0) = pack8(a, b);
                      s0 = (a[0] * a[0] + a[1] * a[1]) + (a[2] * a[2] + a[3] * a[3]) + (b[0] * b[0] + b[1] * b[1]) + (b[2] * b[2] + b[3] * b[3]); }
                    { const f32x4 a = acc[ai][1][m][0], b = acc[ai][1][m][1]; *(u32x4*)(lat + (size_t)row * LATW + c0 + HALF) = pack8(a, b);
                      s1 = (a[0] * a[0] + a[1] * a[1]) + (a[2] * a[2] + a[3] * a[3]) + (b[0] * b[0] + b[1] * b[1]) + (b[2] * b[2] + b[3] * b[3]); }
                    s0 += __shfl_xor(s0, 16); s0 += __shfl_xor(s0, 32); s1 += __shfl_xor(s1, 16); s1 += __shfl_xor(s1, 32);
                    if (fq == 0) {
                        if (pn == 20) ssp[(size_t)wc * M + row] = s0 + s1;
                        else if (pn == 21) { ssp[(size_t)(4 + wc) * M + row] = s0; ssp[(size_t)(12 + wc) * M + row] = s1; }
                        else ssp[(size_t)(8 + wc) * M + row] = s0 + s1; } }
        }
    }
};
struct EpiPlain {
    bf16_t* O; int ldc;
    __device__ __forceinline__ void operator()(const f32x4 (&acc)[2][2][4][2], const Unit& un, int wr, int wc, int fr, int fq) const {
        const int row0 = un.pm * BM + wr * 64 + fr, c0 = 256 * un.pn + 32 * wc + 8 * fq;
#pragma unroll
        for (int ai = 0; ai < 2; ++ai)
#pragma unroll
            for (int m = 0; m < 4; ++m)
#pragma unroll
                for (int bj = 0; bj < 2; ++bj) *(u32x4*)(O + (size_t)(row0 + ai * HALF + m * 16) * ldc + c0 + bj * HALF) = pack8(acc[ai][bj][m][0], acc[ai][bj][m][1]);
    }
};
struct EpiKV {
    bf16_t *Kb, *Vb; const bf16_t* lat; const float* ssp; const float2* cs; const float* k_g; LAS float* xch;
    __device__ __forceinline__ void operator()(const f32x4 (&acc)[2][2][4][2], const Unit& un, int wr, int wc, int fr, int fq) const {
        asm volatile("" : "+v"(fr), "+v"(fq));
        const int h = un.pn, rowt = wr * 64 + fr, b = (un.pm * BM) / SEQ, s0 = (un.pm * BM) % SEQ;
#pragma unroll
        for (int ai = 0; ai < 2; ++ai)
#pragma unroll
            for (int m = 0; m < 4; ++m) {
                const f32x4 a = acc[ai][0][m][0], c = acc[ai][0][m][1];
                float ss = (a[0] * a[0] + a[1] * a[1]) + (a[2] * a[2] + a[3] * a[3]) + (c[0] * c[0] + c[1] * c[1]) + (c[2] * c[2] + c[3] * c[3]);
                ss += __shfl_xor(ss, 16); ss += __shfl_xor(ss, 32);
                if (fq == 0) xch[(rowt + ai * HALF + m * 16) * 4 + wc] = ss; }
        asm volatile("s_waitcnt lgkmcnt(0)" ::: "memory"); __builtin_amdgcn_s_barrier(); asm volatile("" ::: "memory");
        const int c8 = 32 * wc + 8 * fq;
        const f32x4 g0 = *(const f32x4*)(k_g + c8), g1 = *(const f32x4*)(k_g + c8 + 4);
        const int i0 = 8 * wc + 2 * fq;
        const f32x2 gr1 = *(const f32x2*)(k_g + 128 + i0), gr2 = *(const f32x2*)(k_g + 160 + i0);
#pragma unroll
        for (int ai = 0; ai < 2; ++ai)
#pragma unroll
            for (int m = 0; m < 4; ++m) { const int rt = rowt + ai * HALF + m * 16, row = un.pm * BM + rt;
                const float skv = (ssp[(size_t)8 * M + row] + ssp[(size_t)9 * M + row]) + (ssp[(size_t)10 * M + row] + ssp[(size_t)11 * M + row]);
                const float skr = (ssp[(size_t)12 * M + row] + ssp[(size_t)13 * M + row]) + (ssp[(size_t)14 * M + row] + ssp[(size_t)15 * M + row]);
                const float rkv = 1.f / sqrtf(skv * (1.f / KVL) + EPS);
                const f32x4 t4 = *(const LAS f32x4*)(xch + rt * 4);
                const float rk = 1.f / sqrtf((((t4[0] + t4[1]) + (t4[2] + t4[3])) * rkv * rkv + skr) * (1.f / QKH) + EPS);
                const float sk = rkv * rk, sv = rkv;
                const size_t bhs = (size_t)(b * NH + h) * SEQ + s0 + rt;
                bf16_t* Kp = Kb + bhs * QKH; bf16_t* Vp = Vb + bhs * VH;
                *(u32x4*)(Kp + c8) = pack8(acc[ai][0][m][0] * sk * g0, acc[ai][0][m][1] * sk * g1);
                *(u32x4*)(Vp + c8) = pack8(acc[ai][1][m][0] * sv, acc[ai][1][m][1] * sv);
                const unsigned r1 = *(const unsigned*)(lat + (size_t)row * LATW + 384 + i0), r2 = *(const unsigned*)(lat + (size_t)row * LATW + 416 + i0);
                const f32x4 c2 = *(const f32x4*)((const float*)cs + ((size_t)row * 32 + i0) * 2);
                const float x1a = __uint_as_float(r1 << 16) * rk * gr1[0], x1b = __uint_as_float(r1 & 0xffff0000u) * rk * gr1[1];
                const float x2a = __uint_as_float(r2 << 16) * rk * gr2[0], x2b = __uint_as_float(r2 & 0xffff0000u) * rk * gr2[1];
                *(unsigned*)(Kp + 128 + i0) = cvt_pk_bf16(x1a * c2[0] - x2a * c2[1], x1b * c2[2] - x2b * c2[3]);
                *(unsigned*)(Kp + 160 + i0) = cvt_pk_bf16(x2a * c2[0] + x1a * c2[1], x2b * c2[2] + x1b * c2[3]);
                if (m & 1) asm volatile("" ::: "memory"); }
    }
};
struct EpiWo {
    const float* x; const float* mod; float* out;
    __device__ __forceinline__ void operator()(const f32x4 (&acc)[2][2][4][2], const Unit& un, int wr, int wc, int fr, int fq) const {
        const int row0 = un.pm * BM + wr * 64 + fr, b = (un.pm * BM) / SEQ, c0 = 256 * un.pn + 32 * wc + 4 * fq;
        const float* gate = mod + b * 6144 + 2048;
#pragma unroll
        for (int bj = 0; bj < 2; ++bj)
#pragma unroll
            for (int n = 0; n < 2; ++n) { const int c = c0 + bj * HALF + n * 16; const f32x4 gv = *(const f32x4*)(gate + c);
#pragma unroll
                for (int ai = 0; ai < 2; ++ai)
#pragma unroll
                    for (int m = 0; m < 4; ++m) { const size_t off = (size_t)(row0 + ai * HALF + m * 16) * DM + c;
                        *(f32x4*)(out + off) = *(const f32x4*)(x + off) + gv * acc[ai][bj][m][n]; } }
    }
};
namespace att {
constexpr int NW = 8, QBLK = 32, KVBLK = 64, KPITCH = 400;
constexpr int SHM_V = KVBLK * VH * 2, SHM_K = KVBLK * KPITCH;
constexpr int QRP = 144;
constexpr int OFF_V = 0, OFF_K = 2 * SHM_V, OFF_WS = OFF_K + 2 * SHM_K, OFF_QR = OFF_WS + NW * 64 * 4, ATT_LDS = OFF_QR + NW * 32 * QRP;
constexpr float SCALE = 0.07216878364870322f;
constexpr float THR = 8.f;
#define SBAR() __builtin_amdgcn_sched_barrier(0)
__device__ __forceinline__ int crow(int r, int hi) { return (r & 3) + 8 * (r >> 2) + 4 * hi; }
__device__ __forceinline__ void partialSM(f32x16& p0, f32x16& p1, float& m_reg, float& alpha) {
    constexpr float C = SCALE * 1.4426950408889634f;
    float pmax = p0[0];
#pragma unroll
    for (int r = 1; r < 16; ++r) pmax = fmaxf(pmax, p0[r]);
#pragma unroll
    for (int r = 0; r < 16; ++r) pmax = fmaxf(pmax, p1[r]);
    { auto rr = __builtin_amdgcn_permlane32_swap(__float_as_uint(pmax), __float_as_uint(pmax), false, false);
      pmax = fmaxf(__uint_as_float(rr[0]), __uint_as_float(rr[1])); }
    float mn;
    if (__builtin_expect(__all(pmax - m_reg <= THR / SCALE), 1)) { mn = m_reg; alpha = 1.f; }
    else { mn = fmaxf(m_reg, pmax); alpha = __builtin_amdgcn_exp2f((m_reg - mn) * C); m_reg = mn; }
    const float mnC = -mn * C;
#pragma unroll
    for (int r = 0; r < 16; ++r) p0[r] = fmaf(p0[r], C, mnC);
#pragma unroll
    for (int r = 0; r < 16; ++r) p1[r] = fmaf(p1[r], C, mnC);
#pragma unroll
    for (int r = 0; r < 16; ++r) p0[r] = __builtin_amdgcn_exp2f(p0[r]);
}
__device__ __forceinline__ void finishSM(f32x16& p0, f32x16& p1, float alpha, float& l_reg, bf16x8& pa0, bf16x8& pa1, bf16x8& pa2, bf16x8& pa3) {
#pragma unroll
    for (int r = 0; r < 16; ++r) p1[r] = __builtin_amdgcn_exp2f(p1[r]);
    float ps = 0;
#pragma unroll
    for (int r = 0; r < 16; ++r) ps += p0[r];
#pragma unroll
    for (int r = 0; r < 16; ++r) ps += p1[r];
    { auto rr = __builtin_amdgcn_permlane32_swap(__float_as_uint(ps), __float_as_uint(ps), false, false);
      ps = __uint_as_float(rr[0]) + __uint_as_float(rr[1]); }
    l_reg = l_reg * alpha + ps;
#define PK4(P, BASE, OUT) do { unsigned a0 = cvt_pk_bf16(P[BASE + 0], P[BASE + 1]), a1 = cvt_pk_bf16(P[BASE + 2], P[BASE + 3]);   \
    unsigned b0 = cvt_pk_bf16(P[BASE + 4], P[BASE + 5]), b1 = cvt_pk_bf16(P[BASE + 6], P[BASE + 7]);                              \
    auto r0 = __builtin_amdgcn_permlane32_swap(a0, b0, false, false); auto r1 = __builtin_amdgcn_permlane32_swap(a1, b1, false, false); \
    u32x4 w = {r0[0], r1[0], r0[1], r1[1]}; OUT = *reinterpret_cast<bf16x8*>(&w); } while (0)
    PK4(p0, 0, pa0); PK4(p0, 8, pa1); PK4(p1, 0, pa2); PK4(p1, 8, pa3);
#undef PK4
}
__device__ __forceinline__ void qkt(f32x16& p0, f32x16& p1, const LAS char* Ks, const bf16x8 (&qr)[8], const LAS char* qrope, int r32, int hi) {
    p0 = f32x16{}; p1 = f32x16{};
    const LAS char* k0 = Ks + r32 * KPITCH + hi * 16;
#pragma unroll
    for (int d0 = 0; d0 < 8; ++d0) {
        const bf16x8 b0 = *(const LAS bf16x8*)(k0 + d0 * 32);
        const bf16x8 b1 = *(const LAS bf16x8*)(k0 + 32 * KPITCH + d0 * 32);
        p0 = __builtin_amdgcn_mfma_f32_32x32x16_bf16(b0, qr[d0], p0, 0, 0, 0);
        p1 = __builtin_amdgcn_mfma_f32_32x32x16_bf16(b1, qr[d0], p1, 0, 0, 0); }
#pragma unroll
    for (int d0 = 8; d0 < 12; ++d0) {
        const bf16x8 b0 = *(const LAS bf16x8*)(k0 + d0 * 32);
        const bf16x8 b1 = *(const LAS bf16x8*)(k0 + 32 * KPITCH + d0 * 32);
        const bf16x8 qf = *(const LAS bf16x8*)(qrope + (d0 - 8) * 32);
        p0 = __builtin_amdgcn_mfma_f32_32x32x16_bf16(b0, qf, p0, 0, 0, 0);
        p1 = __builtin_amdgcn_mfma_f32_32x32x16_bf16(b1, qf, p1, 0, 0, 0); }
}
__device__ __forceinline__ int v_st(int k, int c) { const int kk = (k & ~0xC) | ((k & 4) << 1) | ((k & 8) >> 1); return ((kk >> 3) * 4 + (c >> 5)) * 512 + ((kk & 7) * 32 + (c & 31)) * 2; }
__device__ __forceinline__ int v_rd_base(int lane) { return ((lane & 3) << 3) | (((lane >> 2) & 3) << 6) | (((lane >> 4) & 1) << 5) | (((lane >> 5) & 1) << 8); }
constexpr int v_rd_off(int d0, int ks, int half) { return d0 * 512 + ks * 4096 + half * 2048; }
template <int OFF> __device__ __forceinline__ s16x4 tr_read(int vb) {
    s16x4 r; asm volatile("ds_read_b64_tr_b16 %0, %1 offset:%2" : "=&v"(r) : "v"(vb), "i"(OFF) : "memory"); return r;
}
template <int D0> __device__ __forceinline__ void pv_one(f32x16& od, int vb, bf16x8 pa0, bf16x8 pa1, bf16x8 pa2, bf16x8 pa3) {
#define PK(L, H) (bf16x8){L[0], L[1], L[2], L[3], H[0], H[1], H[2], H[3]}
    { const s16x4 l0 = tr_read<v_rd_off(D0, 0, 0)>(vb), h0 = tr_read<v_rd_off(D0, 0, 1)>(vb), l1 = tr_read<v_rd_off(D0, 1, 0)>(vb), h1 = tr_read<v_rd_off(D0, 1, 1)>(vb);
      asm volatile("s_waitcnt lgkmcnt(0)" ::: "memory"); SBAR();
      od = __builtin_amdgcn_mfma_f32_32x32x16_bf16(pa0, PK(l0, h0), od, 0, 0, 0);
      od = __builtin_amdgcn_mfma_f32_32x32x16_bf16(pa1, PK(l1, h1), od, 0, 0, 0); }
    { const s16x4 l2 = tr_read<v_rd_off(D0, 2, 0)>(vb), h2 = tr_read<v_rd_off(D0, 2, 1)>(vb), l3 = tr_read<v_rd_off(D0, 3, 0)>(vb), h3 = tr_read<v_rd_off(D0, 3, 1)>(vb);
      asm volatile("s_waitcnt lgkmcnt(0)" ::: "memory"); SBAR();
      od = __builtin_amdgcn_mfma_f32_32x32x16_bf16(pa2, PK(l2, h2), od, 0, 0, 0);
      od = __builtin_amdgcn_mfma_f32_32x32x16_bf16(pa3, PK(l3, h3), od, 0, 0, 0); }
#undef PK
}
__device__ __forceinline__ void pv_d0(f32x16 (&o)[4], int vb, bf16x8 pa0, bf16x8 pa1, bf16x8 pa2, bf16x8 pa3) {
    pv_one<0>(o[0], vb, pa0, pa1, pa2, pa3); pv_one<1>(o[1], vb, pa0, pa1, pa2, pa3); pv_one<2>(o[2], vb, pa0, pa1, pa2, pa3); pv_one<3>(o[3], vb, pa0, pa1, pa2, pa3);
}
__device__ __forceinline__ float bflo(unsigned w) { return __uint_as_float(w << 16); }
__device__ __forceinline__ float bfhi(unsigned w) { return __uint_as_float(w & 0xffff0000u); }

struct AttnArgs { const bf16_t* Q; const bf16_t* Kb; const bf16_t* Vb; const float* ssp; const float2* cs; const float* q_g; const bf16_t *u, *gb, *sg; const float* conv_w; bf16_t* merged; };

__device__ __forceinline__ void attn_unit(const AttnArgs& T, int b, int h, int qb, LAS char* lds) {
    int tid = threadIdx.x; asm volatile("" : "+v"(tid));
    const int lane = tid & 63, r32 = lane & 31, hi = lane >> 5; const int wid = __builtin_amdgcn_readfirstlane(tid >> 6);
    LAS char* V_lds = lds + OFF_V; LAS char* K_lds = lds + OFF_K;
    LAS float* ws = (LAS float*)(lds + OFF_WS) + wid * 64; LAS float* li_l = ws; LAS float* al_l = ws + 32;
    const int mrow = b * SEQ + qb * 256 + wid * QBLK + r32;
    const bf16_t* Kh = T.Kb + (size_t)(b * NH + h) * SEQ * QKH; const bf16_t* Vh = T.Vb + (size_t)(b * NH + h) * SEQ * VH;
    const int sr = tid >> 4, sc = (tid & 15) * 8, vst0 = v_st(sr, sc), vst1 = v_st(32 + sr, sc);
    int kdst[3];
#pragma unroll
    for (int i = 0; i < 3; ++i) { const int id = tid + 512 * i; kdst[i] = (id / 24) * KPITCH + (id % 24) * 16; }
    const int vb0 = (int)(uintptr_t)V_lds + v_rd_base(lane);
    bf16x8 sk0, sk1, sk2, sv0, sv1;
#define SLOAD(t) do { const bf16_t* kp = Kh + (size_t)(t) * KVBLK * QKH + tid * 8; sk0 = *(const bf16x8*)kp; sk1 = *(const bf16x8*)(kp + 4096); sk2 = *(const bf16x8*)(kp + 8192); \
    const bf16_t* vp = Vh + (size_t)((t) * KVBLK + sr) * VH + sc; sv0 = *(const bf16x8*)vp; sv1 = *(const bf16x8*)(vp + 32 * VH); } while (0)
#define SWRITE(bf) do { *(LAS bf16x8*)(V_lds + (bf) * SHM_V + vst0) = sv0; *(LAS bf16x8*)(V_lds + (bf) * SHM_V + vst1) = sv1; \
    *(LAS bf16x8*)(K_lds + (bf) * SHM_K + kdst[0]) = sk0; *(LAS bf16x8*)(K_lds + (bf) * SHM_K + kdst[1]) = sk1; *(LAS bf16x8*)(K_lds + (bf) * SHM_K + kdst[2]) = sk2; } while (0)
#define RESC(a) do { if (__any((a) < 1.f)) { if (hi == 0) al_l[r32] = (a); asm volatile("s_waitcnt lgkmcnt(0)" ::: "memory"); \
    _Pragma("unroll") for (int d = 0; d < 4; ++d) _Pragma("unroll") for (int r = 0; r < 16; ++r) o[d][r] *= al_l[crow(r, hi)]; } } while (0)
    SLOAD(0);
    bf16x8 qr[8];
    LAS char* qrope = lds + OFF_QR + wid * (32 * QRP) + r32 * QRP + hi * 16;
    {
        const bf16_t* Qw = T.Q + (size_t)mrow * 1536 + h * QKH + hi * 8;
        u32x4 raw[12];
#pragma unroll
        for (int d0 = 0; d0 < 12; ++d0) raw[d0] = *(const u32x4*)(Qw + d0 * 16);
        float ssq = 0.f;
#pragma unroll
        for (int j = 0; j < 8; ++j) ssq += T.ssp[(size_t)j * M + mrow];
        float ss = 0.f;
#pragma unroll
        for (int d0 = 0; d0 < 12; ++d0)
#pragma unroll
            for (int e = 0; e < 4; ++e) { const float a = bflo(raw[d0][e]), c = bfhi(raw[d0][e]); ss += a * a + c * c; }
        { auto rr = __builtin_amdgcn_permlane32_swap(__float_as_uint(ss), __float_as_uint(ss), false, false); ss = __uint_as_float(rr[0]) + __uint_as_float(rr[1]); }
        const float rq2 = 1.f / (ssq * (1.f / QL) + EPS);
        const float rn = 1.f / sqrtf(ss * rq2 * (1.f / QKH) + EPS) * sqrtf(rq2);
#pragma unroll
        for (int d0 = 0; d0 < 8; ++d0) { const f32x4 g0 = *(const f32x4*)(T.q_g + d0 * 16 + hi * 8), g1 = *(const f32x4*)(T.q_g + d0 * 16 + hi * 8 + 4);
            u32x4 w; w.x = cvt_pk_bf16(bflo(raw[d0].x) * rn * g0[0], bfhi(raw[d0].x) * rn * g0[1]); w.y = cvt_pk_bf16(bflo(raw[d0].y) * rn * g0[2], bfhi(raw[d0].y) * rn * g0[3]);
            w.z = cvt_pk_bf16(bflo(raw[d0].z) * rn * g1[0], bfhi(raw[d0].z) * rn * g1[1]); w.w = cvt_pk_bf16(bflo(raw[d0].w) * rn * g1[2], bfhi(raw[d0].w) * rn * g1[3]);
            qr[d0] = *reinterpret_cast<bf16x8*>(&w); }
#pragma unroll
        for (int p = 0; p < 2; ++p) {
            const int ib = 16 * p + 8 * hi;
            float x1[8], x2[8];
            const f32x4 ga = *(const f32x4*)(T.q_g + 128 + ib), gb_ = *(const f32x4*)(T.q_g + 128 + ib + 4), gc = *(const f32x4*)(T.q_g + 160 + ib), gd = *(const f32x4*)(T.q_g + 160 + ib + 4);
            const float g1v[8] = {ga[0], ga[1], ga[2], ga[3], gb_[0], gb_[1], gb_[2], gb_[3]}, g2v[8] = {gc[0], gc[1], gc[2], gc[3], gd[0], gd[1], gd[2], gd[3]};
#pragma unroll
            for (int e = 0; e < 4; ++e) { x1[2 * e] = bflo(raw[8 + p][e]) * rn * g1v[2 * e]; x1[2 * e + 1] = bfhi(raw[8 + p][e]) * rn * g1v[2 * e + 1];
                                          x2[2 * e] = bflo(raw[10 + p][e]) * rn * g2v[2 * e]; x2[2 * e + 1] = bfhi(raw[10 + p][e]) * rn * g2v[2 * e + 1]; }
            float y1[8], y2[8];
#pragma unroll
            for (int jj = 0; jj < 4; ++jj) { const f32x4 c2 = *(const f32x4*)((const float*)T.cs + ((size_t)mrow * 32 + ib + 2 * jj) * 2);
                y1[2 * jj] = x1[2 * jj] * c2[0] - x2[2 * jj] * c2[1]; y2[2 * jj] = x2[2 * jj] * c2[0] + x1[2 * jj] * c2[1];
                y1[2 * jj + 1] = x1[2 * jj + 1] * c2[2] - x2[2 * jj + 1] * c2[3]; y2[2 * jj + 1] = x2[2 * jj + 1] * c2[2] + x1[2 * jj + 1] * c2[3]; }
            u32x4 w1, w2; w1.x = cvt_pk_bf16(y1[0], y1[1]); w1.y = cvt_pk_bf16(y1[2], y1[3]); w1.z = cvt_pk_bf16(y1[4], y1[5]); w1.w = cvt_pk_bf16(y1[6], y1[7]);
            w2.x = cvt_pk_bf16(y2[0], y2[1]); w2.y = cvt_pk_bf16(y2[2], y2[3]); w2.z = cvt_pk_bf16(y2[4], y2[5]); w2.w = cvt_pk_bf16(y2[6], y2[7]);
            *(LAS u32x4*)(qrope + p * 32) = w1; *(LAS u32x4*)(qrope + (2 + p) * 32) = w2; }
        asm volatile("s_waitcnt lgkmcnt(0)" ::: "memory");
    }
    float m_reg = -1e30f, l_reg = 0.f; f32x16 o[4] = {};
    f32x16 pA0, pA1, pB0, pB1; float alA = 1.f, alB = 1.f; bf16x8 pa0, pa1, pa2, pa3;
    const int NT = 4 * qb + 4; const int wp = wid >> 1;
    const bool a1 = wp >= 1, a2 = wp >= 2, a3 = wp >= 3;
    const LAS char* K0 = K_lds; const LAS char* K1 = K_lds + SHM_K;
    asm volatile("s_waitcnt vmcnt(0)" ::: "memory"); SWRITE(0); __syncthreads();
    qkt(pA0, pA1, K0, qr, qrope, r32, hi); partialSM(pA0, pA1, m_reg, alA);
    SLOAD(1); asm volatile("s_waitcnt vmcnt(0)" ::: "memory"); SWRITE(1); __syncthreads();
    for (int j = 1; j + 3 < NT; j += 2) {
        SBAR(); qkt(pB0, pB1, K1, qr, qrope, r32, hi);
        finishSM(pA0, pA1, alA, l_reg, pa0, pa1, pa2, pa3); SBAR();
        SLOAD(j + 1); SBAR();
        pv_d0(o, vb0, pa0, pa1, pa2, pa3); partialSM(pB0, pB1, m_reg, alB);
        __syncthreads(); asm volatile("s_waitcnt vmcnt(0)" ::: "memory"); SWRITE(0);
        RESC(alB); __syncthreads();
        SBAR(); qkt(pA0, pA1, K0, qr, qrope, r32, hi);
        finishSM(pB0, pB1, alB, l_reg, pa0, pa1, pa2, pa3); SBAR();
        SLOAD(j + 2); SBAR();
        pv_d0(o, vb0 + SHM_V, pa0, pa1, pa2, pa3); partialSM(pA0, pA1, m_reg, alA);
        __syncthreads(); asm volatile("s_waitcnt vmcnt(0)" ::: "memory"); SWRITE(1);
        RESC(alA); __syncthreads();
    }
#define MASK(P0, P1, act) do { if (!(act)) { _Pragma("unroll") for (int r = 0; r < 16; ++r) { P0[r] = -INFINITY; P1[r] = -INFINITY; } } } while (0)
    {
        SBAR(); qkt(pB0, pB1, K1, qr, qrope, r32, hi); MASK(pB0, pB1, a1);
        finishSM(pA0, pA1, alA, l_reg, pa0, pa1, pa2, pa3); SBAR();
        SLOAD(NT - 2); SBAR();
        pv_d0(o, vb0, pa0, pa1, pa2, pa3); partialSM(pB0, pB1, m_reg, alB);
        __syncthreads(); asm volatile("s_waitcnt vmcnt(0)" ::: "memory"); SWRITE(0);
        RESC(alB); __syncthreads();
        SBAR(); qkt(pA0, pA1, K0, qr, qrope, r32, hi); MASK(pA0, pA1, a2);
        finishSM(pB0, pB1, alB, l_reg, pa0, pa1, pa2, pa3); SBAR();
        SLOAD(NT - 1); SBAR();
        pv_d0(o, vb0 + SHM_V, pa0, pa1, pa2, pa3); partialSM(pA0, pA1, m_reg, alA);
        __syncthreads(); asm volatile("s_waitcnt vmcnt(0)" ::: "memory"); SWRITE(1);
        RESC(alA); __syncthreads();
        SBAR(); qkt(pB0, pB1, K1, qr, qrope, r32, hi); MASK(pB0, pB1, a3);
        finishSM(pA0, pA1, alA, l_reg, pa0, pa1, pa2, pa3); SBAR();
        pv_d0(o, vb0, pa0, pa1, pa2, pa3); partialSM(pB0, pB1, m_reg, alB);
        RESC(alB);
        finishSM(pB0, pB1, alB, l_reg, pa0, pa1, pa2, pa3); SBAR();
        pv_d0(o, vb0 + SHM_V, pa0, pa1, pa2, pa3);
    }
#undef MASK
    if (hi == 0) li_l[r32] = l_reg; asm volatile("s_waitcnt lgkmcnt(0)" ::: "memory");
    float rli[16];
#pragma unroll
    for (int r = 0; r < 16; ++r) rli[r] = __builtin_amdgcn_rcpf(li_l[crow(r, hi)]);
    __syncthreads();
    LAS bf16_t* stg = (LAS bf16_t*)(lds + wid * 8192);
#pragma unroll
    for (int r = 0; r < 16; ++r) { const int orow = crow(r, hi);
#pragma unroll
        for (int d0 = 0; d0 < 4; ++d0) stg[orow * 128 + d0 * 32 + r32] = f2bf(o[d0][r] * rli[r]); }
    asm volatile("s_waitcnt lgkmcnt(0)" ::: "memory");
    {
        const int ch = lane & 15, c = h * VH + ch * 8;
        const f32x4 w0a = *(const f32x4*)(T.conv_w + c), w0b = *(const f32x4*)(T.conv_w + c + 4), w1a = *(const f32x4*)(T.conv_w + DM + c), w1b = *(const f32x4*)(T.conv_w + DM + c + 4),
              w2a = *(const f32x4*)(T.conv_w + 2 * DM + c), w2b = *(const f32x4*)(T.conv_w + 2 * DM + c + 4);
        const float cw0[8] = {w0a[0], w0a[1], w0a[2], w0a[3], w0b[0], w0b[1], w0b[2], w0b[3]}, cw1[8] = {w1a[0], w1a[1], w1a[2], w1a[3], w1b[0], w1b[1], w1b[2], w1b[3]},
                    cw2[8] = {w2a[0], w2a[1], w2a[2], w2a[3], w2b[0], w2b[1], w2b[2], w2b[3]};
#pragma unroll 1
        for (int i = 0; i < 8; ++i) { const int row = i * 4 + (lane >> 4); const int tt = qb * 256 + wid * QBLK + row; const size_t e = (size_t)(b * SEQ + tt) * DM + c;
            const u32x4 ov = *(const LAS u32x4*)(stg + row * 128 + ch * 8);
            const u32x4 u0 = *(const u32x4*)(T.u + e), gbv = *(const u32x4*)(T.gb + e), sgv = *(const u32x4*)(T.sg + e);
            u32x4 u1 = {0u, 0u, 0u, 0u}, u2 = {0u, 0u, 0u, 0u};
            if (tt >= 1) u1 = *(const u32x4*)(T.u + e - DM);
            if (tt >= 2) u2 = *(const u32x4*)(T.u + e - 2 * DM);
            u32x4 res;
#pragma unroll
            for (int q = 0; q < 4; ++q) {
                const float cl = cw0[2 * q] * bflo(u2[q]) + cw1[2 * q] * bflo(u1[q]) + cw2[2 * q] * bflo(u0[q]), chh = cw0[2 * q + 1] * bfhi(u2[q]) + cw1[2 * q + 1] * bfhi(u1[q]) + cw2[2 * q + 1] * bfhi(u0[q]);
                res[q] = cvt_pk_bf16(bflo(gbv[q]) * cl + bflo(sgv[q]) * bflo(ov[q]), bfhi(gbv[q]) * chh + bfhi(sgv[q]) * bfhi(ov[q])); }
            *(u32x4*)(T.merged + e) = res; }
    }
    asm volatile("s_waitcnt lgkmcnt(0)" ::: "memory");
    __syncthreads();
#undef SLOAD
#undef SWRITE
#undef RESC
}
#undef SBAR
}
struct Frame {
    LAS unsigned char* lds; volatile LAS unsigned* MISC; unsigned* ctl;
    int tid, lane, wave, vcu, G;
};
__device__ __forceinline__ float wave_sum(float v) {
#pragma unroll
    for (int o = 1; o < 64; o <<= 1) v += __shfl_xor(v, o);
    return v;
}
__device__ __forceinline__ int tcq(int q, int ch64) { return ((q >> 1) << 7) | (((ch64 >> 4) & 3) << 5) | ((q & 1) << 4) | (((ch64 >> 2) & 3) << 2) | (ch64 & 3); }
struct MapIn { __device__ __forceinline__ int operator()(int c) const {
    if (c < C_ZB) return 256 * (c >> 6) + tcq(0, c & 63);
    if (c < C_ZC) { const int ch = c - C_ZB; return 256 * (ch >> 6) + tcq(2, ch & 63); }
    if (c < C_QL) { const int ch = c - C_ZC; return 256 * (ch >> 6) + tcq(1, ch & 63); }
    if (c < C_KVL) { const int j = c - C_QL; return j < 256 ? 256 * 20 + permL(j) : 256 * 21 + permL(j - 256); }
    if (c < C_KR) return 256 * 22 + permL(c - C_KVL);
    if (c < C_GC) return 256 * 21 + permL(128 + c - C_KR);
    if (c < C_GM) { const int ch = c - C_GC; return 256 * (ch >> 6) + tcq(3, ch & 63); }
    { const int j = c - C_GM; return 256 * (16 + (j >> 8)) + permL(j & 255); } } };
struct MapPerm { __device__ __forceinline__ int operator()(int c) const { return (c & ~255) | permL(c & 255); } };
struct MapId { __device__ __forceinline__ int operator()(int c) const { return c; } };
struct MapGU { int n; __device__ __forceinline__ int operator()(int f) const { const int r = f & 127; return 256 * (f >> 7) + ((((r >> 2) & 1) << 7) | ((r >> 5) << 5) | (n << 4) | (((r >> 3) & 3) << 2) | (r & 3)); } };

template <class RowMap>
__device__ __forceinline__ void transpose_item(const float* W, int N, bf16_t* WT, int ldt, const float* kscale, LAS float* scr, int item, int lane, const RowMap& rm) {
    const int nblk = N / 32, kb = item / nblk, nb = item % nblk, k0 = 64 * kb, n0 = 32 * nb;
#pragma unroll 8
    for (int i = 0; i < 32; ++i) { const int kk = 2 * i + (lane >> 5); const float sc = kscale ? kscale[k0 + kk] : 1.f; scr[kk * 33 + (lane & 31)] = W[(size_t)(k0 + kk) * N + n0 + (lane & 31)] * sc; }
    asm volatile("s_waitcnt lgkmcnt(0)" ::: "memory");
    const int c = lane & 7;
#pragma unroll
    for (int j = 0; j < 4; ++j) { const int n = (lane >> 3) + 8 * j; const LAS float* s = scr + (8 * c) * 33 + n;
        u32x4 o; o.x = cvt_pk_bf16(s[0 * 33], s[1 * 33]); o.y = cvt_pk_bf16(s[2 * 33], s[3 * 33]); o.z = cvt_pk_bf16(s[4 * 33], s[5 * 33]); o.w = cvt_pk_bf16(s[6 * 33], s[7 * 33]);
        *(u32x4*)(WT + (size_t)rm(n0 + n) * ldt + k0 + 8 * c) = o; }
    asm volatile("s_waitcnt lgkmcnt(0)" ::: "memory");
}
constexpr size_t WS_WIN = WS_WSMALL, WS_WQ = WS_WIN + (size_t)5888 * 1024 * 2, WS_WKV = WS_WQ + (size_t)1536 * 384 * 2, WS_WO = WS_WKV + (size_t)2048 * 256 * 2;
static_assert(WS_WO + (size_t)1024 * 1024 * 2 <= WS_A, "small weights fit below region A");
constexpr size_t WS_EGU = WS_C, WS_EDN = WS_C + (size_t)NEXP * 512 * 1024 * 2;
static_assert(WS_EDN + (size_t)NEXP * 1024 * 256 * 2 <= WS_D, "expert weights fit region C");

__device__ __forceinline__ void p0_prologue(const Ptrs& P, Frame& F) {
    LAS float* scr = (LAS float*)(F.lds + RING_OFF + F.wave * 16384);
    const int gw = F.vcu * NWAVES + F.wave, NGW = F.G * NWAVES;
    constexpr int I_IN = (DM / 64) * (DIN / 32), I_Q = (QL / 64) * (1536 / 32), I_KV = (KVL / 64) * (2048 / 32), I_O = (DM / 64) * (DM / 32);
    for (int it = gw; it < I_IN + I_Q + I_KV + I_O; it += NGW) {
        int r = it;
        if (r < I_IN) { transpose_item(P.w_in, DIN, (bf16_t*)(P.ws + WS_WIN), DM, (const float*)nullptr, scr, r, F.lane, MapIn{}); continue; } r -= I_IN;
        if (r < I_Q) { transpose_item(P.w_q_b, 1536, (bf16_t*)(P.ws + WS_WQ), QL, P.q_a_g, scr, r, F.lane, MapPerm{}); continue; } r -= I_Q;
        if (r < I_KV) { transpose_item(P.w_kv_b, 2048, (bf16_t*)(P.ws + WS_WKV), KVL, P.kv_a_g, scr, r, F.lane, MapPerm{}); continue; } r -= I_KV;
        transpose_item(P.w_o, DM, (bf16_t*)(P.ws + WS_WO), DM, (const float*)nullptr, scr, r, F.lane, MapId{});
    }
    {
        const int gt = F.vcu * 512 + F.tid;
        if (gt < 64 * 128) { const int L = 192 + (gt >> 7), ch = gt & 127; *(u32x4*)((bf16_t*)(P.ws + WS_WIN) + (size_t)(256 * 21 + permL(L)) * DM + ch * 8) = (u32x4){0u, 0u, 0u, 0u}; } }
    {
        float2* cs = (float2*)(P.ws + WS_CS);
        for (int idx = F.vcu * 512 + F.tid; idx < M * 32; idx += F.G * 512) { const int m = idx >> 5, i = idx & 31;
            const double inv = exp2(-(double)(2 * i) * (13.287712379549449 / 64.0));
            const double ang = (double)P.pos[m] * inv; float2 v; v.x = (float)cos(ang); v.y = (float)sin(ang); cs[idx] = v; } }
    __syncthreads();
    if (F.vcu < 192) {
        LAS float* cact = (LAS float*)(F.lds + RING_OFF); LAS float* red = (LAS float*)(F.lds + RING_OFF + 65536);
        for (int idx = F.tid; idx < BATCH * DM; idx += 512) { const float cv = P.c[idx]; cact[idx] = cv / (1.f + __expf(-cv)); }
        __syncthreads();
        const int n0 = 32 * F.vcu, kl = F.lane >> 3, c4 = F.lane & 7;
        f32x4 acc[16];
#pragma unroll
        for (int b = 0; b < 16; ++b) acc[b] = (f32x4){0.f, 0.f, 0.f, 0.f};
        for (int it = 0; it < 16; ++it) { const int k = 128 * F.wave + 8 * it + kl;
            const f32x4 wv = *(const f32x4*)(P.w_ada + (size_t)k * 6144 + n0 + 4 * c4);
#pragma unroll
            for (int b = 0; b < 16; ++b) acc[b] += cact[b * DM + k] * wv; }
#pragma unroll
        for (int b = 0; b < 16; ++b)
#pragma unroll
            for (int e = 0; e < 4; ++e) { float v = acc[b][e]; v += __shfl_xor(v, 8); v += __shfl_xor(v, 16); v += __shfl_xor(v, 32); if (kl == 0) red[(F.wave * 16 + b) * 32 + 4 * c4 + e] = v; }
        __syncthreads();
        { const int b = F.tid >> 5, cc = F.tid & 31; float s = P.b_ada[n0 + cc];
#pragma unroll
          for (int w = 0; w < 8; ++w) s += red[(w * 16 + b) * 32 + cc];
          ((float*)(P.ws + WS_MOD))[b * 6144 + n0 + cc] = s; }
        __syncthreads();
    }
}
__device__ __forceinline__ void p_expert_weights(const Ptrs& P, Frame& F) {
    LAS float* scr = (LAS float*)(F.lds + RING_OFF + F.wave * 16384);
    const int gw = F.vcu * NWAVES + F.wave, NGW = F.G * NWAVES;
    constexpr int I_G = (DM / 64) * (DEXP / 32), I_D = (DEXP / 64) * (DM / 32);
    for (int it = gw; it < NEXP * (2 * I_G + I_D); it += NGW) {
        const int e = it / (2 * I_G + I_D); int r = it % (2 * I_G + I_D);
        bf16_t* gu = (bf16_t*)(P.ws + WS_EGU) + (size_t)e * 512 * DM; bf16_t* dn = (bf16_t*)(P.ws + WS_EDN) + (size_t)e * DM * DEXP;
        if (r < I_G) { transpose_item(P.w_gate + (size_t)e * DM * DEXP, DEXP, gu, DM, (const float*)nullptr, scr, r, F.lane, MapGU{0}); continue; } r -= I_G;
        if (r < I_G) { transpose_item(P.w_up + (size_t)e * DM * DEXP, DEXP, gu, DM, (const float*)nullptr, scr, r, F.lane, MapGU{1}); continue; } r -= I_G;
        transpose_item(P.w_down + (size_t)e * DEXP * DM, DM, dn, DEXP, (const float*)nullptr, scr, r, F.lane, MapId{});
    }
    asm volatile("s_waitcnt vmcnt(0) lgkmcnt(0)" ::: "memory"); __syncthreads();
}
__device__ __forceinline__ void p1_norm1(const Ptrs& P, Frame& F) {
    const int gw = F.vcu * NWAVES + F.wave, NGW = F.G * NWAVES;
    bf16_t* h = (bf16_t*)(P.ws + WS_A);
    for (int m = gw; m < M; m += NGW) {
        const float* mod = (const float*)(P.ws + WS_MOD) + (m / SEQ) * 6144;
        const f32x4* xr = (const f32x4*)(P.x + (size_t)m * DM) + F.lane;
        f32x4 v[4]; float s = 0.f;
#pragma unroll
        for (int j = 0; j < 4; ++j) { v[j] = xr[64 * j]; s += (v[j][0] * v[j][0] + v[j][1] * v[j][1]) + (v[j][2] * v[j][2] + v[j][3] * v[j][3]); }
        const float rstd = 1.f / sqrtf(wave_sum(s) * (1.f / DM) + EPS);
        unsigned long long* o8 = (unsigned long long*)(h + (size_t)m * DM) + F.lane;
#pragma unroll
        for (int j = 0; j < 4; ++j) { const int d = 4 * F.lane + 256 * j;
            const f32x4 g = *(const f32x4*)(P.norm1_g + d), sc = *(const f32x4*)(mod + 1024 + d), sh = *(const f32x4*)(mod + d);
            const f32x4 r = v[j] * rstd * g * (sc + 1.f) + sh;
            o8[64 * j] = (unsigned long long)cvt_pk_bf16(r[0], r[1]) | ((unsigned long long)cvt_pk_bf16(r[2], r[3]) << 32); }
    }
}

constexpr size_t WS_WR = 30 * MiB;
constexpr size_t WS_STOK = WS_RT + 512 * 1024, WS_SW = WS_STOK + 320 * 1024;
constexpr int MAXROWS = 81920, MAXTILES = 320;
constexpr size_t WS_H2 = WS_B, WS_HACT = WS_B + 64 * MiB;
constexpr int CW_T = CW_TILES, CW_T0 = CW_TILES + 1, CW_TGRP = CW_TILES + 64;

__device__ __forceinline__ void p0_router_weights(const Ptrs& P, Frame& F) {
    bf16_t* hi = (bf16_t*)(P.ws + WS_WR); bf16_t* lo = hi + 48 * DM;
    for (int idx = F.vcu * 512 + F.tid; idx < 48 * DM; idx += F.G * 512) { const int o = idx >> 10, k = idx & 1023;
        const float v = o < 4 ? P.w_rg[k * 4 + o] : (o < 36 ? P.w_re[k * 32 + o - 4] : 0.f);
        const bf16_t h = f2bf(v); hi[idx] = h; lo[idx] = f2bf(v - bf2f(h)); }
}
__device__ __forceinline__ void p6_rows(const Ptrs& P, Frame& F) {
    LAS float* lg = (LAS float*)(F.lds + RING_OFF) + F.wave * (16 * 48);
    LAS unsigned* hist = (LAS unsigned*)(F.lds + XCH_OFF);
    const bf16_t* WrHi = (const bf16_t*)(P.ws + WS_WR); const bf16_t* WrLo = WrHi + 48 * DM;
    bf16_t* h2 = (bf16_t*)(P.ws + WS_H2);
    int2* rte = (int2*)(P.ws + WS_RT); float2* rtw = (float2*)(P.ws + WS_RT + 256 * 1024);
    const int t = F.lane & 15, q = F.lane >> 4;
    for (int rb = F.vcu; rb < M / 128; rb += F.G) {
        if (F.tid < 64) hist[F.tid] = 0u;
        __syncthreads();
        const int m = rb * 128 + F.wave * 16 + t, b = m / SEQ;
        const float* xrow = P.out + (size_t)m * DM + 8 * q;
        const float* mod = (const float*)(P.ws + WS_MOD) + b * 6144;
        float ss = 0.f;
#pragma unroll 8
        for (int ks = 0; ks < 32; ++ks) { const f32x4 v0 = *(const f32x4*)(xrow + 32 * ks), v1 = *(const f32x4*)(xrow + 32 * ks + 4);
            ss += (v0[0] * v0[0] + v0[1] * v0[1]) + (v0[2] * v0[2] + v0[3] * v0[3]) + (v1[0] * v1[0] + v1[1] * v1[1]) + (v1[2] * v1[2] + v1[3] * v1[3]); }
        ss += __shfl_xor(ss, 16); ss += __shfl_xor(ss, 32);
        const float rstd = 1.f / sqrtf(ss * (1.f / DM) + EPS);
        f32x4 acc[3];
#pragma unroll
        for (int cb = 0; cb < 3; ++cb) acc[cb] = (f32x4){0.f, 0.f, 0.f, 0.f};
#pragma unroll 2
        for (int ks = 0; ks < 32; ++ks) { const int k = 32 * ks + 8 * q;
            const f32x4 v0 = *(const f32x4*)(xrow + 32 * ks), v1 = *(const f32x4*)(xrow + 32 * ks + 4);
            const f32x4 g0 = *(const f32x4*)(P.norm2_g + k), g1 = *(const f32x4*)(P.norm2_g + k + 4);
            const f32x4 c0 = *(const f32x4*)(mod + 4096 + k), c1 = *(const f32x4*)(mod + 4096 + k + 4), s0 = *(const f32x4*)(mod + 3072 + k), s1 = *(const f32x4*)(mod + 3072 + k + 4);
            const f32x4 h0 = v0 * rstd * g0 * (c0 + 1.f) + s0, h1 = v1 * rstd * g1 * (c1 + 1.f) + s1;
            const u32x4 hh = pack8(h0, h1);
            f32x4 r0, r1;
            r0[0] = h0[0] - __uint_as_float(hh.x << 16); r0[1] = h0[1] - __uint_as_float(hh.x & 0xffff0000u); r0[2] = h0[2] - __uint_as_float(hh.y << 16); r0[3] = h0[3] - __uint_as_float(hh.y & 0xffff0000u);
            r1[0] = h1[0] - __uint_as_float(hh.z << 16); r1[1] = h1[1] - __uint_as_float(hh.z & 0xffff0000u); r1[2] = h1[2] - __uint_as_float(hh.w << 16); r1[3] = h1[3] - __uint_as_float(hh.w & 0xffff0000u);
            const u32x4 hl = pack8(r0, r1);
            *(u32x4*)(h2 + (size_t)m * DM + k) = hh;
            const bf16x8 bh = __builtin_bit_cast(bf16x8, hh), bl = __builtin_bit_cast(bf16x8, hl);
#pragma unroll
            for (int cb = 0; cb < 3; ++cb) { const bf16x8 wh = *(const bf16x8*)(WrHi + (size_t)(16 * cb + t) * DM + k), wl = *(const bf16x8*)(WrLo + (size_t)(16 * cb + t) * DM + k);
                acc[cb] = __builtin_amdgcn_mfma_f32_16x16x32_bf16(wh, bh, acc[cb], 0, 0, 0);
                acc[cb] = __builtin_amdgcn_mfma_f32_16x16x32_bf16(wh, bl, acc[cb], 0, 0, 0);
                acc[cb] = __builtin_amdgcn_mfma_f32_16x16x32_bf16(wl, bh, acc[cb], 0, 0, 0); } }
#pragma unroll
        for (int cb = 0; cb < 3; ++cb)
#pragma unroll
            for (int r = 0; r < 4; ++r) lg[t * 48 + 16 * cb + 4 * q + r] = acc[cb][r];
        asm volatile("s_waitcnt lgkmcnt(0)" ::: "memory");
        if (q == 0) {
            const LAS float* l = lg + t * 48;
            float gl[4];
#pragma unroll
            for (int i = 0; i < 4; ++i) gl[i] = l[i] + P.b_rg[i];
            int g = 0; float gm = gl[0];
#pragma unroll
            for (int i = 1; i < 4; ++i) if (gl[i] > gm) { gm = gl[i]; g = i; }
            float se = 0.f;
#pragma unroll
            for (int i = 0; i < 4; ++i) se += __expf(gl[i] - gm);
            const float pg = 1.f / se;
            float e0v = -3.0e38f, e1v = -3.0e38f; int i0 = 0, i1 = 0;
#pragma unroll
            for (int i = 0; i < 8; ++i) { const float v = l[4 + g * 8 + i] + P.b_re[g * 8 + i];
                if (v > e0v) { e1v = e0v; i1 = i0; e0v = v; i0 = i; } else if (v > e1v) { e1v = v; i1 = i; } }
            const float p1 = __expf(e1v - e0v), w0 = 1.f / (1.f + p1), w1 = p1 * w0;
            int2 e; e.x = g * 8 + i0; e.y = g * 8 + i1; float2 w; w.x = w0 * pg; w.y = w1 * pg;
            rte[m] = e; rtw[m] = w;
            __hip_atomic_fetch_add(&hist[e.x], 1u, __ATOMIC_RELAXED, __HIP_MEMORY_SCOPE_WORKGROUP); __hip_atomic_fetch_add(&hist[32 + e.y], 1u, __ATOMIC_RELAXED, __HIP_MEMORY_SCOPE_WORKGROUP);
        }
        __syncthreads();
        if (F.tid < 64) F.ctl[CW_HIST + rb * 64 + F.tid] = hist[F.tid];
        __syncthreads();
    }
}
__device__ __forceinline__ void p7_sort(const Ptrs& P, Frame& F) {
    LAS unsigned* tot = (LAS unsigned*)(F.lds + RING_OFF);
    LAS unsigned* pre = tot + 64;
    LAS unsigned* rbase = pre + 64;
    LAS unsigned* cnt = rbase + 64;
    LAS unsigned* misc = cnt + 64;
    int* stok = (int*)(P.ws + WS_STOK); float* sw = (float*)(P.ws + WS_SW);
    const int2* rte = (const int2*)(P.ws + WS_RT); const float2* rtw = (const float2*)(P.ws + WS_RT + 256 * 1024);
    for (int rb = F.vcu; rb < M / 128; rb += F.G) {
        __syncthreads();
        if (F.tid < 64) { unsigned s = 0u, p = 0u;
            for (int r2 = 0; r2 < M / 128; ++r2) { const unsigned v = F.ctl[CW_HIST + r2 * 64 + F.tid]; if (r2 == rb) p = s; s += v; }
            tot[F.tid] = s; pre[F.tid] = p; cnt[F.tid] = 0u; }
        __syncthreads();
        if (F.tid == 0) { unsigned tb = 0u;
            for (int g = 0; g < 64; ++g) { if (g == 32) misc[1] = tb; rbase[g] = tb * 256u; const unsigned nt = (tot[g] + 255u) >> 8;
                if (rb == 0) for (unsigned k = 0; k < nt; ++k) F.ctl[CW_TGRP + tb + k] = (unsigned)g;
                tb += nt; }
            misc[0] = tb; if (rb == 0) { F.ctl[CW_T] = tb; F.ctl[CW_T0] = misc[1]; } }
        __syncthreads();
        if (F.wave == 0) {
            const unsigned long long ltmask = (1ull << F.lane) - 1ull;
            for (int ch = 0; ch < 2; ++ch) { const int m = rb * 128 + ch * 64 + F.lane; const int2 e = rte[m]; const float2 w = rtw[m];
                for (int j = 0; j < 2; ++j) { const int ex = j ? e.y : e.x; const float wj = j ? w.y : w.x; unsigned rank = 0u, gsz = 0u;
                    for (int x = 0; x < 32; ++x) { const unsigned long long mk = __ballot(ex == x); if (ex == x) { rank = (unsigned)__popcll(mk & ltmask); gsz = (unsigned)__popcll(mk); } }
                    const int g = j * 32 + ex; const unsigned pos = rbase[g] + pre[g] + cnt[g] + rank;
                    stok[pos] = m; sw[pos] = wj;
                    asm volatile("s_waitcnt lgkmcnt(0)" ::: "memory");
                    if (rank == 0u) cnt[g] += gsz;
                    asm volatile("s_waitcnt lgkmcnt(0)" ::: "memory"); } } }
        if (rb < 64) { const unsigned n = tot[rb], padn = (((n + 255u) >> 8) << 8) - n;
            if ((unsigned)F.tid < padn) { stok[rbase[rb] + n + F.tid] = -1; sw[rbase[rb] + n + F.tid] = 0.f; } }
    }
}
struct MoeSched {
    const bf16_t* A; const bf16_t* W; int lda, ldb; const int* stok; const unsigned* tgrp; int t_lo, nun, npn, G, c; size_t wstride; bool gather;
    __device__ bool next(int i, Unit& u) const { const int U = i * G + c; if (U >= nun) return false; u.aux = t_lo + U / npn; u.pn = U % npn; u.pm = (int)(tgrp[u.aux] & 31u); return true; }
    __device__ __forceinline__ const char* abase(const Unit& u) const { return gather ? (const char*)A : (const char*)A + (size_t)u.aux * BM * lda * 2; }
    __device__ __forceinline__ const char* bbase(const Unit& u) const { return (const char*)W + (size_t)u.pm * wstride + (size_t)u.pn * BM * ldb * 2; }
    __device__ __forceinline__ void avoff(const Unit& u, int R0, int C0, int R1, int C1, unsigned (&v0)[2], unsigned (&v1)[2]) const {
        if (gather) { const int* tk = stok + u.aux * BM; int a = tk[R0], b = tk[R1], c2 = tk[HALF + R0], d = tk[HALF + R1];
            a = a < 0 ? 0 : a; b = b < 0 ? 0 : b; c2 = c2 < 0 ? 0 : c2; d = d < 0 ? 0 : d;
            v0[0] = (unsigned)(a * lda + C0) * 2u; v0[1] = (unsigned)(b * lda + C1) * 2u; v1[0] = (unsigned)(c2 * lda + C0) * 2u; v1[1] = (unsigned)(d * lda + C1) * 2u; }
        else { v0[0] = (unsigned)(R0 * lda + C0) * 2u; v0[1] = (unsigned)(R1 * lda + C1) * 2u; v1[0] = v0[0] + (unsigned)(HALF * lda * 2); v1[1] = v0[1] + (unsigned)(HALF * lda * 2); } }
};
struct EpiGU {
    bf16_t* hact; const float* sw;
    __device__ __forceinline__ void operator()(const f32x4 (&acc)[2][2][4][2], const Unit& un, int wr, int wc, int fr, int fq) const {
        const int r0 = un.aux * BM + wr * 64 + fr, c0 = 128 * un.pn + 32 * wc + 8 * fq;
#pragma unroll
        for (int ai = 0; ai < 2; ++ai)
#pragma unroll
            for (int m = 0; m < 4; ++m) { const int row = r0 + ai * HALF + m * 16; const float w = sw[row];
                f32x4 a, b;
#pragma unroll
                for (int i = 0; i < 4; ++i) { const float g0 = acc[ai][0][m][0][i], g1 = acc[ai][1][m][0][i];
                    a[i] = g0 * fsigmoid(g0) * acc[ai][0][m][1][i] * w; b[i] = g1 * fsigmoid(g1) * acc[ai][1][m][1][i] * w; }
                *(u32x4*)(hact + (size_t)row * DEXP + c0) = pack8(a, b); }
    }
};
struct EpiDown {
    float* out; const float* mod; const int* stok;
    __device__ __forceinline__ void operator()(const f32x4 (&acc)[2][2][4][2], const Unit& un, int wr, int wc, int fr, int fq) const {
        const int r0 = un.aux * BM + wr * 64 + fr, c0 = 256 * un.pn + 32 * wc + 4 * fq;
#pragma unroll
        for (int ai = 0; ai < 2; ++ai)
#pragma unroll
            for (int m = 0; m < 4; ++m) { const int tok = stok[r0 + ai * HALF + m * 16];
                if (tok >= 0) { const float* gate = mod + (tok / SEQ) * 6144 + 5120; float* orow = out + (size_t)tok * DM;
#pragma unroll
                    for (int bj = 0; bj < 2; ++bj)
#pragma unroll
                        for (int n = 0; n < 2; ++n) { const int c = c0 + bj * HALF + n * 16;
                            *(f32x4*)(orow + c) = *(const f32x4*)(orow + c) + *(const f32x4*)(gate + c) * acc[ai][bj][m][n]; } }
                if (m & 1) asm volatile("" ::: "memory"); }
    }
};
struct Args { Ptrs P; int ph_lo, ph_hi, li, pad; };
constexpr int N_PHASES = 11;

__global__ void __launch_bounds__(NWAVES * 64, 2) fwd(Args args) {
    extern __shared__ __attribute__((aligned(16))) unsigned char lds_raw[];
    const Ptrs& P = args.P;
    Frame F;
    F.lds = (LAS unsigned char*)lds_raw;
    F.MISC = (volatile LAS unsigned*)(F.lds + MISC_OFF);
    F.tid = threadIdx.x; F.lane = F.tid & 63; F.wave = __builtin_amdgcn_readfirstlane(F.tid >> 6);
    F.G = gridDim.x; { const int bx = blockIdx.x; F.vcu = (F.G % 8 == 0) ? (bx % 8) * (F.G / 8) + bx / 8 : bx; }
    F.ctl = (unsigned*)(P.ws + WS_CTL);
    for (int u = F.tid; u < (LDS_BYTES - LDSCTL_OFF) / 4; u += NWAVES * 64) ((LAS unsigned*)(F.lds + LDSCTL_OFF))[u] = 0u;
    __syncthreads();
    const int lo = args.ph_lo, hi = args.ph_hi;
    XcdBarrier bar; bar.bar = F.ctl + CW_BAR + args.li * XCD_BAR_WORDS; bar.x = 0; bar.st = nullptr;
    if (hi - lo > 1) bar = xcd_barrier_post(F.ctl + CW_BAR + args.li * XCD_BAR_WORDS, F.MISC + 8);
#ifdef ONLY_PHASE
#define IN(k) ((k) == ONLY_PHASE && lo <= (k) && (k) < hi)
#else
#define IN(k) (lo <= (k) && (k) < hi)
#endif
#define SEAM(k) do { if (IN(k) && IN((k) + 1)) xcd_barrier(bar); } while (0)
    unsigned char* ws = P.ws;
    bf16_t* hA = (bf16_t*)(ws + WS_A);
    bf16_t* uB = (bf16_t*)(ws + WS_B); bf16_t* gbB = uB + (size_t)M * DM; bf16_t* sgB = gbB + (size_t)M * DM;
    bf16_t* latC = (bf16_t*)(ws + WS_C);
    bf16_t* Kd = (bf16_t*)(ws + WS_D); bf16_t* Vd = (bf16_t*)(ws + WS_D + 96 * MiB);
    bf16_t* Qo = (bf16_t*)P.out;
    float* ssp = (float*)(ws + WS_SSP); const float2* cs = (const float2*)(ws + WS_CS); const float* mod = (const float*)(ws + WS_MOD);

    if (IN(0)) { p0_router_weights(P, F); p0_prologue(P, F); SEAM(0); }
    if (IN(1)) { p1_norm1(P, F); SEAM(1); }
    if (IN(2)) {
        DenseSched S; S.init(hA, DM, (const bf16_t*)(ws + WS_WIN), DM, M, 5888, F.G, (int)blockIdx.x);
        EpiIn E{uB, gbB, sgB, latC, ssp};
        gemm_phase<false>(F.lds + RING_OFF, DM, S, E);
        SEAM(2);
    }
    if (IN(3)) {
#ifndef P3_NO_Q
        { DenseSched S; S.init(latC, LATW, (const bf16_t*)(ws + WS_WQ), QL, M, 1536, F.G, (int)blockIdx.x);
          EpiPlain E{Qo, 1536};
          gemm_phase<false>(F.lds + RING_OFF, QL, S, E); }
#endif
#ifndef P3_NO_KV
        { DenseSched S; S.init(latC + 512, LATW, (const bf16_t*)(ws + WS_WKV), KVL, M, 2048, F.G, (int)blockIdx.x);
          EpiKV E{Kd, Vd, latC, ssp, cs, P.k_g, (LAS float*)(F.lds + XCH_OFF)};
          gemm_phase<false>(F.lds + RING_OFF, KVL, S, E); }
#endif
        SEAM(3);
    }
    if (IN(4)) {
        att::AttnArgs T{Qo, Kd, Vd, ssp, cs, P.q_g, uB, gbB, sgB, P.conv_w, hA};
        if (F.G == 256) {
            const int bh = F.vcu >> 1, sel = F.vcu & 1;
#pragma unroll 1
            for (int i = 0; i < 4; ++i) { const int qb = sel ? (i == 0 ? 6 : i == 1 ? 1 : i == 2 ? 5 : 2) : (i == 0 ? 7 : i == 1 ? 0 : i == 2 ? 4 : 3);
                att::attn_unit(T, bh >> 3, bh & 7, qb, (LAS char*)(F.lds + RING_OFF)); }
        } else {
#pragma unroll 1
            for (int U = F.vcu; U < BATCH * NH * 8; U += F.G) { const int bh = U >> 3; att::attn_unit(T, bh >> 3, bh & 7, U & 7, (LAS char*)(F.lds + RING_OFF)); }
        }
        SEAM(4);
    }
    if (IN(5)) {
        p_expert_weights(P, F);
        DenseSched S; S.init(hA, DM, (const bf16_t*)(ws + WS_WO), DM, M, DM, F.G, (int)blockIdx.x);
        EpiWo E{P.x, mod, P.out};
        gemm_phase<false>(F.lds + RING_OFF, DM, S, E);
        SEAM(5);
    }
    if (IN(6)) { p6_rows(P, F); SEAM(6); }
    if (IN(7)) { p7_sort(P, F); SEAM(7); }
    const int* stok = (const int*)(ws + WS_STOK); const float* sw = (const float*)(ws + WS_SW);
    bf16_t* h2 = (bf16_t*)(ws + WS_H2); bf16_t* hact = (bf16_t*)(ws + WS_HACT);
    if (IN(8)) {
        const int T = __builtin_amdgcn_readfirstlane((int)F.ctl[CW_T]);
        MoeSched S{h2, (const bf16_t*)(ws + WS_EGU), DM, DM, stok, F.ctl + CW_TGRP, 0, T * 2, 2, F.G, F.vcu, (size_t)512 * DM * 2, true};
        EpiGU E{hact, sw};
        gemm_phase<true>(F.lds + RING_OFF, DM, S, E);
        SEAM(8);
    }
    if (IN(9)) {
        const int T0 = __builtin_amdgcn_readfirstlane((int)F.ctl[CW_T0]);
        MoeSched S{hact, (const bf16_t*)(ws + WS_EDN), DEXP, DEXP, stok, F.ctl + CW_TGRP, 0, T0 * 4, 4, F.G, F.vcu, (size_t)DM * DEXP * 2, false};
        EpiDown E{P.out, mod, stok};
        gemm_phase<false>(F.lds + RING_OFF, DEXP, S, E);
        SEAM(9);
    }
    if (IN(10)) {
        const int T = __builtin_amdgcn_readfirstlane((int)F.ctl[CW_T]), T0 = __builtin_amdgcn_readfirstlane((int)F.ctl[CW_T0]);
        MoeSched S{hact, (const bf16_t*)(ws + WS_EDN), DEXP, DEXP, stok, F.ctl + CW_TGRP, T0, (T - T0) * 4, 4, F.G, F.vcu, (size_t)DM * DEXP * 2, false};
        EpiDown E{P.out, mod, stok};
        gemm_phase<false>(F.lds + RING_OFF, DEXP, S, E);
    }
#undef IN
#undef SEAM
}
}
#ifndef NV2_WMASK
#define NV2_WMASK 15
#endif
#ifndef BOTH_MASK
#define BOTH_MASK 0
#endif
#ifndef FAST_MASK
#define FAST_MASK 0x7f
#endif
#ifndef ONE_LAUNCH
#define ONE_LAUNCH 1
#endif

static void naive_forward(const Ptrs& P, hipStream_t st, int from, int to) {
    unsigned char* ws = P.ws;
    float* scratch = (float*)(ws + WS_D);
    if (from <= 0 && 0 <= to) {
        hipLaunchKernelGGL(nv_mod, dim3(6144 / 256, BATCH), dim3(256), 0, st, P);
        hipLaunchKernelGGL(nv_rope_table, dim3(M * 32 / 256), dim3(256), 0, st, P);
    }
    if (from <= 1 && 1 <= to) hipLaunchKernelGGL(nv_norm1, dim3(M), dim3(256), 0, st, P);
    if (from <= 2 && 2 <= to) {
        for (int b = 0; b < BATCH; ++b) {
            hipLaunchKernelGGL(nv_gemm<bf16_t>, dim3(DIN / 64, SEQ / 64), dim3(256), 0, st, (const bf16_t*)(ws + WS_A) + (size_t)b * SEQ * DM, DM, P.w_in, DIN, (const float*)nullptr, scratch, DIN, DM);
            hipLaunchKernelGGL(nv_z_post, dim3(SEQ), dim3(256), 0, st, P, (const float*)scratch, b, NV2_WMASK);
        }
    }
    if (from <= 3 && 3 <= to) {
        float* s3 = (float*)(ws + WS_A);
        for (int b = 0; b < BATCH; ++b) {
            const bf16_t* latb = (const bf16_t*)(ws + WS_C) + (size_t)b * SEQ * LATW;
            hipLaunchKernelGGL(nv_gemm<bf16_t>, dim3(1536 / 64, SEQ / 64), dim3(256), 0, st, latb, LATW, P.w_q_b, 1536, P.q_a_g, s3, 1536, QL);
            hipLaunchKernelGGL(nv_q_post, dim3(SEQ * 1536 / 256), dim3(256), 0, st, P, (const float*)s3, b);
            float* s3b = s3 + (size_t)SEQ * 1536;
            hipLaunchKernelGGL(nv_gemm<bf16_t>, dim3(2048 / 64, SEQ / 64), dim3(256), 0, st, latb + 512, LATW, P.w_kv_b, 2048, P.kv_a_g, s3b, 2048, KVL);
            hipLaunchKernelGGL(nv_kv_post, dim3(SEQ, NH), dim3(64), 0, st, P, (const float*)s3b, b);
        }
    }
    if (from <= 4 && 4 <= to) hipLaunchKernelGGL(nv_attn, dim3(SEQ, NH, BATCH), dim3(64), 0, st, P);
    if (from <= 5 && 5 <= to) {
        float* s5 = (float*)(ws + WS_C);
        for (int b = 0; b < BATCH; ++b) {
            hipLaunchKernelGGL(nv_gemm<bf16_t>, dim3(DM / 64, SEQ / 64), dim3(256), 0, st, (const bf16_t*)(ws + WS_A) + (size_t)b * SEQ * DM, DM, P.w_o, DM, (const float*)nullptr, s5, DM, DM);
            hipLaunchKernelGGL(nv_resid, dim3(SEQ * DM / 256), dim3(256), 0, st, P, (const float*)s5, b);
        }
    }
    if (from <= 6 && 6 <= to) hipLaunchKernelGGL(nv_norm2_router, dim3(M), dim3(256), 0, st, P);
    if (from <= 7 && 7 <= to) hipLaunchKernelGGL(nv_moe, dim3(M), dim3(256), 0, st, P);
}

extern "C" void kernel_launch(void* const* d_in, const int* in_sizes, int n_in, void* d_out, int out_size, void* d_ws, size_t ws_size, hipStream_t stream) {
    if (n_in != 23 || out_size != M * DM || ws_size < WS_END) { fprintf(stderr, "kernel_launch: unexpected shapes (n_in %d out %d ws %zu)\n", n_in, out_size, ws_size); return; }
    static int grid = 0;
    if (grid == 0) {
        int dev = 0, cus = 0;
        if (hipGetDevice(&dev) != hipSuccess || hipDeviceGetAttribute(&cus, hipDeviceAttributeMultiprocessorCount, dev) != hipSuccess) { fprintf(stderr, "kernel_launch: device query failed\n"); grid = -1; return; }
        if (hipFuncSetAttribute((const void*)fk::fwd, hipFuncAttributeMaxDynamicSharedMemorySize, fk::LDS_BYTES) != hipSuccess) { fprintf(stderr, "kernel_launch: hipFuncSetAttribute failed\n"); grid = -1; return; }
        grid = cus;
    }
    if (grid < 0) return;
    Ptrs P{};
    P.x = (const float*)d_in[0]; P.c = (const float*)d_in[1]; P.pos = (const int*)d_in[2];
    P.w_ada = (const float*)d_in[3]; P.b_ada = (const float*)d_in[4]; P.norm1_g = (const float*)d_in[5]; P.w_in = (const float*)d_in[6]; P.conv_w = (const float*)d_in[7];
    P.q_a_g = (const float*)d_in[8]; P.w_q_b = (const float*)d_in[9]; P.kv_a_g = (const float*)d_in[10]; P.w_kv_b = (const float*)d_in[11]; P.q_g = (const float*)d_in[12]; P.k_g = (const float*)d_in[13];
    P.w_o = (const float*)d_in[14]; P.norm2_g = (const float*)d_in[15]; P.w_rg = (const float*)d_in[16]; P.b_rg = (const float*)d_in[17]; P.w_re = (const float*)d_in[18]; P.b_re = (const float*)d_in[19];
    P.w_gate = (const float*)d_in[20]; P.w_up = (const float*)d_in[21]; P.w_down = (const float*)d_in[22];
    P.out = (float*)d_out; P.ws = (unsigned char*)d_ws;
    (void)hipMemsetAsync((char*)d_ws + WS_CTL, 0, 1 * MiB, stream);
    fk::Args a{}; a.P = P;
    if (ONE_LAUNCH) { a.ph_lo = 0; a.ph_hi = fk::N_PHASES; a.li = 0; hipLaunchKernelGGL(fk::fwd, dim3(grid), dim3(fk::NWAVES * 64), fk::LDS_BYTES, stream, a); }
    else for (int s = 0; s <= 7; ++s) {
        if (s < 6 && ((FAST_MASK >> s) & 1)) { a.ph_lo = s; a.ph_hi = s + 1; a.li = 0; hipLaunchKernelGGL(fk::fwd, dim3(grid), dim3(fk::NWAVES * 64), fk::LDS_BYTES, stream, a); }
        else if (s >= 6 && ((FAST_MASK >> 6) & 1)) { if (s == 6) for (int ph = 6; ph < fk::N_PHASES; ++ph) { a.ph_lo = ph; a.ph_hi = ph + 1; a.li = 0; hipLaunchKernelGGL(fk::fwd, dim3(grid), dim3(fk::NWAVES * 64), fk::LDS_BYTES, stream, a); } }
        else naive_forward(P, stream, s, s);
        if ((BOTH_MASK >> s) & 1) naive_forward(P, stream, s, s);
    }
}
```

```cpp
#define PROBE_REPEAT -1
#include <hip/hip_runtime.h>
#include <cstdio>
#include <cstdint>
#include <cmath>

constexpr int BATCH = 16, SEQ = 2048, DM = 1024, M = BATCH * SEQ;
constexpr int NH = 8, QKN = 128, QKR = 64, QKH = 192, VH = 128, QL = 384, KVL = 256;
constexpr int DIN = 5824, NEXP = 32, DEXP = 256;
constexpr int C_ZX = 0, C_ZB = 1024, C_ZC = 2048, C_QL = 3072, C_KVL = 3456, C_KR = 3712, C_GC = 3776, C_GM = 4800;
constexpr float EPS = 1e-6f;
constexpr int LATW = 768;
constexpr int NSLOT = 16;

typedef unsigned short bf16_t;
typedef float f32x4 __attribute__((ext_vector_type(4)));

constexpr size_t MiB = 1u << 20;
constexpr size_t WS_CTL = 0;
constexpr size_t WS_MOD = 1 * MiB;
constexpr size_t WS_CS = 2 * MiB;
constexpr size_t WS_SSP = 10 * MiB;
constexpr size_t WS_RT = 12 * MiB;
constexpr size_t WS_WSMALL = 14 * MiB;
constexpr size_t WS_A = 32 * MiB;
constexpr size_t WS_B = 96 * MiB;
constexpr size_t WS_C = 288 * MiB;
constexpr size_t WS_D = 336 * MiB;
constexpr size_t WS_END = 496 * MiB;

__device__ __forceinline__ float bf2f(bf16_t v) { return __uint_as_float(((unsigned)v) << 16); }
__device__ __forceinline__ bf16_t f2bf(float f) { unsigned u = __float_as_uint(f); return (bf16_t)((u + 0x7fffu + ((u >> 16) & 1u)) >> 16); }
__device__ __forceinline__ float sigmoidf_(float x) { return 1.f / (1.f + __expf(-x)); }
__device__ __forceinline__ float ldf(const float* p) { return *p; }
__device__ __forceinline__ float ldf(const bf16_t* p) { return bf2f(*p); }

struct Ptrs {
    const float *x, *c; const int* pos;
    const float *w_ada, *b_ada, *norm1_g, *w_in, *conv_w, *q_a_g, *w_q_b, *kv_a_g, *w_kv_b, *q_g, *k_g, *w_o, *norm2_g;
    const float *w_rg, *b_rg, *w_re, *b_re, *w_gate, *w_up, *w_down;
    float* out; unsigned char* ws;
};

__global__ void __launch_bounds__(256) nv_mod(Ptrs P) {
    const int n = blockIdx.x * 256 + threadIdx.x, b = blockIdx.y;
    float acc = P.b_ada[n];
    for (int k = 0; k < DM; ++k) { const float cv = P.c[b * DM + k]; const float s = cv / (1.f + expf(-cv)); acc += s * P.w_ada[(size_t)k * 6144 + n]; }
    ((float*)(P.ws + WS_MOD))[b * 6144 + n] = acc;
}
__global__ void __launch_bounds__(256) nv_rope_table(Ptrs P) {
    const int idx = blockIdx.x * 256 + threadIdx.x;
    const int m = idx >> 5, i = idx & 31;
    const double inv = pow(10000.0, -(double)(2 * i) / 64.0);
    const double ang = (double)P.pos[m] * inv;
    float2 cs; cs.x = (float)cos(ang); cs.y = (float)sin(ang);
    ((float2*)(P.ws + WS_CS))[idx] = cs;
}
__device__ __forceinline__ float block_sum_256(float v, float* red) {
    for (int o = 32; o > 0; o >>= 1) v += __shfl_xor(v, o);
    if ((threadIdx.x & 63) == 0) red[threadIdx.x >> 6] = v;
    __syncthreads();
    const float r = red[0] + red[1] + red[2] + red[3];
    __syncthreads();
    return r;
}
__global__ void __launch_bounds__(256) nv_norm1(Ptrs P) {
    __shared__ float red[4];
    const int m = blockIdx.x, b = m / SEQ, t = threadIdx.x;
    const float* mod = (const float*)(P.ws + WS_MOD) + b * 6144;
    float v[4]; float ss = 0.f;
#pragma unroll
    for (int j = 0; j < 4; ++j) { v[j] = P.x[(size_t)m * DM + t + 256 * j]; ss += v[j] * v[j]; }
    ss = block_sum_256(ss, red);
    const float rstd = 1.f / sqrtf(ss / DM + EPS);
    bf16_t* h = (bf16_t*)(P.ws + WS_A);
#pragma unroll
    for (int j = 0; j < 4; ++j) { const int d = t + 256 * j; h[(size_t)m * DM + d] = f2bf(v[j] * rstd * P.norm1_g[d] * (1.f + mod[1024 + d]) + mod[d]); }
}
template <typename TA>
__global__ void __launch_bounds__(256) nv_gemm(const TA* A, int lda, const float* Bm, int ldb, const float* bscale, float* C, int ldc, int K) {
    __shared__ float As[16][65]; __shared__ float Bs[16][64];
    const int tx = threadIdx.x & 15, ty = threadIdx.x >> 4, m0 = blockIdx.y * 64, n0 = blockIdx.x * 64;
    float acc[4][4];
#pragma unroll
    for (int i = 0; i < 4; ++i)
#pragma unroll
        for (int j = 0; j < 4; ++j) acc[i][j] = 0.f;
    for (int k0 = 0; k0 < K; k0 += 16) {
#pragma unroll
        for (int q = 0; q < 4; ++q) { const int i = threadIdx.x + 256 * q; const int r = i >> 4, c = i & 15; As[c][r] = ldf(A + (size_t)(m0 + r) * lda + k0 + c); }
#pragma unroll
        for (int q = 0; q < 4; ++q) { const int i = threadIdx.x + 256 * q; const int r = i >> 6, c = i & 63; const float s = bscale ? bscale[k0 + r] : 1.f; Bs[r][c] = Bm[(size_t)(k0 + r) * ldb + n0 + c] * s; }
        __syncthreads();
#pragma unroll
        for (int k = 0; k < 16; ++k) {
            float a0 = As[k][ty * 4 + 0], a1 = As[k][ty * 4 + 1], a2 = As[k][ty * 4 + 2], a3 = As[k][ty * 4 + 3];
            float b0 = Bs[k][tx * 4 + 0], b1 = Bs[k][tx * 4 + 1], b2 = Bs[k][tx * 4 + 2], b3 = Bs[k][tx * 4 + 3];
            acc[0][0] += a0 * b0; acc[0][1] += a0 * b1; acc[0][2] += a0 * b2; acc[0][3] += a0 * b3;
            acc[1][0] += a1 * b0; acc[1][1] += a1 * b1; acc[1][2] += a1 * b2; acc[1][3] += a1 * b3;
            acc[2][0] += a2 * b0; acc[2][1] += a2 * b1; acc[2][2] += a2 * b2; acc[2][3] += a2 * b3;
            acc[3][0] += a3 * b0; acc[3][1] += a3 * b1; acc[3][2] += a3 * b2; acc[3][3] += a3 * b3;
        }
        __syncthreads();
    }
#pragma unroll
    for (int i = 0; i < 4; ++i)
#pragma unroll
        for (int j = 0; j < 4; ++j) C[(size_t)(m0 + ty * 4 + i) * ldc + n0 + tx * 4 + j] = acc[i][j];
}
__global__ void __launch_bounds__(256) nv_z_post(Ptrs P, const float* z, int b, int wmask) {
    const int s = blockIdx.x, m = b * SEQ + s, t = threadIdx.x;
    const float* zr = z + (size_t)s * DIN;
    bf16_t* u = (bf16_t*)(P.ws + WS_B); bf16_t* gb = u + (size_t)M * DM; bf16_t* sg = gb + (size_t)M * DM;
    bf16_t* lat = (bf16_t*)(P.ws + WS_C); float* ssp = (float*)(P.ws + WS_SSP);
#pragma unroll
    for (int j = 0; j < 4; ++j) { const int c = t + 256 * j;
        if (wmask & 1) { u[(size_t)m * DM + c] = f2bf(zr[C_ZX + c] * zr[C_ZC + c]);
        gb[(size_t)m * DM + c] = f2bf(zr[C_ZB + c] * sigmoidf_(zr[C_GC + c])); }
        if (wmask & 2) sg[(size_t)m * DM + c] = f2bf(sigmoidf_(zr[C_GM + c])); }
    if (wmask & 4) for (int c = t; c < LATW; c += 256) {
        float v = 0.f;
        if (c < 384) v = zr[C_QL + c]; else if (c < 448) v = zr[C_KR + c - 384]; else if (c >= 512) v = zr[C_KVL + c - 512];
        lat[(size_t)m * LATW + c] = f2bf(v); }
    if ((wmask & 8) && t < NSLOT) {
        float ss = 0.f;
        if (t == 0) for (int c = 0; c < QL; ++c) ss += zr[C_QL + c] * zr[C_QL + c];
        if (t == 8) for (int c = 0; c < KVL; ++c) ss += zr[C_KVL + c] * zr[C_KVL + c];
        if (t == 12) for (int c = 0; c < QKR; ++c) ss += zr[C_KR + c] * zr[C_KR + c];
        ssp[(size_t)t * M + m] = ss; }
}
__global__ void __launch_bounds__(256) nv_q_post(Ptrs P, const float* qraw, int b) {
    const size_t i = (size_t)blockIdx.x * 256 + threadIdx.x;
    ((bf16_t*)P.out)[(size_t)b * SEQ * 1536 + i] = f2bf(qraw[i]);
}
__global__ void __launch_bounds__(64) nv_kv_post(Ptrs P, const float* kvraw, int b) {
    const int s = blockIdx.x, h = blockIdx.y, m = b * SEQ + s, l = threadIdx.x;
    const float* ssp = (const float*)(P.ws + WS_SSP);
    const float sskv = ssp[(size_t)8 * M + m] + ssp[(size_t)9 * M + m] + ssp[(size_t)10 * M + m] + ssp[(size_t)11 * M + m];
    const float sskr = ssp[(size_t)12 * M + m] + ssp[(size_t)13 * M + m] + ssp[(size_t)14 * M + m] + ssp[(size_t)15 * M + m];
    const float rkv = 1.f / sqrtf(sskv / KVL + EPS);
    const float* r = kvraw + (size_t)s * 2048 + h * 256;
    const float kn0 = rkv * r[l], kn1 = rkv * r[l + 64], v0 = rkv * r[128 + l], v1 = rkv * r[192 + l];
    float ss = kn0 * kn0 + kn1 * kn1;
    for (int o = 32; o > 0; o >>= 1) ss += __shfl_xor(ss, o);
    const float rk = 1.f / sqrtf((ss + sskr) / QKH + EPS);
    bf16_t* Kp = (bf16_t*)(P.ws + WS_D) + ((size_t)(b * NH + h) * SEQ + s) * QKH;
    bf16_t* Vp = (bf16_t*)(P.ws + WS_D + 96 * MiB) + ((size_t)(b * NH + h) * SEQ + s) * VH;
    Kp[l] = f2bf(kn0 * rk * P.k_g[l]); Kp[l + 64] = f2bf(kn1 * rk * P.k_g[l + 64]);
    Vp[l] = f2bf(v0); Vp[l + 64] = f2bf(v1);
    if (l < 32) {
        const bf16_t* lat = (const bf16_t*)(P.ws + WS_C) + (size_t)m * LATW + 384;
        const float2 cs = ((const float2*)(P.ws + WS_CS))[(size_t)m * 32 + l];
        const float x1 = bf2f(lat[l]) * rk * P.k_g[128 + l], x2 = bf2f(lat[l + 32]) * rk * P.k_g[160 + l];
        Kp[128 + l] = f2bf(x1 * cs.x - x2 * cs.y); Kp[160 + l] = f2bf(x2 * cs.x + x1 * cs.y); }
}
__global__ void __launch_bounds__(64) nv_attn(Ptrs P) {
    __shared__ float sq[QKH]; __shared__ float sc[SEQ];
    const int t = blockIdx.x, h = blockIdx.y, b = blockIdx.z, m = b * SEQ + t, l = threadIdx.x;
    const float* ssp = (const float*)(P.ws + WS_SSP);
    float ssq = 0.f; for (int j = 0; j < 8; ++j) ssq += ssp[(size_t)j * M + m];
    const float rq = 1.f / sqrtf(ssq / QL + EPS);
    const bf16_t* qr = (const bf16_t*)P.out + (size_t)m * 1536 + h * QKH;
    const float q0 = rq * bf2f(qr[l]), q1 = rq * bf2f(qr[l + 64]), q2 = rq * bf2f(qr[l + 128]);
    float ss = q0 * q0 + q1 * q1 + q2 * q2;
    for (int o = 32; o > 0; o >>= 1) ss += __shfl_xor(ss, o);
    const float rn = 1.f / sqrtf(ss / QKH + EPS);
    sq[l] = q0 * rn * P.q_g[l]; sq[l + 64] = q1 * rn * P.q_g[l + 64]; sq[l + 128] = q2 * rn * P.q_g[l + 128];
    __syncthreads();
    if (l < 32) {
        const float2 cs = ((const float2*)(P.ws + WS_CS))[(size_t)m * 32 + l];
        const float x1 = sq[128 + l], x2 = sq[160 + l];
        sq[128 + l] = x1 * cs.x - x2 * cs.y; sq[160 + l] = x2 * cs.x + x1 * cs.y; }
    __syncthreads();
    const int kend = ((t >> 6) + 1) << 6;
    const bf16_t* Kb = (const bf16_t*)(P.ws + WS_D) + (size_t)(b * NH + h) * SEQ * QKH;
    const bf16_t* Vb = (const bf16_t*)(P.ws + WS_D + 96 * MiB) + (size_t)(b * NH + h) * SEQ * VH;
    const float scale = 0.07216878364870322f;
    float mx = -1e30f;
    for (int j = l; j < kend; j += 64) { const uint4* kr = (const uint4*)(Kb + (size_t)j * QKH); float d = 0.f;
        for (int e = 0; e < QKH / 8; ++e) { const uint4 w = kr[e]; const float* q8 = sq + e * 8;
            d += q8[0] * __uint_as_float(w.x << 16) + q8[1] * __uint_as_float(w.x & 0xffff0000u) + q8[2] * __uint_as_float(w.y << 16) + q8[3] * __uint_as_float(w.y & 0xffff0000u)
               + q8[4] * __uint_as_float(w.z << 16) + q8[5] * __uint_as_float(w.z & 0xffff0000u) + q8[6] * __uint_as_float(w.w << 16) + q8[7] * __uint_as_float(w.w & 0xffff0000u); }
        d *= scale; sc[j] = d; mx = fmaxf(mx, d); }
    for (int o = 32; o > 0; o >>= 1) mx = fmaxf(mx, __shfl_xor(mx, o));
    float sum = 0.f;
    for (int j = l; j < kend; j += 64) { const float p = expf(sc[j] - mx); sc[j] = p; sum += p; }
    for (int o = 32; o > 0; o >>= 1) sum += __shfl_xor(sum, o);
    __syncthreads();
    float o0 = 0.f, o1 = 0.f;
    for (int j = 0; j < kend; ++j) { const float p = sc[j]; o0 += p * bf2f(Vb[(size_t)j * VH + l]); o1 += p * bf2f(Vb[(size_t)j * VH + l + 64]); }
    const float inv = 1.f / sum; o0 *= inv; o1 *= inv;
    const bf16_t* u = (const bf16_t*)(P.ws + WS_B); const bf16_t* gb = u + (size_t)M * DM; const bf16_t* sg = gb + (size_t)M * DM;
    bf16_t* mg = (bf16_t*)(P.ws + WS_A);
#pragma unroll
    for (int j = 0; j < 2; ++j) { const int c = h * VH + l + 64 * j; const size_t e = (size_t)m * DM + c;
        const float u0 = bf2f(u[e]), um1 = t >= 1 ? bf2f(u[e - DM]) : 0.f, um2 = t >= 2 ? bf2f(u[e - 2 * DM]) : 0.f;
        const float cv = P.conv_w[c] * um2 + P.conv_w[DM + c] * um1 + P.conv_w[2 * DM + c] * u0;
        mg[e] = f2bf(bf2f(gb[e]) * cv + bf2f(sg[e]) * (j ? o1 : o0)); }
}
__global__ void __launch_bounds__(256) nv_resid(Ptrs P, const float* y, int b) {
    const size_t i = (size_t)blockIdx.x * 256 + threadIdx.x;
    const int d = (int)(i & (DM - 1)); const size_t e = (size_t)b * SEQ * DM + i;
    P.out[e] = P.x[e] + ((const float*)(P.ws + WS_MOD))[b * 6144 + 2048 + d] * y[i];
}
__global__ void __launch_bounds__(256) nv_norm2_router(Ptrs P) {
    __shared__ float red[4]; __shared__ float hs[DM]; __shared__ float lg[36];
    const int m = blockIdx.x, b = m / SEQ, t = threadIdx.x;
    const float* mod = (const float*)(P.ws + WS_MOD) + b * 6144;
    float v[4]; float ss = 0.f;
#pragma unroll
    for (int j = 0; j < 4; ++j) { v[j] = P.out[(size_t)m * DM + t + 256 * j]; ss += v[j] * v[j]; }
    ss = block_sum_256(ss, red);
    const float rstd = 1.f / sqrtf(ss / DM + EPS);
    bf16_t* h2 = (bf16_t*)(P.ws + WS_B);
#pragma unroll
    for (int j = 0; j < 4; ++j) { const int d = t + 256 * j; const float hv = v[j] * rstd * P.norm2_g[d] * (1.f + mod[4096 + d]) + mod[3072 + d]; hs[d] = hv; h2[(size_t)m * DM + d] = f2bf(hv); }
    __syncthreads();
    if (t < 36) { float a = 0.f;
        if (t < 4) { for (int k = 0; k < DM; ++k) a += hs[k] * P.w_rg[k * 4 + t]; a += P.b_rg[t]; }
        else { for (int k = 0; k < DM; ++k) a += hs[k] * P.w_re[k * 32 + t - 4]; a += P.b_re[t - 4]; }
        lg[t] = a; }
    __syncthreads();
    if (t == 0) {
        int g = 0; for (int i = 1; i < 4; ++i) if (lg[i] > lg[g]) g = i;
        float se = 0.f; for (int i = 0; i < 4; ++i) se += expf(lg[i] - lg[g]);
        const float pg = 1.f / se;
        const float* el = lg + 4 + g * 8;
        int i0 = 0; for (int i = 1; i < 8; ++i) if (el[i] > el[i0]) i0 = i;
        int i1 = (i0 == 0) ? 1 : 0; for (int i = 0; i < 8; ++i) if (i != i0 && el[i] > el[i1]) i1 = i;
        const float p1 = expf(el[i1] - el[i0]);
        const float w0 = 1.f / (1.f + p1), w1 = p1 / (1.f + p1);
        int2 e; e.x = g * 8 + i0; e.y = g * 8 + i1; float2 w; w.x = w0 * pg; w.y = w1 * pg;
        ((int2*)(P.ws + WS_RT))[m] = e; ((float2*)(P.ws + WS_RT + 256 * 1024))[m] = w; }
}
__global__ void __launch_bounds__(256) nv_moe(Ptrs P) {
    __shared__ float hs[DM]; __shared__ float act[DEXP];
    const int m = blockIdx.x, b = m / SEQ, t = threadIdx.x;
    const bf16_t* h2 = (const bf16_t*)(P.ws + WS_B) + (size_t)m * DM;
#pragma unroll
    for (int j = 0; j < 4; ++j) hs[t + 256 * j] = bf2f(h2[t + 256 * j]);
    const int2 e = ((const int2*)(P.ws + WS_RT))[m]; const float2 w = ((const float2*)(P.ws + WS_RT + 256 * 1024))[m];
    float o[4] = {0.f, 0.f, 0.f, 0.f};
    for (int j = 0; j < 2; ++j) {
        const int ex = j ? e.y : e.x; const float wj = j ? w.y : w.x;
        const float* wg = P.w_gate + (size_t)ex * DM * DEXP; const float* wu = P.w_up + (size_t)ex * DM * DEXP; const float* wd = P.w_down + (size_t)ex * DEXP * DM;
        __syncthreads();
        float g = 0.f, uu = 0.f;
        for (int k = 0; k < DM; ++k) { const float hv = hs[k]; g += hv * wg[(size_t)k * DEXP + t]; uu += hv * wu[(size_t)k * DEXP + t]; }
        act[t] = (g / (1.f + expf(-g))) * uu * wj;
        __syncthreads();
        for (int f = 0; f < DEXP; ++f) { const float a = act[f];
#pragma unroll
            for (int q = 0; q < 4; ++q) o[q] += a * wd[(size_t)f * DM + t + 256 * q]; }
    }
    const float* mod = (const float*)(P.ws + WS_MOD) + b * 6144 + 5120;
#pragma unroll
    for (int q = 0; q < 4; ++q) { const int d = t + 256 * q; P.out[(size_t)m * DM + d] += mod[d] * o[q]; }
}

namespace fk {
#define LAS __attribute__((address_space(3)))
#define GAS __attribute__((address_space(1)))
typedef short bf16x8 __attribute__((ext_vector_type(8)));
typedef short s16x4 __attribute__((ext_vector_type(4)));
typedef unsigned u32x4 __attribute__((ext_vector_type(4)));
typedef unsigned u32x2 __attribute__((ext_vector_type(2)));
typedef float f32x2 __attribute__((ext_vector_type(2)));
typedef float f32x16 __attribute__((ext_vector_type(16)));
typedef GAS unsigned gu32;
#define RLX_AGENT __ATOMIC_RELAXED, __HIP_MEMORY_SCOPE_AGENT
constexpr int NWAVES = 8;
constexpr int BM = 256, BK = 64, HALF = 128, HTB = HALF * BK * 2, STAGE_BYTES = 8 * HTB, NXCD = 8, WGM = 8;
constexpr int RING_OFF = 0, RING_BYTES = 131072, XCH_OFF = 131072, XCH_BYTES = 8192, LDSCTL_OFF = XCH_OFF + XCH_BYTES, MISC_OFF = LDSCTL_OFF + 320, LDS_BYTES = 147456;
constexpr int CW_TMO = 0, CW_BAR = 4096;
constexpr int CW_HIST = 16384;
constexpr int CW_TILES = 40960;

typedef __bf16 bf16x2_t __attribute__((ext_vector_type(2)));
__device__ __forceinline__ unsigned cvt_pk_bf16(float lo, float hi) { f32x2 v = {lo, hi}; bf16x2_t b = __builtin_convertvector(v, bf16x2_t); return __builtin_bit_cast(unsigned, b); }
__device__ __forceinline__ float fsigmoid(float x) { return __builtin_amdgcn_rcpf(1.f + __expf(-x)); }

__host__ __device__ __forceinline__ int lds_byte(int r, int c) { const int st = (r >> 4) * 2 + (c >> 5), rr = r & 15, cc = c & 31, ob = rr * 64 + cc * 2; return st * 1024 + (ob ^ (((ob >> 9) & 1) << 5)); }
__host__ __device__ __forceinline__ void stage_rc(int b, int& R, int& C) { const int st = b / 1024, sb = b % 1024, swz = sb ^ (((sb >> 9) & 1) << 5); R = (st >> 1) * 16 + swz / 64; C = (st & 1) * 32 + (swz % 64) / 2; }
__host__ __device__ __forceinline__ int permL(int L) { return (L & 0xE0) | (((L >> 2) & 1) << 4) | (((L >> 3) & 3) << 2) | (L & 3); }

#define XB_TMO      128
#define XB_XCNT(j)  (256  + 64 * (j))
#define XB_XSUB(j)  (1280 + 64 * (j))
#define XB_XGEN(j)  (2304 + 64 * (j))
#define XB_TOP      3328
#define XB_TOPGEN   3392
#define XCD_BAR_WORDS 3456
#define XB_SPIN_CAP (1u << 18)
__device__ __forceinline__ unsigned xb_ld(unsigned* p)              { return __hip_atomic_load(p, __ATOMIC_RELAXED, __HIP_MEMORY_SCOPE_AGENT); }
__device__ __forceinline__ unsigned xb_add(unsigned* p, unsigned v) { return __hip_atomic_fetch_add(p, v, __ATOMIC_RELAXED, __HIP_MEMORY_SCOPE_AGENT); }
__device__ __forceinline__ unsigned xb_xcc_id() { return (unsigned)__builtin_amdgcn_s_getreg((3 << 11) | 20) & 0xFu; }
#define XB_SPIN(cond, bar) do { unsigned _sp = 0; while (cond) { __builtin_amdgcn_s_sleep(1); \
    if ((++_sp & 255u) == 0u) { if (xb_ld(&(bar)[XB_TMO])) break; if (_sp > XB_SPIN_CAP) { atomicAdd(&(bar)[XB_TMO], 1u); break; } } } } while (0)
struct XcdBarrier { unsigned* bar; unsigned x; volatile LAS unsigned* st; };
__device__ __forceinline__ XcdBarrier xcd_barrier_post(unsigned* bar, volatile LAS unsigned* st) {
    XcdBarrier b; b.bar = bar; b.x = xb_xcc_id(); b.st = st;
    if (threadIdx.x == 0) (void)xb_add(&bar[XB_XCNT(b.x)], 1u);
    return b;
}
__device__ __forceinline__ void xcd_barrier_complete(unsigned* bar, unsigned x, unsigned& nloc, unsigned& nx) {
    const unsigned G = gridDim.x * gridDim.y * gridDim.z;
    unsigned sum, cnt, mine, sp = 0u;
    for (;;) {
        sum = 0u; cnt = 0u; mine = 0u;
#pragma unroll
        for (unsigned j = 0; j < 16; ++j) { const unsigned c = xb_ld(&bar[XB_XCNT(j)]); sum += c; cnt += (c > 0u) ? 1u : 0u; mine = (j == x) ? c : mine; }
        if (sum == G) break;
        __builtin_amdgcn_s_sleep(1);
        if ((++sp & 255u) == 0u) { if (xb_ld(&bar[XB_TMO])) break; if (sp > XB_SPIN_CAP) { atomicAdd(&bar[XB_TMO], 1u); break; } }
    }
    nloc = mine > 0u ? mine : 1u; nx = cnt > 0u ? cnt : 1u;
}
__device__ __forceinline__ void xcd_barrier(const XcdBarrier& b) {
    asm volatile("s_waitcnt vmcnt(0)" ::: "memory");
    __syncthreads();
    if (threadIdx.x == 0) {
        unsigned* bar = b.bar;
        __builtin_amdgcn_s_waitcnt(0);
        unsigned nloc = b.st[0], nx = b.st[1];
        if (nloc == 0u) { xcd_barrier_complete(bar, b.x, nloc, nx); b.st[0] = nloc; b.st[1] = nx; }
        const unsigned old = xb_add(&bar[XB_XSUB(b.x)], 1u);
        const unsigned gen = old / nloc;
        if (old + 1u == (gen + 1u) * nloc) {
            __builtin_amdgcn_fence(__ATOMIC_RELEASE, "agent");
            asm volatile("s_waitcnt vmcnt(0)" ::: "memory");
            const unsigned og = xb_add(&bar[XB_TOP], 1u);
            const unsigned tg = og / nx;
            if (og + 1u == (tg + 1u) * nx) xb_add(&bar[XB_TOPGEN], 1u);
            else XB_SPIN(xb_ld(&bar[XB_TOPGEN]) == tg, bar);
            __builtin_amdgcn_fence(__ATOMIC_ACQUIRE, "agent");
            xb_add(&bar[XB_XGEN(b.x)], 1u);
            asm volatile("s_waitcnt vmcnt(0)" ::: "memory");
        } else {
            XB_SPIN(xb_ld(&bar[XB_XGEN(b.x)]) == gen, bar);
            __builtin_amdgcn_fence(__ATOMIC_ACQUIRE, "agent");
            asm volatile("s_waitcnt vmcnt(0)" ::: "memory");
        }
    }
    __syncthreads();
}

struct Unit { int pm, pn, aux; };
struct DenseSched {
    const bf16_t* A; const bf16_t* Bt; int lda, ldb; int nM, nN, nwg, G, c;
    __device__ void init(const bf16_t* A_, int lda_, const bf16_t* Bt_, int ldb_, int M_, int N_, int G_, int c_) { A = A_; Bt = Bt_; lda = lda_; ldb = ldb_; nM = M_ / BM; nN = N_ / BM; nwg = nM * nN; G = G_; c = c_; }
    __device__ bool next(int i, Unit& u) const {
        const long L = (long)i * G + c; if (L >= nwg) return false;
        int wgid = (int)L; { const int q = nwg / NXCD, r = nwg % NXCD, xcd = wgid % NXCD, off = wgid / NXCD; wgid = (xcd < r ? xcd * (q + 1) : r * (q + 1) + (xcd - r) * q) + off; }
        const int nig = WGM * nN, gid = wgid / nig, fm = gid * WGM, gsz = (nM - fm) < WGM ? (nM - fm) : WGM;
        u.pm = fm + ((wgid % nig) % gsz); u.pn = (wgid % nig) / gsz; u.aux = 0; return true;
    }
    __device__ __forceinline__ const char* abase(const Unit& u) const { return (const char*)A + (size_t)u.pm * BM * lda * 2; }
    __device__ __forceinline__ const char* bbase(const Unit& u) const { return (const char*)Bt + (size_t)u.pn * BM * ldb * 2; }
    __device__ __forceinline__ void avoff(const Unit&, int R0, int C0, int R1, int C1, unsigned (&v0)[2], unsigned (&v1)[2]) const {
        v0[0] = (unsigned)(R0 * lda + C0) * 2u; v0[1] = (unsigned)(R1 * lda + C1) * 2u;
        v1[0] = v0[0] + (unsigned)(HALF * lda * 2); v1[1] = v0[1] + (unsigned)(HALF * lda * 2); }
};

template <bool GATHER, class Epi, class Sched>
__device__ __forceinline__ void gemm_phase(LAS unsigned char* lds, const int K, const Sched& S, const Epi& E) {
    const int tid = threadIdx.x, wid = __builtin_amdgcn_readfirstlane(tid >> 6), lane = tid & 63, wr = wid >> 2, wc = wid & 3, fr = lane & 15, fq = lane >> 4;
    const int nt = K / BK;
    int R0, C0, R1, C1; stage_rc(tid * 16, R0, C0); stage_rc(tid * 16 + 8192, R1, C1);
    unsigned voffB[2]; voffB[0] = (unsigned)(R0 * S.ldb + C0) * 2u; voffB[1] = (unsigned)(R1 * S.ldb + C1) * 2u;
    const size_t kstep = (size_t)(BK * 2);
    const size_t hstepB = (size_t)HALF * S.ldb * 2;
    const unsigned ldsw = (unsigned)wid * 1024u;
    const int aoff = lds_byte(wr * 64 + fr, fq * 8), boff = lds_byte(wc * 32 + fr, fq * 8);
#define PG8_SA(b, h) (((b) * 2 + (h)) * HTB)
#define PG8_SB(b, h) ((4 + (b) * 2 + (h)) * HTB)
#define PG8_STAGE(bufoff, gbase, voff) do { _Pragma("unroll") for (int _i = 0; _i < 2; ++_i) \
        __builtin_amdgcn_global_load_lds((const unsigned*)((const char*)(gbase) + (voff)[_i]), (LAS unsigned*)(lds + (bufoff) + ldsw + _i * 8192), 16, 0, 0); } while (0)
#define PG8_LDA(dst, b, h) do { _Pragma("unroll") for (int m = 0; m < 4; ++m) _Pragma("unroll") for (int k = 0; k < 2; ++k) dst[m][k] = *(const LAS bf16x8*)(lds + PG8_SA(b, h) + aoff + m * 2048 + k * 1024); } while (0)
#define PG8_LDB(dst, b, h) do { _Pragma("unroll") for (int n = 0; n < 2; ++n) _Pragma("unroll") for (int k = 0; k < 2; ++k) dst[n][k] = *(const LAS bf16x8*)(lds + PG8_SB(b, h) + boff + n * 2048 + k * 1024); } while (0)
#define PG8_MMA(ai, bj, At, Bt) do { __builtin_amdgcn_s_setprio(1); _Pragma("unroll") for (int m = 0; m < 4; ++m) _Pragma("unroll") for (int n = 0; n < 2; ++n) _Pragma("unroll") for (int k = 0; k < 2; ++k) \
        acc[ai][bj][m][n] = __builtin_amdgcn_mfma_f32_16x16x32_bf16(Bt[n][k], At[m][k], acc[ai][bj][m][n], 0, 0, 0); __builtin_amdgcn_s_setprio(0); } while (0)
#define PG8_WAIT_V(n) asm volatile("s_waitcnt vmcnt(" #n ")" ::: "memory")
#define PG8_WAIT_L(n) asm volatile("s_waitcnt lgkmcnt(" #n ")" ::: "memory")
#define PG8_BAR __builtin_amdgcn_s_barrier()
#define PG8_SCHED __builtin_amdgcn_sched_barrier(0)
    Unit cur, nxt; int ui = 0;
    if (!S.next(0, cur)) return;
    f32x4 acc[2][2][4][2];
#pragma unroll
    for (int a = 0; a < 2; ++a)
#pragma unroll
        for (int b = 0; b < 2; ++b)
#pragma unroll
            for (int m = 0; m < 4; ++m)
#pragma unroll
                for (int n = 0; n < 2; ++n) acc[a][b][m][n] = (f32x4){0.f, 0.f, 0.f, 0.f};
    bf16x8 At[4][2], B0[2][2], B1[2][2];
    unsigned va0[2], va1[2], na0[2], na1[2];
    S.avoff(cur, R0, C0, R1, C1, va0, va1);
    na0[0] = va0[0]; na0[1] = va0[1]; na1[0] = va1[0]; na1[1] = va1[1];
    const char* cA = S.abase(cur); const char* cB = S.bbase(cur);
    PG8_STAGE(PG8_SB(0, 0), cB, voffB); PG8_STAGE(PG8_SB(0, 1), cB + hstepB, voffB); PG8_STAGE(PG8_SA(0, 0), cA, va0); PG8_STAGE(PG8_SA(0, 1), cA, va1);
    if (wr == 1) PG8_BAR;
    PG8_WAIT_V(2); PG8_BAR;
    PG8_STAGE(PG8_SB(1, 0), cB + kstep, voffB); PG8_STAGE(PG8_SA(1, 0), cA + kstep, va0); PG8_STAGE(PG8_SB(1, 1), cB + hstepB + kstep, voffB);
    PG8_WAIT_V(6); PG8_BAR;
    for (;;) {
        const bool has_next = S.next(ui + 1, nxt);
        const char* nA = has_next ? S.abase(nxt) : cA; const char* nB = has_next ? S.bbase(nxt) : cB;
        if constexpr (GATHER) { if (has_next) S.avoff(nxt, R0, C0, R1, C1, na0, na1); }
#pragma unroll 1
        for (int t = 0; t < nt; t += 2) {
            const bool last = (t == nt - 2);
            const char* a1 = cA + (size_t)(t + 1) * kstep;
            const char* a2 = last ? nA : cA + (size_t)(t + 2) * kstep; const char* b2 = last ? nB : cB + (size_t)(t + 2) * kstep;
            const char* a3 = a2 + kstep; const char* b3 = b2 + kstep;
            unsigned x0[2], x1[2];
            if constexpr (GATHER) { x0[0] = last ? na0[0] : va0[0]; x0[1] = last ? na0[1] : va0[1]; x1[0] = last ? na1[0] : va1[0]; x1[1] = last ? na1[1] : va1[1]; }
            else { x0[0] = va0[0]; x0[1] = va0[1]; x1[0] = va1[0]; x1[1] = va1[1]; }
            PG8_LDB(B0, 0, 0); PG8_LDB(B1, 0, 1); PG8_SCHED; PG8_LDA(At, 0, 0); PG8_STAGE(PG8_SA(1, 1), a1, va1);
            PG8_WAIT_V(8); PG8_WAIT_L(0); PG8_BAR; PG8_MMA(0, 0, At, B0); PG8_MMA(0, 1, At, B1); PG8_BAR; PG8_SCHED;
            PG8_LDA(At, 0, 1); PG8_STAGE(PG8_SB(0, 0), b2, voffB); PG8_STAGE(PG8_SB(0, 1), b2 + hstepB, voffB); PG8_STAGE(PG8_SA(0, 0), a2, x0);
            PG8_WAIT_V(8); PG8_WAIT_L(0); PG8_BAR; PG8_MMA(1, 0, At, B0); PG8_MMA(1, 1, At, B1); PG8_BAR; PG8_SCHED;
            PG8_LDB(B0, 1, 0); PG8_LDB(B1, 1, 1); PG8_SCHED; PG8_LDA(At, 1, 0); PG8_STAGE(PG8_SA(0, 1), a2, x1);
            PG8_WAIT_V(8); PG8_WAIT_L(0); PG8_BAR; PG8_MMA(0, 0, At, B0); PG8_MMA(0, 1, At, B1); PG8_BAR; PG8_SCHED;
            PG8_LDA(At, 1, 1); PG8_STAGE(PG8_SB(1, 0), b3, voffB); PG8_STAGE(PG8_SB(1, 1), b3 + hstepB, voffB); PG8_STAGE(PG8_SA(1, 0), a3, x0);
            PG8_WAIT_V(8); PG8_WAIT_L(0); PG8_BAR; PG8_MMA(1, 0, At, B0); PG8_MMA(1, 1, At, B1); PG8_BAR; PG8_SCHED;
        }
        if (wr == 0) PG8_BAR;
        E(acc, cur, wr, wc, fr, fq);
        if (!has_next) break;
#pragma unroll
        for (int a = 0; a < 2; ++a)
#pragma unroll
            for (int b = 0; b < 2; ++b)
#pragma unroll
                for (int m = 0; m < 4; ++m)
#pragma unroll
                    for (int n = 0; n < 2; ++n) acc[a][b][m][n] = (f32x4){0.f, 0.f, 0.f, 0.f};
        cur = nxt; cA = nA; cB = nB; ++ui;
        if constexpr (GATHER) { va0[0] = na0[0]; va0[1] = na0[1]; va1[0] = na1[0]; va1[1] = na1[1]; }
        if (wr == 1) PG8_BAR;
    }
    PG8_WAIT_V(0);
    PG8_BAR;
#undef PG8_SA
#undef PG8_SB
#undef PG8_STAGE
#undef PG8_LDA
#undef PG8_LDB
#undef PG8_MMA
#undef PG8_WAIT_V
#undef PG8_WAIT_L
#undef PG8_BAR
#undef PG8_SCHED
}

__device__ __forceinline__ u32x4 pack8(const f32x4 a, const f32x4 b) { u32x4 w; w.x = cvt_pk_bf16(a[0], a[1]); w.y = cvt_pk_bf16(a[2], a[3]); w.z = cvt_pk_bf16(b[0], b[1]); w.w = cvt_pk_bf16(b[2], b[3]); return w; }

struct EpiIn {
    bf16_t *u, *gb, *sg, *lat; float* rowstat; const float2* cs; const float* k_g; LAS float* xch;
    __device__ __forceinline__ void operator()(const f32x4 (&acc)[2][2][4][2], const Unit& un, int wr, int wc, int fr, int fq) const {
        asm volatile("" : "+v"(fr), "+v"(fq));
        const int row0 = un.pm * BM + wr * 64 + fr, pn = un.pn;
        if (pn < 16) {
            const int ch = 64 * pn + 16 * wc + 4 * fq;
#pragma unroll
            for (int ai = 0; ai < 2; ++ai)
#pragma unroll
                for (int m = 0; m < 4; ++m) { const size_t off = (size_t)(row0 + ai * HALF + m * 16) * DM + ch;
                    const f32x4 zx = acc[ai][0][m][0], zc = acc[ai][0][m][1], zb = acc[ai][1][m][0], zg = acc[ai][1][m][1];
                    const f32x4 uu = zx * zc; f32x4 g; g[0] = zb[0] * fsigmoid(zg[0]); g[1] = zb[1] * fsigmoid(zg[1]); g[2] = zb[2] * fsigmoid(zg[2]); g[3] = zb[3] * fsigmoid(zg[3]);
                    u32x2 w0, w1; w0.x = cvt_pk_bf16(uu[0], uu[1]); w0.y = cvt_pk_bf16(uu[2], uu[3]); w1.x = cvt_pk_bf16(g[0], g[1]); w1.y = cvt_pk_bf16(g[2], g[3]);
                    *(u32x2*)(u + off) = w0; *(u32x2*)(gb + off) = w1; }
        } else if (pn < 20) {
            const int c0 = 256 * (pn - 16) + 32 * wc + 8 * fq;
#pragma unroll
            for (int ai = 0; ai < 2; ++ai)
#pragma unroll
                for (int m = 0; m < 4; ++m)
#pragma unroll
                    for (int bj = 0; bj < 2; ++bj) { f32x4 a = acc[ai][bj][m][0], b = acc[ai][bj][m][1];
#pragma unroll
                        for (int i = 0; i < 4; ++i) { a[i] = fsigmoid(a[i]); b[i] = fsigmoid(b[i]); }
                        *(u32x4*)(sg + (size_t)(row0 + ai * HALF + m * 16) * DM + c0 + bj * HALF) = pack8(a, b); }
        } else {
            const int c0 = 256 * (pn - 20) + 32 * wc + 8 * fq, rowt = wr * 64 + fr;
#pragma unroll
            for (int ai = 0; ai < 2; ++ai)
#pragma unroll
                for (int m = 0; m < 4; ++m) { const int rt = rowt + ai * HALF + m * 16, row = un.pm * BM + rt; float s0, s1;
                    { const f32x4 a = acc[ai][0][m][0], b = acc[ai][0][m][1]; *(u32x4*)(lat + (size_t)row * LATW + c0) = pack8(a, b);
                      s0 = (a[0] * a[0] + a[1] * a[1]) + (a[2] * a[2] + a[3] * a[3]) + (b[0] * b[0] + b[1] * b[1]) + (b[2] * b[2] + b[3] * b[3]); }
                    { const f32x4 a = acc[ai][1][m][0], b = acc[ai][1][m][1];
                      s1 = (a[0] * a[0] + a[1] * a[1]) + (a[2] * a[2] + a[3] * a[3]) + (b[0] * b[0] + b[1] * b[1]) + (b[2] * b[2] + b[3] * b[3]);
                      if (pn != 21) *(u32x4*)(lat + (size_t)row * LATW + c0 + HALF) = pack8(a, b);
                      else if (wc < 2) { const int j = 16 * wc + 4 * fq;
                          const f32x4 g1 = *(const f32x4*)(k_g + 128 + j), g2 = *(const f32x4*)(k_g + 160 + j);
                          const f32x4 cA = *(const f32x4*)((const float*)cs + ((size_t)row * 32 + j) * 2), cB = *(const f32x4*)((const float*)cs + ((size_t)row * 32 + j + 2) * 2);
                          const f32x4 x1 = a * g1, x2 = b * g2; f32x4 y1, y2;
                          y1[0] = x1[0] * cA[0] - x2[0] * cA[1]; y2[0] = x2[0] * cA[0] + x1[0] * cA[1]; y1[1] = x1[1] * cA[2] - x2[1] * cA[3]; y2[1] = x2[1] * cA[2] + x1[1] * cA[3];
                          y1[2] = x1[2] * cB[0] - x2[2] * cB[1]; y2[2] = x2[2] * cB[0] + x1[2] * cB[1]; y1[3] = x1[3] * cB[2] - x2[3] * cB[3]; y2[3] = x2[3] * cB[2] + x1[3] * cB[3];
                          u32x2 w1, w2; w1.x = cvt_pk_bf16(y1[0], y1[1]); w1.y = cvt_pk_bf16(y1[2], y1[3]); w2.x = cvt_pk_bf16(y2[0], y2[1]); w2.y = cvt_pk_bf16(y2[2], y2[3]);
                          *(u32x2*)(lat + (size_t)row * LATW + 384 + j) = w1; *(u32x2*)(lat + (size_t)row * LATW + 416 + j) = w2; } }
                    s0 += __shfl_xor(s0, 16); s0 += __shfl_xor(s0, 32); s1 += __shfl_xor(s1, 16); s1 += __shfl_xor(s1, 32);
                    if (fq == 0) { xch[rt * 8 + wc] = s0; xch[rt * 8 + 4 + wc] = s1; } }
            asm volatile("s_waitcnt lgkmcnt(0)" ::: "memory"); __builtin_amdgcn_s_barrier(); asm volatile("" ::: "memory");
            if (threadIdx.x < 256) { const int rt = threadIdx.x; const f32x4 p0 = *(const LAS f32x4*)(xch + rt * 8), p1 = *(const LAS f32x4*)(xch + rt * 8 + 4);
                const float S0 = (p0[0] + p0[1]) + (p0[2] + p0[3]), S1 = (p1[0] + p1[1]) + (p1[2] + p1[3]); float* st = rowstat + (size_t)(un.pm * BM + rt) * 4;
                if (pn == 20) st[0] = S0 + S1; else if (pn == 21) { st[1] = S0; st[2] = S1; } else st[3] = S0 + S1; }
        }
    }
};
struct EpiPlain {
    bf16_t* O; int ldc;
    __device__ __forceinline__ void operator()(const f32x4 (&acc)[2][2][4][2], const Unit& un, int wr, int wc, int fr, int fq) const {
        asm volatile("" : "+v"(fr), "+v"(fq));
        const int row0 = un.pm * BM + wr * 64 + fr, c0 = 256 * un.pn + 32 * wc + 8 * fq;
#pragma unroll
        for (int ai = 0; ai < 2; ++ai)
#pragma unroll
            for (int m = 0; m < 4; ++m)
#pragma unroll
                for (int bj = 0; bj < 2; ++bj) *(u32x4*)(O + (size_t)(row0 + ai * HALF + m * 16) * ldc + c0 + bj * HALF) = pack8(acc[ai][bj][m][0], acc[ai][bj][m][1]);
    }
};
struct EpiKV {
    bf16_t *Kb, *Vb; const bf16_t* lat; const float* rowstat; const float* k_g; LAS float* xch;
    __device__ __forceinline__ void operator()(const f32x4 (&acc)[2][2][4][2], const Unit& un, int wr, int wc, int fr, int fq) const {
        asm volatile("" : "+v"(fr), "+v"(fq));
        const int h = un.pn, rowt = wr * 64 + fr, b = (un.pm * BM) / SEQ, s0 = (un.pm * BM) % SEQ;
        const int i0 = 8 * wc + 2 * fq;
        f32x4 st[2][4]; unsigned r1[2][4], r2[2][4];
#pragma unroll
        for (int ai = 0; ai < 2; ++ai)
#pragma unroll
            for (int m = 0; m < 4; ++m) { const size_t row = (size_t)(un.pm * BM + rowt + ai * HALF + m * 16);
                st[ai][m] = *(const f32x4*)(rowstat + row * 4); r1[ai][m] = *(const unsigned*)(lat + row * LATW + 384 + i0); r2[ai][m] = *(const unsigned*)(lat + row * LATW + 416 + i0); }
#pragma unroll
        for (int ai = 0; ai < 2; ++ai)
#pragma unroll
            for (int m = 0; m < 4; ++m) {
                const f32x4 a = acc[ai][0][m][0], c = acc[ai][0][m][1];
                float ss = (a[0] * a[0] + a[1] * a[1]) + (a[2] * a[2] + a[3] * a[3]) + (c[0] * c[0] + c[1] * c[1]) + (c[2] * c[2] + c[3] * c[3]);
                ss += __shfl_xor(ss, 16); ss += __shfl_xor(ss, 32);
                if (fq == 0) xch[(rowt + ai * HALF + m * 16) * 4 + wc] = ss; }
        asm volatile("s_waitcnt lgkmcnt(0)" ::: "memory"); __builtin_amdgcn_s_barrier(); asm volatile("" ::: "memory");
        const int c8 = 32 * wc + 8 * fq;
        const f32x4 g0 = *(const f32x4*)(k_g + c8), g1 = *(const f32x4*)(k_g + c8 + 4);
#pragma unroll
        for (int ai = 0; ai < 2; ++ai)
#pragma unroll
            for (int m = 0; m < 4; ++m) { const int rt = rowt + ai * HALF + m * 16;
                const float rkv = 1.f / sqrtf(st[ai][m][3] * (1.f / KVL) + EPS);
                const f32x4 t4 = *(const LAS f32x4*)(xch + rt * 4);
                const float rk = 1.f / sqrtf((((t4[0] + t4[1]) + (t4[2] + t4[3])) * rkv * rkv + st[ai][m][2]) * (1.f / QKH) + EPS);
                const float sk = rkv * rk, sv = rkv;
                const size_t bhs = (size_t)(b * NH + h) * SEQ + s0 + rt;
                bf16_t* Kp = Kb + bhs * QKH; bf16_t* Vp = Vb + bhs * VH;
                *(u32x4*)(Kp + c8) = pack8(acc[ai][0][m][0] * sk * g0, acc[ai][0][m][1] * sk * g1);
                *(u32x4*)(Vp + c8) = pack8(acc[ai][1][m][0] * sv, acc[ai][1][m][1] * sv);
                *(unsigned*)(Kp + 128 + i0) = cvt_pk_bf16(__uint_as_float(r1[ai][m] << 16) * rk, __uint_as_float(r1[ai][m] & 0xffff0000u) * rk);
                *(unsigned*)(Kp + 160 + i0) = cvt_pk_bf16(__uint_as_float(r2[ai][m] << 16) * rk, __uint_as_float(r2[ai][m] & 0xffff0000u) * rk); }
    }
};
struct EpiDelta {
    const float* mod; bf16_t* delta;
    __device__ __forceinline__ void operator()(const f32x4 (&acc)[2][2][4][2], const Unit& un, int wr, int wc, int fr, int fq) const {
        asm volatile("" : "+v"(fr), "+v"(fq));
        const int row0 = un.pm * BM + wr * 64 + fr, b = (un.pm * BM) / SEQ, c0 = 256 * un.pn + 32 * wc + 8 * fq;
        const float* gate = mod + b * 6144 + 2048;
#pragma unroll
        for (int bj = 0; bj < 2; ++bj) { const f32x4 g0 = *(const f32x4*)(gate + c0 + bj * HALF), g1 = *(const f32x4*)(gate + c0 + bj * HALF + 4);
#pragma unroll
            for (int ai = 0; ai < 2; ++ai)
#pragma unroll
                for (int m = 0; m < 4; ++m) *(u32x4*)(delta + (size_t)(row0 + ai * HALF + m * 16) * DM + c0 + bj * HALF) = pack8(acc[ai][bj][m][0] * g0, acc[ai][bj][m][1] * g1); }
    }
};
namespace att {
constexpr int NW = 8, QBLK = 32, KVBLK = 64, KPITCH = 400;
constexpr int SHM_V = KVBLK * VH * 2, SHM_K = KVBLK * KPITCH;
constexpr int QRP = 144;
constexpr int OFF_V = 0, OFF_K = 2 * SHM_V, OFF_WS = OFF_K + 2 * SHM_K, OFF_QR = OFF_WS + NW * 64 * 4, ATT_LDS = OFF_QR + NW * 32 * QRP;
constexpr float SCALE = 0.07216878364870322f;
constexpr float THR = 8.f;
#define SBAR() __builtin_amdgcn_sched_barrier(0)
__device__ __forceinline__ int crow(int r, int hi) { return (r & 3) + 8 * (r >> 2) + 4 * hi; }
__device__ __forceinline__ void partialSM(f32x16& p0, f32x16& p1, float& m_reg, float& alpha) {
    constexpr float C = SCALE * 1.4426950408889634f;
    float pmax = p0[0];
#pragma unroll
    for (int r = 1; r < 16; ++r) pmax = fmaxf(pmax, p0[r]);
#pragma unroll
    for (int r = 0; r < 16; ++r) pmax = fmaxf(pmax, p1[r]);
    { auto rr = __builtin_amdgcn_permlane32_swap(__float_as_uint(pmax), __float_as_uint(pmax), false, false);
      pmax = fmaxf(__uint_as_float(rr[0]), __uint_as_float(rr[1])); }
    float mn;
    if (__builtin_expect(__all(pmax - m_reg <= THR / SCALE), 1)) { mn = m_reg; alpha = 1.f; }
    else { mn = fmaxf(m_reg, pmax); alpha = __builtin_amdgcn_exp2f((m_reg - mn) * C); m_reg = mn; }
    const float mnC = -mn * C;
#pragma unroll
    for (int r = 0; r < 16; ++r) p0[r] = fmaf(p0[r], C, mnC);
#pragma unroll
    for (int r = 0; r < 16; ++r) p1[r] = fmaf(p1[r], C, mnC);
#pragma unroll
    for (int r = 0; r < 16; ++r) p0[r] = __builtin_amdgcn_exp2f(p0[r]);
}
__device__ __forceinline__ void finishSM(f32x16& p0, f32x16& p1, float alpha, float& l_reg, bf16x8& pa0, bf16x8& pa1, bf16x8& pa2, bf16x8& pa3) {
#pragma unroll
    for (int r = 0; r < 16; ++r) p1[r] = __builtin_amdgcn_exp2f(p1[r]);
    float ps = 0;
#pragma unroll
    for (int r = 0; r < 16; ++r) ps += p0[r];
#pragma unroll
    for (int r = 0; r < 16; ++r) ps += p1[r];
    { auto rr = __builtin_amdgcn_permlane32_swap(__float_as_uint(ps), __float_as_uint(ps), false, false);
      ps = __uint_as_float(rr[0]) + __uint_as_float(rr[1]); }
    l_reg = l_reg * alpha + ps;
#define PK4(P, BASE, OUT) do { unsigned a0 = cvt_pk_bf16(P[BASE + 0], P[BASE + 1]), a1 = cvt_pk_bf16(P[BASE + 2], P[BASE + 3]);   \
    unsigned b0 = cvt_pk_bf16(P[BASE + 4], P[BASE + 5]), b1 = cvt_pk_bf16(P[BASE + 6], P[BASE + 7]);                              \
    auto r0 = __builtin_amdgcn_permlane32_swap(a0, b0, false, false); auto r1 = __builtin_amdgcn_permlane32_swap(a1, b1, false, false); \
    u32x4 w = {r0[0], r1[0], r0[1], r1[1]}; OUT = *reinterpret_cast<bf16x8*>(&w); } while (0)
    PK4(p0, 0, pa0); PK4(p0, 8, pa1); PK4(p1, 0, pa2); PK4(p1, 8, pa3);
#undef PK4
}
__device__ __forceinline__ void qkt(f32x16& p0, f32x16& p1, const LAS char* Ks, const bf16x8 (&qr)[8], const LAS char* qrope, int r32, int hi) {
    p0 = f32x16{}; p1 = f32x16{};
    const LAS char* k0 = Ks + r32 * KPITCH + hi * 16;
#pragma unroll
    for (int d0 = 0; d0 < 8; ++d0) {
        const bf16x8 b0 = *(const LAS bf16x8*)(k0 + d0 * 32);
        const bf16x8 b1 = *(const LAS bf16x8*)(k0 + 32 * KPITCH + d0 * 32);
        p0 = __builtin_amdgcn_mfma_f32_32x32x16_bf16(b0, qr[d0], p0, 0, 0, 0);
        p1 = __builtin_amdgcn_mfma_f32_32x32x16_bf16(b1, qr[d0], p1, 0, 0, 0); }
#pragma unroll
    for (int d0 = 8; d0 < 12; ++d0) {
        const bf16x8 b0 = *(const LAS bf16x8*)(k0 + d0 * 32);
        const bf16x8 b1 = *(const LAS bf16x8*)(k0 + 32 * KPITCH + d0 * 32);
        const bf16x8 qf = *(const LAS bf16x8*)(qrope + (d0 - 8) * 32);
        p0 = __builtin_amdgcn_mfma_f32_32x32x16_bf16(b0, qf, p0, 0, 0, 0);
        p1 = __builtin_amdgcn_mfma_f32_32x32x16_bf16(b1, qf, p1, 0, 0, 0); }
}
__device__ __forceinline__ int v_st(int k, int c) { const int kk = (k & ~0xC) | ((k & 4) << 1) | ((k & 8) >> 1); return ((kk >> 3) * 4 + (c >> 5)) * 512 + ((kk & 7) * 32 + (c & 31)) * 2; }
__device__ __forceinline__ int v_rd_base(int lane) { return ((lane & 3) << 3) | (((lane >> 2) & 3) << 6) | (((lane >> 4) & 1) << 5) | (((lane >> 5) & 1) << 8); }
constexpr int v_rd_off(int d0, int ks, int half) { return d0 * 512 + ks * 4096 + half * 2048; }
template <int OFF> __device__ __forceinline__ s16x4 tr_read(int vb) {
    s16x4 r; asm volatile("ds_read_b64_tr_b16 %0, %1 offset:%2" : "=&v"(r) : "v"(vb), "i"(OFF) : "memory"); return r;
}
template <int D0> __device__ __forceinline__ void pv_one(f32x16& od, int vb, bf16x8 pa0, bf16x8 pa1, bf16x8 pa2, bf16x8 pa3) {
#define PK(L, H) (bf16x8){L[0], L[1], L[2], L[3], H[0], H[1], H[2], H[3]}
    { const s16x4 l0 = tr_read<v_rd_off(D0, 0, 0)>(vb), h0 = tr_read<v_rd_off(D0, 0, 1)>(vb), l1 = tr_read<v_rd_off(D0, 1, 0)>(vb), h1 = tr_read<v_rd_off(D0, 1, 1)>(vb);
      asm volatile("s_waitcnt lgkmcnt(0)" ::: "memory"); SBAR();
      od = __builtin_amdgcn_mfma_f32_32x32x16_bf16(pa0, PK(l0, h0), od, 0, 0, 0);
      od = __builtin_amdgcn_mfma_f32_32x32x16_bf16(pa1, PK(l1, h1), od, 0, 0, 0); }
    { const s16x4 l2 = tr_read<v_rd_off(D0, 2, 0)>(vb), h2 = tr_read<v_rd_off(D0, 2, 1)>(vb), l3 = tr_read<v_rd_off(D0, 3, 0)>(vb), h3 = tr_read<v_rd_off(D0, 3, 1)>(vb);
      asm volatile("s_waitcnt lgkmcnt(0)" ::: "memory"); SBAR();
      od = __builtin_amdgcn_mfma_f32_32x32x16_bf16(pa2, PK(l2, h2), od, 0, 0, 0);
      od = __builtin_amdgcn_mfma_f32_32x32x16_bf16(pa3, PK(l3, h3), od, 0, 0, 0); }
#undef PK
}
__device__ __forceinline__ void pv_d0(f32x16 (&o)[4], int vb, bf16x8 pa0, bf16x8 pa1, bf16x8 pa2, bf16x8 pa3) {
    pv_one<0>(o[0], vb, pa0, pa1, pa2, pa3); pv_one<1>(o[1], vb, pa0, pa1, pa2, pa3); pv_one<2>(o[2], vb, pa0, pa1, pa2, pa3); pv_one<3>(o[3], vb, pa0, pa1, pa2, pa3);
}
__device__ __forceinline__ float bflo(unsigned w) { return __uint_as_float(w << 16); }
__device__ __forceinline__ float bfhi(unsigned w) { return __uint_as_float(w & 0xffff0000u); }

struct AttnArgs { const bf16_t* Q; const bf16_t* Kb; const bf16_t* Vb; const float* ssp; const float2* cs; const float* q_g; const bf16_t *u, *gb, *sg; const float* conv_w; bf16_t* merged; };

template <int MODE> __device__ __forceinline__ void attn_unit(const AttnArgs& T, int b, int h, int qb, LAS char* lds) {
    int tid = threadIdx.x; asm volatile("" : "+v"(tid));
    const int lane = tid & 63, r32 = lane & 31, hi = lane >> 5; const int wid = __builtin_amdgcn_readfirstlane(tid >> 6);
    LAS char* V_lds = lds + OFF_V; LAS char* K_lds = lds + OFF_K;
    LAS float* ws = (LAS float*)(lds + OFF_WS) + wid * 64; LAS float* li_l = ws; LAS float* al_l = ws + 32;
    const int mrow = b * SEQ + qb * 256 + wid * QBLK + r32;
    const bf16_t* Kh = T.Kb + (size_t)(b * NH + h) * SEQ * QKH; const bf16_t* Vh = T.Vb + (size_t)(b * NH + h) * SEQ * VH;
    const int sr = tid >> 4, sc = (tid & 15) * 8, vst0 = v_st(sr, sc), vst1 = v_st(32 + sr, sc);
    const int kdst = (tid >> 3) * KPITCH + (tid & 7) * 48;
    const int vb0 = (int)(uintptr_t)V_lds + v_rd_base(lane);
    bf16x8 sk0, sk1, sk2, sv0, sv1;
#define SLOAD(t) do { const bf16_t* kp = Kh + (size_t)(t) * KVBLK * QKH + tid * 24; sk0 = *(const bf16x8*)kp; sk1 = *(const bf16x8*)(kp + 8); sk2 = *(const bf16x8*)(kp + 16); \
    const bf16_t* vp = Vh + (size_t)((t) * KVBLK + sr) * VH + sc; sv0 = *(const bf16x8*)vp; sv1 = *(const bf16x8*)(vp + 32 * VH); } while (0)
#define SWRITE(bf) do { *(LAS bf16x8*)(V_lds + (bf) * SHM_V + vst0) = sv0; *(LAS bf16x8*)(V_lds + (bf) * SHM_V + vst1) = sv1; \
    *(LAS bf16x8*)(K_lds + (bf) * SHM_K + kdst) = sk0; *(LAS bf16x8*)(K_lds + (bf) * SHM_K + kdst + 16) = sk1; *(LAS bf16x8*)(K_lds + (bf) * SHM_K + kdst + 32) = sk2; } while (0)
#define RESC(a) do { if (__any((a) < 1.f)) { if (hi == 0) al_l[r32] = (a); asm volatile("s_waitcnt lgkmcnt(0)" ::: "memory"); \
    _Pragma("unroll") for (int d = 0; d < 4; ++d) _Pragma("unroll") for (int r = 0; r < 16; ++r) o[d][r] *= al_l[crow(r, hi)]; } } while (0)
    SLOAD(0);
    bf16x8 qr[8];
    LAS char* qrope = lds + OFF_QR + wid * (32 * QRP) + r32 * QRP + hi * 16;
    {
        const bf16_t* Qw = T.Q + (size_t)mrow * 1536 + h * QKH + hi * 8;
        u32x4 raw[12];
#pragma unroll
        for (int d0 = 0; d0 < 12; ++d0) raw[d0] = *(const u32x4*)(Qw + d0 * 16);
        const f32x2 sq2 = *(const f32x2*)(T.ssp + (size_t)mrow * 4); const float ssq = sq2[0] + sq2[1];
        float ss = 0.f;
#pragma unroll
        for (int d0 = 0; d0 < 12; ++d0)
#pragma unroll
            for (int e = 0; e < 4; ++e) { const float a = bflo(raw[d0][e]), c = bfhi(raw[d0][e]); ss += a * a + c * c; }
        { auto rr = __builtin_amdgcn_permlane32_swap(__float_as_uint(ss), __float_as_uint(ss), false, false); ss = __uint_as_float(rr[0]) + __uint_as_float(rr[1]); }
        const float rq2 = 1.f / (ssq * (1.f / QL) + EPS);
        const float rn = 1.f / sqrtf(ss * rq2 * (1.f / QKH) + EPS) * sqrtf(rq2);
#pragma unroll
        for (int d0 = 0; d0 < 8; ++d0) { const f32x4 g0 = *(const f32x4*)(T.q_g + d0 * 16 + hi * 8), g1 = *(const f32x4*)(T.q_g + d0 * 16 + hi * 8 + 4);
            u32x4 w; w.x = cvt_pk_bf16(bflo(raw[d0].x) * rn * g0[0], bfhi(raw[d0].x) * rn * g0[1]); w.y = cvt_pk_bf16(bflo(raw[d0].y) * rn * g0[2], bfhi(raw[d0].y) * rn * g0[3]);
            w.z = cvt_pk_bf16(bflo(raw[d0].z) * rn * g1[0], bfhi(raw[d0].z) * rn * g1[1]); w.w = cvt_pk_bf16(bflo(raw[d0].w) * rn * g1[2], bfhi(raw[d0].w) * rn * g1[3]);
            qr[d0] = *reinterpret_cast<bf16x8*>(&w); }
#pragma unroll
        for (int p = 0; p < 2; ++p) {
            const int ib = 16 * p + 8 * hi;
            float x1[8], x2[8];
            const f32x4 ga = *(const f32x4*)(T.q_g + 128 + ib), gb_ = *(const f32x4*)(T.q_g + 128 + ib + 4), gc = *(const f32x4*)(T.q_g + 160 + ib), gd = *(const f32x4*)(T.q_g + 160 + ib + 4);
            const float g1v[8] = {ga[0], ga[1], ga[2], ga[3], gb_[0], gb_[1], gb_[2], gb_[3]}, g2v[8] = {gc[0], gc[1], gc[2], gc[3], gd[0], gd[1], gd[2], gd[3]};
#pragma unroll
            for (int e = 0; e < 4; ++e) { x1[2 * e] = bflo(raw[8 + p][e]) * rn * g1v[2 * e]; x1[2 * e + 1] = bfhi(raw[8 + p][e]) * rn * g1v[2 * e + 1];
                                          x2[2 * e] = bflo(raw[10 + p][e]) * rn * g2v[2 * e]; x2[2 * e + 1] = bfhi(raw[10 + p][e]) * rn * g2v[2 * e + 1]; }
            float y1[8], y2[8];
#pragma unroll
            for (int jj = 0; jj < 4; ++jj) { const f32x4 c2 = *(const f32x4*)((const float*)T.cs + ((size_t)mrow * 32 + ib + 2 * jj) * 2);
                y1[2 * jj] = x1[2 * jj] * c2[0] - x2[2 * jj] * c2[1]; y2[2 * jj] = x2[2 * jj] * c2[0] + x1[2 * jj] * c2[1];
                y1[2 * jj + 1] = x1[2 * jj + 1] * c2[2] - x2[2 * jj + 1] * c2[3]; y2[2 * jj + 1] = x2[2 * jj + 1] * c2[2] + x1[2 * jj + 1] * c2[3]; }
            u32x4 w1, w2; w1.x = cvt_pk_bf16(y1[0], y1[1]); w1.y = cvt_pk_bf16(y1[2], y1[3]); w1.z = cvt_pk_bf16(y1[4], y1[5]); w1.w = cvt_pk_bf16(y1[6], y1[7]);
            w2.x = cvt_pk_bf16(y2[0], y2[1]); w2.y = cvt_pk_bf16(y2[2], y2[3]); w2.z = cvt_pk_bf16(y2[4], y2[5]); w2.w = cvt_pk_bf16(y2[6], y2[7]);
            *(LAS u32x4*)(qrope + p * 32) = w1; *(LAS u32x4*)(qrope + (2 + p) * 32) = w2; }
        asm volatile("s_waitcnt lgkmcnt(0)" ::: "memory");
    }
    float m_reg = -1e30f, l_reg = 0.f; f32x16 o[4] = {};
    f32x16 pA0, pA1, pB0, pB1; float alA = 1.f, alB = 1.f; bf16x8 pa0, pa1, pa2, pa3;
    const int NT = 4 * qb + 4; const int wp = wid >> 1;
    const bool a1 = wp >= 1, a2 = wp >= 2, a3 = wp >= 3;
    const LAS char* K0 = K_lds; const LAS char* K1 = K_lds + SHM_K;
    asm volatile("s_waitcnt vmcnt(0)" ::: "memory"); SWRITE(0); __syncthreads();
    qkt(pA0, pA1, K0, qr, qrope, r32, hi); partialSM(pA0, pA1, m_reg, alA);
    SLOAD(1); asm volatile("s_waitcnt vmcnt(0)" ::: "memory"); SWRITE(1); __syncthreads();
    for (int j = 1; j + 3 < NT; j += 2) {
        SBAR(); qkt(pB0, pB1, K1, qr, qrope, r32, hi);
        finishSM(pA0, pA1, alA, l_reg, pa0, pa1, pa2, pa3); SBAR();
        SLOAD(j + 1); SBAR();
        pv_d0(o, vb0, pa0, pa1, pa2, pa3); partialSM(pB0, pB1, m_reg, alB);
        __syncthreads(); asm volatile("s_waitcnt vmcnt(0)" ::: "memory"); SWRITE(0);
        RESC(alB); __syncthreads();
        SBAR(); qkt(pA0, pA1, K0, qr, qrope, r32, hi);
        finishSM(pB0, pB1, alB, l_reg, pa0, pa1, pa2, pa3); SBAR();
        SLOAD(j + 2); SBAR();
        pv_d0(o, vb0 + SHM_V, pa0, pa1, pa2, pa3); partialSM(pA0, pA1, m_reg, alA);
        __syncthreads(); asm volatile("s_waitcnt vmcnt(0)" ::: "memory"); SWRITE(1);
        RESC(alA); __syncthreads();
    }
#define MASK(P0, P1, act) do { if (!(act)) { _Pragma("unroll") for (int r = 0; r < 16; ++r) { P0[r] = -INFINITY; P1[r] = -INFINITY; } } } while (0)
    {
        SBAR(); if (a1) qkt(pB0, pB1, K1, qr, qrope, r32, hi); MASK(pB0, pB1, a1);
        finishSM(pA0, pA1, alA, l_reg, pa0, pa1, pa2, pa3); SBAR();
        SLOAD(NT - 2); SBAR();
        pv_d0(o, vb0, pa0, pa1, pa2, pa3); partialSM(pB0, pB1, m_reg, alB);
        __syncthreads(); asm volatile("s_waitcnt vmcnt(0)" ::: "memory"); SWRITE(0);
        RESC(alB); __syncthreads();
        SBAR(); if (a2) qkt(pA0, pA1, K0, qr, qrope, r32, hi); MASK(pA0, pA1, a2);
        finishSM(pB0, pB1, alB, l_reg, pa0, pa1, pa2, pa3); SBAR();
        SLOAD(NT - 1); SBAR();
        pv_d0(o, vb0 + SHM_V, pa0, pa1, pa2, pa3); partialSM(pA0, pA1, m_reg, alA);
        __syncthreads(); asm volatile("s_waitcnt vmcnt(0)" ::: "memory"); SWRITE(1);
        RESC(alA); __syncthreads();
        SBAR(); if (a3) qkt(pB0, pB1, K1, qr, qrope, r32, hi); MASK(pB0, pB1, a3);
        finishSM(pA0, pA1, alA, l_reg, pa0, pa1, pa2, pa3); SBAR();
        pv_d0(o, vb0, pa0, pa1, pa2, pa3); partialSM(pB0, pB1, m_reg, alB);
        RESC(alB);
        finishSM(pB0, pB1, alB, l_reg, pa0, pa1, pa2, pa3); SBAR();
        pv_d0(o, vb0 + SHM_V, pa0, pa1, pa2, pa3);
    }
#undef MASK
    if (hi == 0) li_l[r32] = l_reg; asm volatile("s_waitcnt lgkmcnt(0)" ::: "memory");
    float rli[16];
#pragma unroll
    for (int r = 0; r < 16; ++r) rli[r] = __builtin_amdgcn_rcpf(li_l[crow(r, hi)]);
    __syncthreads();
    LAS bf16_t* stg = (LAS bf16_t*)(lds + wid * 8192);
#pragma unroll
    for (int r = 0; r < 16; ++r) { const int orow = crow(r, hi);
#pragma unroll
        for (int d0 = 0; d0 < 4; ++d0) stg[orow * 128 + d0 * 32 + r32] = f2bf(o[d0][r] * rli[r]); }
    asm volatile("s_waitcnt lgkmcnt(0)" ::: "memory");
    if (MODE != 1) {
        const int ch = lane & 15, c = h * VH + ch * 8;
        const f32x4 w0a = *(const f32x4*)(T.conv_w + c), w0b = *(const f32x4*)(T.conv_w + c + 4), w1a = *(const f32x4*)(T.conv_w + DM + c), w1b = *(const f32x4*)(T.conv_w + DM + c + 4),
              w2a = *(const f32x4*)(T.conv_w + 2 * DM + c), w2b = *(const f32x4*)(T.conv_w + 2 * DM + c + 4);
        const float cw0[8] = {w0a[0], w0a[1], w0a[2], w0a[3], w0b[0], w0b[1], w0b[2], w0b[3]}, cw1[8] = {w1a[0], w1a[1], w1a[2], w1a[3], w1b[0], w1b[1], w1b[2], w1b[3]},
                    cw2[8] = {w2a[0], w2a[1], w2a[2], w2a[3], w2b[0], w2b[1], w2b[2], w2b[3]};
#pragma unroll 4
        for (int i = 0; i < 8; ++i) { const int row = i * 4 + (lane >> 4); const int tt = qb * 256 + wid * QBLK + row; const size_t e = (size_t)(b * SEQ + tt) * DM + c;
            const u32x4 ov = *(const LAS u32x4*)(stg + row * 128 + ch * 8);
            const u32x4 u0 = *(const u32x4*)(T.u + e), gbv = *(const u32x4*)(T.gb + e), sgv = *(const u32x4*)(T.sg + e);
            u32x4 u1 = {0u, 0u, 0u, 0u}, u2 = {0u, 0u, 0u, 0u};
            if (tt >= 1) u1 = *(const u32x4*)(T.u + e - DM);
            if (tt >= 2) u2 = *(const u32x4*)(T.u + e - 2 * DM);
            u32x4 res;
#pragma unroll
            for (int q = 0; q < 4; ++q) {
                const float cl = cw0[2 * q] * bflo(u2[q]) + cw1[2 * q] * bflo(u1[q]) + cw2[2 * q] * bflo(u0[q]), chh = cw0[2 * q + 1] * bfhi(u2[q]) + cw1[2 * q + 1] * bfhi(u1[q]) + cw2[2 * q + 1] * bfhi(u0[q]);
                res[q] = cvt_pk_bf16(bflo(gbv[q]) * cl + bflo(sgv[q]) * bflo(ov[q]), bfhi(gbv[q]) * chh + bfhi(sgv[q]) * bfhi(ov[q])); }
            *(u32x4*)(T.merged + e) = res; }
    }
    asm volatile("s_waitcnt lgkmcnt(0)" ::: "memory");
    __syncthreads();
#undef SLOAD
#undef SWRITE
#undef RESC
}
#undef SBAR
}
struct Frame {
    LAS unsigned char* lds; volatile LAS unsigned* MISC; unsigned* ctl;
    int tid, lane, wave, vcu, G;
};
__device__ __forceinline__ float wave_sum(float v) {
#pragma unroll
    for (int o = 1; o < 64; o <<= 1) v += __shfl_xor(v, o);
    return v;
}
__device__ __forceinline__ int tcq(int q, int ch64) { return ((q >> 1) << 7) | (((ch64 >> 4) & 3) << 5) | ((q & 1) << 4) | (((ch64 >> 2) & 3) << 2) | (ch64 & 3); }
struct MapIn { __device__ __forceinline__ int operator()(int c) const {
    if (c < C_ZB) return 256 * (c >> 6) + tcq(0, c & 63);
    if (c < C_ZC) { const int ch = c - C_ZB; return 256 * (ch >> 6) + tcq(2, ch & 63); }
    if (c < C_QL) { const int ch = c - C_ZC; return 256 * (ch >> 6) + tcq(1, ch & 63); }
    if (c < C_KVL) { const int j = c - C_QL; return j < 256 ? 256 * 20 + permL(j) : 256 * 21 + permL(j - 256); }
    if (c < C_KR) return 256 * 22 + permL(c - C_KVL);
    if (c < C_GC) { const int j = c - C_KR, jj = j & 31; return 256 * 21 + 128 + ((jj >> 4) << 5) + ((j >> 5) << 4) + (((jj >> 2) & 3) << 2) + (jj & 3); }
    if (c < C_GM) { const int ch = c - C_GC; return 256 * (ch >> 6) + tcq(3, ch & 63); }
    { const int j = c - C_GM; return 256 * (16 + (j >> 8)) + permL(j & 255); } } };
struct MapPerm { __device__ __forceinline__ int operator()(int c) const { return (c & ~255) | permL(c & 255); } };
struct MapId { __device__ __forceinline__ int operator()(int c) const { return c; } };
struct MapGU { int n; __device__ __forceinline__ int operator()(int f) const { const int r = f & 127; return 256 * (f >> 7) + ((((r >> 2) & 1) << 7) | ((r >> 5) << 5) | (n << 4) | (((r >> 3) & 3) << 2) | (r & 3)); } };

template <class RowMap>
__device__ __forceinline__ void transpose_item(const float* W, int N, bf16_t* WT, int ldt, const float* kscale, LAS float* scr, int item, int lane, const RowMap& rm) {
    const int nblk = N / 32, kb = item / nblk, nb = item % nblk, k0 = 64 * kb, n0 = 32 * nb;
#pragma unroll 8
    for (int i = 0; i < 32; ++i) { const int kk = 2 * i + (lane >> 5); const float sc = kscale ? kscale[k0 + kk] : 1.f; scr[kk * 33 + (lane & 31)] = W[(size_t)(k0 + kk) * N + n0 + (lane & 31)] * sc; }
    asm volatile("s_waitcnt lgkmcnt(0)" ::: "memory");
    const int c = lane & 7;
#pragma unroll
    for (int j = 0; j < 4; ++j) { const int n = (lane >> 3) + 8 * j; const LAS float* s = scr + (8 * c) * 33 + n;
        u32x4 o; o.x = cvt_pk_bf16(s[0 * 33], s[1 * 33]); o.y = cvt_pk_bf16(s[2 * 33], s[3 * 33]); o.z = cvt_pk_bf16(s[4 * 33], s[5 * 33]); o.w = cvt_pk_bf16(s[6 * 33], s[7 * 33]);
        *(u32x4*)(WT + (size_t)rm(n0 + n) * ldt + k0 + 8 * c) = o; }
    asm volatile("s_waitcnt lgkmcnt(0)" ::: "memory");
}
constexpr size_t WS_WIN = WS_WSMALL, WS_WQ = WS_WIN + (size_t)5888 * 1024 * 2, WS_WKV = WS_WQ + (size_t)1536 * 384 * 2, WS_WO = WS_WKV + (size_t)2048 * 256 * 2;
static_assert(WS_WO + (size_t)1024 * 1024 * 2 <= WS_A, "small weights fit below region A");
constexpr size_t WS_EGU = WS_C, WS_EDN = WS_C + (size_t)NEXP * 512 * 1024 * 2;
static_assert(WS_EDN + (size_t)NEXP * 1024 * 256 * 2 <= WS_D, "expert weights fit region C");

__device__ __forceinline__ void p0_prologue(const Ptrs& P, Frame& F) {
    LAS float* scr = (LAS float*)(F.lds + RING_OFF + F.wave * 16384);
    const int gw = F.vcu * NWAVES + F.wave, NGW = F.G * NWAVES;
    constexpr int I_IN = (DM / 64) * (DIN / 32), I_Q = (QL / 64) * (1536 / 32), I_KV = (KVL / 64) * (2048 / 32), I_O = (DM / 64) * (DM / 32);
    for (int it = gw; it < I_IN + I_Q + I_KV + I_O; it += NGW) {
        int r = it;
        if (r < I_IN) { transpose_item(P.w_in, DIN, (bf16_t*)(P.ws + WS_WIN), DM, (const float*)nullptr, scr, r, F.lane, MapIn{}); continue; } r -= I_IN;
        if (r < I_Q) { transpose_item(P.w_q_b, 1536, (bf16_t*)(P.ws + WS_WQ), QL, P.q_a_g, scr, r, F.lane, MapPerm{}); continue; } r -= I_Q;
        if (r < I_KV) { transpose_item(P.w_kv_b, 2048, (bf16_t*)(P.ws + WS_WKV), KVL, P.kv_a_g, scr, r, F.lane, MapPerm{}); continue; } r -= I_KV;
        transpose_item(P.w_o, DM, (bf16_t*)(P.ws + WS_WO), DM, (const float*)nullptr, scr, r, F.lane, MapPerm{});
    }
    {
        const int gt = F.vcu * 512 + F.tid;
        if (gt < 64 * 128) { const int rr = 192 + (gt >> 7), ch = gt & 127; *(u32x4*)((bf16_t*)(P.ws + WS_WIN) + (size_t)(256 * 21 + rr) * DM + ch * 8) = (u32x4){0u, 0u, 0u, 0u}; } }
    {
        float2* cs = (float2*)(P.ws + WS_CS);
        for (int idx = F.vcu * 512 + F.tid; idx < M * 32; idx += F.G * 512) { const int m = idx >> 5, i = idx & 31;
            const double inv = exp2(-(double)(2 * i) * (13.287712379549449 / 64.0));
            const double ang = (double)P.pos[m] * inv; float2 v; v.x = (float)cos(ang); v.y = (float)sin(ang); cs[idx] = v; } }
    __syncthreads();
    if (F.vcu < 192) {
        LAS float* cact = (LAS float*)(F.lds + RING_OFF); LAS float* red = (LAS float*)(F.lds + RING_OFF + 65536);
        for (int idx = F.tid; idx < BATCH * DM; idx += 512) { const float cv = P.c[idx]; cact[idx] = cv / (1.f + __expf(-cv)); }
        __syncthreads();
        const int n0 = 32 * F.vcu, kl = F.lane >> 3, c4 = F.lane & 7;
        f32x4 acc[16];
#pragma unroll
        for (int b = 0; b < 16; ++b) acc[b] = (f32x4){0.f, 0.f, 0.f, 0.f};
        for (int it = 0; it < 16; ++it) { const int k = 128 * F.wave + 8 * it + kl;
            const f32x4 wv = *(const f32x4*)(P.w_ada + (size_t)k * 6144 + n0 + 4 * c4);
#pragma unroll
            for (int b = 0; b < 16; ++b) acc[b] += cact[b * DM + k] * wv; }
#pragma unroll
        for (int b = 0; b < 16; ++b)
#pragma unroll
            for (int e = 0; e < 4; ++e) { float v = acc[b][e]; v += __shfl_xor(v, 8); v += __shfl_xor(v, 16); v += __shfl_xor(v, 32); if (kl == 0) red[(F.wave * 16 + b) * 32 + 4 * c4 + e] = v; }
        __syncthreads();
        { const int b = F.tid >> 5, cc = F.tid & 31; float s = P.b_ada[n0 + cc];
#pragma unroll
          for (int w = 0; w < 8; ++w) s += red[(w * 16 + b) * 32 + cc];
          ((float*)(P.ws + WS_MOD))[b * 6144 + n0 + cc] = s; }
        __syncthreads();
    }
}
__device__ __forceinline__ void expert_weight_items(const Ptrs& P, Frame& F, int w, int nw, int k_lo, int k_hi) {
    LAS float* scr = (LAS float*)(F.lds + RING_OFF + F.wave * 16384);
    constexpr int I_G = (DM / 64) * (DEXP / 32), I_D = (DEXP / 64) * (DM / 32);
    for (int k = k_lo; k < k_hi; ++k) { const int it = w + k * nw; if (it >= NEXP * (2 * I_G + I_D)) break;
        const int e = it / (2 * I_G + I_D); int r = it % (2 * I_G + I_D);
        bf16_t* gu = (bf16_t*)(P.ws + WS_EGU) + (size_t)e * 512 * DM; bf16_t* dn = (bf16_t*)(P.ws + WS_EDN) + (size_t)e * DM * DEXP;
        if (r < I_G) { transpose_item(P.w_gate + (size_t)e * DM * DEXP, DEXP, gu, DM, (const float*)nullptr, scr, r, F.lane, MapGU{0}); continue; } r -= I_G;
        if (r < I_G) { transpose_item(P.w_up + (size_t)e * DM * DEXP, DEXP, gu, DM, (const float*)nullptr, scr, r, F.lane, MapGU{1}); continue; } r -= I_G;
        transpose_item(P.w_down + (size_t)e * DEXP * DM, DM, dn, DEXP, (const float*)nullptr, scr, r, F.lane, MapPerm{});
    }
}
__device__ __forceinline__ void p1_norm1(const Ptrs& P, Frame& F) {
    const int gw = F.vcu * NWAVES + F.wave, NGW = F.G * NWAVES;
    bf16_t* h = (bf16_t*)(P.ws + WS_A);
    for (int m = gw; m < M; m += NGW) {
        const float* mod = (const float*)(P.ws + WS_MOD) + (m / SEQ) * 6144;
        const f32x4* xr = (const f32x4*)(P.x + (size_t)m * DM) + F.lane;
        f32x4 v[4]; float s = 0.f;
#pragma unroll
        for (int j = 0; j < 4; ++j) { v[j] = xr[64 * j]; s += (v[j][0] * v[j][0] + v[j][1] * v[j][1]) + (v[j][2] * v[j][2] + v[j][3] * v[j][3]); }
        const float rstd = 1.f / sqrtf(wave_sum(s) * (1.f / DM) + EPS);
        unsigned long long* o8 = (unsigned long long*)(h + (size_t)m * DM) + F.lane;
#pragma unroll
        for (int j = 0; j < 4; ++j) { const int d = 4 * F.lane + 256 * j;
            const f32x4 g = *(const f32x4*)(P.norm1_g + d), sc = *(const f32x4*)(mod + 1024 + d), sh = *(const f32x4*)(mod + d);
            const f32x4 r = v[j] * rstd * g * (sc + 1.f) + sh;
            o8[64 * j] = (unsigned long long)cvt_pk_bf16(r[0], r[1]) | ((unsigned long long)cvt_pk_bf16(r[2], r[3]) << 32); }
    }
}

constexpr size_t WS_WR = 30 * MiB;
constexpr size_t WS_STOK = WS_RT + 512 * 1024, WS_SW = WS_STOK + 320 * 1024;
constexpr int MAXROWS = 81920, MAXTILES = 320;
constexpr size_t WS_H2 = WS_B, WS_HACT = WS_B + 64 * MiB;
constexpr size_t WS_DELTA = WS_D, WS_Y0 = WS_A, WS_Y1 = WS_D + 64 * MiB;
constexpr int CW_T = CW_TILES, CW_T0 = CW_TILES + 1, CW_TGRP = CW_TILES + 64;

__device__ __forceinline__ void p0_router_weights(const Ptrs& P, Frame& F) {
    bf16_t* hi = (bf16_t*)(P.ws + WS_WR); bf16_t* lo = hi + 48 * DM;
    for (int idx = F.vcu * 512 + F.tid; idx < 48 * DM; idx += F.G * 512) { const int o = idx >> 10, k = idx & 1023;
        const float v = o < 4 ? P.w_rg[k * 4 + o] : (o < 36 ? P.w_re[k * 32 + o - 4] : 0.f);
        const bf16_t h = f2bf(v); hi[idx] = h; lo[idx] = f2bf(v - bf2f(h)); }
}
template <int MODE> __device__ __forceinline__ void p6_rows(const Ptrs& P, Frame& F) {
    LAS unsigned char* tile = F.lds + RING_OFF + F.wave * 8192;
    LAS float* lg = (LAS float*)(F.lds + RING_OFF + 65536 + F.wave * 1536);
    LAS unsigned char* wch = F.lds + RING_OFF + 77824;
    LAS float* gms = (LAS float*)(F.lds + XCH_OFF);
    LAS unsigned* hist = (LAS unsigned*)(F.lds + LDSCTL_OFF + 1024);
    const bf16_t* WrHi = (const bf16_t*)(P.ws + WS_WR); const bf16_t* WrLo = WrHi + 48 * DM;
    bf16_t* h2 = (bf16_t*)(P.ws + WS_H2); const bf16_t* dl = (const bf16_t*)(P.ws + WS_DELTA);
    int2* rte = (int2*)(P.ws + WS_RT); float2* rtw = (float2*)(P.ws + WS_RT + 256 * 1024);
    const int t = F.lane & 15, q = F.lane >> 4;
    for (int rb = F.vcu; rb < M / 128; rb += F.G) {
        const int m0 = rb * 128 + F.wave * 16, b = m0 / SEQ;
        const float* mod = (const float*)(P.ws + WS_MOD) + b * 6144;
        __syncthreads();
        if (F.tid < 64) hist[F.tid] = 0u;
        for (int k = F.tid; k < DM; k += 512) { gms[k] = P.norm2_g[k] * (1.f + mod[4096 + k]); gms[DM + k] = mod[3072 + k]; }
        __syncthreads();
#pragma unroll 1
        for (int hb = 0; hb < 2; ++hb) {
            const int mb = m0 + 8 * hb;
            f32x4 xv[8][4]; float rstd[8];
#pragma unroll
            for (int r = 0; r < 8; ++r) { const f32x4* xr = (const f32x4*)(P.x + (size_t)(mb + r) * DM) + F.lane; const u32x2* dr = (const u32x2*)(dl + (size_t)(mb + r) * DM) + F.lane;
#pragma unroll
                for (int c = 0; c < 4; ++c) { const f32x4 x4 = xr[64 * c]; const u32x2 d = dr[64 * c];
                    xv[r][c][0] = x4[0] + __uint_as_float(d.x << 16); xv[r][c][1] = x4[1] + __uint_as_float(d.x & 0xffff0000u); xv[r][c][2] = x4[2] + __uint_as_float(d.y << 16); xv[r][c][3] = x4[3] + __uint_as_float(d.y & 0xffff0000u); } }
#pragma unroll
            for (int r = 0; r < 8; ++r) { float s = 0.f;
#pragma unroll
                for (int c = 0; c < 4; ++c) s += (xv[r][c][0] * xv[r][c][0] + xv[r][c][1] * xv[r][c][1]) + (xv[r][c][2] * xv[r][c][2] + xv[r][c][3] * xv[r][c][3]);
                rstd[r] = 1.f / sqrtf(wave_sum(s) * (1.f / DM) + EPS); }
            f32x4 acc[3];
#pragma unroll
            for (int cb = 0; cb < 3; ++cb) acc[cb] = (f32x4){0.f, 0.f, 0.f, 0.f};
#pragma unroll
            for (int c = 0; c < 4; ++c) {
                const int k0 = 256 * c + 4 * F.lane;
                __syncthreads();
#pragma unroll
                for (int j = 0; j < 6; ++j) { const int id = F.tid + 512 * j, arr = id / 1536, rem = id - arr * 1536, row = rem >> 5, ch = rem & 31;
                    *(LAS u32x4*)(wch + arr * 24576 + row * 512 + ((ch ^ (row & 15)) << 4)) = *(const u32x4*)((arr ? WrLo : WrHi) + (size_t)row * DM + 256 * c + 8 * ch); }
                const f32x4 gm = *(const LAS f32x4*)(gms + k0), sh = *(const LAS f32x4*)(gms + DM + k0);
#pragma unroll
                for (int r = 0; r < 8; ++r) { const f32x4 h = xv[r][c] * rstd[r] * gm + sh;
                    u32x2 hi; hi.x = cvt_pk_bf16(h[0], h[1]); hi.y = cvt_pk_bf16(h[2], h[3]);
                    u32x2 lo; lo.x = cvt_pk_bf16(h[0] - __uint_as_float(hi.x << 16), h[1] - __uint_as_float(hi.x & 0xffff0000u)); lo.y = cvt_pk_bf16(h[2] - __uint_as_float(hi.y << 16), h[3] - __uint_as_float(hi.y & 0xffff0000u));
                    *(u32x2*)(h2 + (size_t)(mb + r) * DM + k0) = hi;
                    const int off = r * 512 + ((((F.lane >> 1) ^ r) & 31) << 4) + ((F.lane & 1) << 3);
                    *(LAS u32x2*)(tile + off) = hi; *(LAS u32x2*)(tile + 4096 + off) = lo; }
                asm volatile("s_waitcnt vmcnt(0) lgkmcnt(0)" ::: "memory");
                __syncthreads();
#pragma unroll 2
                for (int ks = 0; ks < (MODE == 1 ? 0 : 8); ++ks) { const int tr = t & 7;
                    const int off = tr * 512 + ((((4 * ks + q) ^ tr) & 31) << 4);
                    const bf16x8 bh = *(const LAS bf16x8*)(tile + off), bl = *(const LAS bf16x8*)(tile + 4096 + off);
#pragma unroll
                    for (int cb = 0; cb < 3; ++cb) { const int woff = (16 * cb + t) * 512 + ((((4 * ks + q) ^ t) & 31) << 4);
                        const bf16x8 wh = *(const LAS bf16x8*)(wch + woff), wl = *(const LAS bf16x8*)(wch + 24576 + woff);
                        acc[cb] = __builtin_amdgcn_mfma_f32_16x16x32_bf16(wh, bh, acc[cb], 0, 0, 0);
                        acc[cb] = __builtin_amdgcn_mfma_f32_16x16x32_bf16(wh, bl, acc[cb], 0, 0, 0);
                        acc[cb] = __builtin_amdgcn_mfma_f32_16x16x32_bf16(wl, bh, acc[cb], 0, 0, 0); } }
                asm volatile("s_waitcnt lgkmcnt(0)" ::: "memory");
            }
            if (t < 8) {
#pragma unroll
                for (int cb = 0; cb < 3; ++cb)
#pragma unroll
                    for (int r = 0; r < 4; ++r) lg[t * 48 + 16 * cb + 4 * q + r] = acc[cb][r]; }
            asm volatile("s_waitcnt lgkmcnt(0)" ::: "memory");
            if (MODE != 1 && q == 0 && t < 8) {
                const int m = mb + t;
                const LAS float* l = lg + t * 48;
                float gl[4];
#pragma unroll
                for (int i = 0; i < 4; ++i) gl[i] = l[i] + P.b_rg[i];
                int g = 0; float gmx = gl[0];
#pragma unroll
                for (int i = 1; i < 4; ++i) if (gl[i] > gmx) { gmx = gl[i]; g = i; }
                float se = 0.f;
#pragma unroll
                for (int i = 0; i < 4; ++i) se += __expf(gl[i] - gmx);
                const float pg = 1.f / se;
                float e0v = -3.0e38f, e1v = -3.0e38f; int i0 = 0, i1 = 0;
#pragma unroll
                for (int i = 0; i < 8; ++i) { const float v = l[4 + g * 8 + i] + P.b_re[g * 8 + i];
                    if (v > e0v) { e1v = e0v; i1 = i0; e0v = v; i0 = i; } else if (v > e1v) { e1v = v; i1 = i; } }
                const float p1 = __expf(e1v - e0v), w0 = 1.f / (1.f + p1), w1 = p1 * w0;
                int2 e; e.x = g * 8 + i0; e.y = g * 8 + i1; float2 w; w.x = w0 * pg; w.y = w1 * pg;
                rte[m] = e; rtw[m] = w;
                __hip_atomic_fetch_add(&hist[e.x], 1u, __ATOMIC_RELAXED, __HIP_MEMORY_SCOPE_WORKGROUP); __hip_atomic_fetch_add(&hist[32 + e.y], 1u, __ATOMIC_RELAXED, __HIP_MEMORY_SCOPE_WORKGROUP);
            }
            asm volatile("s_waitcnt lgkmcnt(0)" ::: "memory");
        }
        __syncthreads();
        if (MODE != 1 && F.tid < 64) F.ctl[CW_HIST + rb * 64 + F.tid] = hist[F.tid];
    }
    __syncthreads();
}
__device__ __forceinline__ void p7_sort(const Ptrs& P, Frame& F) {
    LAS unsigned* tot = (LAS unsigned*)(F.lds + RING_OFF);
    LAS unsigned* pre = tot + 64;
    LAS unsigned* rbase = pre + 64;
    LAS unsigned* cnt = rbase + 64;
    LAS unsigned* misc = cnt + 64;
    int* stok = (int*)(P.ws + WS_STOK); float* sw = (float*)(P.ws + WS_SW);
    const int2* rte = (const int2*)(P.ws + WS_RT); const float2* rtw = (const float2*)(P.ws + WS_RT + 256 * 1024);
    const int cw = F.vcu * 7 + F.wave - 1, cnw = F.G * 7; bool first = true;
    for (int rb = F.vcu; rb < M / 128; rb += F.G) {
        __syncthreads();
        if (first && F.wave > 0) expert_weight_items(P, F, cw, cnw, 0, 2);
        if (F.tid < 64) { unsigned s = 0u, p = 0u;
            for (int r2 = 0; r2 < M / 128; ++r2) { const unsigned v = F.ctl[CW_HIST + r2 * 64 + F.tid]; if (r2 == rb) p = s; s += v; }
            tot[F.tid] = s; pre[F.tid] = p; cnt[F.tid] = 0u; }
        __syncthreads();
        if (first && F.wave > 0) expert_weight_items(P, F, cw, cnw, 2, 4);
        if (F.tid == 0) { unsigned tb = 0u;
            for (int g = 0; g < 64; ++g) { if (g == 32) misc[1] = tb; rbase[g] = tb * 256u; const unsigned nt = (tot[g] + 255u) >> 8;
                if (rb == 0) for (unsigned k = 0; k < nt; ++k) F.ctl[CW_TGRP + tb + k] = (unsigned)g;
                tb += nt; }
            misc[0] = tb; if (rb == 0) { F.ctl[CW_T] = tb; F.ctl[CW_T0] = misc[1]; } }
        __syncthreads();
        if (F.wave == 0) {
            const unsigned long long ltmask = (1ull << F.lane) - 1ull;
            for (int ch = 0; ch < 2; ++ch) { const int m = rb * 128 + ch * 64 + F.lane; const int2 e = rte[m]; const float2 w = rtw[m];
                for (int j = 0; j < 2; ++j) { const int ex = j ? e.y : e.x; const float wj = j ? w.y : w.x; unsigned rank = 0u, gsz = 0u;
                    for (int x = 0; x < 32; ++x) { const unsigned long long mk = __ballot(ex == x); if (ex == x) { rank = (unsigned)__popcll(mk & ltmask); gsz = (unsigned)__popcll(mk); } }
                    const int g = j * 32 + ex; const unsigned pos = rbase[g] + pre[g] + cnt[g] + rank;
                    stok[pos] = m; sw[pos] = wj;
                    asm volatile("s_waitcnt lgkmcnt(0)" ::: "memory");
                    if (rank == 0u) cnt[g] += gsz;
                    asm volatile("s_waitcnt lgkmcnt(0)" ::: "memory"); } } }
        if (rb < 64) { const unsigned n = tot[rb], padn = (((n + 255u) >> 8) << 8) - n;
            if ((unsigned)F.tid < padn) { stok[rbase[rb] + n + F.tid] = -1; sw[rbase[rb] + n + F.tid] = 0.f; } }
        if (first && F.wave > 0) expert_weight_items(P, F, cw, cnw, 4, 1 << 20);
        first = false;
    }
}
struct MoeSched {
    const bf16_t* A; const bf16_t* W; int lda, ldb; const int* stok; const unsigned* tgrp; int t_lo, nun, npn, G, c; size_t wstride; bool gather;
    __device__ bool next(int i, Unit& u) const { const int U = i * G + c; if (U >= nun) return false; u.aux = t_lo + U / npn; u.pn = U % npn; u.pm = (int)tgrp[u.aux]; return true; }
    __device__ __forceinline__ const char* abase(const Unit& u) const { return gather ? (const char*)A : (const char*)A + (size_t)u.aux * BM * lda * 2; }
    __device__ __forceinline__ const char* bbase(const Unit& u) const { return (const char*)W + (size_t)(u.pm & 31) * wstride + (size_t)u.pn * BM * ldb * 2; }
    __device__ __forceinline__ void avoff(const Unit& u, int R0, int C0, int R1, int C1, unsigned (&v0)[2], unsigned (&v1)[2]) const {
        if (gather) { const int* tk = stok + u.aux * BM; int a = tk[R0], b = tk[R1], c2 = tk[HALF + R0], d = tk[HALF + R1];
            a = a < 0 ? 0 : a; b = b < 0 ? 0 : b; c2 = c2 < 0 ? 0 : c2; d = d < 0 ? 0 : d;
            v0[0] = (unsigned)(a * lda + C0) * 2u; v0[1] = (unsigned)(b * lda + C1) * 2u; v1[0] = (unsigned)(c2 * lda + C0) * 2u; v1[1] = (unsigned)(d * lda + C1) * 2u; }
        else { v0[0] = (unsigned)(R0 * lda + C0) * 2u; v0[1] = (unsigned)(R1 * lda + C1) * 2u; v1[0] = v0[0] + (unsigned)(HALF * lda * 2); v1[1] = v0[1] + (unsigned)(HALF * lda * 2); } }
};
struct EpiGU {
    bf16_t* hact; const float* sw;
    __device__ __forceinline__ void operator()(const f32x4 (&acc)[2][2][4][2], const Unit& un, int wr, int wc, int fr, int fq) const {
        asm volatile("" : "+v"(fr), "+v"(fq));
        const int r0 = un.aux * BM + wr * 64 + fr, c0 = 128 * un.pn + 32 * wc + 8 * fq;
#pragma unroll
        for (int ai = 0; ai < 2; ++ai)
#pragma unroll
            for (int m = 0; m < 4; ++m) { const int row = r0 + ai * HALF + m * 16; const float w = sw[row];
                f32x4 a, b;
#pragma unroll
                for (int i = 0; i < 4; ++i) { const float g0 = acc[ai][0][m][0][i], g1 = acc[ai][1][m][0][i];
                    a[i] = g0 * fsigmoid(g0) * acc[ai][0][m][1][i] * w; b[i] = g1 * fsigmoid(g1) * acc[ai][1][m][1][i] * w; }
                *(u32x4*)(hact + (size_t)row * DEXP + c0) = pack8(a, b); }
    }
};
struct EpiDown {
    bf16_t* y0; bf16_t* y1; const int* stok;
    __device__ __forceinline__ void operator()(const f32x4 (&acc)[2][2][4][2], const Unit& un, int wr, int wc, int fr, int fq) const {
        asm volatile("" : "+v"(fr), "+v"(fq));
        const int r0 = un.aux * BM + wr * 64 + fr, c0 = 256 * un.pn + 32 * wc + 8 * fq;
        bf16_t* y = (un.pm >> 5) ? y1 : y0;
#pragma unroll
        for (int ai = 0; ai < 2; ++ai)
#pragma unroll
            for (int m = 0; m < 4; ++m) { const int tok = stok[r0 + ai * HALF + m * 16];
                if (tok >= 0) { bf16_t* orow = y + (size_t)tok * DM + c0;
                    *(u32x4*)(orow) = pack8(acc[ai][0][m][0], acc[ai][0][m][1]); *(u32x4*)(orow + HALF) = pack8(acc[ai][1][m][0], acc[ai][1][m][1]); } }
    }
};
__device__ __forceinline__ void p10_combine(const Ptrs& P, Frame& F) {
    const int gw = F.vcu * NWAVES + F.wave, NGW = F.G * NWAVES;
    const bf16_t* dl = (const bf16_t*)(P.ws + WS_DELTA); const bf16_t* y0 = (const bf16_t*)(P.ws + WS_Y0); const bf16_t* y1 = (const bf16_t*)(P.ws + WS_Y1);
    for (int m = gw; m < M; m += NGW) {
        const float* gate = (const float*)(P.ws + WS_MOD) + (m / SEQ) * 6144 + 5120;
        const f32x4* xr = (const f32x4*)(P.x + (size_t)m * DM) + F.lane; f32x4* orow = (f32x4*)(P.out + (size_t)m * DM) + F.lane;
        const u32x2* dr = (const u32x2*)(dl + (size_t)m * DM) + F.lane; const u32x2* a0 = (const u32x2*)(y0 + (size_t)m * DM) + F.lane; const u32x2* a1 = (const u32x2*)(y1 + (size_t)m * DM) + F.lane;
#pragma unroll
        for (int j = 0; j < 4; ++j) { const f32x4 xv = xr[64 * j]; const u32x2 d = dr[64 * j], p = a0[64 * j], q = a1[64 * j]; const f32x4 g = *(const f32x4*)(gate + 4 * F.lane + 256 * j);
            f32x4 o;
            o[0] = xv[0] + __uint_as_float(d.x << 16) + g[0] * (__uint_as_float(p.x << 16) + __uint_as_float(q.x << 16));
            o[1] = xv[1] + __uint_as_float(d.x & 0xffff0000u) + g[1] * (__uint_as_float(p.x & 0xffff0000u) + __uint_as_float(q.x & 0xffff0000u));
            o[2] = xv[2] + __uint_as_float(d.y << 16) + g[2] * (__uint_as_float(p.y << 16) + __uint_as_float(q.y << 16));
            o[3] = xv[3] + __uint_as_float(d.y & 0xffff0000u) + g[3] * (__uint_as_float(p.y & 0xffff0000u) + __uint_as_float(q.y & 0xffff0000u));
            orow[64 * j] = o; }
    }
}
struct Args { Ptrs P; int ph_lo, ph_hi, li, pad; };
constexpr int N_PHASES = 11;

typedef const __attribute__((address_space(4))) Args* KArgs;
__device__ __forceinline__ KArgs kargs() {
#if defined(__HIP_DEVICE_COMPILE__)
    unsigned off = 0u; asm volatile("" : "+s"(off));
    return (KArgs)((const __attribute__((address_space(4))) char*)__builtin_amdgcn_kernarg_segment_ptr() + off);
#else
    return nullptr;
#endif
}
__device__ __forceinline__ Ptrs load_ptrs() {
    Ptrs P{};
#if defined(__HIP_DEVICE_COMPILE__)
    const __attribute__((address_space(4))) unsigned long long* src = (const __attribute__((address_space(4))) unsigned long long*)kargs();
    unsigned long long w[sizeof(Ptrs) / 8];
#pragma unroll
    for (unsigned i = 0; i < sizeof(Ptrs) / 8; ++i) w[i] = src[i];
    __builtin_memcpy(&P, w, sizeof(Ptrs));
#endif
    return P;
}
#define WSPTRS \
    unsigned char* ws = P.ws; bf16_t* hA = (bf16_t*)(ws + WS_A); bf16_t* uB = (bf16_t*)(ws + WS_B); bf16_t* gbB = uB + (size_t)M * DM; bf16_t* sgB = gbB + (size_t)M * DM; \
    bf16_t* latC = (bf16_t*)(ws + WS_C); bf16_t* Kd = (bf16_t*)(ws + WS_D); bf16_t* Vd = (bf16_t*)(ws + WS_D + 96 * MiB); bf16_t* Qo = (bf16_t*)P.out; \
    float* ssp = (float*)(ws + WS_SSP); const float2* cs = (const float2*)(ws + WS_CS); const float* mod = (const float*)(ws + WS_MOD); \
    const int* stok = (const int*)(ws + WS_STOK); const float* sw = (const float*)(ws + WS_SW); bf16_t* h2 = (bf16_t*)(ws + WS_H2); bf16_t* hact = (bf16_t*)(ws + WS_HACT); \
    (void)hA; (void)uB; (void)gbB; (void)sgB; (void)latC; (void)Kd; (void)Vd; (void)Qo; (void)ssp; (void)cs; (void)mod; (void)stok; (void)sw; (void)h2; (void)hact;

__global__ void __launch_bounds__(NWAVES * 64, 2) fwd(Args args_unused) {
    extern __shared__ __attribute__((aligned(16))) unsigned char lds_raw[];
    Frame F;
    F.lds = (LAS unsigned char*)lds_raw;
    F.MISC = (volatile LAS unsigned*)(F.lds + MISC_OFF);
    F.tid = threadIdx.x; F.lane = F.tid & 63; F.wave = __builtin_amdgcn_readfirstlane(F.tid >> 6);
    F.G = gridDim.x; { const int bx = blockIdx.x; F.vcu = (F.G % 8 == 0) ? (bx % 8) * (F.G / 8) + bx / 8 : bx; }
    F.ctl = (unsigned*)(args_unused.P.ws + WS_CTL);
    for (int u = F.tid; u < (LDS_BYTES - LDSCTL_OFF) / 4; u += NWAVES * 64) ((LAS unsigned*)(F.lds + LDSCTL_OFF))[u] = 0u;
    __syncthreads();
    const int lo = args_unused.ph_lo, hi = args_unused.ph_hi;
    XcdBarrier bar; bar.bar = F.ctl + CW_BAR + args_unused.li * XCD_BAR_WORDS; bar.x = 0; bar.st = nullptr;
    if (hi - lo > 1) bar = xcd_barrier_post(F.ctl + CW_BAR + args_unused.li * XCD_BAR_WORDS, F.MISC + 8);
#ifdef ONLY_PHASE
#define IN(k) ((k) == ONLY_PHASE && lo <= (k) && (k) < hi)
#else
#define IN(k) (lo <= (k) && (k) < hi)
#endif
#ifndef PROBE_REPEAT
#define PROBE_REPEAT -1
#endif
#define REPS(k) for (int rep_ = 0; rep_ < ((k) == PROBE_REPEAT ? 2 : 1); ++rep_)
#define SEAM(k) do { if (IN(k) && IN((k) + 1)) xcd_barrier(bar); } while (0)

    if (IN(0)) { const Ptrs P = args_unused.P; REPS(0) { p0_router_weights(P, F); p0_prologue(P, F); } SEAM(0); }
    if (IN(1)) { const Ptrs P = args_unused.P; REPS(1) { p1_norm1(P, F); } SEAM(1); }
    if (IN(2)) {
        const Ptrs P = args_unused.P; WSPTRS
        DenseSched S; S.init(hA, DM, (const bf16_t*)(ws + WS_WIN), DM, M, 5888, F.G, (int)blockIdx.x);
        EpiIn E{uB, gbB, sgB, latC, ssp, cs, P.k_g, (LAS float*)(F.lds + XCH_OFF)};
        gemm_phase<false>(F.lds + RING_OFF, DM, S, E);
        if (PROBE_REPEAT == 2) gemm_phase<false>(F.lds + RING_OFF, DM, S, E);
        SEAM(2);
    }
    if (IN(3)) {
        const Ptrs P = args_unused.P; WSPTRS
        { DenseSched S; S.init(latC, LATW, (const bf16_t*)(ws + WS_WQ), QL, M, 1536, F.G, (int)blockIdx.x);
          EpiPlain E{Qo, 1536};
          gemm_phase<false>(F.lds + RING_OFF, QL, S, E);
          if (PROBE_REPEAT == 30) gemm_phase<false>(F.lds + RING_OFF, QL, S, E); }
        { DenseSched S; S.init(latC + 512, LATW, (const bf16_t*)(ws + WS_WKV), KVL, M, 2048, F.G, (int)blockIdx.x);
          EpiKV E{Kd, Vd, latC, ssp, P.k_g, (LAS float*)(F.lds + XCH_OFF)};
          gemm_phase<false>(F.lds + RING_OFF, KVL, S, E);
          if (PROBE_REPEAT == 31) gemm_phase<false>(F.lds + RING_OFF, KVL, S, E); }
        SEAM(3);
    }
    if (IN(4)) {
        const Ptrs P = args_unused.P; WSPTRS
        att::AttnArgs T{Qo, Kd, Vd, ssp, cs, P.q_g, uB, gbB, sgB, P.conv_w, hA};
        if (F.G == 256) {
            const int bh = F.vcu >> 1, sel = F.vcu & 1;
#pragma unroll 1
            for (int i = 0; i < 4; ++i) { const int qb = sel ? (i == 0 ? 6 : i == 1 ? 1 : i == 2 ? 5 : 2) : (i == 0 ? 7 : i == 1 ? 0 : i == 2 ? 4 : 3);
                att::attn_unit<0>(T, bh >> 3, bh & 7, qb, (LAS char*)(F.lds + RING_OFF)); }
            if (PROBE_REPEAT == 4 || PROBE_REPEAT == 41) {
#pragma unroll 1
                for (int i = 0; i < 4; ++i) { const int qb = sel ? (i == 0 ? 6 : i == 1 ? 1 : i == 2 ? 5 : 2) : (i == 0 ? 7 : i == 1 ? 0 : i == 2 ? 4 : 3);
                    att::attn_unit<(PROBE_REPEAT == 41 ? 1 : 0)>(T, bh >> 3, bh & 7, qb, (LAS char*)(F.lds + RING_OFF)); } }
        } else {
#pragma unroll 1
            for (int U = F.vcu; U < BATCH * NH * 8; U += F.G) { const int bh = U >> 3; att::attn_unit<0>(T, bh >> 3, bh & 7, U & 7, (LAS char*)(F.lds + RING_OFF)); }
        }
        SEAM(4);
    }
    if (IN(5)) {
        const Ptrs P = args_unused.P; WSPTRS
        DenseSched S; S.init(hA, DM, (const bf16_t*)(ws + WS_WO), DM, M, DM, F.G, (int)blockIdx.x);
        EpiDelta E{mod, (bf16_t*)(ws + WS_DELTA)};
        gemm_phase<false>(F.lds + RING_OFF, DM, S, E);
        if (PROBE_REPEAT == 5) gemm_phase<false>(F.lds + RING_OFF, DM, S, E);
        SEAM(5);
    }
    if (IN(6)) { const Ptrs P = args_unused.P; p6_rows<0>(P, F); if (PROBE_REPEAT == 6) p6_rows<0>(P, F); if (PROBE_REPEAT == 61) p6_rows<1>(P, F); SEAM(6); }
    if (IN(7)) { const Ptrs P = args_unused.P; p7_sort(P, F); if (PROBE_REPEAT == 7) p7_sort(P, F); SEAM(7); }
    if (IN(8)) {
        const Ptrs P = args_unused.P; WSPTRS
        const int T = __builtin_amdgcn_readfirstlane((int)F.ctl[CW_T]);
        MoeSched S{h2, (const bf16_t*)(ws + WS_EGU), DM, DM, stok, F.ctl + CW_TGRP, 0, T * 2, 2, F.G, F.vcu, (size_t)512 * DM * 2, true};
        EpiGU E{hact, sw};
        gemm_phase<true>(F.lds + RING_OFF, DM, S, E);
        if (PROBE_REPEAT == 8) gemm_phase<true>(F.lds + RING_OFF, DM, S, E);
        SEAM(8);
    }
    if (IN(9)) {
        const Ptrs P = args_unused.P; WSPTRS
        const int T = __builtin_amdgcn_readfirstlane((int)F.ctl[CW_T]);
        MoeSched S{hact, (const bf16_t*)(ws + WS_EDN), DEXP, DEXP, stok, F.ctl + CW_TGRP, 0, T * 4, 4, F.G, F.vcu, (size_t)DM * DEXP * 2, false};
        EpiDown E{(bf16_t*)(ws + WS_Y0), (bf16_t*)(ws + WS_Y1), stok};
        gemm_phase<false>(F.lds + RING_OFF, DEXP, S, E);
        if (PROBE_REPEAT == 9) gemm_phase<false>(F.lds + RING_OFF, DEXP, S, E);
        SEAM(9);
    }
    if (IN(10)) { const Ptrs P = args_unused.P; REPS(10) p10_combine(P, F); }
#undef IN
#undef SEAM
}
}
#ifndef NV2_WMASK
#define NV2_WMASK 15
#endif
#ifndef BOTH_MASK
#define BOTH_MASK 0
#endif
#ifndef FAST_MASK
#define FAST_MASK 0x7f
#endif
#ifndef ONE_LAUNCH
#define ONE_LAUNCH 1
#endif

static void naive_forward(const Ptrs& P, hipStream_t st, int from, int to) {
    unsigned char* ws = P.ws;
    float* scratch = (float*)(ws + WS_D);
    if (from <= 0 && 0 <= to) {
        hipLaunchKernelGGL(nv_mod, dim3(6144 / 256, BATCH), dim3(256), 0, st, P);
        hipLaunchKernelGGL(nv_rope_table, dim3(M * 32 / 256), dim3(256), 0, st, P);
    }
    if (from <= 1 && 1 <= to) hipLaunchKernelGGL(nv_norm1, dim3(M), dim3(256), 0, st, P);
    if (from <= 2 && 2 <= to) {
        for (int b = 0; b < BATCH; ++b) {
            hipLaunchKernelGGL(nv_gemm<bf16_t>, dim3(DIN / 64, SEQ / 64), dim3(256), 0, st, (const bf16_t*)(ws + WS_A) + (size_t)b * SEQ * DM, DM, P.w_in, DIN, (const float*)nullptr, scratch, DIN, DM);
            hipLaunchKernelGGL(nv_z_post, dim3(SEQ), dim3(256), 0, st, P, (const float*)scratch, b, NV2_WMASK);
        }
    }
    if (from <= 3 && 3 <= to) {
        float* s3 = (float*)(ws + WS_A);
        for (int b = 0; b < BATCH; ++b) {
            const bf16_t* latb = (const bf16_t*)(ws + WS_C) + (size_t)b * SEQ * LATW;
            hipLaunchKernelGGL(nv_gemm<bf16_t>, dim3(1536 / 64, SEQ / 64), dim3(256), 0, st, latb, LATW, P.w_q_b, 1536, P.q_a_g, s3, 1536, QL);
            hipLaunchKernelGGL(nv_q_post, dim3(SEQ * 1536 / 256), dim3(256), 0, st, P, (const float*)s3, b);
            float* s3b = s3 + (size_t)SEQ * 1536;
            hipLaunchKernelGGL(nv_gemm<bf16_t>, dim3(2048 / 64, SEQ / 64), dim3(256), 0, st, latb + 512, LATW, P.w_kv_b, 2048, P.kv_a_g, s3b, 2048, KVL);
            hipLaunchKernelGGL(nv_kv_post, dim3(SEQ, NH), dim3(64), 0, st, P, (const float*)s3b, b);
        }
    }
    if (from <= 4 && 4 <= to) hipLaunchKernelGGL(nv_attn, dim3(SEQ, NH, BATCH), dim3(64), 0, st, P);
    if (from <= 5 && 5 <= to) {
        float* s5 = (float*)(ws + WS_C);
        for (int b = 0; b < BATCH; ++b) {
            hipLaunchKernelGGL(nv_gemm<bf16_t>, dim3(DM / 64, SEQ / 64), dim3(256), 0, st, (const bf16_t*)(ws + WS_A) + (size_t)b * SEQ * DM, DM, P.w_o, DM, (const float*)nullptr, s5, DM, DM);
            hipLaunchKernelGGL(nv_resid, dim3(SEQ * DM / 256), dim3(256), 0, st, P, (const float*)s5, b);
        }
    }
    if (from <= 6 && 6 <= to) hipLaunchKernelGGL(nv_norm2_router, dim3(M), dim3(256), 0, st, P);
    if (from <= 7 && 7 <= to) hipLaunchKernelGGL(nv_moe, dim3(M), dim3(256), 0, st, P);
}

extern "C" void kernel_launch(void* const* d_in, const int* in_sizes, int n_in, void* d_out, int out_size, void* d_ws, size_t ws_size, hipStream_t stream) {
    if (n_in != 23 || out_size != M * DM || ws_size < WS_END) { fprintf(stderr, "kernel_launch: unexpected shapes (n_in %d out %d ws %zu)\n", n_in, out_size, ws_size); return; }
    static int grid = 0;
    if (grid == 0) {
        int dev = 0, cus = 0;
        if (hipGetDevice(&dev) != hipSuccess || hipDeviceGetAttribute(&cus, hipDeviceAttributeMultiprocessorCount, dev) != hipSuccess) { fprintf(stderr, "kernel_launch: device query failed\n"); grid = -1; return; }
        if (hipFuncSetAttribute((const void*)fk::fwd, hipFuncAttributeMaxDynamicSharedMemorySize, fk::LDS_BYTES) != hipSuccess) { fprintf(stderr, "kernel_launch: hipFuncSetAttribute failed\n"); grid = -1; return; }
        grid = cus;
    }
    if (grid < 0) return;
    Ptrs P{};
    P.x = (const float*)d_in[0]; P.c = (const float*)d_in[1]; P.pos = (const int*)d_in[2];
    P.w_ada = (const float*)d_in[3]; P.b_ada = (const float*)d_in[4]; P.norm1_g = (const float*)d_in[5]; P.w_in = (const float*)d_in[6]; P.conv_w = (const float*)d_in[7];
    P.q_a_g = (const float*)d_in[8]; P.w_q_b = (const float*)d_in[9]; P.kv_a_g = (const float*)d_in[10]; P.w_kv_b = (const float*)d_in[11]; P.q_g = (const float*)d_in[12]; P.k_g = (const float*)d_in[13];
    P.w_o = (const float*)d_in[14]; P.norm2_g = (const float*)d_in[15]; P.w_rg = (const float*)d_in[16]; P.b_rg = (const float*)d_in[17]; P.w_re = (const float*)d_in[18]; P.b_re = (const float*)d_in[19];
    P.w_gate = (const float*)d_in[20]; P.w_up = (const float*)d_in[21]; P.w_down = (const float*)d_in[22];
    P.out = (float*)d_out; P.ws = (unsigned char*)d_ws;
    (void)hipMemsetAsync((char*)d_ws + WS_CTL, 0, 1 * MiB, stream);
    fk::Args a{}; a.P = P;
    if (ONE_LAUNCH) { a.ph_lo = 0; a.ph_hi = fk::N_PHASES; a.li = 0; hipLaunchKernelGGL(fk::fwd, dim3(grid), dim3(fk::NWAVES * 64), fk::LDS_BYTES, stream, a); }
    else for (int s = 0; s <= 7; ++s) {
        if (s < 6 && ((FAST_MASK >> s) & 1)) { a.ph_lo = s; a.ph_hi = s + 1; a.li = 0; hipLaunchKernelGGL(fk::fwd, dim3(grid), dim3(fk::NWAVES * 64), fk::LDS_BYTES, stream, a); }
        else if (s >= 6 && ((FAST_MASK >> 6) & 1)) { if (s == 6) for (int ph = 6; ph < fk::N_PHASES; ++ph) { a.ph_lo = ph; a.ph_hi = ph + 1; a.li = 0; hipLaunchKernelGGL(fk::fwd, dim3(grid), dim3(fk::NWAVES * 64), fk::LDS_BYTES, stream, a); } }
        else naive_forward(P, stream, s, s);
        if ((BOTH_MASK >> s) & 1) naive_forward(P, stream, s, s);
    }
}
```

```cpp
#define PROBE_REPEAT -1
#include <hip/hip_runtime.h>
#include <cstdio>
#include <cstdint>
#include <cmath>

constexpr int BATCH = 16, SEQ = 2048, DM = 1024, M = BATCH * SEQ;
constexpr int NH = 8, QKN = 128, QKR = 64, QKH = 192, VH = 128, QL = 384, KVL = 256;
constexpr int DIN = 5824, NEXP = 32, DEXP = 256;
constexpr int C_ZX = 0, C_ZB = 1024, C_ZC = 2048, C_QL = 3072, C_KVL = 3456, C_KR = 3712, C_GC = 3776, C_GM = 4800;
constexpr float EPS = 1e-6f;
constexpr int LATW = 768;
constexpr int NSLOT = 16;

typedef unsigned short bf16_t;
typedef float f32x4 __attribute__((ext_vector_type(4)));

constexpr size_t MiB = 1u << 20;
constexpr size_t WS_CTL = 0;
constexpr size_t WS_MOD = 1 * MiB;
constexpr size_t WS_CS = 2 * MiB;
constexpr size_t WS_SSP = 10 * MiB;
constexpr size_t WS_RT = 12 * MiB;
constexpr size_t WS_WSMALL = 14 * MiB;
constexpr size_t WS_A = 32 * MiB;
constexpr size_t WS_B = 96 * MiB;
constexpr size_t WS_C = 288 * MiB;
constexpr size_t WS_D = 336 * MiB;
constexpr size_t WS_END = 496 * MiB;

__device__ __forceinline__ float bf2f(bf16_t v) { return __uint_as_float(((unsigned)v) << 16); }
__device__ __forceinline__ bf16_t f2bf(float f) { unsigned u = __float_as_uint(f); return (bf16_t)((u + 0x7fffu + ((u >> 16) & 1u)) >> 16); }
__device__ __forceinline__ float sigmoidf_(float x) { return 1.f / (1.f + __expf(-x)); }
__device__ __forceinline__ float ldf(const float* p) { return *p; }
__device__ __forceinline__ float ldf(const bf16_t* p) { return bf2f(*p); }

struct Ptrs {
    const float *x, *c; const int* pos;
    const float *w_ada, *b_ada, *norm1_g, *w_in, *conv_w, *q_a_g, *w_q_b, *kv_a_g, *w_kv_b, *q_g, *k_g, *w_o, *norm2_g;
    const float *w_rg, *b_rg, *w_re, *b_re, *w_gate, *w_up, *w_down;
    float* out; unsigned char* ws;
};

__global__ void __launch_bounds__(256) nv_mod(Ptrs P) {
    const int n = blockIdx.x * 256 + threadIdx.x, b = blockIdx.y;
    float acc = P.b_ada[n];
    for (int k = 0; k < DM; ++k) { const float cv = P.c[b * DM + k]; const float s = cv / (1.f + expf(-cv)); acc += s * P.w_ada[(size_t)k * 6144 + n]; }
    ((float*)(P.ws + WS_MOD))[b * 6144 + n] = acc;
}
__global__ void __launch_bounds__(256) nv_rope_table(Ptrs P) {
    const int idx = blockIdx.x * 256 + threadIdx.x;
    const int m = idx >> 5, i = idx & 31;
    const double inv = pow(10000.0, -(double)(2 * i) / 64.0);
    const double ang = (double)P.pos[m] * inv;
    float2 cs; cs.x = (float)cos(ang); cs.y = (float)sin(ang);
    ((float2*)(P.ws + WS_CS))[idx] = cs;
}
__device__ __forceinline__ float block_sum_256(float v, float* red) {
    for (int o = 32; o > 0; o >>= 1) v += __shfl_xor(v, o);
    if ((threadIdx.x & 63) == 0) red[threadIdx.x >> 6] = v;
    __syncthreads();
    const float r = red[0] + red[1] + red[2] + red[3];
    __syncthreads();
    return r;
}
__global__ void __launch_bounds__(256) nv_norm1(Ptrs P) {
    __shared__ float red[4];
    const int m = blockIdx.x, b = m / SEQ, t = threadIdx.x;
    const float* mod = (const float*)(P.ws + WS_MOD) + b * 6144;
    float v[4]; float ss = 0.f;
#pragma unroll
    for (int j = 0; j < 4; ++j) { v[j] = P.x[(size_t)m * DM + t + 256 * j]; ss += v[j] * v[j]; }
    ss = block_sum_256(ss, red);
    const float rstd = 1.f / sqrtf(ss / DM + EPS);
    bf16_t* h = (bf16_t*)(P.ws + WS_A);
#pragma unroll
    for (int j = 0; j < 4; ++j) { const int d = t + 256 * j; h[(size_t)m * DM + d] = f2bf(v[j] * rstd * P.norm1_g[d] * (1.f + mod[1024 + d]) + mod[d]); }
}
template <typename TA>
__global__ void __launch_bounds__(256) nv_gemm(const TA* A, int lda, const float* Bm, int ldb, const float* bscale, float* C, int ldc, int K) {
    __shared__ float As[16][65]; __shared__ float Bs[16][64];
    const int tx = threadIdx.x & 15, ty = threadIdx.x >> 4, m0 = blockIdx.y * 64, n0 = blockIdx.x * 64;
    float acc[4][4];
#pragma unroll
    for (int i = 0; i < 4; ++i)
#pragma unroll
        for (int j = 0; j < 4; ++j) acc[i][j] = 0.f;
    for (int k0 = 0; k0 < K; k0 += 16) {
#pragma unroll
        for (int q = 0; q < 4; ++q) { const int i = threadIdx.x + 256 * q; const int r = i >> 4, c = i & 15; As[c][r] = ldf(A + (size_t)(m0 + r) * lda + k0 + c); }
#pragma unroll
        for (int q = 0; q < 4; ++q) { const int i = threadIdx.x + 256 * q; const int r = i >> 6, c = i & 63; const float s = bscale ? bscale[k0 + r] : 1.f; Bs[r][c] = Bm[(size_t)(k0 + r) * ldb + n0 + c] * s; }
        __syncthreads();
#pragma unroll
        for (int k = 0; k < 16; ++k) {
            float a0 = As[k][ty * 4 + 0], a1 = As[k][ty * 4 + 1], a2 = As[k][ty * 4 + 2], a3 = As[k][ty * 4 + 3];
            float b0 = Bs[k][tx * 4 + 0], b1 = Bs[k][tx * 4 + 1], b2 = Bs[k][tx * 4 + 2], b3 = Bs[k][tx * 4 + 3];
            acc[0][0] += a0 * b0; acc[0][1] += a0 * b1; acc[0][2] += a0 * b2; acc[0][3] += a0 * b3;
            acc[1][0] += a1 * b0; acc[1][1] += a1 * b1; acc[1][2] += a1 * b2; acc[1][3] += a1 * b3;
            acc[2][0] += a2 * b0; acc[2][1] += a2 * b1; acc[2][2] += a2 * b2; acc[2][3] += a2 * b3;
            acc[3][0] += a3 * b0; acc[3][1] += a3 * b1; acc[3][2] += a3 * b2; acc[3][3] += a3 * b3;
        }
        __syncthreads();
    }
#pragma unroll
    for (int i = 0; i < 4; ++i)
#pragma unroll
        for (int j = 0; j < 4; ++j) C[(size_t)(m0 + ty * 4 + i) * ldc + n0 + tx * 4 + j] = acc[i][j];
}
__global__ void __launch_bounds__(256) nv_z_post(Ptrs P, const float* z, int b, int wmask) {
    const int s = blockIdx.x, m = b * SEQ + s, t = threadIdx.x;
    const float* zr = z + (size_t)s * DIN;
    bf16_t* u = (bf16_t*)(P.ws + WS_B); bf16_t* gb = u + (size_t)M * DM; bf16_t* sg = gb + (size_t)M * DM;
    bf16_t* lat = (bf16_t*)(P.ws + WS_C); float* ssp = (float*)(P.ws + WS_SSP);
#pragma unroll
    for (int j = 0; j < 4; ++j) { const int c = t + 256 * j;
        if (wmask & 1) { u[(size_t)m * DM + c] = f2bf(zr[C_ZX + c] * zr[C_ZC + c]);
        gb[(size_t)m * DM + c] = f2bf(zr[C_ZB + c] * sigmoidf_(zr[C_GC + c])); }
        if (wmask & 2) sg[(size_t)m * DM + c] = f2bf(sigmoidf_(zr[C_GM + c])); }
    if (wmask & 4) for (int c = t; c < LATW; c += 256) {
        float v = 0.f;
        if (c < 384) v = zr[C_QL + c]; else if (c < 448) v = zr[C_KR + c - 384]; else if (c >= 512) v = zr[C_KVL + c - 512];
        lat[(size_t)m * LATW + c] = f2bf(v); }
    if ((wmask & 8) && t < NSLOT) {
        float ss = 0.f;
        if (t == 0) for (int c = 0; c < QL; ++c) ss += zr[C_QL + c] * zr[C_QL + c];
        if (t == 8) for (int c = 0; c < KVL; ++c) ss += zr[C_KVL + c] * zr[C_KVL + c];
        if (t == 12) for (int c = 0; c < QKR; ++c) ss += zr[C_KR + c] * zr[C_KR + c];
        ssp[(size_t)t * M + m] = ss; }
}
__global__ void __launch_bounds__(256) nv_q_post(Ptrs P, const float* qraw, int b) {
    const size_t i = (size_t)blockIdx.x * 256 + threadIdx.x;
    ((bf16_t*)P.out)[(size_t)b * SEQ * 1536 + i] = f2bf(qraw[i]);
}
__global__ void __launch_bounds__(64) nv_kv_post(Ptrs P, const float* kvraw, int b) {
    const int s = blockIdx.x, h = blockIdx.y, m = b * SEQ + s, l = threadIdx.x;
    const float* ssp = (const float*)(P.ws + WS_SSP);
    const float sskv = ssp[(size_t)8 * M + m] + ssp[(size_t)9 * M + m] + ssp[(size_t)10 * M + m] + ssp[(size_t)11 * M + m];
    const float sskr = ssp[(size_t)12 * M + m] + ssp[(size_t)13 * M + m] + ssp[(size_t)14 * M + m] + ssp[(size_t)15 * M + m];
    const float rkv = 1.f / sqrtf(sskv / KVL + EPS);
    const float* r = kvraw + (size_t)s * 2048 + h * 256;
    const float kn0 = rkv * r[l], kn1 = rkv * r[l + 64], v0 = rkv * r[128 + l], v1 = rkv * r[192 + l];
    float ss = kn0 * kn0 + kn1 * kn1;
    for (int o = 32; o > 0; o >>= 1) ss += __shfl_xor(ss, o);
    const float rk = 1.f / sqrtf((ss + sskr) / QKH + EPS);
    bf16_t* Kp = (bf16_t*)(P.ws + WS_D) + ((size_t)(b * NH + h) * SEQ + s) * QKH;
    bf16_t* Vp = (bf16_t*)(P.ws + WS_D + 96 * MiB) + ((size_t)(b * NH + h) * SEQ + s) * VH;
    Kp[l] = f2bf(kn0 * rk * P.k_g[l]); Kp[l + 64] = f2bf(kn1 * rk * P.k_g[l + 64]);
    Vp[l] = f2bf(v0); Vp[l + 64] = f2bf(v1);
    if (l < 32) {
        const bf16_t* lat = (const bf16_t*)(P.ws + WS_C) + (size_t)m * LATW + 384;
        const float2 cs = ((const float2*)(P.ws + WS_CS))[(size_t)m * 32 + l];
        const float x1 = bf2f(lat[l]) * rk * P.k_g[128 + l], x2 = bf2f(lat[l + 32]) * rk * P.k_g[160 + l];
        Kp[128 + l] = f2bf(x1 * cs.x - x2 * cs.y); Kp[160 + l] = f2bf(x2 * cs.x + x1 * cs.y); }
}
__global__ void __launch_bounds__(64) nv_attn(Ptrs P) {
    __shared__ float sq[QKH]; __shared__ float sc[SEQ];
    const int t = blockIdx.x, h = blockIdx.y, b = blockIdx.z, m = b * SEQ + t, l = threadIdx.x;
    const float* ssp = (const float*)(P.ws + WS_SSP);
    float ssq = 0.f; for (int j = 0; j < 8; ++j) ssq += ssp[(size_t)j * M + m];
    const float rq = 1.f / sqrtf(ssq / QL + EPS);
    const bf16_t* qr = (const bf16_t*)P.out + (size_t)m * 1536 + h * QKH;
    const float q0 = rq * bf2f(qr[l]), q1 = rq * bf2f(qr[l + 64]), q2 = rq * bf2f(qr[l + 128]);
    float ss = q0 * q0 + q1 * q1 + q2 * q2;
    for (int o = 32; o > 0; o >>= 1) ss += __shfl_xor(ss, o);
    const float rn = 1.f / sqrtf(ss / QKH + EPS);
    sq[l] = q0 * rn * P.q_g[l]; sq[l + 64] = q1 * rn * P.q_g[l + 64]; sq[l + 128] = q2 * rn * P.q_g[l + 128];
    __syncthreads();
    if (l < 32) {
        const float2 cs = ((const float2*)(P.ws + WS_CS))[(size_t)m * 32 + l];
        const float x1 = sq[128 + l], x2 = sq[160 + l];
        sq[128 + l] = x1 * cs.x - x2 * cs.y; sq[160 + l] = x2 * cs.x + x1 * cs.y; }
    __syncthreads();
    const int kend = ((t >> 6) + 1) << 6;
    const bf16_t* Kb = (const bf16_t*)(P.ws + WS_D) + (size_t)(b * NH + h) * SEQ * QKH;
    const bf16_t* Vb = (const bf16_t*)(P.ws + WS_D + 96 * MiB) + (size_t)(b * NH + h) * SEQ * VH;
    const float scale = 0.07216878364870322f;
    float mx = -1e30f;
    for (int j = l; j < kend; j += 64) { const uint4* kr = (const uint4*)(Kb + (size_t)j * QKH); float d = 0.f;
        for (int e = 0; e < QKH / 8; ++e) { const uint4 w = kr[e]; const float* q8 = sq + e * 8;
            d += q8[0] * __uint_as_float(w.x << 16) + q8[1] * __uint_as_float(w.x & 0xffff0000u) + q8[2] * __uint_as_float(w.y << 16) + q8[3] * __uint_as_float(w.y & 0xffff0000u)
               + q8[4] * __uint_as_float(w.z << 16) + q8[5] * __uint_as_float(w.z & 0xffff0000u) + q8[6] * __uint_as_float(w.w << 16) + q8[7] * __uint_as_float(w.w & 0xffff0000u); }
        d *= scale; sc[j] = d; mx = fmaxf(mx, d); }
    for (int o = 32; o > 0; o >>= 1) mx = fmaxf(mx, __shfl_xor(mx, o));
    float sum = 0.f;
    for (int j = l; j < kend; j += 64) { const float p = expf(sc[j] - mx); sc[j] = p; sum += p; }
    for (int o = 32; o > 0; o >>= 1) sum += __shfl_xor(sum, o);
    __syncthreads();
    float o0 = 0.f, o1 = 0.f;
    for (int j = 0; j < kend; ++j) { const float p = sc[j]; o0 += p * bf2f(Vb[(size_t)j * VH + l]); o1 += p * bf2f(Vb[(size_t)j * VH + l + 64]); }
    const float inv = 1.f / sum; o0 *= inv; o1 *= inv;
    const bf16_t* u = (const bf16_t*)(P.ws + WS_B); const bf16_t* gb = u + (size_t)M * DM; const bf16_t* sg = gb + (size_t)M * DM;
    bf16_t* mg = (bf16_t*)(P.ws + WS_A);
#pragma unroll
    for (int j = 0; j < 2; ++j) { const int c = h * VH + l + 64 * j; const size_t e = (size_t)m * DM + c;
        const float u0 = bf2f(u[e]), um1 = t >= 1 ? bf2f(u[e - DM]) : 0.f, um2 = t >= 2 ? bf2f(u[e - 2 * DM]) : 0.f;
        const float cv = P.conv_w[c] * um2 + P.conv_w[DM + c] * um1 + P.conv_w[2 * DM + c] * u0;
        mg[e] = f2bf(bf2f(gb[e]) * cv + bf2f(sg[e]) * (j ? o1 : o0)); }
}
__global__ void __launch_bounds__(256) nv_resid(Ptrs P, const float* y, int b) {
    const size_t i = (size_t)blockIdx.x * 256 + threadIdx.x;
    const int d = (int)(i & (DM - 1)); const size_t e = (size_t)b * SEQ * DM + i;
    P.out[e] = P.x[e] + ((const float*)(P.ws + WS_MOD))[b * 6144 + 2048 + d] * y[i];
}
__global__ void __launch_bounds__(256) nv_norm2_router(Ptrs P) {
    __shared__ float red[4]; __shared__ float hs[DM]; __shared__ float lg[36];
    const int m = blockIdx.x, b = m / SEQ, t = threadIdx.x;
    const float* mod = (const float*)(P.ws + WS_MOD) + b * 6144;
    float v[4]; float ss = 0.f;
#pragma unroll
    for (int j = 0; j < 4; ++j) { v[j] = P.out[(size_t)m * DM + t + 256 * j]; ss += v[j] * v[j]; }
    ss = block_sum_256(ss, red);
    const float rstd = 1.f / sqrtf(ss / DM + EPS);
    bf16_t* h2 = (bf16_t*)(P.ws + WS_B);
#pragma unroll
    for (int j = 0; j < 4; ++j) { const int d = t + 256 * j; const float hv = v[j] * rstd * P.norm2_g[d] * (1.f + mod[4096 + d]) + mod[3072 + d]; hs[d] = hv; h2[(size_t)m * DM + d] = f2bf(hv); }
    __syncthreads();
    if (t < 36) { float a = 0.f;
        if (t < 4) { for (int k = 0; k < DM; ++k) a += hs[k] * P.w_rg[k * 4 + t]; a += P.b_rg[t]; }
        else { for (int k = 0; k < DM; ++k) a += hs[k] * P.w_re[k * 32 + t - 4]; a += P.b_re[t - 4]; }
        lg[t] = a; }
    __syncthreads();
    if (t == 0) {
        int g = 0; for (int i = 1; i < 4; ++i) if (lg[i] > lg[g]) g = i;
        float se = 0.f; for (int i = 0; i < 4; ++i) se += expf(lg[i] - lg[g]);
        const float pg = 1.f / se;
        const float* el = lg + 4 + g * 8;
        int i0 = 0; for (int i = 1; i < 8; ++i) if (el[i] > el[i0]) i0 = i;
        int i1 = (i0 == 0) ? 1 : 0; for (int i = 0; i < 8; ++i) if (i != i0 && el[i] > el[i1]) i1 = i;
        const float p1 = expf(el[i1] - el[i0]);
        const float w0 = 1.f / (1.f + p1), w1 = p1 / (1.f + p1);
        int2 e; e.x = g * 8 + i0; e.y = g * 8 + i1; float2 w; w.x = w0 * pg; w.y = w1 * pg;
        ((int2*)(P.ws + WS_RT))[m] = e; ((float2*)(P.ws + WS_RT + 256 * 1024))[m] = w; }
}
__global__ void __launch_bounds__(256) nv_moe(Ptrs P) {
    __shared__ float hs[DM]; __shared__ float act[DEXP];
    const int m = blockIdx.x, b = m / SEQ, t = threadIdx.x;
    const bf16_t* h2 = (const bf16_t*)(P.ws + WS_B) + (size_t)m * DM;
#pragma unroll
    for (int j = 0; j < 4; ++j) hs[t + 256 * j] = bf2f(h2[t + 256 * j]);
    const int2 e = ((const int2*)(P.ws + WS_RT))[m]; const float2 w = ((const float2*)(P.ws + WS_RT + 256 * 1024))[m];
    float o[4] = {0.f, 0.f, 0.f, 0.f};
    for (int j = 0; j < 2; ++j) {
        const int ex = j ? e.y : e.x; const float wj = j ? w.y : w.x;
        const float* wg = P.w_gate + (size_t)ex * DM * DEXP; const float* wu = P.w_up + (size_t)ex * DM * DEXP; const float* wd = P.w_down + (size_t)ex * DEXP * DM;
        __syncthreads();
        float g = 0.f, uu = 0.f;
        for (int k = 0; k < DM; ++k) { const float hv = hs[k]; g += hv * wg[(size_t)k * DEXP + t]; uu += hv * wu[(size_t)k * DEXP + t]; }
        act[t] = (g / (1.f + expf(-g))) * uu * wj;
        __syncthreads();
        for (int f = 0; f < DEXP; ++f) { const float a = act[f];
#pragma unroll
            for (int q = 0; q < 4; ++q) o[q] += a * wd[(size_t)f * DM + t + 256 * q]; }
    }
    const float* mod = (const float*)(P.ws + WS_MOD) + b * 6144 + 5120;
#pragma unroll
    for (int q = 0; q < 4; ++q) { const int d = t + 256 * q; P.out[(size_t)m * DM + d] += mod[d] * o[q]; }
}

namespace fk {
#define LAS __attribute__((address_space(3)))
#define GAS __attribute__((address_space(1)))
typedef short bf16x8 __attribute__((ext_vector_type(8)));
typedef short s16x4 __attribute__((ext_vector_type(4)));
typedef unsigned u32x4 __attribute__((ext_vector_type(4)));
typedef unsigned u32x2 __attribute__((ext_vector_type(2)));
typedef float f32x2 __attribute__((ext_vector_type(2)));
typedef float f32x16 __attribute__((ext_vector_type(16)));
typedef GAS unsigned gu32;
#define RLX_AGENT __ATOMIC_RELAXED, __HIP_MEMORY_SCOPE_AGENT
constexpr int NWAVES = 8;
constexpr int BM = 256, BK = 64, HALF = 128, HTB = HALF * BK * 2, STAGE_BYTES = 8 * HTB, NXCD = 8, WGM = 8;
constexpr int RING_OFF = 0, RING_BYTES = 131072, XCH_OFF = 131072, XCH_BYTES = 8192, LDSCTL_OFF = XCH_OFF + XCH_BYTES, MISC_OFF = LDSCTL_OFF + 320, LDS_BYTES = 147456;
constexpr int CW_TMO = 0, CW_BAR = 4096;
constexpr int CW_HIST = 16384;
constexpr int CW_TILES = 40960;

typedef __bf16 bf16x2_t __attribute__((ext_vector_type(2)));
__device__ __forceinline__ unsigned cvt_pk_bf16(float lo, float hi) { f32x2 v = {lo, hi}; bf16x2_t b = __builtin_convertvector(v, bf16x2_t); return __builtin_bit_cast(unsigned, b); }
__device__ __forceinline__ float fsigmoid(float x) { return __builtin_amdgcn_rcpf(1.f + __expf(-x)); }

__host__ __device__ __forceinline__ int lds_byte(int r, int c) { const int st = (r >> 4) * 2 + (c >> 5), rr = r & 15, cc = c & 31, ob = rr * 64 + cc * 2; return st * 1024 + (ob ^ (((ob >> 9) & 1) << 5)); }
__host__ __device__ __forceinline__ void stage_rc(int b, int& R, int& C) { const int st = b / 1024, sb = b % 1024, swz = sb ^ (((sb >> 9) & 1) << 5); R = (st >> 1) * 16 + swz / 64; C = (st & 1) * 32 + (swz % 64) / 2; }
__host__ __device__ __forceinline__ int permL(int L) { return (L & 0xE0) | (((L >> 2) & 1) << 4) | (((L >> 3) & 3) << 2) | (L & 3); }

#define XB_TMO      128
#define XB_XCNT(j)  (256  + 64 * (j))
#define XB_XSUB(j)  (1280 + 64 * (j))
#define XB_XGEN(j)  (2304 + 64 * (j))
#define XB_TOP      3328
#define XB_TOPGEN   3392
#define XCD_BAR_WORDS 3456
#define XB_SPIN_CAP (1u << 18)
__device__ __forceinline__ unsigned xb_ld(unsigned* p)              { return __hip_atomic_load(p, __ATOMIC_RELAXED, __HIP_MEMORY_SCOPE_AGENT); }
__device__ __forceinline__ unsigned xb_add(unsigned* p, unsigned v) { return __hip_atomic_fetch_add(p, v, __ATOMIC_RELAXED, __HIP_MEMORY_SCOPE_AGENT); }
__device__ __forceinline__ unsigned xb_xcc_id() { return (unsigned)__builtin_amdgcn_s_getreg((3 << 11) | 20) & 0xFu; }
#define XB_SPIN(cond, bar) do { unsigned _sp = 0; while (cond) { __builtin_amdgcn_s_sleep(1); \
    if ((++_sp & 255u) == 0u) { if (xb_ld(&(bar)[XB_TMO])) break; if (_sp > XB_SPIN_CAP) { atomicAdd(&(bar)[XB_TMO], 1u); break; } } } } while (0)
struct XcdBarrier { unsigned* bar; unsigned x; volatile LAS unsigned* st; };
__device__ __forceinline__ XcdBarrier xcd_barrier_post(unsigned* bar, volatile LAS unsigned* st) {
    XcdBarrier b; b.bar = bar; b.x = xb_xcc_id(); b.st = st;
    if (threadIdx.x == 0) (void)xb_add(&bar[XB_XCNT(b.x)], 1u);
    return b;
}
__device__ __forceinline__ void xcd_barrier_complete(unsigned* bar, unsigned x, unsigned& nloc, unsigned& nx) {
    const unsigned G = gridDim.x * gridDim.y * gridDim.z;
    unsigned sum, cnt, mine, sp = 0u;
    for (;;) {
        sum = 0u; cnt = 0u; mine = 0u;
#pragma unroll
        for (unsigned j = 0; j < 16; ++j) { const unsigned c = xb_ld(&bar[XB_XCNT(j)]); sum += c; cnt += (c > 0u) ? 1u : 0u; mine = (j == x) ? c : mine; }
        if (sum == G) break;
        __builtin_amdgcn_s_sleep(1);
        if ((++sp & 255u) == 0u) { if (xb_ld(&bar[XB_TMO])) break; if (sp > XB_SPIN_CAP) { atomicAdd(&bar[XB_TMO], 1u); break; } }
    }
    nloc = mine > 0u ? mine : 1u; nx = cnt > 0u ? cnt : 1u;
}
__device__ __forceinline__ void xcd_barrier(const XcdBarrier& b) {
    asm volatile("s_waitcnt vmcnt(0)" ::: "memory");
    __syncthreads();
    if (threadIdx.x == 0) {
        unsigned* bar = b.bar;
        __builtin_amdgcn_s_waitcnt(0);
        unsigned nloc = b.st[0], nx = b.st[1];
        if (nloc == 0u) { xcd_barrier_complete(bar, b.x, nloc, nx); b.st[0] = nloc; b.st[1] = nx; }
        const unsigned old = xb_add(&bar[XB_XSUB(b.x)], 1u);
        const unsigned gen = old / nloc;
        if (old + 1u == (gen + 1u) * nloc) {
            __builtin_amdgcn_fence(__ATOMIC_RELEASE, "agent");
            asm volatile("s_waitcnt vmcnt(0)" ::: "memory");
            const unsigned og = xb_add(&bar[XB_TOP], 1u);
            const unsigned tg = og / nx;
            if (og + 1u == (tg + 1u) * nx) xb_add(&bar[XB_TOPGEN], 1u);
            else XB_SPIN(xb_ld(&bar[XB_TOPGEN]) == tg, bar);
            __builtin_amdgcn_fence(__ATOMIC_ACQUIRE, "agent");
            xb_add(&bar[XB_XGEN(b.x)], 1u);
            asm volatile("s_waitcnt vmcnt(0)" ::: "memory");
        } else {
            XB_SPIN(xb_ld(&bar[XB_XGEN(b.x)]) == gen, bar);
            __builtin_amdgcn_fence(__ATOMIC_ACQUIRE, "agent");
            asm volatile("s_waitcnt vmcnt(0)" ::: "memory");
        }
    }
    __syncthreads();
}

struct Unit { int pm, pn, aux, half; };
struct DenseSched {
    const bf16_t* A; const bf16_t* Bt; int lda, ldb; int nM, nN, nwg, G, c; bool split, pnflip;
    __device__ void init(const bf16_t* A_, int lda_, const bf16_t* Bt_, int ldb_, int M_, int N_, int G_, int c_, bool split_ = false, bool pnflip_ = false) {
        A = A_; Bt = Bt_; lda = lda_; ldb = ldb_; nM = M_ / BM; nN = N_ / BM; nwg = nM * nN; G = G_; c = c_; split = split_; pnflip = pnflip_; }
    __device__ bool next(int i, Unit& u) const {
        const int idx = i * G + c, nfull = (nwg / G) * G, tail = nwg - nfull; int L; u.half = 0;
        if (split && tail > 0 && 2 * tail <= G) { if (idx >= nfull + 2 * tail) return false; if (idx < nfull) L = idx; else { L = nfull + ((idx - nfull) >> 1); u.half = 1 + ((idx - nfull) & 1); } }
        else { if (idx >= nwg) return false; L = idx; }
        int wgid = L; { const int q = nwg / NXCD, r = nwg % NXCD, xcd = wgid % NXCD, off = wgid / NXCD; wgid = (xcd < r ? xcd * (q + 1) : r * (q + 1) + (xcd - r) * q) + off; }
        const int nig = WGM * nN, gid = wgid / nig, fm = gid * WGM, gsz = (nM - fm) < WGM ? (nM - fm) : WGM;
        u.pm = fm + ((wgid % nig) % gsz); u.pn = (wgid % nig) / gsz; if (pnflip) u.pn = nN - 1 - u.pn; u.aux = 0; return true;
    }
    __device__ __forceinline__ const char* abase(const Unit& u) const { return (const char*)A + (size_t)(u.pm * BM + (u.half == 2 ? HALF : 0)) * lda * 2; }
    __device__ __forceinline__ const char* bbase(const Unit& u) const { return (const char*)Bt + (size_t)u.pn * BM * ldb * 2; }
    __device__ __forceinline__ void avoff(const Unit& u, int R0, int C0, int R1, int C1, unsigned (&v0)[2], unsigned (&v1)[2]) const {
        v0[0] = (unsigned)(R0 * lda + C0) * 2u; v0[1] = (unsigned)(R1 * lda + C1) * 2u;
        const unsigned h1 = u.half ? 0u : (unsigned)(HALF * lda * 2);
        v1[0] = v0[0] + h1; v1[1] = v0[1] + h1; }
};

template <bool GATHER, class Epi, class Sched>
__device__ __forceinline__ void gemm_phase(LAS unsigned char* lds, const int K, const Sched& S, const Epi& E) {
    const int tid = threadIdx.x, wid = __builtin_amdgcn_readfirstlane(tid >> 6), lane = tid & 63, wr = wid >> 2, wc = wid & 3, fr = lane & 15, fq = lane >> 4;
    const int nt = K / BK;
    int R0, C0, R1, C1; stage_rc(tid * 16, R0, C0); stage_rc(tid * 16 + 8192, R1, C1);
    unsigned voffB[2]; voffB[0] = (unsigned)(R0 * S.ldb + C0) * 2u; voffB[1] = (unsigned)(R1 * S.ldb + C1) * 2u;
    const size_t kstep = (size_t)(BK * 2);
    const size_t hstepB = (size_t)HALF * S.ldb * 2;
    const unsigned ldsw = (unsigned)wid * 1024u;
    const int aoff = lds_byte(wr * 64 + fr, fq * 8), boff = lds_byte(wc * 32 + fr, fq * 8);
#define PG8_SA(b, h) (((b) * 2 + (h)) * HTB)
#define PG8_SB(b, h) ((4 + (b) * 2 + (h)) * HTB)
#define PG8_STAGE(bufoff, gbase, voff) do { _Pragma("unroll") for (int _i = 0; _i < 2; ++_i) \
        __builtin_amdgcn_global_load_lds((const unsigned*)((const char*)(gbase) + (voff)[_i]), (LAS unsigned*)(lds + (bufoff) + ldsw + _i * 8192), 16, 0, 0); } while (0)
#define PG8_LDA(dst, b, h) do { _Pragma("unroll") for (int m = 0; m < 4; ++m) _Pragma("unroll") for (int k = 0; k < 2; ++k) dst[m][k] = *(const LAS bf16x8*)(lds + PG8_SA(b, h) + aoff + m * 2048 + k * 1024); } while (0)
#define PG8_LDB(dst, b, h) do { _Pragma("unroll") for (int n = 0; n < 2; ++n) _Pragma("unroll") for (int k = 0; k < 2; ++k) dst[n][k] = *(const LAS bf16x8*)(lds + PG8_SB(b, h) + boff + n * 2048 + k * 1024); } while (0)
#define PG8_MMA(ai, bj, At, Bt) do { __builtin_amdgcn_s_setprio(1); _Pragma("unroll") for (int m = 0; m < 4; ++m) _Pragma("unroll") for (int n = 0; n < 2; ++n) _Pragma("unroll") for (int k = 0; k < 2; ++k) \
        acc[ai][bj][m][n] = __builtin_amdgcn_mfma_f32_16x16x32_bf16(Bt[n][k], At[m][k], acc[ai][bj][m][n], 0, 0, 0); __builtin_amdgcn_s_setprio(0); } while (0)
#define PG8_WAIT_V(n) asm volatile("s_waitcnt vmcnt(" #n ")" ::: "memory")
#define PG8_WAIT_L(n) asm volatile("s_waitcnt lgkmcnt(" #n ")" ::: "memory")
#define PG8_BAR __builtin_amdgcn_s_barrier()
#define PG8_SCHED __builtin_amdgcn_sched_barrier(0)
    Unit cur, nxt; int ui = 0;
    if (!S.next(0, cur)) return;
    f32x4 acc[2][2][4][2];
#pragma unroll
    for (int a = 0; a < 2; ++a)
#pragma unroll
        for (int b = 0; b < 2; ++b)
#pragma unroll
            for (int m = 0; m < 4; ++m)
#pragma unroll
                for (int n = 0; n < 2; ++n) acc[a][b][m][n] = (f32x4){0.f, 0.f, 0.f, 0.f};
    bf16x8 At[4][2], B0[2][2], B1[2][2];
    unsigned va0[2], va1[2], na0[2], na1[2];
    S.avoff(cur, R0, C0, R1, C1, va0, va1);
    na0[0] = va0[0]; na0[1] = va0[1]; na1[0] = va1[0]; na1[1] = va1[1];
    const char* cA = S.abase(cur); const char* cB = S.bbase(cur);
    PG8_STAGE(PG8_SB(0, 0), cB, voffB); PG8_STAGE(PG8_SB(0, 1), cB + hstepB, voffB); PG8_STAGE(PG8_SA(0, 0), cA, va0); PG8_STAGE(PG8_SA(0, 1), cA, va1);
    if (wr == 1) PG8_BAR;
    PG8_WAIT_V(2); PG8_BAR;
    PG8_STAGE(PG8_SB(1, 0), cB + kstep, voffB); PG8_STAGE(PG8_SA(1, 0), cA + kstep, va0); PG8_STAGE(PG8_SB(1, 1), cB + hstepB + kstep, voffB);
    PG8_WAIT_V(6); PG8_BAR;
    for (;;) {
        const bool has_next = S.next(ui + 1, nxt);
        const char* nA = has_next ? S.abase(nxt) : cA; const char* nB = has_next ? S.bbase(nxt) : cB;
        if (has_next) S.avoff(nxt, R0, C0, R1, C1, na0, na1);
        const bool hu = cur.half != 0;
#pragma unroll 1
        for (int t = 0; t < nt; t += 2) {
            const bool last = (t == nt - 2);
            const char* a1 = cA + (size_t)(t + 1) * kstep;
            const char* a2 = last ? nA : cA + (size_t)(t + 2) * kstep; const char* b2 = last ? nB : cB + (size_t)(t + 2) * kstep;
            const char* a3 = a2 + kstep; const char* b3 = b2 + kstep;
            unsigned x0[2], x1[2];
            x0[0] = last ? na0[0] : va0[0]; x0[1] = last ? na0[1] : va0[1]; x1[0] = last ? na1[0] : va1[0]; x1[1] = last ? na1[1] : va1[1];
            PG8_LDB(B0, 0, 0); PG8_LDB(B1, 0, 1); PG8_SCHED; PG8_LDA(At, 0, 0); PG8_STAGE(PG8_SA(1, 1), a1, va1);
            PG8_WAIT_V(8); PG8_WAIT_L(0); PG8_BAR; PG8_MMA(0, 0, At, B0); PG8_MMA(0, 1, At, B1); PG8_BAR; PG8_SCHED;
            if (!hu) PG8_LDA(At, 0, 1);
            PG8_STAGE(PG8_SB(0, 0), b2, voffB); PG8_STAGE(PG8_SB(0, 1), b2 + hstepB, voffB); PG8_STAGE(PG8_SA(0, 0), a2, x0);
            PG8_WAIT_V(8); PG8_WAIT_L(0); PG8_BAR; if (!hu) { PG8_MMA(1, 0, At, B0); PG8_MMA(1, 1, At, B1); } PG8_BAR; PG8_SCHED;
            PG8_LDB(B0, 1, 0); PG8_LDB(B1, 1, 1); PG8_SCHED; PG8_LDA(At, 1, 0); PG8_STAGE(PG8_SA(0, 1), a2, x1);
            PG8_WAIT_V(8); PG8_WAIT_L(0); PG8_BAR; PG8_MMA(0, 0, At, B0); PG8_MMA(0, 1, At, B1); PG8_BAR; PG8_SCHED;
            if (!hu) PG8_LDA(At, 1, 1);
            PG8_STAGE(PG8_SB(1, 0), b3, voffB); PG8_STAGE(PG8_SB(1, 1), b3 + hstepB, voffB); PG8_STAGE(PG8_SA(1, 0), a3, x0);
            PG8_WAIT_V(8); PG8_WAIT_L(0); PG8_BAR; if (!hu) { PG8_MMA(1, 0, At, B0); PG8_MMA(1, 1, At, B1); } PG8_BAR; PG8_SCHED;
        }
        if (wr == 0) PG8_BAR;
        E(acc, cur, wr, wc, fr, fq);
        if (!has_next) break;
#pragma unroll
        for (int a = 0; a < 2; ++a)
#pragma unroll
            for (int b = 0; b < 2; ++b)
#pragma unroll
                for (int m = 0; m < 4; ++m)
#pragma unroll
                    for (int n = 0; n < 2; ++n) acc[a][b][m][n] = (f32x4){0.f, 0.f, 0.f, 0.f};
        cur = nxt; cA = nA; cB = nB; ++ui;
        va0[0] = na0[0]; va0[1] = na0[1]; va1[0] = na1[0]; va1[1] = na1[1];
        if (wr == 1) PG8_BAR;
    }
    PG8_WAIT_V(0);
    PG8_BAR;
#undef PG8_SA
#undef PG8_SB
#undef PG8_STAGE
#undef PG8_LDA
#undef PG8_LDB
#undef PG8_MMA
#undef PG8_WAIT_V
#undef PG8_WAIT_L
#undef PG8_BAR
#undef PG8_SCHED
}

__device__ __forceinline__ u32x4 pack8(const f32x4 a, const f32x4 b) { u32x4 w; w.x = cvt_pk_bf16(a[0], a[1]); w.y = cvt_pk_bf16(a[2], a[3]); w.z = cvt_pk_bf16(b[0], b[1]); w.w = cvt_pk_bf16(b[2], b[3]); return w; }

struct EpiIn {
    bf16_t *u, *gb, *sg, *lat; float* rowstat; const float2* cs; const float* k_g; LAS float* xch;
    __device__ __forceinline__ void operator()(const f32x4 (&acc)[2][2][4][2], const Unit& un, int wr, int wc, int fr, int fq) const {
        asm volatile("" : "+v"(fr), "+v"(fq));
        const int row0 = un.pm * BM + wr * 64 + fr, pn = un.pn;
        if (pn < 16) {
            const int c0 = 128 * (pn & 7) + 32 * wc + 8 * fq; bf16_t* dst = pn < 8 ? u : gb; const int rh = row0 + (un.half == 2 ? HALF : 0);
#pragma unroll
            for (int ai = 0; ai < 2; ++ai)
#pragma unroll
                for (int m = 0; m < 4; ++m) { f32x4 r0, r1; if (ai == 1 && un.half) continue;
                    if (pn < 8) { r0 = acc[ai][0][m][0] * acc[ai][1][m][0]; r1 = acc[ai][0][m][1] * acc[ai][1][m][1]; }
                    else { const f32x4 g0 = acc[ai][1][m][0], g1 = acc[ai][1][m][1];
#pragma unroll
                        for (int i = 0; i < 4; ++i) { r0[i] = acc[ai][0][m][0][i] * fsigmoid(g0[i]); r1[i] = acc[ai][0][m][1][i] * fsigmoid(g1[i]); } }
                    *(u32x4*)(dst + (size_t)(rh + ai * HALF + m * 16) * DM + c0) = pack8(r0, r1); }
        } else if (pn < 20) {
            const int c0 = 256 * (pn - 16) + 32 * wc + 8 * fq;
#pragma unroll
            for (int ai = 0; ai < 2; ++ai)
#pragma unroll
                for (int m = 0; m < 4; ++m)
#pragma unroll
                    for (int bj = 0; bj < 2; ++bj) { f32x4 a = acc[ai][bj][m][0], b = acc[ai][bj][m][1];
#pragma unroll
                        for (int i = 0; i < 4; ++i) { a[i] = fsigmoid(a[i]); b[i] = fsigmoid(b[i]); }
                        *(u32x4*)(sg + (size_t)(row0 + ai * HALF + m * 16) * DM + c0 + bj * HALF) = pack8(a, b); }
        } else {
            const int c0 = 256 * (pn - 20) + 32 * wc + 8 * fq, rowt = wr * 64 + fr;
#pragma unroll
            for (int ai = 0; ai < 2; ++ai)
#pragma unroll
                for (int m = 0; m < 4; ++m) { const int rt = rowt + ai * HALF + m * 16, row = un.pm * BM + rt; float s0, s1;
                    { const f32x4 a = acc[ai][0][m][0], b = acc[ai][0][m][1]; *(u32x4*)(lat + (size_t)row * LATW + c0) = pack8(a, b);
                      s0 = (a[0] * a[0] + a[1] * a[1]) + (a[2] * a[2] + a[3] * a[3]) + (b[0] * b[0] + b[1] * b[1]) + (b[2] * b[2] + b[3] * b[3]); }
                    { const f32x4 a = acc[ai][1][m][0], b = acc[ai][1][m][1];
                      s1 = (a[0] * a[0] + a[1] * a[1]) + (a[2] * a[2] + a[3] * a[3]) + (b[0] * b[0] + b[1] * b[1]) + (b[2] * b[2] + b[3] * b[3]);
                      if (pn != 21) *(u32x4*)(lat + (size_t)row * LATW + c0 + HALF) = pack8(a, b);
                      else if (wc < 2) { const int j = 16 * wc + 4 * fq;
                          const f32x4 g1 = *(const f32x4*)(k_g + 128 + j), g2 = *(const f32x4*)(k_g + 160 + j);
                          const f32x4 cA = *(const f32x4*)((const float*)cs + ((size_t)row * 32 + j) * 2), cB = *(const f32x4*)((const float*)cs + ((size_t)row * 32 + j + 2) * 2);
                          const f32x4 x1 = a * g1, x2 = b * g2; f32x4 y1, y2;
                          y1[0] = x1[0] * cA[0] - x2[0] * cA[1]; y2[0] = x2[0] * cA[0] + x1[0] * cA[1]; y1[1] = x1[1] * cA[2] - x2[1] * cA[3]; y2[1] = x2[1] * cA[2] + x1[1] * cA[3];
                          y1[2] = x1[2] * cB[0] - x2[2] * cB[1]; y2[2] = x2[2] * cB[0] + x1[2] * cB[1]; y1[3] = x1[3] * cB[2] - x2[3] * cB[3]; y2[3] = x2[3] * cB[2] + x1[3] * cB[3];
                          u32x2 w1, w2; w1.x = cvt_pk_bf16(y1[0], y1[1]); w1.y = cvt_pk_bf16(y1[2], y1[3]); w2.x = cvt_pk_bf16(y2[0], y2[1]); w2.y = cvt_pk_bf16(y2[2], y2[3]);
                          *(u32x2*)(lat + (size_t)row * LATW + 384 + j) = w1; *(u32x2*)(lat + (size_t)row * LATW + 416 + j) = w2; } }
                    s0 += __shfl_xor(s0, 16); s0 += __shfl_xor(s0, 32); s1 += __shfl_xor(s1, 16); s1 += __shfl_xor(s1, 32);
                    if (fq == 0) { xch[rt * 8 + wc] = s0; xch[rt * 8 + 4 + wc] = s1; } }
            asm volatile("s_waitcnt lgkmcnt(0)" ::: "memory"); __builtin_amdgcn_s_barrier(); asm volatile("" ::: "memory");
            if (threadIdx.x < 256) { const int rt = threadIdx.x; const f32x4 p0 = *(const LAS f32x4*)(xch + rt * 8), p1 = *(const LAS f32x4*)(xch + rt * 8 + 4);
                const float S0 = (p0[0] + p0[1]) + (p0[2] + p0[3]), S1 = (p1[0] + p1[1]) + (p1[2] + p1[3]); float* st = rowstat + (size_t)(un.pm * BM + rt) * 4;
                if (pn == 20) st[0] = S0 + S1; else if (pn == 21) { st[1] = S0; st[2] = S1; } else st[3] = S0 + S1; }
        }
    }
};
struct EpiPlain {
    bf16_t* O; int ldc; int pnmask;
    __device__ __forceinline__ void operator()(const f32x4 (&acc)[2][2][4][2], const Unit& un, int wr, int wc, int fr, int fq) const {
        asm volatile("" : "+v"(fr), "+v"(fq));
        const int row0 = un.pm * BM + wr * 64 + fr, c0 = 256 * (un.pn & pnmask) + 32 * wc + 8 * fq;
#pragma unroll
        for (int ai = 0; ai < 2; ++ai)
#pragma unroll
            for (int m = 0; m < 4; ++m)
#pragma unroll
                for (int bj = 0; bj < 2; ++bj) *(u32x4*)(O + (size_t)(row0 + ai * HALF + m * 16) * ldc + c0 + bj * HALF) = pack8(acc[ai][bj][m][0], acc[ai][bj][m][1]);
    }
};
struct EpiKV {
    bf16_t *Kb, *Vb; const bf16_t* lat; const float* rowstat; const float* k_g; LAS float* xch;
    __device__ __forceinline__ void operator()(const f32x4 (&acc)[2][2][4][2], const Unit& un, int wr, int wc, int fr, int fq) const {
        asm volatile("" : "+v"(fr), "+v"(fq));
        const int h = un.pn, rowt = wr * 64 + fr, b = (un.pm * BM) / SEQ, s0 = (un.pm * BM) % SEQ;
        f32x2 st[2][4];
        u32x4 rp[2][2];
#pragma unroll
        for (int ai = 0; ai < 2; ++ai) {
#pragma unroll
            for (int m = 0; m < 4; ++m) st[ai][m] = *(const f32x2*)(rowstat + (size_t)(un.pm * BM + rowt + ai * HALF + m * 16) * 4 + 2);
            const bf16_t* lr = lat + (size_t)(un.pm * BM + rowt + ai * HALF + wc * 16) * LATW + 384 + 16 * fq;
            rp[ai][0] = *(const u32x4*)lr; rp[ai][1] = *(const u32x4*)(lr + 8); }
#pragma unroll
        for (int ai = 0; ai < 2; ++ai)
#pragma unroll
            for (int m = 0; m < 4; ++m) {
                const f32x4 a = acc[ai][0][m][0], c = acc[ai][0][m][1];
                float ss = (a[0] * a[0] + a[1] * a[1]) + (a[2] * a[2] + a[3] * a[3]) + (c[0] * c[0] + c[1] * c[1]) + (c[2] * c[2] + c[3] * c[3]);
                ss += __shfl_xor(ss, 16); ss += __shfl_xor(ss, 32);
                if (fq == 0) xch[(rowt + ai * HALF + m * 16) * 4 + wc] = ss; }
        asm volatile("s_waitcnt lgkmcnt(0)" ::: "memory"); __builtin_amdgcn_s_barrier(); asm volatile("" ::: "memory");
        const int c8 = 32 * wc + 8 * fq;
        const f32x4 g0 = *(const f32x4*)(k_g + c8), g1 = *(const f32x4*)(k_g + c8 + 4);
#pragma unroll
        for (int ai = 0; ai < 2; ++ai)
#pragma unroll
            for (int m = 0; m < 4; ++m) { const int rt = rowt + ai * HALF + m * 16;
                const float rkv = __builtin_amdgcn_rsqf(st[ai][m][1] * (1.f / KVL) + EPS);
                const f32x4 t4 = *(const LAS f32x4*)(xch + rt * 4);
                const float rk = __builtin_amdgcn_rsqf((((t4[0] + t4[1]) + (t4[2] + t4[3])) * rkv * rkv + st[ai][m][0]) * (1.f / QKH) + EPS);
                const float sk = rkv * rk, sv = rkv;
                const size_t bhs = (size_t)(b * NH + h) * SEQ + s0 + rt;
                bf16_t* Kp = Kb + bhs * QKH; bf16_t* Vp = Vb + bhs * VH;
                *(u32x4*)(Kp + c8) = pack8(acc[ai][0][m][0] * sk * g0, acc[ai][0][m][1] * sk * g1);
                *(u32x4*)(Vp + c8) = pack8(acc[ai][1][m][0] * sv, acc[ai][1][m][1] * sv);
                if (m == wc) {
                    u32x4 o0, o1;
#pragma unroll
                    for (int e = 0; e < 4; ++e) { o0[e] = cvt_pk_bf16(__uint_as_float(rp[ai][0][e] << 16) * rk, __uint_as_float(rp[ai][0][e] & 0xffff0000u) * rk);
                                                  o1[e] = cvt_pk_bf16(__uint_as_float(rp[ai][1][e] << 16) * rk, __uint_as_float(rp[ai][1][e] & 0xffff0000u) * rk); }
                    *(u32x4*)(Kp + 128 + 16 * fq) = o0; *(u32x4*)(Kp + 128 + 16 * fq + 8) = o1; } }
    }
};
struct EpiDelta {
    const float* mod; bf16_t* delta;
    __device__ __forceinline__ void operator()(const f32x4 (&acc)[2][2][4][2], const Unit& un, int wr, int wc, int fr, int fq) const {
        asm volatile("" : "+v"(fr), "+v"(fq));
        const int row0 = un.pm * BM + wr * 64 + fr, b = (un.pm * BM) / SEQ, c0 = 256 * un.pn + 32 * wc + 8 * fq;
        const float* gate = mod + b * 6144 + 2048;
#pragma unroll
        for (int bj = 0; bj < 2; ++bj) { const f32x4 g0 = *(const f32x4*)(gate + c0 + bj * HALF), g1 = *(const f32x4*)(gate + c0 + bj * HALF + 4);
#pragma unroll
            for (int ai = 0; ai < 2; ++ai)
#pragma unroll
                for (int m = 0; m < 4; ++m) *(u32x4*)(delta + (size_t)(row0 + ai * HALF + m * 16) * DM + c0 + bj * HALF) = pack8(acc[ai][bj][m][0] * g0, acc[ai][bj][m][1] * g1); }
    }
};
namespace att {
constexpr int NW = 8, QBLK = 32, KVBLK = 64, KPITCH = 400;
constexpr int SHM_V = KVBLK * VH * 2, SHM_K = KVBLK * KPITCH;
constexpr int QRP = 144;
constexpr int OFF_V = 0, OFF_K = 2 * SHM_V, OFF_WS = OFF_K + 2 * SHM_K, OFF_QR = OFF_WS + NW * 64 * 4, ATT_LDS = OFF_QR + NW * 32 * QRP;
constexpr float SCALE = 0.07216878364870322f;
constexpr float THR = 8.f;
#define SBAR() __builtin_amdgcn_sched_barrier(0)
__device__ __forceinline__ int crow(int r, int hi) { return (r & 3) + 8 * (r >> 2) + 4 * hi; }
__device__ __forceinline__ void partialSM(f32x16& p0, f32x16& p1, float& m_reg, float& alpha) {
    constexpr float C = SCALE * 1.4426950408889634f;
    float pmax = p0[0];
#pragma unroll
    for (int r = 1; r < 16; ++r) pmax = fmaxf(pmax, p0[r]);
#pragma unroll
    for (int r = 0; r < 16; ++r) pmax = fmaxf(pmax, p1[r]);
    { auto rr = __builtin_amdgcn_permlane32_swap(__float_as_uint(pmax), __float_as_uint(pmax), false, false);
      pmax = fmaxf(__uint_as_float(rr[0]), __uint_as_float(rr[1])); }
    float mn;
    if (__builtin_expect(__all(pmax - m_reg <= THR / SCALE), 1)) { mn = m_reg; alpha = 1.f; }
    else { mn = fmaxf(m_reg, pmax); alpha = __builtin_amdgcn_exp2f((m_reg - mn) * C); m_reg = mn; }
    const float mnC = -mn * C;
#pragma unroll
    for (int r = 0; r < 16; ++r) p0[r] = fmaf(p0[r], C, mnC);
#pragma unroll
    for (int r = 0; r < 16; ++r) p1[r] = fmaf(p1[r], C, mnC);
#pragma unroll
    for (int r = 0; r < 16; ++r) p0[r] = __builtin_amdgcn_exp2f(p0[r]);
}
__device__ __forceinline__ void finishSM(f32x16& p0, f32x16& p1, float alpha, float& l_reg, bf16x8& pa0, bf16x8& pa1, bf16x8& pa2, bf16x8& pa3) {
#pragma unroll
    for (int r = 0; r < 16; ++r) p1[r] = __builtin_amdgcn_exp2f(p1[r]);
    float ps = 0;
#pragma unroll
    for (int r = 0; r < 16; ++r) ps += p0[r];
#pragma unroll
    for (int r = 0; r < 16; ++r) ps += p1[r];
    { auto rr = __builtin_amdgcn_permlane32_swap(__float_as_uint(ps), __float_as_uint(ps), false, false);
      ps = __uint_as_float(rr[0]) + __uint_as_float(rr[1]); }
    l_reg = l_reg * alpha + ps;
#define PK4(P, BASE, OUT) do { unsigned a0 = cvt_pk_bf16(P[BASE + 0], P[BASE + 1]), a1 = cvt_pk_bf16(P[BASE + 2], P[BASE + 3]);   \
    unsigned b0 = cvt_pk_bf16(P[BASE + 4], P[BASE + 5]), b1 = cvt_pk_bf16(P[BASE + 6], P[BASE + 7]);                              \
    auto r0 = __builtin_amdgcn_permlane32_swap(a0, b0, false, false); auto r1 = __builtin_amdgcn_permlane32_swap(a1, b1, false, false); \
    u32x4 w = {r0[0], r1[0], r0[1], r1[1]}; OUT = *reinterpret_cast<bf16x8*>(&w); } while (0)
    PK4(p0, 0, pa0); PK4(p0, 8, pa1); PK4(p1, 0, pa2); PK4(p1, 8, pa3);
#undef PK4
}
__device__ __forceinline__ void qkt(f32x16& p0, f32x16& p1, const LAS char* Ks, const bf16x8 (&qr)[8], const LAS char* qrope, int r32, int hi) {
    p0 = f32x16{}; p1 = f32x16{};
    const LAS char* k0 = Ks + r32 * KPITCH + hi * 16;
#pragma unroll
    for (int d0 = 0; d0 < 8; ++d0) {
        const bf16x8 b0 = *(const LAS bf16x8*)(k0 + d0 * 32);
        const bf16x8 b1 = *(const LAS bf16x8*)(k0 + 32 * KPITCH + d0 * 32);
        p0 = __builtin_amdgcn_mfma_f32_32x32x16_bf16(b0, qr[d0], p0, 0, 0, 0);
        p1 = __builtin_amdgcn_mfma_f32_32x32x16_bf16(b1, qr[d0], p1, 0, 0, 0); }
#pragma unroll
    for (int d0 = 8; d0 < 12; ++d0) {
        const bf16x8 b0 = *(const LAS bf16x8*)(k0 + d0 * 32);
        const bf16x8 b1 = *(const LAS bf16x8*)(k0 + 32 * KPITCH + d0 * 32);
        const bf16x8 qf = *(const LAS bf16x8*)(qrope + (d0 - 8) * 32);
        p0 = __builtin_amdgcn_mfma_f32_32x32x16_bf16(b0, qf, p0, 0, 0, 0);
        p1 = __builtin_amdgcn_mfma_f32_32x32x16_bf16(b1, qf, p1, 0, 0, 0); }
}
__device__ __forceinline__ int v_st(int k, int c) { const int kk = (k & ~0xC) | ((k & 4) << 1) | ((k & 8) >> 1); return ((kk >> 3) * 4 + (c >> 5)) * 512 + ((kk & 7) * 32 + (c & 31)) * 2; }
__device__ __forceinline__ int v_rd_base(int lane) { return ((lane & 3) << 3) | (((lane >> 2) & 3) << 6) | (((lane >> 4) & 1) << 5) | (((lane >> 5) & 1) << 8); }
constexpr int v_rd_off(int d0, int ks, int half) { return d0 * 512 + ks * 4096 + half * 2048; }
template <int OFF> __device__ __forceinline__ s16x4 tr_read(int vb) {
    s16x4 r; asm volatile("ds_read_b64_tr_b16 %0, %1 offset:%2" : "=&v"(r) : "v"(vb), "i"(OFF) : "memory"); return r;
}
template <int D0> __device__ __forceinline__ void pv_one(f32x16& od, int vb, bf16x8 pa0, bf16x8 pa1, bf16x8 pa2, bf16x8 pa3) {
#define PK(L, H) (bf16x8){L[0], L[1], L[2], L[3], H[0], H[1], H[2], H[3]}
    { const s16x4 l0 = tr_read<v_rd_off(D0, 0, 0)>(vb), h0 = tr_read<v_rd_off(D0, 0, 1)>(vb), l1 = tr_read<v_rd_off(D0, 1, 0)>(vb), h1 = tr_read<v_rd_off(D0, 1, 1)>(vb);
      asm volatile("s_waitcnt lgkmcnt(0)" ::: "memory"); SBAR();
      od = __builtin_amdgcn_mfma_f32_32x32x16_bf16(pa0, PK(l0, h0), od, 0, 0, 0);
      od = __builtin_amdgcn_mfma_f32_32x32x16_bf16(pa1, PK(l1, h1), od, 0, 0, 0); }
    { const s16x4 l2 = tr_read<v_rd_off(D0, 2, 0)>(vb), h2 = tr_read<v_rd_off(D0, 2, 1)>(vb), l3 = tr_read<v_rd_off(D0, 3, 0)>(vb), h3 = tr_read<v_rd_off(D0, 3, 1)>(vb);
      asm volatile("s_waitcnt lgkmcnt(0)" ::: "memory"); SBAR();
      od = __builtin_amdgcn_mfma_f32_32x32x16_bf16(pa2, PK(l2, h2), od, 0, 0, 0);
      od = __builtin_amdgcn_mfma_f32_32x32x16_bf16(pa3, PK(l3, h3), od, 0, 0, 0); }
#undef PK
}
__device__ __forceinline__ void pv_d0(f32x16 (&o)[4], int vb, bf16x8 pa0, bf16x8 pa1, bf16x8 pa2, bf16x8 pa3) {
    pv_one<0>(o[0], vb, pa0, pa1, pa2, pa3); pv_one<1>(o[1], vb, pa0, pa1, pa2, pa3); pv_one<2>(o[2], vb, pa0, pa1, pa2, pa3); pv_one<3>(o[3], vb, pa0, pa1, pa2, pa3);
}
__device__ __forceinline__ float bflo(unsigned w) { return __uint_as_float(w << 16); }
__device__ __forceinline__ float bfhi(unsigned w) { return __uint_as_float(w & 0xffff0000u); }

struct AttnArgs { const bf16_t* Q; const bf16_t* Kb; const bf16_t* Vb; const float* ssp; const float2* cs; const float* q_g; const bf16_t *u, *gb, *sg; const float* conv_w; bf16_t* merged; };

template <int MODE> __device__ __forceinline__ void attn_unit(const AttnArgs& T, int b, int h, int qb, LAS char* lds) {
    int tid = threadIdx.x; asm volatile("" : "+v"(tid));
    const int lane = tid & 63, r32 = lane & 31, hi = lane >> 5; const int wid = __builtin_amdgcn_readfirstlane(tid >> 6);
    LAS char* V_lds = lds + OFF_V; LAS char* K_lds = lds + OFF_K;
    LAS float* ws = (LAS float*)(lds + OFF_WS) + wid * 64; LAS float* li_l = ws; LAS float* al_l = ws + 32;
    const int mrow = b * SEQ + qb * 256 + wid * QBLK + r32;
    const bf16_t* Kh = T.Kb + (size_t)(b * NH + h) * SEQ * QKH; const bf16_t* Vh = T.Vb + (size_t)(b * NH + h) * SEQ * VH;
    const int sr = tid >> 4, sc = (tid & 15) * 8, vst0 = v_st(sr, sc), vst1 = v_st(32 + sr, sc);
    const int kdst = (tid >> 3) * KPITCH + (tid & 7) * 48;
    const int vb0 = (int)(uintptr_t)V_lds + v_rd_base(lane);
    bf16x8 sk0, sk1, sk2, sv0, sv1;
#define SLOAD(t) do { const bf16_t* kp = Kh + (size_t)(t) * KVBLK * QKH + tid * 24; sk0 = *(const bf16x8*)kp; sk1 = *(const bf16x8*)(kp + 8); sk2 = *(const bf16x8*)(kp + 16); \
    const bf16_t* vp = Vh + (size_t)((t) * KVBLK + sr) * VH + sc; sv0 = *(const bf16x8*)vp; sv1 = *(const bf16x8*)(vp + 32 * VH); } while (0)
#define SWRITE(bf) do { *(LAS bf16x8*)(V_lds + (bf) * SHM_V + vst0) = sv0; *(LAS bf16x8*)(V_lds + (bf) * SHM_V + vst1) = sv1; \
    *(LAS bf16x8*)(K_lds + (bf) * SHM_K + kdst) = sk0; *(LAS bf16x8*)(K_lds + (bf) * SHM_K + kdst + 16) = sk1; *(LAS bf16x8*)(K_lds + (bf) * SHM_K + kdst + 32) = sk2; } while (0)
#define RESC(a) do { if (__any((a) < 1.f)) { if (hi == 0) al_l[r32] = (a); asm volatile("s_waitcnt lgkmcnt(0)" ::: "memory"); \
    _Pragma("unroll") for (int d = 0; d < 4; ++d) _Pragma("unroll") for (int r = 0; r < 16; ++r) o[d][r] *= al_l[crow(r, hi)]; } } while (0)
    SLOAD(0);
    bf16x8 qr[8];
    LAS char* qrope = lds + OFF_QR + wid * (32 * QRP) + r32 * QRP + hi * 16;
    {
        const bf16_t* Qw = T.Q + (size_t)mrow * 1536 + h * QKH + hi * 8;
        u32x4 raw[12];
#pragma unroll
        for (int d0 = 0; d0 < 12; ++d0) raw[d0] = *(const u32x4*)(Qw + d0 * 16);
        const f32x2 sq2 = *(const f32x2*)(T.ssp + (size_t)mrow * 4); const float ssq = sq2[0] + sq2[1];
        float ss = 0.f;
#pragma unroll
        for (int d0 = 0; d0 < 12; ++d0)
#pragma unroll
            for (int e = 0; e < 4; ++e) { const float a = bflo(raw[d0][e]), c = bfhi(raw[d0][e]); ss += a * a + c * c; }
        { auto rr = __builtin_amdgcn_permlane32_swap(__float_as_uint(ss), __float_as_uint(ss), false, false); ss = __uint_as_float(rr[0]) + __uint_as_float(rr[1]); }
        const float rq2 = 1.f / (ssq * (1.f / QL) + EPS);
        const float rn = 1.f / sqrtf(ss * rq2 * (1.f / QKH) + EPS) * sqrtf(rq2);
#pragma unroll
        for (int d0 = 0; d0 < 8; ++d0) { const f32x4 g0 = *(const f32x4*)(T.q_g + d0 * 16 + hi * 8), g1 = *(const f32x4*)(T.q_g + d0 * 16 + hi * 8 + 4);
            u32x4 w; w.x = cvt_pk_bf16(bflo(raw[d0].x) * rn * g0[0], bfhi(raw[d0].x) * rn * g0[1]); w.y = cvt_pk_bf16(bflo(raw[d0].y) * rn * g0[2], bfhi(raw[d0].y) * rn * g0[3]);
            w.z = cvt_pk_bf16(bflo(raw[d0].z) * rn * g1[0], bfhi(raw[d0].z) * rn * g1[1]); w.w = cvt_pk_bf16(bflo(raw[d0].w) * rn * g1[2], bfhi(raw[d0].w) * rn * g1[3]);
            qr[d0] = *reinterpret_cast<bf16x8*>(&w); }
#pragma unroll
        for (int p = 0; p < 2; ++p) {
            const int ib = 16 * p + 8 * hi;
            float x1[8], x2[8];
            const f32x4 ga = *(const f32x4*)(T.q_g + 128 + ib), gb_ = *(const f32x4*)(T.q_g + 128 + ib + 4), gc = *(const f32x4*)(T.q_g + 160 + ib), gd = *(const f32x4*)(T.q_g + 160 + ib + 4);
            const float g1v[8] = {ga[0], ga[1], ga[2], ga[3], gb_[0], gb_[1], gb_[2], gb_[3]}, g2v[8] = {gc[0], gc[1], gc[2], gc[3], gd[0], gd[1], gd[2], gd[3]};
#pragma unroll
            for (int e = 0; e < 4; ++e) { x1[2 * e] = bflo(raw[8 + p][e]) * rn * g1v[2 * e]; x1[2 * e + 1] = bfhi(raw[8 + p][e]) * rn * g1v[2 * e + 1];
                                          x2[2 * e] = bflo(raw[10 + p][e]) * rn * g2v[2 * e]; x2[2 * e + 1] = bfhi(raw[10 + p][e]) * rn * g2v[2 * e + 1]; }
            float y1[8], y2[8];
#pragma unroll
            for (int jj = 0; jj < 4; ++jj) { const f32x4 c2 = *(const f32x4*)((const float*)T.cs + ((size_t)mrow * 32 + ib + 2 * jj) * 2);
                y1[2 * jj] = x1[2 * jj] * c2[0] - x2[2 * jj] * c2[1]; y2[2 * jj] = x2[2 * jj] * c2[0] + x1[2 * jj] * c2[1];
                y1[2 * jj + 1] = x1[2 * jj + 1] * c2[2] - x2[2 * jj + 1] * c2[3]; y2[2 * jj + 1] = x2[2 * jj + 1] * c2[2] + x1[2 * jj + 1] * c2[3]; }
            u32x4 w1, w2; w1.x = cvt_pk_bf16(y1[0], y1[1]); w1.y = cvt_pk_bf16(y1[2], y1[3]); w1.z = cvt_pk_bf16(y1[4], y1[5]); w1.w = cvt_pk_bf16(y1[6], y1[7]);
            w2.x = cvt_pk_bf16(y2[0], y2[1]); w2.y = cvt_pk_bf16(y2[2], y2[3]); w2.z = cvt_pk_bf16(y2[4], y2[5]); w2.w = cvt_pk_bf16(y2[6], y2[7]);
            *(LAS u32x4*)(qrope + p * 32) = w1; *(LAS u32x4*)(qrope + (2 + p) * 32) = w2; }
        asm volatile("s_waitcnt lgkmcnt(0)" ::: "memory");
    }
    float m_reg = -1e30f, l_reg = 0.f; f32x16 o[4] = {};
    f32x16 pA0, pA1, pB0, pB1; float alA = 1.f, alB = 1.f; bf16x8 pa0, pa1, pa2, pa3;
    const int NT = 4 * qb + 4; const int wp = wid >> 1;
    const bool a1 = wp >= 1, a2 = wp >= 2, a3 = wp >= 3;
    const LAS char* K0 = K_lds; const LAS char* K1 = K_lds + SHM_K;
    asm volatile("s_waitcnt vmcnt(0)" ::: "memory"); SWRITE(0); __syncthreads();
    qkt(pA0, pA1, K0, qr, qrope, r32, hi); partialSM(pA0, pA1, m_reg, alA);
    SLOAD(1); asm volatile("s_waitcnt vmcnt(0)" ::: "memory"); SWRITE(1); __syncthreads();
    for (int j = 1; j + 3 < NT; j += 2) {
        SBAR(); qkt(pB0, pB1, K1, qr, qrope, r32, hi);
        finishSM(pA0, pA1, alA, l_reg, pa0, pa1, pa2, pa3); SBAR();
        SLOAD(j + 1); SBAR();
        pv_d0(o, vb0, pa0, pa1, pa2, pa3); partialSM(pB0, pB1, m_reg, alB);
        __syncthreads(); asm volatile("s_waitcnt vmcnt(0)" ::: "memory"); SWRITE(0);
        RESC(alB); __syncthreads();
        SBAR(); qkt(pA0, pA1, K0, qr, qrope, r32, hi);
        finishSM(pB0, pB1, alB, l_reg, pa0, pa1, pa2, pa3); SBAR();
        SLOAD(j + 2); SBAR();
        pv_d0(o, vb0 + SHM_V, pa0, pa1, pa2, pa3); partialSM(pA0, pA1, m_reg, alA);
        __syncthreads(); asm volatile("s_waitcnt vmcnt(0)" ::: "memory"); SWRITE(1);
        RESC(alA); __syncthreads();
    }
#define MASK(P0, P1, act) do { if (!(act)) { _Pragma("unroll") for (int r = 0; r < 16; ++r) { P0[r] = -INFINITY; P1[r] = -INFINITY; } } } while (0)
    {
        SBAR(); if (a1) qkt(pB0, pB1, K1, qr, qrope, r32, hi); MASK(pB0, pB1, a1);
        finishSM(pA0, pA1, alA, l_reg, pa0, pa1, pa2, pa3); SBAR();
        SLOAD(NT - 2); SBAR();
        pv_d0(o, vb0, pa0, pa1, pa2, pa3); partialSM(pB0, pB1, m_reg, alB);
        __syncthreads(); asm volatile("s_waitcnt vmcnt(0)" ::: "memory"); SWRITE(0);
        RESC(alB); __syncthreads();
        SBAR(); if (a2) qkt(pA0, pA1, K0, qr, qrope, r32, hi); MASK(pA0, pA1, a2);
        finishSM(pB0, pB1, alB, l_reg, pa0, pa1, pa2, pa3); SBAR();
        SLOAD(NT - 1); SBAR();
        pv_d0(o, vb0 + SHM_V, pa0, pa1, pa2, pa3); partialSM(pA0, pA1, m_reg, alA);
        __syncthreads(); asm volatile("s_waitcnt vmcnt(0)" ::: "memory"); SWRITE(1);
        RESC(alA); __syncthreads();
        SBAR(); if (a3) qkt(pB0, pB1, K1, qr, qrope, r32, hi); MASK(pB0, pB1, a3);
        finishSM(pA0, pA1, alA, l_reg, pa0, pa1, pa2, pa3); SBAR();
        pv_d0(o, vb0, pa0, pa1, pa2, pa3); partialSM(pB0, pB1, m_reg, alB);
        RESC(alB);
        finishSM(pB0, pB1, alB, l_reg, pa0, pa1, pa2, pa3); SBAR();
        pv_d0(o, vb0 + SHM_V, pa0, pa1, pa2, pa3);
    }
#undef MASK
    if (hi == 0) li_l[r32] = l_reg; asm volatile("s_waitcnt lgkmcnt(0)" ::: "memory");
    float rli[16];
#pragma unroll
    for (int r = 0; r < 16; ++r) rli[r] = __builtin_amdgcn_rcpf(li_l[crow(r, hi)]);
    __syncthreads();
    LAS bf16_t* stg = (LAS bf16_t*)(lds + wid * 8192);
#pragma unroll
    for (int r = 0; r < 16; ++r) { const int orow = crow(r, hi);
#pragma unroll
        for (int d0 = 0; d0 < 4; ++d0) stg[orow * 128 + d0 * 32 + r32] = f2bf(o[d0][r] * rli[r]); }
    asm volatile("s_waitcnt lgkmcnt(0)" ::: "memory");
    if (MODE != 1) {
        const int ch = lane & 15, c = h * VH + ch * 8;
        const f32x4 w0a = *(const f32x4*)(T.conv_w + c), w0b = *(const f32x4*)(T.conv_w + c + 4), w1a = *(const f32x4*)(T.conv_w + DM + c), w1b = *(const f32x4*)(T.conv_w + DM + c + 4),
              w2a = *(const f32x4*)(T.conv_w + 2 * DM + c), w2b = *(const f32x4*)(T.conv_w + 2 * DM + c + 4);
        const float cw0[8] = {w0a[0], w0a[1], w0a[2], w0a[3], w0b[0], w0b[1], w0b[2], w0b[3]}, cw1[8] = {w1a[0], w1a[1], w1a[2], w1a[3], w1b[0], w1b[1], w1b[2], w1b[3]},
                    cw2[8] = {w2a[0], w2a[1], w2a[2], w2a[3], w2b[0], w2b[1], w2b[2], w2b[3]};
#pragma unroll 4
        for (int i = 0; i < 8; ++i) { const int row = i * 4 + (lane >> 4); const int tt = qb * 256 + wid * QBLK + row; const size_t e = (size_t)(b * SEQ + tt) * DM + c;
            const u32x4 ov = *(const LAS u32x4*)(stg + row * 128 + ch * 8);
            const u32x4 u0 = *(const u32x4*)(T.u + e), gbv = *(const u32x4*)(T.gb + e), sgv = *(const u32x4*)(T.sg + e);
            u32x4 u1 = {0u, 0u, 0u, 0u}, u2 = {0u, 0u, 0u, 0u};
            if (tt >= 1) u1 = *(const u32x4*)(T.u + e - DM);
            if (tt >= 2) u2 = *(const u32x4*)(T.u + e - 2 * DM);
            u32x4 res;
#pragma unroll
            for (int q = 0; q < 4; ++q) {
                const float cl = cw0[2 * q] * bflo(u2[q]) + cw1[2 * q] * bflo(u1[q]) + cw2[2 * q] * bflo(u0[q]), chh = cw0[2 * q + 1] * bfhi(u2[q]) + cw1[2 * q + 1] * bfhi(u1[q]) + cw2[2 * q + 1] * bfhi(u0[q]);
                res[q] = cvt_pk_bf16(bflo(gbv[q]) * cl + bflo(sgv[q]) * bflo(ov[q]), bfhi(gbv[q]) * chh + bfhi(sgv[q]) * bfhi(ov[q])); }
            *(u32x4*)(T.merged + e) = res; }
    }
    asm volatile("s_waitcnt lgkmcnt(0)" ::: "memory");
    __syncthreads();
#undef SLOAD
#undef SWRITE
#undef RESC
}
#undef SBAR
}
struct Frame {
    LAS unsigned char* lds; volatile LAS unsigned* MISC; unsigned* ctl;
    int tid, lane, wave, vcu, G;
};
__device__ __forceinline__ float wave_sum(float v) {
#pragma unroll
    for (int o = 1; o < 64; o <<= 1) v += __shfl_xor(v, o);
    return v;
}
__device__ __forceinline__ int tcc(int bj, int ch128) { return (bj << 7) | (ch128 & 0x60) | (((ch128 >> 2) & 1) << 4) | (((ch128 >> 3) & 3) << 2) | (ch128 & 3); }
struct MapIn { __device__ __forceinline__ int operator()(int c) const {
    if (c < C_ZB) return 256 * (c >> 7) + tcc(0, c & 127);
    if (c < C_ZC) { const int ch = c - C_ZB; return 256 * (8 + (ch >> 7)) + tcc(0, ch & 127); }
    if (c < C_QL) { const int ch = c - C_ZC; return 256 * (ch >> 7) + tcc(1, ch & 127); }
    if (c < C_KVL) { const int j = c - C_QL; return j < 256 ? 256 * 20 + permL(j) : 256 * 21 + permL(j - 256); }
    if (c < C_KR) return 256 * 22 + permL(c - C_KVL);
    if (c < C_GC) { const int j = c - C_KR, jj = j & 31; return 256 * 21 + 128 + ((jj >> 4) << 5) + ((j >> 5) << 4) + (((jj >> 2) & 3) << 2) + (jj & 3); }
    if (c < C_GM) { const int ch = c - C_GC; return 256 * (8 + (ch >> 7)) + tcc(1, ch & 127); }
    { const int j = c - C_GM; return 256 * (16 + (j >> 8)) + permL(j & 255); } } };
struct MapPerm { __device__ __forceinline__ int operator()(int c) const { return (c & ~255) | permL(c & 255); } };
struct MapId { __device__ __forceinline__ int operator()(int c) const { return c; } };
struct MapGU { int n; __device__ __forceinline__ int operator()(int f) const { const int r = f & 127; return 256 * (f >> 7) + ((((r >> 2) & 1) << 7) | ((r >> 5) << 5) | (n << 4) | (((r >> 3) & 3) << 2) | (r & 3)); } };

template <class RowMap>
__device__ __forceinline__ void transpose_item(const float* W, int N, bf16_t* WT, int ldt, const float* kscale, LAS float* scr, int item, int lane, const RowMap& rm) {
    const int nblk = N / 32, kb = item / nblk, nb = item % nblk, k0 = 64 * kb, n0 = 32 * nb;
#pragma unroll 8
    for (int i = 0; i < 32; ++i) { const int kk = 2 * i + (lane >> 5); const float sc = kscale ? kscale[k0 + kk] : 1.f; scr[kk * 33 + (lane & 31)] = W[(size_t)(k0 + kk) * N + n0 + (lane & 31)] * sc; }
    asm volatile("s_waitcnt lgkmcnt(0)" ::: "memory");
    const int c = lane & 7;
#pragma unroll
    for (int j = 0; j < 4; ++j) { const int n = (lane >> 3) + 8 * j; const LAS float* s = scr + (8 * c) * 33 + n;
        u32x4 o; o.x = cvt_pk_bf16(s[0 * 33], s[1 * 33]); o.y = cvt_pk_bf16(s[2 * 33], s[3 * 33]); o.z = cvt_pk_bf16(s[4 * 33], s[5 * 33]); o.w = cvt_pk_bf16(s[6 * 33], s[7 * 33]);
        *(u32x4*)(WT + (size_t)rm(n0 + n) * ldt + k0 + 8 * c) = o; }
    asm volatile("s_waitcnt lgkmcnt(0)" ::: "memory");
}
constexpr size_t WS_WIN = WS_WSMALL, WS_WQ = WS_WIN + (size_t)5888 * 1024 * 2, WS_WKV = WS_WQ + (size_t)1536 * 384 * 2, WS_WO = WS_WKV + (size_t)2048 * 256 * 2;
static_assert(WS_WO + (size_t)1024 * 1024 * 2 <= WS_A, "small weights fit below region A");
constexpr size_t WS_EGU = WS_C, WS_EDN = WS_C + (size_t)NEXP * 512 * 1024 * 2;
static_assert(WS_EDN + (size_t)NEXP * 1024 * 256 * 2 <= WS_D, "expert weights fit region C");

__device__ __forceinline__ void p0_weights_tables(const Ptrs& P, Frame& F) {
    LAS float* scr = (LAS float*)(F.lds + RING_OFF + F.wave * 16384);
    const int gw = F.vcu * NWAVES + F.wave, NGW = F.G * NWAVES;
    constexpr int I_IN = (DM / 64) * (DIN / 32), I_Q = (QL / 64) * (1536 / 32), I_KV = (KVL / 64) * (2048 / 32), I_O = (DM / 64) * (DM / 32);
    for (int it = gw; it < I_IN + I_Q + I_KV + I_O; it += NGW) {
        int r = it;
        if (r < I_IN) { transpose_item(P.w_in, DIN, (bf16_t*)(P.ws + WS_WIN), DM, (const float*)nullptr, scr, r, F.lane, MapIn{}); continue; } r -= I_IN;
        if (r < I_Q) { transpose_item(P.w_q_b, 1536, (bf16_t*)(P.ws + WS_WQ), QL, P.q_a_g, scr, r, F.lane, MapPerm{}); continue; } r -= I_Q;
        if (r < I_KV) { transpose_item(P.w_kv_b, 2048, (bf16_t*)(P.ws + WS_WKV), KVL, P.kv_a_g, scr, r, F.lane, MapPerm{}); continue; } r -= I_KV;
        transpose_item(P.w_o, DM, (bf16_t*)(P.ws + WS_WO), DM, (const float*)nullptr, scr, r, F.lane, MapPerm{});
    }
    {
        const int gt = F.vcu * 512 + F.tid;
        if (gt < 64 * 128) { const int rr = 192 + (gt >> 7), ch = gt & 127; *(u32x4*)((bf16_t*)(P.ws + WS_WIN) + (size_t)(256 * 21 + rr) * DM + ch * 8) = (u32x4){0u, 0u, 0u, 0u}; } }
    {
        float2* cs = (float2*)(P.ws + WS_CS);
        for (int idx = F.vcu * 512 + F.tid; idx < M * 32; idx += F.G * 512) { const int m = idx >> 5, i = idx & 31;
            const double inv = exp2(-(double)(2 * i) * (13.287712379549449 / 64.0));
            const double ang = (double)P.pos[m] * inv; float2 v; v.x = (float)cos(ang); v.y = (float)sin(ang); cs[idx] = v; } }
    asm volatile("s_waitcnt vmcnt(0) lgkmcnt(0)" ::: "memory"); __syncthreads();
}
__device__ __forceinline__ void p0_mod(const Ptrs& P, Frame& F) {
    if (F.vcu < 192) {
        LAS float* cact = (LAS float*)(F.lds + RING_OFF); LAS float* red = (LAS float*)(F.lds + RING_OFF + 65536);
        for (int idx = F.tid; idx < BATCH * DM; idx += 512) { const float cv = P.c[idx]; cact[idx] = cv / (1.f + __expf(-cv)); }
        __syncthreads();
        const int n0 = 32 * F.vcu, kl = F.lane >> 3, c4 = F.lane & 7;
        f32x4 acc[16];
#pragma unroll
        for (int b = 0; b < 16; ++b) acc[b] = (f32x4){0.f, 0.f, 0.f, 0.f};
        for (int it = 0; it < 16; ++it) { const int k = 128 * F.wave + 8 * it + kl;
            const f32x4 wv = *(const f32x4*)(P.w_ada + (size_t)k * 6144 + n0 + 4 * c4);
#pragma unroll
            for (int b = 0; b < 16; ++b) acc[b] += cact[b * DM + k] * wv; }
#pragma unroll
        for (int b = 0; b < 16; ++b)
#pragma unroll
            for (int e = 0; e < 4; ++e) { float v = acc[b][e]; v += __shfl_xor(v, 8); v += __shfl_xor(v, 16); v += __shfl_xor(v, 32); if (kl == 0) red[(F.wave * 16 + b) * 32 + 4 * c4 + e] = v; }
        __syncthreads();
        { const int b = F.tid >> 5, cc = F.tid & 31; float s = P.b_ada[n0 + cc];
#pragma unroll
          for (int w = 0; w < 8; ++w) s += red[(w * 16 + b) * 32 + cc];
          ((float*)(P.ws + WS_MOD))[b * 6144 + n0 + cc] = s; }
        __syncthreads();
    }
}
__device__ __forceinline__ void expert_weight_items(const Ptrs& P, Frame& F, int w, int nw, int k_lo, int k_hi) {
    LAS float* scr = (LAS float*)(F.lds + RING_OFF + F.wave * 16384);
    constexpr int I_G = (DM / 64) * (DEXP / 32), I_D = (DEXP / 64) * (DM / 32);
    for (int k = k_lo; k < k_hi; ++k) { const int it = w + k * nw; if (it >= NEXP * (2 * I_G + I_D)) break;
        const int e = it / (2 * I_G + I_D); int r = it % (2 * I_G + I_D);
        bf16_t* gu = (bf16_t*)(P.ws + WS_EGU) + (size_t)e * 512 * DM; bf16_t* dn = (bf16_t*)(P.ws + WS_EDN) + (size_t)e * DM * DEXP;
        if (r < I_G) { transpose_item(P.w_gate + (size_t)e * DM * DEXP, DEXP, gu, DM, (const float*)nullptr, scr, r, F.lane, MapGU{0}); continue; } r -= I_G;
        if (r < I_G) { transpose_item(P.w_up + (size_t)e * DM * DEXP, DEXP, gu, DM, (const float*)nullptr, scr, r, F.lane, MapGU{1}); continue; } r -= I_G;
        transpose_item(P.w_down + (size_t)e * DEXP * DM, DM, dn, DEXP, (const float*)nullptr, scr, r, F.lane, MapPerm{});
    }
}
__device__ __forceinline__ void p1_norm1(const Ptrs& P, Frame& F) {
    const int gw = F.vcu * NWAVES + F.wave, NGW = F.G * NWAVES;
    bf16_t* h = (bf16_t*)(P.ws + WS_A);
    for (int m = gw; m < M; m += NGW) {
        const float* mod = (const float*)(P.ws + WS_MOD) + (m / SEQ) * 6144;
        const f32x4* xr = (const f32x4*)(P.x + (size_t)m * DM) + F.lane;
        f32x4 v[4]; float s = 0.f;
#pragma unroll
        for (int j = 0; j < 4; ++j) { v[j] = xr[64 * j]; s += (v[j][0] * v[j][0] + v[j][1] * v[j][1]) + (v[j][2] * v[j][2] + v[j][3] * v[j][3]); }
        const float rstd = 1.f / sqrtf(wave_sum(s) * (1.f / DM) + EPS);
        unsigned long long* o8 = (unsigned long long*)(h + (size_t)m * DM) + F.lane;
#pragma unroll
        for (int j = 0; j < 4; ++j) { const int d = 4 * F.lane + 256 * j;
            const f32x4 g = *(const f32x4*)(P.norm1_g + d), sc = *(const f32x4*)(mod + 1024 + d), sh = *(const f32x4*)(mod + d);
            const f32x4 r = v[j] * rstd * g * (sc + 1.f) + sh;
            o8[64 * j] = (unsigned long long)cvt_pk_bf16(r[0], r[1]) | ((unsigned long long)cvt_pk_bf16(r[2], r[3]) << 32); }
    }
}

constexpr size_t WS_WR = 30 * MiB;
constexpr size_t WS_STOK = WS_RT + 512 * 1024, WS_SW = WS_STOK + 320 * 1024;
constexpr int MAXROWS = 81920, MAXTILES = 320;
constexpr size_t WS_H2 = WS_B, WS_HACT = WS_B + 64 * MiB;
constexpr size_t WS_X1B = WS_B + 128 * MiB;
constexpr size_t WS_DELTA = WS_D, WS_Y0 = WS_A, WS_Y1 = WS_D + 64 * MiB;
constexpr int CW_T = CW_TILES, CW_T0 = CW_TILES + 1, CW_TGRP = CW_TILES + 64;

__device__ __forceinline__ void p0_router_weights(const Ptrs& P, Frame& F) {
    bf16_t* hi = (bf16_t*)(P.ws + WS_WR); bf16_t* lo = hi + 48 * DM;
    for (int idx = F.vcu * 512 + F.tid; idx < 48 * DM; idx += F.G * 512) { const int o = idx >> 10, k = idx & 1023;
        const float v = o < 4 ? P.w_rg[k * 4 + o] : (o < 36 ? P.w_re[k * 32 + o - 4] : 0.f);
        const bf16_t h = f2bf(v); hi[idx] = h; lo[idx] = f2bf(v - bf2f(h)); }
}
template <int MODE> __device__ __forceinline__ void p6_rows(const Ptrs& P, Frame& F) {
    LAS unsigned char* tile = F.lds + RING_OFF + F.wave * 8192;
    LAS float* lg = (LAS float*)(F.lds + RING_OFF + 65536 + F.wave * 1536);
    LAS unsigned char* wch = F.lds + RING_OFF + 77824;
    LAS float* gms = (LAS float*)(F.lds + XCH_OFF);
    LAS unsigned* hist = (LAS unsigned*)(F.lds + LDSCTL_OFF + 1024);
    const bf16_t* WrHi = (const bf16_t*)(P.ws + WS_WR); const bf16_t* WrLo = WrHi + 48 * DM;
    bf16_t* h2 = (bf16_t*)(P.ws + WS_H2); const bf16_t* dl = (const bf16_t*)(P.ws + WS_DELTA); bf16_t* x1b = (bf16_t*)(P.ws + WS_X1B);
    int2* rte = (int2*)(P.ws + WS_RT); float2* rtw = (float2*)(P.ws + WS_RT + 256 * 1024);
    const int t = F.lane & 15, q = F.lane >> 4;
    for (int rb = F.vcu; rb < M / 128; rb += F.G) {
        const int m0 = rb * 128 + F.wave * 16, b = m0 / SEQ;
        const float* mod = (const float*)(P.ws + WS_MOD) + b * 6144;
        __syncthreads();
        if (F.tid < 64) hist[F.tid] = 0u;
        for (int k = F.tid; k < DM; k += 512) { gms[k] = P.norm2_g[k] * (1.f + mod[4096 + k]); gms[DM + k] = mod[3072 + k]; }
        __syncthreads();
#pragma unroll 1
        for (int hb = 0; hb < 2; ++hb) {
            const int mb = m0 + 8 * hb;
            f32x4 xv[8][4]; float rstd[8];
#pragma unroll
            for (int r = 0; r < 8; ++r) { const f32x4* xr = (const f32x4*)(P.x + (size_t)(mb + r) * DM) + F.lane; const u32x2* dr = (const u32x2*)(dl + (size_t)(mb + r) * DM) + F.lane;
#pragma unroll
                for (int c = 0; c < 4; ++c) { const f32x4 x4 = xr[64 * c]; const u32x2 d = dr[64 * c];
                    xv[r][c][0] = x4[0] + __uint_as_float(d.x << 16); xv[r][c][1] = x4[1] + __uint_as_float(d.x & 0xffff0000u); xv[r][c][2] = x4[2] + __uint_as_float(d.y << 16); xv[r][c][3] = x4[3] + __uint_as_float(d.y & 0xffff0000u); } }
#pragma unroll
            for (int r = 0; r < 8; ++r) { float s = 0.f;
#pragma unroll
                for (int c = 0; c < 4; ++c) s += (xv[r][c][0] * xv[r][c][0] + xv[r][c][1] * xv[r][c][1]) + (xv[r][c][2] * xv[r][c][2] + xv[r][c][3] * xv[r][c][3]);
                rstd[r] = 1.f / sqrtf(wave_sum(s) * (1.f / DM) + EPS); }
            f32x4 acc[3];
#pragma unroll
            for (int cb = 0; cb < 3; ++cb) acc[cb] = (f32x4){0.f, 0.f, 0.f, 0.f};
#pragma unroll
            for (int c = 0; c < 4; ++c) {
                const int k0 = 256 * c + 4 * F.lane;
                __syncthreads();
#pragma unroll
                for (int j = 0; j < 6; ++j) { const int id = F.tid + 512 * j, arr = id / 1536, rem = id - arr * 1536, row = rem >> 5, ch = rem & 31;
                    *(LAS u32x4*)(wch + arr * 24576 + row * 512 + ((ch ^ (row & 15)) << 4)) = *(const u32x4*)((arr ? WrLo : WrHi) + (size_t)row * DM + 256 * c + 8 * ch); }
                const f32x4 gm = *(const LAS f32x4*)(gms + k0), sh = *(const LAS f32x4*)(gms + DM + k0);
#pragma unroll
                for (int r = 0; r < 8; ++r) { const f32x4 h = xv[r][c] * rstd[r] * gm + sh;
                    u32x2 hi; hi.x = cvt_pk_bf16(h[0], h[1]); hi.y = cvt_pk_bf16(h[2], h[3]);
                    u32x2 lo; lo.x = cvt_pk_bf16(h[0] - __uint_as_float(hi.x << 16), h[1] - __uint_as_float(hi.x & 0xffff0000u)); lo.y = cvt_pk_bf16(h[2] - __uint_as_float(hi.y << 16), h[3] - __uint_as_float(hi.y & 0xffff0000u));
                    *(u32x2*)(h2 + (size_t)(mb + r) * DM + k0) = hi;
                    const int off = r * 512 + ((((F.lane >> 1) ^ r) & 31) << 4) + ((F.lane & 1) << 3);
                    *(LAS u32x2*)(tile + off) = hi; *(LAS u32x2*)(tile + 4096 + off) = lo; }
                asm volatile("s_waitcnt vmcnt(0) lgkmcnt(0)" ::: "memory");
                __syncthreads();
#pragma unroll 2
                for (int ks = 0; ks < (MODE == 1 ? 0 : 8); ++ks) { const int tr = t & 7;
                    const int off = tr * 512 + ((((4 * ks + q) ^ tr) & 31) << 4);
                    const bf16x8 bh = *(const LAS bf16x8*)(tile + off), bl = *(const LAS bf16x8*)(tile + 4096 + off);
#pragma unroll
                    for (int cb = 0; cb < 3; ++cb) { const int woff = (16 * cb + t) * 512 + ((((4 * ks + q) ^ t) & 31) << 4);
                        const bf16x8 wh = *(const LAS bf16x8*)(wch + woff), wl = *(const LAS bf16x8*)(wch + 24576 + woff);
                        acc[cb] = __builtin_amdgcn_mfma_f32_16x16x32_bf16(wh, bh, acc[cb], 0, 0, 0);
                        acc[cb] = __builtin_amdgcn_mfma_f32_16x16x32_bf16(wh, bl, acc[cb], 0, 0, 0);
                        acc[cb] = __builtin_amdgcn_mfma_f32_16x16x32_bf16(wl, bh, acc[cb], 0, 0, 0); } }
                asm volatile("s_waitcnt lgkmcnt(0)" ::: "memory");
            }
            if (t < 8) {
#pragma unroll
                for (int cb = 0; cb < 3; ++cb)
#pragma unroll
                    for (int r = 0; r < 4; ++r) lg[t * 48 + 16 * cb + 4 * q + r] = acc[cb][r]; }
            asm volatile("s_waitcnt lgkmcnt(0)" ::: "memory");
            if (MODE != 1 && q == 0 && t < 8) {
                const int m = mb + t;
                const LAS float* l = lg + t * 48;
                float gl[4];
#pragma unroll
                for (int i = 0; i < 4; ++i) gl[i] = l[i] + P.b_rg[i];
                int g = 0; float gmx = gl[0];
#pragma unroll
                for (int i = 1; i < 4; ++i) if (gl[i] > gmx) { gmx = gl[i]; g = i; }
                float se = 0.f;
#pragma unroll
                for (int i = 0; i < 4; ++i) se += __expf(gl[i] - gmx);
                const float pg = 1.f / se;
                float e0v = -3.0e38f, e1v = -3.0e38f; int i0 = 0, i1 = 0;
#pragma unroll
                for (int i = 0; i < 8; ++i) { const float v = l[4 + g * 8 + i] + P.b_re[g * 8 + i];
                    if (v > e0v) { e1v = e0v; i1 = i0; e0v = v; i0 = i; } else if (v > e1v) { e1v = v; i1 = i; } }
                const float p1 = __expf(e1v - e0v), w0 = 1.f / (1.f + p1), w1 = p1 * w0;
                int2 e; e.x = g * 8 + i0; e.y = g * 8 + i1; float2 w; w.x = w0 * pg; w.y = w1 * pg;
                rte[m] = e; rtw[m] = w;
                __hip_atomic_fetch_add(&hist[e.x], 1u, __ATOMIC_RELAXED, __HIP_MEMORY_SCOPE_WORKGROUP); __hip_atomic_fetch_add(&hist[32 + e.y], 1u, __ATOMIC_RELAXED, __HIP_MEMORY_SCOPE_WORKGROUP);
            }
            asm volatile("s_waitcnt lgkmcnt(0)" ::: "memory");
        }
        __syncthreads();
        if (MODE != 1 && F.tid < 64) F.ctl[CW_HIST + rb * 64 + F.tid] = hist[F.tid];
    }
    __syncthreads();
}
__device__ __forceinline__ void p7_sort(const Ptrs& P, Frame& F) {
    LAS unsigned* tot = (LAS unsigned*)(F.lds + RING_OFF);
    LAS unsigned* pre = tot + 64;
    LAS unsigned* rbase = pre + 64;
    LAS unsigned* cnt = rbase + 64;
    LAS unsigned* misc = cnt + 64;
    int* stok = (int*)(P.ws + WS_STOK); float* sw = (float*)(P.ws + WS_SW);
    const int2* rte = (const int2*)(P.ws + WS_RT); const float2* rtw = (const float2*)(P.ws + WS_RT + 256 * 1024);
    const int cw = F.vcu * 7 + F.wave - 1, cnw = F.G * 7; bool first = true;
    for (int rb = F.vcu; rb < M / 128; rb += F.G) {
        __syncthreads();
        if (first && F.wave > 0) expert_weight_items(P, F, cw, cnw, 0, 2);
        if (F.tid < 64) { unsigned s = 0u, p = 0u;
            for (int r2 = 0; r2 < M / 128; ++r2) { const unsigned v = F.ctl[CW_HIST + r2 * 64 + F.tid]; if (r2 == rb) p = s; s += v; }
            tot[F.tid] = s; pre[F.tid] = p; cnt[F.tid] = 0u; }
        __syncthreads();
        if (first && F.wave > 0) expert_weight_items(P, F, cw, cnw, 2, 4);
        if (F.tid == 0) { unsigned tb = 0u;
            for (int g = 0; g < 64; ++g) { if (g == 32) misc[1] = tb; rbase[g] = tb * 256u; const unsigned nt = (tot[g] + 255u) >> 8;
                if (rb == 0) for (unsigned k = 0; k < nt; ++k) F.ctl[CW_TGRP + tb + k] = (unsigned)g;
                tb += nt; }
            misc[0] = tb; if (rb == 0) { F.ctl[CW_T] = tb; F.ctl[CW_T0] = misc[1]; } }
        __syncthreads();
        if (F.wave == 0) {
            const unsigned long long ltmask = (1ull << F.lane) - 1ull;
            for (int ch = 0; ch < 2; ++ch) { const int m = rb * 128 + ch * 64 + F.lane; const int2 e = rte[m]; const float2 w = rtw[m];
                for (int j = 0; j < 2; ++j) { const int ex = j ? e.y : e.x; const float wj = j ? w.y : w.x; unsigned rank = 0u, gsz = 0u;
                    for (int x = 0; x < 32; ++x) { const unsigned long long mk = __ballot(ex == x); if (ex == x) { rank = (unsigned)__popcll(mk & ltmask); gsz = (unsigned)__popcll(mk); } }
                    const int g = j * 32 + ex; const unsigned pos = rbase[g] + pre[g] + cnt[g] + rank;
                    stok[pos] = m; sw[pos] = wj;
                    asm volatile("s_waitcnt lgkmcnt(0)" ::: "memory");
                    if (rank == 0u) cnt[g] += gsz;
                    asm volatile("s_waitcnt lgkmcnt(0)" ::: "memory"); } } }
        if (rb < 64) { const unsigned n = tot[rb], padn = (((n + 255u) >> 8) << 8) - n;
            if ((unsigned)F.tid < padn) { stok[rbase[rb] + n + F.tid] = -1; sw[rbase[rb] + n + F.tid] = 0.f; } }
        if (first && F.wave > 0) expert_weight_items(P, F, cw, cnw, 4, 1 << 20);
        first = false;
    }
}
struct MoeSched {
    const bf16_t* A; const bf16_t* W; int lda, ldb; const int* stok; const unsigned* tgrp; int t_lo, nun, npn, G, c; size_t wstride; bool gather, split;
    __device__ bool next(int i, Unit& u) const {
        const int idx = i * G + c, nfull = (nun / G) * G, tail = nun - nfull; int U; u.half = 0;
        if (split && tail > 0 && 2 * tail <= G) { if (idx >= nfull + 2 * tail) return false; if (idx < nfull) U = idx; else { U = nfull + ((idx - nfull) >> 1); u.half = 1 + ((idx - nfull) & 1); } }
        else { if (idx >= nun) return false; U = idx; }
        u.aux = t_lo + U / npn; u.pn = U % npn; u.pm = (int)tgrp[u.aux]; return true; }
    __device__ __forceinline__ const char* abase(const Unit& u) const { return gather ? (const char*)A : (const char*)A + (size_t)(u.aux * BM + (u.half == 2 ? HALF : 0)) * lda * 2; }
    __device__ __forceinline__ const char* bbase(const Unit& u) const { return (const char*)W + (size_t)(u.pm & 31) * wstride + (size_t)u.pn * BM * ldb * 2; }
    __device__ __forceinline__ void avoff(const Unit& u, int R0, int C0, int R1, int C1, unsigned (&v0)[2], unsigned (&v1)[2]) const {
        if (gather) { const int* tk = stok + u.aux * BM + (u.half == 2 ? HALF : 0); const int o1 = u.half ? 0 : HALF; int a = tk[R0], b = tk[R1], c2 = tk[o1 + R0], d = tk[o1 + R1];
            a = a < 0 ? 0 : a; b = b < 0 ? 0 : b; c2 = c2 < 0 ? 0 : c2; d = d < 0 ? 0 : d;
            v0[0] = (unsigned)(a * lda + C0) * 2u; v0[1] = (unsigned)(b * lda + C1) * 2u; v1[0] = (unsigned)(c2 * lda + C0) * 2u; v1[1] = (unsigned)(d * lda + C1) * 2u; }
        else { v0[0] = (unsigned)(R0 * lda + C0) * 2u; v0[1] = (unsigned)(R1 * lda + C1) * 2u; const unsigned h1 = u.half ? 0u : (unsigned)(HALF * lda * 2); v1[0] = v0[0] + h1; v1[1] = v0[1] + h1; } }
};
struct EpiGU {
    bf16_t* hact; const float* sw;
    __device__ __forceinline__ void operator()(const f32x4 (&acc)[2][2][4][2], const Unit& un, int wr, int wc, int fr, int fq) const {
        asm volatile("" : "+v"(fr), "+v"(fq));
        const int r0 = un.aux * BM + (un.half == 2 ? HALF : 0) + wr * 64 + fr, c0 = 128 * un.pn + 32 * wc + 8 * fq;
#pragma unroll
        for (int ai = 0; ai < 2; ++ai)
#pragma unroll
            for (int m = 0; m < 4; ++m) { if (ai == 1 && un.half) continue; const int row = r0 + ai * HALF + m * 16; const float w = sw[row];
                f32x4 a, b;
#pragma unroll
                for (int i = 0; i < 4; ++i) { const float g0 = acc[ai][0][m][0][i], g1 = acc[ai][1][m][0][i];
                    a[i] = g0 * fsigmoid(g0) * acc[ai][0][m][1][i] * w; b[i] = g1 * fsigmoid(g1) * acc[ai][1][m][1][i] * w; }
                *(u32x4*)(hact + (size_t)row * DEXP + c0) = pack8(a, b); }
    }
};
struct EpiDown {
    bf16_t* y0; bf16_t* y1; const int* stok;
    __device__ __forceinline__ void operator()(const f32x4 (&acc)[2][2][4][2], const Unit& un, int wr, int wc, int fr, int fq) const {
        asm volatile("" : "+v"(fr), "+v"(fq));
        const int r0 = un.aux * BM + wr * 64 + fr, c0 = 256 * un.pn + 32 * wc + 8 * fq;
        bf16_t* y = (un.pm >> 5) ? y1 : y0;
#pragma unroll
        for (int ai = 0; ai < 2; ++ai)
#pragma unroll
            for (int m = 0; m < 4; ++m) { const int tok = stok[r0 + ai * HALF + m * 16];
                if (tok >= 0) { bf16_t* orow = y + (size_t)tok * DM + c0;
                    *(u32x4*)(orow) = pack8(acc[ai][0][m][0], acc[ai][0][m][1]); *(u32x4*)(orow + HALF) = pack8(acc[ai][1][m][0], acc[ai][1][m][1]); } }
    }
};
__device__ __forceinline__ void p10_combine(const Ptrs& P, Frame& F) {
    const int gw = F.vcu * NWAVES + F.wave, NGW = F.G * NWAVES;
    const bf16_t* dl = (const bf16_t*)(P.ws + WS_DELTA); const bf16_t* y0 = (const bf16_t*)(P.ws + WS_Y0); const bf16_t* y1 = (const bf16_t*)(P.ws + WS_Y1);
    for (int m = gw; m < M; m += NGW) {
        const float* gate = (const float*)(P.ws + WS_MOD) + (m / SEQ) * 6144 + 5120;
        const f32x4* xr = (const f32x4*)(P.x + (size_t)m * DM) + F.lane; f32x4* orow = (f32x4*)(P.out + (size_t)m * DM) + F.lane;
        const u32x2* dr = (const u32x2*)(dl + (size_t)m * DM) + F.lane; const u32x2* a0 = (const u32x2*)(y0 + (size_t)m * DM) + F.lane; const u32x2* a1 = (const u32x2*)(y1 + (size_t)m * DM) + F.lane;
#pragma unroll
        for (int j = 0; j < 4; ++j) { const f32x4 xv = xr[64 * j]; const u32x2 d = dr[64 * j], p = a0[64 * j], q = a1[64 * j]; const f32x4 g = *(const f32x4*)(gate + 4 * F.lane + 256 * j);
            f32x4 o;
            o[0] = xv[0] + __uint_as_float(d.x << 16) + g[0] * (__uint_as_float(p.x << 16) + __uint_as_float(q.x << 16));
            o[1] = xv[1] + __uint_as_float(d.x & 0xffff0000u) + g[1] * (__uint_as_float(p.x & 0xffff0000u) + __uint_as_float(q.x & 0xffff0000u));
            o[2] = xv[2] + __uint_as_float(d.y << 16) + g[2] * (__uint_as_float(p.y << 16) + __uint_as_float(q.y << 16));
            o[3] = xv[3] + __uint_as_float(d.y & 0xffff0000u) + g[3] * (__uint_as_float(p.y & 0xffff0000u) + __uint_as_float(q.y & 0xffff0000u));
            orow[64 * j] = o; }
    }
}
struct Args { Ptrs P; int ph_lo, ph_hi, li, pad; };
constexpr int N_PHASES = 11;

typedef const __attribute__((address_space(4))) Args* KArgs;
__device__ __forceinline__ KArgs kargs() {
#if defined(__HIP_DEVICE_COMPILE__)
    unsigned off = 0u; asm volatile("" : "+s"(off));
    return (KArgs)((const __attribute__((address_space(4))) char*)__builtin_amdgcn_kernarg_segment_ptr() + off);
#else
    return nullptr;
#endif
}
__device__ __forceinline__ Ptrs load_ptrs() {
    Ptrs P{};
#if defined(__HIP_DEVICE_COMPILE__)
    const __attribute__((address_space(4))) unsigned long long* src = (const __attribute__((address_space(4))) unsigned long long*)kargs();
    unsigned long long w[sizeof(Ptrs) / 8];
#pragma unroll
    for (unsigned i = 0; i < sizeof(Ptrs) / 8; ++i) w[i] = src[i];
    __builtin_memcpy(&P, w, sizeof(Ptrs));
#endif
    return P;
}
#define WSPTRS \
    unsigned char* ws = P.ws; bf16_t* hA = (bf16_t*)(ws + WS_A); bf16_t* uB = (bf16_t*)(ws + WS_B); bf16_t* gbB = uB + (size_t)M * DM; bf16_t* sgB = gbB + (size_t)M * DM; \
    bf16_t* latC = (bf16_t*)(ws + WS_C); bf16_t* Kd = (bf16_t*)(ws + WS_D); bf16_t* Vd = (bf16_t*)(ws + WS_D + 96 * MiB); bf16_t* Qo = (bf16_t*)P.out; \
    float* ssp = (float*)(ws + WS_SSP); const float2* cs = (const float2*)(ws + WS_CS); const float* mod = (const float*)(ws + WS_MOD); \
    const int* stok = (const int*)(ws + WS_STOK); const float* sw = (const float*)(ws + WS_SW); bf16_t* h2 = (bf16_t*)(ws + WS_H2); bf16_t* hact = (bf16_t*)(ws + WS_HACT); \
    (void)hA; (void)uB; (void)gbB; (void)sgB; (void)latC; (void)Kd; (void)Vd; (void)Qo; (void)ssp; (void)cs; (void)mod; (void)stok; (void)sw; (void)h2; (void)hact;

__global__ void __launch_bounds__(NWAVES * 64, 2) fwd(Args args_unused) {
    extern __shared__ __attribute__((aligned(16))) unsigned char lds_raw[];
    Frame F;
    F.lds = (LAS unsigned char*)lds_raw;
    F.MISC = (volatile LAS unsigned*)(F.lds + MISC_OFF);
    F.tid = threadIdx.x; F.lane = F.tid & 63; F.wave = __builtin_amdgcn_readfirstlane(F.tid >> 6);
    F.G = gridDim.x; { const int bx = blockIdx.x; F.vcu = (F.G % 8 == 0) ? (bx % 8) * (F.G / 8) + bx / 8 : bx; }
    F.ctl = (unsigned*)(args_unused.P.ws + WS_CTL);
    for (int u = F.tid; u < (LDS_BYTES - LDSCTL_OFF) / 4; u += NWAVES * 64) ((LAS unsigned*)(F.lds + LDSCTL_OFF))[u] = 0u;
    __syncthreads();
    const int lo = args_unused.ph_lo, hi = args_unused.ph_hi;
    XcdBarrier bar; bar.bar = F.ctl + CW_BAR + args_unused.li * XCD_BAR_WORDS; bar.x = 0; bar.st = nullptr;
    if (hi - lo > 1) bar = xcd_barrier_post(F.ctl + CW_BAR + args_unused.li * XCD_BAR_WORDS, F.MISC + 8);
#ifdef ONLY_PHASE
#define IN(k) ((k) == ONLY_PHASE && lo <= (k) && (k) < hi)
#else
#define IN(k) (lo <= (k) && (k) < hi)
#endif
#ifndef PROBE_REPEAT
#define PROBE_REPEAT -1
#endif
#define REPS(k) for (int rep_ = 0; rep_ < ((k) == PROBE_REPEAT ? 2 : 1); ++rep_)
#define SEAM(k) do { if (IN(k) && IN((k) + 1)) xcd_barrier(bar); } while (0)

    if (IN(0)) { const Ptrs P = args_unused.P; REPS(0) { p0_router_weights(P, F); p0_mod(P, F); } SEAM(0); }
    if (IN(1)) { const Ptrs P = args_unused.P; REPS(1) { p1_norm1(P, F); p0_weights_tables(P, F); } SEAM(1); }
    if (IN(2)) {
        const Ptrs P = args_unused.P; WSPTRS
        DenseSched S; S.init(hA, DM, (const bf16_t*)(ws + WS_WIN), DM, M, 5888, F.G, (int)blockIdx.x, true, true);
        EpiIn E{uB, gbB, sgB, latC, ssp, cs, P.k_g, (LAS float*)(F.lds + XCH_OFF)};
        gemm_phase<false>(F.lds + RING_OFF, DM, S, E);
        if (PROBE_REPEAT == 2) gemm_phase<false>(F.lds + RING_OFF, DM, S, E);
        SEAM(2);
    }
    if (IN(3)) {
        const Ptrs P = args_unused.P; WSPTRS
        { DenseSched S; S.init(latC, LATW, (const bf16_t*)(ws + WS_WQ), QL, M, 1536, F.G, (int)blockIdx.x);
          EpiPlain E{Qo, 1536, 255};
          gemm_phase<false>(F.lds + RING_OFF, QL, S, E);
          if (PROBE_REPEAT == 30) gemm_phase<false>(F.lds + RING_OFF, QL, S, E); }
        { DenseSched S; S.init(latC + 512, LATW, (const bf16_t*)(ws + WS_WKV), KVL, M, 2048, F.G, (int)blockIdx.x);
          EpiKV E{Kd, Vd, latC, ssp, P.k_g, (LAS float*)(F.lds + XCH_OFF)};
          gemm_phase<false>(F.lds + RING_OFF, KVL, S, E);
          if (PROBE_REPEAT == 31) gemm_phase<false>(F.lds + RING_OFF, KVL, S, E);
          if (PROBE_REPEAT == 32) { EpiPlain E2{hA, 1024, 3}; gemm_phase<false>(F.lds + RING_OFF, KVL, S, E2); } }
        SEAM(3);
    }
    if (IN(4)) {
        const Ptrs P = args_unused.P; WSPTRS
        att::AttnArgs T{Qo, Kd, Vd, ssp, cs, P.q_g, uB, gbB, sgB, P.conv_w, hA};
        if (F.G == 256) {
            const int bh = F.vcu >> 1, sel = F.vcu & 1;
#pragma unroll 1
            for (int i = 0; i < 4; ++i) { const int qb = sel ? (i == 0 ? 6 : i == 1 ? 1 : i == 2 ? 5 : 2) : (i == 0 ? 7 : i == 1 ? 0 : i == 2 ? 4 : 3);
                att::attn_unit<0>(T, bh >> 3, bh & 7, qb, (LAS char*)(F.lds + RING_OFF)); }
            if (PROBE_REPEAT == 4 || PROBE_REPEAT == 41) {
#pragma unroll 1
                for (int i = 0; i < 4; ++i) { const int qb = sel ? (i == 0 ? 6 : i == 1 ? 1 : i == 2 ? 5 : 2) : (i == 0 ? 7 : i == 1 ? 0 : i == 2 ? 4 : 3);
                    att::attn_unit<(PROBE_REPEAT == 41 ? 1 : 0)>(T, bh >> 3, bh & 7, qb, (LAS char*)(F.lds + RING_OFF)); } }
        } else {
#pragma unroll 1
            for (int U = F.vcu; U < BATCH * NH * 8; U += F.G) { const int bh = U >> 3; att::attn_unit<0>(T, bh >> 3, bh & 7, U & 7, (LAS char*)(F.lds + RING_OFF)); }
        }
        SEAM(4);
    }
    if (IN(5)) {
        const Ptrs P = args_unused.P; WSPTRS
        DenseSched S; S.init(hA, DM, (const bf16_t*)(ws + WS_WO), DM, M, DM, F.G, (int)blockIdx.x);
        EpiDelta E{mod, (bf16_t*)(ws + WS_DELTA)};
        gemm_phase<false>(F.lds + RING_OFF, DM, S, E);
        if (PROBE_REPEAT == 5) gemm_phase<false>(F.lds + RING_OFF, DM, S, E);
        SEAM(5);
    }
    if (IN(6)) { const Ptrs P = args_unused.P; p6_rows<0>(P, F); if (PROBE_REPEAT == 6) p6_rows<0>(P, F); if (PROBE_REPEAT == 61) p6_rows<1>(P, F); SEAM(6); }
    if (IN(7)) { const Ptrs P = args_unused.P; p7_sort(P, F); if (PROBE_REPEAT == 7) p7_sort(P, F); SEAM(7); }
    if (IN(8)) {
        const Ptrs P = args_unused.P; WSPTRS
        const int T = __builtin_amdgcn_readfirstlane((int)F.ctl[CW_T]);
        MoeSched S{h2, (const bf16_t*)(ws + WS_EGU), DM, DM, stok, F.ctl + CW_TGRP, 0, T * 2, 2, F.G, F.vcu, (size_t)512 * DM * 2, true, true};
        EpiGU E{hact, sw};
        gemm_phase<true>(F.lds + RING_OFF, DM, S, E);
        if (PROBE_REPEAT == 8) gemm_phase<true>(F.lds + RING_OFF, DM, S, E);
        SEAM(8);
    }
    if (IN(9)) {
        const Ptrs P = args_unused.P; WSPTRS
        const int T = __builtin_amdgcn_readfirstlane((int)F.ctl[CW_T]);
        MoeSched S{hact, (const bf16_t*)(ws + WS_EDN), DEXP, DEXP, stok, F.ctl + CW_TGRP, 0, T * 4, 4, F.G, F.vcu, (size_t)DM * DEXP * 2, false, false};
        EpiDown E{(bf16_t*)(ws + WS_Y0), (bf16_t*)(ws + WS_Y1), stok};
        gemm_phase<false>(F.lds + RING_OFF, DEXP, S, E);
        if (PROBE_REPEAT == 9) gemm_phase<false>(F.lds + RING_OFF, DEXP, S, E);
        SEAM(9);
    }
    if (IN(10)) { const Ptrs P = args_unused.P; REPS(10) p10_combine(P, F); }
#undef IN
#undef SEAM
}
}
#ifndef NV2_WMASK
#define NV2_WMASK 15
#endif
#ifndef BOTH_MASK
#define BOTH_MASK 0
#endif
#ifndef FAST_MASK
#define FAST_MASK 0x7f
#endif
#ifndef ONE_LAUNCH
#define ONE_LAUNCH 1
#endif

static void naive_forward(const Ptrs& P, hipStream_t st, int from, int to) {
    unsigned char* ws = P.ws;
    float* scratch = (float*)(ws + WS_D);
    if (from <= 0 && 0 <= to) {
        hipLaunchKernelGGL(nv_mod, dim3(6144 / 256, BATCH), dim3(256), 0, st, P);
        hipLaunchKernelGGL(nv_rope_table, dim3(M * 32 / 256), dim3(256), 0, st, P);
    }
    if (from <= 1 && 1 <= to) hipLaunchKernelGGL(nv_norm1, dim3(M), dim3(256), 0, st, P);
    if (from <= 2 && 2 <= to) {
        for (int b = 0; b < BATCH; ++b) {
            hipLaunchKernelGGL(nv_gemm<bf16_t>, dim3(DIN / 64, SEQ / 64), dim3(256), 0, st, (const bf16_t*)(ws + WS_A) + (size_t)b * SEQ * DM, DM, P.w_in, DIN, (const float*)nullptr, scratch, DIN, DM);
            hipLaunchKernelGGL(nv_z_post, dim3(SEQ), dim3(256), 0, st, P, (const float*)scratch, b, NV2_WMASK);
        }
    }
    if (from <= 3 && 3 <= to) {
        float* s3 = (float*)(ws + WS_A);
        for (int b = 0; b < BATCH; ++b) {
            const bf16_t* latb = (const bf16_t*)(ws + WS_C) + (size_t)b * SEQ * LATW;
            hipLaunchKernelGGL(nv_gemm<bf16_t>, dim3(1536 / 64, SEQ / 64), dim3(256), 0, st, latb, LATW, P.w_q_b, 1536, P.q_a_g, s3, 1536, QL);
            hipLaunchKernelGGL(nv_q_post, dim3(SEQ * 1536 / 256), dim3(256), 0, st, P, (const float*)s3, b);
            float* s3b = s3 + (size_t)SEQ * 1536;
            hipLaunchKernelGGL(nv_gemm<bf16_t>, dim3(2048 / 64, SEQ / 64), dim3(256), 0, st, latb + 512, LATW, P.w_kv_b, 2048, P.kv_a_g, s3b, 2048, KVL);
            hipLaunchKernelGGL(nv_kv_post, dim3(SEQ, NH), dim3(64), 0, st, P, (const float*)s3b, b);
        }
    }
    if (from <= 4 && 4 <= to) hipLaunchKernelGGL(nv_attn, dim3(SEQ, NH, BATCH), dim3(64), 0, st, P);
    if (from <= 5 && 5 <= to) {
        float* s5 = (float*)(ws + WS_C);
        for (int b = 0; b < BATCH; ++b) {
            hipLaunchKernelGGL(nv_gemm<bf16_t>, dim3(DM / 64, SEQ / 64), dim3(256), 0, st, (const bf16_t*)(ws + WS_A) + (size_t)b * SEQ * DM, DM, P.w_o, DM, (const float*)nullptr, s5, DM, DM);
            hipLaunchKernelGGL(nv_resid, dim3(SEQ * DM / 256), dim3(256), 0, st, P, (const float*)s5, b);
        }
    }
    if (from <= 6 && 6 <= to) hipLaunchKernelGGL(nv_norm2_router, dim3(M), dim3(256), 0, st, P);
    if (from <= 7 && 7 <= to) hipLaunchKernelGGL(nv_moe, dim3(M), dim3(256), 0, st, P);
}

extern "C" void kernel_launch(void* const* d_in, const int* in_sizes, int n_in, void* d_out, int out_size, void* d_ws, size_t ws_size, hipStream_t stream) {
    if (n_in != 23 || out_size != M * DM || ws_size < WS_END) { fprintf(stderr, "kernel_launch: unexpected shapes (n_in %d out %d ws %zu)\n", n_in, out_size, ws_size); return; }
    static int grid = 0;
    if (grid == 0) {
        int dev = 0, cus = 0;
        if (hipGetDevice(&dev) != hipSuccess || hipDeviceGetAttribute(&cus, hipDeviceAttributeMultiprocessorCount, dev) != hipSuccess) { fprintf(stderr, "kernel_launch: device query failed\n"); grid = -1; return; }
        if (hipFuncSetAttribute((const void*)fk::fwd, hipFuncAttributeMaxDynamicSharedMemorySize, fk::LDS_BYTES) != hipSuccess) { fprintf(stderr, "kernel_launch: hipFuncSetAttribute failed\n"); grid = -1; return; }
        grid = cus;
    }
    if (grid < 0) return;
    Ptrs P{};
    P.x = (const float*)d_in[0]; P.c = (const float*)d_in[1]; P.pos = (const int*)d_in[2];
    P.w_ada = (const float*)d_in[3]; P.b_ada = (const float*)d_in[4]; P.norm1_g = (const float*)d_in[5]; P.w_in = (const float*)d_in[6]; P.conv_w = (const float*)d_in[7];
    P.q_a_g = (const float*)d_in[8]; P.w_q_b = (const float*)d_in[9]; P.kv_a_g = (const float*)d_in[10]; P.w_kv_b = (const float*)d_in[11]; P.q_g = (const float*)d_in[12]; P.k_g = (const float*)d_in[13];
    P.w_o = (const float*)d_in[14]; P.norm2_g = (const float*)d_in[15]; P.w_rg = (const float*)d_in[16]; P.b_rg = (const float*)d_in[17]; P.w_re = (const float*)d_in[18]; P.b_re = (const float*)d_in[19];
    P.w_gate = (const float*)d_in[20]; P.w_up = (const float*)d_in[21]; P.w_down = (const float*)d_in[22];
    P.out = (float*)d_out; P.ws = (unsigned char*)d_ws;
    (void)hipMemsetAsync((char*)d_ws + WS_CTL, 0, 1 * MiB, stream);
    fk::Args a{}; a.P = P;
    if (ONE_LAUNCH) { a.ph_lo = 0; a.ph_hi = fk::N_PHASES; a.li = 0; hipLaunchKernelGGL(fk::fwd, dim3(grid), dim3(fk::NWAVES * 64), fk::LDS_BYTES, stream, a); }
    else for (int s = 0; s <= 7; ++s) {
        if (s < 6 && ((FAST_MASK >> s) & 1)) { a.ph_lo = s; a.ph_hi = s + 1; a.li = 0; hipLaunchKernelGGL(fk::fwd, dim3(grid), dim3(fk::NWAVES * 64), fk::LDS_BYTES, stream, a); }
        else if (s >= 6 && ((FAST_MASK >> 6) & 1)) { if (s == 6) for (int ph = 6; ph < fk::N_PHASES; ++ph) { a.ph_lo = ph; a.ph_hi = ph + 1; a.li = 0; hipLaunchKernelGGL(fk::fwd, dim3(grid), dim3(fk::NWAVES * 64), fk::LDS_BYTES, stream, a); } }
        else naive_forward(P, stream, s, s);
        if ((BOTH_MASK >> s) & 1) naive_forward(P, stream, s, s);
    }
}
```

```cpp
#define PROBE_REPEAT -1
#include <hip/hip_runtime.h>
#include <cstdio>
#include <cstdint>
#include <cmath>

constexpr int BATCH = 16, SEQ = 2048, DM = 1024, M = BATCH * SEQ;
constexpr int NH = 8, QKN = 128, QKR = 64, QKH = 192, VH = 128, QL = 384, KVL = 256;
constexpr int DIN = 5824, NEXP = 32, DEXP = 256;
constexpr int C_ZX = 0, C_ZB = 1024, C_ZC = 2048, C_QL = 3072, C_KVL = 3456, C_KR = 3712, C_GC = 3776, C_GM = 4800;
constexpr float EPS = 1e-6f;
constexpr int LATW = 768;
constexpr int NSLOT = 16;

typedef unsigned short bf16_t;
typedef float f32x4 __attribute__((ext_vector_type(4)));

constexpr size_t MiB = 1u << 20;
constexpr size_t WS_CTL = 0;
constexpr size_t WS_MOD = 1 * MiB;
constexpr size_t WS_CS = 2 * MiB;
constexpr size_t WS_SSP = 10 * MiB;
constexpr size_t WS_RT = 12 * MiB;
constexpr size_t WS_WSMALL = 14 * MiB;
constexpr size_t WS_A = 32 * MiB;
constexpr size_t WS_B = 96 * MiB;
constexpr size_t WS_C = 288 * MiB;
constexpr size_t WS_D = 336 * MiB;
constexpr size_t WS_END = 496 * MiB;

__device__ __forceinline__ float bf2f(bf16_t v) { return __uint_as_float(((unsigned)v) << 16); }
__device__ __forceinline__ bf16_t f2bf(float f) { unsigned u = __float_as_uint(f); return (bf16_t)((u + 0x7fffu + ((u >> 16) & 1u)) >> 16); }
__device__ __forceinline__ float sigmoidf_(float x) { return 1.f / (1.f + __expf(-x)); }
__device__ __forceinline__ float ldf(const float* p) { return *p; }
__device__ __forceinline__ float ldf(const bf16_t* p) { return bf2f(*p); }

struct Ptrs {
    const float *x, *c; const int* pos;
    const float *w_ada, *b_ada, *norm1_g, *w_in, *conv_w, *q_a_g, *w_q_b, *kv_a_g, *w_kv_b, *q_g, *k_g, *w_o, *norm2_g;
    const float *w_rg, *b_rg, *w_re, *b_re, *w_gate, *w_up, *w_down;
    float* out; unsigned char* ws;
};

__global__ void __launch_bounds__(256) nv_mod(Ptrs P) {
    const int n = blockIdx.x * 256 + threadIdx.x, b = blockIdx.y;
    float acc = P.b_ada[n];
    for (int k = 0; k < DM; ++k) { const float cv = P.c[b * DM + k]; const float s = cv / (1.f + expf(-cv)); acc += s * P.w_ada[(size_t)k * 6144 + n]; }
    ((float*)(P.ws + WS_MOD))[b * 6144 + n] = acc;
}
__global__ void __launch_bounds__(256) nv_rope_table(Ptrs P) {
    const int idx = blockIdx.x * 256 + threadIdx.x;
    const int m = idx >> 5, i = idx & 31;
    const double inv = pow(10000.0, -(double)(2 * i) / 64.0);
    const double ang = (double)P.pos[m] * inv;
    float2 cs; cs.x = (float)cos(ang); cs.y = (float)sin(ang);
    ((float2*)(P.ws + WS_CS))[idx] = cs;
}
__device__ __forceinline__ float block_sum_256(float v, float* red) {
    for (int o = 32; o > 0; o >>= 1) v += __shfl_xor(v, o);
    if ((threadIdx.x & 63) == 0) red[threadIdx.x >> 6] = v;
    __syncthreads();
    const float r = red[0] + red[1] + red[2] + red[3];
    __syncthreads();
    return r;
}
__global__ void __launch_bounds__(256) nv_norm1(Ptrs P) {
    __shared__ float red[4];
    const int m = blockIdx.x, b = m / SEQ, t = threadIdx.x;
    const float* mod = (const float*)(P.ws + WS_MOD) + b * 6144;
    float v[4]; float ss = 0.f;
#pragma unroll
    for (int j = 0; j < 4; ++j) { v[j] = P.x[(size_t)m * DM + t + 256 * j]; ss += v[j] * v[j]; }
    ss = block_sum_256(ss, red);
    const float rstd = 1.f / sqrtf(ss / DM + EPS);
    bf16_t* h = (bf16_t*)(P.ws + WS_A);
#pragma unroll
    for (int j = 0; j < 4; ++j) { const int d = t + 256 * j; h[(size_t)m * DM + d] = f2bf(v[j] * rstd * P.norm1_g[d] * (1.f + mod[1024 + d]) + mod[d]); }
}
template <typename TA>
__global__ void __launch_bounds__(256) nv_gemm(const TA* A, int lda, const float* Bm, int ldb, const float* bscale, float* C, int ldc, int K) {
    __shared__ float As[16][65]; __shared__ float Bs[16][64];
    const int tx = threadIdx.x & 15, ty = threadIdx.x >> 4, m0 = blockIdx.y * 64, n0 = blockIdx.x * 64;
    float acc[4][4];
#pragma unroll
    for (int i = 0; i < 4; ++i)
#pragma unroll
        for (int j = 0; j < 4; ++j) acc[i][j] = 0.f;
    for (int k0 = 0; k0 < K; k0 += 16) {
#pragma unroll
        for (int q = 0; q < 4; ++q) { const int i = threadIdx.x + 256 * q; const int r = i >> 4, c = i & 15; As[c][r] = ldf(A + (size_t)(m0 + r) * lda + k0 + c); }
#pragma unroll
        for (int q = 0; q < 4; ++q) { const int i = threadIdx.x + 256 * q; const int r = i >> 6, c = i & 63; const float s = bscale ? bscale[k0 + r] : 1.f; Bs[r][c] = Bm[(size_t)(k0 + r) * ldb + n0 + c] * s; }
        __syncthreads();
#pragma unroll
        for (int k = 0; k < 16; ++k) {
            float a0 = As[k][ty * 4 + 0], a1 = As[k][ty * 4 + 1], a2 = As[k][ty * 4 + 2], a3 = As[k][ty * 4 + 3];
            float b0 = Bs[k][tx * 4 + 0], b1 = Bs[k][tx * 4 + 1], b2 = Bs[k][tx * 4 + 2], b3 = Bs[k][tx * 4 + 3];
            acc[0][0] += a0 * b0; acc[0][1] += a0 * b1; acc[0][2] += a0 * b2; acc[0][3] += a0 * b3;
            acc[1][0] += a1 * b0; acc[1][1] += a1 * b1; acc[1][2] += a1 * b2; acc[1][3] += a1 * b3;
            acc[2][0] += a2 * b0; acc[2][1] += a2 * b1; acc[2][2] += a2 * b2; acc[2][3] += a2 * b3;
            acc[3][0] += a3 * b0; acc[3][1] += a3 * b1; acc[3][2] += a3 * b2; acc[3][3] += a3 * b3;
        }
        __syncthreads();
    }
#pragma unroll
    for (int i = 0; i < 4; ++i)
#pragma unroll
        for (int j = 0; j < 4; ++j) C[(size_t)(m0 + ty * 4 + i) * ldc + n0 + tx * 4 + j] = acc[i][j];
}
__global__ void __launch_bounds__(256) nv_z_post(Ptrs P, const float* z, int b, int wmask) {
    const int s = blockIdx.x, m = b * SEQ + s, t = threadIdx.x;
    const float* zr = z + (size_t)s * DIN;
    bf16_t* u = (bf16_t*)(P.ws + WS_B); bf16_t* gb = u + (size_t)M * DM; bf16_t* sg = gb + (size_t)M * DM;
    bf16_t* lat = (bf16_t*)(P.ws + WS_C); float* ssp = (float*)(P.ws + WS_SSP);
#pragma unroll
    for (int j = 0; j < 4; ++j) { const int c = t + 256 * j;
        if (wmask & 1) { u[(size_t)m * DM + c] = f2bf(zr[C_ZX + c] * zr[C_ZC + c]);
        gb[(size_t)m * DM + c] = f2bf(zr[C_ZB + c] * sigmoidf_(zr[C_GC + c])); }
        if (wmask & 2) sg[(size_t)m * DM + c] = f2bf(sigmoidf_(zr[C_GM + c])); }
    if (wmask & 4) for (int c = t; c < LATW; c += 256) {
        float v = 0.f;
        if (c < 384) v = zr[C_QL + c]; else if (c < 448) v = zr[C_KR + c - 384]; else if (c >= 512) v = zr[C_KVL + c - 512];
        lat[(size_t)m * LATW + c] = f2bf(v); }
    if ((wmask & 8) && t < NSLOT) {
        float ss = 0.f;
        if (t == 0) for (int c = 0; c < QL; ++c) ss += zr[C_QL + c] * zr[C_QL + c];
        if (t == 8) for (int c = 0; c < KVL; ++c) ss += zr[C_KVL + c] * zr[C_KVL + c];
        if (t == 12) for (int c = 0; c < QKR; ++c) ss += zr[C_KR + c] * zr[C_KR + c];
        ssp[(size_t)t * M + m] = ss; }
}
__global__ void __launch_bounds__(256) nv_q_post(Ptrs P, const float* qraw, int b) {
    const size_t i = (size_t)blockIdx.x * 256 + threadIdx.x;
    ((bf16_t*)P.out)[(size_t)b * SEQ * 1536 + i] = f2bf(qraw[i]);
}
__global__ void __launch_bounds__(64) nv_kv_post(Ptrs P, const float* kvraw, int b) {
    const int s = blockIdx.x, h = blockIdx.y, m = b * SEQ + s, l = threadIdx.x;
    const float* ssp = (const float*)(P.ws + WS_SSP);
    const float sskv = ssp[(size_t)8 * M + m] + ssp[(size_t)9 * M + m] + ssp[(size_t)10 * M + m] + ssp[(size_t)11 * M + m];
    const float sskr = ssp[(size_t)12 * M + m] + ssp[(size_t)13 * M + m] + ssp[(size_t)14 * M + m] + ssp[(size_t)15 * M + m];
    const float rkv = 1.f / sqrtf(sskv / KVL + EPS);
    const float* r = kvraw + (size_t)s * 2048 + h * 256;
    const float kn0 = rkv * r[l], kn1 = rkv * r[l + 64], v0 = rkv * r[128 + l], v1 = rkv * r[192 + l];
    float ss = kn0 * kn0 + kn1 * kn1;
    for (int o = 32; o > 0; o >>= 1) ss += __shfl_xor(ss, o);
    const float rk = 1.f / sqrtf((ss + sskr) / QKH + EPS);
    bf16_t* Kp = (bf16_t*)(P.ws + WS_D) + ((size_t)(b * NH + h) * SEQ + s) * QKH;
    bf16_t* Vp = (bf16_t*)(P.ws + WS_D + 96 * MiB) + ((size_t)(b * NH + h) * SEQ + s) * VH;
    Kp[l] = f2bf(kn0 * rk * P.k_g[l]); Kp[l + 64] = f2bf(kn1 * rk * P.k_g[l + 64]);
    Vp[l] = f2bf(v0); Vp[l + 64] = f2bf(v1);
    if (l < 32) {
        const bf16_t* lat = (const bf16_t*)(P.ws + WS_C) + (size_t)m * LATW + 384;
        const float2 cs = ((const float2*)(P.ws + WS_CS))[(size_t)m * 32 + l];
        const float x1 = bf2f(lat[l]) * rk * P.k_g[128 + l], x2 = bf2f(lat[l + 32]) * rk * P.k_g[160 + l];
        Kp[128 + l] = f2bf(x1 * cs.x - x2 * cs.y); Kp[160 + l] = f2bf(x2 * cs.x + x1 * cs.y); }
}
__global__ void __launch_bounds__(64) nv_attn(Ptrs P) {
    __shared__ float sq[QKH]; __shared__ float sc[SEQ];
    const int t = blockIdx.x, h = blockIdx.y, b = blockIdx.z, m = b * SEQ + t, l = threadIdx.x;
    const float* ssp = (const float*)(P.ws + WS_SSP);
    float ssq = 0.f; for (int j = 0; j < 8; ++j) ssq += ssp[(size_t)j * M + m];
    const float rq = 1.f / sqrtf(ssq / QL + EPS);
    const bf16_t* qr = (const bf16_t*)P.out + (size_t)m * 1536 + h * QKH;
    const float q0 = rq * bf2f(qr[l]), q1 = rq * bf2f(qr[l + 64]), q2 = rq * bf2f(qr[l + 128]);
    float ss = q0 * q0 + q1 * q1 + q2 * q2;
    for (int o = 32; o > 0; o >>= 1) ss += __shfl_xor(ss, o);
    const float rn = 1.f / sqrtf(ss / QKH + EPS);
    sq[l] = q0 * rn * P.q_g[l]; sq[l + 64] = q1 * rn * P.q_g[l + 64]; sq[l + 128] = q2 * rn * P.q_g[l + 128];
    __syncthreads();
    if (l < 32) {
        const float2 cs = ((const float2*)(P.ws + WS_CS))[(size_t)m * 32 + l];
        const float x1 = sq[128 + l], x2 = sq[160 + l];
        sq[128 + l] = x1 * cs.x - x2 * cs.y; sq[160 + l] = x2 * cs.x + x1 * cs.y; }
    __syncthreads();
    const int kend = ((t >> 6) + 1) << 6;
    const bf16_t* Kb = (const bf16_t*)(P.ws + WS_D) + (size_t)(b * NH + h) * SEQ * QKH;
    const bf16_t* Vb = (const bf16_t*)(P.ws + WS_D + 96 * MiB) + (size_t)(b * NH + h) * SEQ * VH;
    const float scale = 0.07216878364870322f;
    float mx = -1e30f;
    for (int j = l; j < kend; j += 64) { const uint4* kr = (const uint4*)(Kb + (size_t)j * QKH); float d = 0.f;
        for (int e = 0; e < QKH / 8; ++e) { const uint4 w = kr[e]; const float* q8 = sq + e * 8;
            d += q8[0] * __uint_as_float(w.x << 16) + q8[1] * __uint_as_float(w.x & 0xffff0000u) + q8[2] * __uint_as_float(w.y << 16) + q8[3] * __uint_as_float(w.y & 0xffff0000u)
               + q8[4] * __uint_as_float(w.z << 16) + q8[5] * __uint_as_float(w.z & 0xffff0000u) + q8[6] * __uint_as_float(w.w << 16) + q8[7] * __uint_as_float(w.w & 0xffff0000u); }
        d *= scale; sc[j] = d; mx = fmaxf(mx, d); }
    for (int o = 32; o > 0; o >>= 1) mx = fmaxf(mx, __shfl_xor(mx, o));
    float sum = 0.f;
    for (int j = l; j < kend; j += 64) { const float p = expf(sc[j] - mx); sc[j] = p; sum += p; }
    for (int o = 32; o > 0; o >>= 1) sum += __shfl_xor(sum, o);
    __syncthreads();
    float o0 = 0.f, o1 = 0.f;
    for (int j = 0; j < kend; ++j) { const float p = sc[j]; o0 += p * bf2f(Vb[(size_t)j * VH + l]); o1 += p * bf2f(Vb[(size_t)j * VH + l + 64]); }
    const float inv = 1.f / sum; o0 *= inv; o1 *= inv;
    const bf16_t* u = (const bf16_t*)(P.ws + WS_B); const bf16_t* gb = u + (size_t)M * DM; const bf16_t* sg = gb + (size_t)M * DM;
    bf16_t* mg = (bf16_t*)(P.ws + WS_A);
#pragma unroll
    for (int j = 0; j < 2; ++j) { const int c = h * VH + l + 64 * j; const size_t e = (size_t)m * DM + c;
        const float u0 = bf2f(u[e]), um1 = t >= 1 ? bf2f(u[e - DM]) : 0.f, um2 = t >= 2 ? bf2f(u[e - 2 * DM]) : 0.f;
        const float cv = P.conv_w[c] * um2 + P.conv_w[DM + c] * um1 + P.conv_w[2 * DM + c] * u0;
        mg[e] = f2bf(bf2f(gb[e]) * cv + bf2f(sg[e]) * (j ? o1 : o0)); }
}
__global__ void __launch_bounds__(256) nv_resid(Ptrs P, const float* y, int b) {
    const size_t i = (size_t)blockIdx.x * 256 + threadIdx.x;
    const int d = (int)(i & (DM - 1)); const size_t e = (size_t)b * SEQ * DM + i;
    P.out[e] = P.x[e] + ((const float*)(P.ws + WS_MOD))[b * 6144 + 2048 + d] * y[i];
}
__global__ void __launch_bounds__(256) nv_norm2_router(Ptrs P) {
    __shared__ float red[4]; __shared__ float hs[DM]; __shared__ float lg[36];
    const int m = blockIdx.x, b = m / SEQ, t = threadIdx.x;
    const float* mod = (const float*)(P.ws + WS_MOD) + b * 6144;
    float v[4]; float ss = 0.f;
#pragma unroll
    for (int j = 0; j < 4; ++j) { v[j] = P.out[(size_t)m * DM + t + 256 * j]; ss += v[j] * v[j]; }
    ss = block_sum_256(ss, red);
    const float rstd = 1.f / sqrtf(ss / DM + EPS);
    bf16_t* h2 = (bf16_t*)(P.ws + WS_B);
#pragma unroll
    for (int j = 0; j < 4; ++j) { const int d = t + 256 * j; const float hv = v[j] * rstd * P.norm2_g[d] * (1.f + mod[4096 + d]) + mod[3072 + d]; hs[d] = hv; h2[(size_t)m * DM + d] = f2bf(hv); }
    __syncthreads();
    if (t < 36) { float a = 0.f;
        if (t < 4) { for (int k = 0; k < DM; ++k) a += hs[k] * P.w_rg[k * 4 + t]; a += P.b_rg[t]; }
        else { for (int k = 0; k < DM; ++k) a += hs[k] * P.w_re[k * 32 + t - 4]; a += P.b_re[t - 4]; }
        lg[t] = a; }
    __syncthreads();
    if (t == 0) {
        int g = 0; for (int i = 1; i < 4; ++i) if (lg[i] > lg[g]) g = i;
        float se = 0.f; for (int i = 0; i < 4; ++i) se += expf(lg[i] - lg[g]);
        const float pg = 1.f / se;
        const float* el = lg + 4 + g * 8;
        int i0 = 0; for (int i = 1; i < 8; ++i) if (el[i] > el[i0]) i0 = i;
        int i1 = (i0 == 0) ? 1 : 0; for (int i = 0; i < 8; ++i) if (i != i0 && el[i] > el[i1]) i1 = i;
        const float p1 = expf(el[i1] - el[i0]);
        const float w0 = 1.f / (1.f + p1), w1 = p1 / (1.f + p1);
        int2 e; e.x = g * 8 + i0; e.y = g * 8 + i1; float2 w; w.x = w0 * pg; w.y = w1 * pg;
        ((int2*)(P.ws + WS_RT))[m] = e; ((float2*)(P.ws + WS_RT + 256 * 1024))[m] = w; }
}
__global__ void __launch_bounds__(256) nv_moe(Ptrs P) {
    __shared__ float hs[DM]; __shared__ float act[DEXP];
    const int m = blockIdx.x, b = m / SEQ, t = threadIdx.x;
    const bf16_t* h2 = (const bf16_t*)(P.ws + WS_B) + (size_t)m * DM;
#pragma unroll
    for (int j = 0; j < 4; ++j) hs[t + 256 * j] = bf2f(h2[t + 256 * j]);
    const int2 e = ((const int2*)(P.ws + WS_RT))[m]; const float2 w = ((const float2*)(P.ws + WS_RT + 256 * 1024))[m];
    float o[4] = {0.f, 0.f, 0.f, 0.f};
    for (int j = 0; j < 2; ++j) {
        const int ex = j ? e.y : e.x; const float wj = j ? w.y : w.x;
        const float* wg = P.w_gate + (size_t)ex * DM * DEXP; const float* wu = P.w_up + (size_t)ex * DM * DEXP; const float* wd = P.w_down + (size_t)ex * DEXP * DM;
        __syncthreads();
        float g = 0.f, uu = 0.f;
        for (int k = 0; k < DM; ++k) { const float hv = hs[k]; g += hv * wg[(size_t)k * DEXP + t]; uu += hv * wu[(size_t)k * DEXP + t]; }
        act[t] = (g / (1.f + expf(-g))) * uu * wj;
        __syncthreads();
        for (int f = 0; f < DEXP; ++f) { const float a = act[f];
#pragma unroll
            for (int q = 0; q < 4; ++q) o[q] += a * wd[(size_t)f * DM + t + 256 * q]; }
    }
    const float* mod = (const float*)(P.ws + WS_MOD) + b * 6144 + 5120;
#pragma unroll
    for (int q = 0; q < 4; ++q) { const int d = t + 256 * q; P.out[(size_t)m * DM + d] += mod[d] * o[q]; }
}

namespace fk {
#define LAS __attribute__((address_space(3)))
#define GAS __attribute__((address_space(1)))
typedef short bf16x8 __attribute__((ext_vector_type(8)));
typedef short s16x4 __attribute__((ext_vector_type(4)));
typedef unsigned u32x4 __attribute__((ext_vector_type(4)));
typedef unsigned u32x2 __attribute__((ext_vector_type(2)));
typedef float f32x2 __attribute__((ext_vector_type(2)));
typedef float f32x16 __attribute__((ext_vector_type(16)));
typedef GAS unsigned gu32;
#define RLX_AGENT __ATOMIC_RELAXED, __HIP_MEMORY_SCOPE_AGENT
constexpr int NWAVES = 8;
constexpr int BM = 256, BK = 64, HALF = 128, HTB = HALF * BK * 2, STAGE_BYTES = 8 * HTB, NXCD = 8, WGM = 8;
constexpr int RING_OFF = 0, RING_BYTES = 131072, XCH_OFF = 131072, XCH_BYTES = 8192, LDSCTL_OFF = XCH_OFF + XCH_BYTES, MISC_OFF = LDSCTL_OFF + 320, LDS_BYTES = 147456;
constexpr int CW_TMO = 0, CW_BAR = 4096;
constexpr int CW_HIST = 16384;
constexpr int CW_TILES = 40960;

typedef __bf16 bf16x2_t __attribute__((ext_vector_type(2)));
__device__ __forceinline__ unsigned cvt_pk_bf16(float lo, float hi) { f32x2 v = {lo, hi}; bf16x2_t b = __builtin_convertvector(v, bf16x2_t); return __builtin_bit_cast(unsigned, b); }
__device__ __forceinline__ float fsigmoid(float x) { return __builtin_amdgcn_rcpf(1.f + __expf(-x)); }

__host__ __device__ __forceinline__ int lds_byte(int r, int c) { const int st = (r >> 4) * 2 + (c >> 5), rr = r & 15, cc = c & 31, ob = rr * 64 + cc * 2; return st * 1024 + (ob ^ (((ob >> 9) & 1) << 5)); }
__host__ __device__ __forceinline__ void stage_rc(int b, int& R, int& C) { const int st = b / 1024, sb = b % 1024, swz = sb ^ (((sb >> 9) & 1) << 5); R = (st >> 1) * 16 + swz / 64; C = (st & 1) * 32 + (swz % 64) / 2; }
__host__ __device__ __forceinline__ int permL(int L) { return (L & 0xE0) | (((L >> 2) & 1) << 4) | (((L >> 3) & 3) << 2) | (L & 3); }

#define XB_TMO      128
#define XB_XCNT(j)  (256  + 64 * (j))
#define XB_XSUB(j)  (1280 + 64 * (j))
#define XB_XGEN(j)  (2304 + 64 * (j))
#define XB_TOP      3328
#define XB_TOPGEN   3392
#define XCD_BAR_WORDS 3456
#define XB_SPIN_CAP (1u << 18)
__device__ __forceinline__ unsigned xb_ld(unsigned* p)              { return __hip_atomic_load(p, __ATOMIC_RELAXED, __HIP_MEMORY_SCOPE_AGENT); }
__device__ __forceinline__ unsigned xb_add(unsigned* p, unsigned v) { return __hip_atomic_fetch_add(p, v, __ATOMIC_RELAXED, __HIP_MEMORY_SCOPE_AGENT); }
__device__ __forceinline__ unsigned xb_xcc_id() { return (unsigned)__builtin_amdgcn_s_getreg((3 << 11) | 20) & 0xFu; }
#define XB_SPIN(cond, bar) do { unsigned _sp = 0; while (cond) { __builtin_amdgcn_s_sleep(1); \
    if ((++_sp & 255u) == 0u) { if (xb_ld(&(bar)[XB_TMO])) break; if (_sp > XB_SPIN_CAP) { atomicAdd(&(bar)[XB_TMO], 1u); break; } } } } while (0)
struct XcdBarrier { unsigned* bar; unsigned x; volatile LAS unsigned* st; };
__device__ __forceinline__ XcdBarrier xcd_barrier_post(unsigned* bar, volatile LAS unsigned* st) {
    XcdBarrier b; b.bar = bar; b.x = xb_xcc_id(); b.st = st;
    if (threadIdx.x == 0) (void)xb_add(&bar[XB_XCNT(b.x)], 1u);
    return b;
}
__device__ __forceinline__ void xcd_barrier_complete(unsigned* bar, unsigned x, unsigned& nloc, unsigned& nx) {
    const unsigned G = gridDim.x * gridDim.y * gridDim.z;
    unsigned sum, cnt, mine, sp = 0u;
    for (;;) {
        sum = 0u; cnt = 0u; mine = 0u;
#pragma unroll
        for (unsigned j = 0; j < 16; ++j) { const unsigned c = xb_ld(&bar[XB_XCNT(j)]); sum += c; cnt += (c > 0u) ? 1u : 0u; mine = (j == x) ? c : mine; }
        if (sum == G) break;
        __builtin_amdgcn_s_sleep(1);
        if ((++sp & 255u) == 0u) { if (xb_ld(&bar[XB_TMO])) break; if (sp > XB_SPIN_CAP) { atomicAdd(&bar[XB_TMO], 1u); break; } }
    }
    nloc = mine > 0u ? mine : 1u; nx = cnt > 0u ? cnt : 1u;
}
__device__ __forceinline__ void xcd_barrier(const XcdBarrier& b) {
    asm volatile("s_waitcnt vmcnt(0)" ::: "memory");
    __syncthreads();
    if (threadIdx.x == 0) {
        unsigned* bar = b.bar;
        __builtin_amdgcn_s_waitcnt(0);
        unsigned nloc = b.st[0], nx = b.st[1];
        if (nloc == 0u) { xcd_barrier_complete(bar, b.x, nloc, nx); b.st[0] = nloc; b.st[1] = nx; }
        const unsigned old = xb_add(&bar[XB_XSUB(b.x)], 1u);
        const unsigned gen = old / nloc;
        if (old + 1u == (gen + 1u) * nloc) {
            __builtin_amdgcn_fence(__ATOMIC_RELEASE, "agent");
            asm volatile("s_waitcnt vmcnt(0)" ::: "memory");
            const unsigned og = xb_add(&bar[XB_TOP], 1u);
            const unsigned tg = og / nx;
            if (og + 1u == (tg + 1u) * nx) xb_add(&bar[XB_TOPGEN], 1u);
            else XB_SPIN(xb_ld(&bar[XB_TOPGEN]) == tg, bar);
            __builtin_amdgcn_fence(__ATOMIC_ACQUIRE, "agent");
            xb_add(&bar[XB_XGEN(b.x)], 1u);
            asm volatile("s_waitcnt vmcnt(0)" ::: "memory");
        } else {
            XB_SPIN(xb_ld(&bar[XB_XGEN(b.x)]) == gen, bar);
            __builtin_amdgcn_fence(__ATOMIC_ACQUIRE, "agent");
            asm volatile("s_waitcnt vmcnt(0)" ::: "memory");
        }
    }
    __syncthreads();
}

struct Unit { int pm, pn, aux, half; };
struct DenseSched {
    const bf16_t* A; const bf16_t* Bt; int lda, ldb; int nM, nN, nwg, G, c; bool split, pnflip;
    __device__ void init(const bf16_t* A_, int lda_, const bf16_t* Bt_, int ldb_, int M_, int N_, int G_, int c_, bool split_ = false, bool pnflip_ = false) {
        A = A_; Bt = Bt_; lda = lda_; ldb = ldb_; nM = M_ / BM; nN = N_ / BM; nwg = nM * nN; G = G_; c = c_; split = split_; pnflip = pnflip_; }
    __device__ bool next(int i, Unit& u) const {
        const int idx = i * G + c, nfull = (nwg / G) * G, tail = nwg - nfull; int L; u.half = 0;
        if (split && tail > 0 && 2 * tail <= G) { if (idx >= nfull + 2 * tail) return false; if (idx < nfull) L = idx; else { L = nfull + ((idx - nfull) >> 1); u.half = 1 + ((idx - nfull) & 1); } }
        else { if (idx >= nwg) return false; L = idx; }
        int wgid = L; { const int q = nwg / NXCD, r = nwg % NXCD, xcd = wgid % NXCD, off = wgid / NXCD; wgid = (xcd < r ? xcd * (q + 1) : r * (q + 1) + (xcd - r) * q) + off; }
        const int nig = WGM * nN, gid = wgid / nig, fm = gid * WGM, gsz = (nM - fm) < WGM ? (nM - fm) : WGM;
        u.pm = fm + ((wgid % nig) % gsz); u.pn = (wgid % nig) / gsz; if (pnflip) u.pn = nN - 1 - u.pn; u.aux = 0; return true;
    }
    __device__ __forceinline__ const char* abase(const Unit& u) const { return (const char*)A + (size_t)(u.pm * BM + (u.half == 2 ? HALF : 0)) * lda * 2; }
    __device__ __forceinline__ const char* bbase(const Unit& u) const { return (const char*)Bt + (size_t)u.pn * BM * ldb * 2; }
    __device__ __forceinline__ void avoff(const Unit& u, int R0, int C0, int R1, int C1, unsigned (&v0)[2], unsigned (&v1)[2]) const {
        v0[0] = (unsigned)(R0 * lda + C0) * 2u; v0[1] = (unsigned)(R1 * lda + C1) * 2u;
        const unsigned h1 = u.half ? 0u : (unsigned)(HALF * lda * 2);
        v1[0] = v0[0] + h1; v1[1] = v0[1] + h1; }
};

template <bool GATHER, class Epi, class Sched>
__device__ __forceinline__ void gemm_phase(LAS unsigned char* lds, const int K, const Sched& S, const Epi& E) {
    const int tid = threadIdx.x, wid = __builtin_amdgcn_readfirstlane(tid >> 6), lane = tid & 63, wr = wid >> 2, wc = wid & 3, fr = lane & 15, fq = lane >> 4;
    const int nt = K / BK;
    int R0, C0, R1, C1; stage_rc(tid * 16, R0, C0); stage_rc(tid * 16 + 8192, R1, C1);
    unsigned voffB[2]; voffB[0] = (unsigned)(R0 * S.ldb + C0) * 2u; voffB[1] = (unsigned)(R1 * S.ldb + C1) * 2u;
    const size_t kstep = (size_t)(BK * 2);
    const size_t hstepB = (size_t)HALF * S.ldb * 2;
    const unsigned ldsw = (unsigned)wid * 1024u;
    const int aoff = lds_byte(wr * 64 + fr, fq * 8), boff = lds_byte(wc * 32 + fr, fq * 8);
#define PG8_SA(b, h) (((b) * 2 + (h)) * HTB)
#define PG8_SB(b, h) ((4 + (b) * 2 + (h)) * HTB)
#define PG8_STAGE(bufoff, gbase, voff) do { _Pragma("unroll") for (int _i = 0; _i < 2; ++_i) \
        __builtin_amdgcn_global_load_lds((const unsigned*)((const char*)(gbase) + (voff)[_i]), (LAS unsigned*)(lds + (bufoff) + ldsw + _i * 8192), 16, 0, 0); } while (0)
#define PG8_LDA(dst, b, h) do { _Pragma("unroll") for (int m = 0; m < 4; ++m) _Pragma("unroll") for (int k = 0; k < 2; ++k) dst[m][k] = *(const LAS bf16x8*)(lds + PG8_SA(b, h) + aoff + m * 2048 + k * 1024); } while (0)
#define PG8_LDB(dst, b, h) do { _Pragma("unroll") for (int n = 0; n < 2; ++n) _Pragma("unroll") for (int k = 0; k < 2; ++k) dst[n][k] = *(const LAS bf16x8*)(lds + PG8_SB(b, h) + boff + n * 2048 + k * 1024); } while (0)
#define PG8_MMA(ai, bj, At, Bt) do { __builtin_amdgcn_s_setprio(1); _Pragma("unroll") for (int m = 0; m < 4; ++m) _Pragma("unroll") for (int n = 0; n < 2; ++n) _Pragma("unroll") for (int k = 0; k < 2; ++k) \
        acc[ai][bj][m][n] = __builtin_amdgcn_mfma_f32_16x16x32_bf16(Bt[n][k], At[m][k], acc[ai][bj][m][n], 0, 0, 0); __builtin_amdgcn_s_setprio(0); } while (0)
#define PG8_WAIT_V(n) asm volatile("s_waitcnt vmcnt(" #n ")" ::: "memory")
#define PG8_WAIT_L(n) asm volatile("s_waitcnt lgkmcnt(" #n ")" ::: "memory")
#define PG8_BAR __builtin_amdgcn_s_barrier()
#define PG8_SCHED __builtin_amdgcn_sched_barrier(0)
    Unit cur, nxt; int ui = 0;
    if (!S.next(0, cur)) return;
    f32x4 acc[2][2][4][2];
#pragma unroll
    for (int a = 0; a < 2; ++a)
#pragma unroll
        for (int b = 0; b < 2; ++b)
#pragma unroll
            for (int m = 0; m < 4; ++m)
#pragma unroll
                for (int n = 0; n < 2; ++n) acc[a][b][m][n] = (f32x4){0.f, 0.f, 0.f, 0.f};
    bf16x8 At[4][2], B0[2][2], B1[2][2];
    unsigned va0[2], va1[2], na0[2], na1[2];
    S.avoff(cur, R0, C0, R1, C1, va0, va1);
    na0[0] = va0[0]; na0[1] = va0[1]; na1[0] = va1[0]; na1[1] = va1[1];
    const char* cA = S.abase(cur); const char* cB = S.bbase(cur);
    PG8_STAGE(PG8_SB(0, 0), cB, voffB); PG8_STAGE(PG8_SB(0, 1), cB + hstepB, voffB); PG8_STAGE(PG8_SA(0, 0), cA, va0); PG8_STAGE(PG8_SA(0, 1), cA, va1);
    if (wr == 1) PG8_BAR;
    PG8_WAIT_V(2); PG8_BAR;
    PG8_STAGE(PG8_SB(1, 0), cB + kstep, voffB); PG8_STAGE(PG8_SA(1, 0), cA + kstep, va0); PG8_STAGE(PG8_SB(1, 1), cB + hstepB + kstep, voffB);
    PG8_WAIT_V(6); PG8_BAR;
    for (;;) {
        const bool has_next = S.next(ui + 1, nxt);
        const char* nA = has_next ? S.abase(nxt) : cA; const char* nB = has_next ? S.bbase(nxt) : cB;
        if (has_next) S.avoff(nxt, R0, C0, R1, C1, na0, na1);
        const bool hu = cur.half != 0;
#pragma unroll 1
        for (int t = 0; t < nt; t += 2) {
            const bool last = (t == nt - 2);
            const char* a1 = cA + (size_t)(t + 1) * kstep;
            const char* a2 = last ? nA : cA + (size_t)(t + 2) * kstep; const char* b2 = last ? nB : cB + (size_t)(t + 2) * kstep;
            const char* a3 = a2 + kstep; const char* b3 = b2 + kstep;
            unsigned x0[2], x1[2];
            x0[0] = last ? na0[0] : va0[0]; x0[1] = last ? na0[1] : va0[1]; x1[0] = last ? na1[0] : va1[0]; x1[1] = last ? na1[1] : va1[1];
            PG8_LDB(B0, 0, 0); PG8_LDB(B1, 0, 1); PG8_SCHED; PG8_LDA(At, 0, 0); PG8_STAGE(PG8_SA(1, 1), a1, va1);
            PG8_WAIT_V(8); PG8_WAIT_L(0); PG8_BAR; PG8_MMA(0, 0, At, B0); PG8_MMA(0, 1, At, B1); PG8_BAR; PG8_SCHED;
            if (!hu) PG8_LDA(At, 0, 1);
            PG8_STAGE(PG8_SB(0, 0), b2, voffB); PG8_STAGE(PG8_SB(0, 1), b2 + hstepB, voffB); PG8_STAGE(PG8_SA(0, 0), a2, x0);
            PG8_WAIT_V(8); PG8_WAIT_L(0); PG8_BAR; if (!hu) { PG8_MMA(1, 0, At, B0); PG8_MMA(1, 1, At, B1); } PG8_BAR; PG8_SCHED;
            PG8_LDB(B0, 1, 0); PG8_LDB(B1, 1, 1); PG8_SCHED; PG8_LDA(At, 1, 0); PG8_STAGE(PG8_SA(0, 1), a2, x1);
            PG8_WAIT_V(8); PG8_WAIT_L(0); PG8_BAR; PG8_MMA(0, 0, At, B0); PG8_MMA(0, 1, At, B1); PG8_BAR; PG8_SCHED;
            if (!hu) PG8_LDA(At, 1, 1);
            PG8_STAGE(PG8_SB(1, 0), b3, voffB); PG8_STAGE(PG8_SB(1, 1), b3 + hstepB, voffB); PG8_STAGE(PG8_SA(1, 0), a3, x0);
            PG8_WAIT_V(8); PG8_WAIT_L(0); PG8_BAR; if (!hu) { PG8_MMA(1, 0, At, B0); PG8_MMA(1, 1, At, B1); } PG8_BAR; PG8_SCHED;
        }
        if (wr == 0) PG8_BAR;
        E(acc, cur, wr, wc, fr, fq);
        if (!has_next) break;
#pragma unroll
        for (int a = 0; a < 2; ++a)
#pragma unroll
            for (int b = 0; b < 2; ++b)
#pragma unroll
                for (int m = 0; m < 4; ++m)
#pragma unroll
                    for (int n = 0; n < 2; ++n) acc[a][b][m][n] = (f32x4){0.f, 0.f, 0.f, 0.f};
        cur = nxt; cA = nA; cB = nB; ++ui;
        va0[0] = na0[0]; va0[1] = na0[1]; va1[0] = na1[0]; va1[1] = na1[1];
        if (wr == 1) PG8_BAR;
    }
    PG8_WAIT_V(0);
    PG8_BAR;
#undef PG8_SA
#undef PG8_SB
#undef PG8_STAGE
#undef PG8_LDA
#undef PG8_LDB
#undef PG8_MMA
#undef PG8_WAIT_V
#undef PG8_WAIT_L
#undef PG8_BAR
#undef PG8_SCHED
}

__device__ __forceinline__ u32x4 pack8(const f32x4 a, const f32x4 b) { u32x4 w; w.x = cvt_pk_bf16(a[0], a[1]); w.y = cvt_pk_bf16(a[2], a[3]); w.z = cvt_pk_bf16(b[0], b[1]); w.w = cvt_pk_bf16(b[2], b[3]); return w; }

struct EpiIn {
    bf16_t *u, *gb, *sg, *lat; float* rowstat; const float2* cs; const float* k_g; LAS float* xch;
    __device__ __forceinline__ void operator()(const f32x4 (&acc)[2][2][4][2], const Unit& un, int wr, int wc, int fr, int fq) const {
        asm volatile("" : "+v"(fr), "+v"(fq));
        const int row0 = un.pm * BM + wr * 64 + fr, pn = un.pn;
        if (pn < 16) {
            const int c0 = 128 * (pn & 7) + 32 * wc + 8 * fq; bf16_t* dst = pn < 8 ? u : gb; const int rh = row0 + (un.half == 2 ? HALF : 0);
#pragma unroll
            for (int ai = 0; ai < 2; ++ai)
#pragma unroll
                for (int m = 0; m < 4; ++m) { f32x4 r0, r1; if (ai == 1 && un.half) continue;
                    if (pn < 8) { r0 = acc[ai][0][m][0] * acc[ai][1][m][0]; r1 = acc[ai][0][m][1] * acc[ai][1][m][1]; }
                    else { const f32x4 g0 = acc[ai][1][m][0], g1 = acc[ai][1][m][1];
#pragma unroll
                        for (int i = 0; i < 4; ++i) { r0[i] = acc[ai][0][m][0][i] * fsigmoid(g0[i]); r1[i] = acc[ai][0][m][1][i] * fsigmoid(g1[i]); } }
                    *(u32x4*)(dst + (size_t)(rh + ai * HALF + m * 16) * DM + c0) = pack8(r0, r1); }
        } else if (pn < 20) {
            const int c0 = 256 * (pn - 16) + 32 * wc + 8 * fq;
#pragma unroll
            for (int ai = 0; ai < 2; ++ai)
#pragma unroll
                for (int m = 0; m < 4; ++m)
#pragma unroll
                    for (int bj = 0; bj < 2; ++bj) { f32x4 a = acc[ai][bj][m][0], b = acc[ai][bj][m][1];
#pragma unroll
                        for (int i = 0; i < 4; ++i) { a[i] = fsigmoid(a[i]); b[i] = fsigmoid(b[i]); }
                        *(u32x4*)(sg + (size_t)(row0 + ai * HALF + m * 16) * DM + c0 + bj * HALF) = pack8(a, b); }
        } else {
            const int c0 = 256 * (pn - 20) + 32 * wc + 8 * fq, rowt = wr * 64 + fr;
#pragma unroll
            for (int ai = 0; ai < 2; ++ai)
#pragma unroll
                for (int m = 0; m < 4; ++m) { const int rt = rowt + ai * HALF + m * 16, row = un.pm * BM + rt; float s0, s1;
                    { const f32x4 a = acc[ai][0][m][0], b = acc[ai][0][m][1]; *(u32x4*)(lat + (size_t)row * LATW + c0) = pack8(a, b);
                      s0 = (a[0] * a[0] + a[1] * a[1]) + (a[2] * a[2] + a[3] * a[3]) + (b[0] * b[0] + b[1] * b[1]) + (b[2] * b[2] + b[3] * b[3]); }
                    { const f32x4 a = acc[ai][1][m][0], b = acc[ai][1][m][1];
                      s1 = (a[0] * a[0] + a[1] * a[1]) + (a[2] * a[2] + a[3] * a[3]) + (b[0] * b[0] + b[1] * b[1]) + (b[2] * b[2] + b[3] * b[3]);
                      if (pn != 21) *(u32x4*)(lat + (size_t)row * LATW + c0 + HALF) = pack8(a, b);
                      else if (wc < 2) { const int j = 16 * wc + 4 * fq;
                          const f32x4 g1 = *(const f32x4*)(k_g + 128 + j), g2 = *(const f32x4*)(k_g + 160 + j);
                          const f32x4 cA = *(const f32x4*)((const float*)cs + ((size_t)row * 32 + j) * 2), cB = *(const f32x4*)((const float*)cs + ((size_t)row * 32 + j + 2) * 2);
                          const f32x4 x1 = a * g1, x2 = b * g2; f32x4 y1, y2;
                          y1[0] = x1[0] * cA[0] - x2[0] * cA[1]; y2[0] = x2[0] * cA[0] + x1[0] * cA[1]; y1[1] = x1[1] * cA[2] - x2[1] * cA[3]; y2[1] = x2[1] * cA[2] + x1[1] * cA[3];
                          y1[2] = x1[2] * cB[0] - x2[2] * cB[1]; y2[2] = x2[2] * cB[0] + x1[2] * cB[1]; y1[3] = x1[3] * cB[2] - x2[3] * cB[3]; y2[3] = x2[3] * cB[2] + x1[3] * cB[3];
                          u32x2 w1, w2; w1.x = cvt_pk_bf16(y1[0], y1[1]); w1.y = cvt_pk_bf16(y1[2], y1[3]); w2.x = cvt_pk_bf16(y2[0], y2[1]); w2.y = cvt_pk_bf16(y2[2], y2[3]);
                          *(u32x2*)(lat + (size_t)row * LATW + 384 + j) = w1; *(u32x2*)(lat + (size_t)row * LATW + 416 + j) = w2; } }
                    s0 += __shfl_xor(s0, 16); s0 += __shfl_xor(s0, 32); s1 += __shfl_xor(s1, 16); s1 += __shfl_xor(s1, 32);
                    if (fq == 0) { xch[rt * 8 + wc] = s0; xch[rt * 8 + 4 + wc] = s1; } }
            asm volatile("s_waitcnt lgkmcnt(0)" ::: "memory"); __builtin_amdgcn_s_barrier(); asm volatile("" ::: "memory");
            if (threadIdx.x < 256) { const int rt = threadIdx.x; const f32x4 p0 = *(const LAS f32x4*)(xch + rt * 8), p1 = *(const LAS f32x4*)(xch + rt * 8 + 4);
                const float S0 = (p0[0] + p0[1]) + (p0[2] + p0[3]), S1 = (p1[0] + p1[1]) + (p1[2] + p1[3]); float* st = rowstat + (size_t)(un.pm * BM + rt) * 4;
                if (pn == 20) st[0] = S0 + S1; else if (pn == 21) { st[1] = S0; st[2] = S1; } else st[3] = S0 + S1; }
        }
    }
};
struct EpiPlain {
    bf16_t* O; int ldc; int pnmask;
    __device__ __forceinline__ void operator()(const f32x4 (&acc)[2][2][4][2], const Unit& un, int wr, int wc, int fr, int fq) const {
        asm volatile("" : "+v"(fr), "+v"(fq));
        const int row0 = un.pm * BM + wr * 64 + fr, c0 = 256 * (un.pn & pnmask) + 32 * wc + 8 * fq;
#pragma unroll
        for (int ai = 0; ai < 2; ++ai)
#pragma unroll
            for (int m = 0; m < 4; ++m)
#pragma unroll
                for (int bj = 0; bj < 2; ++bj) *(u32x4*)(O + (size_t)(row0 + ai * HALF + m * 16) * ldc + c0 + bj * HALF) = pack8(acc[ai][bj][m][0], acc[ai][bj][m][1]);
    }
};
struct EpiKV {
    bf16_t *Kb, *Vb; const bf16_t* lat; const float* rowstat; const float* k_g; LAS float* xch;
    __device__ __forceinline__ void operator()(const f32x4 (&acc)[2][2][4][2], const Unit& un, int wr, int wc, int fr, int fq) const {
        asm volatile("" : "+v"(fr), "+v"(fq));
        const int h = un.pn, rowt = wr * 64 + fr, b = (un.pm * BM) / SEQ, s0 = (un.pm * BM) % SEQ;
        f32x2 st[2][4];
        u32x4 rp[2][2];
#pragma unroll
        for (int ai = 0; ai < 2; ++ai) {
#pragma unroll
            for (int m = 0; m < 4; ++m) st[ai][m] = *(const f32x2*)(rowstat + (size_t)(un.pm * BM + rowt + ai * HALF + m * 16) * 4 + 2);
            const bf16_t* lr = lat + (size_t)(un.pm * BM + rowt + ai * HALF + wc * 16) * LATW + 384 + 16 * fq;
            rp[ai][0] = *(const u32x4*)lr; rp[ai][1] = *(const u32x4*)(lr + 8); }
#pragma unroll
        for (int ai = 0; ai < 2; ++ai)
#pragma unroll
            for (int m = 0; m < 4; ++m) {
                const f32x4 a = acc[ai][0][m][0], c = acc[ai][0][m][1];
                float ss = (a[0] * a[0] + a[1] * a[1]) + (a[2] * a[2] + a[3] * a[3]) + (c[0] * c[0] + c[1] * c[1]) + (c[2] * c[2] + c[3] * c[3]);
                ss += __shfl_xor(ss, 16); ss += __shfl_xor(ss, 32);
                if (fq == 0) xch[(rowt + ai * HALF + m * 16) * 4 + wc] = ss; }
        asm volatile("s_waitcnt lgkmcnt(0)" ::: "memory"); __builtin_amdgcn_s_barrier(); asm volatile("" ::: "memory");
        const int c8 = 32 * wc + 8 * fq;
        const f32x4 g0 = *(const f32x4*)(k_g + c8), g1 = *(const f32x4*)(k_g + c8 + 4);
#pragma unroll
        for (int ai = 0; ai < 2; ++ai)
#pragma unroll
            for (int m = 0; m < 4; ++m) { const int rt = rowt + ai * HALF + m * 16;
                const float rkv = __builtin_amdgcn_rsqf(st[ai][m][1] * (1.f / KVL) + EPS);
                const f32x4 t4 = *(const LAS f32x4*)(xch + rt * 4);
                const float rk = __builtin_amdgcn_rsqf((((t4[0] + t4[1]) + (t4[2] + t4[3])) * rkv * rkv + st[ai][m][0]) * (1.f / QKH) + EPS);
                const float sk = rkv * rk, sv = rkv;
                const size_t bhs = (size_t)(b * NH + h) * SEQ + s0 + rt;
                bf16_t* Kp = Kb + bhs * QKH; bf16_t* Vp = Vb + bhs * VH;
                *(u32x4*)(Kp + c8) = pack8(acc[ai][0][m][0] * sk * g0, acc[ai][0][m][1] * sk * g1);
                *(u32x4*)(Vp + c8) = pack8(acc[ai][1][m][0] * sv, acc[ai][1][m][1] * sv);
                if (m == wc) {
                    u32x4 o0, o1;
#pragma unroll
                    for (int e = 0; e < 4; ++e) { o0[e] = cvt_pk_bf16(__uint_as_float(rp[ai][0][e] << 16) * rk, __uint_as_float(rp[ai][0][e] & 0xffff0000u) * rk);
                                                  o1[e] = cvt_pk_bf16(__uint_as_float(rp[ai][1][e] << 16) * rk, __uint_as_float(rp[ai][1][e] & 0xffff0000u) * rk); }
                    *(u32x4*)(Kp + 128 + 16 * fq) = o0; *(u32x4*)(Kp + 128 + 16 * fq + 8) = o1; } }
    }
};
struct EpiDelta {
    const float* mod; bf16_t* delta;
    __device__ __forceinline__ void operator()(const f32x4 (&acc)[2][2][4][2], const Unit& un, int wr, int wc, int fr, int fq) const {
        asm volatile("" : "+v"(fr), "+v"(fq));
        const int row0 = un.pm * BM + wr * 64 + fr, b = (un.pm * BM) / SEQ, c0 = 256 * un.pn + 32 * wc + 8 * fq;
        const float* gate = mod + b * 6144 + 2048;
#pragma unroll
        for (int bj = 0; bj < 2; ++bj) { const f32x4 g0 = *(const f32x4*)(gate + c0 + bj * HALF), g1 = *(const f32x4*)(gate + c0 + bj * HALF + 4);
#pragma unroll
            for (int ai = 0; ai < 2; ++ai)
#pragma unroll
                for (int m = 0; m < 4; ++m) *(u32x4*)(delta + (size_t)(row0 + ai * HALF + m * 16) * DM + c0 + bj * HALF) = pack8(acc[ai][bj][m][0] * g0, acc[ai][bj][m][1] * g1); }
    }
};
namespace att {
constexpr int NW = 8, QBLK = 32, KVBLK = 64, KPITCH = 400;
constexpr int SHM_V = KVBLK * VH * 2, SHM_K = KVBLK * KPITCH;
constexpr int QRP = 144;
constexpr int OFF_V = 0, OFF_K = 2 * SHM_V, OFF_WS = OFF_K + 2 * SHM_K, OFF_QR = OFF_WS + NW * 64 * 4, ATT_LDS = OFF_QR + NW * 32 * QRP;
constexpr float SCALE = 0.07216878364870322f;
constexpr float THR = 8.f;
#define SBAR() __builtin_amdgcn_sched_barrier(0)
__device__ __forceinline__ int crow(int r, int hi) { return (r & 3) + 8 * (r >> 2) + 4 * hi; }
__device__ __forceinline__ void partialSM(f32x16& p0, f32x16& p1, float& m_reg, float& alpha) {
    constexpr float C = SCALE * 1.4426950408889634f;
    float pmax = p0[0];
#pragma unroll
    for (int r = 1; r < 16; ++r) pmax = fmaxf(pmax, p0[r]);
#pragma unroll
    for (int r = 0; r < 16; ++r) pmax = fmaxf(pmax, p1[r]);
    { auto rr = __builtin_amdgcn_permlane32_swap(__float_as_uint(pmax), __float_as_uint(pmax), false, false);
      pmax = fmaxf(__uint_as_float(rr[0]), __uint_as_float(rr[1])); }
    float mn;
    if (__builtin_expect(__all(pmax - m_reg <= THR / SCALE), 1)) { mn = m_reg; alpha = 1.f; }
    else { mn = fmaxf(m_reg, pmax); alpha = __builtin_amdgcn_exp2f((m_reg - mn) * C); m_reg = mn; }
    const float mnC = -mn * C;
#pragma unroll
    for (int r = 0; r < 16; ++r) p0[r] = fmaf(p0[r], C, mnC);
#pragma unroll
    for (int r = 0; r < 16; ++r) p1[r] = fmaf(p1[r], C, mnC);
#pragma unroll
    for (int r = 0; r < 16; ++r) p0[r] = __builtin_amdgcn_exp2f(p0[r]);
}
__device__ __forceinline__ void finishSM(f32x16& p0, f32x16& p1, float alpha, float& l_reg, bf16x8& pa0, bf16x8& pa1, bf16x8& pa2, bf16x8& pa3) {
#pragma unroll
    for (int r = 0; r < 16; ++r) p1[r] = __builtin_amdgcn_exp2f(p1[r]);
    float ps = 0;
#pragma unroll
    for (int r = 0; r < 16; ++r) ps += p0[r];
#pragma unroll
    for (int r = 0; r < 16; ++r) ps += p1[r];
    { auto rr = __builtin_amdgcn_permlane32_swap(__float_as_uint(ps), __float_as_uint(ps), false, false);
      ps = __uint_as_float(rr[0]) + __uint_as_float(rr[1]); }
    l_reg = l_reg * alpha + ps;
#define PK4(P, BASE, OUT) do { unsigned a0 = cvt_pk_bf16(P[BASE + 0], P[BASE + 1]), a1 = cvt_pk_bf16(P[BASE + 2], P[BASE + 3]);   \
    unsigned b0 = cvt_pk_bf16(P[BASE + 4], P[BASE + 5]), b1 = cvt_pk_bf16(P[BASE + 6], P[BASE + 7]);                              \
    auto r0 = __builtin_amdgcn_permlane32_swap(a0, b0, false, false); auto r1 = __builtin_amdgcn_permlane32_swap(a1, b1, false, false); \
    u32x4 w = {r0[0], r1[0], r0[1], r1[1]}; OUT = *reinterpret_cast<bf16x8*>(&w); } while (0)
    PK4(p0, 0, pa0); PK4(p0, 8, pa1); PK4(p1, 0, pa2); PK4(p1, 8, pa3);
#undef PK4
}
__device__ __forceinline__ void qkt(f32x16& p0, f32x16& p1, const LAS char* Ks, const bf16x8 (&qr)[8], const LAS char* qrope, int r32, int hi) {
    p0 = f32x16{}; p1 = f32x16{};
    const LAS char* k0 = Ks + r32 * KPITCH + hi * 16;
#pragma unroll
    for (int d0 = 0; d0 < 8; ++d0) {
        const bf16x8 b0 = *(const LAS bf16x8*)(k0 + d0 * 32);
        const bf16x8 b1 = *(const LAS bf16x8*)(k0 + 32 * KPITCH + d0 * 32);
        p0 = __builtin_amdgcn_mfma_f32_32x32x16_bf16(b0, qr[d0], p0, 0, 0, 0);
        p1 = __builtin_amdgcn_mfma_f32_32x32x16_bf16(b1, qr[d0], p1, 0, 0, 0); }
#pragma unroll
    for (int d0 = 8; d0 < 12; ++d0) {
        const bf16x8 b0 = *(const LAS bf16x8*)(k0 + d0 * 32);
        const bf16x8 b1 = *(const LAS bf16x8*)(k0 + 32 * KPITCH + d0 * 32);
        const bf16x8 qf = *(const LAS bf16x8*)(qrope + (d0 - 8) * 32);
        p0 = __builtin_amdgcn_mfma_f32_32x32x16_bf16(b0, qf, p0, 0, 0, 0);
        p1 = __builtin_amdgcn_mfma_f32_32x32x16_bf16(b1, qf, p1, 0, 0, 0); }
}
__device__ __forceinline__ int v_st(int k, int c) { const int kk = (k & ~0xC) | ((k & 4) << 1) | ((k & 8) >> 1); return ((kk >> 3) * 4 + (c >> 5)) * 512 + ((kk & 7) * 32 + (c & 31)) * 2; }
__device__ __forceinline__ int v_rd_base(int lane) { return ((lane & 3) << 3) | (((lane >> 2) & 3) << 6) | (((lane >> 4) & 1) << 5) | (((lane >> 5) & 1) << 8); }
constexpr int v_rd_off(int d0, int ks, int half) { return d0 * 512 + ks * 4096 + half * 2048; }
template <int OFF> __device__ __forceinline__ s16x4 tr_read(int vb) {
    s16x4 r; asm volatile("ds_read_b64_tr_b16 %0, %1 offset:%2" : "=&v"(r) : "v"(vb), "i"(OFF) : "memory"); return r;
}
template <int D0> __device__ __forceinline__ void pv_one(f32x16& od, int vb, bf16x8 pa0, bf16x8 pa1, bf16x8 pa2, bf16x8 pa3) {
#define PK(L, H) (bf16x8){L[0], L[1], L[2], L[3], H[0], H[1], H[2], H[3]}
    { const s16x4 l0 = tr_read<v_rd_off(D0, 0, 0)>(vb), h0 = tr_read<v_rd_off(D0, 0, 1)>(vb), l1 = tr_read<v_rd_off(D0, 1, 0)>(vb), h1 = tr_read<v_rd_off(D0, 1, 1)>(vb);
      asm volatile("s_waitcnt lgkmcnt(0)" ::: "memory"); SBAR();
      od = __builtin_amdgcn_mfma_f32_32x32x16_bf16(pa0, PK(l0, h0), od, 0, 0, 0);
      od = __builtin_amdgcn_mfma_f32_32x32x16_bf16(pa1, PK(l1, h1), od, 0, 0, 0); }
    { const s16x4 l2 = tr_read<v_rd_off(D0, 2, 0)>(vb), h2 = tr_read<v_rd_off(D0, 2, 1)>(vb), l3 = tr_read<v_rd_off(D0, 3, 0)>(vb), h3 = tr_read<v_rd_off(D0, 3, 1)>(vb);
      asm volatile("s_waitcnt lgkmcnt(0)" ::: "memory"); SBAR();
      od = __builtin_amdgcn_mfma_f32_32x32x16_bf16(pa2, PK(l2, h2), od, 0, 0, 0);
      od = __builtin_amdgcn_mfma_f32_32x32x16_bf16(pa3, PK(l3, h3), od, 0, 0, 0); }
#undef PK
}
__device__ __forceinline__ void pv_d0(f32x16 (&o)[4], int vb, bf16x8 pa0, bf16x8 pa1, bf16x8 pa2, bf16x8 pa3) {
    pv_one<0>(o[0], vb, pa0, pa1, pa2, pa3); pv_one<1>(o[1], vb, pa0, pa1, pa2, pa3); pv_one<2>(o[2], vb, pa0, pa1, pa2, pa3); pv_one<3>(o[3], vb, pa0, pa1, pa2, pa3);
}
__device__ __forceinline__ float bflo(unsigned w) { return __uint_as_float(w << 16); }
__device__ __forceinline__ float bfhi(unsigned w) { return __uint_as_float(w & 0xffff0000u); }

struct AttnArgs { const bf16_t* Q; const bf16_t* Kb; const bf16_t* Vb; const float* ssp; const float2* cs; const float* q_g; const bf16_t *u, *gb, *sg; const float* conv_w; bf16_t* merged; };

template <int MODE> __device__ __forceinline__ void attn_unit(const AttnArgs& T, int b, int h, int qb, LAS char* lds) {
    int tid = threadIdx.x; asm volatile("" : "+v"(tid));
    const int lane = tid & 63, r32 = lane & 31, hi = lane >> 5; const int wid = __builtin_amdgcn_readfirstlane(tid >> 6);
    LAS char* V_lds = lds + OFF_V; LAS char* K_lds = lds + OFF_K;
    LAS float* ws = (LAS float*)(lds + OFF_WS) + wid * 64; LAS float* li_l = ws; LAS float* al_l = ws + 32;
    const int mrow = b * SEQ + qb * 256 + wid * QBLK + r32;
    const bf16_t* Kh = T.Kb + (size_t)(b * NH + h) * SEQ * QKH; const bf16_t* Vh = T.Vb + (size_t)(b * NH + h) * SEQ * VH;
    const int sr = tid >> 4, sc = (tid & 15) * 8, vst0 = v_st(sr, sc), vst1 = v_st(32 + sr, sc);
    const int kdst = (tid >> 3) * KPITCH + (tid & 7) * 48;
    const int vb0 = (int)(uintptr_t)V_lds + v_rd_base(lane);
    bf16x8 sk0, sk1, sk2, sv0, sv1;
#define SLOAD(t) do { const bf16_t* kp = Kh + (size_t)(t) * KVBLK * QKH + tid * 24; sk0 = *(const bf16x8*)kp; sk1 = *(const bf16x8*)(kp + 8); sk2 = *(const bf16x8*)(kp + 16); \
    const bf16_t* vp = Vh + (size_t)((t) * KVBLK + sr) * VH + sc; sv0 = *(const bf16x8*)vp; sv1 = *(const bf16x8*)(vp + 32 * VH); } while (0)
#define SWRITE(bf) do { *(LAS bf16x8*)(V_lds + (bf) * SHM_V + vst0) = sv0; *(LAS bf16x8*)(V_lds + (bf) * SHM_V + vst1) = sv1; \
    *(LAS bf16x8*)(K_lds + (bf) * SHM_K + kdst) = sk0; *(LAS bf16x8*)(K_lds + (bf) * SHM_K + kdst + 16) = sk1; *(LAS bf16x8*)(K_lds + (bf) * SHM_K + kdst + 32) = sk2; } while (0)
#define RESC(a) do { if (__any((a) < 1.f)) { if (hi == 0) al_l[r32] = (a); asm volatile("s_waitcnt lgkmcnt(0)" ::: "memory"); \
    _Pragma("unroll") for (int d = 0; d < 4; ++d) _Pragma("unroll") for (int r = 0; r < 16; ++r) o[d][r] *= al_l[crow(r, hi)]; } } while (0)
    SLOAD(0);
    bf16x8 qr[8];
    LAS char* qrope = lds + OFF_QR + wid * (32 * QRP) + r32 * QRP + hi * 16;
    {
        const bf16_t* Qw = T.Q + (size_t)mrow * 1536 + h * QKH + hi * 8;
        u32x4 raw[12];
#pragma unroll
        for (int d0 = 0; d0 < 12; ++d0) raw[d0] = *(const u32x4*)(Qw + d0 * 16);
        const f32x2 sq2 = *(const f32x2*)(T.ssp + (size_t)mrow * 4); const float ssq = sq2[0] + sq2[1];
        float ss = 0.f;
#pragma unroll
        for (int d0 = 0; d0 < 12; ++d0)
#pragma unroll
            for (int e = 0; e < 4; ++e) { const float a = bflo(raw[d0][e]), c = bfhi(raw[d0][e]); ss += a * a + c * c; }
        { auto rr = __builtin_amdgcn_permlane32_swap(__float_as_uint(ss), __float_as_uint(ss), false, false); ss = __uint_as_float(rr[0]) + __uint_as_float(rr[1]); }
        const float rq2 = 1.f / (ssq * (1.f / QL) + EPS);
        const float rn = 1.f / sqrtf(ss * rq2 * (1.f / QKH) + EPS) * sqrtf(rq2);
#pragma unroll
        for (int d0 = 0; d0 < 8; ++d0) { const f32x4 g0 = *(const f32x4*)(T.q_g + d0 * 16 + hi * 8), g1 = *(const f32x4*)(T.q_g + d0 * 16 + hi * 8 + 4);
            u32x4 w; w.x = cvt_pk_bf16(bflo(raw[d0].x) * rn * g0[0], bfhi(raw[d0].x) * rn * g0[1]); w.y = cvt_pk_bf16(bflo(raw[d0].y) * rn * g0[2], bfhi(raw[d0].y) * rn * g0[3]);
            w.z = cvt_pk_bf16(bflo(raw[d0].z) * rn * g1[0], bfhi(raw[d0].z) * rn * g1[1]); w.w = cvt_pk_bf16(bflo(raw[d0].w) * rn * g1[2], bfhi(raw[d0].w) * rn * g1[3]);
            qr[d0] = *reinterpret_cast<bf16x8*>(&w); }
#pragma unroll
        for (int p = 0; p < 2; ++p) {
            const int ib = 16 * p + 8 * hi;
            float x1[8], x2[8];
            const f32x4 ga = *(const f32x4*)(T.q_g + 128 + ib), gb_ = *(const f32x4*)(T.q_g + 128 + ib + 4), gc = *(const f32x4*)(T.q_g + 160 + ib), gd = *(const f32x4*)(T.q_g + 160 + ib + 4);
            const float g1v[8] = {ga[0], ga[1], ga[2], ga[3], gb_[0], gb_[1], gb_[2], gb_[3]}, g2v[8] = {gc[0], gc[1], gc[2], gc[3], gd[0], gd[1], gd[2], gd[3]};
#pragma unroll
            for (int e = 0; e < 4; ++e) { x1[2 * e] = bflo(raw[8 + p][e]) * rn * g1v[2 * e]; x1[2 * e + 1] = bfhi(raw[8 + p][e]) * rn * g1v[2 * e + 1];
                                          x2[2 * e] = bflo(raw[10 + p][e]) * rn * g2v[2 * e]; x2[2 * e + 1] = bfhi(raw[10 + p][e]) * rn * g2v[2 * e + 1]; }
            float y1[8], y2[8];
#pragma unroll
            for (int jj = 0; jj < 4; ++jj) { const f32x4 c2 = *(const f32x4*)((const float*)T.cs + ((size_t)mrow * 32 + ib + 2 * jj) * 2);
                y1[2 * jj] = x1[2 * jj] * c2[0] - x2[2 * jj] * c2[1]; y2[2 * jj] = x2[2 * jj] * c2[0] + x1[2 * jj] * c2[1];
                y1[2 * jj + 1] = x1[2 * jj + 1] * c2[2] - x2[2 * jj + 1] * c2[3]; y2[2 * jj + 1] = x2[2 * jj + 1] * c2[2] + x1[2 * jj + 1] * c2[3]; }
            u32x4 w1, w2; w1.x = cvt_pk_bf16(y1[0], y1[1]); w1.y = cvt_pk_bf16(y1[2], y1[3]); w1.z = cvt_pk_bf16(y1[4], y1[5]); w1.w = cvt_pk_bf16(y1[6], y1[7]);
            w2.x = cvt_pk_bf16(y2[0], y2[1]); w2.y = cvt_pk_bf16(y2[2], y2[3]); w2.z = cvt_pk_bf16(y2[4], y2[5]); w2.w = cvt_pk_bf16(y2[6], y2[7]);
            *(LAS u32x4*)(qrope + p * 32) = w1; *(LAS u32x4*)(qrope + (2 + p) * 32) = w2; }
        asm volatile("s_waitcnt lgkmcnt(0)" ::: "memory");
    }
    float m_reg = -1e30f, l_reg = 0.f; f32x16 o[4] = {};
    f32x16 pA0, pA1, pB0, pB1; float alA = 1.f, alB = 1.f; bf16x8 pa0, pa1, pa2, pa3;
    const int NT = 4 * qb + 4; const int wp = wid >> 1;
    const bool a1 = wp >= 1, a2 = wp >= 2, a3 = wp >= 3;
    const LAS char* K0 = K_lds; const LAS char* K1 = K_lds + SHM_K;
    asm volatile("s_waitcnt vmcnt(0)" ::: "memory"); SWRITE(0); __syncthreads();
    qkt(pA0, pA1, K0, qr, qrope, r32, hi); partialSM(pA0, pA1, m_reg, alA);
    SLOAD(1); asm volatile("s_waitcnt vmcnt(0)" ::: "memory"); SWRITE(1); __syncthreads();
    for (int j = 1; j + 3 < NT; j += 2) {
        SBAR(); qkt(pB0, pB1, K1, qr, qrope, r32, hi);
        finishSM(pA0, pA1, alA, l_reg, pa0, pa1, pa2, pa3); SBAR();
        SLOAD(j + 1); SBAR();
        pv_d0(o, vb0, pa0, pa1, pa2, pa3); partialSM(pB0, pB1, m_reg, alB);
        __syncthreads(); asm volatile("s_waitcnt vmcnt(0)" ::: "memory"); SWRITE(0);
        RESC(alB); __syncthreads();
        SBAR(); qkt(pA0, pA1, K0, qr, qrope, r32, hi);
        finishSM(pB0, pB1, alB, l_reg, pa0, pa1, pa2, pa3); SBAR();
        SLOAD(j + 2); SBAR();
        pv_d0(o, vb0 + SHM_V, pa0, pa1, pa2, pa3); partialSM(pA0, pA1, m_reg, alA);
        __syncthreads(); asm volatile("s_waitcnt vmcnt(0)" ::: "memory"); SWRITE(1);
        RESC(alA); __syncthreads();
    }
#define MASK(P0, P1, act) do { if (!(act)) { _Pragma("unroll") for (int r = 0; r < 16; ++r) { P0[r] = -INFINITY; P1[r] = -INFINITY; } } } while (0)
    {
        SBAR(); if (a1) qkt(pB0, pB1, K1, qr, qrope, r32, hi); MASK(pB0, pB1, a1);
        finishSM(pA0, pA1, alA, l_reg, pa0, pa1, pa2, pa3); SBAR();
        SLOAD(NT - 2); SBAR();
        pv_d0(o, vb0, pa0, pa1, pa2, pa3); partialSM(pB0, pB1, m_reg, alB);
        __syncthreads(); asm volatile("s_waitcnt vmcnt(0)" ::: "memory"); SWRITE(0);
        RESC(alB); __syncthreads();
        SBAR(); if (a2) qkt(pA0, pA1, K0, qr, qrope, r32, hi); MASK(pA0, pA1, a2);
        finishSM(pB0, pB1, alB, l_reg, pa0, pa1, pa2, pa3); SBAR();
        SLOAD(NT - 1); SBAR();
        pv_d0(o, vb0 + SHM_V, pa0, pa1, pa2, pa3); partialSM(pA0, pA1, m_reg, alA);
        __syncthreads(); asm volatile("s_waitcnt vmcnt(0)" ::: "memory"); SWRITE(1);
        RESC(alA); __syncthreads();
        SBAR(); if (a3) qkt(pB0, pB1, K1, qr, qrope, r32, hi); MASK(pB0, pB1, a3);
        finishSM(pA0, pA1, alA, l_reg, pa0, pa1, pa2, pa3); SBAR();
        pv_d0(o, vb0, pa0, pa1, pa2, pa3); partialSM(pB0, pB1, m_reg, alB);
        RESC(alB);
        finishSM(pB0, pB1, alB, l_reg, pa0, pa1, pa2, pa3); SBAR();
        pv_d0(o, vb0 + SHM_V, pa0, pa1, pa2, pa3);
    }
#undef MASK
    if (hi == 0) li_l[r32] = l_reg; asm volatile("s_waitcnt lgkmcnt(0)" ::: "memory");
    float rli[16];
#pragma unroll
    for (int r = 0; r < 16; ++r) rli[r] = __builtin_amdgcn_rcpf(li_l[crow(r, hi)]);
    __syncthreads();
    LAS bf16_t* stg = (LAS bf16_t*)(lds + wid * 8192);
#pragma unroll
    for (int r = 0; r < 16; ++r) { const int orow = crow(r, hi);
#pragma unroll
        for (int d0 = 0; d0 < 4; ++d0) stg[orow * 128 + d0 * 32 + r32] = f2bf(o[d0][r] * rli[r]); }
    asm volatile("s_waitcnt lgkmcnt(0)" ::: "memory");
    if (MODE != 1) {
        const int ch = lane & 15, c = h * VH + ch * 8;
        const f32x4 w0a = *(const f32x4*)(T.conv_w + c), w0b = *(const f32x4*)(T.conv_w + c + 4), w1a = *(const f32x4*)(T.conv_w + DM + c), w1b = *(const f32x4*)(T.conv_w + DM + c + 4),
              w2a = *(const f32x4*)(T.conv_w + 2 * DM + c), w2b = *(const f32x4*)(T.conv_w + 2 * DM + c + 4);
        const float cw0[8] = {w0a[0], w0a[1], w0a[2], w0a[3], w0b[0], w0b[1], w0b[2], w0b[3]}, cw1[8] = {w1a[0], w1a[1], w1a[2], w1a[3], w1b[0], w1b[1], w1b[2], w1b[3]},
                    cw2[8] = {w2a[0], w2a[1], w2a[2], w2a[3], w2b[0], w2b[1], w2b[2], w2b[3]};
#pragma unroll 4
        for (int i = 0; i < 8; ++i) { const int row = i * 4 + (lane >> 4); const int tt = qb * 256 + wid * QBLK + row; const size_t e = (size_t)(b * SEQ + tt) * DM + c;
            const u32x4 ov = *(const LAS u32x4*)(stg + row * 128 + ch * 8);
            const u32x4 u0 = *(const u32x4*)(T.u + e), gbv = *(const u32x4*)(T.gb + e), sgv = *(const u32x4*)(T.sg + e);
            u32x4 u1 = {0u, 0u, 0u, 0u}, u2 = {0u, 0u, 0u, 0u};
            if (tt >= 1) u1 = *(const u32x4*)(T.u + e - DM);
            if (tt >= 2) u2 = *(const u32x4*)(T.u + e - 2 * DM);
            u32x4 res;
#pragma unroll
            for (int q = 0; q < 4; ++q) {
                const float cl = cw0[2 * q] * bflo(u2[q]) + cw1[2 * q] * bflo(u1[q]) + cw2[2 * q] * bflo(u0[q]), chh = cw0[2 * q + 1] * bfhi(u2[q]) + cw1[2 * q + 1] * bfhi(u1[q]) + cw2[2 * q + 1] * bfhi(u0[q]);
                res[q] = cvt_pk_bf16(bflo(gbv[q]) * cl + bflo(sgv[q]) * bflo(ov[q]), bfhi(gbv[q]) * chh + bfhi(sgv[q]) * bfhi(ov[q])); }
            *(u32x4*)(T.merged + e) = res; }
    }
    asm volatile("s_waitcnt lgkmcnt(0)" ::: "memory");
    __syncthreads();
#undef SLOAD
#undef SWRITE
#undef RESC
}

constexpr int K2_BYTES = KVBLK * QKH * 2, V2_OFF = 0, K2_OFF = 3 * SHM_V, WS2_OFF = K2_OFF + 2 * K2_BYTES, ATT2_LDS = WS2_OFF + NW * 64 * 4;
__device__ __forceinline__ void qkt2(f32x16& p0, f32x16& p1, const LAS char* Krow, const int (&koff)[4], const bf16x8 (&qr)[12]) {
    p0 = f32x16{}; p1 = f32x16{};
#pragma unroll
    for (int d0 = 0; d0 < 12; ++d0) {
        const LAS char* a = Krow + (d0 >> 2) * 128 + koff[d0 & 3];
        const bf16x8 b0 = *(const LAS bf16x8*)a;
        const bf16x8 b1 = *(const LAS bf16x8*)(a + 32 * QKH * 2);
        p0 = __builtin_amdgcn_mfma_f32_32x32x16_bf16(b0, qr[d0], p0, 0, 0, 0);
        p1 = __builtin_amdgcn_mfma_f32_32x32x16_bf16(b1, qr[d0], p1, 0, 0, 0); }
}
template <int MODE> __device__ __forceinline__ void attn_unit2(const AttnArgs& T, int b, int h, int qb, LAS char* lds) {
    int tid = threadIdx.x; asm volatile("" : "+v"(tid));
    const int lane = tid & 63, r32 = lane & 31, hi = lane >> 5; const int wid = __builtin_amdgcn_readfirstlane(tid >> 6);
    LAS char* V_lds = lds + V2_OFF; LAS char* K_lds = lds + K2_OFF;
    LAS float* ws = (LAS float*)(lds + WS2_OFF) + wid * 64; LAS float* li_l = ws; LAS float* al_l = ws + 32;
    const int mrow = b * SEQ + qb * 256 + wid * QBLK + r32;
    const char* Kh = (const char*)(T.Kb + (size_t)(b * NH + h) * SEQ * QKH); const char* Vh = (const char*)(T.Vb + (size_t)(b * NH + h) * SEQ * VH);
#define DMA_KV(t, kbuf, vbuf) do { const char* kt = Kh + (size_t)(t) * K2_BYTES; const char* vt = Vh + (size_t)(t) * SHM_V; int ln = lane; asm volatile("" : "+v"(ln)); \
    _Pragma("unroll") for (int _i = 0; _i < 3; ++_i) { const int q = (wid * 3 + _i) * 64 + ln, r = q / 24, cp = q - r * 24, c = (cp & ~7) | ((cp & 7) ^ ((r >> 1) & 7)); \
        __builtin_amdgcn_global_load_lds((const unsigned*)(kt + (unsigned)(r * 384 + c * 16)), (LAS unsigned*)(K_lds + (kbuf) * K2_BYTES + (wid * 3 + _i) * 1024), 16, 0, 0); } \
    _Pragma("unroll") for (int _i = 0; _i < 2; ++_i) { const int q = (wid * 2 + _i) * 64 + ln, sub = q >> 5, w = q & 31, kk = ((sub >> 2) << 3) | (w >> 2), k = (kk & ~0xC) | ((kk & 4) << 1) | ((kk & 8) >> 1), c = ((sub & 3) << 5) | ((w & 3) << 3); \
        __builtin_amdgcn_global_load_lds((const unsigned*)(vt + (unsigned)(k * 256 + c * 2)), (LAS unsigned*)(V_lds + (vbuf) * SHM_V + (wid * 2 + _i) * 1024), 16, 0, 0); } } while (0)
#define RESC(a) do { if (__any((a) < 1.f)) { if (hi == 0) al_l[r32] = (a); asm volatile("s_waitcnt lgkmcnt(0)" ::: "memory"); \
    _Pragma("unroll") for (int d = 0; d < 4; ++d) _Pragma("unroll") for (int r = 0; r < 16; ++r) o[d][r] *= al_l[crow(r, hi)]; } } while (0)
    DMA_KV(0, 0, 0);
    const int vb0 = (int)(uintptr_t)V_lds + v_rd_base(lane);
    const LAS char* Krow = K_lds + r32 * (QKH * 2);
    int koff[4];
    { const int sw = (r32 >> 1) & 7;
#pragma unroll
      for (int j = 0; j < 4; ++j) koff[j] = ((2 * j + hi) ^ sw) * 16; }
    bf16x8 qr[12];
    {
        const bf16_t* Qw = T.Q + (size_t)mrow * 1536 + h * QKH + hi * 8;
        u32x4 raw[12];
#pragma unroll
        for (int d0 = 0; d0 < 12; ++d0) raw[d0] = *(const u32x4*)(Qw + d0 * 16);
        const f32x2 sq2 = *(const f32x2*)(T.ssp + (size_t)mrow * 4); const float ssq = sq2[0] + sq2[1];
        float ss = 0.f;
#pragma unroll
        for (int d0 = 0; d0 < 12; ++d0)
#pragma unroll
            for (int e = 0; e < 4; ++e) { const float a = bflo(raw[d0][e]), c = bfhi(raw[d0][e]); ss += a * a + c * c; }
        { auto rr = __builtin_amdgcn_permlane32_swap(__float_as_uint(ss), __float_as_uint(ss), false, false); ss = __uint_as_float(rr[0]) + __uint_as_float(rr[1]); }
        const float rq2 = 1.f / (ssq * (1.f / QL) + EPS);
        const float rn = 1.f / sqrtf(ss * rq2 * (1.f / QKH) + EPS) * sqrtf(rq2);
#pragma unroll
        for (int d0 = 0; d0 < 8; ++d0) { const f32x4 g0 = *(const f32x4*)(T.q_g + d0 * 16 + hi * 8), g1 = *(const f32x4*)(T.q_g + d0 * 16 + hi * 8 + 4);
            u32x4 w; w.x = cvt_pk_bf16(bflo(raw[d0].x) * rn * g0[0], bfhi(raw[d0].x) * rn * g0[1]); w.y = cvt_pk_bf16(bflo(raw[d0].y) * rn * g0[2], bfhi(raw[d0].y) * rn * g0[3]);
            w.z = cvt_pk_bf16(bflo(raw[d0].z) * rn * g1[0], bfhi(raw[d0].z) * rn * g1[1]); w.w = cvt_pk_bf16(bflo(raw[d0].w) * rn * g1[2], bfhi(raw[d0].w) * rn * g1[3]);
            qr[d0] = *reinterpret_cast<bf16x8*>(&w); }
#pragma unroll
        for (int p = 0; p < 2; ++p) {
            const int ib = 16 * p + 8 * hi;
            float x1[8], x2[8];
            const f32x4 ga = *(const f32x4*)(T.q_g + 128 + ib), gb_ = *(const f32x4*)(T.q_g + 128 + ib + 4), gc = *(const f32x4*)(T.q_g + 160 + ib), gd = *(const f32x4*)(T.q_g + 160 + ib + 4);
            const float g1v[8] = {ga[0], ga[1], ga[2], ga[3], gb_[0], gb_[1], gb_[2], gb_[3]}, g2v[8] = {gc[0], gc[1], gc[2], gc[3], gd[0], gd[1], gd[2], gd[3]};
#pragma unroll
            for (int e = 0; e < 4; ++e) { x1[2 * e] = bflo(raw[8 + p][e]) * rn * g1v[2 * e]; x1[2 * e + 1] = bfhi(raw[8 + p][e]) * rn * g1v[2 * e + 1];
                                          x2[2 * e] = bflo(raw[10 + p][e]) * rn * g2v[2 * e]; x2[2 * e + 1] = bfhi(raw[10 + p][e]) * rn * g2v[2 * e + 1]; }
            float y1[8], y2[8];
#pragma unroll
            for (int jj = 0; jj < 4; ++jj) { const f32x4 c2 = *(const f32x4*)((const float*)T.cs + ((size_t)mrow * 32 + ib + 2 * jj) * 2);
                y1[2 * jj] = x1[2 * jj] * c2[0] - x2[2 * jj] * c2[1]; y2[2 * jj] = x2[2 * jj] * c2[0] + x1[2 * jj] * c2[1];
                y1[2 * jj + 1] = x1[2 * jj + 1] * c2[2] - x2[2 * jj + 1] * c2[3]; y2[2 * jj + 1] = x2[2 * jj + 1] * c2[2] + x1[2 * jj + 1] * c2[3]; }
            u32x4 w1, w2; w1.x = cvt_pk_bf16(y1[0], y1[1]); w1.y = cvt_pk_bf16(y1[2], y1[3]); w1.z = cvt_pk_bf16(y1[4], y1[5]); w1.w = cvt_pk_bf16(y1[6], y1[7]);
            w2.x = cvt_pk_bf16(y2[0], y2[1]); w2.y = cvt_pk_bf16(y2[2], y2[3]); w2.z = cvt_pk_bf16(y2[4], y2[5]); w2.w = cvt_pk_bf16(y2[6], y2[7]);
            qr[8 + p] = *reinterpret_cast<bf16x8*>(&w1); qr[10 + p] = *reinterpret_cast<bf16x8*>(&w2); }
    }
    float m_reg = -1e30f, l_reg = 0.f; f32x16 o[4] = {};
    f32x16 pA0, pA1, pB0, pB1; float alA = 1.f, alB = 1.f; bf16x8 pa0, pa1, pa2, pa3;
    const int NT = 4 * qb + 4; const int wp = wid >> 1;
    const bool a1 = wp >= 1, a2 = wp >= 2, a3 = wp >= 3;
#define MASK(P0, P1, act) do { if (!(act)) { _Pragma("unroll") for (int r = 0; r < 16; ++r) { P0[r] = -INFINITY; P1[r] = -INFINITY; } } } while (0)
#define INTERVAL(PN0, PN1, PO0, PO1, alN, alO, t, act, load) do { \
        if (load) DMA_KV((t) + 1, ((t) + 1) & 1, vnext); \
        SBAR(); if (act) qkt2(PN0, PN1, Krow + ((t) & 1) * K2_BYTES, koff, qr); MASK(PN0, PN1, act); \
        if (MODE == 2) { asm volatile("" : "+v"(PO0), "+v"(PO1)); pa0 = __builtin_bit_cast(bf16x8, (u32x4){__float_as_uint(PO0[0]), __float_as_uint(PO0[1]), __float_as_uint(PO0[2]), __float_as_uint(PO0[3])}); pa1 = pa0; pa2 = pa0; pa3 = pa0; } \
        else finishSM(PO0, PO1, alO, l_reg, pa0, pa1, pa2, pa3); \
        SBAR(); pv_d0(o, vb0 + vprev * SHM_V, pa0, pa1, pa2, pa3); if (MODE == 2) { asm volatile("" : "+v"(PN0), "+v"(PN1)); } else partialSM(PN0, PN1, m_reg, alN); \
        __syncthreads(); RESC(alN); \
        vprev = vcur; vcur = vnext; vnext = (vnext == 2) ? 0 : vnext + 1; } while (0)
    __syncthreads();
    int vprev = 0, vcur = 1, vnext = 2;
    DMA_KV(1, 1, 1);
    qkt2(pA0, pA1, Krow, koff, qr); partialSM(pA0, pA1, m_reg, alA);
    __syncthreads();
    for (int j = 1; j + 3 < NT; j += 2) {
        INTERVAL(pB0, pB1, pA0, pA1, alB, alA, j, true, true);
        INTERVAL(pA0, pA1, pB0, pB1, alA, alB, j + 1, true, true);
    }
    INTERVAL(pB0, pB1, pA0, pA1, alB, alA, NT - 3, a1, true);
    INTERVAL(pA0, pA1, pB0, pB1, alA, alB, NT - 2, a2, true);
    INTERVAL(pB0, pB1, pA0, pA1, alB, alA, NT - 1, a3, false);
    finishSM(pB0, pB1, alB, l_reg, pa0, pa1, pa2, pa3); SBAR();
    pv_d0(o, vb0 + vprev * SHM_V, pa0, pa1, pa2, pa3);
#undef INTERVAL
#undef MASK
    if (hi == 0) li_l[r32] = l_reg; asm volatile("s_waitcnt lgkmcnt(0)" ::: "memory");
    float rli[16];
#pragma unroll
    for (int r = 0; r < 16; ++r) rli[r] = __builtin_amdgcn_rcpf(li_l[crow(r, hi)]);
    __syncthreads();
    LAS bf16_t* stg = (LAS bf16_t*)(lds + wid * 8192);
#pragma unroll
    for (int r = 0; r < 16; ++r) { const int orow = crow(r, hi);
#pragma unroll
        for (int d0 = 0; d0 < 4; ++d0) stg[orow * 128 + d0 * 32 + r32] = f2bf(o[d0][r] * rli[r]); }
    asm volatile("s_waitcnt lgkmcnt(0)" ::: "memory");
    if (MODE == 0) {
        const int g = lane >> 4, ch = lane & 15, c = h * VH + ch * 8; const int t0 = qb * 256 + wid * QBLK;
        const size_t e0 = (size_t)(b * SEQ + t0) * DM + c;
        u32x4 uu[8], gv[8], sv[8];
#pragma unroll
        for (int i = 0; i < 8; ++i) { const size_t e = e0 + (size_t)(4 * i + g) * DM; uu[i] = *(const u32x4*)(T.u + e); gv[i] = *(const u32x4*)(T.gb + e); sv[i] = *(const u32x4*)(T.sg + e); }
        u32x4 uvirt = {0u, 0u, 0u, 0u};
        if (g >= 2 && t0 > 0) uvirt = *(const u32x4*)(T.u + e0 - (size_t)(4 - g) * DM);
        const f32x4 w0a = *(const f32x4*)(T.conv_w + c), w0b = *(const f32x4*)(T.conv_w + c + 4), w1a = *(const f32x4*)(T.conv_w + DM + c), w1b = *(const f32x4*)(T.conv_w + DM + c + 4),
              w2a = *(const f32x4*)(T.conv_w + 2 * DM + c), w2b = *(const f32x4*)(T.conv_w + 2 * DM + c + 4);
        const float cw0[8] = {w0a[0], w0a[1], w0a[2], w0a[3], w0b[0], w0b[1], w0b[2], w0b[3]}, cw1[8] = {w1a[0], w1a[1], w1a[2], w1a[3], w1b[0], w1b[1], w1b[2], w1b[3]},
                    cw2[8] = {w2a[0], w2a[1], w2a[2], w2a[3], w2b[0], w2b[1], w2b[2], w2b[3]};
        const int src1 = ((lane - 16) & 63) << 2, src2 = (lane ^ 32) << 2;
#pragma unroll
        for (int i = 0; i < 8; ++i) { const int row = i * 4 + g; const size_t e = e0 + (size_t)row * DM;
            const u32x4 ov = *(const LAS u32x4*)(stg + row * 128 + ch * 8);
            const u32x4 up = (i == 0) ? uvirt : uu[i > 0 ? i - 1 : 0];
            u32x4 u1, u2, res;
#pragma unroll
            for (int q = 0; q < 4; ++q) { const unsigned x1 = (g == 3) ? up[q] : uu[i][q], x2 = (g >= 2) ? up[q] : uu[i][q];
                u1[q] = (unsigned)__builtin_amdgcn_ds_bpermute(src1, (int)x1); u2[q] = (unsigned)__builtin_amdgcn_ds_bpermute(src2, (int)x2); }
#pragma unroll
            for (int q = 0; q < 4; ++q) {
                const float cl = cw0[2 * q] * bflo(u2[q]) + cw1[2 * q] * bflo(u1[q]) + cw2[2 * q] * bflo(uu[i][q]), chh = cw0[2 * q + 1] * bfhi(u2[q]) + cw1[2 * q + 1] * bfhi(u1[q]) + cw2[2 * q + 1] * bfhi(uu[i][q]);
                res[q] = cvt_pk_bf16(bflo(gv[i][q]) * cl + bflo(sv[i][q]) * bflo(ov[q]), bfhi(gv[i][q]) * chh + bfhi(sv[i][q]) * bfhi(ov[q])); }
            *(u32x4*)(T.merged + e) = res; }
    }
    asm volatile("s_waitcnt lgkmcnt(0)" ::: "memory");
    __syncthreads();
#undef DMA_KV
#undef RESC
}
#undef SBAR
}
#ifndef ATTN_UNIT
#define ATTN_UNIT attn_unit2
#endif
struct Frame {
    LAS unsigned char* lds; volatile LAS unsigned* MISC; unsigned* ctl;
    int tid, lane, wave, vcu, G;
};
__device__ __forceinline__ float wave_sum(float v) {
#pragma unroll
    for (int o = 1; o < 64; o <<= 1) v += __shfl_xor(v, o);
    return v;
}
__device__ __forceinline__ int tcc(int bj, int ch128) { return (bj << 7) | (ch128 & 0x60) | (((ch128 >> 2) & 1) << 4) | (((ch128 >> 3) & 3) << 2) | (ch128 & 3); }
struct MapIn { __device__ __forceinline__ int operator()(int c) const {
    if (c < C_ZB) return 256 * (c >> 7) + tcc(0, c & 127);
    if (c < C_ZC) { const int ch = c - C_ZB; return 256 * (8 + (ch >> 7)) + tcc(0, ch & 127); }
    if (c < C_QL) { const int ch = c - C_ZC; return 256 * (ch >> 7) + tcc(1, ch & 127); }
    if (c < C_KVL) { const int j = c - C_QL; return j < 256 ? 256 * 20 + permL(j) : 256 * 21 + permL(j - 256); }
    if (c < C_KR) return 256 * 22 + permL(c - C_KVL);
    if (c < C_GC) { const int j = c - C_KR, jj = j & 31; return 256 * 21 + 128 + ((jj >> 4) << 5) + ((j >> 5) << 4) + (((jj >> 2) & 3) << 2) + (jj & 3); }
    if (c < C_GM) { const int ch = c - C_GC; return 256 * (8 + (ch >> 7)) + tcc(1, ch & 127); }
    { const int j = c - C_GM; return 256 * (16 + (j >> 8)) + permL(j & 255); } } };
struct MapPerm { __device__ __forceinline__ int operator()(int c) const { return (c & ~255) | permL(c & 255); } };
struct MapId { __device__ __forceinline__ int operator()(int c) const { return c; } };
struct MapGU { int n; __device__ __forceinline__ int operator()(int f) const { const int r = f & 127; return 256 * (f >> 7) + ((((r >> 2) & 1) << 7) | ((r >> 5) << 5) | (n << 4) | (((r >> 3) & 3) << 2) | (r & 3)); } };

template <class RowMap>
__device__ __forceinline__ void transpose_item(const float* W, int N, bf16_t* WT, int ldt, const float* kscale, LAS float* scr, int item, int lane, const RowMap& rm) {
    const int nblk = N / 32, kb = item / nblk, nb = item % nblk, k0 = 64 * kb, n0 = 32 * nb;
    float wv[32];
#pragma unroll
    for (int i = 0; i < 32; ++i) wv[i] = W[(size_t)(k0 + 2 * i + (lane >> 5)) * N + n0 + (lane & 31)];
#pragma unroll
    for (int i = 0; i < 32; ++i) { const int kk = 2 * i + (lane >> 5); const float sc = kscale ? kscale[k0 + kk] : 1.f; scr[kk * 33 + (lane & 31)] = wv[i] * sc; }
    asm volatile("s_waitcnt lgkmcnt(0)" ::: "memory");
    const int c = lane & 7;
#pragma unroll
    for (int j = 0; j < 4; ++j) { const int n = (lane >> 3) + 8 * j; const LAS float* s = scr + (8 * c) * 33 + n;
        u32x4 o; o.x = cvt_pk_bf16(s[0 * 33], s[1 * 33]); o.y = cvt_pk_bf16(s[2 * 33], s[3 * 33]); o.z = cvt_pk_bf16(s[4 * 33], s[5 * 33]); o.w = cvt_pk_bf16(s[6 * 33], s[7 * 33]);
        *(u32x4*)(WT + (size_t)rm(n0 + n) * ldt + k0 + 8 * c) = o; }
    asm volatile("s_waitcnt lgkmcnt(0)" ::: "memory");
}
constexpr size_t WS_WIN = WS_WSMALL, WS_WQ = WS_WIN + (size_t)5888 * 1024 * 2, WS_WKV = WS_WQ + (size_t)1536 * 384 * 2, WS_WO = WS_WKV + (size_t)2048 * 256 * 2;
static_assert(WS_WO + (size_t)1024 * 1024 * 2 <= WS_A, "small weights fit below region A");
constexpr size_t WS_EGU = WS_C, WS_EDN = WS_C + (size_t)NEXP * 512 * 1024 * 2;
static_assert(WS_EDN + (size_t)NEXP * 1024 * 256 * 2 <= WS_D, "expert weights fit region C");

__device__ __forceinline__ void p0_weights_tables(const Ptrs& P, Frame& F) {
    LAS float* scr = (LAS float*)(F.lds + RING_OFF + F.wave * 16384);
    const int gw = F.vcu * NWAVES + F.wave, NGW = F.G * NWAVES;
    constexpr int I_IN = (DM / 64) * (DIN / 32), I_Q = (QL / 64) * (1536 / 32), I_KV = (KVL / 64) * (2048 / 32), I_O = (DM / 64) * (DM / 32);
    for (int it = gw; it < I_IN + I_Q + I_KV + I_O; it += NGW) {
        int r = it;
        if (r < I_IN) { transpose_item(P.w_in, DIN, (bf16_t*)(P.ws + WS_WIN), DM, (const float*)nullptr, scr, r, F.lane, MapIn{}); continue; } r -= I_IN;
        if (r < I_Q) { transpose_item(P.w_q_b, 1536, (bf16_t*)(P.ws + WS_WQ), QL, P.q_a_g, scr, r, F.lane, MapPerm{}); continue; } r -= I_Q;
        if (r < I_KV) { transpose_item(P.w_kv_b, 2048, (bf16_t*)(P.ws + WS_WKV), KVL, P.kv_a_g, scr, r, F.lane, MapPerm{}); continue; } r -= I_KV;
        transpose_item(P.w_o, DM, (bf16_t*)(P.ws + WS_WO), DM, (const float*)nullptr, scr, r, F.lane, MapPerm{});
    }
    {
        const int gt = F.vcu * 512 + F.tid;
        if (gt < 64 * 128) { const int rr = 192 + (gt >> 7), ch = gt & 127; *(u32x4*)((bf16_t*)(P.ws + WS_WIN) + (size_t)(256 * 21 + rr) * DM + ch * 8) = (u32x4){0u, 0u, 0u, 0u}; } }
    {
        float2* cs = (float2*)(P.ws + WS_CS);
        for (int idx = F.vcu * 512 + F.tid; idx < M * 32; idx += F.G * 512) { const int m = idx >> 5, i = idx & 31;
            const double inv = exp2(-(double)(2 * i) * (13.287712379549449 / 64.0));
            const double ang = (double)P.pos[m] * inv; float2 v; v.x = (float)cos(ang); v.y = (float)sin(ang); cs[idx] = v; } }
    asm volatile("s_waitcnt vmcnt(0) lgkmcnt(0)" ::: "memory"); __syncthreads();
}
__device__ __forceinline__ void p0_mod(const Ptrs& P, Frame& F) {
    if (F.vcu < 192) {
        LAS float* cact = (LAS float*)(F.lds + RING_OFF); LAS float* red = (LAS float*)(F.lds + RING_OFF + 65536);
        for (int idx = F.tid; idx < BATCH * DM; idx += 512) { const float cv = P.c[idx]; cact[idx] = cv / (1.f + __expf(-cv)); }
        __syncthreads();
        const int n0 = 32 * F.vcu, kl = F.lane >> 3, c4 = F.lane & 7;
        f32x4 acc[16];
#pragma unroll
        for (int b = 0; b < 16; ++b) acc[b] = (f32x4){0.f, 0.f, 0.f, 0.f};
        for (int it = 0; it < 16; ++it) { const int k = 128 * F.wave + 8 * it + kl;
            const f32x4 wv = *(const f32x4*)(P.w_ada + (size_t)k * 6144 + n0 + 4 * c4);
#pragma unroll
            for (int b = 0; b < 16; ++b) acc[b] += cact[b * DM + k] * wv; }
#pragma unroll
        for (int b = 0; b < 16; ++b)
#pragma unroll
            for (int e = 0; e < 4; ++e) { float v = acc[b][e]; v += __shfl_xor(v, 8); v += __shfl_xor(v, 16); v += __shfl_xor(v, 32); if (kl == 0) red[(F.wave * 16 + b) * 32 + 4 * c4 + e] = v; }
        __syncthreads();
        { const int b = F.tid >> 5, cc = F.tid & 31; float s = P.b_ada[n0 + cc];
#pragma unroll
          for (int w = 0; w < 8; ++w) s += red[(w * 16 + b) * 32 + cc];
          ((float*)(P.ws + WS_MOD))[b * 6144 + n0 + cc] = s; }
        __syncthreads();
    }
}
__device__ __forceinline__ void expert_weight_items(const Ptrs& P, Frame& F, int w, int nw, int k_lo, int k_hi) {
    LAS float* scr = (LAS float*)(F.lds + RING_OFF + F.wave * 16384);
    constexpr int I_G = (DM / 64) * (DEXP / 32), I_D = (DEXP / 64) * (DM / 32);
    for (int k = k_lo; k < k_hi; ++k) { const int it = w + k * nw; if (it >= NEXP * (2 * I_G + I_D)) break;
        const int e = it / (2 * I_G + I_D); int r = it % (2 * I_G + I_D);
        bf16_t* gu = (bf16_t*)(P.ws + WS_EGU) + (size_t)e * 512 * DM; bf16_t* dn = (bf16_t*)(P.ws + WS_EDN) + (size_t)e * DM * DEXP;
        if (r < I_G) { transpose_item(P.w_gate + (size_t)e * DM * DEXP, DEXP, gu, DM, (const float*)nullptr, scr, r, F.lane, MapGU{0}); continue; } r -= I_G;
        if (r < I_G) { transpose_item(P.w_up + (size_t)e * DM * DEXP, DEXP, gu, DM, (const float*)nullptr, scr, r, F.lane, MapGU{1}); continue; } r -= I_G;
        transpose_item(P.w_down + (size_t)e * DEXP * DM, DM, dn, DEXP, (const float*)nullptr, scr, r, F.lane, MapPerm{});
    }
}
__device__ __forceinline__ void p1_norm1(const Ptrs& P, Frame& F) {
    const int gw = F.vcu * NWAVES + F.wave, NGW = F.G * NWAVES;
    bf16_t* h = (bf16_t*)(P.ws + WS_A);
    for (int m = gw; m < M; m += NGW) {
        const float* mod = (const float*)(P.ws + WS_MOD) + (m / SEQ) * 6144;
        const f32x4* xr = (const f32x4*)(P.x + (size_t)m * DM) + F.lane;
        f32x4 v[4]; float s = 0.f;
#pragma unroll
        for (int j = 0; j < 4; ++j) { v[j] = xr[64 * j]; s += (v[j][0] * v[j][0] + v[j][1] * v[j][1]) + (v[j][2] * v[j][2] + v[j][3] * v[j][3]); }
        const float rstd = 1.f / sqrtf(wave_sum(s) * (1.f / DM) + EPS);
        unsigned long long* o8 = (unsigned long long*)(h + (size_t)m * DM) + F.lane;
#pragma unroll
        for (int j = 0; j < 4; ++j) { const int d = 4 * F.lane + 256 * j;
            const f32x4 g = *(const f32x4*)(P.norm1_g + d), sc = *(const f32x4*)(mod + 1024 + d), sh = *(const f32x4*)(mod + d);
            const f32x4 r = v[j] * rstd * g * (sc + 1.f) + sh;
            o8[64 * j] = (unsigned long long)cvt_pk_bf16(r[0], r[1]) | ((unsigned long long)cvt_pk_bf16(r[2], r[3]) << 32); }
    }
}

constexpr size_t WS_WR = 30 * MiB;
constexpr size_t WS_STOK = WS_RT + 512 * 1024, WS_SW = WS_STOK + 320 * 1024;
constexpr int MAXROWS = 81920, MAXTILES = 320;
constexpr size_t WS_H2 = WS_B, WS_HACT = WS_B + 64 * MiB;
constexpr size_t WS_X1B = WS_B + 128 * MiB;
constexpr size_t WS_DELTA = WS_D, WS_Y0 = WS_A, WS_Y1 = WS_D + 64 * MiB;
constexpr int CW_T = CW_TILES, CW_T0 = CW_TILES + 1, CW_TGRP = CW_TILES + 64;

__device__ __forceinline__ void p0_router_weights(const Ptrs& P, Frame& F) {
    bf16_t* hi = (bf16_t*)(P.ws + WS_WR); bf16_t* lo = hi + 48 * DM;
    for (int idx = F.vcu * 512 + F.tid; idx < 48 * DM; idx += F.G * 512) { const int o = idx >> 10, k = idx & 1023;
        const float v = o < 4 ? P.w_rg[k * 4 + o] : (o < 36 ? P.w_re[k * 32 + o - 4] : 0.f);
        const bf16_t h = f2bf(v); hi[idx] = h; lo[idx] = f2bf(v - bf2f(h)); }
}
template <int MODE> __device__ __forceinline__ void p6_rows(const Ptrs& P, Frame& F) {
    LAS unsigned char* tile = F.lds + RING_OFF + F.wave * 8192;
    LAS float* lg = (LAS float*)(F.lds + RING_OFF + 65536 + F.wave * 1536);
    LAS unsigned char* wch = F.lds + RING_OFF + 77824;
    LAS float* gms = (LAS float*)(F.lds + XCH_OFF);
    LAS unsigned* hist = (LAS unsigned*)(F.lds + LDSCTL_OFF + 1024);
    const bf16_t* WrHi = (const bf16_t*)(P.ws + WS_WR); const bf16_t* WrLo = WrHi + 48 * DM;
    bf16_t* h2 = (bf16_t*)(P.ws + WS_H2); const bf16_t* dl = (const bf16_t*)(P.ws + WS_DELTA); bf16_t* x1b = (bf16_t*)(P.ws + WS_X1B);
    int2* rte = (int2*)(P.ws + WS_RT); float2* rtw = (float2*)(P.ws + WS_RT + 256 * 1024);
    const int t = F.lane & 15, q = F.lane >> 4;
    for (int rb = F.vcu; rb < M / 128; rb += F.G) {
        const int m0 = rb * 128 + F.wave * 16, b = m0 / SEQ;
        const float* mod = (const float*)(P.ws + WS_MOD) + b * 6144;
        __syncthreads();
        if (F.tid < 64) hist[F.tid] = 0u;
        for (int k = F.tid; k < DM; k += 512) { gms[k] = P.norm2_g[k] * (1.f + mod[4096 + k]); gms[DM + k] = mod[3072 + k]; }
        __syncthreads();
#pragma unroll 1
        for (int hb = 0; hb < 2; ++hb) {
            const int mb = m0 + 8 * hb;
            f32x4 xv[8][4]; float rstd[8];
#pragma unroll
            for (int r = 0; r < 8; ++r) { const f32x4* xr = (const f32x4*)(P.x + (size_t)(mb + r) * DM) + F.lane; const u32x2* dr = (const u32x2*)(dl + (size_t)(mb + r) * DM) + F.lane;
#pragma unroll
                for (int c = 0; c < 4; ++c) { const f32x4 x4 = xr[64 * c]; const u32x2 d = dr[64 * c];
                    xv[r][c][0] = x4[0] + __uint_as_float(d.x << 16); xv[r][c][1] = x4[1] + __uint_as_float(d.x & 0xffff0000u); xv[r][c][2] = x4[2] + __uint_as_float(d.y << 16); xv[r][c][3] = x4[3] + __uint_as_float(d.y & 0xffff0000u); } }
#pragma unroll
            for (int r = 0; r < 8; ++r) { float s = 0.f;
#pragma unroll
                for (int c = 0; c < 4; ++c) s += (xv[r][c][0] * xv[r][c][0] + xv[r][c][1] * xv[r][c][1]) + (xv[r][c][2] * xv[r][c][2] + xv[r][c][3] * xv[r][c][3]);
                rstd[r] = 1.f / sqrtf(wave_sum(s) * (1.f / DM) + EPS); }
            f32x4 acc[3];
#pragma unroll
            for (int cb = 0; cb < 3; ++cb) acc[cb] = (f32x4){0.f, 0.f, 0.f, 0.f};
#pragma unroll
            for (int c = 0; c < 4; ++c) {
                const int k0 = 256 * c + 4 * F.lane;
                __syncthreads();
#pragma unroll
                for (int j = 0; j < 6; ++j) { const int id = F.tid + 512 * j, arr = id / 1536, rem = id - arr * 1536, row = rem >> 5, ch = rem & 31;
                    *(LAS u32x4*)(wch + arr * 24576 + row * 512 + ((ch ^ (row & 15)) << 4)) = *(const u32x4*)((arr ? WrLo : WrHi) + (size_t)row * DM + 256 * c + 8 * ch); }
                const f32x4 gm = *(const LAS f32x4*)(gms + k0), sh = *(const LAS f32x4*)(gms + DM + k0);
#pragma unroll
                for (int r = 0; r < 8; ++r) { const f32x4 h = xv[r][c] * rstd[r] * gm + sh;
                    u32x2 hi; hi.x = cvt_pk_bf16(h[0], h[1]); hi.y = cvt_pk_bf16(h[2], h[3]);
                    u32x2 lo; lo.x = cvt_pk_bf16(h[0] - __uint_as_float(hi.x << 16), h[1] - __uint_as_float(hi.x & 0xffff0000u)); lo.y = cvt_pk_bf16(h[2] - __uint_as_float(hi.y << 16), h[3] - __uint_as_float(hi.y & 0xffff0000u));
                    *(u32x2*)(h2 + (size_t)(mb + r) * DM + k0) = hi;
                    const int off = r * 512 + ((((F.lane >> 1) ^ r) & 31) << 4) + ((F.lane & 1) << 3);
                    *(LAS u32x2*)(tile + off) = hi; *(LAS u32x2*)(tile + 4096 + off) = lo; }
                asm volatile("s_waitcnt vmcnt(0) lgkmcnt(0)" ::: "memory");
                __syncthreads();
#pragma unroll 2
                for (int ks = 0; ks < (MODE == 1 ? 0 : 8); ++ks) { const int tr = t & 7;
                    const int off = tr * 512 + ((((4 * ks + q) ^ tr) & 31) << 4);
                    const bf16x8 bh = *(const LAS bf16x8*)(tile + off), bl = *(const LAS bf16x8*)(tile + 4096 + off);
#pragma unroll
                    for (int cb = 0; cb < 3; ++cb) { const int woff = (16 * cb + t) * 512 + ((((4 * ks + q) ^ t) & 31) << 4);
                        const bf16x8 wh = *(const LAS bf16x8*)(wch + woff), wl = *(const LAS bf16x8*)(wch + 24576 + woff);
                        acc[cb] = __builtin_amdgcn_mfma_f32_16x16x32_bf16(wh, bh, acc[cb], 0, 0, 0);
                        acc[cb] = __builtin_amdgcn_mfma_f32_16x16x32_bf16(wh, bl, acc[cb], 0, 0, 0);
                        acc[cb] = __builtin_amdgcn_mfma_f32_16x16x32_bf16(wl, bh, acc[cb], 0, 0, 0); } }
                asm volatile("s_waitcnt lgkmcnt(0)" ::: "memory");
            }
            if (t < 8) {
#pragma unroll
                for (int cb = 0; cb < 3; ++cb)
#pragma unroll
                    for (int r = 0; r < 4; ++r) lg[t * 48 + 16 * cb + 4 * q + r] = acc[cb][r]; }
            asm volatile("s_waitcnt lgkmcnt(0)" ::: "memory");
            if (MODE != 1 && q == 0 && t < 8) {
                const int m = mb + t;
                const LAS float* l = lg + t * 48;
                float gl[4];
#pragma unroll
                for (int i = 0; i < 4; ++i) gl[i] = l[i] + P.b_rg[i];
                int g = 0; float gmx = gl[0];
#pragma unroll
                for (int i = 1; i < 4; ++i) if (gl[i] > gmx) { gmx = gl[i]; g = i; }
                float se = 0.f;
#pragma unroll
                for (int i = 0; i < 4; ++i) se += __expf(gl[i] - gmx);
                const float pg = 1.f / se;
                float e0v = -3.0e38f, e1v = -3.0e38f; int i0 = 0, i1 = 0;
#pragma unroll
                for (int i = 0; i < 8; ++i) { const float v = l[4 + g * 8 + i] + P.b_re[g * 8 + i];
                    if (v > e0v) { e1v = e0v; i1 = i0; e0v = v; i0 = i; } else if (v > e1v) { e1v = v; i1 = i; } }
                const float p1 = __expf(e1v - e0v), w0 = 1.f / (1.f + p1), w1 = p1 * w0;
                int2 e; e.x = g * 8 + i0; e.y = g * 8 + i1; float2 w; w.x = w0 * pg; w.y = w1 * pg;
                rte[m] = e; rtw[m] = w;
                __hip_atomic_fetch_add(&hist[e.x], 1u, __ATOMIC_RELAXED, __HIP_MEMORY_SCOPE_WORKGROUP); __hip_atomic_fetch_add(&hist[32 + e.y], 1u, __ATOMIC_RELAXED, __HIP_MEMORY_SCOPE_WORKGROUP);
            }
            asm volatile("s_waitcnt lgkmcnt(0)" ::: "memory");
        }
        __syncthreads();
        if (MODE != 1 && F.tid < 64) F.ctl[CW_HIST + rb * 64 + F.tid] = hist[F.tid];
    }
    __syncthreads();
}
__device__ __forceinline__ void p7_sort(const Ptrs& P, Frame& F) {
    LAS unsigned* tot = (LAS unsigned*)(F.lds + RING_OFF);
    LAS unsigned* pre = tot + 64;
    LAS unsigned* rbase = pre + 64;
    LAS unsigned* cnt = rbase + 64;
    LAS unsigned* misc = cnt + 64;
    int* stok = (int*)(P.ws + WS_STOK); float* sw = (float*)(P.ws + WS_SW);
    const int2* rte = (const int2*)(P.ws + WS_RT); const float2* rtw = (const float2*)(P.ws + WS_RT + 256 * 1024);
    const int cw = F.vcu * 7 + F.wave - 1, cnw = F.G * 7; bool first = true;
    for (int rb = F.vcu; rb < M / 128; rb += F.G) {
        __syncthreads();
        if (first && F.wave > 0) expert_weight_items(P, F, cw, cnw, 0, 2);
        if (F.tid < 64) { unsigned s = 0u, p = 0u;
            for (int r2 = 0; r2 < M / 128; ++r2) { const unsigned v = F.ctl[CW_HIST + r2 * 64 + F.tid]; if (r2 == rb) p = s; s += v; }
            tot[F.tid] = s; pre[F.tid] = p; cnt[F.tid] = 0u; }
        __syncthreads();
        if (first && F.wave > 0) expert_weight_items(P, F, cw, cnw, 2, 4);
        if (F.tid == 0) { unsigned tb = 0u;
            for (int g = 0; g < 64; ++g) { if (g == 32) misc[1] = tb; rbase[g] = tb * 256u; const unsigned nt = (tot[g] + 255u) >> 8;
                if (rb == 0) for (unsigned k = 0; k < nt; ++k) F.ctl[CW_TGRP + tb + k] = (unsigned)g;
                tb += nt; }
            misc[0] = tb; if (rb == 0) { F.ctl[CW_T] = tb; F.ctl[CW_T0] = misc[1]; } }
        __syncthreads();
        if (F.wave == 0) {
            const unsigned long long ltmask = (1ull << F.lane) - 1ull;
            for (int ch = 0; ch < 2; ++ch) { const int m = rb * 128 + ch * 64 + F.lane; const int2 e = rte[m]; const float2 w = rtw[m];
                for (int j = 0; j < 2; ++j) { const int ex = j ? e.y : e.x; const float wj = j ? w.y : w.x; unsigned rank = 0u, gsz = 0u;
                    for (int x = 0; x < 32; ++x) { const unsigned long long mk = __ballot(ex == x); if (ex == x) { rank = (unsigned)__popcll(mk & ltmask); gsz = (unsigned)__popcll(mk); } }
                    const int g = j * 32 + ex; const unsigned pos = rbase[g] + pre[g] + cnt[g] + rank;
                    stok[pos] = m; sw[pos] = wj;
                    asm volatile("s_waitcnt lgkmcnt(0)" ::: "memory");
                    if (rank == 0u) cnt[g] += gsz;
                    asm volatile("s_waitcnt lgkmcnt(0)" ::: "memory"); } } }
        if (rb < 64) { const unsigned n = tot[rb], padn = (((n + 255u) >> 8) << 8) - n;
            if ((unsigned)F.tid < padn) { stok[rbase[rb] + n + F.tid] = -1; sw[rbase[rb] + n + F.tid] = 0.f; } }
        if (first && F.wave > 0) expert_weight_items(P, F, cw, cnw, 4, 1 << 20);
        first = false;
    }
}
struct MoeSched {
    const bf16_t* A; const bf16_t* W; int lda, ldb; const int* stok; const unsigned* tgrp; int t_lo, nun, npn, G, c; size_t wstride; bool gather, split;
    __device__ bool next(int i, Unit& u) const {
        const int idx = i * G + c, nfull = (nun / G) * G, tail = nun - nfull; int U; u.half = 0;
        if (split && tail > 0 && 2 * tail <= G) { if (idx >= nfull + 2 * tail) return false; if (idx < nfull) U = idx; else { U = nfull + ((idx - nfull) >> 1); u.half = 1 + ((idx - nfull) & 1); } }
        else { if (idx >= nun) return false; U = idx; }
        u.aux = t_lo + U / npn; u.pn = U % npn; u.pm = (int)tgrp[u.aux]; return true; }
    __device__ __forceinline__ const char* abase(const Unit& u) const { return gather ? (const char*)A : (const char*)A + (size_t)(u.aux * BM + (u.half == 2 ? HALF : 0)) * lda * 2; }
    __device__ __forceinline__ const char* bbase(const Unit& u) const { return (const char*)W + (size_t)(u.pm & 31) * wstride + (size_t)u.pn * BM * ldb * 2; }
    __device__ __forceinline__ void avoff(const Unit& u, int R0, int C0, int R1, int C1, unsigned (&v0)[2], unsigned (&v1)[2]) const {
        if (gather) { const int* tk = stok + u.aux * BM + (u.half == 2 ? HALF : 0); const int o1 = u.half ? 0 : HALF; int a = tk[R0], b = tk[R1], c2 = tk[o1 + R0], d = tk[o1 + R1];
            a = a < 0 ? 0 : a; b = b < 0 ? 0 : b; c2 = c2 < 0 ? 0 : c2; d = d < 0 ? 0 : d;
            v0[0] = (unsigned)(a * lda + C0) * 2u; v0[1] = (unsigned)(b * lda + C1) * 2u; v1[0] = (unsigned)(c2 * lda + C0) * 2u; v1[1] = (unsigned)(d * lda + C1) * 2u; }
        else { v0[0] = (unsigned)(R0 * lda + C0) * 2u; v0[1] = (unsigned)(R1 * lda + C1) * 2u; const unsigned h1 = u.half ? 0u : (unsigned)(HALF * lda * 2); v1[0] = v0[0] + h1; v1[1] = v0[1] + h1; } }
};
struct EpiGU {
    bf16_t* hact; const float* sw;
    __device__ __forceinline__ void operator()(const f32x4 (&acc)[2][2][4][2], const Unit& un, int wr, int wc, int fr, int fq) const {
        asm volatile("" : "+v"(fr), "+v"(fq));
        const int r0 = un.aux * BM + (un.half == 2 ? HALF : 0) + wr * 64 + fr, c0 = 128 * un.pn + 32 * wc + 8 * fq;
#pragma unroll
        for (int ai = 0; ai < 2; ++ai)
#pragma unroll
            for (int m = 0; m < 4; ++m) { if (ai == 1 && un.half) continue; const int row = r0 + ai * HALF + m * 16; const float w = sw[row];
                f32x4 a, b;
#pragma unroll
                for (int i = 0; i < 4; ++i) { const float g0 = acc[ai][0][m][0][i], g1 = acc[ai][1][m][0][i];
                    a[i] = g0 * fsigmoid(g0) * acc[ai][0][m][1][i] * w; b[i] = g1 * fsigmoid(g1) * acc[ai][1][m][1][i] * w; }
                *(u32x4*)(hact + (size_t)row * DEXP + c0) = pack8(a, b); }
    }
};
struct EpiDown {
    bf16_t* y0; bf16_t* y1; const int* stok;
    __device__ __forceinline__ void operator()(const f32x4 (&acc)[2][2][4][2], const Unit& un, int wr, int wc, int fr, int fq) const {
        asm volatile("" : "+v"(fr), "+v"(fq));
        const int r0 = un.aux * BM + wr * 64 + fr, c0 = 256 * un.pn + 32 * wc + 8 * fq;
        bf16_t* y = (un.pm >> 5) ? y1 : y0;
#pragma unroll
        for (int ai = 0; ai < 2; ++ai)
#pragma unroll
            for (int m = 0; m < 4; ++m) { const int tok = stok[r0 + ai * HALF + m * 16];
                if (tok >= 0) { bf16_t* orow = y + (size_t)tok * DM + c0;
                    *(u32x4*)(orow) = pack8(acc[ai][0][m][0], acc[ai][0][m][1]); *(u32x4*)(orow + HALF) = pack8(acc[ai][1][m][0], acc[ai][1][m][1]); } }
    }
};
__device__ __forceinline__ void p10_combine(const Ptrs& P, Frame& F) {
    const int gw = F.vcu * NWAVES + F.wave, NGW = F.G * NWAVES;
    const bf16_t* dl = (const bf16_t*)(P.ws + WS_DELTA); const bf16_t* y0 = (const bf16_t*)(P.ws + WS_Y0); const bf16_t* y1 = (const bf16_t*)(P.ws + WS_Y1);
    for (int m = gw; m < M; m += NGW) {
        const float* gate = (const float*)(P.ws + WS_MOD) + (m / SEQ) * 6144 + 5120;
        const f32x4* xr = (const f32x4*)(P.x + (size_t)m * DM) + F.lane; f32x4* orow = (f32x4*)(P.out + (size_t)m * DM) + F.lane;
        const u32x2* dr = (const u32x2*)(dl + (size_t)m * DM) + F.lane; const u32x2* a0 = (const u32x2*)(y0 + (size_t)m * DM) + F.lane; const u32x2* a1 = (const u32x2*)(y1 + (size_t)m * DM) + F.lane;
#pragma unroll
        for (int j = 0; j < 4; ++j) { const f32x4 xv = xr[64 * j]; const u32x2 d = dr[64 * j], p = a0[64 * j], q = a1[64 * j]; const f32x4 g = *(const f32x4*)(gate + 4 * F.lane + 256 * j);
            f32x4 o;
            o[0] = xv[0] + __uint_as_float(d.x << 16) + g[0] * (__uint_as_float(p.x << 16) + __uint_as_float(q.x << 16));
            o[1] = xv[1] + __uint_as_float(d.x & 0xffff0000u) + g[1] * (__uint_as_float(p.x & 0xffff0000u) + __uint_as_float(q.x & 0xffff0000u));
            o[2] = xv[2] + __uint_as_float(d.y << 16) + g[2] * (__uint_as_float(p.y << 16) + __uint_as_float(q.y << 16));
            o[3] = xv[3] + __uint_as_float(d.y & 0xffff0000u) + g[3] * (__uint_as_float(p.y & 0xffff0000u) + __uint_as_float(q.y & 0xffff0000u));
            orow[64 * j] = o; }
    }
}
struct Args { Ptrs P; int ph_lo, ph_hi, li, pad; };
constexpr int N_PHASES = 11;

typedef const __attribute__((address_space(4))) Args* KArgs;
__device__ __forceinline__ KArgs kargs() {
#if defined(__HIP_DEVICE_COMPILE__)
    unsigned off = 0u; asm volatile("" : "+s"(off));
    return (KArgs)((const __attribute__((address_space(4))) char*)__builtin_amdgcn_kernarg_segment_ptr() + off);
#else
    return nullptr;
#endif
}
__device__ __forceinline__ Ptrs load_ptrs() {
    Ptrs P{};
#if defined(__HIP_DEVICE_COMPILE__)
    const __attribute__((address_space(4))) unsigned long long* src = (const __attribute__((address_space(4))) unsigned long long*)kargs();
    unsigned long long w[sizeof(Ptrs) / 8];
#pragma unroll
    for (unsigned i = 0; i < sizeof(Ptrs) / 8; ++i) w[i] = src[i];
    __builtin_memcpy(&P, w, sizeof(Ptrs));
#endif
    return P;
}
#define WSPTRS \
    unsigned char* ws = P.ws; bf16_t* hA = (bf16_t*)(ws + WS_A); bf16_t* uB = (bf16_t*)(ws + WS_B); bf16_t* gbB = uB + (size_t)M * DM; bf16_t* sgB = gbB + (size_t)M * DM; \
    bf16_t* latC = (bf16_t*)(ws + WS_C); bf16_t* Kd = (bf16_t*)(ws + WS_D); bf16_t* Vd = (bf16_t*)(ws + WS_D + 96 * MiB); bf16_t* Qo = (bf16_t*)P.out; \
    float* ssp = (float*)(ws + WS_SSP); const float2* cs = (const float2*)(ws + WS_CS); const float* mod = (const float*)(ws + WS_MOD); \
    const int* stok = (const int*)(ws + WS_STOK); const float* sw = (const float*)(ws + WS_SW); bf16_t* h2 = (bf16_t*)(ws + WS_H2); bf16_t* hact = (bf16_t*)(ws + WS_HACT); \
    (void)hA; (void)uB; (void)gbB; (void)sgB; (void)latC; (void)Kd; (void)Vd; (void)Qo; (void)ssp; (void)cs; (void)mod; (void)stok; (void)sw; (void)h2; (void)hact;

__global__ void __launch_bounds__(NWAVES * 64, 2) fwd(Args args_unused) {
    extern __shared__ __attribute__((aligned(16))) unsigned char lds_raw[];
    Frame F;
    F.lds = (LAS unsigned char*)lds_raw;
    F.MISC = (volatile LAS unsigned*)(F.lds + MISC_OFF);
    F.tid = threadIdx.x; F.lane = F.tid & 63; F.wave = __builtin_amdgcn_readfirstlane(F.tid >> 6);
    F.G = gridDim.x; { const int bx = blockIdx.x; F.vcu = (F.G % 8 == 0) ? (bx % 8) * (F.G / 8) + bx / 8 : bx; }
    F.ctl = (unsigned*)(args_unused.P.ws + WS_CTL);
    for (int u = F.tid; u < (LDS_BYTES - LDSCTL_OFF) / 4; u += NWAVES * 64) ((LAS unsigned*)(F.lds + LDSCTL_OFF))[u] = 0u;
    __syncthreads();
    const int lo = args_unused.ph_lo, hi = args_unused.ph_hi;
    XcdBarrier bar; bar.bar = F.ctl + CW_BAR + args_unused.li * XCD_BAR_WORDS; bar.x = 0; bar.st = nullptr;
    if (hi - lo > 1) bar = xcd_barrier_post(F.ctl + CW_BAR + args_unused.li * XCD_BAR_WORDS, F.MISC + 8);
#ifdef ONLY_PHASE
#define IN(k) ((k) == ONLY_PHASE && lo <= (k) && (k) < hi)
#else
#define IN(k) (lo <= (k) && (k) < hi)
#endif
#ifndef PROBE_REPEAT
#define PROBE_REPEAT -1
#endif
#define REPS(k) for (int rep_ = 0; rep_ < ((k) == PROBE_REPEAT ? 2 : 1); ++rep_)
#define SEAM(k) do { if (IN(k) && IN((k) + 1)) xcd_barrier(bar); } while (0)

    if (IN(0)) { const Ptrs P = args_unused.P; REPS(0) { p0_router_weights(P, F); p0_mod(P, F); } SEAM(0); }
    if (IN(1)) { const Ptrs P = args_unused.P; REPS(1) { p1_norm1(P, F); p0_weights_tables(P, F); } SEAM(1); }
    if (IN(2)) {
        const Ptrs P = args_unused.P; WSPTRS
        DenseSched S; S.init(hA, DM, (const bf16_t*)(ws + WS_WIN), DM, M, 5888, F.G, (int)blockIdx.x, true, true);
        EpiIn E{uB, gbB, sgB, latC, ssp, cs, P.k_g, (LAS float*)(F.lds + XCH_OFF)};
        gemm_phase<false>(F.lds + RING_OFF, DM, S, E);
        if (PROBE_REPEAT == 2) gemm_phase<false>(F.lds + RING_OFF, DM, S, E);
        SEAM(2);
    }
    if (IN(3)) {
        const Ptrs P = args_unused.P; WSPTRS
        { DenseSched S; S.init(latC, LATW, (const bf16_t*)(ws + WS_WQ), QL, M, 1536, F.G, (int)blockIdx.x);
          EpiPlain E{Qo, 1536, 255};
          gemm_phase<false>(F.lds + RING_OFF, QL, S, E);
          if (PROBE_REPEAT == 30) gemm_phase<false>(F.lds + RING_OFF, QL, S, E); }
        { DenseSched S; S.init(latC + 512, LATW, (const bf16_t*)(ws + WS_WKV), KVL, M, 2048, F.G, (int)blockIdx.x);
          EpiKV E{Kd, Vd, latC, ssp, P.k_g, (LAS float*)(F.lds + XCH_OFF)};
          gemm_phase<false>(F.lds + RING_OFF, KVL, S, E);
          if (PROBE_REPEAT == 31) gemm_phase<false>(F.lds + RING_OFF, KVL, S, E);
          if (PROBE_REPEAT == 32) { EpiPlain E2{hA, 1024, 3}; gemm_phase<false>(F.lds + RING_OFF, KVL, S, E2); } }
        SEAM(3);
    }
    if (IN(4)) {
        const Ptrs P = args_unused.P; WSPTRS
        att::AttnArgs T{Qo, Kd, Vd, ssp, cs, P.q_g, uB, gbB, sgB, P.conv_w, hA};
        if (F.G == 256) {
            const int bh = F.vcu >> 1, sel = F.vcu & 1;
#pragma unroll 1
            for (int i = 0; i < 4; ++i) { const int qb = sel ? (i == 0 ? 6 : i == 1 ? 1 : i == 2 ? 5 : 2) : (i == 0 ? 7 : i == 1 ? 0 : i == 2 ? 4 : 3);
                att::ATTN_UNIT<0>(T, bh >> 3, bh & 7, qb, (LAS char*)(F.lds + RING_OFF)); }
            if (PROBE_REPEAT == 4 || PROBE_REPEAT == 41 || PROBE_REPEAT == 42) {
#pragma unroll 1
                for (int i = 0; i < 4; ++i) { const int qb = sel ? (i == 0 ? 6 : i == 1 ? 1 : i == 2 ? 5 : 2) : (i == 0 ? 7 : i == 1 ? 0 : i == 2 ? 4 : 3);
                    att::ATTN_UNIT<(PROBE_REPEAT == 41 ? 1 : PROBE_REPEAT == 42 ? 2 : 0)>(T, bh >> 3, bh & 7, qb, (LAS char*)(F.lds + RING_OFF)); } }
        } else {
#pragma unroll 1
            for (int U = F.vcu; U < BATCH * NH * 8; U += F.G) { const int bh = U >> 3; att::ATTN_UNIT<0>(T, bh >> 3, bh & 7, U & 7, (LAS char*)(F.lds + RING_OFF)); }
        }
        SEAM(4);
    }
    if (IN(5)) {
        const Ptrs P = args_unused.P; WSPTRS
        DenseSched S; S.init(hA, DM, (const bf16_t*)(ws + WS_WO), DM, M, DM, F.G, (int)blockIdx.x);
        EpiDelta E{mod, (bf16_t*)(ws + WS_DELTA)};
        gemm_phase<false>(F.lds + RING_OFF, DM, S, E);
        if (PROBE_REPEAT == 5) gemm_phase<false>(F.lds + RING_OFF, DM, S, E);
        SEAM(5);
    }
    if (IN(6)) { const Ptrs P = args_unused.P; p6_rows<0>(P, F); if (PROBE_REPEAT == 6) p6_rows<0>(P, F); if (PROBE_REPEAT == 61) p6_rows<1>(P, F); SEAM(6); }
    if (IN(7)) { const Ptrs P = args_unused.P; p7_sort(P, F); if (PROBE_REPEAT == 7) p7_sort(P, F); SEAM(7); }
    if (IN(8)) {
        const Ptrs P = args_unused.P; WSPTRS
        const int T = __builtin_amdgcn_readfirstlane((int)F.ctl[CW_T]);
        MoeSched S{h2, (const bf16_t*)(ws + WS_EGU), DM, DM, stok, F.ctl + CW_TGRP, 0, T * 2, 2, F.G, F.vcu, (size_t)512 * DM * 2, true, true};
        EpiGU E{hact, sw};
        gemm_phase<true>(F.lds + RING_OFF, DM, S, E);
        if (PROBE_REPEAT == 8) gemm_phase<true>(F.lds + RING_OFF, DM, S, E);
        SEAM(8);
    }
    if (IN(9)) {
        const Ptrs P = args_unused.P; WSPTRS
        const int T = __builtin_amdgcn_readfirstlane((int)F.ctl[CW_T]);
        MoeSched S{hact, (const bf16_t*)(ws + WS_EDN), DEXP, DEXP, stok, F.ctl + CW_TGRP, 0, T * 4, 4, F.G, F.vcu, (size_t)DM * DEXP * 2, false, false};
        EpiDown E{(bf16_t*)(ws + WS_Y0), (bf16_t*)(ws + WS_Y1), stok};
        gemm_phase<false>(F.lds + RING_OFF, DEXP, S, E);
        if (PROBE_REPEAT == 9) gemm_phase<false>(F.lds + RING_OFF, DEXP, S, E);
        SEAM(9);
    }
    if (IN(10)) { const Ptrs P = args_unused.P; REPS(10) p10_combine(P, F); }
#undef IN
#undef SEAM
}
}
#ifndef NV2_WMASK
#define NV2_WMASK 15
#endif
#ifndef BOTH_MASK
#define BOTH_MASK 0
#endif
#ifndef FAST_MASK
#define FAST_MASK 0x7f
#endif
#ifndef ONE_LAUNCH
#define ONE_LAUNCH 1
#endif

static void naive_forward(const Ptrs& P, hipStream_t st, int from, int to) {
    unsigned char* ws = P.ws;
    float* scratch = (float*)(ws + WS_D);
    if (from <= 0 && 0 <= to) {
        hipLaunchKernelGGL(nv_mod, dim3(6144 / 256, BATCH), dim3(256), 0, st, P);
        hipLaunchKernelGGL(nv_rope_table, dim3(M * 32 / 256), dim3(256), 0, st, P);
    }
    if (from <= 1 && 1 <= to) hipLaunchKernelGGL(nv_norm1, dim3(M), dim3(256), 0, st, P);
    if (from <= 2 && 2 <= to) {
        for (int b = 0; b < BATCH; ++b) {
            hipLaunchKernelGGL(nv_gemm<bf16_t>, dim3(DIN / 64, SEQ / 64), dim3(256), 0, st, (const bf16_t*)(ws + WS_A) + (size_t)b * SEQ * DM, DM, P.w_in, DIN, (const float*)nullptr, scratch, DIN, DM);
            hipLaunchKernelGGL(nv_z_post, dim3(SEQ), dim3(256), 0, st, P, (const float*)scratch, b, NV2_WMASK);
        }
    }
    if (from <= 3 && 3 <= to) {
        float* s3 = (float*)(ws + WS_A);
        for (int b = 0; b < BATCH; ++b) {
            const bf16_t* latb = (const bf16_t*)(ws + WS_C) + (size_t)b * SEQ * LATW;
            hipLaunchKernelGGL(nv_gemm<bf16_t>, dim3(1536 / 64, SEQ / 64), dim3(256), 0, st, latb, LATW, P.w_q_b, 1536, P.q_a_g, s3, 1536, QL);
            hipLaunchKernelGGL(nv_q_post, dim3(SEQ * 1536 / 256), dim3(256), 0, st, P, (const float*)s3, b);
            float* s3b = s3 + (size_t)SEQ * 1536;
            hipLaunchKernelGGL(nv_gemm<bf16_t>, dim3(2048 / 64, SEQ / 64), dim3(256), 0, st, latb + 512, LATW, P.w_kv_b, 2048, P.kv_a_g, s3b, 2048, KVL);
            hipLaunchKernelGGL(nv_kv_post, dim3(SEQ, NH), dim3(64), 0, st, P, (const float*)s3b, b);
        }
    }
    if (from <= 4 && 4 <= to) hipLaunchKernelGGL(nv_attn, dim3(SEQ, NH, BATCH), dim3(64), 0, st, P);
    if (from <= 5 && 5 <= to) {
        float* s5 = (float*)(ws + WS_C);
        for (int b = 0; b < BATCH; ++b) {
            hipLaunchKernelGGL(nv_gemm<bf16_t>, dim3(DM / 64, SEQ / 64), dim3(256), 0, st, (const bf16_t*)(ws + WS_A) + (size_t)b * SEQ * DM, DM, P.w_o, DM, (const float*)nullptr, s5, DM, DM);
            hipLaunchKernelGGL(nv_resid, dim3(SEQ * DM / 256), dim3(256), 0, st, P, (const float*)s5, b);
        }
    }
    if (from <= 6 && 6 <= to) hipLaunchKernelGGL(nv_norm2_router, dim3(M), dim3(256), 0, st, P);
    if (from <= 7 && 7 <= to) hipLaunchKernelGGL(nv_moe, dim3(M), dim3(256), 0, st, P);
}

extern "C" void kernel_launch(void* const* d_in, const int* in_sizes, int n_in, void* d_out, int out_size, void* d_ws, size_t ws_size, hipStream_t stream) {
    if (n_in != 23 || out_size != M * DM || ws_size < WS_END) { fprintf(stderr, "kernel_launch: unexpected shapes (n_in %d out %d ws %zu)\n", n_in, out_size, ws_size); return; }
    static int grid = 0;
    if (grid == 0) {
        int dev = 0, cus = 0;
        if (hipGetDevice(&dev) != hipSuccess || hipDeviceGetAttribute(&cus, hipDeviceAttributeMultiprocessorCount, dev) != hipSuccess) { fprintf(stderr, "kernel_launch: device query failed\n"); grid = -1; return; }
        if (hipFuncSetAttribute((const void*)fk::fwd, hipFuncAttributeMaxDynamicSharedMemorySize, fk::LDS_BYTES) != hipSuccess) { fprintf(stderr, "kernel_launch: hipFuncSetAttribute failed\n"); grid = -1; return; }
        grid = cus;
    }
    if (grid < 0) return;
    Ptrs P{};
    P.x = (const float*)d_in[0]; P.c = (const float*)d_in[1]; P.pos = (const int*)d_in[2];
    P.w_ada = (const float*)d_in[3]; P.b_ada = (const float*)d_in[4]; P.norm1_g = (const float*)d_in[5]; P.w_in = (const float*)d_in[6]; P.conv_w = (const float*)d_in[7];
    P.q_a_g = (const float*)d_in[8]; P.w_q_b = (const float*)d_in[9]; P.kv_a_g = (const float*)d_in[10]; P.w_kv_b = (const float*)d_in[11]; P.q_g = (const float*)d_in[12]; P.k_g = (const float*)d_in[13];
    P.w_o = (const float*)d_in[14]; P.norm2_g = (const float*)d_in[15]; P.w_rg = (const float*)d_in[16]; P.b_rg = (const float*)d_in[17]; P.w_re = (const float*)d_in[18]; P.b_re = (const float*)d_in[19];
    P.w_gate = (const float*)d_in[20]; P.w_up = (const float*)d_in[21]; P.w_down = (const float*)d_in[22];
    P.out = (float*)d_out; P.ws = (unsigned char*)d_ws;
    (void)hipMemsetAsync((char*)d_ws + WS_CTL, 0, 1 * MiB, stream);
    fk::Args a{}; a.P = P;
    if (ONE_LAUNCH) { a.ph_lo = 0; a.ph_hi = fk::N_PHASES; a.li = 0; hipLaunchKernelGGL(fk::fwd, dim3(grid), dim3(fk::NWAVES * 64), fk::LDS_BYTES, stream, a); }
    else for (int s = 0; s <= 7; ++s) {
        if (s < 6 && ((FAST_MASK >> s) & 1)) { a.ph_lo = s; a.ph_hi = s + 1; a.li = 0; hipLaunchKernelGGL(fk::fwd, dim3(grid), dim3(fk::NWAVES * 64), fk::LDS_BYTES, stream, a); }
        else if (s >= 6 && ((FAST_MASK >> 6) & 1)) { if (s == 6) for (int ph = 6; ph < fk::N_PHASES; ++ph) { a.ph_lo = ph; a.ph_hi = ph + 1; a.li = 0; hipLaunchKernelGGL(fk::fwd, dim3(grid), dim3(fk::NWAVES * 64), fk::LDS_BYTES, stream, a); } }
        else naive_forward(P, stream, s, s);
        if ((BOTH_MASK >> s) & 1) naive_forward(P, stream, s, s);
    }
}
```

```cpp
#define PROBE_REPEAT -1
#include <hip/hip_runtime.h>
#include <cstdio>
#include <cstdint>
#include <cmath>

constexpr int BATCH = 16, SEQ = 2048, DM = 1024, M = BATCH * SEQ;
constexpr int NH = 8, QKN = 128, QKR = 64, QKH = 192, VH = 128, QL = 384, KVL = 256;
constexpr int DIN = 5824, NEXP = 32, DEXP = 256;
constexpr int C_ZX = 0, C_ZB = 1024, C_ZC = 2048, C_QL = 3072, C_KVL = 3456, C_KR = 3712, C_GC = 3776, C_GM = 4800;
constexpr float EPS = 1e-6f;
constexpr int LATW = 768;

typedef unsigned short bf16_t;
typedef float f32x4 __attribute__((ext_vector_type(4)));

constexpr size_t MiB = 1u << 20;
constexpr size_t WS_CTL = 0;
constexpr size_t WS_MOD = 1 * MiB;
constexpr size_t WS_CS = 2 * MiB;
constexpr size_t WS_SSP = 10 * MiB;
constexpr size_t WS_RT = 12 * MiB;
constexpr size_t WS_WSMALL = 14 * MiB;
constexpr size_t WS_A = 32 * MiB;
constexpr size_t WS_B = 96 * MiB;
constexpr size_t WS_C = 288 * MiB;
constexpr size_t WS_D = 336 * MiB;
constexpr size_t WS_END = 496 * MiB;

__device__ __forceinline__ float bf2f(bf16_t v) { return __uint_as_float(((unsigned)v) << 16); }
__device__ __forceinline__ bf16_t f2bf(float f) { unsigned u = __float_as_uint(f); return (bf16_t)((u + 0x7fffu + ((u >> 16) & 1u)) >> 16); }

struct Ptrs {
    const float *x, *c; const int* pos;
    const float *w_ada, *b_ada, *norm1_g, *w_in, *conv_w, *q_a_g, *w_q_b, *kv_a_g, *w_kv_b, *q_g, *k_g, *w_o, *norm2_g;
    const float *w_rg, *b_rg, *w_re, *b_re, *w_gate, *w_up, *w_down;
    float* out; unsigned char* ws;
};

namespace fk {
#define LAS __attribute__((address_space(3)))
#define GAS __attribute__((address_space(1)))
typedef short bf16x8 __attribute__((ext_vector_type(8)));
typedef short s16x4 __attribute__((ext_vector_type(4)));
typedef unsigned u32x4 __attribute__((ext_vector_type(4)));
typedef unsigned u32x2 __attribute__((ext_vector_type(2)));
typedef float f32x2 __attribute__((ext_vector_type(2)));
typedef float f32x16 __attribute__((ext_vector_type(16)));
typedef GAS unsigned gu32;
#define RLX_AGENT __ATOMIC_RELAXED, __HIP_MEMORY_SCOPE_AGENT
constexpr int NWAVES = 8;
constexpr int BM = 256, BK = 64, HALF = 128, HTB = HALF * BK * 2, STAGE_BYTES = 8 * HTB, NXCD = 8, WGM = 8;
constexpr int RING_OFF = 0, RING_BYTES = 131072, XCH_OFF = 131072, XCH_BYTES = 8192, LDSCTL_OFF = XCH_OFF + XCH_BYTES, MISC_OFF = LDSCTL_OFF + 320, LDS_BYTES = 147456;
constexpr int CW_TMO = 0, CW_BAR = 4096;
constexpr int CW_HIST = 16384;
constexpr int CW_TILES = 40960;

typedef __bf16 bf16x2_t __attribute__((ext_vector_type(2)));
__device__ __forceinline__ unsigned cvt_pk_bf16(float lo, float hi) { f32x2 v = {lo, hi}; bf16x2_t b = __builtin_convertvector(v, bf16x2_t); return __builtin_bit_cast(unsigned, b); }
__device__ __forceinline__ float fsigmoid(float x) { return __builtin_amdgcn_rcpf(1.f + __expf(-x)); }

__host__ __device__ __forceinline__ int lds_byte(int r, int c) { const int st = (r >> 4) * 2 + (c >> 5), rr = r & 15, cc = c & 31, ob = rr * 64 + cc * 2; return st * 1024 + (ob ^ (((ob >> 9) & 1) << 5)); }
__host__ __device__ __forceinline__ void stage_rc(int b, int& R, int& C) { const int st = b / 1024, sb = b % 1024, swz = sb ^ (((sb >> 9) & 1) << 5); R = (st >> 1) * 16 + swz / 64; C = (st & 1) * 32 + (swz % 64) / 2; }
__host__ __device__ __forceinline__ int permL(int L) { return (L & 0xE0) | (((L >> 2) & 1) << 4) | (((L >> 3) & 3) << 2) | (L & 3); }

#define XB_TMO      128
#define XB_XCNT(j)  (256  + 64 * (j))
#define XB_XSUB(j)  (1280 + 64 * (j))
#define XB_XGEN(j)  (2304 + 64 * (j))
#define XB_TOP      3328
#define XB_TOPGEN   3392
#define XCD_BAR_WORDS 3456
#define XB_SPIN_CAP (1u << 18)
__device__ __forceinline__ unsigned xb_ld(unsigned* p)              { return __hip_atomic_load(p, __ATOMIC_RELAXED, __HIP_MEMORY_SCOPE_AGENT); }
__device__ __forceinline__ unsigned xb_add(unsigned* p, unsigned v) { return __hip_atomic_fetch_add(p, v, __ATOMIC_RELAXED, __HIP_MEMORY_SCOPE_AGENT); }
__device__ __forceinline__ unsigned xb_xcc_id() { return (unsigned)__builtin_amdgcn_s_getreg((3 << 11) | 20) & 0xFu; }
#define XB_SPIN(cond, bar) do { unsigned _sp = 0; while (cond) { __builtin_amdgcn_s_sleep(1); \
    if ((++_sp & 255u) == 0u) { if (xb_ld(&(bar)[XB_TMO])) break; if (_sp > XB_SPIN_CAP) { atomicAdd(&(bar)[XB_TMO], 1u); break; } } } } while (0)
struct XcdBarrier { unsigned* bar; unsigned x; volatile LAS unsigned* st; };
__device__ __forceinline__ XcdBarrier xcd_barrier_post(unsigned* bar, volatile LAS unsigned* st) {
    XcdBarrier b; b.bar = bar; b.x = xb_xcc_id(); b.st = st;
    if (threadIdx.x == 0) (void)xb_add(&bar[XB_XCNT(b.x)], 1u);
    return b;
}
__device__ __forceinline__ void xcd_barrier_complete(unsigned* bar, unsigned x, unsigned& nloc, unsigned& nx) {
    const unsigned G = gridDim.x * gridDim.y * gridDim.z;
    unsigned sum, cnt, mine, sp = 0u;
    for (;;) {
        sum = 0u; cnt = 0u; mine = 0u;
#pragma unroll
        for (unsigned j = 0; j < 16; ++j) { const unsigned c = xb_ld(&bar[XB_XCNT(j)]); sum += c; cnt += (c > 0u) ? 1u : 0u; mine = (j == x) ? c : mine; }
        if (sum == G) break;
        __builtin_amdgcn_s_sleep(1);
        if ((++sp & 255u) == 0u) { if (xb_ld(&bar[XB_TMO])) break; if (sp > XB_SPIN_CAP) { atomicAdd(&bar[XB_TMO], 1u); break; } }
    }
    nloc = mine > 0u ? mine : 1u; nx = cnt > 0u ? cnt : 1u;
}
__device__ __forceinline__ void xcd_barrier(const XcdBarrier& b) {
    asm volatile("s_waitcnt vmcnt(0)" ::: "memory");
    __syncthreads();
    if (threadIdx.x == 0) {
        unsigned* bar = b.bar;
        __builtin_amdgcn_s_waitcnt(0);
        unsigned nloc = b.st[0], nx = b.st[1];
        if (nloc == 0u) { xcd_barrier_complete(bar, b.x, nloc, nx); b.st[0] = nloc; b.st[1] = nx; }
        const unsigned old = xb_add(&bar[XB_XSUB(b.x)], 1u);
        const unsigned gen = old / nloc;
        if (old + 1u == (gen + 1u) * nloc) {
            __builtin_amdgcn_fence(__ATOMIC_RELEASE, "agent");
            asm volatile("s_waitcnt vmcnt(0)" ::: "memory");
            const unsigned og = xb_add(&bar[XB_TOP], 1u);
            const unsigned tg = og / nx;
            if (og + 1u == (tg + 1u) * nx) xb_add(&bar[XB_TOPGEN], 1u);
            else XB_SPIN(xb_ld(&bar[XB_TOPGEN]) == tg, bar);
            __builtin_amdgcn_fence(__ATOMIC_ACQUIRE, "agent");
            xb_add(&bar[XB_XGEN(b.x)], 1u);
            asm volatile("s_waitcnt vmcnt(0)" ::: "memory");
        } else {
            XB_SPIN(xb_ld(&bar[XB_XGEN(b.x)]) == gen, bar);
            __builtin_amdgcn_fence(__ATOMIC_ACQUIRE, "agent");
            asm volatile("s_waitcnt vmcnt(0)" ::: "memory");
        }
    }
    __syncthreads();
}

struct Unit { int pm, pn, aux, half; };
struct DenseSched {
    const bf16_t* A; const bf16_t* Bt; int lda, ldb; int nM, nN, nwg, G, c; bool split, pnflip;
    __device__ void init(const bf16_t* A_, int lda_, const bf16_t* Bt_, int ldb_, int M_, int N_, int G_, int c_, bool split_ = false, bool pnflip_ = false) {
        A = A_; Bt = Bt_; lda = lda_; ldb = ldb_; nM = M_ / BM; nN = N_ / BM; nwg = nM * nN; G = G_; c = c_; split = split_; pnflip = pnflip_; }
    __device__ bool next(int i, Unit& u) const {
        const int idx = i * G + c, nfull = (nwg / G) * G, tail = nwg - nfull; int L; u.half = 0;
        if (split && tail > 0 && 2 * tail <= G) { if (idx >= nfull + 2 * tail) return false; if (idx < nfull) L = idx; else { L = nfull + ((idx - nfull) >> 1); u.half = 1 + ((idx - nfull) & 1); } }
        else { if (idx >= nwg) return false; L = idx; }
        int wgid = L; { const int q = nwg / NXCD, r = nwg % NXCD, xcd = wgid % NXCD, off = wgid / NXCD; wgid = (xcd < r ? xcd * (q + 1) : r * (q + 1) + (xcd - r) * q) + off; }
        const int nig = WGM * nN, gid = wgid / nig, fm = gid * WGM, gsz = (nM - fm) < WGM ? (nM - fm) : WGM;
        u.pm = fm + ((wgid % nig) % gsz); u.pn = (wgid % nig) / gsz; if (pnflip) u.pn = nN - 1 - u.pn; u.aux = 0; return true;
    }
    __device__ __forceinline__ const char* abase(const Unit& u) const { return (const char*)A + (size_t)(u.pm * BM + (u.half == 2 ? HALF : 0)) * lda * 2; }
    __device__ __forceinline__ const char* bbase(const Unit& u) const { return (const char*)Bt + (size_t)u.pn * BM * ldb * 2; }
    __device__ __forceinline__ void avoff(const Unit& u, int R0, int C0, int R1, int C1, unsigned (&v0)[2], unsigned (&v1)[2]) const {
        v0[0] = (unsigned)(R0 * lda + C0) * 2u; v0[1] = (unsigned)(R1 * lda + C1) * 2u;
        const unsigned h1 = u.half ? 0u : (unsigned)(HALF * lda * 2);
        v1[0] = v0[0] + h1; v1[1] = v0[1] + h1; }
};

template <bool GATHER, class Epi, class Sched>
__device__ __forceinline__ void gemm_phase(LAS unsigned char* lds, const int K, const Sched& S, const Epi& E) {
    const int tid = threadIdx.x, wid = __builtin_amdgcn_readfirstlane(tid >> 6), lane = tid & 63, wr = wid >> 2, wc = wid & 3, fr = lane & 15, fq = lane >> 4;
    const int nt = K / BK;
    int R0, C0, R1, C1; stage_rc(tid * 16, R0, C0); stage_rc(tid * 16 + 8192, R1, C1);
    unsigned voffB[2]; voffB[0] = (unsigned)(R0 * S.ldb + C0) * 2u; voffB[1] = (unsigned)(R1 * S.ldb + C1) * 2u;
    const size_t kstep = (size_t)(BK * 2);
    const size_t hstepB = (size_t)HALF * S.ldb * 2;
    const unsigned ldsw = (unsigned)wid * 1024u;
    const int aoff = lds_byte(wr * 64 + fr, fq * 8), boff = lds_byte(wc * 32 + fr, fq * 8);
#define PG8_SA(b, h) (((b) * 2 + (h)) * HTB)
#define PG8_SB(b, h) ((4 + (b) * 2 + (h)) * HTB)
#define PG8_STAGE(bufoff, gbase, voff) do { _Pragma("unroll") for (int _i = 0; _i < 2; ++_i) \
        __builtin_amdgcn_global_load_lds((const unsigned*)((const char*)(gbase) + (voff)[_i]), (LAS unsigned*)(lds + (bufoff) + ldsw + _i * 8192), 16, 0, 0); } while (0)
#define PG8_LDA(dst, b, h) do { _Pragma("unroll") for (int m = 0; m < 4; ++m) _Pragma("unroll") for (int k = 0; k < 2; ++k) dst[m][k] = *(const LAS bf16x8*)(lds + PG8_SA(b, h) + aoff + m * 2048 + k * 1024); } while (0)
#define PG8_LDB(dst, b, h) do { _Pragma("unroll") for (int n = 0; n < 2; ++n) _Pragma("unroll") for (int k = 0; k < 2; ++k) dst[n][k] = *(const LAS bf16x8*)(lds + PG8_SB(b, h) + boff + n * 2048 + k * 1024); } while (0)
#define PG8_MMA(ai, bj, At, Bt) do { __builtin_amdgcn_s_setprio(1); _Pragma("unroll") for (int m = 0; m < 4; ++m) _Pragma("unroll") for (int n = 0; n < 2; ++n) _Pragma("unroll") for (int k = 0; k < 2; ++k) \
        acc[ai][bj][m][n] = __builtin_amdgcn_mfma_f32_16x16x32_bf16(Bt[n][k], At[m][k], acc[ai][bj][m][n], 0, 0, 0); __builtin_amdgcn_s_setprio(0); } while (0)
#define PG8_WAIT_V(n) asm volatile("s_waitcnt vmcnt(" #n ")" ::: "memory")
#define PG8_WAIT_L(n) asm volatile("s_waitcnt lgkmcnt(" #n ")" ::: "memory")
#define PG8_BAR __builtin_amdgcn_s_barrier()
#define PG8_SCHED __builtin_amdgcn_sched_barrier(0)
    Unit cur, nxt; int ui = 0;
    if (!S.next(0, cur)) return;
    f32x4 acc[2][2][4][2];
#pragma unroll
    for (int a = 0; a < 2; ++a)
#pragma unroll
        for (int b = 0; b < 2; ++b)
#pragma unroll
            for (int m = 0; m < 4; ++m)
#pragma unroll
                for (int n = 0; n < 2; ++n) acc[a][b][m][n] = (f32x4){0.f, 0.f, 0.f, 0.f};
    bf16x8 At[4][2], B0[2][2], B1[2][2];
    unsigned va0[2], va1[2], na0[2], na1[2];
    S.avoff(cur, R0, C0, R1, C1, va0, va1);
    na0[0] = va0[0]; na0[1] = va0[1]; na1[0] = va1[0]; na1[1] = va1[1];
    const char* cA = S.abase(cur); const char* cB = S.bbase(cur);
    PG8_STAGE(PG8_SB(0, 0), cB, voffB); PG8_STAGE(PG8_SB(0, 1), cB + hstepB, voffB); PG8_STAGE(PG8_SA(0, 0), cA, va0); PG8_STAGE(PG8_SA(0, 1), cA, va1);
    if (wr == 1) PG8_BAR;
    PG8_WAIT_V(2); PG8_BAR;
    PG8_STAGE(PG8_SB(1, 0), cB + kstep, voffB); PG8_STAGE(PG8_SA(1, 0), cA + kstep, va0); PG8_STAGE(PG8_SB(1, 1), cB + hstepB + kstep, voffB);
    PG8_WAIT_V(6); PG8_BAR;
    for (;;) {
        const bool has_next = S.next(ui + 1, nxt);
        const char* nA = has_next ? S.abase(nxt) : cA; const char* nB = has_next ? S.bbase(nxt) : cB;
        if (has_next) S.avoff(nxt, R0, C0, R1, C1, na0, na1);
        const bool hu = cur.half != 0;
#pragma unroll 1
        for (int t = 0; t < nt; t += 2) {
            const bool last = (t == nt - 2);
            const char* a1 = cA + (size_t)(t + 1) * kstep;
            const char* a2 = last ? nA : cA + (size_t)(t + 2) * kstep; const char* b2 = last ? nB : cB + (size_t)(t + 2) * kstep;
            const char* a3 = a2 + kstep; const char* b3 = b2 + kstep;
            unsigned x0[2], x1[2];
            x0[0] = last ? na0[0] : va0[0]; x0[1] = last ? na0[1] : va0[1]; x1[0] = last ? na1[0] : va1[0]; x1[1] = last ? na1[1] : va1[1];
            PG8_LDB(B0, 0, 0); PG8_LDB(B1, 0, 1); PG8_SCHED; PG8_LDA(At, 0, 0); PG8_STAGE(PG8_SA(1, 1), a1, va1);
            PG8_WAIT_V(8); PG8_WAIT_L(0); PG8_BAR; PG8_MMA(0, 0, At, B0); PG8_MMA(0, 1, At, B1); PG8_BAR; PG8_SCHED;
            if (!hu) PG8_LDA(At, 0, 1);
            PG8_STAGE(PG8_SB(0, 0), b2, voffB); PG8_STAGE(PG8_SB(0, 1), b2 + hstepB, voffB); PG8_STAGE(PG8_SA(0, 0), a2, x0);
            PG8_WAIT_V(8); PG8_WAIT_L(0); PG8_BAR; if (!hu) { PG8_MMA(1, 0, At, B0); PG8_MMA(1, 1, At, B1); } PG8_BAR; PG8_SCHED;
            PG8_LDB(B0, 1, 0); PG8_LDB(B1, 1, 1); PG8_SCHED; PG8_LDA(At, 1, 0); PG8_STAGE(PG8_SA(0, 1), a2, x1);
            PG8_WAIT_V(8); PG8_WAIT_L(0); PG8_BAR; PG8_MMA(0, 0, At, B0); PG8_MMA(0, 1, At, B1); PG8_BAR; PG8_SCHED;
            if (!hu) PG8_LDA(At, 1, 1);
            PG8_STAGE(PG8_SB(1, 0), b3, voffB); PG8_STAGE(PG8_SB(1, 1), b3 + hstepB, voffB); PG8_STAGE(PG8_SA(1, 0), a3, x0);
            PG8_WAIT_V(8); PG8_WAIT_L(0); PG8_BAR; if (!hu) { PG8_MMA(1, 0, At, B0); PG8_MMA(1, 1, At, B1); } PG8_BAR; PG8_SCHED;
        }
        if (wr == 0) PG8_BAR;
        E(acc, cur, wr, wc, fr, fq);
        if (!has_next) break;
#pragma unroll
        for (int a = 0; a < 2; ++a)
#pragma unroll
            for (int b = 0; b < 2; ++b)
#pragma unroll
                for (int m = 0; m < 4; ++m)
#pragma unroll
                    for (int n = 0; n < 2; ++n) acc[a][b][m][n] = (f32x4){0.f, 0.f, 0.f, 0.f};
        cur = nxt; cA = nA; cB = nB; ++ui;
        va0[0] = na0[0]; va0[1] = na0[1]; va1[0] = na1[0]; va1[1] = na1[1];
        if (wr == 1) PG8_BAR;
    }
    PG8_WAIT_V(0);
    PG8_BAR;
#undef PG8_SA
#undef PG8_SB
#undef PG8_STAGE
#undef PG8_LDA
#undef PG8_LDB
#undef PG8_MMA
#undef PG8_WAIT_V
#undef PG8_WAIT_L
#undef PG8_BAR
#undef PG8_SCHED
}

__device__ __forceinline__ u32x4 pack8(const f32x4 a, const f32x4 b) { u32x4 w; w.x = cvt_pk_bf16(a[0], a[1]); w.y = cvt_pk_bf16(a[2], a[3]); w.z = cvt_pk_bf16(b[0], b[1]); w.w = cvt_pk_bf16(b[2], b[3]); return w; }

struct EpiIn {
    bf16_t *u, *gb, *sg, *lat; float* rowstat; const float2* cs; const float* k_g; LAS float* xch;
    __device__ __forceinline__ void operator()(const f32x4 (&acc)[2][2][4][2], const Unit& un, int wr, int wc, int fr, int fq) const {
        asm volatile("" : "+v"(fr), "+v"(fq));
        const int row0 = un.pm * BM + wr * 64 + fr, pn = un.pn;
        if (pn < 16) {
            const int c0 = 128 * (pn & 7) + 32 * wc + 8 * fq; bf16_t* dst = pn < 8 ? u : gb; const int rh = row0 + (un.half == 2 ? HALF : 0);
#pragma unroll
            for (int ai = 0; ai < 2; ++ai)
#pragma unroll
                for (int m = 0; m < 4; ++m) { f32x4 r0, r1; if (ai == 1 && un.half) continue;
                    if (pn < 8) { r0 = acc[ai][0][m][0] * acc[ai][1][m][0]; r1 = acc[ai][0][m][1] * acc[ai][1][m][1]; }
                    else { const f32x4 g0 = acc[ai][1][m][0], g1 = acc[ai][1][m][1];
#pragma unroll
                        for (int i = 0; i < 4; ++i) { r0[i] = acc[ai][0][m][0][i] * fsigmoid(g0[i]); r1[i] = acc[ai][0][m][1][i] * fsigmoid(g1[i]); } }
                    *(u32x4*)(dst + (size_t)(rh + ai * HALF + m * 16) * DM + c0) = pack8(r0, r1); }
        } else if (pn < 20) {
            const int c0 = 256 * (pn - 16) + 32 * wc + 8 * fq;
#pragma unroll
            for (int ai = 0; ai < 2; ++ai)
#pragma unroll
                for (int m = 0; m < 4; ++m)
#pragma unroll
                    for (int bj = 0; bj < 2; ++bj) { f32x4 a = acc[ai][bj][m][0], b = acc[ai][bj][m][1];
#pragma unroll
                        for (int i = 0; i < 4; ++i) { a[i] = fsigmoid(a[i]); b[i] = fsigmoid(b[i]); }
                        *(u32x4*)(sg + (size_t)(row0 + ai * HALF + m * 16) * DM + c0 + bj * HALF) = pack8(a, b); }
        } else {
            const int c0 = 256 * (pn - 20) + 32 * wc + 8 * fq, rowt = wr * 64 + fr;
#pragma unroll
            for (int ai = 0; ai < 2; ++ai)
#pragma unroll
                for (int m = 0; m < 4; ++m) { const int rt = rowt + ai * HALF + m * 16, row = un.pm * BM + rt; float s0, s1;
                    { const f32x4 a = acc[ai][0][m][0], b = acc[ai][0][m][1]; *(u32x4*)(lat + (size_t)row * LATW + c0) = pack8(a, b);
                      s0 = (a[0] * a[0] + a[1] * a[1]) + (a[2] * a[2] + a[3] * a[3]) + (b[0] * b[0] + b[1] * b[1]) + (b[2] * b[2] + b[3] * b[3]); }
                    { const f32x4 a = acc[ai][1][m][0], b = acc[ai][1][m][1];
                      s1 = (a[0] * a[0] + a[1] * a[1]) + (a[2] * a[2] + a[3] * a[3]) + (b[0] * b[0] + b[1] * b[1]) + (b[2] * b[2] + b[3] * b[3]);
                      if (pn != 21) *(u32x4*)(lat + (size_t)row * LATW + c0 + HALF) = pack8(a, b);
                      else if (wc < 2) { const int j = 16 * wc + 4 * fq;
                          const f32x4 g1 = *(const f32x4*)(k_g + 128 + j), g2 = *(const f32x4*)(k_g + 160 + j);
                          const f32x4 cA = *(const f32x4*)((const float*)cs + ((size_t)row * 32 + j) * 2), cB = *(const f32x4*)((const float*)cs + ((size_t)row * 32 + j + 2) * 2);
                          const f32x4 x1 = a * g1, x2 = b * g2; f32x4 y1, y2;
                          y1[0] = x1[0] * cA[0] - x2[0] * cA[1]; y2[0] = x2[0] * cA[0] + x1[0] * cA[1]; y1[1] = x1[1] * cA[2] - x2[1] * cA[3]; y2[1] = x2[1] * cA[2] + x1[1] * cA[3];
                          y1[2] = x1[2] * cB[0] - x2[2] * cB[1]; y2[2] = x2[2] * cB[0] + x1[2] * cB[1]; y1[3] = x1[3] * cB[2] - x2[3] * cB[3]; y2[3] = x2[3] * cB[2] + x1[3] * cB[3];
                          u32x2 w1, w2; w1.x = cvt_pk_bf16(y1[0], y1[1]); w1.y = cvt_pk_bf16(y1[2], y1[3]); w2.x = cvt_pk_bf16(y2[0], y2[1]); w2.y = cvt_pk_bf16(y2[2], y2[3]);
                          *(u32x2*)(lat + (size_t)row * LATW + 384 + j) = w1; *(u32x2*)(lat + (size_t)row * LATW + 416 + j) = w2; } }
                    s0 += __shfl_xor(s0, 16); s0 += __shfl_xor(s0, 32); s1 += __shfl_xor(s1, 16); s1 += __shfl_xor(s1, 32);
                    if (fq == 0) { xch[rt * 8 + wc] = s0; xch[rt * 8 + 4 + wc] = s1; } }
            asm volatile("s_waitcnt lgkmcnt(0)" ::: "memory"); __builtin_amdgcn_s_barrier(); asm volatile("" ::: "memory");
            if (threadIdx.x < 256) { const int rt = threadIdx.x; const f32x4 p0 = *(const LAS f32x4*)(xch + rt * 8), p1 = *(const LAS f32x4*)(xch + rt * 8 + 4);
                const float S0 = (p0[0] + p0[1]) + (p0[2] + p0[3]), S1 = (p1[0] + p1[1]) + (p1[2] + p1[3]); float* st = rowstat + (size_t)(un.pm * BM + rt) * 4;
                if (pn == 20) st[0] = S0 + S1; else if (pn == 21) { st[1] = S0; st[2] = S1; } else st[3] = S0 + S1; }
        }
    }
};
struct EpiPlain {
    bf16_t* O; int ldc; int pnmask;
    __device__ __forceinline__ void operator()(const f32x4 (&acc)[2][2][4][2], const Unit& un, int wr, int wc, int fr, int fq) const {
        asm volatile("" : "+v"(fr), "+v"(fq));
        const int row0 = un.pm * BM + wr * 64 + fr, c0 = 256 * (un.pn & pnmask) + 32 * wc + 8 * fq;
#pragma unroll
        for (int ai = 0; ai < 2; ++ai)
#pragma unroll
            for (int m = 0; m < 4; ++m)
#pragma unroll
                for (int bj = 0; bj < 2; ++bj) *(u32x4*)(O + (size_t)(row0 + ai * HALF + m * 16) * ldc + c0 + bj * HALF) = pack8(acc[ai][bj][m][0], acc[ai][bj][m][1]);
    }
};
struct EpiKV {
    bf16_t *Kb, *Vb; const bf16_t* lat; const float* rowstat; const float* k_g; LAS float* xch;
    __device__ __forceinline__ void operator()(const f32x4 (&acc)[2][2][4][2], const Unit& un, int wr, int wc, int fr, int fq) const {
        asm volatile("" : "+v"(fr), "+v"(fq));
        const int h = un.pn, rowt = wr * 64 + fr, b = (un.pm * BM) / SEQ, s0 = (un.pm * BM) % SEQ;
        f32x2 st[2][4];
        u32x4 rp[2][2];
#pragma unroll
        for (int ai = 0; ai < 2; ++ai) {
#pragma unroll
            for (int m = 0; m < 4; ++m) st[ai][m] = *(const f32x2*)(rowstat + (size_t)(un.pm * BM + rowt + ai * HALF + m * 16) * 4 + 2);
            const bf16_t* lr = lat + (size_t)(un.pm * BM + rowt + ai * HALF + wc * 16) * LATW + 384 + 16 * fq;
            rp[ai][0] = *(const u32x4*)lr; rp[ai][1] = *(const u32x4*)(lr + 8); }
#pragma unroll
        for (int ai = 0; ai < 2; ++ai)
#pragma unroll
            for (int m = 0; m < 4; ++m) {
                const f32x4 a = acc[ai][0][m][0], c = acc[ai][0][m][1];
                float ss = (a[0] * a[0] + a[1] * a[1]) + (a[2] * a[2] + a[3] * a[3]) + (c[0] * c[0] + c[1] * c[1]) + (c[2] * c[2] + c[3] * c[3]);
                ss += __shfl_xor(ss, 16); ss += __shfl_xor(ss, 32);
                if (fq == 0) xch[(rowt + ai * HALF + m * 16) * 4 + wc] = ss; }
        asm volatile("s_waitcnt lgkmcnt(0)" ::: "memory"); __builtin_amdgcn_s_barrier(); asm volatile("" ::: "memory");
        const int c8 = 32 * wc + 8 * fq;
        const f32x4 g0 = *(const f32x4*)(k_g + c8), g1 = *(const f32x4*)(k_g + c8 + 4);
#pragma unroll
        for (int ai = 0; ai < 2; ++ai)
#pragma unroll
            for (int m = 0; m < 4; ++m) { const int rt = rowt + ai * HALF + m * 16;
                const float rkv = __builtin_amdgcn_rsqf(st[ai][m][1] * (1.f / KVL) + EPS);
                const f32x4 t4 = *(const LAS f32x4*)(xch + rt * 4);
                const float rk = __builtin_amdgcn_rsqf((((t4[0] + t4[1]) + (t4[2] + t4[3])) * rkv * rkv + st[ai][m][0]) * (1.f / QKH) + EPS);
                const float sk = rkv * rk, sv = rkv;
                const size_t bhs = (size_t)(b * NH + h) * SEQ + s0 + rt;
                bf16_t* Kp = Kb + bhs * QKH; bf16_t* Vp = Vb + bhs * VH;
                *(u32x4*)(Kp + c8) = pack8(acc[ai][0][m][0] * sk * g0, acc[ai][0][m][1] * sk * g1);
                *(u32x4*)(Vp + c8) = pack8(acc[ai][1][m][0] * sv, acc[ai][1][m][1] * sv);
                if (m == wc) {
                    u32x4 o0, o1;
#pragma unroll
                    for (int e = 0; e < 4; ++e) { o0[e] = cvt_pk_bf16(__uint_as_float(rp[ai][0][e] << 16) * rk, __uint_as_float(rp[ai][0][e] & 0xffff0000u) * rk);
                                                  o1[e] = cvt_pk_bf16(__uint_as_float(rp[ai][1][e] << 16) * rk, __uint_as_float(rp[ai][1][e] & 0xffff0000u) * rk); }
                    *(u32x4*)(Kp + 128 + 16 * fq) = o0; *(u32x4*)(Kp + 128 + 16 * fq + 8) = o1; } }
    }
};
struct EpiDelta {
    const float* mod; bf16_t* delta;
    __device__ __forceinline__ void operator()(const f32x4 (&acc)[2][2][4][2], const Unit& un, int wr, int wc, int fr, int fq) const {
        asm volatile("" : "+v"(fr), "+v"(fq));
        const int row0 = un.pm * BM + wr * 64 + fr, b = (un.pm * BM) / SEQ, c0 = 256 * un.pn + 32 * wc + 8 * fq;
        const float* gate = mod + b * 6144 + 2048;
#pragma unroll
        for (int bj = 0; bj < 2; ++bj) { const f32x4 g0 = *(const f32x4*)(gate + c0 + bj * HALF), g1 = *(const f32x4*)(gate + c0 + bj * HALF + 4);
#pragma unroll
            for (int ai = 0; ai < 2; ++ai)
#pragma unroll
                for (int m = 0; m < 4; ++m) *(u32x4*)(delta + (size_t)(row0 + ai * HALF + m * 16) * DM + c0 + bj * HALF) = pack8(acc[ai][bj][m][0] * g0, acc[ai][bj][m][1] * g1); }
    }
};
namespace att {
constexpr int NW = 8, QBLK = 32, KVBLK = 64, KPITCH = 400;
constexpr int SHM_V = KVBLK * VH * 2, SHM_K = KVBLK * KPITCH;
constexpr int QRP = 144;
constexpr int OFF_V = 0, OFF_K = 2 * SHM_V, OFF_WS = OFF_K + 2 * SHM_K, OFF_QR = OFF_WS + NW * 64 * 4, ATT_LDS = OFF_QR + NW * 32 * QRP;
constexpr float SCALE = 0.07216878364870322f;
constexpr float THR = 8.f;
#define SBAR() __builtin_amdgcn_sched_barrier(0)
__device__ __forceinline__ int crow(int r, int hi) { return (r & 3) + 8 * (r >> 2) + 4 * hi; }
__device__ __forceinline__ void partialSM(f32x16& p0, f32x16& p1, float& m_reg, float& alpha) {
    constexpr float C = SCALE * 1.4426950408889634f;
    float pmax = p0[0];
#pragma unroll
    for (int r = 1; r < 16; ++r) pmax = fmaxf(pmax, p0[r]);
#pragma unroll
    for (int r = 0; r < 16; ++r) pmax = fmaxf(pmax, p1[r]);
    { auto rr = __builtin_amdgcn_permlane32_swap(__float_as_uint(pmax), __float_as_uint(pmax), false, false);
      pmax = fmaxf(__uint_as_float(rr[0]), __uint_as_float(rr[1])); }
    float mn;
    if (__builtin_expect(__all(pmax - m_reg <= THR / SCALE), 1)) { mn = m_reg; alpha = 1.f; }
    else { mn = fmaxf(m_reg, pmax); alpha = __builtin_amdgcn_exp2f((m_reg - mn) * C); m_reg = mn; }
    const float mnC = -mn * C;
#pragma unroll
    for (int r = 0; r < 16; ++r) p0[r] = fmaf(p0[r], C, mnC);
#pragma unroll
    for (int r = 0; r < 16; ++r) p1[r] = fmaf(p1[r], C, mnC);
#pragma unroll
    for (int r = 0; r < 16; ++r) p0[r] = __builtin_amdgcn_exp2f(p0[r]);
}
__device__ __forceinline__ void finishSM(f32x16& p0, f32x16& p1, float alpha, float& l_reg, bf16x8& pa0, bf16x8& pa1, bf16x8& pa2, bf16x8& pa3) {
#pragma unroll
    for (int r = 0; r < 16; ++r) p1[r] = __builtin_amdgcn_exp2f(p1[r]);
    float ps = 0;
#pragma unroll
    for (int r = 0; r < 16; ++r) ps += p0[r];
#pragma unroll
    for (int r = 0; r < 16; ++r) ps += p1[r];
    { auto rr = __builtin_amdgcn_permlane32_swap(__float_as_uint(ps), __float_as_uint(ps), false, false);
      ps = __uint_as_float(rr[0]) + __uint_as_float(rr[1]); }
    l_reg = l_reg * alpha + ps;
#define PK4(P, BASE, OUT) do { unsigned a0 = cvt_pk_bf16(P[BASE + 0], P[BASE + 1]), a1 = cvt_pk_bf16(P[BASE + 2], P[BASE + 3]);   \
    unsigned b0 = cvt_pk_bf16(P[BASE + 4], P[BASE + 5]), b1 = cvt_pk_bf16(P[BASE + 6], P[BASE + 7]);                              \
    auto r0 = __builtin_amdgcn_permlane32_swap(a0, b0, false, false); auto r1 = __builtin_amdgcn_permlane32_swap(a1, b1, false, false); \
    u32x4 w = {r0[0], r1[0], r0[1], r1[1]}; OUT = *reinterpret_cast<bf16x8*>(&w); } while (0)
    PK4(p0, 0, pa0); PK4(p0, 8, pa1); PK4(p1, 0, pa2); PK4(p1, 8, pa3);
#undef PK4
}
__device__ __forceinline__ void qkt(f32x16& p0, f32x16& p1, const LAS char* Ks, const bf16x8 (&qr)[8], const LAS char* qrope, int r32, int hi) {
    p0 = f32x16{}; p1 = f32x16{};
    const LAS char* k0 = Ks + r32 * KPITCH + hi * 16;
#pragma unroll
    for (int d0 = 0; d0 < 8; ++d0) {
        const bf16x8 b0 = *(const LAS bf16x8*)(k0 + d0 * 32);
        const bf16x8 b1 = *(const LAS bf16x8*)(k0 + 32 * KPITCH + d0 * 32);
        p0 = __builtin_amdgcn_mfma_f32_32x32x16_bf16(b0, qr[d0], p0, 0, 0, 0);
        p1 = __builtin_amdgcn_mfma_f32_32x32x16_bf16(b1, qr[d0], p1, 0, 0, 0); }
#pragma unroll
    for (int d0 = 8; d0 < 12; ++d0) {
        const bf16x8 b0 = *(const LAS bf16x8*)(k0 + d0 * 32);
        const bf16x8 b1 = *(const LAS bf16x8*)(k0 + 32 * KPITCH + d0 * 32);
        const bf16x8 qf = *(const LAS bf16x8*)(qrope + (d0 - 8) * 32);
        p0 = __builtin_amdgcn_mfma_f32_32x32x16_bf16(b0, qf, p0, 0, 0, 0);
        p1 = __builtin_amdgcn_mfma_f32_32x32x16_bf16(b1, qf, p1, 0, 0, 0); }
}
__device__ __forceinline__ int v_st(int k, int c) { const int kk = (k & ~0xC) | ((k & 4) << 1) | ((k & 8) >> 1); return ((kk >> 3) * 4 + (c >> 5)) * 512 + ((kk & 7) * 32 + (c & 31)) * 2; }
__device__ __forceinline__ int v_rd_base(int lane) { return ((lane & 3) << 3) | (((lane >> 2) & 3) << 6) | (((lane >> 4) & 1) << 5) | (((lane >> 5) & 1) << 8); }
constexpr int v_rd_off(int d0, int ks, int half) { return d0 * 512 + ks * 4096 + half * 2048; }
template <int OFF> __device__ __forceinline__ s16x4 tr_read(int vb) {
    s16x4 r; asm volatile("ds_read_b64_tr_b16 %0, %1 offset:%2" : "=&v"(r) : "v"(vb), "i"(OFF) : "memory"); return r;
}
template <int D0> __device__ __forceinline__ void pv_one(f32x16& od, int vb, bf16x8 pa0, bf16x8 pa1, bf16x8 pa2, bf16x8 pa3) {
    const s16x4 l0 = tr_read<v_rd_off(D0, 0, 0)>(vb), h0 = tr_read<v_rd_off(D0, 0, 1)>(vb), l1 = tr_read<v_rd_off(D0, 1, 0)>(vb), h1 = tr_read<v_rd_off(D0, 1, 1)>(vb);
    const s16x4 l2 = tr_read<v_rd_off(D0, 2, 0)>(vb), h2 = tr_read<v_rd_off(D0, 2, 1)>(vb), l3 = tr_read<v_rd_off(D0, 3, 0)>(vb), h3 = tr_read<v_rd_off(D0, 3, 1)>(vb);
    asm volatile("s_waitcnt lgkmcnt(0)" ::: "memory"); SBAR();
#define PK(L, H) (bf16x8){L[0], L[1], L[2], L[3], H[0], H[1], H[2], H[3]}
    od = __builtin_amdgcn_mfma_f32_32x32x16_bf16(pa0, PK(l0, h0), od, 0, 0, 0);
    od = __builtin_amdgcn_mfma_f32_32x32x16_bf16(pa1, PK(l1, h1), od, 0, 0, 0);
    od = __builtin_amdgcn_mfma_f32_32x32x16_bf16(pa2, PK(l2, h2), od, 0, 0, 0);
    od = __builtin_amdgcn_mfma_f32_32x32x16_bf16(pa3, PK(l3, h3), od, 0, 0, 0);
#undef PK
}
__device__ __forceinline__ void pv_d0(f32x16 (&o)[4], int vb, bf16x8 pa0, bf16x8 pa1, bf16x8 pa2, bf16x8 pa3) {
    pv_one<0>(o[0], vb, pa0, pa1, pa2, pa3); pv_one<1>(o[1], vb, pa0, pa1, pa2, pa3); pv_one<2>(o[2], vb, pa0, pa1, pa2, pa3); pv_one<3>(o[3], vb, pa0, pa1, pa2, pa3);
}
__device__ __forceinline__ float bflo(unsigned w) { return __uint_as_float(w << 16); }
__device__ __forceinline__ float bfhi(unsigned w) { return __uint_as_float(w & 0xffff0000u); }

struct AttnArgs { const bf16_t* Q; const bf16_t* Kb; const bf16_t* Vb; const float* ssp; const float2* cs; const float* q_g; const bf16_t *u, *gb, *sg; const float* conv_w; bf16_t* merged; };

template <int MODE> __device__ __forceinline__ void attn_unit(const AttnArgs& T, int b, int h, int qb, LAS char* lds) {
    int tid = threadIdx.x; asm volatile("" : "+v"(tid));
    const int lane = tid & 63, r32 = lane & 31, hi = lane >> 5; const int wid = __builtin_amdgcn_readfirstlane(tid >> 6);
    LAS char* V_lds = lds + OFF_V; LAS char* K_lds = lds + OFF_K;
    LAS float* ws = (LAS float*)(lds + OFF_WS) + wid * 64; LAS float* li_l = ws; LAS float* al_l = ws + 32;
    const int mrow = b * SEQ + qb * 256 + wid * QBLK + r32;
    const bf16_t* Kh = T.Kb + (size_t)(b * NH + h) * SEQ * QKH; const bf16_t* Vh = T.Vb + (size_t)(b * NH + h) * SEQ * VH;
    const int sr = tid >> 4, sc = (tid & 15) * 8, vst0 = v_st(sr, sc), vst1 = v_st(32 + sr, sc);
    const int kdst = (tid >> 3) * KPITCH + (tid & 7) * 48;
    const int vb0 = (int)(uintptr_t)V_lds + v_rd_base(lane);
    bf16x8 sk0, sk1, sk2, sv0, sv1;
#define SLOAD(t) do { const bf16_t* kp = Kh + (size_t)(t) * KVBLK * QKH + tid * 24; sk0 = *(const bf16x8*)kp; sk1 = *(const bf16x8*)(kp + 8); sk2 = *(const bf16x8*)(kp + 16); \
    const bf16_t* vp = Vh + (size_t)((t) * KVBLK + sr) * VH + sc; sv0 = *(const bf16x8*)vp; sv1 = *(const bf16x8*)(vp + 32 * VH); } while (0)
#define SWRITE(bf) do { *(LAS bf16x8*)(V_lds + (bf) * SHM_V + vst0) = sv0; *(LAS bf16x8*)(V_lds + (bf) * SHM_V + vst1) = sv1; \
    *(LAS bf16x8*)(K_lds + (bf) * SHM_K + kdst) = sk0; *(LAS bf16x8*)(K_lds + (bf) * SHM_K + kdst + 16) = sk1; *(LAS bf16x8*)(K_lds + (bf) * SHM_K + kdst + 32) = sk2; } while (0)
#define RESC(a) do { if (__any((a) < 1.f)) { if (hi == 0) al_l[r32] = (a); asm volatile("s_waitcnt lgkmcnt(0)" ::: "memory"); \
    _Pragma("unroll") for (int d = 0; d < 4; ++d) _Pragma("unroll") for (int r = 0; r < 16; ++r) o[d][r] *= al_l[crow(r, hi)]; } } while (0)
    SLOAD(0);
    bf16x8 qr[8];
    LAS char* qrope = lds + OFF_QR + wid * (32 * QRP) + r32 * QRP + hi * 16;
    {
        const bf16_t* Qw = T.Q + (size_t)mrow * 1536 + h * QKH + hi * 8;
        u32x4 raw[12];
#pragma unroll
        for (int d0 = 0; d0 < 12; ++d0) raw[d0] = *(const u32x4*)(Qw + d0 * 16);
        const f32x2 sq2 = *(const f32x2*)(T.ssp + (size_t)mrow * 4); const float ssq = sq2[0] + sq2[1];
        float ss = 0.f;
#pragma unroll
        for (int d0 = 0; d0 < 12; ++d0)
#pragma unroll
            for (int e = 0; e < 4; ++e) { const float a = bflo(raw[d0][e]), c = bfhi(raw[d0][e]); ss += a * a + c * c; }
        { auto rr = __builtin_amdgcn_permlane32_swap(__float_as_uint(ss), __float_as_uint(ss), false, false); ss = __uint_as_float(rr[0]) + __uint_as_float(rr[1]); }
        const float rq2 = 1.f / (ssq * (1.f / QL) + EPS);
        const float rn = 1.f / sqrtf(ss * rq2 * (1.f / QKH) + EPS) * sqrtf(rq2);
#pragma unroll
        for (int d0 = 0; d0 < 8; ++d0) { const f32x4 g0 = *(const f32x4*)(T.q_g + d0 * 16 + hi * 8), g1 = *(const f32x4*)(T.q_g + d0 * 16 + hi * 8 + 4);
            u32x4 w; w.x = cvt_pk_bf16(bflo(raw[d0].x) * rn * g0[0], bfhi(raw[d0].x) * rn * g0[1]); w.y = cvt_pk_bf16(bflo(raw[d0].y) * rn * g0[2], bfhi(raw[d0].y) * rn * g0[3]);
            w.z = cvt_pk_bf16(bflo(raw[d0].z) * rn * g1[0], bfhi(raw[d0].z) * rn * g1[1]); w.w = cvt_pk_bf16(bflo(raw[d0].w) * rn * g1[2], bfhi(raw[d0].w) * rn * g1[3]);
            qr[d0] = *reinterpret_cast<bf16x8*>(&w); }
#pragma unroll
        for (int p = 0; p < 2; ++p) {
            const int ib = 16 * p + 8 * hi;
            float x1[8], x2[8];
            const f32x4 ga = *(const f32x4*)(T.q_g + 128 + ib), gb_ = *(const f32x4*)(T.q_g + 128 + ib + 4), gc = *(const f32x4*)(T.q_g + 160 + ib), gd = *(const f32x4*)(T.q_g + 160 + ib + 4);
            const float g1v[8] = {ga[0], ga[1], ga[2], ga[3], gb_[0], gb_[1], gb_[2], gb_[3]}, g2v[8] = {gc[0], gc[1], gc[2], gc[3], gd[0], gd[1], gd[2], gd[3]};
#pragma unroll
            for (int e = 0; e < 4; ++e) { x1[2 * e] = bflo(raw[8 + p][e]) * rn * g1v[2 * e]; x1[2 * e + 1] = bfhi(raw[8 + p][e]) * rn * g1v[2 * e + 1];
                                          x2[2 * e] = bflo(raw[10 + p][e]) * rn * g2v[2 * e]; x2[2 * e + 1] = bfhi(raw[10 + p][e]) * rn * g2v[2 * e + 1]; }
            float y1[8], y2[8];
#pragma unroll
            for (int jj = 0; jj < 4; ++jj) { const f32x4 c2 = *(const f32x4*)((const float*)T.cs + ((size_t)mrow * 32 + ib + 2 * jj) * 2);
                y1[2 * jj] = x1[2 * jj] * c2[0] - x2[2 * jj] * c2[1]; y2[2 * jj] = x2[2 * jj] * c2[0] + x1[2 * jj] * c2[1];
                y1[2 * jj + 1] = x1[2 * jj + 1] * c2[2] - x2[2 * jj + 1] * c2[3]; y2[2 * jj + 1] = x2[2 * jj + 1] * c2[2] + x1[2 * jj + 1] * c2[3]; }
            u32x4 w1, w2; w1.x = cvt_pk_bf16(y1[0], y1[1]); w1.y = cvt_pk_bf16(y1[2], y1[3]); w1.z = cvt_pk_bf16(y1[4], y1[5]); w1.w = cvt_pk_bf16(y1[6], y1[7]);
            w2.x = cvt_pk_bf16(y2[0], y2[1]); w2.y = cvt_pk_bf16(y2[2], y2[3]); w2.z = cvt_pk_bf16(y2[4], y2[5]); w2.w = cvt_pk_bf16(y2[6], y2[7]);
            *(LAS u32x4*)(qrope + p * 32) = w1; *(LAS u32x4*)(qrope + (2 + p) * 32) = w2; }
        asm volatile("s_waitcnt lgkmcnt(0)" ::: "memory");
    }
    float m_reg = -1e30f, l_reg = 0.f; f32x16 o[4] = {};
    f32x16 pA0, pA1, pB0, pB1; float alA = 1.f, alB = 1.f; bf16x8 pa0, pa1, pa2, pa3;
    const int NT = 4 * qb + 4; const int wp = wid >> 1;
    const bool a1 = wp >= 1, a2 = wp >= 2, a3 = wp >= 3;
    const LAS char* K0 = K_lds; const LAS char* K1 = K_lds + SHM_K;
    asm volatile("s_waitcnt vmcnt(0)" ::: "memory"); SWRITE(0); __syncthreads();
    qkt(pA0, pA1, K0, qr, qrope, r32, hi); partialSM(pA0, pA1, m_reg, alA);
    SLOAD(1); asm volatile("s_waitcnt vmcnt(0)" ::: "memory"); SWRITE(1); __syncthreads();
    for (int j = 1; j + 3 < NT; j += 2) {
        SBAR(); qkt(pB0, pB1, K1, qr, qrope, r32, hi);
        finishSM(pA0, pA1, alA, l_reg, pa0, pa1, pa2, pa3); SBAR();
        SLOAD(j + 1); SBAR();
        pv_d0(o, vb0, pa0, pa1, pa2, pa3); partialSM(pB0, pB1, m_reg, alB);
        __syncthreads(); asm volatile("s_waitcnt vmcnt(0)" ::: "memory"); SWRITE(0);
        RESC(alB); __syncthreads();
        SBAR(); qkt(pA0, pA1, K0, qr, qrope, r32, hi);
        finishSM(pB0, pB1, alB, l_reg, pa0, pa1, pa2, pa3); SBAR();
        SLOAD(j + 2); SBAR();
        pv_d0(o, vb0 + SHM_V, pa0, pa1, pa2, pa3); partialSM(pA0, pA1, m_reg, alA);
        __syncthreads(); asm volatile("s_waitcnt vmcnt(0)" ::: "memory"); SWRITE(1);
        RESC(alA); __syncthreads();
    }
#define MASK(P0, P1, act) do { if (!(act)) { _Pragma("unroll") for (int r = 0; r < 16; ++r) { P0[r] = -INFINITY; P1[r] = -INFINITY; } } } while (0)
    {
        SBAR(); if (a1) qkt(pB0, pB1, K1, qr, qrope, r32, hi); MASK(pB0, pB1, a1);
        finishSM(pA0, pA1, alA, l_reg, pa0, pa1, pa2, pa3); SBAR();
        SLOAD(NT - 2); SBAR();
        pv_d0(o, vb0, pa0, pa1, pa2, pa3); partialSM(pB0, pB1, m_reg, alB);
        __syncthreads(); asm volatile("s_waitcnt vmcnt(0)" ::: "memory"); SWRITE(0);
        RESC(alB); __syncthreads();
        SBAR(); if (a2) qkt(pA0, pA1, K0, qr, qrope, r32, hi); MASK(pA0, pA1, a2);
        finishSM(pB0, pB1, alB, l_reg, pa0, pa1, pa2, pa3); SBAR();
        SLOAD(NT - 1); SBAR();
        pv_d0(o, vb0 + SHM_V, pa0, pa1, pa2, pa3); partialSM(pA0, pA1, m_reg, alA);
        __syncthreads(); asm volatile("s_waitcnt vmcnt(0)" ::: "memory"); SWRITE(1);
        RESC(alA); __syncthreads();
        SBAR(); if (a3) qkt(pB0, pB1, K1, qr, qrope, r32, hi); MASK(pB0, pB1, a3);
        finishSM(pA0, pA1, alA, l_reg, pa0, pa1, pa2, pa3); SBAR();
        pv_d0(o, vb0, pa0, pa1, pa2, pa3); partialSM(pB0, pB1, m_reg, alB);
        RESC(alB);
        finishSM(pB0, pB1, alB, l_reg, pa0, pa1, pa2, pa3); SBAR();
        pv_d0(o, vb0 + SHM_V, pa0, pa1, pa2, pa3);
    }
#undef MASK
    if (hi == 0) li_l[r32] = l_reg; asm volatile("s_waitcnt lgkmcnt(0)" ::: "memory");
    float rli[16];
#pragma unroll
    for (int r = 0; r < 16; ++r) rli[r] = __builtin_amdgcn_rcpf(li_l[crow(r, hi)]);
    __syncthreads();
    LAS bf16_t* stg = (LAS bf16_t*)(lds + wid * 8192);
#pragma unroll
    for (int r = 0; r < 16; ++r) { const int orow = crow(r, hi);
#pragma unroll
        for (int d0 = 0; d0 < 4; ++d0) stg[orow * 128 + d0 * 32 + r32] = f2bf(o[d0][r] * rli[r]); }
    asm volatile("s_waitcnt lgkmcnt(0)" ::: "memory");
    if (MODE != 1) {
        const int ch = lane & 15, c = h * VH + ch * 8;
        const f32x4 w0a = *(const f32x4*)(T.conv_w + c), w0b = *(const f32x4*)(T.conv_w + c + 4), w1a = *(const f32x4*)(T.conv_w + DM + c), w1b = *(const f32x4*)(T.conv_w + DM + c + 4),
              w2a = *(const f32x4*)(T.conv_w + 2 * DM + c), w2b = *(const f32x4*)(T.conv_w + 2 * DM + c + 4);
        const float cw0[8] = {w0a[0], w0a[1], w0a[2], w0a[3], w0b[0], w0b[1], w0b[2], w0b[3]}, cw1[8] = {w1a[0], w1a[1], w1a[2], w1a[3], w1b[0], w1b[1], w1b[2], w1b[3]},
                    cw2[8] = {w2a[0], w2a[1], w2a[2], w2a[3], w2b[0], w2b[1], w2b[2], w2b[3]};
#pragma unroll 4
        for (int i = 0; i < 8; ++i) { const int row = i * 4 + (lane >> 4); const int tt = qb * 256 + wid * QBLK + row; const size_t e = (size_t)(b * SEQ + tt) * DM + c;
            const u32x4 ov = *(const LAS u32x4*)(stg + row * 128 + ch * 8);
            const u32x4 u0 = *(const u32x4*)(T.u + e), gbv = *(const u32x4*)(T.gb + e), sgv = *(const u32x4*)(T.sg + e);
            u32x4 u1 = {0u, 0u, 0u, 0u}, u2 = {0u, 0u, 0u, 0u};
            if (tt >= 1) u1 = *(const u32x4*)(T.u + e - DM);
            if (tt >= 2) u2 = *(const u32x4*)(T.u + e - 2 * DM);
            u32x4 res;
#pragma unroll
            for (int q = 0; q < 4; ++q) {
                const float cl = cw0[2 * q] * bflo(u2[q]) + cw1[2 * q] * bflo(u1[q]) + cw2[2 * q] * bflo(u0[q]), chh = cw0[2 * q + 1] * bfhi(u2[q]) + cw1[2 * q + 1] * bfhi(u1[q]) + cw2[2 * q + 1] * bfhi(u0[q]);
                res[q] = cvt_pk_bf16(bflo(gbv[q]) * cl + bflo(sgv[q]) * bflo(ov[q]), bfhi(gbv[q]) * chh + bfhi(sgv[q]) * bfhi(ov[q])); }
            *(u32x4*)(T.merged + e) = res; }
    }
    asm volatile("s_waitcnt lgkmcnt(0)" ::: "memory");
    __syncthreads();
#undef SLOAD
#undef SWRITE
#undef RESC
}

constexpr int K2_BYTES = KVBLK * QKH * 2, V2_OFF = 0, K2_OFF = 3 * SHM_V, WS2_OFF = K2_OFF + 2 * K2_BYTES, ATT2_LDS = WS2_OFF + NW * 64 * 4;
__device__ __forceinline__ void qkt2(f32x16& p0, f32x16& p1, const LAS char* Krow, const int (&koff)[4], const bf16x8 (&qr)[12]) {
    p0 = f32x16{}; p1 = f32x16{};
#pragma unroll
    for (int d0 = 0; d0 < 12; ++d0) {
        const LAS char* a = Krow + (d0 >> 2) * 128 + koff[d0 & 3];
        const bf16x8 b0 = *(const LAS bf16x8*)a;
        const bf16x8 b1 = *(const LAS bf16x8*)(a + 32 * QKH * 2);
        p0 = __builtin_amdgcn_mfma_f32_32x32x16_bf16(b0, qr[d0], p0, 0, 0, 0);
        p1 = __builtin_amdgcn_mfma_f32_32x32x16_bf16(b1, qr[d0], p1, 0, 0, 0); }
}
template <int MODE> __device__ __forceinline__ void attn_unit2(const AttnArgs& T, int b, int h, int qb, LAS char* lds) {
    int tid = threadIdx.x; asm volatile("" : "+v"(tid));
    const int lane = tid & 63, r32 = lane & 31, hi = lane >> 5; const int wid = __builtin_amdgcn_readfirstlane(tid >> 6);
    LAS char* V_lds = lds + V2_OFF; LAS char* K_lds = lds + K2_OFF;
    LAS float* ws = (LAS float*)(lds + WS2_OFF) + wid * 64; LAS float* li_l = ws; LAS float* al_l = ws + 32;
    const int mrow = b * SEQ + qb * 256 + wid * QBLK + r32;
    const char* Kh = (const char*)(T.Kb + (size_t)(b * NH + h) * SEQ * QKH); const char* Vh = (const char*)(T.Vb + (size_t)(b * NH + h) * SEQ * VH);
#define DMA_KV(t, kbuf, vbuf) do { const char* kt = Kh + (size_t)(t) * K2_BYTES; const char* vt = Vh + (size_t)(t) * SHM_V; int ln = lane; asm volatile("" : "+v"(ln)); \
    _Pragma("unroll") for (int _i = 0; _i < 3; ++_i) { const int q = (wid * 3 + _i) * 64 + ln, r = q / 24, cp = q - r * 24, c = (cp & ~7) | ((cp & 7) ^ ((r >> 1) & 7)); \
        __builtin_amdgcn_global_load_lds((const unsigned*)(kt + (unsigned)(r * 384 + c * 16)), (LAS unsigned*)(K_lds + (kbuf) * K2_BYTES + (wid * 3 + _i) * 1024), 16, 0, 0); } \
    _Pragma("unroll") for (int _i = 0; _i < 2; ++_i) { const int q = (wid * 2 + _i) * 64 + ln, sub = q >> 5, w = q & 31, kk = ((sub >> 2) << 3) | (w >> 2), k = (kk & ~0xC) | ((kk & 4) << 1) | ((kk & 8) >> 1), c = ((sub & 3) << 5) | ((w & 3) << 3); \
        __builtin_amdgcn_global_load_lds((const unsigned*)(vt + (unsigned)(k * 256 + c * 2)), (LAS unsigned*)(V_lds + (vbuf) * SHM_V + (wid * 2 + _i) * 1024), 16, 0, 0); } } while (0)
#define RESC(a) do { if (__any((a) < 1.f)) { if (hi == 0) al_l[r32] = (a); asm volatile("s_waitcnt lgkmcnt(0)" ::: "memory"); \
    _Pragma("unroll") for (int d = 0; d < 4; ++d) _Pragma("unroll") for (int r = 0; r < 16; ++r) o[d][r] *= al_l[crow(r, hi)]; } } while (0)
    DMA_KV(0, 0, 0);
    const int vb0 = (int)(uintptr_t)V_lds + v_rd_base(lane);
    const LAS char* Krow = K_lds + r32 * (QKH * 2);
    int koff[4];
    { const int sw = (r32 >> 1) & 7;
#pragma unroll
      for (int j = 0; j < 4; ++j) koff[j] = ((2 * j + hi) ^ sw) * 16; }
    bf16x8 qr[12];
    {
        const bf16_t* Qw = T.Q + (size_t)mrow * 1536 + h * QKH + hi * 8;
        u32x4 raw[12];
#pragma unroll
        for (int d0 = 0; d0 < 12; ++d0) raw[d0] = *(const u32x4*)(Qw + d0 * 16);
        const f32x2 sq2 = *(const f32x2*)(T.ssp + (size_t)mrow * 4); const float ssq = sq2[0] + sq2[1];
        float ss = 0.f;
#pragma unroll
        for (int d0 = 0; d0 < 12; ++d0)
#pragma unroll
            for (int e = 0; e < 4; ++e) { const float a = bflo(raw[d0][e]), c = bfhi(raw[d0][e]); ss += a * a + c * c; }
        { auto rr = __builtin_amdgcn_permlane32_swap(__float_as_uint(ss), __float_as_uint(ss), false, false); ss = __uint_as_float(rr[0]) + __uint_as_float(rr[1]); }
        const float rq2 = 1.f / (ssq * (1.f / QL) + EPS);
        const float rn = 1.f / sqrtf(ss * rq2 * (1.f / QKH) + EPS) * sqrtf(rq2);
#pragma unroll
        for (int d0 = 0; d0 < 8; ++d0) { const f32x4 g0 = *(const f32x4*)(T.q_g + d0 * 16 + hi * 8), g1 = *(const f32x4*)(T.q_g + d0 * 16 + hi * 8 + 4);
            u32x4 w; w.x = cvt_pk_bf16(bflo(raw[d0].x) * rn * g0[0], bfhi(raw[d0].x) * rn * g0[1]); w.y = cvt_pk_bf16(bflo(raw[d0].y) * rn * g0[2], bfhi(raw[d0].y) * rn * g0[3]);
            w.z = cvt_pk_bf16(bflo(raw[d0].z) * rn * g1[0], bfhi(raw[d0].z) * rn * g1[1]); w.w = cvt_pk_bf16(bflo(raw[d0].w) * rn * g1[2], bfhi(raw[d0].w) * rn * g1[3]);
            qr[d0] = *reinterpret_cast<bf16x8*>(&w); }
#pragma unroll
        for (int p = 0; p < 2; ++p) {
            const int ib = 16 * p + 8 * hi;
            float x1[8], x2[8];
            const f32x4 ga = *(const f32x4*)(T.q_g + 128 + ib), gb_ = *(const f32x4*)(T.q_g + 128 + ib + 4), gc = *(const f32x4*)(T.q_g + 160 + ib), gd = *(const f32x4*)(T.q_g + 160 + ib + 4);
            const float g1v[8] = {ga[0], ga[1], ga[2], ga[3], gb_[0], gb_[1], gb_[2], gb_[3]}, g2v[8] = {gc[0], gc[1], gc[2], gc[3], gd[0], gd[1], gd[2], gd[3]};
#pragma unroll
            for (int e = 0; e < 4; ++e) { x1[2 * e] = bflo(raw[8 + p][e]) * rn * g1v[2 * e]; x1[2 * e + 1] = bfhi(raw[8 + p][e]) * rn * g1v[2 * e + 1];
                                          x2[2 * e] = bflo(raw[10 + p][e]) * rn * g2v[2 * e]; x2[2 * e + 1] = bfhi(raw[10 + p][e]) * rn * g2v[2 * e + 1]; }
            float y1[8], y2[8];
#pragma unroll
            for (int jj = 0; jj < 4; ++jj) { const f32x4 c2 = *(const f32x4*)((const float*)T.cs + ((size_t)mrow * 32 + ib + 2 * jj) * 2);
                y1[2 * jj] = x1[2 * jj] * c2[0] - x2[2 * jj] * c2[1]; y2[2 * jj] = x2[2 * jj] * c2[0] + x1[2 * jj] * c2[1];
                y1[2 * jj + 1] = x1[2 * jj + 1] * c2[2] - x2[2 * jj + 1] * c2[3]; y2[2 * jj + 1] = x2[2 * jj + 1] * c2[2] + x1[2 * jj + 1] * c2[3]; }
            u32x4 w1, w2; w1.x = cvt_pk_bf16(y1[0], y1[1]); w1.y = cvt_pk_bf16(y1[2], y1[3]); w1.z = cvt_pk_bf16(y1[4], y1[5]); w1.w = cvt_pk_bf16(y1[6], y1[7]);
            w2.x = cvt_pk_bf16(y2[0], y2[1]); w2.y = cvt_pk_bf16(y2[2], y2[3]); w2.z = cvt_pk_bf16(y2[4], y2[5]); w2.w = cvt_pk_bf16(y2[6], y2[7]);
            qr[8 + p] = *reinterpret_cast<bf16x8*>(&w1); qr[10 + p] = *reinterpret_cast<bf16x8*>(&w2); }
    }
    float m_reg = -1e30f, l_reg = 0.f; f32x16 o[4] = {};
    f32x16 pA0, pA1, pB0, pB1; float alA = 1.f, alB = 1.f; bf16x8 pa0, pa1, pa2, pa3;
    const int NT = 4 * qb + 4; const int wp = wid >> 1;
    const bool a1 = wp >= 1, a2 = wp >= 2, a3 = wp >= 3;
#define MASK(P0, P1, act) do { if (!(act)) { _Pragma("unroll") for (int r = 0; r < 16; ++r) { P0[r] = -INFINITY; P1[r] = -INFINITY; } } } while (0)
#define INTERVAL(PN0, PN1, PO0, PO1, alN, alO, t, act, load) do { \
        if (load) DMA_KV((t) + 1, ((t) + 1) & 1, vnext); \
        SBAR(); if (act) qkt2(PN0, PN1, Krow + ((t) & 1) * K2_BYTES, koff, qr); MASK(PN0, PN1, act); \
        if (MODE == 2) { asm volatile("" : "+v"(PO0), "+v"(PO1)); pa0 = __builtin_bit_cast(bf16x8, (u32x4){__float_as_uint(PO0[0]), __float_as_uint(PO0[1]), __float_as_uint(PO0[2]), __float_as_uint(PO0[3])}); pa1 = pa0; pa2 = pa0; pa3 = pa0; } \
        else finishSM(PO0, PO1, alO, l_reg, pa0, pa1, pa2, pa3); \
        SBAR(); pv_d0(o, vb0 + vprev * SHM_V, pa0, pa1, pa2, pa3); if (MODE == 2) { asm volatile("" : "+v"(PN0), "+v"(PN1)); } else partialSM(PN0, PN1, m_reg, alN); \
        __syncthreads(); RESC(alN); \
        vprev = vcur; vcur = vnext; vnext = (vnext == 2) ? 0 : vnext + 1; } while (0)
    __syncthreads();
    int vprev = 0, vcur = 1, vnext = 2;
    DMA_KV(1, 1, 1);
    qkt2(pA0, pA1, Krow, koff, qr); partialSM(pA0, pA1, m_reg, alA);
    __syncthreads();
    for (int j = 1; j + 3 < NT; j += 2) {
        INTERVAL(pB0, pB1, pA0, pA1, alB, alA, j, true, true);
        INTERVAL(pA0, pA1, pB0, pB1, alA, alB, j + 1, true, true);
    }
    INTERVAL(pB0, pB1, pA0, pA1, alB, alA, NT - 3, a1, true);
    INTERVAL(pA0, pA1, pB0, pB1, alA, alB, NT - 2, a2, true);
    INTERVAL(pB0, pB1, pA0, pA1, alB, alA, NT - 1, a3, false);
    finishSM(pB0, pB1, alB, l_reg, pa0, pa1, pa2, pa3); SBAR();
    pv_d0(o, vb0 + vprev * SHM_V, pa0, pa1, pa2, pa3);
#undef INTERVAL
#undef MASK
    if (hi == 0) li_l[r32] = l_reg; asm volatile("s_waitcnt lgkmcnt(0)" ::: "memory");
    float rli[16];
#pragma unroll
    for (int r = 0; r < 16; ++r) rli[r] = __builtin_amdgcn_rcpf(li_l[crow(r, hi)]);
    __syncthreads();
    LAS bf16_t* stg = (LAS bf16_t*)(lds + wid * 8192);
#pragma unroll
    for (int r = 0; r < 16; ++r) { const int orow = crow(r, hi);
#pragma unroll
        for (int d0 = 0; d0 < 4; ++d0) stg[orow * 128 + d0 * 32 + r32] = f2bf(o[d0][r] * rli[r]); }
    asm volatile("s_waitcnt lgkmcnt(0)" ::: "memory");
    if (MODE == 0) {
        const int g = lane >> 4, ch = lane & 15, c = h * VH + ch * 8; const int t0 = qb * 256 + wid * QBLK;
        const size_t e0 = (size_t)(b * SEQ + t0) * DM + c;
        u32x4 uu[8], gv[8], sv[8];
#pragma unroll
        for (int i = 0; i < 8; ++i) { const size_t e = e0 + (size_t)(4 * i + g) * DM; uu[i] = *(const u32x4*)(T.u + e); gv[i] = *(const u32x4*)(T.gb + e); sv[i] = *(const u32x4*)(T.sg + e); }
        u32x4 uvirt = {0u, 0u, 0u, 0u};
        if (g >= 2 && t0 > 0) uvirt = *(const u32x4*)(T.u + e0 - (size_t)(4 - g) * DM);
        const f32x4 w0a = *(const f32x4*)(T.conv_w + c), w0b = *(const f32x4*)(T.conv_w + c + 4), w1a = *(const f32x4*)(T.conv_w + DM + c), w1b = *(const f32x4*)(T.conv_w + DM + c + 4),
              w2a = *(const f32x4*)(T.conv_w + 2 * DM + c), w2b = *(const f32x4*)(T.conv_w + 2 * DM + c + 4);
        const float cw0[8] = {w0a[0], w0a[1], w0a[2], w0a[3], w0b[0], w0b[1], w0b[2], w0b[3]}, cw1[8] = {w1a[0], w1a[1], w1a[2], w1a[3], w1b[0], w1b[1], w1b[2], w1b[3]},
                    cw2[8] = {w2a[0], w2a[1], w2a[2], w2a[3], w2b[0], w2b[1], w2b[2], w2b[3]};
        const int src1 = ((lane - 16) & 63) << 2, src2 = (lane ^ 32) << 2;
#pragma unroll
        for (int i = 0; i < 8; ++i) { const int row = i * 4 + g; const size_t e = e0 + (size_t)row * DM;
            const u32x4 ov = *(const LAS u32x4*)(stg + row * 128 + ch * 8);
            const u32x4 up = (i == 0) ? uvirt : uu[i > 0 ? i - 1 : 0];
            u32x4 u1, u2, res;
#pragma unroll
            for (int q = 0; q < 4; ++q) { const unsigned x1 = (g == 3) ? up[q] : uu[i][q], x2 = (g >= 2) ? up[q] : uu[i][q];
                u1[q] = (unsigned)__builtin_amdgcn_ds_bpermute(src1, (int)x1); u2[q] = (unsigned)__builtin_amdgcn_ds_bpermute(src2, (int)x2); }
#pragma unroll
            for (int q = 0; q < 4; ++q) {
                const float cl = cw0[2 * q] * bflo(u2[q]) + cw1[2 * q] * bflo(u1[q]) + cw2[2 * q] * bflo(uu[i][q]), chh = cw0[2 * q + 1] * bfhi(u2[q]) + cw1[2 * q + 1] * bfhi(u1[q]) + cw2[2 * q + 1] * bfhi(uu[i][q]);
                res[q] = cvt_pk_bf16(bflo(gv[i][q]) * cl + bflo(sv[i][q]) * bflo(ov[q]), bfhi(gv[i][q]) * chh + bfhi(sv[i][q]) * bfhi(ov[q])); }
            *(u32x4*)(T.merged + e) = res; }
    }
    asm volatile("s_waitcnt lgkmcnt(0)" ::: "memory");
    __syncthreads();
#undef DMA_KV
#undef RESC
}
#undef SBAR
}
#ifndef ATTN_UNIT
#define ATTN_UNIT attn_unit2
#endif
struct Frame {
    LAS unsigned char* lds; volatile LAS unsigned* MISC; unsigned* ctl;
    int tid, lane, wave, vcu, G;
};
__device__ __forceinline__ float wave_sum(float v) {
#pragma unroll
    for (int o = 1; o < 64; o <<= 1) v += __shfl_xor(v, o);
    return v;
}
__device__ __forceinline__ int tcc(int bj, int ch128) { return (bj << 7) | (ch128 & 0x60) | (((ch128 >> 2) & 1) << 4) | (((ch128 >> 3) & 3) << 2) | (ch128 & 3); }
struct MapIn { __device__ __forceinline__ int operator()(int c) const {
    if (c < C_ZB) return 256 * (c >> 7) + tcc(0, c & 127);
    if (c < C_ZC) { const int ch = c - C_ZB; return 256 * (8 + (ch >> 7)) + tcc(0, ch & 127); }
    if (c < C_QL) { const int ch = c - C_ZC; return 256 * (ch >> 7) + tcc(1, ch & 127); }
    if (c < C_KVL) { const int j = c - C_QL; return j < 256 ? 256 * 20 + permL(j) : 256 * 21 + permL(j - 256); }
    if (c < C_KR) return 256 * 22 + permL(c - C_KVL);
    if (c < C_GC) { const int j = c - C_KR, jj = j & 31; return 256 * 21 + 128 + ((jj >> 4) << 5) + ((j >> 5) << 4) + (((jj >> 2) & 3) << 2) + (jj & 3); }
    if (c < C_GM) { const int ch = c - C_GC; return 256 * (8 + (ch >> 7)) + tcc(1, ch & 127); }
    { const int j = c - C_GM; return 256 * (16 + (j >> 8)) + permL(j & 255); } } };
struct MapPerm { __device__ __forceinline__ int operator()(int c) const { return (c & ~255) | permL(c & 255); } };
struct MapId { __device__ __forceinline__ int operator()(int c) const { return c; } };
struct MapGU { int n; __device__ __forceinline__ int operator()(int f) const { const int r = f & 127; return 256 * (f >> 7) + ((((r >> 2) & 1) << 7) | ((r >> 5) << 5) | (n << 4) | (((r >> 3) & 3) << 2) | (r & 3)); } };

template <class RowMap>
__device__ __forceinline__ void transpose_item(const float* W, int N, bf16_t* WT, int ldt, const float* kscale, LAS float* scr, int item, int lane, const RowMap& rm) {
    const int nblk = N / 32, kb = item / nblk, nb = item % nblk, k0 = 64 * kb, n0 = 32 * nb;
    float wv[32];
#pragma unroll
    for (int i = 0; i < 32; ++i) wv[i] = W[(size_t)(k0 + 2 * i + (lane >> 5)) * N + n0 + (lane & 31)];
#pragma unroll
    for (int i = 0; i < 32; ++i) { const int kk = 2 * i + (lane >> 5); const float sc = kscale ? kscale[k0 + kk] : 1.f; scr[kk * 33 + (lane & 31)] = wv[i] * sc; }
    asm volatile("s_waitcnt lgkmcnt(0)" ::: "memory");
    const int c = lane & 7;
#pragma unroll
    for (int j = 0; j < 4; ++j) { const int n = (lane >> 3) + 8 * j; const LAS float* s = scr + (8 * c) * 33 + n;
        u32x4 o; o.x = cvt_pk_bf16(s[0 * 33], s[1 * 33]); o.y = cvt_pk_bf16(s[2 * 33], s[3 * 33]); o.z = cvt_pk_bf16(s[4 * 33], s[5 * 33]); o.w = cvt_pk_bf16(s[6 * 33], s[7 * 33]);
        *(u32x4*)(WT + (size_t)rm(n0 + n) * ldt + k0 + 8 * c) = o; }
    asm volatile("s_waitcnt lgkmcnt(0)" ::: "memory");
}
constexpr size_t WS_WIN = WS_WSMALL, WS_WQ = WS_WIN + (size_t)5888 * 1024 * 2, WS_WKV = WS_WQ + (size_t)1536 * 384 * 2, WS_WO = WS_WKV + (size_t)2048 * 256 * 2;
static_assert(WS_WO + (size_t)1024 * 1024 * 2 <= WS_A, "small weights fit below region A");
constexpr size_t WS_EGU = WS_C, WS_EDN = WS_C + (size_t)NEXP * 512 * 1024 * 2;
static_assert(WS_EDN + (size_t)NEXP * 1024 * 256 * 2 <= WS_D, "expert weights fit region C");

__device__ __forceinline__ void p0_weights_tables(const Ptrs& P, Frame& F) {
    LAS float* scr = (LAS float*)(F.lds + RING_OFF + F.wave * 16384);
    const int gw = F.vcu * NWAVES + F.wave, NGW = F.G * NWAVES;
    constexpr int I_IN = (DM / 64) * (DIN / 32), I_Q = (QL / 64) * (1536 / 32), I_KV = (KVL / 64) * (2048 / 32), I_O = (DM / 64) * (DM / 32);
    for (int it = gw; it < I_IN + I_Q + I_KV + I_O; it += NGW) {
        int r = it;
        if (r < I_IN) { transpose_item(P.w_in, DIN, (bf16_t*)(P.ws + WS_WIN), DM, (const float*)nullptr, scr, r, F.lane, MapIn{}); continue; } r -= I_IN;
        if (r < I_Q) { transpose_item(P.w_q_b, 1536, (bf16_t*)(P.ws + WS_WQ), QL, P.q_a_g, scr, r, F.lane, MapPerm{}); continue; } r -= I_Q;
        if (r < I_KV) { transpose_item(P.w_kv_b, 2048, (bf16_t*)(P.ws + WS_WKV), KVL, P.kv_a_g, scr, r, F.lane, MapPerm{}); continue; } r -= I_KV;
        transpose_item(P.w_o, DM, (bf16_t*)(P.ws + WS_WO), DM, (const float*)nullptr, scr, r, F.lane, MapPerm{});
    }
    {
        const int gt = F.vcu * 512 + F.tid;
        if (gt < 64 * 128) { const int rr = 192 + (gt >> 7), ch = gt & 127; *(u32x4*)((bf16_t*)(P.ws + WS_WIN) + (size_t)(256 * 21 + rr) * DM + ch * 8) = (u32x4){0u, 0u, 0u, 0u}; } }
    {
        float2* cs = (float2*)(P.ws + WS_CS);
        for (int idx = F.vcu * 512 + F.tid; idx < M * 32; idx += F.G * 512) { const int m = idx >> 5, i = idx & 31;
            const double inv = exp2(-(double)(2 * i) * (13.287712379549449 / 64.0));
            const double ang = (double)P.pos[m] * inv; float2 v; v.x = (float)cos(ang); v.y = (float)sin(ang); cs[idx] = v; } }
    asm volatile("s_waitcnt vmcnt(0) lgkmcnt(0)" ::: "memory"); __syncthreads();
}
__device__ __forceinline__ void p0_mod(const Ptrs& P, Frame& F) {
    if (F.vcu < 192) {
        LAS float* cact = (LAS float*)(F.lds + RING_OFF); LAS float* red = (LAS float*)(F.lds + RING_OFF + 65536);
        for (int idx = F.tid; idx < BATCH * DM; idx += 512) { const float cv = P.c[idx]; cact[idx] = cv / (1.f + __expf(-cv)); }
        __syncthreads();
        const int n0 = 32 * F.vcu, kl = F.lane >> 3, c4 = F.lane & 7;
        f32x4 acc[16];
#pragma unroll
        for (int b = 0; b < 16; ++b) acc[b] = (f32x4){0.f, 0.f, 0.f, 0.f};
        for (int it = 0; it < 16; ++it) { const int k = 128 * F.wave + 8 * it + kl;
            const f32x4 wv = *(const f32x4*)(P.w_ada + (size_t)k * 6144 + n0 + 4 * c4);
#pragma unroll
            for (int b = 0; b < 16; ++b) acc[b] += cact[b * DM + k] * wv; }
#pragma unroll
        for (int b = 0; b < 16; ++b)
#pragma unroll
            for (int e = 0; e < 4; ++e) { float v = acc[b][e]; v += __shfl_xor(v, 8); v += __shfl_xor(v, 16); v += __shfl_xor(v, 32); if (kl == 0) red[(F.wave * 16 + b) * 32 + 4 * c4 + e] = v; }
        __syncthreads();
        { const int b = F.tid >> 5, cc = F.tid & 31; float s = P.b_ada[n0 + cc];
#pragma unroll
          for (int w = 0; w < 8; ++w) s += red[(w * 16 + b) * 32 + cc];
          ((float*)(P.ws + WS_MOD))[b * 6144 + n0 + cc] = s; }
        __syncthreads();
    }
}
__device__ __forceinline__ void expert_weight_items(const Ptrs& P, Frame& F, int w, int nw, int k_lo, int k_hi) {
    LAS float* scr = (LAS float*)(F.lds + RING_OFF + F.wave * 16384);
    constexpr int I_G = (DM / 64) * (DEXP / 32), I_D = (DEXP / 64) * (DM / 32);
    for (int k = k_lo; k < k_hi; ++k) { const int it = w + k * nw; if (it >= NEXP * (2 * I_G + I_D)) break;
        const int e = it / (2 * I_G + I_D); int r = it % (2 * I_G + I_D);
        bf16_t* gu = (bf16_t*)(P.ws + WS_EGU) + (size_t)e * 512 * DM; bf16_t* dn = (bf16_t*)(P.ws + WS_EDN) + (size_t)e * DM * DEXP;
        if (r < I_G) { transpose_item(P.w_gate + (size_t)e * DM * DEXP, DEXP, gu, DM, (const float*)nullptr, scr, r, F.lane, MapGU{0}); continue; } r -= I_G;
        if (r < I_G) { transpose_item(P.w_up + (size_t)e * DM * DEXP, DEXP, gu, DM, (const float*)nullptr, scr, r, F.lane, MapGU{1}); continue; } r -= I_G;
        transpose_item(P.w_down + (size_t)e * DEXP * DM, DM, dn, DEXP, (const float*)nullptr, scr, r, F.lane, MapPerm{});
    }
}
__device__ __forceinline__ void p1_norm1(const Ptrs& P, Frame& F) {
    const int gw = F.vcu * NWAVES + F.wave, NGW = F.G * NWAVES;
    bf16_t* h = (bf16_t*)(P.ws + WS_A);
    for (int m = gw; m < M; m += NGW) {
        const float* mod = (const float*)(P.ws + WS_MOD) + (m / SEQ) * 6144;
        const f32x4* xr = (const f32x4*)(P.x + (size_t)m * DM) + F.lane;
        f32x4 v[4]; float s = 0.f;
#pragma unroll
        for (int j = 0; j < 4; ++j) { v[j] = xr[64 * j]; s += (v[j][0] * v[j][0] + v[j][1] * v[j][1]) + (v[j][2] * v[j][2] + v[j][3] * v[j][3]); }
        const float rstd = 1.f / sqrtf(wave_sum(s) * (1.f / DM) + EPS);
        unsigned long long* o8 = (unsigned long long*)(h + (size_t)m * DM) + F.lane;
#pragma unroll
        for (int j = 0; j < 4; ++j) { const int d = 4 * F.lane + 256 * j;
            const f32x4 g = *(const f32x4*)(P.norm1_g + d), sc = *(const f32x4*)(mod + 1024 + d), sh = *(const f32x4*)(mod + d);
            const f32x4 r = v[j] * rstd * g * (sc + 1.f) + sh;
            o8[64 * j] = (unsigned long long)cvt_pk_bf16(r[0], r[1]) | ((unsigned long long)cvt_pk_bf16(r[2], r[3]) << 32); }
    }
}

constexpr size_t WS_WR = 30 * MiB;
constexpr size_t WS_STOK = WS_RT + 512 * 1024, WS_SW = WS_STOK + 320 * 1024;
constexpr int MAXROWS = 81920, MAXTILES = 320;
constexpr size_t WS_H2 = WS_B, WS_HACT = WS_B + 64 * MiB;
constexpr size_t WS_X1B = WS_B + 128 * MiB;
constexpr size_t WS_DELTA = WS_D, WS_Y0 = WS_A, WS_Y1 = WS_D + 64 * MiB;
constexpr int CW_T = CW_TILES, CW_T0 = CW_TILES + 1, CW_TGRP = CW_TILES + 64;

__device__ __forceinline__ void p0_router_weights(const Ptrs& P, Frame& F) {
    bf16_t* hi = (bf16_t*)(P.ws + WS_WR); bf16_t* lo = hi + 48 * DM;
    for (int idx = F.vcu * 512 + F.tid; idx < 48 * DM; idx += F.G * 512) { const int o = idx >> 10, k = idx & 1023;
        const float v = o < 4 ? P.w_rg[k * 4 + o] : (o < 36 ? P.w_re[k * 32 + o - 4] : 0.f);
        const bf16_t h = f2bf(v); hi[idx] = h; lo[idx] = f2bf(v - bf2f(h)); }
}
template <int MODE> __device__ __forceinline__ void p6_rows(const Ptrs& P, Frame& F) {
    LAS unsigned char* tile = F.lds + RING_OFF + F.wave * 8192;
    LAS float* lg = (LAS float*)(F.lds + RING_OFF + 65536 + F.wave * 1536);
    LAS unsigned char* wch = F.lds + RING_OFF + 77824;
    LAS float* gms = (LAS float*)(F.lds + XCH_OFF);
    LAS unsigned* hist = (LAS unsigned*)(F.lds + LDSCTL_OFF + 1024);
    const bf16_t* WrHi = (const bf16_t*)(P.ws + WS_WR); const bf16_t* WrLo = WrHi + 48 * DM;
    bf16_t* h2 = (bf16_t*)(P.ws + WS_H2); const bf16_t* dl = (const bf16_t*)(P.ws + WS_DELTA); bf16_t* x1b = (bf16_t*)(P.ws + WS_X1B);
    int2* rte = (int2*)(P.ws + WS_RT); float2* rtw = (float2*)(P.ws + WS_RT + 256 * 1024);
    const int t = F.lane & 15, q = F.lane >> 4;
    for (int rb = F.vcu; rb < M / 128; rb += F.G) {
        const int m0 = rb * 128 + F.wave * 16, b = m0 / SEQ;
        const float* mod = (const float*)(P.ws + WS_MOD) + b * 6144;
        __syncthreads();
        if (F.tid < 64) hist[F.tid] = 0u;
        for (int k = F.tid; k < DM; k += 512) { gms[k] = P.norm2_g[k] * (1.f + mod[4096 + k]); gms[DM + k] = mod[3072 + k]; }
        __syncthreads();
#pragma unroll 1
        for (int hb = 0; hb < 2; ++hb) {
            const int mb = m0 + 8 * hb;
            f32x4 xv[8][4]; float rstd[8];
#pragma unroll
            for (int r = 0; r < 8; ++r) { const f32x4* xr = (const f32x4*)(P.x + (size_t)(mb + r) * DM) + F.lane; const u32x2* dr = (const u32x2*)(dl + (size_t)(mb + r) * DM) + F.lane;
#pragma unroll
                for (int c = 0; c < 4; ++c) { const f32x4 x4 = xr[64 * c]; const u32x2 d = dr[64 * c];
                    xv[r][c][0] = x4[0] + __uint_as_float(d.x << 16); xv[r][c][1] = x4[1] + __uint_as_float(d.x & 0xffff0000u); xv[r][c][2] = x4[2] + __uint_as_float(d.y << 16); xv[r][c][3] = x4[3] + __uint_as_float(d.y & 0xffff0000u); } }
#pragma unroll
            for (int r = 0; r < 8; ++r) { float s = 0.f;
#pragma unroll
                for (int c = 0; c < 4; ++c) s += (xv[r][c][0] * xv[r][c][0] + xv[r][c][1] * xv[r][c][1]) + (xv[r][c][2] * xv[r][c][2] + xv[r][c][3] * xv[r][c][3]);
                rstd[r] = 1.f / sqrtf(wave_sum(s) * (1.f / DM) + EPS); }
            f32x4 acc[3];
#pragma unroll
            for (int cb = 0; cb < 3; ++cb) acc[cb] = (f32x4){0.f, 0.f, 0.f, 0.f};
#pragma unroll
            for (int c = 0; c < 4; ++c) {
                const int k0 = 256 * c + 4 * F.lane;
                __syncthreads();
#pragma unroll
                for (int j = 0; j < 6; ++j) { const int id = F.tid + 512 * j, arr = id / 1536, rem = id - arr * 1536, row = rem >> 5, ch = rem & 31;
                    *(LAS u32x4*)(wch + arr * 24576 + row * 512 + ((ch ^ (row & 15)) << 4)) = *(const u32x4*)((arr ? WrLo : WrHi) + (size_t)row * DM + 256 * c + 8 * ch); }
                const f32x4 gm = *(const LAS f32x4*)(gms + k0), sh = *(const LAS f32x4*)(gms + DM + k0);
#pragma unroll
                for (int r = 0; r < 8; ++r) { const f32x4 h = xv[r][c] * rstd[r] * gm + sh;
                    u32x2 hi; hi.x = cvt_pk_bf16(h[0], h[1]); hi.y = cvt_pk_bf16(h[2], h[3]);
                    u32x2 lo; lo.x = cvt_pk_bf16(h[0] - __uint_as_float(hi.x << 16), h[1] - __uint_as_float(hi.x & 0xffff0000u)); lo.y = cvt_pk_bf16(h[2] - __uint_as_float(hi.y << 16), h[3] - __uint_as_float(hi.y & 0xffff0000u));
                    *(u32x2*)(h2 + (size_t)(mb + r) * DM + k0) = hi;
                    const int off = r * 512 + ((((F.lane >> 1) ^ r) & 31) << 4) + ((F.lane & 1) << 3);
                    *(LAS u32x2*)(tile + off) = hi; *(LAS u32x2*)(tile + 4096 + off) = lo; }
                asm volatile("s_waitcnt vmcnt(0) lgkmcnt(0)" ::: "memory");
                __syncthreads();
#pragma unroll 2
                for (int ks = 0; ks < (MODE == 1 ? 0 : 8); ++ks) { const int tr = t & 7;
                    const int off = tr * 512 + ((((4 * ks + q) ^ tr) & 31) << 4);
                    const bf16x8 bh = *(const LAS bf16x8*)(tile + off), bl = *(const LAS bf16x8*)(tile + 4096 + off);
#pragma unroll
                    for (int cb = 0; cb < 3; ++cb) { const int woff = (16 * cb + t) * 512 + ((((4 * ks + q) ^ t) & 31) << 4);
                        const bf16x8 wh = *(const LAS bf16x8*)(wch + woff), wl = *(const LAS bf16x8*)(wch + 24576 + woff);
                        acc[cb] = __builtin_amdgcn_mfma_f32_16x16x32_bf16(wh, bh, acc[cb], 0, 0, 0);
                        acc[cb] = __builtin_amdgcn_mfma_f32_16x16x32_bf16(wh, bl, acc[cb], 0, 0, 0);
                        acc[cb] = __builtin_amdgcn_mfma_f32_16x16x32_bf16(wl, bh, acc[cb], 0, 0, 0); } }
                asm volatile("s_waitcnt lgkmcnt(0)" ::: "memory");
            }
            if (t < 8) {
#pragma unroll
                for (int cb = 0; cb < 3; ++cb)
#pragma unroll
                    for (int r = 0; r < 4; ++r) lg[t * 48 + 16 * cb + 4 * q + r] = acc[cb][r]; }
            asm volatile("s_waitcnt lgkmcnt(0)" ::: "memory");
            if (MODE != 1 && q == 0 && t < 8) {
                const int m = mb + t;
                const LAS float* l = lg + t * 48;
                float gl[4];
#pragma unroll
                for (int i = 0; i < 4; ++i) gl[i] = l[i] + P.b_rg[i];
                int g = 0; float gmx = gl[0];
#pragma unroll
                for (int i = 1; i < 4; ++i) if (gl[i] > gmx) { gmx = gl[i]; g = i; }
                float se = 0.f;
#pragma unroll
                for (int i = 0; i < 4; ++i) se += __expf(gl[i] - gmx);
                const float pg = 1.f / se;
                float e0v = -3.0e38f, e1v = -3.0e38f; int i0 = 0, i1 = 0;
#pragma unroll
                for (int i = 0; i < 8; ++i) { const float v = l[4 + g * 8 + i] + P.b_re[g * 8 + i];
                    if (v > e0v) { e1v = e0v; i1 = i0; e0v = v; i0 = i; } else if (v > e1v) { e1v = v; i1 = i; } }
                const float p1 = __expf(e1v - e0v), w0 = 1.f / (1.f + p1), w1 = p1 * w0;
                int2 e; e.x = g * 8 + i0; e.y = g * 8 + i1; float2 w; w.x = w0 * pg; w.y = w1 * pg;
                rte[m] = e; rtw[m] = w;
                __hip_atomic_fetch_add(&hist[e.x], 1u, __ATOMIC_RELAXED, __HIP_MEMORY_SCOPE_WORKGROUP); __hip_atomic_fetch_add(&hist[32 + e.y], 1u, __ATOMIC_RELAXED, __HIP_MEMORY_SCOPE_WORKGROUP);
            }
            asm volatile("s_waitcnt lgkmcnt(0)" ::: "memory");
        }
        __syncthreads();
        if (MODE != 1 && F.tid < 64) F.ctl[CW_HIST + rb * 64 + F.tid] = hist[F.tid];
    }
    __syncthreads();
}
__device__ __forceinline__ void p7_sort(const Ptrs& P, Frame& F) {
    LAS unsigned* tot = (LAS unsigned*)(F.lds + RING_OFF);
    LAS unsigned* pre = tot + 64;
    LAS unsigned* rbase = pre + 64;
    LAS unsigned* cnt = rbase + 64;
    LAS unsigned* misc = cnt + 64;
    int* stok = (int*)(P.ws + WS_STOK); float* sw = (float*)(P.ws + WS_SW);
    const int2* rte = (const int2*)(P.ws + WS_RT); const float2* rtw = (const float2*)(P.ws + WS_RT + 256 * 1024);
    const int cw = F.vcu * 7 + F.wave - 1, cnw = F.G * 7; bool first = true;
    for (int rb = F.vcu; rb < M / 128; rb += F.G) {
        __syncthreads();
        {
            LAS unsigned* ptot = misc + 8; LAS unsigned* ppre = ptot + 512;
            const int g = F.tid & 63, pt = F.tid >> 6; unsigned hv[32];
#pragma unroll
            for (int k = 0; k < 32; ++k) hv[k] = F.ctl[CW_HIST + (32 * pt + k) * 64 + g];
            unsigned s = 0u, p = 0u;
#pragma unroll
            for (int k = 0; k < 32; ++k) { if (32 * pt + k == rb) p = s; s += hv[k]; }
            if (rb >= 32 * pt + 32) p = s;
            ptot[pt * 64 + g] = s; ppre[pt * 64 + g] = p;
        }
        __syncthreads();
        if (F.tid < 64) { unsigned s = 0u, p = 0u;
#pragma unroll
            for (int pt = 0; pt < 8; ++pt) { s += misc[8 + pt * 64 + F.tid]; p += misc[8 + 512 + pt * 64 + F.tid]; }
            tot[F.tid] = s; pre[F.tid] = p; cnt[F.tid] = 0u; }
        if (first && F.wave > 0) expert_weight_items(P, F, cw, cnw, 0, 2);
        __syncthreads();
        if (first && F.wave > 0) expert_weight_items(P, F, cw, cnw, 2, 4);
        if (F.tid == 0) { unsigned tb = 0u;
            for (int g = 0; g < 64; ++g) { if (g == 32) misc[1] = tb; rbase[g] = tb * 256u; const unsigned nt = (tot[g] + 255u) >> 8;
                if (rb == 0) for (unsigned k = 0; k < nt; ++k) F.ctl[CW_TGRP + tb + k] = (unsigned)g;
                tb += nt; }
            misc[0] = tb; if (rb == 0) { F.ctl[CW_T] = tb; F.ctl[CW_T0] = misc[1]; } }
        __syncthreads();
        if (F.wave == 0) {
            const unsigned long long ltmask = (1ull << F.lane) - 1ull;
            for (int ch = 0; ch < 2; ++ch) { const int m = rb * 128 + ch * 64 + F.lane; const int2 e = rte[m]; const float2 w = rtw[m];
                for (int j = 0; j < 2; ++j) { const int ex = j ? e.y : e.x; const float wj = j ? w.y : w.x; unsigned rank = 0u, gsz = 0u;
                    for (int x = 0; x < 32; ++x) { const unsigned long long mk = __ballot(ex == x); if (ex == x) { rank = (unsigned)__popcll(mk & ltmask); gsz = (unsigned)__popcll(mk); } }
                    const int g = j * 32 + ex; const unsigned pos = rbase[g] + pre[g] + cnt[g] + rank;
                    stok[pos] = m; sw[pos] = wj;
                    asm volatile("s_waitcnt lgkmcnt(0)" ::: "memory");
                    if (rank == 0u) cnt[g] += gsz;
                    asm volatile("s_waitcnt lgkmcnt(0)" ::: "memory"); } } }
        if (rb < 64) { const unsigned n = tot[rb], padn = (((n + 255u) >> 8) << 8) - n;
            if ((unsigned)F.tid < padn) { stok[rbase[rb] + n + F.tid] = -1; sw[rbase[rb] + n + F.tid] = 0.f; } }
        if (first && F.wave > 0) expert_weight_items(P, F, cw, cnw, 4, 1 << 20);
        first = false;
    }
}
struct MoeSched {
    const bf16_t* A; const bf16_t* W; int lda, ldb; const int* stok; const unsigned* tgrp; int t_lo, nun, npn, G, c; size_t wstride; bool gather, split;
    __device__ bool next(int i, Unit& u) const {
        const int idx = i * G + c, nfull = (nun / G) * G, tail = nun - nfull; int U; u.half = 0;
        if (split && tail > 0 && 2 * tail <= G) { if (idx >= nfull + 2 * tail) return false; if (idx < nfull) U = idx; else { U = nfull + ((idx - nfull) >> 1); u.half = 1 + ((idx - nfull) & 1); } }
        else { if (idx >= nun) return false; U = idx; }
        u.aux = t_lo + U / npn; u.pn = U % npn; u.pm = (int)tgrp[u.aux]; return true; }
    __device__ __forceinline__ const char* abase(const Unit& u) const { return gather ? (const char*)A : (const char*)A + (size_t)(u.aux * BM + (u.half == 2 ? HALF : 0)) * lda * 2; }
    __device__ __forceinline__ const char* bbase(const Unit& u) const { return (const char*)W + (size_t)(u.pm & 31) * wstride + (size_t)u.pn * BM * ldb * 2; }
    __device__ __forceinline__ void avoff(const Unit& u, int R0, int C0, int R1, int C1, unsigned (&v0)[2], unsigned (&v1)[2]) const {
        if (gather) { const int* tk = stok + u.aux * BM + (u.half == 2 ? HALF : 0); const int o1 = u.half ? 0 : HALF; int a = tk[R0], b = tk[R1], c2 = tk[o1 + R0], d = tk[o1 + R1];
            a = a < 0 ? 0 : a; b = b < 0 ? 0 : b; c2 = c2 < 0 ? 0 : c2; d = d < 0 ? 0 : d;
            v0[0] = (unsigned)(a * lda + C0) * 2u; v0[1] = (unsigned)(b * lda + C1) * 2u; v1[0] = (unsigned)(c2 * lda + C0) * 2u; v1[1] = (unsigned)(d * lda + C1) * 2u; }
        else { v0[0] = (unsigned)(R0 * lda + C0) * 2u; v0[1] = (unsigned)(R1 * lda + C1) * 2u; const unsigned h1 = u.half ? 0u : (unsigned)(HALF * lda * 2); v1[0] = v0[0] + h1; v1[1] = v0[1] + h1; } }
};
struct EpiGU {
    bf16_t* hact; const float* sw;
    __device__ __forceinline__ void operator()(const f32x4 (&acc)[2][2][4][2], const Unit& un, int wr, int wc, int fr, int fq) const {
        asm volatile("" : "+v"(fr), "+v"(fq));
        const int r0 = un.aux * BM + (un.half == 2 ? HALF : 0) + wr * 64 + fr, c0 = 128 * un.pn + 32 * wc + 8 * fq;
#pragma unroll
        for (int ai = 0; ai < 2; ++ai)
#pragma unroll
            for (int m = 0; m < 4; ++m) { if (ai == 1 && un.half) continue; const int row = r0 + ai * HALF + m * 16; const float w = sw[row];
                f32x4 a, b;
#pragma unroll
                for (int i = 0; i < 4; ++i) { const float g0 = acc[ai][0][m][0][i], g1 = acc[ai][1][m][0][i];
                    a[i] = g0 * fsigmoid(g0) * acc[ai][0][m][1][i] * w; b[i] = g1 * fsigmoid(g1) * acc[ai][1][m][1][i] * w; }
                *(u32x4*)(hact + (size_t)row * DEXP + c0) = pack8(a, b); }
    }
};
struct EpiDown {
    bf16_t* y0; bf16_t* y1; const int* stok;
    __device__ __forceinline__ void operator()(const f32x4 (&acc)[2][2][4][2], const Unit& un, int wr, int wc, int fr, int fq) const {
        asm volatile("" : "+v"(fr), "+v"(fq));
        const int r0 = un.aux * BM + wr * 64 + fr, c0 = 256 * un.pn + 32 * wc + 8 * fq;
        bf16_t* y = (un.pm >> 5) ? y1 : y0;
#pragma unroll
        for (int ai = 0; ai < 2; ++ai)
#pragma unroll
            for (int m = 0; m < 4; ++m) { const int tok = stok[r0 + ai * HALF + m * 16];
                if (tok >= 0) { bf16_t* orow = y + (size_t)tok * DM + c0;
                    *(u32x4*)(orow) = pack8(acc[ai][0][m][0], acc[ai][0][m][1]); *(u32x4*)(orow + HALF) = pack8(acc[ai][1][m][0], acc[ai][1][m][1]); } }
    }
};
__device__ __forceinline__ void p10_combine(const Ptrs& P, Frame& F) {
    const int gw = F.vcu * NWAVES + F.wave, NGW = F.G * NWAVES;
    const bf16_t* dl = (const bf16_t*)(P.ws + WS_DELTA); const bf16_t* y0 = (const bf16_t*)(P.ws + WS_Y0); const bf16_t* y1 = (const bf16_t*)(P.ws + WS_Y1);
    for (int m = gw; m < M; m += NGW) {
        const float* gate = (const float*)(P.ws + WS_MOD) + (m / SEQ) * 6144 + 5120;
        const f32x4* xr = (const f32x4*)(P.x + (size_t)m * DM) + F.lane; f32x4* orow = (f32x4*)(P.out + (size_t)m * DM) + F.lane;
        const u32x2* dr = (const u32x2*)(dl + (size_t)m * DM) + F.lane; const u32x2* a0 = (const u32x2*)(y0 + (size_t)m * DM) + F.lane; const u32x2* a1 = (const u32x2*)(y1 + (size_t)m * DM) + F.lane;
#pragma unroll
        for (int j = 0; j < 4; ++j) { const f32x4 xv = xr[64 * j]; const u32x2 d = dr[64 * j], p = a0[64 * j], q = a1[64 * j]; const f32x4 g = *(const f32x4*)(gate + 4 * F.lane + 256 * j);
            f32x4 o;
            o[0] = xv[0] + __uint_as_float(d.x << 16) + g[0] * (__uint_as_float(p.x << 16) + __uint_as_float(q.x << 16));
            o[1] = xv[1] + __uint_as_float(d.x & 0xffff0000u) + g[1] * (__uint_as_float(p.x & 0xffff0000u) + __uint_as_float(q.x & 0xffff0000u));
            o[2] = xv[2] + __uint_as_float(d.y << 16) + g[2] * (__uint_as_float(p.y << 16) + __uint_as_float(q.y << 16));
            o[3] = xv[3] + __uint_as_float(d.y & 0xffff0000u) + g[3] * (__uint_as_float(p.y & 0xffff0000u) + __uint_as_float(q.y & 0xffff0000u));
            orow[64 * j] = o; }
    }
}
struct Args { Ptrs P; int ph_lo, ph_hi, li, pad; };
constexpr int N_PHASES = 11;

typedef const __attribute__((address_space(4))) Args* KArgs;
__device__ __forceinline__ KArgs kargs() {
#if defined(__HIP_DEVICE_COMPILE__)
    unsigned off = 0u; asm volatile("" : "+s"(off));
    return (KArgs)((const __attribute__((address_space(4))) char*)__builtin_amdgcn_kernarg_segment_ptr() + off);
#else
    return nullptr;
#endif
}
__device__ __forceinline__ Ptrs load_ptrs() {
    Ptrs P{};
#if defined(__HIP_DEVICE_COMPILE__)
    const __attribute__((address_space(4))) unsigned long long* src = (const __attribute__((address_space(4))) unsigned long long*)kargs();
    unsigned long long w[sizeof(Ptrs) / 8];
#pragma unroll
    for (unsigned i = 0; i < sizeof(Ptrs) / 8; ++i) w[i] = src[i];
    __builtin_memcpy(&P, w, sizeof(Ptrs));
#endif
    return P;
}
#define WSPTRS \
    unsigned char* ws = P.ws; bf16_t* hA = (bf16_t*)(ws + WS_A); bf16_t* uB = (bf16_t*)(ws + WS_B); bf16_t* gbB = uB + (size_t)M * DM; bf16_t* sgB = gbB + (size_t)M * DM; \
    bf16_t* latC = (bf16_t*)(ws + WS_C); bf16_t* Kd = (bf16_t*)(ws + WS_D); bf16_t* Vd = (bf16_t*)(ws + WS_D + 96 * MiB); bf16_t* Qo = (bf16_t*)P.out; \
    float* ssp = (float*)(ws + WS_SSP); const float2* cs = (const float2*)(ws + WS_CS); const float* mod = (const float*)(ws + WS_MOD); \
    const int* stok = (const int*)(ws + WS_STOK); const float* sw = (const float*)(ws + WS_SW); bf16_t* h2 = (bf16_t*)(ws + WS_H2); bf16_t* hact = (bf16_t*)(ws + WS_HACT); \
    (void)hA; (void)uB; (void)gbB; (void)sgB; (void)latC; (void)Kd; (void)Vd; (void)Qo; (void)ssp; (void)cs; (void)mod; (void)stok; (void)sw; (void)h2; (void)hact;

__global__ void __launch_bounds__(NWAVES * 64, 2) fwd(Args args_unused) {
    extern __shared__ __attribute__((aligned(16))) unsigned char lds_raw[];
    Frame F;
    F.lds = (LAS unsigned char*)lds_raw;
    F.MISC = (volatile LAS unsigned*)(F.lds + MISC_OFF);
    F.tid = threadIdx.x; F.lane = F.tid & 63; F.wave = __builtin_amdgcn_readfirstlane(F.tid >> 6);
    F.G = gridDim.x; { const int bx = blockIdx.x; F.vcu = (F.G % 8 == 0) ? (bx % 8) * (F.G / 8) + bx / 8 : bx; }
    F.ctl = (unsigned*)(args_unused.P.ws + WS_CTL);
    for (int u = F.tid; u < (LDS_BYTES - LDSCTL_OFF) / 4; u += NWAVES * 64) ((LAS unsigned*)(F.lds + LDSCTL_OFF))[u] = 0u;
    __syncthreads();
    const int lo = args_unused.ph_lo, hi = args_unused.ph_hi;
    XcdBarrier bar; bar.bar = F.ctl + CW_BAR + args_unused.li * XCD_BAR_WORDS; bar.x = 0; bar.st = nullptr;
    if (hi - lo > 1) bar = xcd_barrier_post(F.ctl + CW_BAR + args_unused.li * XCD_BAR_WORDS, F.MISC + 8);
#ifdef ONLY_PHASE
#define IN(k) ((k) == ONLY_PHASE && lo <= (k) && (k) < hi)
#else
#define IN(k) (lo <= (k) && (k) < hi)
#endif
#ifndef PROBE_REPEAT
#define PROBE_REPEAT -1
#endif
#define REPS(k) for (int rep_ = 0; rep_ < ((k) == PROBE_REPEAT ? 2 : 1); ++rep_)
#define SEAM(k) do { if (IN(k) && IN((k) + 1)) xcd_barrier(bar); } while (0)

    if (IN(0)) { const Ptrs P = args_unused.P; REPS(0) { p0_router_weights(P, F); p0_mod(P, F); } SEAM(0); }
    if (IN(1)) { const Ptrs P = args_unused.P; REPS(1) { p1_norm1(P, F); p0_weights_tables(P, F); } SEAM(1); }
    if (IN(2)) {
        const Ptrs P = args_unused.P; WSPTRS
        DenseSched S; S.init(hA, DM, (const bf16_t*)(ws + WS_WIN), DM, M, 5888, F.G, (int)blockIdx.x, true, true);
        EpiIn E{uB, gbB, sgB, latC, ssp, cs, P.k_g, (LAS float*)(F.lds + XCH_OFF)};
        gemm_phase<false>(F.lds + RING_OFF, DM, S, E);
        if (PROBE_REPEAT == 2) gemm_phase<false>(F.lds + RING_OFF, DM, S, E);
        SEAM(2);
    }
    if (IN(3)) {
        const Ptrs P = args_unused.P; WSPTRS
        { DenseSched S; S.init(latC, LATW, (const bf16_t*)(ws + WS_WQ), QL, M, 1536, F.G, (int)blockIdx.x);
          EpiPlain E{Qo, 1536, 255};
          gemm_phase<false>(F.lds + RING_OFF, QL, S, E);
          if (PROBE_REPEAT == 30) gemm_phase<false>(F.lds + RING_OFF, QL, S, E); }
        { DenseSched S; S.init(latC + 512, LATW, (const bf16_t*)(ws + WS_WKV), KVL, M, 2048, F.G, (int)blockIdx.x);
          EpiKV E{Kd, Vd, latC, ssp, P.k_g, (LAS float*)(F.lds + XCH_OFF)};
          gemm_phase<false>(F.lds + RING_OFF, KVL, S, E);
          if (PROBE_REPEAT == 31) gemm_phase<false>(F.lds + RING_OFF, KVL, S, E);
          if (PROBE_REPEAT == 32) { EpiPlain E2{hA, 1024, 3}; gemm_phase<false>(F.lds + RING_OFF, KVL, S, E2); } }
        SEAM(3);
    }
    if (IN(4)) {
        const Ptrs P = args_unused.P; WSPTRS
        att::AttnArgs T{Qo, Kd, Vd, ssp, cs, P.q_g, uB, gbB, sgB, P.conv_w, hA};
        if (F.G == 256) {
            const int bh = F.vcu >> 1, sel = F.vcu & 1;
#pragma unroll 1
            for (int i = 0; i < 4; ++i) { const int qb = sel ? (i == 0 ? 6 : i == 1 ? 1 : i == 2 ? 5 : 2) : (i == 0 ? 7 : i == 1 ? 0 : i == 2 ? 4 : 3);
                att::ATTN_UNIT<0>(T, bh >> 3, bh & 7, qb, (LAS char*)(F.lds + RING_OFF)); }
            if (PROBE_REPEAT == 4 || PROBE_REPEAT == 41 || PROBE_REPEAT == 42) {
#pragma unroll 1
                for (int i = 0; i < 4; ++i) { const int qb = sel ? (i == 0 ? 6 : i == 1 ? 1 : i == 2 ? 5 : 2) : (i == 0 ? 7 : i == 1 ? 0 : i == 2 ? 4 : 3);
                    att::ATTN_UNIT<(PROBE_REPEAT == 41 ? 1 : PROBE_REPEAT == 42 ? 2 : 0)>(T, bh >> 3, bh & 7, qb, (LAS char*)(F.lds + RING_OFF)); } }
        } else {
#pragma unroll 1
            for (int U = F.vcu; U < BATCH * NH * 8; U += F.G) { const int bh = U >> 3; att::ATTN_UNIT<0>(T, bh >> 3, bh & 7, U & 7, (LAS char*)(F.lds + RING_OFF)); }
        }
        SEAM(4);
    }
    if (IN(5)) {
        const Ptrs P = args_unused.P; WSPTRS
        DenseSched S; S.init(hA, DM, (const bf16_t*)(ws + WS_WO), DM, M, DM, F.G, (int)blockIdx.x);
        EpiDelta E{mod, (bf16_t*)(ws + WS_DELTA)};
        gemm_phase<false>(F.lds + RING_OFF, DM, S, E);
        if (PROBE_REPEAT == 5) gemm_phase<false>(F.lds + RING_OFF, DM, S, E);
        SEAM(5);
    }
    if (IN(6)) { const Ptrs P = args_unused.P; p6_rows<0>(P, F); if (PROBE_REPEAT == 6) p6_rows<0>(P, F); if (PROBE_REPEAT == 61) p6_rows<1>(P, F); SEAM(6); }
    if (IN(7)) { const Ptrs P = args_unused.P; p7_sort(P, F); if (PROBE_REPEAT == 7) p7_sort(P, F); SEAM(7); }
    if (IN(8)) {
        const Ptrs P = args_unused.P; WSPTRS
        const int T = __builtin_amdgcn_readfirstlane((int)F.ctl[CW_T]);
        MoeSched S{h2, (const bf16_t*)(ws + WS_EGU), DM, DM, stok, F.ctl + CW_TGRP, 0, T * 2, 2, F.G, F.vcu, (size_t)512 * DM * 2, true, true};
        EpiGU E{hact, sw};
        gemm_phase<true>(F.lds + RING_OFF, DM, S, E);
        if (PROBE_REPEAT == 8) gemm_phase<true>(F.lds + RING_OFF, DM, S, E);
        SEAM(8);
    }
    if (IN(9)) {
        const Ptrs P = args_unused.P; WSPTRS
        const int T = __builtin_amdgcn_readfirstlane((int)F.ctl[CW_T]);
        MoeSched S{hact, (const bf16_t*)(ws + WS_EDN), DEXP, DEXP, stok, F.ctl + CW_TGRP, 0, T * 4, 4, F.G, F.vcu, (size_t)DM * DEXP * 2, false, false};
        EpiDown E{(bf16_t*)(ws + WS_Y0), (bf16_t*)(ws + WS_Y1), stok};
        gemm_phase<false>(F.lds + RING_OFF, DEXP, S, E);
        if (PROBE_REPEAT == 9) gemm_phase<false>(F.lds + RING_OFF, DEXP, S, E);
        SEAM(9);
    }
    if (IN(10)) { const Ptrs P = args_unused.P; REPS(10) p10_combine(P, F); }
#undef IN
#undef SEAM
}
}
extern "C" void kernel_launch(void* const* d_in, const int* in_sizes, int n_in, void* d_out, int out_size, void* d_ws, size_t ws_size, hipStream_t stream) {
    if (n_in != 23 || out_size != M * DM || ws_size < WS_END) { fprintf(stderr, "kernel_launch: unexpected shapes (n_in %d out %d ws %zu)\n", n_in, out_size, ws_size); return; }
    static int grid = 0;
    if (grid == 0) {
        int dev = 0, cus = 0;
        if (hipGetDevice(&dev) != hipSuccess || hipDeviceGetAttribute(&cus, hipDeviceAttributeMultiprocessorCount, dev) != hipSuccess) { fprintf(stderr, "kernel_launch: device query failed\n"); grid = -1; return; }
        if (hipFuncSetAttribute((const void*)fk::fwd, hipFuncAttributeMaxDynamicSharedMemorySize, fk::LDS_BYTES) != hipSuccess) { fprintf(stderr, "kernel_launch: hipFuncSetAttribute failed\n"); grid = -1; return; }
        grid = cus;
    }
    if (grid < 0) return;
    Ptrs P{};
    P.x = (const float*)d_in[0]; P.c = (const float*)d_in[1]; P.pos = (const int*)d_in[2];
    P.w_ada = (const float*)d_in[3]; P.b_ada = (const float*)d_in[4]; P.norm1_g = (const float*)d_in[5]; P.w_in = (const float*)d_in[6]; P.conv_w = (const float*)d_in[7];
    P.q_a_g = (const float*)d_in[8]; P.w_q_b = (const float*)d_in[9]; P.kv_a_g = (const float*)d_in[10]; P.w_kv_b = (const float*)d_in[11]; P.q_g = (const float*)d_in[12]; P.k_g = (const float*)d_in[13];
    P.w_o = (const float*)d_in[14]; P.norm2_g = (const float*)d_in[15]; P.w_rg = (const float*)d_in[16]; P.b_rg = (const float*)d_in[17]; P.w_re = (const float*)d_in[18]; P.b_re = (const float*)d_in[19];
    P.w_gate = (const float*)d_in[20]; P.w_up = (const float*)d_in[21]; P.w_down = (const float*)d_in[22];
    P.out = (float*)d_out; P.ws = (unsigned char*)d_ws;
    (void)hipMemsetAsync((char*)d_ws + WS_CTL, 0, 1 * MiB, stream);
    fk::Args a{}; a.P = P; a.ph_lo = 0; a.ph_hi = fk::N_PHASES; a.li = 0;
    hipLaunchKernelGGL(fk::fwd, dim3(grid), dim3(fk::NWAVES * 64), fk::LDS_BYTES, stream, a);
}
```

```cpp
#define PROBE_REPEAT -1
#include <hip/hip_runtime.h>
#include <cstdio>
#include <cstdint>
#include <cmath>

constexpr int BATCH = 16, SEQ = 2048, DM = 1024, M = BATCH * SEQ;
constexpr int NH = 8, QKN = 128, QKR = 64, QKH = 192, VH = 128, QL = 384, KVL = 256;
constexpr int DIN = 5824, NEXP = 32, DEXP = 256;
constexpr int C_ZX = 0, C_ZB = 1024, C_ZC = 2048, C_QL = 3072, C_KVL = 3456, C_KR = 3712, C_GC = 3776, C_GM = 4800;
constexpr float EPS = 1e-6f;
constexpr int LATW = 768;

typedef unsigned short bf16_t;
typedef float f32x4 __attribute__((ext_vector_type(4)));

constexpr size_t MiB = 1u << 20;
constexpr size_t WS_CTL = 0;
constexpr size_t WS_MOD = 1 * MiB;
constexpr size_t WS_CS = 2 * MiB;
constexpr size_t WS_SSP = 10 * MiB;
constexpr size_t WS_RT = 12 * MiB;
constexpr size_t WS_WSMALL = 14 * MiB;
constexpr size_t WS_A = 32 * MiB;
constexpr size_t WS_B = 96 * MiB;
constexpr size_t WS_C = 288 * MiB;
constexpr size_t WS_D = 336 * MiB;
constexpr size_t WS_END = 496 * MiB;

__device__ __forceinline__ float bf2f(bf16_t v) { return __uint_as_float(((unsigned)v) << 16); }
__device__ __forceinline__ bf16_t f2bf(float f) { unsigned u = __float_as_uint(f); return (bf16_t)((u + 0x7fffu + ((u >> 16) & 1u)) >> 16); }

struct Ptrs {
    const float *x, *c; const int* pos;
    const float *w_ada, *b_ada, *norm1_g, *w_in, *conv_w, *q_a_g, *w_q_b, *kv_a_g, *w_kv_b, *q_g, *k_g, *w_o, *norm2_g;
    const float *w_rg, *b_rg, *w_re, *b_re, *w_gate, *w_up, *w_down;
    float* out; unsigned char* ws;
};

namespace fk {
#define LAS __attribute__((address_space(3)))
#define GAS __attribute__((address_space(1)))
typedef short bf16x8 __attribute__((ext_vector_type(8)));
typedef short s16x4 __attribute__((ext_vector_type(4)));
typedef unsigned u32x4 __attribute__((ext_vector_type(4)));
typedef unsigned u32x2 __attribute__((ext_vector_type(2)));
typedef float f32x2 __attribute__((ext_vector_type(2)));
typedef float f32x16 __attribute__((ext_vector_type(16)));
typedef GAS unsigned gu32;
#define RLX_AGENT __ATOMIC_RELAXED, __HIP_MEMORY_SCOPE_AGENT
constexpr int NWAVES = 8;
constexpr int BM = 256, BK = 64, HALF = 128, HTB = HALF * BK * 2, STAGE_BYTES = 8 * HTB, NXCD = 8, WGM = 8;
constexpr int RING_OFF = 0, RING_BYTES = 131072, XCH_OFF = 131072, XCH_BYTES = 8192, LDSCTL_OFF = XCH_OFF + XCH_BYTES, MISC_OFF = LDSCTL_OFF + 320, LDS_BYTES = 147456;
constexpr int CW_TMO = 0, CW_BAR = 4096;
constexpr int CW_HIST = 16384;
constexpr int CW_TILES = 40960;

typedef __bf16 bf16x2_t __attribute__((ext_vector_type(2)));
__device__ __forceinline__ unsigned cvt_pk_bf16(float lo, float hi) { f32x2 v = {lo, hi}; bf16x2_t b = __builtin_convertvector(v, bf16x2_t); return __builtin_bit_cast(unsigned, b); }
__device__ __forceinline__ float fsigmoid(float x) { return __builtin_amdgcn_rcpf(1.f + __expf(-x)); }

__host__ __device__ __forceinline__ int lds_byte(int r, int c) { const int st = (r >> 4) * 2 + (c >> 5), rr = r & 15, cc = c & 31, ob = rr * 64 + cc * 2; return st * 1024 + (ob ^ (((ob >> 9) & 1) << 5)); }
__host__ __device__ __forceinline__ void stage_rc(int b, int& R, int& C) { const int st = b / 1024, sb = b % 1024, swz = sb ^ (((sb >> 9) & 1) << 5); R = (st >> 1) * 16 + swz / 64; C = (st & 1) * 32 + (swz % 64) / 2; }
__host__ __device__ __forceinline__ int permL(int L) { return (L & 0xE0) | (((L >> 2) & 1) << 4) | (((L >> 3) & 3) << 2) | (L & 3); }

#define XB_TMO      128
#define XB_XCNT(j)  (256  + 64 * (j))
#define XB_XSUB(j)  (1280 + 64 * (j))
#define XB_XGEN(j)  (2304 + 64 * (j))
#define XB_TOP      3328
#define XB_TOPGEN   3392
#define XCD_BAR_WORDS 3456
#define XB_SPIN_CAP (1u << 18)
__device__ __forceinline__ unsigned xb_ld(unsigned* p)              { return __hip_atomic_load(p, __ATOMIC_RELAXED, __HIP_MEMORY_SCOPE_AGENT); }
__device__ __forceinline__ unsigned xb_add(unsigned* p, unsigned v) { return __hip_atomic_fetch_add(p, v, __ATOMIC_RELAXED, __HIP_MEMORY_SCOPE_AGENT); }
__device__ __forceinline__ unsigned xb_xcc_id() { return (unsigned)__builtin_amdgcn_s_getreg((3 << 11) | 20) & 0xFu; }
#define XB_SPIN(cond, bar) do { unsigned _sp = 0; while (cond) { __builtin_amdgcn_s_sleep(1); \
    if ((++_sp & 255u) == 0u) { if (xb_ld(&(bar)[XB_TMO])) break; if (_sp > XB_SPIN_CAP) { atomicAdd(&(bar)[XB_TMO], 1u); break; } } } } while (0)
struct XcdBarrier { unsigned* bar; unsigned x; volatile LAS unsigned* st; };
__device__ __forceinline__ XcdBarrier xcd_barrier_post(unsigned* bar, volatile LAS unsigned* st) {
    XcdBarrier b; b.bar = bar; b.x = xb_xcc_id(); b.st = st;
    if (threadIdx.x == 0) (void)xb_add(&bar[XB_XCNT(b.x)], 1u);
    return b;
}
__device__ __forceinline__ void xcd_barrier_complete(unsigned* bar, unsigned x, unsigned& nloc, unsigned& nx) {
    const unsigned G = gridDim.x * gridDim.y * gridDim.z;
    unsigned sum, cnt, mine, sp = 0u;
    for (;;) {
        sum = 0u; cnt = 0u; mine = 0u;
#pragma unroll
        for (unsigned j = 0; j < 16; ++j) { const unsigned c = xb_ld(&bar[XB_XCNT(j)]); sum += c; cnt += (c > 0u) ? 1u : 0u; mine = (j == x) ? c : mine; }
        if (sum == G) break;
        __builtin_amdgcn_s_sleep(1);
        if ((++sp & 255u) == 0u) { if (xb_ld(&bar[XB_TMO])) break; if (sp > XB_SPIN_CAP) { atomicAdd(&bar[XB_TMO], 1u); break; } }
    }
    nloc = mine > 0u ? mine : 1u; nx = cnt > 0u ? cnt : 1u;
}
__device__ __forceinline__ void xcd_barrier(const XcdBarrier& b) {
    asm volatile("s_waitcnt vmcnt(0)" ::: "memory");
    __syncthreads();
    if (threadIdx.x == 0) {
        unsigned* bar = b.bar;
        __builtin_amdgcn_s_waitcnt(0);
        unsigned nloc = b.st[0], nx = b.st[1];
        if (nloc == 0u) { xcd_barrier_complete(bar, b.x, nloc, nx); b.st[0] = nloc; b.st[1] = nx; }
        const unsigned old = xb_add(&bar[XB_XSUB(b.x)], 1u);
        const unsigned gen = old / nloc;
        if (old + 1u == (gen + 1u) * nloc) {
            __builtin_amdgcn_fence(__ATOMIC_RELEASE, "agent");
            asm volatile("s_waitcnt vmcnt(0)" ::: "memory");
            const unsigned og = xb_add(&bar[XB_TOP], 1u);
            const unsigned tg = og / nx;
            if (og + 1u == (tg + 1u) * nx) xb_add(&bar[XB_TOPGEN], 1u);
            else XB_SPIN(xb_ld(&bar[XB_TOPGEN]) == tg, bar);
            __builtin_amdgcn_fence(__ATOMIC_ACQUIRE, "agent");
            xb_add(&bar[XB_XGEN(b.x)], 1u);
            asm volatile("s_waitcnt vmcnt(0)" ::: "memory");
        } else {
            XB_SPIN(xb_ld(&bar[XB_XGEN(b.x)]) == gen, bar);
            __builtin_amdgcn_fence(__ATOMIC_ACQUIRE, "agent");
            asm volatile("s_waitcnt vmcnt(0)" ::: "memory");
        }
    }
    __syncthreads();
}

struct Unit { int pm, pn, aux, half; };
struct DenseSched {
    const bf16_t* A; const bf16_t* Bt; int lda, ldb; int nM, nN, nwg, G, c; bool split, pnflip;
    __device__ void init(const bf16_t* A_, int lda_, const bf16_t* Bt_, int ldb_, int M_, int N_, int G_, int c_, bool split_ = false, bool pnflip_ = false) {
        A = A_; Bt = Bt_; lda = lda_; ldb = ldb_; nM = M_ / BM; nN = N_ / BM; nwg = nM * nN; G = G_; c = c_; split = split_; pnflip = pnflip_; }
    __device__ bool next(int i, Unit& u) const {
        const int idx = i * G + c, nfull = (nwg / G) * G, tail = nwg - nfull; int L; u.half = 0;
        if (split && tail > 0 && 2 * tail <= G) { if (idx >= nfull + 2 * tail) return false; if (idx < nfull) L = idx; else { L = nfull + ((idx - nfull) >> 1); u.half = 1 + ((idx - nfull) & 1); } }
        else { if (idx >= nwg) return false; L = idx; }
        int wgid = L; { const int q = nwg / NXCD, r = nwg % NXCD, xcd = wgid % NXCD, off = wgid / NXCD; wgid = (xcd < r ? xcd * (q + 1) : r * (q + 1) + (xcd - r) * q) + off; }
        const int nig = WGM * nN, gid = wgid / nig, fm = gid * WGM, gsz = (nM - fm) < WGM ? (nM - fm) : WGM;
        u.pm = fm + ((wgid % nig) % gsz); u.pn = (wgid % nig) / gsz; if (pnflip) u.pn = nN - 1 - u.pn; u.aux = 0; return true;
    }
    __device__ __forceinline__ const char* abase(const Unit& u) const { return (const char*)A + (size_t)(u.pm * BM + (u.half == 2 ? HALF : 0)) * lda * 2; }
    __device__ __forceinline__ const char* bbase(const Unit& u) const { return (const char*)Bt + (size_t)u.pn * BM * ldb * 2; }
    __device__ __forceinline__ void avoff(const Unit& u, int R0, int C0, int R1, int C1, unsigned (&v0)[2], unsigned (&v1)[2]) const {
        v0[0] = (unsigned)(R0 * lda + C0) * 2u; v0[1] = (unsigned)(R1 * lda + C1) * 2u;
        const unsigned h1 = u.half ? 0u : (unsigned)(HALF * lda * 2);
        v1[0] = v0[0] + h1; v1[1] = v0[1] + h1; }
};

template <bool GATHER, class Epi, class Sched>
__device__ __forceinline__ void gemm_phase(LAS unsigned char* lds, const int K, const Sched& S, const Epi& E) {
    const int tid = threadIdx.x, wid = __builtin_amdgcn_readfirstlane(tid >> 6), lane = tid & 63, wr = wid >> 2, wc = wid & 3, fr = lane & 15, fq = lane >> 4;
    const int nt = K / BK;
    int R0, C0, R1, C1; stage_rc(tid * 16, R0, C0); stage_rc(tid * 16 + 8192, R1, C1);
    unsigned voffB[2]; voffB[0] = (unsigned)(R0 * S.ldb + C0) * 2u; voffB[1] = (unsigned)(R1 * S.ldb + C1) * 2u;
    const size_t kstep = (size_t)(BK * 2);
    const size_t hstepB = (size_t)HALF * S.ldb * 2;
    const unsigned ldsw = (unsigned)wid * 1024u;
    const int aoff = lds_byte(wr * 64 + fr, fq * 8), boff = lds_byte(wc * 32 + fr, fq * 8);
#define PG8_SA(b, h) (((b) * 2 + (h)) * HTB)
#define PG8_SB(b, h) ((4 + (b) * 2 + (h)) * HTB)
#define PG8_STAGE(bufoff, gbase, voff) do { _Pragma("unroll") for (int _i = 0; _i < 2; ++_i) \
        __builtin_amdgcn_global_load_lds((const unsigned*)((const char*)(gbase) + (voff)[_i]), (LAS unsigned*)(lds + (bufoff) + ldsw + _i * 8192), 16, 0, 0); } while (0)
#define PG8_LDA(dst, b, h) do { _Pragma("unroll") for (int m = 0; m < 4; ++m) _Pragma("unroll") for (int k = 0; k < 2; ++k) dst[m][k] = *(const LAS bf16x8*)(lds + PG8_SA(b, h) + aoff + m * 2048 + k * 1024); } while (0)
#define PG8_LDB(dst, b, h) do { _Pragma("unroll") for (int n = 0; n < 2; ++n) _Pragma("unroll") for (int k = 0; k < 2; ++k) dst[n][k] = *(const LAS bf16x8*)(lds + PG8_SB(b, h) + boff + n * 2048 + k * 1024); } while (0)
#define PG8_MMA(ai, bj, At, Bt) do { __builtin_amdgcn_s_setprio(1); _Pragma("unroll") for (int m = 0; m < 4; ++m) _Pragma("unroll") for (int n = 0; n < 2; ++n) _Pragma("unroll") for (int k = 0; k < 2; ++k) \
        acc[ai][bj][m][n] = __builtin_amdgcn_mfma_f32_16x16x32_bf16(Bt[n][k], At[m][k], acc[ai][bj][m][n], 0, 0, 0); __builtin_amdgcn_s_setprio(0); } while (0)
#define PG8_WAIT_V(n) asm volatile("s_waitcnt vmcnt(" #n ")" ::: "memory")
#define PG8_WAIT_L(n) asm volatile("s_waitcnt lgkmcnt(" #n ")" ::: "memory")
#define PG8_BAR __builtin_amdgcn_s_barrier()
#define PG8_SCHED __builtin_amdgcn_sched_barrier(0)
    Unit cur, nxt; int ui = 0;
    if (!S.next(0, cur)) return;
    f32x4 acc[2][2][4][2];
#pragma unroll
    for (int a = 0; a < 2; ++a)
#pragma unroll
        for (int b = 0; b < 2; ++b)
#pragma unroll
            for (int m = 0; m < 4; ++m)
#pragma unroll
                for (int n = 0; n < 2; ++n) acc[a][b][m][n] = (f32x4){0.f, 0.f, 0.f, 0.f};
    bf16x8 At[4][2], B0[2][2], B1[2][2];
    unsigned va0[2], va1[2], na0[2], na1[2];
    S.avoff(cur, R0, C0, R1, C1, va0, va1);
    na0[0] = va0[0]; na0[1] = va0[1]; na1[0] = va1[0]; na1[1] = va1[1];
    const char* cA = S.abase(cur); const char* cB = S.bbase(cur);
    PG8_STAGE(PG8_SB(0, 0), cB, voffB); PG8_STAGE(PG8_SB(0, 1), cB + hstepB, voffB); PG8_STAGE(PG8_SA(0, 0), cA, va0); PG8_STAGE(PG8_SA(0, 1), cA, va1);
    if (wr == 1) PG8_BAR;
    PG8_WAIT_V(2); PG8_BAR;
    PG8_STAGE(PG8_SB(1, 0), cB + kstep, voffB); PG8_STAGE(PG8_SA(1, 0), cA + kstep, va0); PG8_STAGE(PG8_SB(1, 1), cB + hstepB + kstep, voffB);
    PG8_WAIT_V(6); PG8_BAR;
    for (;;) {
        const bool has_next = S.next(ui + 1, nxt);
        const char* nA = has_next ? S.abase(nxt) : cA; const char* nB = has_next ? S.bbase(nxt) : cB;
        if (has_next) S.avoff(nxt, R0, C0, R1, C1, na0, na1);
        const bool hu = cur.half != 0;
#pragma unroll 1
        for (int t = 0; t < nt; t += 2) {
            const bool last = (t == nt - 2);
            const char* a1 = cA + (size_t)(t + 1) * kstep;
            const char* a2 = last ? nA : cA + (size_t)(t + 2) * kstep; const char* b2 = last ? nB : cB + (size_t)(t + 2) * kstep;
            const char* a3 = a2 + kstep; const char* b3 = b2 + kstep;
            unsigned x0[2], x1[2];
            x0[0] = last ? na0[0] : va0[0]; x0[1] = last ? na0[1] : va0[1]; x1[0] = last ? na1[0] : va1[0]; x1[1] = last ? na1[1] : va1[1];
            PG8_LDB(B0, 0, 0); PG8_LDB(B1, 0, 1); PG8_SCHED; PG8_LDA(At, 0, 0); PG8_STAGE(PG8_SA(1, 1), a1, va1);
            PG8_WAIT_V(8); PG8_WAIT_L(0); PG8_BAR; PG8_MMA(0, 0, At, B0); PG8_MMA(0, 1, At, B1); PG8_BAR; PG8_SCHED;
            if (!hu) PG8_LDA(At, 0, 1);
            PG8_STAGE(PG8_SB(0, 0), b2, voffB); PG8_STAGE(PG8_SB(0, 1), b2 + hstepB, voffB); PG8_STAGE(PG8_SA(0, 0), a2, x0);
            PG8_WAIT_V(8); PG8_WAIT_L(0); PG8_BAR; if (!hu) { PG8_MMA(1, 0, At, B0); PG8_MMA(1, 1, At, B1); } PG8_BAR; PG8_SCHED;
            PG8_LDB(B0, 1, 0); PG8_LDB(B1, 1, 1); PG8_SCHED; PG8_LDA(At, 1, 0); PG8_STAGE(PG8_SA(0, 1), a2, x1);
            PG8_WAIT_V(8); PG8_WAIT_L(0); PG8_BAR; PG8_MMA(0, 0, At, B0); PG8_MMA(0, 1, At, B1); PG8_BAR; PG8_SCHED;
            if (!hu) PG8_LDA(At, 1, 1);
            PG8_STAGE(PG8_SB(1, 0), b3, voffB); PG8_STAGE(PG8_SB(1, 1), b3 + hstepB, voffB); PG8_STAGE(PG8_SA(1, 0), a3, x0);
            PG8_WAIT_V(8); PG8_WAIT_L(0); PG8_BAR; if (!hu) { PG8_MMA(1, 0, At, B0); PG8_MMA(1, 1, At, B1); } PG8_BAR; PG8_SCHED;
        }
        if (wr == 0) PG8_BAR;
        E(acc, cur, wr, wc, fr, fq);
        if (!has_next) break;
#pragma unroll
        for (int a = 0; a < 2; ++a)
#pragma unroll
            for (int b = 0; b < 2; ++b)
#pragma unroll
                for (int m = 0; m < 4; ++m)
#pragma unroll
                    for (int n = 0; n < 2; ++n) acc[a][b][m][n] = (f32x4){0.f, 0.f, 0.f, 0.f};
        cur = nxt; cA = nA; cB = nB; ++ui;
        va0[0] = na0[0]; va0[1] = na0[1]; va1[0] = na1[0]; va1[1] = na1[1];
        if (wr == 1) PG8_BAR;
    }
    PG8_WAIT_V(0);
    PG8_BAR;
#undef PG8_SA
#undef PG8_SB
#undef PG8_STAGE
#undef PG8_LDA
#undef PG8_LDB
#undef PG8_MMA
#undef PG8_WAIT_V
#undef PG8_WAIT_L
#undef PG8_BAR
#undef PG8_SCHED
}

__device__ __forceinline__ u32x4 pack8(const f32x4 a, const f32x4 b) { u32x4 w; w.x = cvt_pk_bf16(a[0], a[1]); w.y = cvt_pk_bf16(a[2], a[3]); w.z = cvt_pk_bf16(b[0], b[1]); w.w = cvt_pk_bf16(b[2], b[3]); return w; }

struct EpiIn {
    bf16_t *u, *gb, *sg, *lat; float* rowstat; const float2* cs; const float* k_g; LAS float* xch;
    __device__ __forceinline__ void operator()(const f32x4 (&acc)[2][2][4][2], const Unit& un, int wr, int wc, int fr, int fq) const {
        asm volatile("" : "+v"(fr), "+v"(fq));
        const int row0 = un.pm * BM + wr * 64 + fr, pn = un.pn;
        if (pn < 16) {
            const int c0 = 128 * (pn & 7) + 32 * wc + 8 * fq; bf16_t* dst = pn < 8 ? u : gb; const int rh = row0 + (un.half == 2 ? HALF : 0);
#pragma unroll
            for (int ai = 0; ai < 2; ++ai)
#pragma unroll
                for (int m = 0; m < 4; ++m) { f32x4 r0, r1; if (ai == 1 && un.half) continue;
                    if (pn < 8) { r0 = acc[ai][0][m][0] * acc[ai][1][m][0]; r1 = acc[ai][0][m][1] * acc[ai][1][m][1]; }
                    else { const f32x4 g0 = acc[ai][1][m][0], g1 = acc[ai][1][m][1];
#pragma unroll
                        for (int i = 0; i < 4; ++i) { r0[i] = acc[ai][0][m][0][i] * fsigmoid(g0[i]); r1[i] = acc[ai][0][m][1][i] * fsigmoid(g1[i]); } }
                    *(u32x4*)(dst + (size_t)(rh + ai * HALF + m * 16) * DM + c0) = pack8(r0, r1); }
        } else if (pn < 20) {
            const int c0 = 256 * (pn - 16) + 32 * wc + 8 * fq;
#pragma unroll
            for (int ai = 0; ai < 2; ++ai)
#pragma unroll
                for (int m = 0; m < 4; ++m)
#pragma unroll
                    for (int bj = 0; bj < 2; ++bj) { f32x4 a = acc[ai][bj][m][0], b = acc[ai][bj][m][1];
#pragma unroll
                        for (int i = 0; i < 4; ++i) { a[i] = fsigmoid(a[i]); b[i] = fsigmoid(b[i]); }
                        *(u32x4*)(sg + (size_t)(row0 + ai * HALF + m * 16) * DM + c0 + bj * HALF) = pack8(a, b); }
        } else {
            const int c0 = 256 * (pn - 20) + 32 * wc + 8 * fq, rowt = wr * 64 + fr;
#pragma unroll
            for (int ai = 0; ai < 2; ++ai)
#pragma unroll
                for (int m = 0; m < 4; ++m) { const int rt = rowt + ai * HALF + m * 16, row = un.pm * BM + rt; float s0, s1;
                    { const f32x4 a = acc[ai][0][m][0], b = acc[ai][0][m][1]; *(u32x4*)(lat + (size_t)row * LATW + c0) = pack8(a, b);
                      s0 = (a[0] * a[0] + a[1] * a[1]) + (a[2] * a[2] + a[3] * a[3]) + (b[0] * b[0] + b[1] * b[1]) + (b[2] * b[2] + b[3] * b[3]); }
                    { const f32x4 a = acc[ai][1][m][0], b = acc[ai][1][m][1];
                      s1 = (a[0] * a[0] + a[1] * a[1]) + (a[2] * a[2] + a[3] * a[3]) + (b[0] * b[0] + b[1] * b[1]) + (b[2] * b[2] + b[3] * b[3]);
                      if (pn != 21) *(u32x4*)(lat + (size_t)row * LATW + c0 + HALF) = pack8(a, b);
                      else if (wc < 2) { const int j = 16 * wc + 4 * fq;
                          const f32x4 g1 = *(const f32x4*)(k_g + 128 + j), g2 = *(const f32x4*)(k_g + 160 + j);
                          const f32x4 cA = *(const f32x4*)((const float*)cs + ((size_t)row * 32 + j) * 2), cB = *(const f32x4*)((const float*)cs + ((size_t)row * 32 + j + 2) * 2);
                          const f32x4 x1 = a * g1, x2 = b * g2; f32x4 y1, y2;
                          y1[0] = x1[0] * cA[0] - x2[0] * cA[1]; y2[0] = x2[0] * cA[0] + x1[0] * cA[1]; y1[1] = x1[1] * cA[2] - x2[1] * cA[3]; y2[1] = x2[1] * cA[2] + x1[1] * cA[3];
                          y1[2] = x1[2] * cB[0] - x2[2] * cB[1]; y2[2] = x2[2] * cB[0] + x1[2] * cB[1]; y1[3] = x1[3] * cB[2] - x2[3] * cB[3]; y2[3] = x2[3] * cB[2] + x1[3] * cB[3];
                          u32x2 w1, w2; w1.x = cvt_pk_bf16(y1[0], y1[1]); w1.y = cvt_pk_bf16(y1[2], y1[3]); w2.x = cvt_pk_bf16(y2[0], y2[1]); w2.y = cvt_pk_bf16(y2[2], y2[3]);
                          *(u32x2*)(lat + (size_t)row * LATW + 384 + j) = w1; *(u32x2*)(lat + (size_t)row * LATW + 416 + j) = w2; } }
                    s0 += __shfl_xor(s0, 16); s0 += __shfl_xor(s0, 32); s1 += __shfl_xor(s1, 16); s1 += __shfl_xor(s1, 32);
                    if (fq == 0) { xch[rt * 8 + wc] = s0; xch[rt * 8 + 4 + wc] = s1; } }
            asm volatile("s_waitcnt lgkmcnt(0)" ::: "memory"); __builtin_amdgcn_s_barrier(); asm volatile("" ::: "memory");
            if (threadIdx.x < 256) { const int rt = threadIdx.x; const f32x4 p0 = *(const LAS f32x4*)(xch + rt * 8), p1 = *(const LAS f32x4*)(xch + rt * 8 + 4);
                const float S0 = (p0[0] + p0[1]) + (p0[2] + p0[3]), S1 = (p1[0] + p1[1]) + (p1[2] + p1[3]); float* st = rowstat + (size_t)(un.pm * BM + rt) * 4;
                if (pn == 20) st[0] = S0 + S1; else if (pn == 21) { st[1] = S0; st[2] = S1; } else st[3] = S0 + S1; }
        }
    }
};
struct EpiPlain {
    bf16_t* O; int ldc; int pnmask;
    __device__ __forceinline__ void operator()(const f32x4 (&acc)[2][2][4][2], const Unit& un, int wr, int wc, int fr, int fq) const {
        asm volatile("" : "+v"(fr), "+v"(fq));
        const int row0 = un.pm * BM + wr * 64 + fr, c0 = 256 * (un.pn & pnmask) + 32 * wc + 8 * fq;
#pragma unroll
        for (int ai = 0; ai < 2; ++ai)
#pragma unroll
            for (int m = 0; m < 4; ++m)
#pragma unroll
                for (int bj = 0; bj < 2; ++bj) *(u32x4*)(O + (size_t)(row0 + ai * HALF + m * 16) * ldc + c0 + bj * HALF) = pack8(acc[ai][bj][m][0], acc[ai][bj][m][1]);
    }
};
struct EpiKV {
    bf16_t *Kb, *Vb; const bf16_t* lat; const float* rowstat; const float* k_g; LAS float* xch;
    __device__ __forceinline__ void operator()(const f32x4 (&acc)[2][2][4][2], const Unit& un, int wr, int wc, int fr, int fq) const {
        asm volatile("" : "+v"(fr), "+v"(fq));
        const int h = un.pn, rowt = wr * 64 + fr, b = (un.pm * BM) / SEQ, s0 = (un.pm * BM) % SEQ;
        f32x2 st[2][4];
        u32x4 rp[2][2];
#pragma unroll
        for (int ai = 0; ai < 2; ++ai) {
#pragma unroll
            for (int m = 0; m < 4; ++m) st[ai][m] = *(const f32x2*)(rowstat + (size_t)(un.pm * BM + rowt + ai * HALF + m * 16) * 4 + 2);
            const bf16_t* lr = lat + (size_t)(un.pm * BM + rowt + ai * HALF + wc * 16) * LATW + 384 + 16 * fq;
            rp[ai][0] = *(const u32x4*)lr; rp[ai][1] = *(const u32x4*)(lr + 8); }
#pragma unroll
        for (int ai = 0; ai < 2; ++ai)
#pragma unroll
            for (int m = 0; m < 4; ++m) {
                const f32x4 a = acc[ai][0][m][0], c = acc[ai][0][m][1];
                float ss = (a[0] * a[0] + a[1] * a[1]) + (a[2] * a[2] + a[3] * a[3]) + (c[0] * c[0] + c[1] * c[1]) + (c[2] * c[2] + c[3] * c[3]);
                ss += __shfl_xor(ss, 16); ss += __shfl_xor(ss, 32);
                if (fq == 0) xch[(rowt + ai * HALF + m * 16) * 4 + wc] = ss; }
        asm volatile("s_waitcnt lgkmcnt(0)" ::: "memory"); __builtin_amdgcn_s_barrier(); asm volatile("" ::: "memory");
        const int c8 = 32 * wc + 8 * fq;
        const f32x4 g0 = *(const f32x4*)(k_g + c8), g1 = *(const f32x4*)(k_g + c8 + 4);
#pragma unroll
        for (int ai = 0; ai < 2; ++ai)
#pragma unroll
            for (int m = 0; m < 4; ++m) { const int rt = rowt + ai * HALF + m * 16;
                const float rkv = __builtin_amdgcn_rsqf(st[ai][m][1] * (1.f / KVL) + EPS);
                const f32x4 t4 = *(const LAS f32x4*)(xch + rt * 4);
                const float rk = __builtin_amdgcn_rsqf((((t4[0] + t4[1]) + (t4[2] + t4[3])) * rkv * rkv + st[ai][m][0]) * (1.f / QKH) + EPS);
                const float sk = rkv * rk, sv = rkv;
                const size_t bhs = (size_t)(b * NH + h) * SEQ + s0 + rt;
                bf16_t* Kp = Kb + bhs * QKH; bf16_t* Vp = Vb + bhs * VH;
                *(u32x4*)(Kp + c8) = pack8(acc[ai][0][m][0] * sk * g0, acc[ai][0][m][1] * sk * g1);
                *(u32x4*)(Vp + c8) = pack8(acc[ai][1][m][0] * sv, acc[ai][1][m][1] * sv);
                if (m == wc) {
                    u32x4 o0, o1;
#pragma unroll
                    for (int e = 0; e < 4; ++e) { o0[e] = cvt_pk_bf16(__uint_as_float(rp[ai][0][e] << 16) * rk, __uint_as_float(rp[ai][0][e] & 0xffff0000u) * rk);
                                                  o1[e] = cvt_pk_bf16(__uint_as_float(rp[ai][1][e] << 16) * rk, __uint_as_float(rp[ai][1][e] & 0xffff0000u) * rk); }
                    *(u32x4*)(Kp + 128 + 16 * fq) = o0; *(u32x4*)(Kp + 128 + 16 * fq + 8) = o1; } }
    }
};
struct EpiNull {
    __device__ __forceinline__ void operator()(const f32x4 (&acc)[2][2][4][2], const Unit& un, int wr, int wc, int fr, int fq) const {
#pragma unroll
        for (int ai = 0; ai < 2; ++ai)
#pragma unroll
            for (int bj = 0; bj < 2; ++bj)
#pragma unroll
                for (int m = 0; m < 4; ++m) { f32x4 a = acc[ai][bj][m][0], b = acc[ai][bj][m][1]; asm volatile("" :: "v"(a), "v"(b)); }
    }
};
struct EpiDelta {
    const float* mod; bf16_t* delta;
    __device__ __forceinline__ void operator()(const f32x4 (&acc)[2][2][4][2], const Unit& un, int wr, int wc, int fr, int fq) const {
        asm volatile("" : "+v"(fr), "+v"(fq));
        const int row0 = un.pm * BM + wr * 64 + fr, b = (un.pm * BM) / SEQ, c0 = 256 * un.pn + 32 * wc + 8 * fq;
        const float* gate = mod + b * 6144 + 2048;
#pragma unroll
        for (int bj = 0; bj < 2; ++bj) { const f32x4 g0 = *(const f32x4*)(gate + c0 + bj * HALF), g1 = *(const f32x4*)(gate + c0 + bj * HALF + 4);
#pragma unroll
            for (int ai = 0; ai < 2; ++ai)
#pragma unroll
                for (int m = 0; m < 4; ++m) *(u32x4*)(delta + (size_t)(row0 + ai * HALF + m * 16) * DM + c0 + bj * HALF) = pack8(acc[ai][bj][m][0] * g0, acc[ai][bj][m][1] * g1); }
    }
};
namespace att {
constexpr int NW = 8, QBLK = 32, KVBLK = 64, KPITCH = 400;
constexpr int SHM_V = KVBLK * VH * 2, SHM_K = KVBLK * KPITCH;
constexpr int QRP = 144;
constexpr int OFF_V = 0, OFF_K = 2 * SHM_V, OFF_WS = OFF_K + 2 * SHM_K, OFF_QR = OFF_WS + NW * 64 * 4, ATT_LDS = OFF_QR + NW * 32 * QRP;
constexpr float SCALE = 0.07216878364870322f;
constexpr float THR = 8.f;
#define SBAR() __builtin_amdgcn_sched_barrier(0)
__device__ __forceinline__ int crow(int r, int hi) { return (r & 3) + 8 * (r >> 2) + 4 * hi; }
__device__ __forceinline__ void partialSM(f32x16& p0, f32x16& p1, float& m_reg, float& alpha) {
    constexpr float C = SCALE * 1.4426950408889634f;
    float pmax = p0[0];
#pragma unroll
    for (int r = 1; r < 16; ++r) pmax = fmaxf(pmax, p0[r]);
#pragma unroll
    for (int r = 0; r < 16; ++r) pmax = fmaxf(pmax, p1[r]);
    { auto rr = __builtin_amdgcn_permlane32_swap(__float_as_uint(pmax), __float_as_uint(pmax), false, false);
      pmax = fmaxf(__uint_as_float(rr[0]), __uint_as_float(rr[1])); }
    float mn;
    if (__builtin_expect(__all(pmax - m_reg <= THR / SCALE), 1)) { mn = m_reg; alpha = 1.f; }
    else { mn = fmaxf(m_reg, pmax); alpha = __builtin_amdgcn_exp2f((m_reg - mn) * C); m_reg = mn; }
    const float mnC = -mn * C;
#pragma unroll
    for (int r = 0; r < 16; ++r) p0[r] = fmaf(p0[r], C, mnC);
#pragma unroll
    for (int r = 0; r < 16; ++r) p1[r] = fmaf(p1[r], C, mnC);
#pragma unroll
    for (int r = 0; r < 16; ++r) p0[r] = __builtin_amdgcn_exp2f(p0[r]);
}
__device__ __forceinline__ void finishSM(f32x16& p0, f32x16& p1, float alpha, float& l_reg, bf16x8& pa0, bf16x8& pa1, bf16x8& pa2, bf16x8& pa3) {
#pragma unroll
    for (int r = 0; r < 16; ++r) p1[r] = __builtin_amdgcn_exp2f(p1[r]);
    float ps = 0;
#pragma unroll
    for (int r = 0; r < 16; ++r) ps += p0[r];
#pragma unroll
    for (int r = 0; r < 16; ++r) ps += p1[r];
    { auto rr = __builtin_amdgcn_permlane32_swap(__float_as_uint(ps), __float_as_uint(ps), false, false);
      ps = __uint_as_float(rr[0]) + __uint_as_float(rr[1]); }
    l_reg = l_reg * alpha + ps;
#define PK4(P, BASE, OUT) do { unsigned a0 = cvt_pk_bf16(P[BASE + 0], P[BASE + 1]), a1 = cvt_pk_bf16(P[BASE + 2], P[BASE + 3]);   \
    unsigned b0 = cvt_pk_bf16(P[BASE + 4], P[BASE + 5]), b1 = cvt_pk_bf16(P[BASE + 6], P[BASE + 7]);                              \
    auto r0 = __builtin_amdgcn_permlane32_swap(a0, b0, false, false); auto r1 = __builtin_amdgcn_permlane32_swap(a1, b1, false, false); \
    u32x4 w = {r0[0], r1[0], r0[1], r1[1]}; OUT = *reinterpret_cast<bf16x8*>(&w); } while (0)
    PK4(p0, 0, pa0); PK4(p0, 8, pa1); PK4(p1, 0, pa2); PK4(p1, 8, pa3);
#undef PK4
}
__device__ __forceinline__ void qkt(f32x16& p0, f32x16& p1, const LAS char* Ks, const bf16x8 (&qr)[8], const LAS char* qrope, int r32, int hi) {
    p0 = f32x16{}; p1 = f32x16{};
    const LAS char* k0 = Ks + r32 * KPITCH + hi * 16;
#pragma unroll
    for (int d0 = 0; d0 < 8; ++d0) {
        const bf16x8 b0 = *(const LAS bf16x8*)(k0 + d0 * 32);
        const bf16x8 b1 = *(const LAS bf16x8*)(k0 + 32 * KPITCH + d0 * 32);
        p0 = __builtin_amdgcn_mfma_f32_32x32x16_bf16(b0, qr[d0], p0, 0, 0, 0);
        p1 = __builtin_amdgcn_mfma_f32_32x32x16_bf16(b1, qr[d0], p1, 0, 0, 0); }
#pragma unroll
    for (int d0 = 8; d0 < 12; ++d0) {
        const bf16x8 b0 = *(const LAS bf16x8*)(k0 + d0 * 32);
        const bf16x8 b1 = *(const LAS bf16x8*)(k0 + 32 * KPITCH + d0 * 32);
        const bf16x8 qf = *(const LAS bf16x8*)(qrope + (d0 - 8) * 32);
        p0 = __builtin_amdgcn_mfma_f32_32x32x16_bf16(b0, qf, p0, 0, 0, 0);
        p1 = __builtin_amdgcn_mfma_f32_32x32x16_bf16(b1, qf, p1, 0, 0, 0); }
}
__device__ __forceinline__ int v_st(int k, int c) { const int kk = (k & ~0xC) | ((k & 4) << 1) | ((k & 8) >> 1); return ((kk >> 3) * 4 + (c >> 5)) * 512 + ((kk & 7) * 32 + (c & 31)) * 2; }
__device__ __forceinline__ int v_rd_base(int lane) { return ((lane & 3) << 3) | (((lane >> 2) & 3) << 6) | (((lane >> 4) & 1) << 5) | (((lane >> 5) & 1) << 8); }
constexpr int v_rd_off(int d0, int ks, int half) { return d0 * 512 + ks * 4096 + half * 2048; }
template <int OFF> __device__ __forceinline__ s16x4 tr_read(int vb) {
    s16x4 r; asm volatile("ds_read_b64_tr_b16 %0, %1 offset:%2" : "=&v"(r) : "v"(vb), "i"(OFF) : "memory"); return r;
}
template <int D0> __device__ __forceinline__ void pv_one(f32x16& od, int vb, bf16x8 pa0, bf16x8 pa1, bf16x8 pa2, bf16x8 pa3) {
    const s16x4 l0 = tr_read<v_rd_off(D0, 0, 0)>(vb), h0 = tr_read<v_rd_off(D0, 0, 1)>(vb), l1 = tr_read<v_rd_off(D0, 1, 0)>(vb), h1 = tr_read<v_rd_off(D0, 1, 1)>(vb);
    const s16x4 l2 = tr_read<v_rd_off(D0, 2, 0)>(vb), h2 = tr_read<v_rd_off(D0, 2, 1)>(vb), l3 = tr_read<v_rd_off(D0, 3, 0)>(vb), h3 = tr_read<v_rd_off(D0, 3, 1)>(vb);
    asm volatile("s_waitcnt lgkmcnt(0)" ::: "memory"); SBAR();
#define PK(L, H) (bf16x8){L[0], L[1], L[2], L[3], H[0], H[1], H[2], H[3]}
    od = __builtin_amdgcn_mfma_f32_32x32x16_bf16(pa0, PK(l0, h0), od, 0, 0, 0);
    od = __builtin_amdgcn_mfma_f32_32x32x16_bf16(pa1, PK(l1, h1), od, 0, 0, 0);
    od = __builtin_amdgcn_mfma_f32_32x32x16_bf16(pa2, PK(l2, h2), od, 0, 0, 0);
    od = __builtin_amdgcn_mfma_f32_32x32x16_bf16(pa3, PK(l3, h3), od, 0, 0, 0);
#undef PK
}
__device__ __forceinline__ void pv_d0(f32x16 (&o)[4], int vb, bf16x8 pa0, bf16x8 pa1, bf16x8 pa2, bf16x8 pa3) {
    pv_one<0>(o[0], vb, pa0, pa1, pa2, pa3); pv_one<1>(o[1], vb, pa0, pa1, pa2, pa3); pv_one<2>(o[2], vb, pa0, pa1, pa2, pa3); pv_one<3>(o[3], vb, pa0, pa1, pa2, pa3);
}
__device__ __forceinline__ float bflo(unsigned w) { return __uint_as_float(w << 16); }
__device__ __forceinline__ float bfhi(unsigned w) { return __uint_as_float(w & 0xffff0000u); }

struct AttnArgs { const bf16_t* Q; const bf16_t* Kb; const bf16_t* Vb; const float* ssp; const float2* cs; const float* q_g; const bf16_t *u, *gb, *sg; const float* conv_w; bf16_t* merged; };

template <int MODE> __device__ __forceinline__ void attn_unit(const AttnArgs& T, int b, int h, int qb, LAS char* lds) {
    int tid = threadIdx.x; asm volatile("" : "+v"(tid));
    const int lane = tid & 63, r32 = lane & 31, hi = lane >> 5; const int wid = __builtin_amdgcn_readfirstlane(tid >> 6);
    LAS char* V_lds = lds + OFF_V; LAS char* K_lds = lds + OFF_K;
    LAS float* ws = (LAS float*)(lds + OFF_WS) + wid * 64; LAS float* li_l = ws; LAS float* al_l = ws + 32;
    const int mrow = b * SEQ + qb * 256 + wid * QBLK + r32;
    const bf16_t* Kh = T.Kb + (size_t)(b * NH + h) * SEQ * QKH; const bf16_t* Vh = T.Vb + (size_t)(b * NH + h) * SEQ * VH;
    const int sr = tid >> 4, sc = (tid & 15) * 8, vst0 = v_st(sr, sc), vst1 = v_st(32 + sr, sc);
    const int kdst = (tid >> 3) * KPITCH + (tid & 7) * 48;
    const int vb0 = (int)(uintptr_t)V_lds + v_rd_base(lane);
    bf16x8 sk0, sk1, sk2, sv0, sv1;
#define SLOAD(t) do { const bf16_t* kp = Kh + (size_t)(t) * KVBLK * QKH + tid * 24; sk0 = *(const bf16x8*)kp; sk1 = *(const bf16x8*)(kp + 8); sk2 = *(const bf16x8*)(kp + 16); \
    const bf16_t* vp = Vh + (size_t)((t) * KVBLK + sr) * VH + sc; sv0 = *(const bf16x8*)vp; sv1 = *(const bf16x8*)(vp + 32 * VH); } while (0)
#define SWRITE(bf) do { *(LAS bf16x8*)(V_lds + (bf) * SHM_V + vst0) = sv0; *(LAS bf16x8*)(V_lds + (bf) * SHM_V + vst1) = sv1; \
    *(LAS bf16x8*)(K_lds + (bf) * SHM_K + kdst) = sk0; *(LAS bf16x8*)(K_lds + (bf) * SHM_K + kdst + 16) = sk1; *(LAS bf16x8*)(K_lds + (bf) * SHM_K + kdst + 32) = sk2; } while (0)
#define RESC(a) do { if (__any((a) < 1.f)) { if (hi == 0) al_l[r32] = (a); asm volatile("s_waitcnt lgkmcnt(0)" ::: "memory"); \
    _Pragma("unroll") for (int d = 0; d < 4; ++d) _Pragma("unroll") for (int r = 0; r < 16; ++r) o[d][r] *= al_l[crow(r, hi)]; } } while (0)
    SLOAD(0);
    bf16x8 qr[8];
    LAS char* qrope = lds + OFF_QR + wid * (32 * QRP) + r32 * QRP + hi * 16;
    {
        const bf16_t* Qw = T.Q + (size_t)mrow * 1536 + h * QKH + hi * 8;
        u32x4 raw[12];
#pragma unroll
        for (int d0 = 0; d0 < 12; ++d0) raw[d0] = *(const u32x4*)(Qw + d0 * 16);
        const f32x2 sq2 = *(const f32x2*)(T.ssp + (size_t)mrow * 4); const float ssq = sq2[0] + sq2[1];
        float ss = 0.f;
#pragma unroll
        for (int d0 = 0; d0 < 12; ++d0)
#pragma unroll
            for (int e = 0; e < 4; ++e) { const float a = bflo(raw[d0][e]), c = bfhi(raw[d0][e]); ss += a * a + c * c; }
        { auto rr = __builtin_amdgcn_permlane32_swap(__float_as_uint(ss), __float_as_uint(ss), false, false); ss = __uint_as_float(rr[0]) + __uint_as_float(rr[1]); }
        const float rq2 = 1.f / (ssq * (1.f / QL) + EPS);
        const float rn = 1.f / sqrtf(ss * rq2 * (1.f / QKH) + EPS) * sqrtf(rq2);
#pragma unroll
        for (int d0 = 0; d0 < 8; ++d0) { const f32x4 g0 = *(const f32x4*)(T.q_g + d0 * 16 + hi * 8), g1 = *(const f32x4*)(T.q_g + d0 * 16 + hi * 8 + 4);
            u32x4 w; w.x = cvt_pk_bf16(bflo(raw[d0].x) * rn * g0[0], bfhi(raw[d0].x) * rn * g0[1]); w.y = cvt_pk_bf16(bflo(raw[d0].y) * rn * g0[2], bfhi(raw[d0].y) * rn * g0[3]);
            w.z = cvt_pk_bf16(bflo(raw[d0].z) * rn * g1[0], bfhi(raw[d0].z) * rn * g1[1]); w.w = cvt_pk_bf16(bflo(raw[d0].w) * rn * g1[2], bfhi(raw[d0].w) * rn * g1[3]);
            qr[d0] = *reinterpret_cast<bf16x8*>(&w); }
#pragma unroll
        for (int p = 0; p < 2; ++p) {
            const int ib = 16 * p + 8 * hi;
            float x1[8], x2[8];
            const f32x4 ga = *(const f32x4*)(T.q_g + 128 + ib), gb_ = *(const f32x4*)(T.q_g + 128 + ib + 4), gc = *(const f32x4*)(T.q_g + 160 + ib), gd = *(const f32x4*)(T.q_g + 160 + ib + 4);
            const float g1v[8] = {ga[0], ga[1], ga[2], ga[3], gb_[0], gb_[1], gb_[2], gb_[3]}, g2v[8] = {gc[0], gc[1], gc[2], gc[3], gd[0], gd[1], gd[2], gd[3]};
#pragma unroll
            for (int e = 0; e < 4; ++e) { x1[2 * e] = bflo(raw[8 + p][e]) * rn * g1v[2 * e]; x1[2 * e + 1] = bfhi(raw[8 + p][e]) * rn * g1v[2 * e + 1];
                                          x2[2 * e] = bflo(raw[10 + p][e]) * rn * g2v[2 * e]; x2[2 * e + 1] = bfhi(raw[10 + p][e]) * rn * g2v[2 * e + 1]; }
            float y1[8], y2[8];
#pragma unroll
            for (int jj = 0; jj < 4; ++jj) { const f32x4 c2 = *(const f32x4*)((const float*)T.cs + ((size_t)mrow * 32 + ib + 2 * jj) * 2);
                y1[2 * jj] = x1[2 * jj] * c2[0] - x2[2 * jj] * c2[1]; y2[2 * jj] = x2[2 * jj] * c2[0] + x1[2 * jj] * c2[1];
                y1[2 * jj + 1] = x1[2 * jj + 1] * c2[2] - x2[2 * jj + 1] * c2[3]; y2[2 * jj + 1] = x2[2 * jj + 1] * c2[2] + x1[2 * jj + 1] * c2[3]; }
            u32x4 w1, w2; w1.x = cvt_pk_bf16(y1[0], y1[1]); w1.y = cvt_pk_bf16(y1[2], y1[3]); w1.z = cvt_pk_bf16(y1[4], y1[5]); w1.w = cvt_pk_bf16(y1[6], y1[7]);
            w2.x = cvt_pk_bf16(y2[0], y2[1]); w2.y = cvt_pk_bf16(y2[2], y2[3]); w2.z = cvt_pk_bf16(y2[4], y2[5]); w2.w = cvt_pk_bf16(y2[6], y2[7]);
            *(LAS u32x4*)(qrope + p * 32) = w1; *(LAS u32x4*)(qrope + (2 + p) * 32) = w2; }
        asm volatile("s_waitcnt lgkmcnt(0)" ::: "memory");
    }
    float m_reg = -1e30f, l_reg = 0.f; f32x16 o[4] = {};
    f32x16 pA0, pA1, pB0, pB1; float alA = 1.f, alB = 1.f; bf16x8 pa0, pa1, pa2, pa3;
    const int NT = 4 * qb + 4; const int wp = wid >> 1;
    const bool a1 = wp >= 1, a2 = wp >= 2, a3 = wp >= 3;
    const LAS char* K0 = K_lds; const LAS char* K1 = K_lds + SHM_K;
    asm volatile("s_waitcnt vmcnt(0)" ::: "memory"); SWRITE(0); __syncthreads();
    qkt(pA0, pA1, K0, qr, qrope, r32, hi); partialSM(pA0, pA1, m_reg, alA);
    SLOAD(1); asm volatile("s_waitcnt vmcnt(0)" ::: "memory"); SWRITE(1); __syncthreads();
    for (int j = 1; j + 3 < NT; j += 2) {
        SBAR(); qkt(pB0, pB1, K1, qr, qrope, r32, hi);
        finishSM(pA0, pA1, alA, l_reg, pa0, pa1, pa2, pa3); SBAR();
        SLOAD(j + 1); SBAR();
        pv_d0(o, vb0, pa0, pa1, pa2, pa3); partialSM(pB0, pB1, m_reg, alB);
        __syncthreads(); asm volatile("s_waitcnt vmcnt(0)" ::: "memory"); SWRITE(0);
        RESC(alB); __syncthreads();
        SBAR(); qkt(pA0, pA1, K0, qr, qrope, r32, hi);
        finishSM(pB0, pB1, alB, l_reg, pa0, pa1, pa2, pa3); SBAR();
        SLOAD(j + 2); SBAR();
        pv_d0(o, vb0 + SHM_V, pa0, pa1, pa2, pa3); partialSM(pA0, pA1, m_reg, alA);
        __syncthreads(); asm volatile("s_waitcnt vmcnt(0)" ::: "memory"); SWRITE(1);
        RESC(alA); __syncthreads();
    }
#define MASK(P0, P1, act) do { if (!(act)) { _Pragma("unroll") for (int r = 0; r < 16; ++r) { P0[r] = -INFINITY; P1[r] = -INFINITY; } } } while (0)
    {
        SBAR(); if (a1) qkt(pB0, pB1, K1, qr, qrope, r32, hi); MASK(pB0, pB1, a1);
        finishSM(pA0, pA1, alA, l_reg, pa0, pa1, pa2, pa3); SBAR();
        SLOAD(NT - 2); SBAR();
        pv_d0(o, vb0, pa0, pa1, pa2, pa3); partialSM(pB0, pB1, m_reg, alB);
        __syncthreads(); asm volatile("s_waitcnt vmcnt(0)" ::: "memory"); SWRITE(0);
        RESC(alB); __syncthreads();
        SBAR(); if (a2) qkt(pA0, pA1, K0, qr, qrope, r32, hi); MASK(pA0, pA1, a2);
        finishSM(pB0, pB1, alB, l_reg, pa0, pa1, pa2, pa3); SBAR();
        SLOAD(NT - 1); SBAR();
        pv_d0(o, vb0 + SHM_V, pa0, pa1, pa2, pa3); partialSM(pA0, pA1, m_reg, alA);
        __syncthreads(); asm volatile("s_waitcnt vmcnt(0)" ::: "memory"); SWRITE(1);
        RESC(alA); __syncthreads();
        SBAR(); if (a3) qkt(pB0, pB1, K1, qr, qrope, r32, hi); MASK(pB0, pB1, a3);
        finishSM(pA0, pA1, alA, l_reg, pa0, pa1, pa2, pa3); SBAR();
        pv_d0(o, vb0, pa0, pa1, pa2, pa3); partialSM(pB0, pB1, m_reg, alB);
        RESC(alB);
        finishSM(pB0, pB1, alB, l_reg, pa0, pa1, pa2, pa3); SBAR();
        pv_d0(o, vb0 + SHM_V, pa0, pa1, pa2, pa3);
    }
#undef MASK
    if (hi == 0) li_l[r32] = l_reg; asm volatile("s_waitcnt lgkmcnt(0)" ::: "memory");
    float rli[16];
#pragma unroll
    for (int r = 0; r < 16; ++r) rli[r] = __builtin_amdgcn_rcpf(li_l[crow(r, hi)]);
    __syncthreads();
    LAS bf16_t* stg = (LAS bf16_t*)(lds + wid * 8192);
#pragma unroll
    for (int r = 0; r < 16; ++r) { const int orow = crow(r, hi);
#pragma unroll
        for (int d0 = 0; d0 < 4; ++d0) stg[orow * 128 + d0 * 32 + r32] = f2bf(o[d0][r] * rli[r]); }
    asm volatile("s_waitcnt lgkmcnt(0)" ::: "memory");
    if (MODE != 1) {
        const int ch = lane & 15, c = h * VH + ch * 8;
        const f32x4 w0a = *(const f32x4*)(T.conv_w + c), w0b = *(const f32x4*)(T.conv_w + c + 4), w1a = *(const f32x4*)(T.conv_w + DM + c), w1b = *(const f32x4*)(T.conv_w + DM + c + 4),
              w2a = *(const f32x4*)(T.conv_w + 2 * DM + c), w2b = *(const f32x4*)(T.conv_w + 2 * DM + c + 4);
        const float cw0[8] = {w0a[0], w0a[1], w0a[2], w0a[3], w0b[0], w0b[1], w0b[2], w0b[3]}, cw1[8] = {w1a[0], w1a[1], w1a[2], w1a[3], w1b[0], w1b[1], w1b[2], w1b[3]},
                    cw2[8] = {w2a[0], w2a[1], w2a[2], w2a[3], w2b[0], w2b[1], w2b[2], w2b[3]};
#pragma unroll 4
        for (int i = 0; i < 8; ++i) { const int row = i * 4 + (lane >> 4); const int tt = qb * 256 + wid * QBLK + row; const size_t e = (size_t)(b * SEQ + tt) * DM + c;
            const u32x4 ov = *(const LAS u32x4*)(stg + row * 128 + ch * 8);
            const u32x4 u0 = *(const u32x4*)(T.u + e), gbv = *(const u32x4*)(T.gb + e), sgv = *(const u32x4*)(T.sg + e);
            u32x4 u1 = {0u, 0u, 0u, 0u}, u2 = {0u, 0u, 0u, 0u};
            if (tt >= 1) u1 = *(const u32x4*)(T.u + e - DM);
            if (tt >= 2) u2 = *(const u32x4*)(T.u + e - 2 * DM);
            u32x4 res;
#pragma unroll
            for (int q = 0; q < 4; ++q) {
                const float cl = cw0[2 * q] * bflo(u2[q]) + cw1[2 * q] * bflo(u1[q]) + cw2[2 * q] * bflo(u0[q]), chh = cw0[2 * q + 1] * bfhi(u2[q]) + cw1[2 * q + 1] * bfhi(u1[q]) + cw2[2 * q + 1] * bfhi(u0[q]);
                res[q] = cvt_pk_bf16(bflo(gbv[q]) * cl + bflo(sgv[q]) * bflo(ov[q]), bfhi(gbv[q]) * chh + bfhi(sgv[q]) * bfhi(ov[q])); }
            *(u32x4*)(T.merged + e) = res; }
    }
    asm volatile("s_waitcnt lgkmcnt(0)" ::: "memory");
    __syncthreads();
#undef SLOAD
#undef SWRITE
#undef RESC
}

constexpr int K2_BYTES = KVBLK * QKH * 2, V2_OFF = 0, K2_OFF = 3 * SHM_V, WS2_OFF = K2_OFF + 2 * K2_BYTES, ATT2_LDS = WS2_OFF + NW * 64 * 4;
__device__ __forceinline__ void qkt2(f32x16& p0, f32x16& p1, const LAS char* Krow, const int (&koff)[4], const bf16x8 (&qr)[12]) {
    p0 = f32x16{}; p1 = f32x16{};
    bf16x8 fa[4], fb[4];
#define KRD(dst, d0) do { const LAS char* a_ = Krow + ((d0) >> 2) * 128 + koff[(d0) & 3]; dst[0] = *(const LAS bf16x8*)a_; dst[1] = *(const LAS bf16x8*)(a_ + 32 * QKH * 2); \
                          const LAS char* c_ = Krow + (((d0) + 1) >> 2) * 128 + koff[((d0) + 1) & 3]; dst[2] = *(const LAS bf16x8*)c_; dst[3] = *(const LAS bf16x8*)(c_ + 32 * QKH * 2); } while (0)
#define KMM(src, d0) do { p0 = __builtin_amdgcn_mfma_f32_32x32x16_bf16(src[0], qr[d0], p0, 0, 0, 0); p1 = __builtin_amdgcn_mfma_f32_32x32x16_bf16(src[1], qr[d0], p1, 0, 0, 0); \
                          p0 = __builtin_amdgcn_mfma_f32_32x32x16_bf16(src[2], qr[(d0) + 1], p0, 0, 0, 0); p1 = __builtin_amdgcn_mfma_f32_32x32x16_bf16(src[3], qr[(d0) + 1], p1, 0, 0, 0); } while (0)
    KRD(fa, 0); KRD(fb, 2);
    KMM(fa, 0); KRD(fa, 4);
    KMM(fb, 2); KRD(fb, 6);
    KMM(fa, 4); KRD(fa, 8);
    KMM(fb, 6); KRD(fb, 10);
    KMM(fa, 8);
    KMM(fb, 10);
#undef KRD
#undef KMM
}
template <int MODE> __device__ __forceinline__ void attn_unit2(const AttnArgs& T, int b, int h, int qb, LAS char* lds) {
    int tid = threadIdx.x; asm volatile("" : "+v"(tid));
    const int lane = tid & 63, r32 = lane & 31, hi = lane >> 5; const int wid = __builtin_amdgcn_readfirstlane(tid >> 6);
    LAS char* V_lds = lds + V2_OFF; LAS char* K_lds = lds + K2_OFF;
    LAS float* ws = (LAS float*)(lds + WS2_OFF) + wid * 64; LAS float* li_l = ws; LAS float* al_l = ws + 32;
    const int mrow = b * SEQ + qb * 256 + wid * QBLK + r32;
    const char* Kh = (const char*)(T.Kb + (size_t)(b * NH + h) * SEQ * QKH); const char* Vh = (const char*)(T.Vb + (size_t)(b * NH + h) * SEQ * VH);
#define DMA_KV(t, kbuf, vbuf) do { const char* kt = Kh + (size_t)(t) * K2_BYTES; const char* vt = Vh + (size_t)(t) * SHM_V; int ln = lane; asm volatile("" : "+v"(ln)); \
    _Pragma("unroll") for (int _i = 0; _i < 3; ++_i) { const int q = (wid * 3 + _i) * 64 + ln, r = q / 24, cp = q - r * 24, c = (cp & ~7) | ((cp & 7) ^ ((r >> 1) & 7)); \
        __builtin_amdgcn_global_load_lds((const unsigned*)(kt + (unsigned)(r * 384 + c * 16)), (LAS unsigned*)(K_lds + (kbuf) * K2_BYTES + (wid * 3 + _i) * 1024), 16, 0, 0); } \
    _Pragma("unroll") for (int _i = 0; _i < 2; ++_i) { const int q = (wid * 2 + _i) * 64 + ln, sub = q >> 5, w = q & 31, kk = ((sub >> 2) << 3) | (w >> 2), k = (kk & ~0xC) | ((kk & 4) << 1) | ((kk & 8) >> 1), c = ((sub & 3) << 5) | ((w & 3) << 3); \
        __builtin_amdgcn_global_load_lds((const unsigned*)(vt + (unsigned)(k * 256 + c * 2)), (LAS unsigned*)(V_lds + (vbuf) * SHM_V + (wid * 2 + _i) * 1024), 16, 0, 0); } } while (0)
#define RESC(a) do { if (__any((a) < 1.f)) { if (hi == 0) al_l[r32] = (a); asm volatile("s_waitcnt lgkmcnt(0)" ::: "memory"); \
    _Pragma("unroll") for (int d = 0; d < 4; ++d) _Pragma("unroll") for (int r = 0; r < 16; ++r) o[d][r] *= al_l[crow(r, hi)]; } } while (0)
    DMA_KV(0, 0, 0);
    const int vb0 = (int)(uintptr_t)V_lds + v_rd_base(lane);
    const LAS char* Krow = K_lds + r32 * (QKH * 2);
    int koff[4];
    { const int sw = (r32 >> 1) & 7;
#pragma unroll
      for (int j = 0; j < 4; ++j) koff[j] = ((2 * j + hi) ^ sw) * 16; }
    bf16x8 qr[12];
    {
        const bf16_t* Qw = T.Q + (size_t)mrow * 1536 + h * QKH + hi * 8;
        u32x4 raw[12];
#pragma unroll
        for (int d0 = 0; d0 < 12; ++d0) raw[d0] = *(const u32x4*)(Qw + d0 * 16);
        const f32x2 sq2 = *(const f32x2*)(T.ssp + (size_t)mrow * 4); const float ssq = sq2[0] + sq2[1];
        float ss = 0.f;
#pragma unroll
        for (int d0 = 0; d0 < 12; ++d0)
#pragma unroll
            for (int e = 0; e < 4; ++e) { const float a = bflo(raw[d0][e]), c = bfhi(raw[d0][e]); ss += a * a + c * c; }
        { auto rr = __builtin_amdgcn_permlane32_swap(__float_as_uint(ss), __float_as_uint(ss), false, false); ss = __uint_as_float(rr[0]) + __uint_as_float(rr[1]); }
        const float rq2 = 1.f / (ssq * (1.f / QL) + EPS);
        const float rn = 1.f / sqrtf(ss * rq2 * (1.f / QKH) + EPS) * sqrtf(rq2);
#pragma unroll
        for (int d0 = 0; d0 < 8; ++d0) { const f32x4 g0 = *(const f32x4*)(T.q_g + d0 * 16 + hi * 8), g1 = *(const f32x4*)(T.q_g + d0 * 16 + hi * 8 + 4);
            u32x4 w; w.x = cvt_pk_bf16(bflo(raw[d0].x) * rn * g0[0], bfhi(raw[d0].x) * rn * g0[1]); w.y = cvt_pk_bf16(bflo(raw[d0].y) * rn * g0[2], bfhi(raw[d0].y) * rn * g0[3]);
            w.z = cvt_pk_bf16(bflo(raw[d0].z) * rn * g1[0], bfhi(raw[d0].z) * rn * g1[1]); w.w = cvt_pk_bf16(bflo(raw[d0].w) * rn * g1[2], bfhi(raw[d0].w) * rn * g1[3]);
            qr[d0] = *reinterpret_cast<bf16x8*>(&w); }
#pragma unroll
        for (int p = 0; p < 2; ++p) {
            const int ib = 16 * p + 8 * hi;
            float x1[8], x2[8];
            const f32x4 ga = *(const f32x4*)(T.q_g + 128 + ib), gb_ = *(const f32x4*)(T.q_g + 128 + ib + 4), gc = *(const f32x4*)(T.q_g + 160 + ib), gd = *(const f32x4*)(T.q_g + 160 + ib + 4);
            const float g1v[8] = {ga[0], ga[1], ga[2], ga[3], gb_[0], gb_[1], gb_[2], gb_[3]}, g2v[8] = {gc[0], gc[1], gc[2], gc[3], gd[0], gd[1], gd[2], gd[3]};
#pragma unroll
            for (int e = 0; e < 4; ++e) { x1[2 * e] = bflo(raw[8 + p][e]) * rn * g1v[2 * e]; x1[2 * e + 1] = bfhi(raw[8 + p][e]) * rn * g1v[2 * e + 1];
                                          x2[2 * e] = bflo(raw[10 + p][e]) * rn * g2v[2 * e]; x2[2 * e + 1] = bfhi(raw[10 + p][e]) * rn * g2v[2 * e + 1]; }
            float y1[8], y2[8];
#pragma unroll
            for (int jj = 0; jj < 4; ++jj) { const f32x4 c2 = *(const f32x4*)((const float*)T.cs + ((size_t)mrow * 32 + ib + 2 * jj) * 2);
                y1[2 * jj] = x1[2 * jj] * c2[0] - x2[2 * jj] * c2[1]; y2[2 * jj] = x2[2 * jj] * c2[0] + x1[2 * jj] * c2[1];
                y1[2 * jj + 1] = x1[2 * jj + 1] * c2[2] - x2[2 * jj + 1] * c2[3]; y2[2 * jj + 1] = x2[2 * jj + 1] * c2[2] + x1[2 * jj + 1] * c2[3]; }
            u32x4 w1, w2; w1.x = cvt_pk_bf16(y1[0], y1[1]); w1.y = cvt_pk_bf16(y1[2], y1[3]); w1.z = cvt_pk_bf16(y1[4], y1[5]); w1.w = cvt_pk_bf16(y1[6], y1[7]);
            w2.x = cvt_pk_bf16(y2[0], y2[1]); w2.y = cvt_pk_bf16(y2[2], y2[3]); w2.z = cvt_pk_bf16(y2[4], y2[5]); w2.w = cvt_pk_bf16(y2[6], y2[7]);
            qr[8 + p] = *reinterpret_cast<bf16x8*>(&w1); qr[10 + p] = *reinterpret_cast<bf16x8*>(&w2); }
    }
    float m_reg = -1e30f, l_reg = 0.f; f32x16 o[4] = {};
    f32x16 pA0, pA1, pB0, pB1; float alA = 1.f, alB = 1.f; bf16x8 pa0, pa1, pa2, pa3;
    const int NT = 4 * qb + 4; const int wp = wid >> 1;
    const bool a1 = wp >= 1, a2 = wp >= 2, a3 = wp >= 3;
#define MASK(P0, P1, act) do { if (!(act)) { _Pragma("unroll") for (int r = 0; r < 16; ++r) { P0[r] = -INFINITY; P1[r] = -INFINITY; } } } while (0)
#define INTERVAL(PN0, PN1, PO0, PO1, alN, alO, t, act, load) do { \
        if (load) DMA_KV((t) + 1, ((t) + 1) & 1, vnext); \
        SBAR(); if (act) qkt2(PN0, PN1, Krow + ((t) & 1) * K2_BYTES, koff, qr); MASK(PN0, PN1, act); \
        if (MODE == 2) { asm volatile("" : "+v"(PO0), "+v"(PO1)); pa0 = __builtin_bit_cast(bf16x8, (u32x4){__float_as_uint(PO0[0]), __float_as_uint(PO0[1]), __float_as_uint(PO0[2]), __float_as_uint(PO0[3])}); pa1 = pa0; pa2 = pa0; pa3 = pa0; } \
        else finishSM(PO0, PO1, alO, l_reg, pa0, pa1, pa2, pa3); \
        SBAR(); pv_d0(o, vb0 + vprev * SHM_V, pa0, pa1, pa2, pa3); if (MODE == 2) { asm volatile("" : "+v"(PN0), "+v"(PN1)); } else partialSM(PN0, PN1, m_reg, alN); \
        __syncthreads(); RESC(alN); \
        vprev = vcur; vcur = vnext; vnext = (vnext == 2) ? 0 : vnext + 1; } while (0)
    __syncthreads();
    int vprev = 0, vcur = 1, vnext = 2;
    DMA_KV(1, 1, 1);
    qkt2(pA0, pA1, Krow, koff, qr); partialSM(pA0, pA1, m_reg, alA);
    __syncthreads();
    for (int j = 1; j + 3 < NT; j += 2) {
        INTERVAL(pB0, pB1, pA0, pA1, alB, alA, j, true, true);
        INTERVAL(pA0, pA1, pB0, pB1, alA, alB, j + 1, true, true);
    }
    INTERVAL(pB0, pB1, pA0, pA1, alB, alA, NT - 3, a1, true);
    INTERVAL(pA0, pA1, pB0, pB1, alA, alB, NT - 2, a2, true);
    INTERVAL(pB0, pB1, pA0, pA1, alB, alA, NT - 1, a3, false);
    finishSM(pB0, pB1, alB, l_reg, pa0, pa1, pa2, pa3); SBAR();
    pv_d0(o, vb0 + vprev * SHM_V, pa0, pa1, pa2, pa3);
#undef INTERVAL
#undef MASK
    if (hi == 0) li_l[r32] = l_reg; asm volatile("s_waitcnt lgkmcnt(0)" ::: "memory");
    float rli[16];
#pragma unroll
    for (int r = 0; r < 16; ++r) rli[r] = __builtin_amdgcn_rcpf(li_l[crow(r, hi)]);
    __syncthreads();
    LAS bf16_t* stg = (LAS bf16_t*)(lds + wid * 8192);
#pragma unroll
    for (int r = 0; r < 16; ++r) { const int orow = crow(r, hi);
#pragma unroll
        for (int d0 = 0; d0 < 4; ++d0) stg[orow * 128 + d0 * 32 + r32] = f2bf(o[d0][r] * rli[r]); }
    asm volatile("s_waitcnt lgkmcnt(0)" ::: "memory");
    if (MODE == 0) {
        const int g = lane >> 4, ch = lane & 15, c = h * VH + ch * 8; const int t0 = qb * 256 + wid * QBLK;
        const size_t e0 = (size_t)(b * SEQ + t0) * DM + c;
        u32x4 uu[8], gv[8], sv[8];
#pragma unroll
        for (int i = 0; i < 8; ++i) { const size_t e = e0 + (size_t)(4 * i + g) * DM; uu[i] = *(const u32x4*)(T.u + e); gv[i] = *(const u32x4*)(T.gb + e); sv[i] = *(const u32x4*)(T.sg + e); }
        u32x4 uvirt = {0u, 0u, 0u, 0u};
        if (g >= 2 && t0 > 0) uvirt = *(const u32x4*)(T.u + e0 - (size_t)(4 - g) * DM);
        const f32x4 w0a = *(const f32x4*)(T.conv_w + c), w0b = *(const f32x4*)(T.conv_w + c + 4), w1a = *(const f32x4*)(T.conv_w + DM + c), w1b = *(const f32x4*)(T.conv_w + DM + c + 4),
              w2a = *(const f32x4*)(T.conv_w + 2 * DM + c), w2b = *(const f32x4*)(T.conv_w + 2 * DM + c + 4);
        const float cw0[8] = {w0a[0], w0a[1], w0a[2], w0a[3], w0b[0], w0b[1], w0b[2], w0b[3]}, cw1[8] = {w1a[0], w1a[1], w1a[2], w1a[3], w1b[0], w1b[1], w1b[2], w1b[3]},
                    cw2[8] = {w2a[0], w2a[1], w2a[2], w2a[3], w2b[0], w2b[1], w2b[2], w2b[3]};
        const int src1 = ((lane - 16) & 63) << 2, src2 = (lane ^ 32) << 2;
#pragma unroll
        for (int i = 0; i < 8; ++i) { const int row = i * 4 + g; const size_t e = e0 + (size_t)row * DM;
            const u32x4 ov = *(const LAS u32x4*)(stg + row * 128 + ch * 8);
            const u32x4 up = (i == 0) ? uvirt : uu[i > 0 ? i - 1 : 0];
            u32x4 u1, u2, res;
#pragma unroll
            for (int q = 0; q < 4; ++q) { const unsigned x1 = (g == 3) ? up[q] : uu[i][q], x2 = (g >= 2) ? up[q] : uu[i][q];
                u1[q] = (unsigned)__builtin_amdgcn_ds_bpermute(src1, (int)x1); u2[q] = (unsigned)__builtin_amdgcn_ds_bpermute(src2, (int)x2); }
#pragma unroll
            for (int q = 0; q < 4; ++q) {
                const float cl = cw0[2 * q] * bflo(u2[q]) + cw1[2 * q] * bflo(u1[q]) + cw2[2 * q] * bflo(uu[i][q]), chh = cw0[2 * q + 1] * bfhi(u2[q]) + cw1[2 * q + 1] * bfhi(u1[q]) + cw2[2 * q + 1] * bfhi(uu[i][q]);
                res[q] = cvt_pk_bf16(bflo(gv[i][q]) * cl + bflo(sv[i][q]) * bflo(ov[q]), bfhi(gv[i][q]) * chh + bfhi(sv[i][q]) * bfhi(ov[q])); }
            *(u32x4*)(T.merged + e) = res; }
    }
    asm volatile("s_waitcnt lgkmcnt(0)" ::: "memory");
    __syncthreads();
#undef DMA_KV
#undef RESC
}
#undef SBAR
}
#ifndef ATTN_UNIT
#define ATTN_UNIT attn_unit2
#endif
struct Frame {
    LAS unsigned char* lds; volatile LAS unsigned* MISC; unsigned* ctl;
    int tid, lane, wave, vcu, G;
};
__device__ __forceinline__ float wave_sum(float v) {
#pragma unroll
    for (int o = 1; o < 64; o <<= 1) v += __shfl_xor(v, o);
    return v;
}
__device__ __forceinline__ int tcc(int bj, int ch128) { return (bj << 7) | (ch128 & 0x60) | (((ch128 >> 2) & 1) << 4) | (((ch128 >> 3) & 3) << 2) | (ch128 & 3); }
struct MapIn { __device__ __forceinline__ int operator()(int c) const {
    if (c < C_ZB) return 256 * (c >> 7) + tcc(0, c & 127);
    if (c < C_ZC) { const int ch = c - C_ZB; return 256 * (8 + (ch >> 7)) + tcc(0, ch & 127); }
    if (c < C_QL) { const int ch = c - C_ZC; return 256 * (ch >> 7) + tcc(1, ch & 127); }
    if (c < C_KVL) { const int j = c - C_QL; return j < 256 ? 256 * 20 + permL(j) : 256 * 21 + permL(j - 256); }
    if (c < C_KR) return 256 * 22 + permL(c - C_KVL);
    if (c < C_GC) { const int j = c - C_KR, jj = j & 31; return 256 * 21 + 128 + ((jj >> 4) << 5) + ((j >> 5) << 4) + (((jj >> 2) & 3) << 2) + (jj & 3); }
    if (c < C_GM) { const int ch = c - C_GC; return 256 * (8 + (ch >> 7)) + tcc(1, ch & 127); }
    { const int j = c - C_GM; return 256 * (16 + (j >> 8)) + permL(j & 255); } } };
struct MapPerm { __device__ __forceinline__ int operator()(int c) const { return (c & ~255) | permL(c & 255); } };
struct MapId { __device__ __forceinline__ int operator()(int c) const { return c; } };
struct MapGU { int n; __device__ __forceinline__ int operator()(int f) const { const int r = f & 127; return 256 * (f >> 7) + ((((r >> 2) & 1) << 7) | ((r >> 5) << 5) | (n << 4) | (((r >> 3) & 3) << 2) | (r & 3)); } };

template <class RowMap>
__device__ __forceinline__ void transpose_item(const float* W, int N, bf16_t* WT, int ldt, const float* kscale, LAS float* scr, int item, int lane, const RowMap& rm) {
    const int nblk = N / 32, kb = item / nblk, nb = item % nblk, k0 = 64 * kb, n0 = 32 * nb;
    float wv[32];
#pragma unroll
    for (int i = 0; i < 32; ++i) wv[i] = W[(size_t)(k0 + 2 * i + (lane >> 5)) * N + n0 + (lane & 31)];
#pragma unroll
    for (int i = 0; i < 32; ++i) { const int kk = 2 * i + (lane >> 5); const float sc = kscale ? kscale[k0 + kk] : 1.f; scr[kk * 33 + (lane & 31)] = wv[i] * sc; }
    asm volatile("s_waitcnt lgkmcnt(0)" ::: "memory");
    const int c = lane & 7;
#pragma unroll
    for (int j = 0; j < 4; ++j) { const int n = (lane >> 3) + 8 * j; const LAS float* s = scr + (8 * c) * 33 + n;
        u32x4 o; o.x = cvt_pk_bf16(s[0 * 33], s[1 * 33]); o.y = cvt_pk_bf16(s[2 * 33], s[3 * 33]); o.z = cvt_pk_bf16(s[4 * 33], s[5 * 33]); o.w = cvt_pk_bf16(s[6 * 33], s[7 * 33]);
        *(u32x4*)(WT + (size_t)rm(n0 + n) * ldt + k0 + 8 * c) = o; }
    asm volatile("s_waitcnt lgkmcnt(0)" ::: "memory");
}
constexpr size_t WS_WIN = WS_WSMALL, WS_WQ = WS_WIN + (size_t)5888 * 1024 * 2, WS_WKV = WS_WQ + (size_t)1536 * 384 * 2, WS_WO = WS_WKV + (size_t)2048 * 256 * 2;
static_assert(WS_WO + (size_t)1024 * 1024 * 2 <= WS_A, "small weights fit below region A");
constexpr size_t WS_EGU = WS_C, WS_EDN = WS_C + (size_t)NEXP * 512 * 1024 * 2;
static_assert(WS_EDN + (size_t)NEXP * 1024 * 256 * 2 <= WS_D, "expert weights fit region C");

__device__ __forceinline__ void p0_weights_tables(const Ptrs& P, Frame& F) {
    LAS float* scr = (LAS float*)(F.lds + RING_OFF + F.wave * 16384);
    const int gw = F.vcu * NWAVES + F.wave, NGW = F.G * NWAVES;
    constexpr int I_IN = (DM / 64) * (DIN / 32), I_Q = (QL / 64) * (1536 / 32), I_KV = (KVL / 64) * (2048 / 32), I_O = (DM / 64) * (DM / 32);
    for (int it = gw; it < I_IN + I_Q + I_KV + I_O; it += NGW) {
        int r = it;
        if (r < I_IN) { transpose_item(P.w_in, DIN, (bf16_t*)(P.ws + WS_WIN), DM, (const float*)nullptr, scr, r, F.lane, MapIn{}); continue; } r -= I_IN;
        if (r < I_Q) { transpose_item(P.w_q_b, 1536, (bf16_t*)(P.ws + WS_WQ), QL, P.q_a_g, scr, r, F.lane, MapPerm{}); continue; } r -= I_Q;
        if (r < I_KV) { transpose_item(P.w_kv_b, 2048, (bf16_t*)(P.ws + WS_WKV), KVL, P.kv_a_g, scr, r, F.lane, MapPerm{}); continue; } r -= I_KV;
        transpose_item(P.w_o, DM, (bf16_t*)(P.ws + WS_WO), DM, (const float*)nullptr, scr, r, F.lane, MapPerm{});
    }
    {
        const int gt = F.vcu * 512 + F.tid;
        if (gt < 64 * 128) { const int rr = 192 + (gt >> 7), ch = gt & 127; *(u32x4*)((bf16_t*)(P.ws + WS_WIN) + (size_t)(256 * 21 + rr) * DM + ch * 8) = (u32x4){0u, 0u, 0u, 0u}; } }
    {
        float2* cs = (float2*)(P.ws + WS_CS);
        for (int idx = F.vcu * 512 + F.tid; idx < M * 32; idx += F.G * 512) { const int m = idx >> 5, i = idx & 31;
            const double inv = exp2(-(double)(2 * i) * (13.287712379549449 / 64.0));
            const double ang = (double)P.pos[m] * inv; float2 v; v.x = (float)cos(ang); v.y = (float)sin(ang); cs[idx] = v; } }
    asm volatile("s_waitcnt vmcnt(0) lgkmcnt(0)" ::: "memory"); __syncthreads();
}
__device__ __forceinline__ void p0_mod(const Ptrs& P, Frame& F) {
    if (F.vcu < 192) {
        LAS float* cact = (LAS float*)(F.lds + RING_OFF); LAS float* red = (LAS float*)(F.lds + RING_OFF + 65536);
        for (int idx = F.tid; idx < BATCH * DM; idx += 512) { const float cv = P.c[idx]; cact[idx] = cv / (1.f + __expf(-cv)); }
        __syncthreads();
        const int n0 = 32 * F.vcu, kl = F.lane >> 3, c4 = F.lane & 7;
        f32x4 acc[16];
#pragma unroll
        for (int b = 0; b < 16; ++b) acc[b] = (f32x4){0.f, 0.f, 0.f, 0.f};
        for (int it = 0; it < 16; ++it) { const int k = 128 * F.wave + 8 * it + kl;
            const f32x4 wv = *(const f32x4*)(P.w_ada + (size_t)k * 6144 + n0 + 4 * c4);
#pragma unroll
            for (int b = 0; b < 16; ++b) acc[b] += cact[b * DM + k] * wv; }
#pragma unroll
        for (int b = 0; b < 16; ++b)
#pragma unroll
            for (int e = 0; e < 4; ++e) { float v = acc[b][e]; v += __shfl_xor(v, 8); v += __shfl_xor(v, 16); v += __shfl_xor(v, 32); if (kl == 0) red[(F.wave * 16 + b) * 32 + 4 * c4 + e] = v; }
        __syncthreads();
        { const int b = F.tid >> 5, cc = F.tid & 31; float s = P.b_ada[n0 + cc];
#pragma unroll
          for (int w = 0; w < 8; ++w) s += red[(w * 16 + b) * 32 + cc];
          ((float*)(P.ws + WS_MOD))[b * 6144 + n0 + cc] = s; }
        __syncthreads();
    }
}
__device__ __forceinline__ void expert_weight_items(const Ptrs& P, Frame& F, int w, int nw, int k_lo, int k_hi) {
    LAS float* scr = (LAS float*)(F.lds + RING_OFF + F.wave * 16384);
    constexpr int I_G = (DM / 64) * (DEXP / 32), I_D = (DEXP / 64) * (DM / 32);
    for (int k = k_lo; k < k_hi; ++k) { const int it = w + k * nw; if (it >= NEXP * (2 * I_G + I_D)) break;
        const int e = it / (2 * I_G + I_D); int r = it % (2 * I_G + I_D);
        bf16_t* gu = (bf16_t*)(P.ws + WS_EGU) + (size_t)e * 512 * DM; bf16_t* dn = (bf16_t*)(P.ws + WS_EDN) + (size_t)e * DM * DEXP;
        if (r < I_G) { transpose_item(P.w_gate + (size_t)e * DM * DEXP, DEXP, gu, DM, (const float*)nullptr, scr, r, F.lane, MapGU{0}); continue; } r -= I_G;
        if (r < I_G) { transpose_item(P.w_up + (size_t)e * DM * DEXP, DEXP, gu, DM, (const float*)nullptr, scr, r, F.lane, MapGU{1}); continue; } r -= I_G;
        transpose_item(P.w_down + (size_t)e * DEXP * DM, DM, dn, DEXP, (const float*)nullptr, scr, r, F.lane, MapPerm{});
    }
}
__device__ __forceinline__ void p1_norm1(const Ptrs& P, Frame& F) {
    const int gw = F.vcu * NWAVES + F.wave, NGW = F.G * NWAVES;
    bf16_t* h = (bf16_t*)(P.ws + WS_A);
    for (int m = gw; m < M; m += NGW) {
        const float* mod = (const float*)(P.ws + WS_MOD) + (m / SEQ) * 6144;
        const f32x4* xr = (const f32x4*)(P.x + (size_t)m * DM) + F.lane;
        f32x4 v[4]; float s = 0.f;
#pragma unroll
        for (int j = 0; j < 4; ++j) { v[j] = xr[64 * j]; s += (v[j][0] * v[j][0] + v[j][1] * v[j][1]) + (v[j][2] * v[j][2] + v[j][3] * v[j][3]); }
        const float rstd = 1.f / sqrtf(wave_sum(s) * (1.f / DM) + EPS);
        unsigned long long* o8 = (unsigned long long*)(h + (size_t)m * DM) + F.lane;
#pragma unroll
        for (int j = 0; j < 4; ++j) { const int d = 4 * F.lane + 256 * j;
            const f32x4 g = *(const f32x4*)(P.norm1_g + d), sc = *(const f32x4*)(mod + 1024 + d), sh = *(const f32x4*)(mod + d);
            const f32x4 r = v[j] * rstd * g * (sc + 1.f) + sh;
            o8[64 * j] = (unsigned long long)cvt_pk_bf16(r[0], r[1]) | ((unsigned long long)cvt_pk_bf16(r[2], r[3]) << 32); }
    }
}

constexpr size_t WS_WR = 30 * MiB;
constexpr size_t WS_STOK = WS_RT + 512 * 1024, WS_SW = WS_STOK + 320 * 1024;
constexpr int MAXROWS = 81920, MAXTILES = 320;
constexpr size_t WS_H2 = WS_B, WS_HACT = WS_B + 64 * MiB;
constexpr size_t WS_X1B = WS_B + 128 * MiB;
constexpr size_t WS_DELTA = WS_D, WS_Y0 = WS_A, WS_Y1 = WS_D + 64 * MiB;
constexpr int CW_T = CW_TILES, CW_T0 = CW_TILES + 1, CW_TGRP = CW_TILES + 64;

__device__ __forceinline__ void p0_router_weights(const Ptrs& P, Frame& F) {
    bf16_t* hi = (bf16_t*)(P.ws + WS_WR); bf16_t* lo = hi + 48 * DM;
    for (int idx = F.vcu * 512 + F.tid; idx < 48 * DM; idx += F.G * 512) { const int o = idx >> 10, k = idx & 1023;
        const float v = o < 4 ? P.w_rg[k * 4 + o] : (o < 36 ? P.w_re[k * 32 + o - 4] : 0.f);
        const bf16_t h = f2bf(v); hi[idx] = h; lo[idx] = f2bf(v - bf2f(h)); }
}
template <int MODE> __device__ __forceinline__ void p6_rows(const Ptrs& P, Frame& F) {
    LAS unsigned char* tile = F.lds + RING_OFF + F.wave * 8192;
    LAS float* lg = (LAS float*)(F.lds + RING_OFF + 65536 + F.wave * 1536);
    LAS unsigned char* wch = F.lds + RING_OFF + 77824;
    LAS float* gms = (LAS float*)(F.lds + XCH_OFF);
    LAS unsigned* hist = (LAS unsigned*)(F.lds + LDSCTL_OFF + 1024);
    const bf16_t* WrHi = (const bf16_t*)(P.ws + WS_WR); const bf16_t* WrLo = WrHi + 48 * DM;
    bf16_t* h2 = (bf16_t*)(P.ws + WS_H2); const bf16_t* dl = (const bf16_t*)(P.ws + WS_DELTA); bf16_t* x1b = (bf16_t*)(P.ws + WS_X1B);
    int2* rte = (int2*)(P.ws + WS_RT); float2* rtw = (float2*)(P.ws + WS_RT + 256 * 1024);
    const int t = F.lane & 15, q = F.lane >> 4;
    for (int rb = F.vcu; rb < M / 128; rb += F.G) {
        const int m0 = rb * 128 + F.wave * 16, b = m0 / SEQ;
        const float* mod = (const float*)(P.ws + WS_MOD) + b * 6144;
        __syncthreads();
        if (F.tid < 64) hist[F.tid] = 0u;
        for (int k = F.tid; k < DM; k += 512) { gms[k] = P.norm2_g[k] * (1.f + mod[4096 + k]); gms[DM + k] = mod[3072 + k]; }
        __syncthreads();
#pragma unroll 1
        for (int hb = 0; hb < 2; ++hb) {
            const int mb = m0 + 8 * hb;
            f32x4 xv[8][4]; float rstd[8];
#pragma unroll
            for (int r = 0; r < 8; ++r) { const f32x4* xr = (const f32x4*)(P.x + (size_t)(mb + r) * DM) + F.lane; const u32x2* dr = (const u32x2*)(dl + (size_t)(mb + r) * DM) + F.lane;
#pragma unroll
                for (int c = 0; c < 4; ++c) { const f32x4 x4 = xr[64 * c]; const u32x2 d = dr[64 * c];
                    xv[r][c][0] = x4[0] + __uint_as_float(d.x << 16); xv[r][c][1] = x4[1] + __uint_as_float(d.x & 0xffff0000u); xv[r][c][2] = x4[2] + __uint_as_float(d.y << 16); xv[r][c][3] = x4[3] + __uint_as_float(d.y & 0xffff0000u); } }
#pragma unroll
            for (int r = 0; r < 8; ++r) { float s = 0.f;
#pragma unroll
                for (int c = 0; c < 4; ++c) s += (xv[r][c][0] * xv[r][c][0] + xv[r][c][1] * xv[r][c][1]) + (xv[r][c][2] * xv[r][c][2] + xv[r][c][3] * xv[r][c][3]);
                rstd[r] = 1.f / sqrtf(wave_sum(s) * (1.f / DM) + EPS); }
            f32x4 acc[3];
#pragma unroll
            for (int cb = 0; cb < 3; ++cb) acc[cb] = (f32x4){0.f, 0.f, 0.f, 0.f};
#pragma unroll
            for (int c = 0; c < 4; ++c) {
                const int k0 = 256 * c + 4 * F.lane;
                __syncthreads();
#pragma unroll
                for (int j = 0; j < 6; ++j) { const int id = F.tid + 512 * j, arr = id / 1536, rem = id - arr * 1536, row = rem >> 5, ch = rem & 31;
                    *(LAS u32x4*)(wch + arr * 24576 + row * 512 + ((ch ^ (row & 15)) << 4)) = *(const u32x4*)((arr ? WrLo : WrHi) + (size_t)row * DM + 256 * c + 8 * ch); }
                const f32x4 gm = *(const LAS f32x4*)(gms + k0), sh = *(const LAS f32x4*)(gms + DM + k0);
#pragma unroll
                for (int r = 0; r < 8; ++r) { const f32x4 h = xv[r][c] * rstd[r] * gm + sh;
                    u32x2 hi; hi.x = cvt_pk_bf16(h[0], h[1]); hi.y = cvt_pk_bf16(h[2], h[3]);
                    u32x2 lo; lo.x = cvt_pk_bf16(h[0] - __uint_as_float(hi.x << 16), h[1] - __uint_as_float(hi.x & 0xffff0000u)); lo.y = cvt_pk_bf16(h[2] - __uint_as_float(hi.y << 16), h[3] - __uint_as_float(hi.y & 0xffff0000u));
                    *(u32x2*)(h2 + (size_t)(mb + r) * DM + k0) = hi;
                    const int off = r * 512 + ((((F.lane >> 1) ^ r) & 31) << 4) + ((F.lane & 1) << 3);
                    *(LAS u32x2*)(tile + off) = hi; *(LAS u32x2*)(tile + 4096 + off) = lo; }
                asm volatile("s_waitcnt vmcnt(0) lgkmcnt(0)" ::: "memory");
                __syncthreads();
#pragma unroll 2
                for (int ks = 0; ks < (MODE == 1 ? 0 : 8); ++ks) { const int tr = t & 7;
                    const int off = tr * 512 + ((((4 * ks + q) ^ tr) & 31) << 4);
                    const bf16x8 bh = *(const LAS bf16x8*)(tile + off), bl = *(const LAS bf16x8*)(tile + 4096 + off);
#pragma unroll
                    for (int cb = 0; cb < 3; ++cb) { const int woff = (16 * cb + t) * 512 + ((((4 * ks + q) ^ t) & 31) << 4);
                        const bf16x8 wh = *(const LAS bf16x8*)(wch + woff), wl = *(const LAS bf16x8*)(wch + 24576 + woff);
                        acc[cb] = __builtin_amdgcn_mfma_f32_16x16x32_bf16(wh, bh, acc[cb], 0, 0, 0);
                        acc[cb] = __builtin_amdgcn_mfma_f32_16x16x32_bf16(wh, bl, acc[cb], 0, 0, 0);
                        acc[cb] = __builtin_amdgcn_mfma_f32_16x16x32_bf16(wl, bh, acc[cb], 0, 0, 0); } }
                asm volatile("s_waitcnt lgkmcnt(0)" ::: "memory");
            }
            if (t < 8) {
#pragma unroll
                for (int cb = 0; cb < 3; ++cb)
#pragma unroll
                    for (int r = 0; r < 4; ++r) lg[t * 48 + 16 * cb + 4 * q + r] = acc[cb][r]; }
            asm volatile("s_waitcnt lgkmcnt(0)" ::: "memory");
            if (MODE != 1 && q == 0 && t < 8) {
                const int m = mb + t;
                const LAS float* l = lg + t * 48;
                float gl[4];
#pragma unroll
                for (int i = 0; i < 4; ++i) gl[i] = l[i] + P.b_rg[i];
                int g = 0; float gmx = gl[0];
#pragma unroll
                for (int i = 1; i < 4; ++i) if (gl[i] > gmx) { gmx = gl[i]; g = i; }
                float se = 0.f;
#pragma unroll
                for (int i = 0; i < 4; ++i) se += __expf(gl[i] - gmx);
                const float pg = 1.f / se;
                float e0v = -3.0e38f, e1v = -3.0e38f; int i0 = 0, i1 = 0;
#pragma unroll
                for (int i = 0; i < 8; ++i) { const float v = l[4 + g * 8 + i] + P.b_re[g * 8 + i];
                    if (v > e0v) { e1v = e0v; i1 = i0; e0v = v; i0 = i; } else if (v > e1v) { e1v = v; i1 = i; } }
                const float p1 = __expf(e1v - e0v), w0 = 1.f / (1.f + p1), w1 = p1 * w0;
                int2 e; e.x = g * 8 + i0; e.y = g * 8 + i1; float2 w; w.x = w0 * pg; w.y = w1 * pg;
                rte[m] = e; rtw[m] = w;
                __hip_atomic_fetch_add(&hist[e.x], 1u, __ATOMIC_RELAXED, __HIP_MEMORY_SCOPE_WORKGROUP); __hip_atomic_fetch_add(&hist[32 + e.y], 1u, __ATOMIC_RELAXED, __HIP_MEMORY_SCOPE_WORKGROUP);
            }
            asm volatile("s_waitcnt lgkmcnt(0)" ::: "memory");
        }
        __syncthreads();
        if (MODE != 1 && F.tid < 64) F.ctl[CW_HIST + rb * 64 + F.tid] = hist[F.tid];
    }
    __syncthreads();
}
__device__ __forceinline__ void p7_sort(const Ptrs& P, Frame& F) {
    LAS unsigned* tot = (LAS unsigned*)(F.lds + RING_OFF);
    LAS unsigned* pre = tot + 64;
    LAS unsigned* rbase = pre + 64;
    LAS unsigned* cnt = rbase + 64;
    LAS unsigned* misc = cnt + 64;
    int* stok = (int*)(P.ws + WS_STOK); float* sw = (float*)(P.ws + WS_SW);
    const int2* rte = (const int2*)(P.ws + WS_RT); const float2* rtw = (const float2*)(P.ws + WS_RT + 256 * 1024);
    const int cw = F.vcu * 7 + F.wave - 1, cnw = F.G * 7; bool first = true;
    for (int rb = F.vcu; rb < M / 128; rb += F.G) {
        __syncthreads();
        {
            LAS unsigned* ptot = misc + 8; LAS unsigned* ppre = ptot + 512;
            const int g = F.tid & 63, pt = F.tid >> 6; unsigned hv[32];
#pragma unroll
            for (int k = 0; k < 32; ++k) hv[k] = F.ctl[CW_HIST + (32 * pt + k) * 64 + g];
            unsigned s = 0u, p = 0u;
#pragma unroll
            for (int k = 0; k < 32; ++k) { if (32 * pt + k == rb) p = s; s += hv[k]; }
            if (rb >= 32 * pt + 32) p = s;
            ptot[pt * 64 + g] = s; ppre[pt * 64 + g] = p;
        }
        __syncthreads();
        if (F.tid < 64) { unsigned s = 0u, p = 0u;
#pragma unroll
            for (int pt = 0; pt < 8; ++pt) { s += misc[8 + pt * 64 + F.tid]; p += misc[8 + 512 + pt * 64 + F.tid]; }
            tot[F.tid] = s; pre[F.tid] = p; cnt[F.tid] = 0u; }
        if (first && F.wave > 0) expert_weight_items(P, F, cw, cnw, 0, 2);
        __syncthreads();
        if (first && F.wave > 0) expert_weight_items(P, F, cw, cnw, 2, 4);
        if (F.tid == 0) { unsigned tb = 0u;
            for (int g = 0; g < 64; ++g) { if (g == 32) misc[1] = tb; rbase[g] = tb * 256u; const unsigned nt = (tot[g] + 255u) >> 8;
                if (rb == 0) for (unsigned k = 0; k < nt; ++k) F.ctl[CW_TGRP + tb + k] = (unsigned)g;
                tb += nt; }
            misc[0] = tb; if (rb == 0) { F.ctl[CW_T] = tb; F.ctl[CW_T0] = misc[1]; } }
        __syncthreads();
        if (F.wave == 0) {
            const unsigned long long ltmask = (1ull << F.lane) - 1ull;
            for (int ch = 0; ch < 2; ++ch) { const int m = rb * 128 + ch * 64 + F.lane; const int2 e = rte[m]; const float2 w = rtw[m];
                for (int j = 0; j < 2; ++j) { const int ex = j ? e.y : e.x; const float wj = j ? w.y : w.x; unsigned rank = 0u, gsz = 0u;
                    for (int x = 0; x < 32; ++x) { const unsigned long long mk = __ballot(ex == x); if (ex == x) { rank = (unsigned)__popcll(mk & ltmask); gsz = (unsigned)__popcll(mk); } }
                    const int g = j * 32 + ex; const unsigned pos = rbase[g] + pre[g] + cnt[g] + rank;
                    stok[pos] = m; sw[pos] = wj;
                    asm volatile("s_waitcnt lgkmcnt(0)" ::: "memory");
                    if (rank == 0u) cnt[g] += gsz;
                    asm volatile("s_waitcnt lgkmcnt(0)" ::: "memory"); } } }
        if (rb < 64) { const unsigned n = tot[rb], padn = (((n + 255u) >> 8) << 8) - n;
            if ((unsigned)F.tid < padn) { stok[rbase[rb] + n + F.tid] = -1; sw[rbase[rb] + n + F.tid] = 0.f; } }
        if (first && F.wave > 0) expert_weight_items(P, F, cw, cnw, 4, 1 << 20);
        first = false;
    }
}
struct MoeSched {
    const bf16_t* A; const bf16_t* W; int lda, ldb; const int* stok; const unsigned* tgrp; int t_lo, nun, npn, G, c; size_t wstride; bool gather, split;
    __device__ bool next(int i, Unit& u) const {
        const int idx = i * G + c, nfull = (nun / G) * G, tail = nun - nfull; int U; u.half = 0;
        if (split && tail > 0 && 2 * tail <= G) { if (idx >= nfull + 2 * tail) return false; if (idx < nfull) U = idx; else { U = nfull + ((idx - nfull) >> 1); u.half = 1 + ((idx - nfull) & 1); } }
        else { if (idx >= nun) return false; U = idx; }
        u.aux = t_lo + U / npn; u.pn = U % npn; u.pm = (int)tgrp[u.aux]; return true; }
    __device__ __forceinline__ const char* abase(const Unit& u) const { return gather ? (const char*)A : (const char*)A + (size_t)(u.aux * BM + (u.half == 2 ? HALF : 0)) * lda * 2; }
    __device__ __forceinline__ const char* bbase(const Unit& u) const { return (const char*)W + (size_t)(u.pm & 31) * wstride + (size_t)u.pn * BM * ldb * 2; }
    __device__ __forceinline__ void avoff(const Unit& u, int R0, int C0, int R1, int C1, unsigned (&v0)[2], unsigned (&v1)[2]) const {
        if (gather) { const int* tk = stok + u.aux * BM + (u.half == 2 ? HALF : 0); const int o1 = u.half ? 0 : HALF; int a = tk[R0], b = tk[R1], c2 = tk[o1 + R0], d = tk[o1 + R1];
            a = a < 0 ? 0 : a; b = b < 0 ? 0 : b; c2 = c2 < 0 ? 0 : c2; d = d < 0 ? 0 : d;
            v0[0] = (unsigned)(a * lda + C0) * 2u; v0[1] = (unsigned)(b * lda + C1) * 2u; v1[0] = (unsigned)(c2 * lda + C0) * 2u; v1[1] = (unsigned)(d * lda + C1) * 2u; }
        else { v0[0] = (unsigned)(R0 * lda + C0) * 2u; v0[1] = (unsigned)(R1 * lda + C1) * 2u; const unsigned h1 = u.half ? 0u : (unsigned)(HALF * lda * 2); v1[0] = v0[0] + h1; v1[1] = v0[1] + h1; } }
};
struct EpiGU {
    bf16_t* hact; const float* sw;
    __device__ __forceinline__ void operator()(const f32x4 (&acc)[2][2][4][2], const Unit& un, int wr, int wc, int fr, int fq) const {
        asm volatile("" : "+v"(fr), "+v"(fq));
        const int r0 = un.aux * BM + (un.half == 2 ? HALF : 0) + wr * 64 + fr, c0 = 128 * un.pn + 32 * wc + 8 * fq;
#pragma unroll
        for (int ai = 0; ai < 2; ++ai)
#pragma unroll
            for (int m = 0; m < 4; ++m) { if (ai == 1 && un.half) continue; const int row = r0 + ai * HALF + m * 16; const float w = sw[row];
                f32x4 a, b;
#pragma unroll
                for (int i = 0; i < 4; ++i) { const float g0 = acc[ai][0][m][0][i], g1 = acc[ai][1][m][0][i];
                    a[i] = g0 * fsigmoid(g0) * acc[ai][0][m][1][i] * w; b[i] = g1 * fsigmoid(g1) * acc[ai][1][m][1][i] * w; }
                *(u32x4*)(hact + (size_t)row * DEXP + c0) = pack8(a, b); }
    }
};
struct EpiDown {
    bf16_t* y0; bf16_t* y1; const int* stok;
    __device__ __forceinline__ void operator()(const f32x4 (&acc)[2][2][4][2], const Unit& un, int wr, int wc, int fr, int fq) const {
        asm volatile("" : "+v"(fr), "+v"(fq));
        const int r0 = un.aux * BM + wr * 64 + fr, c0 = 256 * un.pn + 32 * wc + 8 * fq;
        bf16_t* y = (un.pm >> 5) ? y1 : y0;
#pragma unroll
        for (int ai = 0; ai < 2; ++ai)
#pragma unroll
            for (int m = 0; m < 4; ++m) { const int tok = stok[r0 + ai * HALF + m * 16];
                if (tok >= 0) { bf16_t* orow = y + (size_t)tok * DM + c0;
                    *(u32x4*)(orow) = pack8(acc[ai][0][m][0], acc[ai][0][m][1]); *(u32x4*)(orow + HALF) = pack8(acc[ai][1][m][0], acc[ai][1][m][1]); } }
    }
};
__device__ __forceinline__ void p10_combine(const Ptrs& P, Frame& F) {
    const int gw = F.vcu * NWAVES + F.wave, NGW = F.G * NWAVES;
    const bf16_t* dl = (const bf16_t*)(P.ws + WS_DELTA); const bf16_t* y0 = (const bf16_t*)(P.ws + WS_Y0); const bf16_t* y1 = (const bf16_t*)(P.ws + WS_Y1);
    for (int m = gw; m < M; m += NGW) {
        const float* gate = (const float*)(P.ws + WS_MOD) + (m / SEQ) * 6144 + 5120;
        const f32x4* xr = (const f32x4*)(P.x + (size_t)m * DM) + F.lane; f32x4* orow = (f32x4*)(P.out + (size_t)m * DM) + F.lane;
        const u32x2* dr = (const u32x2*)(dl + (size_t)m * DM) + F.lane; const u32x2* a0 = (const u32x2*)(y0 + (size_t)m * DM) + F.lane; const u32x2* a1 = (const u32x2*)(y1 + (size_t)m * DM) + F.lane;
#pragma unroll
        for (int j = 0; j < 4; ++j) { const f32x4 xv = xr[64 * j]; const u32x2 d = dr[64 * j], p = a0[64 * j], q = a1[64 * j]; const f32x4 g = *(const f32x4*)(gate + 4 * F.lane + 256 * j);
            f32x4 o;
            o[0] = xv[0] + __uint_as_float(d.x << 16) + g[0] * (__uint_as_float(p.x << 16) + __uint_as_float(q.x << 16));
            o[1] = xv[1] + __uint_as_float(d.x & 0xffff0000u) + g[1] * (__uint_as_float(p.x & 0xffff0000u) + __uint_as_float(q.x & 0xffff0000u));
            o[2] = xv[2] + __uint_as_float(d.y << 16) + g[2] * (__uint_as_float(p.y << 16) + __uint_as_float(q.y << 16));
            o[3] = xv[3] + __uint_as_float(d.y & 0xffff0000u) + g[3] * (__uint_as_float(p.y & 0xffff0000u) + __uint_as_float(q.y & 0xffff0000u));
            orow[64 * j] = o; }
    }
}
struct Args { Ptrs P; int ph_lo, ph_hi, li, pad; };
constexpr int N_PHASES = 11;

typedef const __attribute__((address_space(4))) Args* KArgs;
__device__ __forceinline__ KArgs kargs() {
#if defined(__HIP_DEVICE_COMPILE__)
    unsigned off = 0u; asm volatile("" : "+s"(off));
    return (KArgs)((const __attribute__((address_space(4))) char*)__builtin_amdgcn_kernarg_segment_ptr() + off);
#else
    return nullptr;
#endif
}
__device__ __forceinline__ Ptrs load_ptrs() {
    Ptrs P{};
#if defined(__HIP_DEVICE_COMPILE__)
    const __attribute__((address_space(4))) unsigned long long* src = (const __attribute__((address_space(4))) unsigned long long*)kargs();
    unsigned long long w[sizeof(Ptrs) / 8];
#pragma unroll
    for (unsigned i = 0; i < sizeof(Ptrs) / 8; ++i) w[i] = src[i];
    __builtin_memcpy(&P, w, sizeof(Ptrs));
#endif
    return P;
}
#define WSPTRS \
    unsigned char* ws = P.ws; bf16_t* hA = (bf16_t*)(ws + WS_A); bf16_t* uB = (bf16_t*)(ws + WS_B); bf16_t* gbB = uB + (size_t)M * DM; bf16_t* sgB = gbB + (size_t)M * DM; \
    bf16_t* latC = (bf16_t*)(ws + WS_C); bf16_t* Kd = (bf16_t*)(ws + WS_D); bf16_t* Vd = (bf16_t*)(ws + WS_D + 96 * MiB); bf16_t* Qo = (bf16_t*)P.out; \
    float* ssp = (float*)(ws + WS_SSP); const float2* cs = (const float2*)(ws + WS_CS); const float* mod = (const float*)(ws + WS_MOD); \
    const int* stok = (const int*)(ws + WS_STOK); const float* sw = (const float*)(ws + WS_SW); bf16_t* h2 = (bf16_t*)(ws + WS_H2); bf16_t* hact = (bf16_t*)(ws + WS_HACT); \
    (void)hA; (void)uB; (void)gbB; (void)sgB; (void)latC; (void)Kd; (void)Vd; (void)Qo; (void)ssp; (void)cs; (void)mod; (void)stok; (void)sw; (void)h2; (void)hact;

__global__ void __launch_bounds__(NWAVES * 64, 2) fwd(Args args_unused) {
    extern __shared__ __attribute__((aligned(16))) unsigned char lds_raw[];
    Frame F;
    F.lds = (LAS unsigned char*)lds_raw;
    F.MISC = (volatile LAS unsigned*)(F.lds + MISC_OFF);
    F.tid = threadIdx.x; F.lane = F.tid & 63; F.wave = __builtin_amdgcn_readfirstlane(F.tid >> 6);
    F.G = gridDim.x; { const int bx = blockIdx.x; F.vcu = (F.G % 8 == 0) ? (bx % 8) * (F.G / 8) + bx / 8 : bx; }
    F.ctl = (unsigned*)(args_unused.P.ws + WS_CTL);
    for (int u = F.tid; u < (LDS_BYTES - LDSCTL_OFF) / 4; u += NWAVES * 64) ((LAS unsigned*)(F.lds + LDSCTL_OFF))[u] = 0u;
    __syncthreads();
    const int lo = args_unused.ph_lo, hi = args_unused.ph_hi;
    XcdBarrier bar; bar.bar = F.ctl + CW_BAR + args_unused.li * XCD_BAR_WORDS; bar.x = 0; bar.st = nullptr;
    if (hi - lo > 1) bar = xcd_barrier_post(F.ctl + CW_BAR + args_unused.li * XCD_BAR_WORDS, F.MISC + 8);
#ifdef ONLY_PHASE
#define IN(k) ((k) == ONLY_PHASE && lo <= (k) && (k) < hi)
#else
#define IN(k) (lo <= (k) && (k) < hi)
#endif
#ifndef PROBE_REPEAT
#define PROBE_REPEAT -1
#endif
#define REPS(k) for (int rep_ = 0; rep_ < ((k) == PROBE_REPEAT ? 2 : 1); ++rep_)
#define SEAM(k) do { if (IN(k) && IN((k) + 1)) xcd_barrier(bar); } while (0)

    if (IN(0)) { const Ptrs P = args_unused.P; REPS(0) { p0_router_weights(P, F); p0_mod(P, F); } SEAM(0); }
    if (IN(1)) { const Ptrs P = args_unused.P; REPS(1) { p1_norm1(P, F); p0_weights_tables(P, F); } SEAM(1); }
    if (IN(2)) {
        const Ptrs P = args_unused.P; WSPTRS
        DenseSched S; S.init(hA, DM, (const bf16_t*)(ws + WS_WIN), DM, M, 5888, F.G, (int)blockIdx.x, true, true);
        EpiIn E{uB, gbB, sgB, latC, ssp, cs, P.k_g, (LAS float*)(F.lds + XCH_OFF)};
        gemm_phase<false>(F.lds + RING_OFF, DM, S, E);
        if (PROBE_REPEAT == 2) gemm_phase<false>(F.lds + RING_OFF, DM, S, E);
        SEAM(2);
    }
    if (IN(3)) {
        const Ptrs P = args_unused.P; WSPTRS
        { DenseSched S; S.init(latC, LATW, (const bf16_t*)(ws + WS_WQ), QL, M, 1536, F.G, (int)blockIdx.x);
          EpiPlain E{Qo, 1536, 255};
          gemm_phase<false>(F.lds + RING_OFF, QL, S, E);
          if (PROBE_REPEAT == 30) gemm_phase<false>(F.lds + RING_OFF, QL, S, E); }
        { DenseSched S; S.init(latC + 512, LATW, (const bf16_t*)(ws + WS_WKV), KVL, M, 2048, F.G, (int)blockIdx.x);
          EpiKV E{Kd, Vd, latC, ssp, P.k_g, (LAS float*)(F.lds + XCH_OFF)};
          gemm_phase<false>(F.lds + RING_OFF, KVL, S, E);
          if (PROBE_REPEAT == 31) gemm_phase<false>(F.lds + RING_OFF, KVL, S, E);
          if (PROBE_REPEAT == 32) { EpiPlain E2{hA, 1024, 3}; gemm_phase<false>(F.lds + RING_OFF, KVL, S, E2); } }
        SEAM(3);
    }
    if (IN(4)) {
        const Ptrs P = args_unused.P; WSPTRS
        att::AttnArgs T{Qo, Kd, Vd, ssp, cs, P.q_g, uB, gbB, sgB, P.conv_w, hA};
        if (F.G == 256) {
            const int bh = F.vcu >> 1, sel = F.vcu & 1;
#pragma unroll 1
            for (int i = 0; i < 4; ++i) { const int qb = sel ? (i == 0 ? 6 : i == 1 ? 1 : i == 2 ? 5 : 2) : (i == 0 ? 7 : i == 1 ? 0 : i == 2 ? 4 : 3);
                att::ATTN_UNIT<0>(T, bh >> 3, bh & 7, qb, (LAS char*)(F.lds + RING_OFF)); }
            if (PROBE_REPEAT == 4 || PROBE_REPEAT == 41 || PROBE_REPEAT == 42) {
#pragma unroll 1
                for (int i = 0; i < 4; ++i) { const int qb = sel ? (i == 0 ? 6 : i == 1 ? 1 : i == 2 ? 5 : 2) : (i == 0 ? 7 : i == 1 ? 0 : i == 2 ? 4 : 3);
                    att::ATTN_UNIT<(PROBE_REPEAT == 41 ? 1 : PROBE_REPEAT == 42 ? 2 : 0)>(T, bh >> 3, bh & 7, qb, (LAS char*)(F.lds + RING_OFF)); } }
        } else {
#pragma unroll 1
            for (int U = F.vcu; U < BATCH * NH * 8; U += F.G) { const int bh = U >> 3; att::ATTN_UNIT<0>(T, bh >> 3, bh & 7, U & 7, (LAS char*)(F.lds + RING_OFF)); }
        }
        SEAM(4);
    }
    if (IN(5)) {
        const Ptrs P = args_unused.P; WSPTRS
        DenseSched S; S.init(hA, DM, (const bf16_t*)(ws + WS_WO), DM, M, DM, F.G, (int)blockIdx.x);
        EpiDelta E{mod, (bf16_t*)(ws + WS_DELTA)};
        gemm_phase<false>(F.lds + RING_OFF, DM, S, E);
        if (PROBE_REPEAT == 5) gemm_phase<false>(F.lds + RING_OFF, DM, S, E);
        if (PROBE_REPEAT == 51) { EpiNull E0; gemm_phase<false>(F.lds + RING_OFF, DM, S, E0); }
        SEAM(5);
    }
    if (IN(6)) { const Ptrs P = args_unused.P; p6_rows<0>(P, F); if (PROBE_REPEAT == 6) p6_rows<0>(P, F); if (PROBE_REPEAT == 61) p6_rows<1>(P, F); SEAM(6); }
    if (IN(7)) { const Ptrs P = args_unused.P; p7_sort(P, F); if (PROBE_REPEAT == 7) p7_sort(P, F); SEAM(7); }
    if (IN(8)) {
        const Ptrs P = args_unused.P; WSPTRS
        const int T = __builtin_amdgcn_readfirstlane((int)F.ctl[CW_T]);
        MoeSched S{h2, (const bf16_t*)(ws + WS_EGU), DM, DM, stok, F.ctl + CW_TGRP, 0, T * 2, 2, F.G, F.vcu, (size_t)512 * DM * 2, true, true};
        EpiGU E{hact, sw};
        gemm_phase<true>(F.lds + RING_OFF, DM, S, E);
        if (PROBE_REPEAT == 8) gemm_phase<true>(F.lds + RING_OFF, DM, S, E);
        SEAM(8);
    }
    if (IN(9)) {
        const Ptrs P = args_unused.P; WSPTRS
        const int T = __builtin_amdgcn_readfirstlane((int)F.ctl[CW_T]);
        MoeSched S{hact, (const bf16_t*)(ws + WS_EDN), DEXP, DEXP, stok, F.ctl + CW_TGRP, 0, T * 4, 4, F.G, F.vcu, (size_t)DM * DEXP * 2, false, false};
        EpiDown E{(bf16_t*)(ws + WS_Y0), (bf16_t*)(ws + WS_Y1), stok};
        gemm_phase<false>(F.lds + RING_OFF, DEXP, S, E);
        if (PROBE_REPEAT == 9) gemm_phase<false>(F.lds + RING_OFF, DEXP, S, E);
        SEAM(9);
    }
    if (IN(10)) { const Ptrs P = args_unused.P; REPS(10) p10_combine(P, F); }
#undef IN
#undef SEAM
}
}
extern "C" void kernel_launch(void* const* d_in, const int* in_sizes, int n_in, void* d_out, int out_size, void* d_ws, size_t ws_size, hipStream_t stream) {
    if (n_in != 23 || out_size != M * DM || ws_size < WS_END) { fprintf(stderr, "kernel_launch: unexpected shapes (n_in %d out %d ws %zu)\n", n_in, out_size, ws_size); return; }
    static int grid = 0;
    if (grid == 0) {
        int dev = 0, cus = 0;
        if (hipGetDevice(&dev) != hipSuccess || hipDeviceGetAttribute(&cus, hipDeviceAttributeMultiprocessorCount, dev) != hipSuccess) { fprintf(stderr, "kernel_launch: device query failed\n"); grid = -1; return; }
        if (hipFuncSetAttribute((const void*)fk::fwd, hipFuncAttributeMaxDynamicSharedMemorySize, fk::LDS_BYTES) != hipSuccess) { fprintf(stderr, "kernel_launch: hipFuncSetAttribute failed\n"); grid = -1; return; }
        grid = cus;
    }
    if (grid < 0) return;
    Ptrs P{};
    P.x = (const float*)d_in[0]; P.c = (const float*)d_in[1]; P.pos = (const int*)d_in[2];
    P.w_ada = (const float*)d_in[3]; P.b_ada = (const float*)d_in[4]; P.norm1_g = (const float*)d_in[5]; P.w_in = (const float*)d_in[6]; P.conv_w = (const float*)d_in[7];
    P.q_a_g = (const float*)d_in[8]; P.w_q_b = (const float*)d_in[9]; P.kv_a_g = (const float*)d_in[10]; P.w_kv_b = (const float*)d_in[11]; P.q_g = (const float*)d_in[12]; P.k_g = (const float*)d_in[13];
    P.w_o = (const float*)d_in[14]; P.norm2_g = (const float*)d_in[15]; P.w_rg = (const float*)d_in[16]; P.b_rg = (const float*)d_in[17]; P.w_re = (const float*)d_in[18]; P.b_re = (const float*)d_in[19];
    P.w_gate = (const float*)d_in[20]; P.w_up = (const float*)d_in[21]; P.w_down = (const float*)d_in[22];
    P.out = (float*)d_out; P.ws = (unsigned char*)d_ws;
    (void)hipMemsetAsync((char*)d_ws + WS_CTL, 0, 1 * MiB, stream);
    fk::Args a{}; a.P = P; a.ph_lo = 0; a.ph_hi = fk::N_PHASES; a.li = 0;
    hipLaunchKernelGGL(fk::fwd, dim3(grid), dim3(fk::NWAVES * 64), fk::LDS_BYTES, stream, a);
}
```

```cpp
#define PROBE_REPEAT -1
#include <hip/hip_runtime.h>
#include <cstdio>
#include <cstdint>
#include <cmath>

constexpr int BATCH = 16, SEQ = 2048, DM = 1024, M = BATCH * SEQ;
constexpr int NH = 8, QKN = 128, QKR = 64, QKH = 192, VH = 128, QL = 384, KVL = 256;
constexpr int DIN = 5824, NEXP = 32, DEXP = 256;
constexpr int C_ZX = 0, C_ZB = 1024, C_ZC = 2048, C_QL = 3072, C_KVL = 3456, C_KR = 3712, C_GC = 3776, C_GM = 4800;
constexpr float EPS = 1e-6f;
constexpr int LATW = 768;

typedef unsigned short bf16_t;
typedef float f32x4 __attribute__((ext_vector_type(4)));

constexpr size_t MiB = 1u << 20;
constexpr size_t WS_CTL = 0;
constexpr size_t WS_MOD = 1 * MiB;
constexpr size_t WS_CS = 2 * MiB;
constexpr size_t WS_SSP = 10 * MiB;
constexpr size_t WS_RT = 12 * MiB;
constexpr size_t WS_WSMALL = 14 * MiB;
constexpr size_t WS_A = 32 * MiB;
constexpr size_t WS_B = 96 * MiB;
constexpr size_t WS_C = 288 * MiB;
constexpr size_t WS_D = 336 * MiB;
constexpr size_t WS_END = 496 * MiB;

__device__ __forceinline__ float bf2f(bf16_t v) { return __uint_as_float(((unsigned)v) << 16); }
__device__ __forceinline__ bf16_t f2bf(float f) { unsigned u = __float_as_uint(f); return (bf16_t)((u + 0x7fffu + ((u >> 16) & 1u)) >> 16); }

struct Ptrs {
    const float *x, *c; const int* pos;
    const float *w_ada, *b_ada, *norm1_g, *w_in, *conv_w, *q_a_g, *w_q_b, *kv_a_g, *w_kv_b, *q_g, *k_g, *w_o, *norm2_g;
    const float *w_rg, *b_rg, *w_re, *b_re, *w_gate, *w_up, *w_down;
    float* out; unsigned char* ws;
};

namespace fk {
#define LAS __attribute__((address_space(3)))
#define GAS __attribute__((address_space(1)))
typedef short bf16x8 __attribute__((ext_vector_type(8)));
typedef short s16x4 __attribute__((ext_vector_type(4)));
typedef unsigned u32x4 __attribute__((ext_vector_type(4)));
typedef unsigned u32x2 __attribute__((ext_vector_type(2)));
typedef float f32x2 __attribute__((ext_vector_type(2)));
typedef float f32x16 __attribute__((ext_vector_type(16)));
typedef GAS unsigned gu32;
#define RLX_AGENT __ATOMIC_RELAXED, __HIP_MEMORY_SCOPE_AGENT
constexpr int NWAVES = 8;
constexpr int BM = 256, BK = 64, HALF = 128, HTB = HALF * BK * 2, STAGE_BYTES = 8 * HTB, NXCD = 8, WGM = 8;
constexpr int RING_OFF = 0, RING_BYTES = 131072, XCH_OFF = 131072, XCH_BYTES = 8192, LDSCTL_OFF = XCH_OFF + XCH_BYTES, MISC_OFF = LDSCTL_OFF + 320, LDS_BYTES = 147456;
constexpr int CW_TMO = 0, CW_BAR = 4096;
constexpr int CW_HIST = 16384;
constexpr int CW_TILES = 40960;

typedef __bf16 bf16x2_t __attribute__((ext_vector_type(2)));
__device__ __forceinline__ unsigned cvt_pk_bf16(float lo, float hi) { f32x2 v = {lo, hi}; bf16x2_t b = __builtin_convertvector(v, bf16x2_t); return __builtin_bit_cast(unsigned, b); }
__device__ __forceinline__ float fsigmoid(float x) { return __builtin_amdgcn_rcpf(1.f + __expf(-x)); }

__host__ __device__ __forceinline__ int lds_byte(int r, int c) { const int st = (r >> 4) * 2 + (c >> 5), rr = r & 15, cc = c & 31, ob = rr * 64 + cc * 2; return st * 1024 + (ob ^ (((ob >> 9) & 1) << 5)); }
__host__ __device__ __forceinline__ void stage_rc(int b, int& R, int& C) { const int st = b / 1024, sb = b % 1024, swz = sb ^ (((sb >> 9) & 1) << 5); R = (st >> 1) * 16 + swz / 64; C = (st & 1) * 32 + (swz % 64) / 2; }
__host__ __device__ __forceinline__ int permL(int L) { return (L & 0xE0) | (((L >> 2) & 1) << 4) | (((L >> 3) & 3) << 2) | (L & 3); }

#define XB_TMO      128
#define XB_XCNT(j)  (256  + 64 * (j))
#define XB_XSUB(j)  (1280 + 64 * (j))
#define XB_XGEN(j)  (2304 + 64 * (j))
#define XB_TOP      3328
#define XB_TOPGEN   3392
#define XCD_BAR_WORDS 3456
#define XB_SPIN_CAP (1u << 18)
__device__ __forceinline__ unsigned xb_ld(unsigned* p)              { return __hip_atomic_load(p, __ATOMIC_RELAXED, __HIP_MEMORY_SCOPE_AGENT); }
__device__ __forceinline__ unsigned xb_add(unsigned* p, unsigned v) { return __hip_atomic_fetch_add(p, v, __ATOMIC_RELAXED, __HIP_MEMORY_SCOPE_AGENT); }
__device__ __forceinline__ unsigned xb_xcc_id() { return (unsigned)__builtin_amdgcn_s_getreg((3 << 11) | 20) & 0xFu; }
#define XB_SPIN(cond, bar) do { unsigned _sp = 0; while (cond) { __builtin_amdgcn_s_sleep(1); \
    if ((++_sp & 255u) == 0u) { if (xb_ld(&(bar)[XB_TMO])) break; if (_sp > XB_SPIN_CAP) { atomicAdd(&(bar)[XB_TMO], 1u); break; } } } } while (0)
struct XcdBarrier { unsigned* bar; unsigned x; volatile LAS unsigned* st; };
__device__ __forceinline__ XcdBarrier xcd_barrier_post(unsigned* bar, volatile LAS unsigned* st) {
    XcdBarrier b; b.bar = bar; b.x = xb_xcc_id(); b.st = st;
    if (threadIdx.x == 0) (void)xb_add(&bar[XB_XCNT(b.x)], 1u);
    return b;
}
__device__ __forceinline__ void xcd_barrier_complete(unsigned* bar, unsigned x, unsigned& nloc, unsigned& nx) {
    const unsigned G = gridDim.x * gridDim.y * gridDim.z;
    unsigned sum, cnt, mine, sp = 0u;
    for (;;) {
        sum = 0u; cnt = 0u; mine = 0u;
#pragma unroll
        for (unsigned j = 0; j < 16; ++j) { const unsigned c = xb_ld(&bar[XB_XCNT(j)]); sum += c; cnt += (c > 0u) ? 1u : 0u; mine = (j == x) ? c : mine; }
        if (sum == G) break;
        __builtin_amdgcn_s_sleep(1);
        if ((++sp & 255u) == 0u) { if (xb_ld(&bar[XB_TMO])) break; if (sp > XB_SPIN_CAP) { atomicAdd(&bar[XB_TMO], 1u); break; } }
    }
    nloc = mine > 0u ? mine : 1u; nx = cnt > 0u ? cnt : 1u;
}
__device__ __forceinline__ void xcd_barrier(const XcdBarrier& b) {
    asm volatile("s_waitcnt vmcnt(0)" ::: "memory");
    __syncthreads();
    if (threadIdx.x == 0) {
        unsigned* bar = b.bar;
        __builtin_amdgcn_s_waitcnt(0);
        unsigned nloc = b.st[0], nx = b.st[1];
        if (nloc == 0u) { xcd_barrier_complete(bar, b.x, nloc, nx); b.st[0] = nloc; b.st[1] = nx; }
        const unsigned old = xb_add(&bar[XB_XSUB(b.x)], 1u);
        const unsigned gen = old / nloc;
        if (old + 1u == (gen + 1u) * nloc) {
            __builtin_amdgcn_fence(__ATOMIC_RELEASE, "agent");
            asm volatile("s_waitcnt vmcnt(0)" ::: "memory");
            const unsigned og = xb_add(&bar[XB_TOP], 1u);
            const unsigned tg = og / nx;
            if (og + 1u == (tg + 1u) * nx) xb_add(&bar[XB_TOPGEN], 1u);
            else XB_SPIN(xb_ld(&bar[XB_TOPGEN]) == tg, bar);
            __builtin_amdgcn_fence(__ATOMIC_ACQUIRE, "agent");
            xb_add(&bar[XB_XGEN(b.x)], 1u);
            asm volatile("s_waitcnt vmcnt(0)" ::: "memory");
        } else {
            XB_SPIN(xb_ld(&bar[XB_XGEN(b.x)]) == gen, bar);
            __builtin_amdgcn_fence(__ATOMIC_ACQUIRE, "agent");
            asm volatile("s_waitcnt vmcnt(0)" ::: "memory");
        }
    }
    __syncthreads();
}

struct Unit { int pm, pn, aux, half; };
struct DenseSched {
    const bf16_t* A; const bf16_t* Bt; int lda, ldb; int nM, nN, nwg, G, c; bool split, pnflip;
    __device__ void init(const bf16_t* A_, int lda_, const bf16_t* Bt_, int ldb_, int M_, int N_, int G_, int c_, bool split_ = false, bool pnflip_ = false) {
        A = A_; Bt = Bt_; lda = lda_; ldb = ldb_; nM = M_ / BM; nN = N_ / BM; nwg = nM * nN; G = G_; c = c_; split = split_; pnflip = pnflip_; }
    __device__ bool next(int i, Unit& u) const {
        const int idx = i * G + c, nfull = (nwg / G) * G, tail = nwg - nfull; int L; u.half = 0;
        if (split && tail > 0 && 2 * tail <= G) { if (idx >= nfull + 2 * tail) return false; if (idx < nfull) L = idx; else { L = nfull + ((idx - nfull) >> 1); u.half = 1 + ((idx - nfull) & 1); } }
        else { if (idx >= nwg) return false; L = idx; }
        int wgid = L; { const int q = nwg / NXCD, r = nwg % NXCD, xcd = wgid % NXCD, off = wgid / NXCD; wgid = (xcd < r ? xcd * (q + 1) : r * (q + 1) + (xcd - r) * q) + off; }
        const int nig = WGM * nN, gid = wgid / nig, fm = gid * WGM, gsz = (nM - fm) < WGM ? (nM - fm) : WGM;
        u.pm = fm + ((wgid % nig) % gsz); u.pn = (wgid % nig) / gsz; if (pnflip) u.pn = nN - 1 - u.pn; u.aux = 0; return true;
    }
    __device__ __forceinline__ const char* abase(const Unit& u) const { return (const char*)A + (size_t)(u.pm * BM + (u.half == 2 ? HALF : 0)) * lda * 2; }
    __device__ __forceinline__ const char* bbase(const Unit& u) const { return (const char*)Bt + (size_t)u.pn * BM * ldb * 2; }
    __device__ __forceinline__ void avoff(const Unit& u, int R0, int C0, int R1, int C1, unsigned (&v0)[2], unsigned (&v1)[2]) const {
        v0[0] = (unsigned)(R0 * lda + C0) * 2u; v0[1] = (unsigned)(R1 * lda + C1) * 2u;
        const unsigned h1 = u.half ? 0u : (unsigned)(HALF * lda * 2);
        v1[0] = v0[0] + h1; v1[1] = v0[1] + h1; }
};

template <bool GATHER, class Epi, class Sched>
__device__ __forceinline__ void gemm_phase(LAS unsigned char* lds, const int K, const Sched& S, const Epi& E) {
    const int tid = threadIdx.x, wid = __builtin_amdgcn_readfirstlane(tid >> 6), lane = tid & 63, wr = wid >> 2, wc = wid & 3, fr = lane & 15, fq = lane >> 4;
    const int nt = K / BK;
    int R0, C0, R1, C1; stage_rc(tid * 16, R0, C0); stage_rc(tid * 16 + 8192, R1, C1);
    unsigned voffB[2]; voffB[0] = (unsigned)(R0 * S.ldb + C0) * 2u; voffB[1] = (unsigned)(R1 * S.ldb + C1) * 2u;
    const size_t kstep = (size_t)(BK * 2);
    const size_t hstepB = (size_t)HALF * S.ldb * 2;
    const unsigned ldsw = (unsigned)wid * 1024u;
    const int aoff = lds_byte(wr * 64 + fr, fq * 8), boff = lds_byte(wc * 32 + fr, fq * 8);
#define PG8_SA(b, h) (((b) * 2 + (h)) * HTB)
#define PG8_SB(b, h) ((4 + (b) * 2 + (h)) * HTB)
#define PG8_STAGE(bufoff, gbase, voff) do { _Pragma("unroll") for (int _i = 0; _i < 2; ++_i) \
        __builtin_amdgcn_global_load_lds((const unsigned*)((const char*)(gbase) + (voff)[_i]), (LAS unsigned*)(lds + (bufoff) + ldsw + _i * 8192), 16, 0, 0); } while (0)
#define PG8_LDA(dst, b, h) do { _Pragma("unroll") for (int m = 0; m < 4; ++m) _Pragma("unroll") for (int k = 0; k < 2; ++k) dst[m][k] = *(const LAS bf16x8*)(lds + PG8_SA(b, h) + aoff + m * 2048 + k * 1024); } while (0)
#define PG8_LDB(dst, b, h) do { _Pragma("unroll") for (int n = 0; n < 2; ++n) _Pragma("unroll") for (int k = 0; k < 2; ++k) dst[n][k] = *(const LAS bf16x8*)(lds + PG8_SB(b, h) + boff + n * 2048 + k * 1024); } while (0)
#define PG8_MMA(ai, bj, At, Bt) do { __builtin_amdgcn_s_setprio(1); _Pragma("unroll") for (int m = 0; m < 4; ++m) _Pragma("unroll") for (int n = 0; n < 2; ++n) _Pragma("unroll") for (int k = 0; k < 2; ++k) \
        acc[ai][bj][m][n] = __builtin_amdgcn_mfma_f32_16x16x32_bf16(Bt[n][k], At[m][k], acc[ai][bj][m][n], 0, 0, 0); __builtin_amdgcn_s_setprio(0); } while (0)
#define PG8_WAIT_V(n) asm volatile("s_waitcnt vmcnt(" #n ")" ::: "memory")
#define PG8_WAIT_L(n) asm volatile("s_waitcnt lgkmcnt(" #n ")" ::: "memory")
#define PG8_BAR __builtin_amdgcn_s_barrier()
#define PG8_SCHED __builtin_amdgcn_sched_barrier(0)
    Unit cur, nxt; int ui = 0;
    if (!S.next(0, cur)) return;
    f32x4 acc[2][2][4][2];
#pragma unroll
    for (int a = 0; a < 2; ++a)
#pragma unroll
        for (int b = 0; b < 2; ++b)
#pragma unroll
            for (int m = 0; m < 4; ++m)
#pragma unroll
                for (int n = 0; n < 2; ++n) acc[a][b][m][n] = (f32x4){0.f, 0.f, 0.f, 0.f};
    bf16x8 At[4][2], B0[2][2], B1[2][2];
    unsigned va0[2], va1[2], na0[2], na1[2];
    S.avoff(cur, R0, C0, R1, C1, va0, va1);
    na0[0] = va0[0]; na0[1] = va0[1]; na1[0] = va1[0]; na1[1] = va1[1];
    const char* cA = S.abase(cur); const char* cB = S.bbase(cur);
    PG8_STAGE(PG8_SB(0, 0), cB, voffB); PG8_STAGE(PG8_SB(0, 1), cB + hstepB, voffB); PG8_STAGE(PG8_SA(0, 0), cA, va0); PG8_STAGE(PG8_SA(0, 1), cA, va1);
    if (wr == 1) PG8_BAR;
    PG8_WAIT_V(2); PG8_BAR;
    PG8_STAGE(PG8_SB(1, 0), cB + kstep, voffB); PG8_STAGE(PG8_SA(1, 0), cA + kstep, va0); PG8_STAGE(PG8_SB(1, 1), cB + hstepB + kstep, voffB);
    PG8_WAIT_V(6); PG8_BAR;
    for (;;) {
        const bool has_next = S.next(ui + 1, nxt);
        const char* nA = has_next ? S.abase(nxt) : cA; const char* nB = has_next ? S.bbase(nxt) : cB;
        if (has_next) S.avoff(nxt, R0, C0, R1, C1, na0, na1);
        const bool hu = cur.half != 0;
#pragma unroll 1
        for (int t = 0; t < nt; t += 2) {
            const bool last = (t == nt - 2);
            const char* a1 = cA + (size_t)(t + 1) * kstep;
            const char* a2 = last ? nA : cA + (size_t)(t + 2) * kstep; const char* b2 = last ? nB : cB + (size_t)(t + 2) * kstep;
            const char* a3 = a2 + kstep; const char* b3 = b2 + kstep;
            unsigned x0[2], x1[2];
            x0[0] = last ? na0[0] : va0[0]; x0[1] = last ? na0[1] : va0[1]; x1[0] = last ? na1[0] : va1[0]; x1[1] = last ? na1[1] : va1[1];
            PG8_LDB(B0, 0, 0); PG8_LDB(B1, 0, 1); PG8_SCHED; PG8_LDA(At, 0, 0); PG8_STAGE(PG8_SA(1, 1), a1, va1);
            PG8_WAIT_V(8); PG8_WAIT_L(0); PG8_BAR; PG8_MMA(0, 0, At, B0); PG8_MMA(0, 1, At, B1); PG8_BAR; PG8_SCHED;
            if (!hu) PG8_LDA(At, 0, 1);
            PG8_STAGE(PG8_SB(0, 0), b2, voffB); PG8_STAGE(PG8_SB(0, 1), b2 + hstepB, voffB); PG8_STAGE(PG8_SA(0, 0), a2, x0);
            PG8_WAIT_V(8); PG8_WAIT_L(0); PG8_BAR; if (!hu) { PG8_MMA(1, 0, At, B0); PG8_MMA(1, 1, At, B1); } PG8_BAR; PG8_SCHED;
            PG8_LDB(B0, 1, 0); PG8_LDB(B1, 1, 1); PG8_SCHED; PG8_LDA(At, 1, 0); PG8_STAGE(PG8_SA(0, 1), a2, x1);
            PG8_WAIT_V(8); PG8_WAIT_L(0); PG8_BAR; PG8_MMA(0, 0, At, B0); PG8_MMA(0, 1, At, B1); PG8_BAR; PG8_SCHED;
            if (!hu) PG8_LDA(At, 1, 1);
            PG8_STAGE(PG8_SB(1, 0), b3, voffB); PG8_STAGE(PG8_SB(1, 1), b3 + hstepB, voffB); PG8_STAGE(PG8_SA(1, 0), a3, x0);
            PG8_WAIT_V(8); PG8_WAIT_L(0); PG8_BAR; if (!hu) { PG8_MMA(1, 0, At, B0); PG8_MMA(1, 1, At, B1); } PG8_BAR; PG8_SCHED;
        }
        if (wr == 0) PG8_BAR;
        E(acc, cur, wr, wc, fr, fq);
        if (!has_next) break;
#pragma unroll
        for (int a = 0; a < 2; ++a)
#pragma unroll
            for (int b = 0; b < 2; ++b)
#pragma unroll
                for (int m = 0; m < 4; ++m)
#pragma unroll
                    for (int n = 0; n < 2; ++n) acc[a][b][m][n] = (f32x4){0.f, 0.f, 0.f, 0.f};
        cur = nxt; cA = nA; cB = nB; ++ui;
        va0[0] = na0[0]; va0[1] = na0[1]; va1[0] = na1[0]; va1[1] = na1[1];
        if (wr == 1) PG8_BAR;
    }
    PG8_WAIT_V(0);
    PG8_BAR;
#undef PG8_SA
#undef PG8_SB
#undef PG8_STAGE
#undef PG8_LDA
#undef PG8_LDB
#undef PG8_MMA
#undef PG8_WAIT_V
#undef PG8_WAIT_L
#undef PG8_BAR
#undef PG8_SCHED
}

__device__ __forceinline__ u32x4 pack8(const f32x4 a, const f32x4 b) { u32x4 w; w.x = cvt_pk_bf16(a[0], a[1]); w.y = cvt_pk_bf16(a[2], a[3]); w.z = cvt_pk_bf16(b[0], b[1]); w.w = cvt_pk_bf16(b[2], b[3]); return w; }

struct EpiIn {
    bf16_t *u, *gb, *sg, *lat; float* rowstat; const float2* cs; const float* k_g; LAS float* xch;
    __device__ __forceinline__ void operator()(const f32x4 (&acc)[2][2][4][2], const Unit& un, int wr, int wc, int fr, int fq) const {
        asm volatile("" : "+v"(fr), "+v"(fq));
        const int row0 = un.pm * BM + wr * 64 + fr, pn = un.pn;
        if (pn < 16) {
            const int c0 = 128 * (pn & 7) + 32 * wc + 8 * fq; bf16_t* dst = pn < 8 ? u : gb; const int rh = row0 + (un.half == 2 ? HALF : 0);
#pragma unroll
            for (int ai = 0; ai < 2; ++ai)
#pragma unroll
                for (int m = 0; m < 4; ++m) { f32x4 r0, r1; if (ai == 1 && un.half) continue;
                    if (pn < 8) { r0 = acc[ai][0][m][0] * acc[ai][1][m][0]; r1 = acc[ai][0][m][1] * acc[ai][1][m][1]; }
                    else { const f32x4 g0 = acc[ai][1][m][0], g1 = acc[ai][1][m][1];
#pragma unroll
                        for (int i = 0; i < 4; ++i) { r0[i] = acc[ai][0][m][0][i] * fsigmoid(g0[i]); r1[i] = acc[ai][0][m][1][i] * fsigmoid(g1[i]); } }
                    __builtin_nontemporal_store(pack8(r0, r1), (u32x4*)(dst + (size_t)(rh + ai * HALF + m * 16) * DM + c0)); }
        } else if (pn < 20) {
            const int c0 = 256 * (pn - 16) + 32 * wc + 8 * fq;
#pragma unroll
            for (int ai = 0; ai < 2; ++ai)
#pragma unroll
                for (int m = 0; m < 4; ++m)
#pragma unroll
                    for (int bj = 0; bj < 2; ++bj) { f32x4 a = acc[ai][bj][m][0], b = acc[ai][bj][m][1];
#pragma unroll
                        for (int i = 0; i < 4; ++i) { a[i] = fsigmoid(a[i]); b[i] = fsigmoid(b[i]); }
                        __builtin_nontemporal_store(pack8(a, b), (u32x4*)(sg + (size_t)(row0 + ai * HALF + m * 16) * DM + c0 + bj * HALF)); }
        } else {
            const int c0 = 256 * (pn - 20) + 32 * wc + 8 * fq, rowt = wr * 64 + fr;
#pragma unroll
            for (int ai = 0; ai < 2; ++ai)
#pragma unroll
                for (int m = 0; m < 4; ++m) { const int rt = rowt + ai * HALF + m * 16, row = un.pm * BM + rt; float s0, s1;
                    { const f32x4 a = acc[ai][0][m][0], b = acc[ai][0][m][1]; *(u32x4*)(lat + (size_t)row * LATW + c0) = pack8(a, b);
                      s0 = (a[0] * a[0] + a[1] * a[1]) + (a[2] * a[2] + a[3] * a[3]) + (b[0] * b[0] + b[1] * b[1]) + (b[2] * b[2] + b[3] * b[3]); }
                    { const f32x4 a = acc[ai][1][m][0], b = acc[ai][1][m][1];
                      s1 = (a[0] * a[0] + a[1] * a[1]) + (a[2] * a[2] + a[3] * a[3]) + (b[0] * b[0] + b[1] * b[1]) + (b[2] * b[2] + b[3] * b[3]);
                      if (pn != 21) *(u32x4*)(lat + (size_t)row * LATW + c0 + HALF) = pack8(a, b);
                      else if (wc < 2) { const int j = 16 * wc + 4 * fq;
                          const f32x4 g1 = *(const f32x4*)(k_g + 128 + j), g2 = *(const f32x4*)(k_g + 160 + j);
                          const f32x4 cA = *(const f32x4*)((const float*)cs + ((size_t)row * 32 + j) * 2), cB = *(const f32x4*)((const float*)cs + ((size_t)row * 32 + j + 2) * 2);
                          const f32x4 x1 = a * g1, x2 = b * g2; f32x4 y1, y2;
                          y1[0] = x1[0] * cA[0] - x2[0] * cA[1]; y2[0] = x2[0] * cA[0] + x1[0] * cA[1]; y1[1] = x1[1] * cA[2] - x2[1] * cA[3]; y2[1] = x2[1] * cA[2] + x1[1] * cA[3];
                          y1[2] = x1[2] * cB[0] - x2[2] * cB[1]; y2[2] = x2[2] * cB[0] + x1[2] * cB[1]; y1[3] = x1[3] * cB[2] - x2[3] * cB[3]; y2[3] = x2[3] * cB[2] + x1[3] * cB[3];
                          u32x2 w1, w2; w1.x = cvt_pk_bf16(y1[0], y1[1]); w1.y = cvt_pk_bf16(y1[2], y1[3]); w2.x = cvt_pk_bf16(y2[0], y2[1]); w2.y = cvt_pk_bf16(y2[2], y2[3]);
                          *(u32x2*)(lat + (size_t)row * LATW + 384 + j) = w1; *(u32x2*)(lat + (size_t)row * LATW + 416 + j) = w2; } }
                    s0 += __shfl_xor(s0, 16); s0 += __shfl_xor(s0, 32); s1 += __shfl_xor(s1, 16); s1 += __shfl_xor(s1, 32);
                    if (fq == 0) { xch[rt * 8 + wc] = s0; xch[rt * 8 + 4 + wc] = s1; } }
            asm volatile("s_waitcnt lgkmcnt(0)" ::: "memory"); __builtin_amdgcn_s_barrier(); asm volatile("" ::: "memory");
            if (threadIdx.x < 256) { const int rt = threadIdx.x; const f32x4 p0 = *(const LAS f32x4*)(xch + rt * 8), p1 = *(const LAS f32x4*)(xch + rt * 8 + 4);
                const float S0 = (p0[0] + p0[1]) + (p0[2] + p0[3]), S1 = (p1[0] + p1[1]) + (p1[2] + p1[3]); float* st = rowstat + (size_t)(un.pm * BM + rt) * 4;
                if (pn == 20) st[0] = S0 + S1; else if (pn == 21) { st[1] = S0; st[2] = S1; } else st[3] = S0 + S1; }
        }
    }
};
struct EpiPlain {
    bf16_t* O; int ldc; int pnmask;
    __device__ __forceinline__ void operator()(const f32x4 (&acc)[2][2][4][2], const Unit& un, int wr, int wc, int fr, int fq) const {
        asm volatile("" : "+v"(fr), "+v"(fq));
        const int row0 = un.pm * BM + wr * 64 + fr, c0 = 256 * (un.pn & pnmask) + 32 * wc + 8 * fq;
#pragma unroll
        for (int ai = 0; ai < 2; ++ai)
#pragma unroll
            for (int m = 0; m < 4; ++m)
#pragma unroll
                for (int bj = 0; bj < 2; ++bj) __builtin_nontemporal_store(pack8(acc[ai][bj][m][0], acc[ai][bj][m][1]), (u32x4*)(O + (size_t)(row0 + ai * HALF + m * 16) * ldc + c0 + bj * HALF));
    }
};
struct EpiKV {
    bf16_t *Kb, *Vb; const bf16_t* lat; const float* rowstat; const float* k_g; LAS float* xch;
    __device__ __forceinline__ void operator()(const f32x4 (&acc)[2][2][4][2], const Unit& un, int wr, int wc, int fr, int fq) const {
        asm volatile("" : "+v"(fr), "+v"(fq));
        const int h = un.pn, rowt = wr * 64 + fr, b = (un.pm * BM) / SEQ, s0 = (un.pm * BM) % SEQ;
        f32x2 st[2][4];
        u32x4 rp[2][2];
#pragma unroll
        for (int ai = 0; ai < 2; ++ai) {
#pragma unroll
            for (int m = 0; m < 4; ++m) st[ai][m] = *(const f32x2*)(rowstat + (size_t)(un.pm * BM + rowt + ai * HALF + m * 16) * 4 + 2);
            const bf16_t* lr = lat + (size_t)(un.pm * BM + rowt + ai * HALF + wc * 16) * LATW + 384 + 16 * fq;
            rp[ai][0] = *(const u32x4*)lr; rp[ai][1] = *(const u32x4*)(lr + 8); }
#pragma unroll
        for (int ai = 0; ai < 2; ++ai)
#pragma unroll
            for (int m = 0; m < 4; ++m) {
                const f32x4 a = acc[ai][0][m][0], c = acc[ai][0][m][1];
                float ss = (a[0] * a[0] + a[1] * a[1]) + (a[2] * a[2] + a[3] * a[3]) + (c[0] * c[0] + c[1] * c[1]) + (c[2] * c[2] + c[3] * c[3]);
                ss += __shfl_xor(ss, 16); ss += __shfl_xor(ss, 32);
                if (fq == 0) xch[(rowt + ai * HALF + m * 16) * 4 + wc] = ss; }
        asm volatile("s_waitcnt lgkmcnt(0)" ::: "memory"); __builtin_amdgcn_s_barrier(); asm volatile("" ::: "memory");
        const int c8 = 32 * wc + 8 * fq;
        const f32x4 g0 = *(const f32x4*)(k_g + c8), g1 = *(const f32x4*)(k_g + c8 + 4);
#pragma unroll
        for (int ai = 0; ai < 2; ++ai)
#pragma unroll
            for (int m = 0; m < 4; ++m) { const int rt = rowt + ai * HALF + m * 16;
                const float rkv = __builtin_amdgcn_rsqf(st[ai][m][1] * (1.f / KVL) + EPS);
                const f32x4 t4 = *(const LAS f32x4*)(xch + rt * 4);
                const float rk = __builtin_amdgcn_rsqf((((t4[0] + t4[1]) + (t4[2] + t4[3])) * rkv * rkv + st[ai][m][0]) * (1.f / QKH) + EPS);
                const float sk = rkv * rk, sv = rkv;
                const size_t bhs = (size_t)(b * NH + h) * SEQ + s0 + rt;
                bf16_t* Kp = Kb + bhs * QKH; bf16_t* Vp = Vb + bhs * VH;
                *(u32x4*)(Kp + c8) = pack8(acc[ai][0][m][0] * sk * g0, acc[ai][0][m][1] * sk * g1);
                *(u32x4*)(Vp + c8) = pack8(acc[ai][1][m][0] * sv, acc[ai][1][m][1] * sv);
                if (m == wc) {
                    u32x4 o0, o1;
#pragma unroll
                    for (int e = 0; e < 4; ++e) { o0[e] = cvt_pk_bf16(__uint_as_float(rp[ai][0][e] << 16) * rk, __uint_as_float(rp[ai][0][e] & 0xffff0000u) * rk);
                                                  o1[e] = cvt_pk_bf16(__uint_as_float(rp[ai][1][e] << 16) * rk, __uint_as_float(rp[ai][1][e] & 0xffff0000u) * rk); }
                    *(u32x4*)(Kp + 128 + 16 * fq) = o0; *(u32x4*)(Kp + 128 + 16 * fq + 8) = o1; } }
    }
};
struct EpiNull {
    __device__ __forceinline__ void operator()(const f32x4 (&acc)[2][2][4][2], const Unit& un, int wr, int wc, int fr, int fq) const {
#pragma unroll
        for (int ai = 0; ai < 2; ++ai)
#pragma unroll
            for (int bj = 0; bj < 2; ++bj)
#pragma unroll
                for (int m = 0; m < 4; ++m) { f32x4 a = acc[ai][bj][m][0], b = acc[ai][bj][m][1]; asm volatile("" :: "v"(a), "v"(b)); }
    }
};
struct EpiDelta {
    const float* mod; bf16_t* delta;
    __device__ __forceinline__ void operator()(const f32x4 (&acc)[2][2][4][2], const Unit& un, int wr, int wc, int fr, int fq) const {
        asm volatile("" : "+v"(fr), "+v"(fq));
        const int row0 = un.pm * BM + wr * 64 + fr, b = (un.pm * BM) / SEQ, c0 = 256 * un.pn + 32 * wc + 8 * fq;
        const float* gate = mod + b * 6144 + 2048;
#pragma unroll
        for (int bj = 0; bj < 2; ++bj) { const f32x4 g0 = *(const f32x4*)(gate + c0 + bj * HALF), g1 = *(const f32x4*)(gate + c0 + bj * HALF + 4);
#pragma unroll
            for (int ai = 0; ai < 2; ++ai)
#pragma unroll
                for (int m = 0; m < 4; ++m) *(u32x4*)(delta + (size_t)(row0 + ai * HALF + m * 16) * DM + c0 + bj * HALF) = pack8(acc[ai][bj][m][0] * g0, acc[ai][bj][m][1] * g1); }
    }
};
namespace att {
constexpr int NW = 8, QBLK = 32, KVBLK = 64, KPITCH = 400;
constexpr int SHM_V = KVBLK * VH * 2, SHM_K = KVBLK * KPITCH;
constexpr int QRP = 144;
constexpr int OFF_V = 0, OFF_K = 2 * SHM_V, OFF_WS = OFF_K + 2 * SHM_K, OFF_QR = OFF_WS + NW * 64 * 4, ATT_LDS = OFF_QR + NW * 32 * QRP;
constexpr float SCALE = 0.07216878364870322f;
constexpr float THR = 8.f;
#define SBAR() __builtin_amdgcn_sched_barrier(0)
__device__ __forceinline__ int crow(int r, int hi) { return (r & 3) + 8 * (r >> 2) + 4 * hi; }
__device__ __forceinline__ void partialSM(f32x16& p0, f32x16& p1, float& m_reg, float& alpha) {
    constexpr float C = SCALE * 1.4426950408889634f;
    float pmax = p0[0];
#pragma unroll
    for (int r = 1; r < 16; ++r) pmax = fmaxf(pmax, p0[r]);
#pragma unroll
    for (int r = 0; r < 16; ++r) pmax = fmaxf(pmax, p1[r]);
    { auto rr = __builtin_amdgcn_permlane32_swap(__float_as_uint(pmax), __float_as_uint(pmax), false, false);
      pmax = fmaxf(__uint_as_float(rr[0]), __uint_as_float(rr[1])); }
    float mn;
    if (__builtin_expect(__all(pmax - m_reg <= THR / SCALE), 1)) { mn = m_reg; alpha = 1.f; }
    else { mn = fmaxf(m_reg, pmax); alpha = __builtin_amdgcn_exp2f((m_reg - mn) * C); m_reg = mn; }
    const float mnC = -mn * C;
#pragma unroll
    for (int r = 0; r < 16; ++r) p0[r] = fmaf(p0[r], C, mnC);
#pragma unroll
    for (int r = 0; r < 16; ++r) p1[r] = fmaf(p1[r], C, mnC);
#pragma unroll
    for (int r = 0; r < 16; ++r) p0[r] = __builtin_amdgcn_exp2f(p0[r]);
}
__device__ __forceinline__ void finishSM(f32x16& p0, f32x16& p1, float alpha, float& l_reg, bf16x8& pa0, bf16x8& pa1, bf16x8& pa2, bf16x8& pa3) {
#pragma unroll
    for (int r = 0; r < 16; ++r) p1[r] = __builtin_amdgcn_exp2f(p1[r]);
    float ps = 0;
#pragma unroll
    for (int r = 0; r < 16; ++r) ps += p0[r];
#pragma unroll
    for (int r = 0; r < 16; ++r) ps += p1[r];
    { auto rr = __builtin_amdgcn_permlane32_swap(__float_as_uint(ps), __float_as_uint(ps), false, false);
      ps = __uint_as_float(rr[0]) + __uint_as_float(rr[1]); }
    l_reg = l_reg * alpha + ps;
#define PK4(P, BASE, OUT) do { unsigned a0 = cvt_pk_bf16(P[BASE + 0], P[BASE + 1]), a1 = cvt_pk_bf16(P[BASE + 2], P[BASE + 3]);   \
    unsigned b0 = cvt_pk_bf16(P[BASE + 4], P[BASE + 5]), b1 = cvt_pk_bf16(P[BASE + 6], P[BASE + 7]);                              \
    auto r0 = __builtin_amdgcn_permlane32_swap(a0, b0, false, false); auto r1 = __builtin_amdgcn_permlane32_swap(a1, b1, false, false); \
    u32x4 w = {r0[0], r1[0], r0[1], r1[1]}; OUT = *reinterpret_cast<bf16x8*>(&w); } while (0)
    PK4(p0, 0, pa0); PK4(p0, 8, pa1); PK4(p1, 0, pa2); PK4(p1, 8, pa3);
#undef PK4
}
__device__ __forceinline__ void qkt(f32x16& p0, f32x16& p1, const LAS char* Ks, const bf16x8 (&qr)[8], const LAS char* qrope, int r32, int hi) {
    p0 = f32x16{}; p1 = f32x16{};
    const LAS char* k0 = Ks + r32 * KPITCH + hi * 16;
#pragma unroll
    for (int d0 = 0; d0 < 8; ++d0) {
        const bf16x8 b0 = *(const LAS bf16x8*)(k0 + d0 * 32);
        const bf16x8 b1 = *(const LAS bf16x8*)(k0 + 32 * KPITCH + d0 * 32);
        p0 = __builtin_amdgcn_mfma_f32_32x32x16_bf16(b0, qr[d0], p0, 0, 0, 0);
        p1 = __builtin_amdgcn_mfma_f32_32x32x16_bf16(b1, qr[d0], p1, 0, 0, 0); }
#pragma unroll
    for (int d0 = 8; d0 < 12; ++d0) {
        const bf16x8 b0 = *(const LAS bf16x8*)(k0 + d0 * 32);
        const bf16x8 b1 = *(const LAS bf16x8*)(k0 + 32 * KPITCH + d0 * 32);
        const bf16x8 qf = *(const LAS bf16x8*)(qrope + (d0 - 8) * 32);
        p0 = __builtin_amdgcn_mfma_f32_32x32x16_bf16(b0, qf, p0, 0, 0, 0);
        p1 = __builtin_amdgcn_mfma_f32_32x32x16_bf16(b1, qf, p1, 0, 0, 0); }
}
__device__ __forceinline__ int v_st(int k, int c) { const int kk = (k & ~0xC) | ((k & 4) << 1) | ((k & 8) >> 1); return ((kk >> 3) * 4 + (c >> 5)) * 512 + ((kk & 7) * 32 + (c & 31)) * 2; }
__device__ __forceinline__ int v_rd_base(int lane) { return ((lane & 3) << 3) | (((lane >> 2) & 3) << 6) | (((lane >> 4) & 1) << 5) | (((lane >> 5) & 1) << 8); }
constexpr int v_rd_off(int d0, int ks, int half) { return d0 * 512 + ks * 4096 + half * 2048; }
template <int OFF> __device__ __forceinline__ s16x4 tr_read(int vb) {
    s16x4 r; asm volatile("ds_read_b64_tr_b16 %0, %1 offset:%2" : "=&v"(r) : "v"(vb), "i"(OFF) : "memory"); return r;
}
template <int D0> __device__ __forceinline__ void pv_one(f32x16& od, int vb, bf16x8 pa0, bf16x8 pa1, bf16x8 pa2, bf16x8 pa3) {
    const s16x4 l0 = tr_read<v_rd_off(D0, 0, 0)>(vb), h0 = tr_read<v_rd_off(D0, 0, 1)>(vb), l1 = tr_read<v_rd_off(D0, 1, 0)>(vb), h1 = tr_read<v_rd_off(D0, 1, 1)>(vb);
    const s16x4 l2 = tr_read<v_rd_off(D0, 2, 0)>(vb), h2 = tr_read<v_rd_off(D0, 2, 1)>(vb), l3 = tr_read<v_rd_off(D0, 3, 0)>(vb), h3 = tr_read<v_rd_off(D0, 3, 1)>(vb);
    asm volatile("s_waitcnt lgkmcnt(0)" ::: "memory"); SBAR();
#define PK(L, H) (bf16x8){L[0], L[1], L[2], L[3], H[0], H[1], H[2], H[3]}
    od = __builtin_amdgcn_mfma_f32_32x32x16_bf16(pa0, PK(l0, h0), od, 0, 0, 0);
    od = __builtin_amdgcn_mfma_f32_32x32x16_bf16(pa1, PK(l1, h1), od, 0, 0, 0);
    od = __builtin_amdgcn_mfma_f32_32x32x16_bf16(pa2, PK(l2, h2), od, 0, 0, 0);
    od = __builtin_amdgcn_mfma_f32_32x32x16_bf16(pa3, PK(l3, h3), od, 0, 0, 0);
#undef PK
}
__device__ __forceinline__ void pv_d0(f32x16 (&o)[4], int vb, bf16x8 pa0, bf16x8 pa1, bf16x8 pa2, bf16x8 pa3) {
    pv_one<0>(o[0], vb, pa0, pa1, pa2, pa3); pv_one<1>(o[1], vb, pa0, pa1, pa2, pa3); pv_one<2>(o[2], vb, pa0, pa1, pa2, pa3); pv_one<3>(o[3], vb, pa0, pa1, pa2, pa3);
}
__device__ __forceinline__ float bflo(unsigned w) { return __uint_as_float(w << 16); }
__device__ __forceinline__ float bfhi(unsigned w) { return __uint_as_float(w & 0xffff0000u); }

struct AttnArgs { const bf16_t* Q; const bf16_t* Kb; const bf16_t* Vb; const float* ssp; const float2* cs; const float* q_g; const bf16_t *u, *gb, *sg; const float* conv_w; bf16_t* merged; };

template <int MODE> __device__ __forceinline__ void attn_unit(const AttnArgs& T, int b, int h, int qb, LAS char* lds) {
    int tid = threadIdx.x; asm volatile("" : "+v"(tid));
    const int lane = tid & 63, r32 = lane & 31, hi = lane >> 5; const int wid = __builtin_amdgcn_readfirstlane(tid >> 6);
    LAS char* V_lds = lds + OFF_V; LAS char* K_lds = lds + OFF_K;
    LAS float* ws = (LAS float*)(lds + OFF_WS) + wid * 64; LAS float* li_l = ws; LAS float* al_l = ws + 32;
    const int mrow = b * SEQ + qb * 256 + wid * QBLK + r32;
    const bf16_t* Kh = T.Kb + (size_t)(b * NH + h) * SEQ * QKH; const bf16_t* Vh = T.Vb + (size_t)(b * NH + h) * SEQ * VH;
    const int sr = tid >> 4, sc = (tid & 15) * 8, vst0 = v_st(sr, sc), vst1 = v_st(32 + sr, sc);
    const int kdst = (tid >> 3) * KPITCH + (tid & 7) * 48;
    const int vb0 = (int)(uintptr_t)V_lds + v_rd_base(lane);
    bf16x8 sk0, sk1, sk2, sv0, sv1;
#define SLOAD(t) do { const bf16_t* kp = Kh + (size_t)(t) * KVBLK * QKH + tid * 24; sk0 = *(const bf16x8*)kp; sk1 = *(const bf16x8*)(kp + 8); sk2 = *(const bf16x8*)(kp + 16); \
    const bf16_t* vp = Vh + (size_t)((t) * KVBLK + sr) * VH + sc; sv0 = *(const bf16x8*)vp; sv1 = *(const bf16x8*)(vp + 32 * VH); } while (0)
#define SWRITE(bf) do { *(LAS bf16x8*)(V_lds + (bf) * SHM_V + vst0) = sv0; *(LAS bf16x8*)(V_lds + (bf) * SHM_V + vst1) = sv1; \
    *(LAS bf16x8*)(K_lds + (bf) * SHM_K + kdst) = sk0; *(LAS bf16x8*)(K_lds + (bf) * SHM_K + kdst + 16) = sk1; *(LAS bf16x8*)(K_lds + (bf) * SHM_K + kdst + 32) = sk2; } while (0)
#define RESC(a) do { if (__any((a) < 1.f)) { if (hi == 0) al_l[r32] = (a); asm volatile("s_waitcnt lgkmcnt(0)" ::: "memory"); \
    _Pragma("unroll") for (int d = 0; d < 4; ++d) _Pragma("unroll") for (int r = 0; r < 16; ++r) o[d][r] *= al_l[crow(r, hi)]; } } while (0)
    SLOAD(0);
    bf16x8 qr[8];
    LAS char* qrope = lds + OFF_QR + wid * (32 * QRP) + r32 * QRP + hi * 16;
    {
        const bf16_t* Qw = T.Q + (size_t)mrow * 1536 + h * QKH + hi * 8;
        u32x4 raw[12];
#pragma unroll
        for (int d0 = 0; d0 < 12; ++d0) raw[d0] = *(const u32x4*)(Qw + d0 * 16);
        const f32x2 sq2 = *(const f32x2*)(T.ssp + (size_t)mrow * 4); const float ssq = sq2[0] + sq2[1];
        float ss = 0.f;
#pragma unroll
        for (int d0 = 0; d0 < 12; ++d0)
#pragma unroll
            for (int e = 0; e < 4; ++e) { const float a = bflo(raw[d0][e]), c = bfhi(raw[d0][e]); ss += a * a + c * c; }
        { auto rr = __builtin_amdgcn_permlane32_swap(__float_as_uint(ss), __float_as_uint(ss), false, false); ss = __uint_as_float(rr[0]) + __uint_as_float(rr[1]); }
        const float rq2 = 1.f / (ssq * (1.f / QL) + EPS);
        const float rn = 1.f / sqrtf(ss * rq2 * (1.f / QKH) + EPS) * sqrtf(rq2);
#pragma unroll
        for (int d0 = 0; d0 < 8; ++d0) { const f32x4 g0 = *(const f32x4*)(T.q_g + d0 * 16 + hi * 8), g1 = *(const f32x4*)(T.q_g + d0 * 16 + hi * 8 + 4);
            u32x4 w; w.x = cvt_pk_bf16(bflo(raw[d0].x) * rn * g0[0], bfhi(raw[d0].x) * rn * g0[1]); w.y = cvt_pk_bf16(bflo(raw[d0].y) * rn * g0[2], bfhi(raw[d0].y) * rn * g0[3]);
            w.z = cvt_pk_bf16(bflo(raw[d0].z) * rn * g1[0], bfhi(raw[d0].z) * rn * g1[1]); w.w = cvt_pk_bf16(bflo(raw[d0].w) * rn * g1[2], bfhi(raw[d0].w) * rn * g1[3]);
            qr[d0] = *reinterpret_cast<bf16x8*>(&w); }
#pragma unroll
        for (int p = 0; p < 2; ++p) {
            const int ib = 16 * p + 8 * hi;
            float x1[8], x2[8];
            const f32x4 ga = *(const f32x4*)(T.q_g + 128 + ib), gb_ = *(const f32x4*)(T.q_g + 128 + ib + 4), gc = *(const f32x4*)(T.q_g + 160 + ib), gd = *(const f32x4*)(T.q_g + 160 + ib + 4);
            const float g1v[8] = {ga[0], ga[1], ga[2], ga[3], gb_[0], gb_[1], gb_[2], gb_[3]}, g2v[8] = {gc[0], gc[1], gc[2], gc[3], gd[0], gd[1], gd[2], gd[3]};
#pragma unroll
            for (int e = 0; e < 4; ++e) { x1[2 * e] = bflo(raw[8 + p][e]) * rn * g1v[2 * e]; x1[2 * e + 1] = bfhi(raw[8 + p][e]) * rn * g1v[2 * e + 1];
                                          x2[2 * e] = bflo(raw[10 + p][e]) * rn * g2v[2 * e]; x2[2 * e + 1] = bfhi(raw[10 + p][e]) * rn * g2v[2 * e + 1]; }
            float y1[8], y2[8];
#pragma unroll
            for (int jj = 0; jj < 4; ++jj) { const f32x4 c2 = *(const f32x4*)((const float*)T.cs + ((size_t)mrow * 32 + ib + 2 * jj) * 2);
                y1[2 * jj] = x1[2 * jj] * c2[0] - x2[2 * jj] * c2[1]; y2[2 * jj] = x2[2 * jj] * c2[0] + x1[2 * jj] * c2[1];
                y1[2 * jj + 1] = x1[2 * jj + 1] * c2[2] - x2[2 * jj + 1] * c2[3]; y2[2 * jj + 1] = x2[2 * jj + 1] * c2[2] + x1[2 * jj + 1] * c2[3]; }
            u32x4 w1, w2; w1.x = cvt_pk_bf16(y1[0], y1[1]); w1.y = cvt_pk_bf16(y1[2], y1[3]); w1.z = cvt_pk_bf16(y1[4], y1[5]); w1.w = cvt_pk_bf16(y1[6], y1[7]);
            w2.x = cvt_pk_bf16(y2[0], y2[1]); w2.y = cvt_pk_bf16(y2[2], y2[3]); w2.z = cvt_pk_bf16(y2[4], y2[5]); w2.w = cvt_pk_bf16(y2[6], y2[7]);
            *(LAS u32x4*)(qrope + p * 32) = w1; *(LAS u32x4*)(qrope + (2 + p) * 32) = w2; }
        asm volatile("s_waitcnt lgkmcnt(0)" ::: "memory");
    }
    float m_reg = -1e30f, l_reg = 0.f; f32x16 o[4] = {};
    f32x16 pA0, pA1, pB0, pB1; float alA = 1.f, alB = 1.f; bf16x8 pa0, pa1, pa2, pa3;
    const int NT = 4 * qb + 4; const int wp = wid >> 1;
    const bool a1 = wp >= 1, a2 = wp >= 2, a3 = wp >= 3;
    const LAS char* K0 = K_lds; const LAS char* K1 = K_lds + SHM_K;
    asm volatile("s_waitcnt vmcnt(0)" ::: "memory"); SWRITE(0); __syncthreads();
    qkt(pA0, pA1, K0, qr, qrope, r32, hi); partialSM(pA0, pA1, m_reg, alA);
    SLOAD(1); asm volatile("s_waitcnt vmcnt(0)" ::: "memory"); SWRITE(1); __syncthreads();
    for (int j = 1; j + 3 < NT; j += 2) {
        SBAR(); qkt(pB0, pB1, K1, qr, qrope, r32, hi);
        finishSM(pA0, pA1, alA, l_reg, pa0, pa1, pa2, pa3); SBAR();
        SLOAD(j + 1); SBAR();
        pv_d0(o, vb0, pa0, pa1, pa2, pa3); partialSM(pB0, pB1, m_reg, alB);
        __syncthreads(); asm volatile("s_waitcnt vmcnt(0)" ::: "memory"); SWRITE(0);
        RESC(alB); __syncthreads();
        SBAR(); qkt(pA0, pA1, K0, qr, qrope, r32, hi);
        finishSM(pB0, pB1, alB, l_reg, pa0, pa1, pa2, pa3); SBAR();
        SLOAD(j + 2); SBAR();
        pv_d0(o, vb0 + SHM_V, pa0, pa1, pa2, pa3); partialSM(pA0, pA1, m_reg, alA);
        __syncthreads(); asm volatile("s_waitcnt vmcnt(0)" ::: "memory"); SWRITE(1);
        RESC(alA); __syncthreads();
    }
#define MASK(P0, P1, act) do { if (!(act)) { _Pragma("unroll") for (int r = 0; r < 16; ++r) { P0[r] = -INFINITY; P1[r] = -INFINITY; } } } while (0)
    {
        SBAR(); if (a1) qkt(pB0, pB1, K1, qr, qrope, r32, hi); MASK(pB0, pB1, a1);
        finishSM(pA0, pA1, alA, l_reg, pa0, pa1, pa2, pa3); SBAR();
        SLOAD(NT - 2); SBAR();
        pv_d0(o, vb0, pa0, pa1, pa2, pa3); partialSM(pB0, pB1, m_reg, alB);
        __syncthreads(); asm volatile("s_waitcnt vmcnt(0)" ::: "memory"); SWRITE(0);
        RESC(alB); __syncthreads();
        SBAR(); if (a2) qkt(pA0, pA1, K0, qr, qrope, r32, hi); MASK(pA0, pA1, a2);
        finishSM(pB0, pB1, alB, l_reg, pa0, pa1, pa2, pa3); SBAR();
        SLOAD(NT - 1); SBAR();
        pv_d0(o, vb0 + SHM_V, pa0, pa1, pa2, pa3); partialSM(pA0, pA1, m_reg, alA);
        __syncthreads(); asm volatile("s_waitcnt vmcnt(0)" ::: "memory"); SWRITE(1);
        RESC(alA); __syncthreads();
        SBAR(); if (a3) qkt(pB0, pB1, K1, qr, qrope, r32, hi); MASK(pB0, pB1, a3);
        finishSM(pA0, pA1, alA, l_reg, pa0, pa1, pa2, pa3); SBAR();
        pv_d0(o, vb0, pa0, pa1, pa2, pa3); partialSM(pB0, pB1, m_reg, alB);
        RESC(alB);
        finishSM(pB0, pB1, alB, l_reg, pa0, pa1, pa2, pa3); SBAR();
        pv_d0(o, vb0 + SHM_V, pa0, pa1, pa2, pa3);
    }
#undef MASK
    if (hi == 0) li_l[r32] = l_reg; asm volatile("s_waitcnt lgkmcnt(0)" ::: "memory");
    float rli[16];
#pragma unroll
    for (int r = 0; r < 16; ++r) rli[r] = __builtin_amdgcn_rcpf(li_l[crow(r, hi)]);
    __syncthreads();
    LAS bf16_t* stg = (LAS bf16_t*)(lds + wid * 8192);
#pragma unroll
    for (int r = 0; r < 16; ++r) { const int orow = crow(r, hi);
#pragma unroll
        for (int d0 = 0; d0 < 4; ++d0) stg[orow * 128 + d0 * 32 + r32] = f2bf(o[d0][r] * rli[r]); }
    asm volatile("s_waitcnt lgkmcnt(0)" ::: "memory");
    if (MODE != 1) {
        const int ch = lane & 15, c = h * VH + ch * 8;
        const f32x4 w0a = *(const f32x4*)(T.conv_w + c), w0b = *(const f32x4*)(T.conv_w + c + 4), w1a = *(const f32x4*)(T.conv_w + DM + c), w1b = *(const f32x4*)(T.conv_w + DM + c + 4),
              w2a = *(const f32x4*)(T.conv_w + 2 * DM + c), w2b = *(const f32x4*)(T.conv_w + 2 * DM + c + 4);
        const float cw0[8] = {w0a[0], w0a[1], w0a[2], w0a[3], w0b[0], w0b[1], w0b[2], w0b[3]}, cw1[8] = {w1a[0], w1a[1], w1a[2], w1a[3], w1b[0], w1b[1], w1b[2], w1b[3]},
                    cw2[8] = {w2a[0], w2a[1], w2a[2], w2a[3], w2b[0], w2b[1], w2b[2], w2b[3]};
#pragma unroll 4
        for (int i = 0; i < 8; ++i) { const int row = i * 4 + (lane >> 4); const int tt = qb * 256 + wid * QBLK + row; const size_t e = (size_t)(b * SEQ + tt) * DM + c;
            const u32x4 ov = *(const LAS u32x4*)(stg + row * 128 + ch * 8);
            const u32x4 u0 = *(const u32x4*)(T.u + e), gbv = *(const u32x4*)(T.gb + e), sgv = *(const u32x4*)(T.sg + e);
            u32x4 u1 = {0u, 0u, 0u, 0u}, u2 = {0u, 0u, 0u, 0u};
            if (tt >= 1) u1 = *(const u32x4*)(T.u + e - DM);
            if (tt >= 2) u2 = *(const u32x4*)(T.u + e - 2 * DM);
            u32x4 res;
#pragma unroll
            for (int q = 0; q < 4; ++q) {
                const float cl = cw0[2 * q] * bflo(u2[q]) + cw1[2 * q] * bflo(u1[q]) + cw2[2 * q] * bflo(u0[q]), chh = cw0[2 * q + 1] * bfhi(u2[q]) + cw1[2 * q + 1] * bfhi(u1[q]) + cw2[2 * q + 1] * bfhi(u0[q]);
                res[q] = cvt_pk_bf16(bflo(gbv[q]) * cl + bflo(sgv[q]) * bflo(ov[q]), bfhi(gbv[q]) * chh + bfhi(sgv[q]) * bfhi(ov[q])); }
            *(u32x4*)(T.merged + e) = res; }
    }
    asm volatile("s_waitcnt lgkmcnt(0)" ::: "memory");
    __syncthreads();
#undef SLOAD
#undef SWRITE
#undef RESC
}

constexpr int K2_BYTES = KVBLK * QKH * 2, V2_OFF = 0, K2_OFF = 3 * SHM_V, WS2_OFF = K2_OFF + 2 * K2_BYTES, ATT2_LDS = WS2_OFF + NW * 64 * 4;
__device__ __forceinline__ void qkt2(f32x16& p0, f32x16& p1, const LAS char* Krow, const int (&koff)[4], const bf16x8 (&qr)[12]) {
    p0 = f32x16{}; p1 = f32x16{};
    bf16x8 fa[4], fb[4];
#define KRD(dst, d0) do { const LAS char* a_ = Krow + ((d0) >> 2) * 128 + koff[(d0) & 3]; dst[0] = *(const LAS bf16x8*)a_; dst[1] = *(const LAS bf16x8*)(a_ + 32 * QKH * 2); \
                          const LAS char* c_ = Krow + (((d0) + 1) >> 2) * 128 + koff[((d0) + 1) & 3]; dst[2] = *(const LAS bf16x8*)c_; dst[3] = *(const LAS bf16x8*)(c_ + 32 * QKH * 2); } while (0)
#define KMM(src, d0) do { p0 = __builtin_amdgcn_mfma_f32_32x32x16_bf16(src[0], qr[d0], p0, 0, 0, 0); p1 = __builtin_amdgcn_mfma_f32_32x32x16_bf16(src[1], qr[d0], p1, 0, 0, 0); \
                          p0 = __builtin_amdgcn_mfma_f32_32x32x16_bf16(src[2], qr[(d0) + 1], p0, 0, 0, 0); p1 = __builtin_amdgcn_mfma_f32_32x32x16_bf16(src[3], qr[(d0) + 1], p1, 0, 0, 0); } while (0)
    KRD(fa, 0); KRD(fb, 2);
    KMM(fa, 0); KRD(fa, 4);
    KMM(fb, 2); KRD(fb, 6);
    KMM(fa, 4); KRD(fa, 8);
    KMM(fb, 6); KRD(fb, 10);
    KMM(fa, 8);
    KMM(fb, 10);
#undef KRD
#undef KMM
}
template <int MODE> __device__ __forceinline__ void attn_unit2(const AttnArgs& T, int b, int h, int qb, LAS char* lds) {
    int tid = threadIdx.x; asm volatile("" : "+v"(tid));
    const int lane = tid & 63, r32 = lane & 31, hi = lane >> 5; const int wid = __builtin_amdgcn_readfirstlane(tid >> 6);
    LAS char* V_lds = lds + V2_OFF; LAS char* K_lds = lds + K2_OFF;
    LAS float* ws = (LAS float*)(lds + WS2_OFF) + wid * 64; LAS float* li_l = ws; LAS float* al_l = ws + 32;
    const int mrow = b * SEQ + qb * 256 + wid * QBLK + r32;
    const char* Kh = (const char*)(T.Kb + (size_t)(b * NH + h) * SEQ * QKH); const char* Vh = (const char*)(T.Vb + (size_t)(b * NH + h) * SEQ * VH);
#define DMA_KV(t, kbuf, vbuf) do { const char* kt = Kh + (size_t)(t) * K2_BYTES; const char* vt = Vh + (size_t)(t) * SHM_V; int ln = lane; asm volatile("" : "+v"(ln)); \
    _Pragma("unroll") for (int _i = 0; _i < 3; ++_i) { const int q = (wid * 3 + _i) * 64 + ln, r = q / 24, cp = q - r * 24, c = (cp & ~7) | ((cp & 7) ^ ((r >> 1) & 7)); \
        __builtin_amdgcn_global_load_lds((const unsigned*)(kt + (unsigned)(r * 384 + c * 16)), (LAS unsigned*)(K_lds + (kbuf) * K2_BYTES + (wid * 3 + _i) * 1024), 16, 0, 0); } \
    _Pragma("unroll") for (int _i = 0; _i < 2; ++_i) { const int q = (wid * 2 + _i) * 64 + ln, sub = q >> 5, w = q & 31, kk = ((sub >> 2) << 3) | (w >> 2), k = (kk & ~0xC) | ((kk & 4) << 1) | ((kk & 8) >> 1), c = ((sub & 3) << 5) | ((w & 3) << 3); \
        __builtin_amdgcn_global_load_lds((const unsigned*)(vt + (unsigned)(k * 256 + c * 2)), (LAS unsigned*)(V_lds + (vbuf) * SHM_V + (wid * 2 + _i) * 1024), 16, 0, 0); } } while (0)
#define RESC(a) do { if (__any((a) < 1.f)) { if (hi == 0) al_l[r32] = (a); asm volatile("s_waitcnt lgkmcnt(0)" ::: "memory"); \
    _Pragma("unroll") for (int d = 0; d < 4; ++d) _Pragma("unroll") for (int r = 0; r < 16; ++r) o[d][r] *= al_l[crow(r, hi)]; } } while (0)
    DMA_KV(0, 0, 0);
    const int vb0 = (int)(uintptr_t)V_lds + v_rd_base(lane);
    const LAS char* Krow = K_lds + r32 * (QKH * 2);
    int koff[4];
    { const int sw = (r32 >> 1) & 7;
#pragma unroll
      for (int j = 0; j < 4; ++j) koff[j] = ((2 * j + hi) ^ sw) * 16; }
    bf16x8 qr[12];
    {
        const bf16_t* Qw = T.Q + (size_t)mrow * 1536 + h * QKH + hi * 8;
        u32x4 raw[12];
#pragma unroll
        for (int d0 = 0; d0 < 12; ++d0) raw[d0] = *(const u32x4*)(Qw + d0 * 16);
        const f32x2 sq2 = *(const f32x2*)(T.ssp + (size_t)mrow * 4); const float ssq = sq2[0] + sq2[1];
        float ss = 0.f;
#pragma unroll
        for (int d0 = 0; d0 < 12; ++d0)
#pragma unroll
            for (int e = 0; e < 4; ++e) { const float a = bflo(raw[d0][e]), c = bfhi(raw[d0][e]); ss += a * a + c * c; }
        { auto rr = __builtin_amdgcn_permlane32_swap(__float_as_uint(ss), __float_as_uint(ss), false, false); ss = __uint_as_float(rr[0]) + __uint_as_float(rr[1]); }
        const float rq2 = 1.f / (ssq * (1.f / QL) + EPS);
        const float rn = 1.f / sqrtf(ss * rq2 * (1.f / QKH) + EPS) * sqrtf(rq2);
#pragma unroll
        for (int d0 = 0; d0 < 8; ++d0) { const f32x4 g0 = *(const f32x4*)(T.q_g + d0 * 16 + hi * 8), g1 = *(const f32x4*)(T.q_g + d0 * 16 + hi * 8 + 4);
            u32x4 w; w.x = cvt_pk_bf16(bflo(raw[d0].x) * rn * g0[0], bfhi(raw[d0].x) * rn * g0[1]); w.y = cvt_pk_bf16(bflo(raw[d0].y) * rn * g0[2], bfhi(raw[d0].y) * rn * g0[3]);
            w.z = cvt_pk_bf16(bflo(raw[d0].z) * rn * g1[0], bfhi(raw[d0].z) * rn * g1[1]); w.w = cvt_pk_bf16(bflo(raw[d0].w) * rn * g1[2], bfhi(raw[d0].w) * rn * g1[3]);
            qr[d0] = *reinterpret_cast<bf16x8*>(&w); }
#pragma unroll
        for (int p = 0; p < 2; ++p) {
            const int ib = 16 * p + 8 * hi;
            float x1[8], x2[8];
            const f32x4 ga = *(const f32x4*)(T.q_g + 128 + ib), gb_ = *(const f32x4*)(T.q_g + 128 + ib + 4), gc = *(const f32x4*)(T.q_g + 160 + ib), gd = *(const f32x4*)(T.q_g + 160 + ib + 4);
            const float g1v[8] = {ga[0], ga[1], ga[2], ga[3], gb_[0], gb_[1], gb_[2], gb_[3]}, g2v[8] = {gc[0], gc[1], gc[2], gc[3], gd[0], gd[1], gd[2], gd[3]};
#pragma unroll
            for (int e = 0; e < 4; ++e) { x1[2 * e] = bflo(raw[8 + p][e]) * rn * g1v[2 * e]; x1[2 * e + 1] = bfhi(raw[8 + p][e]) * rn * g1v[2 * e + 1];
                                          x2[2 * e] = bflo(raw[10 + p][e]) * rn * g2v[2 * e]; x2[2 * e + 1] = bfhi(raw[10 + p][e]) * rn * g2v[2 * e + 1]; }
            float y1[8], y2[8];
#pragma unroll
            for (int jj = 0; jj < 4; ++jj) { const f32x4 c2 = *(const f32x4*)((const float*)T.cs + ((size_t)mrow * 32 + ib + 2 * jj) * 2);
                y1[2 * jj] = x1[2 * jj] * c2[0] - x2[2 * jj] * c2[1]; y2[2 * jj] = x2[2 * jj] * c2[0] + x1[2 * jj] * c2[1];
                y1[2 * jj + 1] = x1[2 * jj + 1] * c2[2] - x2[2 * jj + 1] * c2[3]; y2[2 * jj + 1] = x2[2 * jj + 1] * c2[2] + x1[2 * jj + 1] * c2[3]; }
            u32x4 w1, w2; w1.x = cvt_pk_bf16(y1[0], y1[1]); w1.y = cvt_pk_bf16(y1[2], y1[3]); w1.z = cvt_pk_bf16(y1[4], y1[5]); w1.w = cvt_pk_bf16(y1[6], y1[7]);
            w2.x = cvt_pk_bf16(y2[0], y2[1]); w2.y = cvt_pk_bf16(y2[2], y2[3]); w2.z = cvt_pk_bf16(y2[4], y2[5]); w2.w = cvt_pk_bf16(y2[6], y2[7]);
            qr[8 + p] = *reinterpret_cast<bf16x8*>(&w1); qr[10 + p] = *reinterpret_cast<bf16x8*>(&w2); }
    }
    float m_reg = -1e30f, l_reg = 0.f; f32x16 o[4] = {};
    f32x16 pA0, pA1, pB0, pB1; float alA = 1.f, alB = 1.f; bf16x8 pa0, pa1, pa2, pa3;
    const int NT = 4 * qb + 4; const int wp = wid >> 1;
    const bool a1 = wp >= 1, a2 = wp >= 2, a3 = wp >= 3;
#define MASK(P0, P1, act) do { if (!(act)) { _Pragma("unroll") for (int r = 0; r < 16; ++r) { P0[r] = -INFINITY; P1[r] = -INFINITY; } } } while (0)
#define INTERVAL(PN0, PN1, PO0, PO1, alN, alO, t, act, load) do { \
        if (load) DMA_KV((t) + 1, ((t) + 1) & 1, vnext); \
        SBAR(); if (act) qkt2(PN0, PN1, Krow + ((t) & 1) * K2_BYTES, koff, qr); MASK(PN0, PN1, act); \
        if (MODE == 2) { asm volatile("" : "+v"(PO0), "+v"(PO1)); pa0 = __builtin_bit_cast(bf16x8, (u32x4){__float_as_uint(PO0[0]), __float_as_uint(PO0[1]), __float_as_uint(PO0[2]), __float_as_uint(PO0[3])}); pa1 = pa0; pa2 = pa0; pa3 = pa0; } \
        else finishSM(PO0, PO1, alO, l_reg, pa0, pa1, pa2, pa3); \
        SBAR(); pv_d0(o, vb0 + vprev * SHM_V, pa0, pa1, pa2, pa3); if (MODE == 2) { asm volatile("" : "+v"(PN0), "+v"(PN1)); } else partialSM(PN0, PN1, m_reg, alN); \
        __syncthreads(); RESC(alN); \
        vprev = vcur; vcur = vnext; vnext = (vnext == 2) ? 0 : vnext + 1; } while (0)
    __syncthreads();
    int vprev = 0, vcur = 1, vnext = 2;
    DMA_KV(1, 1, 1);
    qkt2(pA0, pA1, Krow, koff, qr); partialSM(pA0, pA1, m_reg, alA);
    __syncthreads();
    for (int j = 1; j + 3 < NT; j += 2) {
        INTERVAL(pB0, pB1, pA0, pA1, alB, alA, j, true, true);
        INTERVAL(pA0, pA1, pB0, pB1, alA, alB, j + 1, true, true);
    }
    INTERVAL(pB0, pB1, pA0, pA1, alB, alA, NT - 3, a1, true);
    INTERVAL(pA0, pA1, pB0, pB1, alA, alB, NT - 2, a2, true);
    INTERVAL(pB0, pB1, pA0, pA1, alB, alA, NT - 1, a3, false);
    finishSM(pB0, pB1, alB, l_reg, pa0, pa1, pa2, pa3); SBAR();
    pv_d0(o, vb0 + vprev * SHM_V, pa0, pa1, pa2, pa3);
#undef INTERVAL
#undef MASK
    if (hi == 0) li_l[r32] = l_reg; asm volatile("s_waitcnt lgkmcnt(0)" ::: "memory");
    float rli[16];
#pragma unroll
    for (int r = 0; r < 16; ++r) rli[r] = __builtin_amdgcn_rcpf(li_l[crow(r, hi)]);
    __syncthreads();
    LAS bf16_t* stg = (LAS bf16_t*)(lds + wid * 8192);
#pragma unroll
    for (int r = 0; r < 16; ++r) { const int orow = crow(r, hi);
#pragma unroll
        for (int d0 = 0; d0 < 4; ++d0) stg[orow * 128 + d0 * 32 + r32] = f2bf(o[d0][r] * rli[r]); }
    asm volatile("s_waitcnt lgkmcnt(0)" ::: "memory");
    if (MODE == 0) {
        const int g = lane >> 4, ch = lane & 15, c = h * VH + ch * 8; const int t0 = qb * 256 + wid * QBLK;
        const size_t e0 = (size_t)(b * SEQ + t0) * DM + c;
        u32x4 uu[8], gv[8], sv[8];
#pragma unroll
        for (int i = 0; i < 8; ++i) { const size_t e = e0 + (size_t)(4 * i + g) * DM; uu[i] = *(const u32x4*)(T.u + e); gv[i] = __builtin_nontemporal_load((const u32x4*)(T.gb + e)); sv[i] = __builtin_nontemporal_load((const u32x4*)(T.sg + e)); }
        u32x4 uvirt = {0u, 0u, 0u, 0u};
        if (g >= 2 && t0 > 0) uvirt = *(const u32x4*)(T.u + e0 - (size_t)(4 - g) * DM);
        const f32x4 w0a = *(const f32x4*)(T.conv_w + c), w0b = *(const f32x4*)(T.conv_w + c + 4), w1a = *(const f32x4*)(T.conv_w + DM + c), w1b = *(const f32x4*)(T.conv_w + DM + c + 4),
              w2a = *(const f32x4*)(T.conv_w + 2 * DM + c), w2b = *(const f32x4*)(T.conv_w + 2 * DM + c + 4);
        const float cw0[8] = {w0a[0], w0a[1], w0a[2], w0a[3], w0b[0], w0b[1], w0b[2], w0b[3]}, cw1[8] = {w1a[0], w1a[1], w1a[2], w1a[3], w1b[0], w1b[1], w1b[2], w1b[3]},
                    cw2[8] = {w2a[0], w2a[1], w2a[2], w2a[3], w2b[0], w2b[1], w2b[2], w2b[3]};
        const int src1 = ((lane - 16) & 63) << 2, src2 = (lane ^ 32) << 2;
#pragma unroll
        for (int i = 0; i < 8; ++i) { const int row = i * 4 + g; const size_t e = e0 + (size_t)row * DM;
            const u32x4 ov = *(const LAS u32x4*)(stg + row * 128 + ch * 8);
            const u32x4 up = (i == 0) ? uvirt : uu[i > 0 ? i - 1 : 0];
            u32x4 u1, u2, res;
#pragma unroll
            for (int q = 0; q < 4; ++q) { const unsigned x1 = (g == 3) ? up[q] : uu[i][q], x2 = (g >= 2) ? up[q] : uu[i][q];
                u1[q] = (unsigned)__builtin_amdgcn_ds_bpermute(src1, (int)x1); u2[q] = (unsigned)__builtin_amdgcn_ds_bpermute(src2, (int)x2); }
#pragma unroll
            for (int q = 0; q < 4; ++q) {
                const float cl = cw0[2 * q] * bflo(u2[q]) + cw1[2 * q] * bflo(u1[q]) + cw2[2 * q] * bflo(uu[i][q]), chh = cw0[2 * q + 1] * bfhi(u2[q]) + cw1[2 * q + 1] * bfhi(u1[q]) + cw2[2 * q + 1] * bfhi(uu[i][q]);
                res[q] = cvt_pk_bf16(bflo(gv[i][q]) * cl + bflo(sv[i][q]) * bflo(ov[q]), bfhi(gv[i][q]) * chh + bfhi(sv[i][q]) * bfhi(ov[q])); }
            *(u32x4*)(T.merged + e) = res; }
    }
    asm volatile("s_waitcnt lgkmcnt(0)" ::: "memory");
    __syncthreads();
#undef DMA_KV
#undef RESC
}
#undef SBAR
}
#ifndef ATTN_UNIT
#define ATTN_UNIT attn_unit2
#endif
struct Frame {
    LAS unsigned char* lds; volatile LAS unsigned* MISC; unsigned* ctl;
    int tid, lane, wave, vcu, G;
};
__device__ __forceinline__ float wave_sum(float v) {
#pragma unroll
    for (int o = 1; o < 64; o <<= 1) v += __shfl_xor(v, o);
    return v;
}
__device__ __forceinline__ int tcc(int bj, int ch128) { return (bj << 7) | (ch128 & 0x60) | (((ch128 >> 2) & 1) << 4) | (((ch128 >> 3) & 3) << 2) | (ch128 & 3); }
struct MapIn { __device__ __forceinline__ int operator()(int c) const {
    if (c < C_ZB) return 256 * (c >> 7) + tcc(0, c & 127);
    if (c < C_ZC) { const int ch = c - C_ZB; return 256 * (8 + (ch >> 7)) + tcc(0, ch & 127); }
    if (c < C_QL) { const int ch = c - C_ZC; return 256 * (ch >> 7) + tcc(1, ch & 127); }
    if (c < C_KVL) { const int j = c - C_QL; return j < 256 ? 256 * 20 + permL(j) : 256 * 21 + permL(j - 256); }
    if (c < C_KR) return 256 * 22 + permL(c - C_KVL);
    if (c < C_GC) { const int j = c - C_KR, jj = j & 31; return 256 * 21 + 128 + ((jj >> 4) << 5) + ((j >> 5) << 4) + (((jj >> 2) & 3) << 2) + (jj & 3); }
    if (c < C_GM) { const int ch = c - C_GC; return 256 * (8 + (ch >> 7)) + tcc(1, ch & 127); }
    { const int j = c - C_GM; return 256 * (16 + (j >> 8)) + permL(j & 255); } } };
struct MapPerm { __device__ __forceinline__ int operator()(int c) const { return (c & ~255) | permL(c & 255); } };
struct MapId { __device__ __forceinline__ int operator()(int c) const { return c; } };
struct MapGU { int n; __device__ __forceinline__ int operator()(int f) const { const int r = f & 127; return 256 * (f >> 7) + ((((r >> 2) & 1) << 7) | ((r >> 5) << 5) | (n << 4) | (((r >> 3) & 3) << 2) | (r & 3)); } };

template <class RowMap>
__device__ __forceinline__ void transpose_item(const float* W, int N, bf16_t* WT, int ldt, const float* kscale, LAS float* scr, int item, int lane, const RowMap& rm) {
    const int nblk = N / 32, kb = item / nblk, nb = item % nblk, k0 = 64 * kb, n0 = 32 * nb;
    float wv[32];
#pragma unroll
    for (int i = 0; i < 32; ++i) wv[i] = __builtin_nontemporal_load(W + (size_t)(k0 + 2 * i + (lane >> 5)) * N + n0 + (lane & 31));
#pragma unroll
    for (int i = 0; i < 32; ++i) { const int kk = 2 * i + (lane >> 5); const float sc = kscale ? kscale[k0 + kk] : 1.f; scr[kk * 33 + (lane & 31)] = wv[i] * sc; }
    asm volatile("s_waitcnt lgkmcnt(0)" ::: "memory");
    const int c = lane & 7;
#pragma unroll
    for (int j = 0; j < 4; ++j) { const int n = (lane >> 3) + 8 * j; const LAS float* s = scr + (8 * c) * 33 + n;
        u32x4 o; o.x = cvt_pk_bf16(s[0 * 33], s[1 * 33]); o.y = cvt_pk_bf16(s[2 * 33], s[3 * 33]); o.z = cvt_pk_bf16(s[4 * 33], s[5 * 33]); o.w = cvt_pk_bf16(s[6 * 33], s[7 * 33]);
        *(u32x4*)(WT + (size_t)rm(n0 + n) * ldt + k0 + 8 * c) = o; }
    asm volatile("s_waitcnt lgkmcnt(0)" ::: "memory");
}
constexpr size_t WS_WIN = WS_WSMALL, WS_WQ = WS_WIN + (size_t)5888 * 1024 * 2, WS_WKV = WS_WQ + (size_t)1536 * 384 * 2, WS_WO = WS_WKV + (size_t)2048 * 256 * 2;
static_assert(WS_WO + (size_t)1024 * 1024 * 2 <= WS_A, "small weights fit below region A");
constexpr size_t WS_EGU = WS_C, WS_EDN = WS_C + (size_t)NEXP * 512 * 1024 * 2;
static_assert(WS_EDN + (size_t)NEXP * 1024 * 256 * 2 <= WS_D, "expert weights fit region C");

__device__ __forceinline__ void p0_weights_tables(const Ptrs& P, Frame& F) {
    LAS float* scr = (LAS float*)(F.lds + RING_OFF + F.wave * 16384);
    const int gw = F.vcu * NWAVES + F.wave, NGW = F.G * NWAVES;
    constexpr int I_IN = (DM / 64) * (DIN / 32), I_Q = (QL / 64) * (1536 / 32), I_KV = (KVL / 64) * (2048 / 32), I_O = (DM / 64) * (DM / 32);
    for (int it = gw; it < I_IN + I_Q + I_KV + I_O; it += NGW) {
        int r = it;
        if (r < I_IN) { transpose_item(P.w_in, DIN, (bf16_t*)(P.ws + WS_WIN), DM, (const float*)nullptr, scr, r, F.lane, MapIn{}); continue; } r -= I_IN;
        if (r < I_Q) { transpose_item(P.w_q_b, 1536, (bf16_t*)(P.ws + WS_WQ), QL, P.q_a_g, scr, r, F.lane, MapPerm{}); continue; } r -= I_Q;
        if (r < I_KV) { transpose_item(P.w_kv_b, 2048, (bf16_t*)(P.ws + WS_WKV), KVL, P.kv_a_g, scr, r, F.lane, MapPerm{}); continue; } r -= I_KV;
        transpose_item(P.w_o, DM, (bf16_t*)(P.ws + WS_WO), DM, (const float*)nullptr, scr, r, F.lane, MapPerm{});
    }
    {
        const int gt = F.vcu * 512 + F.tid;
        if (gt < 64 * 128) { const int rr = 192 + (gt >> 7), ch = gt & 127; *(u32x4*)((bf16_t*)(P.ws + WS_WIN) + (size_t)(256 * 21 + rr) * DM + ch * 8) = (u32x4){0u, 0u, 0u, 0u}; } }
    {
        float2* cs = (float2*)(P.ws + WS_CS);
        for (int idx = F.vcu * 512 + F.tid; idx < M * 32; idx += F.G * 512) { const int m = idx >> 5, i = idx & 31;
            const double inv = exp2(-(double)(2 * i) * (13.287712379549449 / 64.0));
            const double ang = (double)P.pos[m] * inv; float2 v; v.x = (float)cos(ang); v.y = (float)sin(ang); cs[idx] = v; } }
    asm volatile("s_waitcnt vmcnt(0) lgkmcnt(0)" ::: "memory"); __syncthreads();
}
__device__ __forceinline__ void p0_mod(const Ptrs& P, Frame& F) {
    if (F.vcu < 192) {
        LAS float* cact = (LAS float*)(F.lds + RING_OFF); LAS float* red = (LAS float*)(F.lds + RING_OFF + 65536);
        for (int idx = F.tid; idx < BATCH * DM; idx += 512) { const float cv = P.c[idx]; cact[idx] = cv / (1.f + __expf(-cv)); }
        __syncthreads();
        const int n0 = 32 * F.vcu, kl = F.lane >> 3, c4 = F.lane & 7;
        f32x4 acc[16];
#pragma unroll
        for (int b = 0; b < 16; ++b) acc[b] = (f32x4){0.f, 0.f, 0.f, 0.f};
        for (int it = 0; it < 16; ++it) { const int k = 128 * F.wave + 8 * it + kl;
            const f32x4 wv = __builtin_nontemporal_load((const f32x4*)(P.w_ada + (size_t)k * 6144 + n0 + 4 * c4));
#pragma unroll
            for (int b = 0; b < 16; ++b) acc[b] += cact[b * DM + k] * wv; }
#pragma unroll
        for (int b = 0; b < 16; ++b)
#pragma unroll
            for (int e = 0; e < 4; ++e) { float v = acc[b][e]; v += __shfl_xor(v, 8); v += __shfl_xor(v, 16); v += __shfl_xor(v, 32); if (kl == 0) red[(F.wave * 16 + b) * 32 + 4 * c4 + e] = v; }
        __syncthreads();
        { const int b = F.tid >> 5, cc = F.tid & 31; float s = P.b_ada[n0 + cc];
#pragma unroll
          for (int w = 0; w < 8; ++w) s += red[(w * 16 + b) * 32 + cc];
          ((float*)(P.ws + WS_MOD))[b * 6144 + n0 + cc] = s; }
        __syncthreads();
    }
}
__device__ __forceinline__ void expert_weight_items(const Ptrs& P, Frame& F, int w, int nw, int k_lo, int k_hi) {
    LAS float* scr = (LAS float*)(F.lds + RING_OFF + F.wave * 16384);
    constexpr int I_G = (DM / 64) * (DEXP / 32), I_D = (DEXP / 64) * (DM / 32);
    for (int k = k_lo; k < k_hi; ++k) { const int it = w + k * nw; if (it >= NEXP * (2 * I_G + I_D)) break;
        const int e = it / (2 * I_G + I_D); int r = it % (2 * I_G + I_D);
        bf16_t* gu = (bf16_t*)(P.ws + WS_EGU) + (size_t)e * 512 * DM; bf16_t* dn = (bf16_t*)(P.ws + WS_EDN) + (size_t)e * DM * DEXP;
        if (r < I_G) { transpose_item(P.w_gate + (size_t)e * DM * DEXP, DEXP, gu, DM, (const float*)nullptr, scr, r, F.lane, MapGU{0}); continue; } r -= I_G;
        if (r < I_G) { transpose_item(P.w_up + (size_t)e * DM * DEXP, DEXP, gu, DM, (const float*)nullptr, scr, r, F.lane, MapGU{1}); continue; } r -= I_G;
        transpose_item(P.w_down + (size_t)e * DEXP * DM, DM, dn, DEXP, (const float*)nullptr, scr, r, F.lane, MapPerm{});
    }
}
__device__ __forceinline__ void p1_norm1(const Ptrs& P, Frame& F) {
    const int gw = F.vcu * NWAVES + F.wave, NGW = F.G * NWAVES;
    bf16_t* h = (bf16_t*)(P.ws + WS_A);
    for (int m = gw; m < M; m += NGW) {
        const float* mod = (const float*)(P.ws + WS_MOD) + (m / SEQ) * 6144;
        const f32x4* xr = (const f32x4*)(P.x + (size_t)m * DM) + F.lane;
        f32x4 v[4]; float s = 0.f;
#pragma unroll
        for (int j = 0; j < 4; ++j) { v[j] = __builtin_nontemporal_load(xr + 64 * j); s += (v[j][0] * v[j][0] + v[j][1] * v[j][1]) + (v[j][2] * v[j][2] + v[j][3] * v[j][3]); }
        const float rstd = 1.f / sqrtf(wave_sum(s) * (1.f / DM) + EPS);
        unsigned long long* o8 = (unsigned long long*)(h + (size_t)m * DM) + F.lane;
#pragma unroll
        for (int j = 0; j < 4; ++j) { const int d = 4 * F.lane + 256 * j;
            const f32x4 g = *(const f32x4*)(P.norm1_g + d), sc = *(const f32x4*)(mod + 1024 + d), sh = *(const f32x4*)(mod + d);
            const f32x4 r = v[j] * rstd * g * (sc + 1.f) + sh;
            o8[64 * j] = (unsigned long long)cvt_pk_bf16(r[0], r[1]) | ((unsigned long long)cvt_pk_bf16(r[2], r[3]) << 32); }
    }
}

constexpr size_t WS_WR = 30 * MiB;
constexpr size_t WS_STOK = WS_RT + 512 * 1024, WS_SW = WS_STOK + 320 * 1024;
constexpr int MAXROWS = 81920, MAXTILES = 320;
constexpr size_t WS_H2 = WS_B, WS_HACT = WS_B + 64 * MiB;
constexpr size_t WS_X1B = WS_B + 128 * MiB;
constexpr size_t WS_DELTA = WS_D, WS_Y0 = WS_A, WS_Y1 = WS_D + 64 * MiB;
constexpr int CW_T = CW_TILES, CW_T0 = CW_TILES + 1, CW_TGRP = CW_TILES + 64;

__device__ __forceinline__ void p0_router_weights(const Ptrs& P, Frame& F) {
    bf16_t* hi = (bf16_t*)(P.ws + WS_WR); bf16_t* lo = hi + 48 * DM;
    for (int idx = F.vcu * 512 + F.tid; idx < 48 * DM; idx += F.G * 512) { const int o = idx >> 10, k = idx & 1023;
        const float v = o < 4 ? P.w_rg[k * 4 + o] : (o < 36 ? P.w_re[k * 32 + o - 4] : 0.f);
        const bf16_t h = f2bf(v); hi[idx] = h; lo[idx] = f2bf(v - bf2f(h)); }
}
template <int MODE> __device__ __forceinline__ void p6_rows(const Ptrs& P, Frame& F) {
    LAS unsigned char* tile = F.lds + RING_OFF + F.wave * 8192;
    LAS float* lg = (LAS float*)(F.lds + RING_OFF + 65536 + F.wave * 1536);
    LAS unsigned char* wch = F.lds + RING_OFF + 77824;
    LAS float* gms = (LAS float*)(F.lds + XCH_OFF);
    LAS unsigned* hist = (LAS unsigned*)(F.lds + LDSCTL_OFF + 1024);
    const bf16_t* WrHi = (const bf16_t*)(P.ws + WS_WR); const bf16_t* WrLo = WrHi + 48 * DM;
    bf16_t* h2 = (bf16_t*)(P.ws + WS_H2); const bf16_t* dl = (const bf16_t*)(P.ws + WS_DELTA); bf16_t* x1b = (bf16_t*)(P.ws + WS_X1B);
    int2* rte = (int2*)(P.ws + WS_RT); float2* rtw = (float2*)(P.ws + WS_RT + 256 * 1024);
    const int t = F.lane & 15, q = F.lane >> 4;
    u32x4 wreg[6];
#pragma unroll
    for (int j = 0; j < 6; ++j) { const int id = F.tid + 512 * j, arr = id / 1536, rem = id - arr * 1536, row = rem >> 5, ch = rem & 31; wreg[j] = *(const u32x4*)((arr ? WrLo : WrHi) + (size_t)row * DM + 8 * ch); }
    for (int rb = F.vcu; rb < M / 128; rb += F.G) {
        const int m0 = rb * 128 + F.wave * 16, b = m0 / SEQ;
        const float* mod = (const float*)(P.ws + WS_MOD) + b * 6144;
        __syncthreads();
        if (F.tid < 64) hist[F.tid] = 0u;
        for (int k = F.tid; k < DM; k += 512) { gms[k] = P.norm2_g[k] * (1.f + mod[4096 + k]); gms[DM + k] = mod[3072 + k]; }
        __syncthreads();
#pragma unroll 1
        for (int hb = 0; hb < 2; ++hb) {
            const int mb = m0 + 8 * hb;
            f32x4 xv[8][4]; float rstd[8];
#pragma unroll
            for (int r = 0; r < 8; ++r) { const f32x4* xr = (const f32x4*)(P.x + (size_t)(mb + r) * DM) + F.lane; const u32x2* dr = (const u32x2*)(dl + (size_t)(mb + r) * DM) + F.lane;
#pragma unroll
                for (int c = 0; c < 4; ++c) { const f32x4 x4 = __builtin_nontemporal_load(xr + 64 * c); const u32x2 d = __builtin_nontemporal_load(dr + 64 * c);
                    xv[r][c][0] = x4[0] + __uint_as_float(d.x << 16); xv[r][c][1] = x4[1] + __uint_as_float(d.x & 0xffff0000u); xv[r][c][2] = x4[2] + __uint_as_float(d.y << 16); xv[r][c][3] = x4[3] + __uint_as_float(d.y & 0xffff0000u); } }
#pragma unroll
            for (int r = 0; r < 8; ++r) { float s = 0.f;
#pragma unroll
                for (int c = 0; c < 4; ++c) s += (xv[r][c][0] * xv[r][c][0] + xv[r][c][1] * xv[r][c][1]) + (xv[r][c][2] * xv[r][c][2] + xv[r][c][3] * xv[r][c][3]);
                rstd[r] = 1.f / sqrtf(wave_sum(s) * (1.f / DM) + EPS); }
            f32x4 acc[3];
#pragma unroll
            for (int cb = 0; cb < 3; ++cb) acc[cb] = (f32x4){0.f, 0.f, 0.f, 0.f};
#pragma unroll
            for (int c = 0; c < 4; ++c) {
                const int k0 = 256 * c + 4 * F.lane;
                __syncthreads();
#pragma unroll
                for (int j = 0; j < 6; ++j) { const int id = F.tid + 512 * j, arr = id / 1536, rem = id - arr * 1536, row = rem >> 5, ch = rem & 31;
                    *(LAS u32x4*)(wch + arr * 24576 + row * 512 + ((ch ^ (row & 15)) << 4)) = wreg[j]; }
#pragma unroll
                for (int j = 0; j < 6; ++j) { const int id = F.tid + 512 * j, arr = id / 1536, rem = id - arr * 1536, row = rem >> 5, ch = rem & 31;
                    wreg[j] = *(const u32x4*)((arr ? WrLo : WrHi) + (size_t)row * DM + 256 * ((c + 1) & 3) + 8 * ch); }
                const f32x4 gm = *(const LAS f32x4*)(gms + k0), sh = *(const LAS f32x4*)(gms + DM + k0);
#pragma unroll
                for (int r = 0; r < 8; ++r) { const f32x4 h = xv[r][c] * rstd[r] * gm + sh;
                    u32x2 hi; hi.x = cvt_pk_bf16(h[0], h[1]); hi.y = cvt_pk_bf16(h[2], h[3]);
                    u32x2 lo; lo.x = cvt_pk_bf16(h[0] - __uint_as_float(hi.x << 16), h[1] - __uint_as_float(hi.x & 0xffff0000u)); lo.y = cvt_pk_bf16(h[2] - __uint_as_float(hi.y << 16), h[3] - __uint_as_float(hi.y & 0xffff0000u));
                    *(u32x2*)(h2 + (size_t)(mb + r) * DM + k0) = hi;
                    const int off = r * 512 + ((((F.lane >> 1) ^ r) & 31) << 4) + ((F.lane & 1) << 3);
                    *(LAS u32x2*)(tile + off) = hi; *(LAS u32x2*)(tile + 4096 + off) = lo; }
                asm volatile("s_waitcnt lgkmcnt(0)" ::: "memory");
                __syncthreads();
#pragma unroll 2
                for (int ks = 0; ks < (MODE == 1 ? 0 : 8); ++ks) { const int tr = t & 7;
                    const int off = tr * 512 + ((((4 * ks + q) ^ tr) & 31) << 4);
                    const bf16x8 bh = *(const LAS bf16x8*)(tile + off), bl = *(const LAS bf16x8*)(tile + 4096 + off);
#pragma unroll
                    for (int cb = 0; cb < 3; ++cb) { const int woff = (16 * cb + t) * 512 + ((((4 * ks + q) ^ t) & 31) << 4);
                        const bf16x8 wh = *(const LAS bf16x8*)(wch + woff), wl = *(const LAS bf16x8*)(wch + 24576 + woff);
                        acc[cb] = __builtin_amdgcn_mfma_f32_16x16x32_bf16(wh, bh, acc[cb], 0, 0, 0);
                        acc[cb] = __builtin_amdgcn_mfma_f32_16x16x32_bf16(wh, bl, acc[cb], 0, 0, 0);
                        acc[cb] = __builtin_amdgcn_mfma_f32_16x16x32_bf16(wl, bh, acc[cb], 0, 0, 0); } }
                asm volatile("s_waitcnt lgkmcnt(0)" ::: "memory");
            }
            if (t < 8) {
#pragma unroll
                for (int cb = 0; cb < 3; ++cb)
#pragma unroll
                    for (int r = 0; r < 4; ++r) lg[t * 48 + 16 * cb + 4 * q + r] = acc[cb][r]; }
            asm volatile("s_waitcnt lgkmcnt(0)" ::: "memory");
            if (MODE != 1 && q == 0 && t < 8) {
                const int m = mb + t;
                const LAS float* l = lg + t * 48;
                float gl[4];
#pragma unroll
                for (int i = 0; i < 4; ++i) gl[i] = l[i] + P.b_rg[i];
                int g = 0; float gmx = gl[0];
#pragma unroll
                for (int i = 1; i < 4; ++i) if (gl[i] > gmx) { gmx = gl[i]; g = i; }
                float se = 0.f;
#pragma unroll
                for (int i = 0; i < 4; ++i) se += __expf(gl[i] - gmx);
                const float pg = 1.f / se;
                float e0v = -3.0e38f, e1v = -3.0e38f; int i0 = 0, i1 = 0;
#pragma unroll
                for (int i = 0; i < 8; ++i) { const float v = l[4 + g * 8 + i] + P.b_re[g * 8 + i];
                    if (v > e0v) { e1v = e0v; i1 = i0; e0v = v; i0 = i; } else if (v > e1v) { e1v = v; i1 = i; } }
                const float p1 = __expf(e1v - e0v), w0 = 1.f / (1.f + p1), w1 = p1 * w0;
                int2 e; e.x = g * 8 + i0; e.y = g * 8 + i1; float2 w; w.x = w0 * pg; w.y = w1 * pg;
                rte[m] = e; rtw[m] = w;
                __hip_atomic_fetch_add(&hist[e.x], 1u, __ATOMIC_RELAXED, __HIP_MEMORY_SCOPE_WORKGROUP); __hip_atomic_fetch_add(&hist[32 + e.y], 1u, __ATOMIC_RELAXED, __HIP_MEMORY_SCOPE_WORKGROUP);
            }
            asm volatile("s_waitcnt lgkmcnt(0)" ::: "memory");
        }
        __syncthreads();
        if (MODE != 1 && F.tid < 64) F.ctl[CW_HIST + rb * 64 + F.tid] = hist[F.tid];
    }
    __syncthreads();
}
__device__ __forceinline__ void p7_sort(const Ptrs& P, Frame& F) {
    LAS unsigned* tot = (LAS unsigned*)(F.lds + RING_OFF);
    LAS unsigned* pre = tot + 64;
    LAS unsigned* rbase = pre + 64;
    LAS unsigned* cnt = rbase + 64;
    LAS unsigned* misc = cnt + 64;
    int* stok = (int*)(P.ws + WS_STOK); float* sw = (float*)(P.ws + WS_SW);
    const int2* rte = (const int2*)(P.ws + WS_RT); const float2* rtw = (const float2*)(P.ws + WS_RT + 256 * 1024);
    const int cw = F.vcu * 7 + F.wave - 1, cnw = F.G * 7; bool first = true;
    for (int rb = F.vcu; rb < M / 128; rb += F.G) {
        __syncthreads();
        {
            LAS unsigned* ptot = misc + 8; LAS unsigned* ppre = ptot + 512;
            const int g = F.tid & 63, pt = F.tid >> 6; unsigned hv[32];
#pragma unroll
            for (int k = 0; k < 32; ++k) hv[k] = F.ctl[CW_HIST + (32 * pt + k) * 64 + g];
            unsigned s = 0u, p = 0u;
#pragma unroll
            for (int k = 0; k < 32; ++k) { if (32 * pt + k == rb) p = s; s += hv[k]; }
            if (rb >= 32 * pt + 32) p = s;
            ptot[pt * 64 + g] = s; ppre[pt * 64 + g] = p;
        }
        __syncthreads();
        if (F.tid < 64) { unsigned s = 0u, p = 0u;
#pragma unroll
            for (int pt = 0; pt < 8; ++pt) { s += misc[8 + pt * 64 + F.tid]; p += misc[8 + 512 + pt * 64 + F.tid]; }
            tot[F.tid] = s; pre[F.tid] = p; cnt[F.tid] = 0u; }
        if (first && F.wave > 0) expert_weight_items(P, F, cw, cnw, 0, 2);
        __syncthreads();
        if (first && F.wave > 0) expert_weight_items(P, F, cw, cnw, 2, 4);
        if (F.tid == 0) { unsigned tb = 0u;
            for (int g = 0; g < 64; ++g) { if (g == 32) misc[1] = tb; rbase[g] = tb * 256u; const unsigned nt = (tot[g] + 255u) >> 8;
                if (rb == 0) for (unsigned k = 0; k < nt; ++k) F.ctl[CW_TGRP + tb + k] = (unsigned)g;
                tb += nt; }
            misc[0] = tb; if (rb == 0) { F.ctl[CW_T] = tb; F.ctl[CW_T0] = misc[1]; } }
        __syncthreads();
        if (F.wave == 0) {
            const unsigned long long ltmask = (1ull << F.lane) - 1ull;
            for (int ch = 0; ch < 2; ++ch) { const int m = rb * 128 + ch * 64 + F.lane; const int2 e = rte[m]; const float2 w = rtw[m];
                for (int j = 0; j < 2; ++j) { const int ex = j ? e.y : e.x; const float wj = j ? w.y : w.x; unsigned rank = 0u, gsz = 0u;
                    for (int x = 0; x < 32; ++x) { const unsigned long long mk = __ballot(ex == x); if (ex == x) { rank = (unsigned)__popcll(mk & ltmask); gsz = (unsigned)__popcll(mk); } }
                    const int g = j * 32 + ex; const unsigned pos = rbase[g] + pre[g] + cnt[g] + rank;
                    stok[pos] = m; sw[pos] = wj;
                    asm volatile("s_waitcnt lgkmcnt(0)" ::: "memory");
                    if (rank == 0u) cnt[g] += gsz;
                    asm volatile("s_waitcnt lgkmcnt(0)" ::: "memory"); } } }
        if (rb < 64) { const unsigned n = tot[rb], padn = (((n + 255u) >> 8) << 8) - n;
            if ((unsigned)F.tid < padn) { stok[rbase[rb] + n + F.tid] = -1; sw[rbase[rb] + n + F.tid] = 0.f; } }
        if (first && F.wave > 0) expert_weight_items(P, F, cw, cnw, 4, 1 << 20);
        first = false;
    }
}
struct MoeSched {
    const bf16_t* A; const bf16_t* W; int lda, ldb; const int* stok; const unsigned* tgrp; int t_lo, nun, npn, G, c; size_t wstride; bool gather, split;
    __device__ bool next(int i, Unit& u) const {
        const int idx = i * G + c, nfull = (nun / G) * G, tail = nun - nfull; int U; u.half = 0;
        if (split && tail > 0 && 2 * tail <= G) { if (idx >= nfull + 2 * tail) return false; if (idx < nfull) U = idx; else { U = nfull + ((idx - nfull) >> 1); u.half = 1 + ((idx - nfull) & 1); } }
        else { if (idx >= nun) return false; U = idx; }
        u.aux = t_lo + U / npn; u.pn = U % npn; u.pm = (int)tgrp[u.aux]; return true; }
    __device__ __forceinline__ const char* abase(const Unit& u) const { return gather ? (const char*)A : (const char*)A + (size_t)(u.aux * BM + (u.half == 2 ? HALF : 0)) * lda * 2; }
    __device__ __forceinline__ const char* bbase(const Unit& u) const { return (const char*)W + (size_t)(u.pm & 31) * wstride + (size_t)u.pn * BM * ldb * 2; }
    __device__ __forceinline__ void avoff(const Unit& u, int R0, int C0, int R1, int C1, unsigned (&v0)[2], unsigned (&v1)[2]) const {
        if (gather) { const int* tk = stok + u.aux * BM + (u.half == 2 ? HALF : 0); const int o1 = u.half ? 0 : HALF; int a = tk[R0], b = tk[R1], c2 = tk[o1 + R0], d = tk[o1 + R1];
            a = a < 0 ? 0 : a; b = b < 0 ? 0 : b; c2 = c2 < 0 ? 0 : c2; d = d < 0 ? 0 : d;
            v0[0] = (unsigned)(a * lda + C0) * 2u; v0[1] = (unsigned)(b * lda + C1) * 2u; v1[0] = (unsigned)(c2 * lda + C0) * 2u; v1[1] = (unsigned)(d * lda + C1) * 2u; }
        else { v0[0] = (unsigned)(R0 * lda + C0) * 2u; v0[1] = (unsigned)(R1 * lda + C1) * 2u; const unsigned h1 = u.half ? 0u : (unsigned)(HALF * lda * 2); v1[0] = v0[0] + h1; v1[1] = v0[1] + h1; } }
};
struct EpiGU {
    bf16_t* hact; const float* sw;
    __device__ __forceinline__ void operator()(const f32x4 (&acc)[2][2][4][2], const Unit& un, int wr, int wc, int fr, int fq) const {
        asm volatile("" : "+v"(fr), "+v"(fq));
        const int r0 = un.aux * BM + (un.half == 2 ? HALF : 0) + wr * 64 + fr, c0 = 128 * un.pn + 32 * wc + 8 * fq;
#pragma unroll
        for (int ai = 0; ai < 2; ++ai)
#pragma unroll
            for (int m = 0; m < 4; ++m) { if (ai == 1 && un.half) continue; const int row = r0 + ai * HALF + m * 16; const float w = sw[row];
                f32x4 a, b;
#pragma unroll
                for (int i = 0; i < 4; ++i) { const float g0 = acc[ai][0][m][0][i], g1 = acc[ai][1][m][0][i];
                    a[i] = g0 * fsigmoid(g0) * acc[ai][0][m][1][i] * w; b[i] = g1 * fsigmoid(g1) * acc[ai][1][m][1][i] * w; }
                *(u32x4*)(hact + (size_t)row * DEXP + c0) = pack8(a, b); }
    }
};
struct EpiDown {
    bf16_t* y0; bf16_t* y1; const int* stok;
    __device__ __forceinline__ void operator()(const f32x4 (&acc)[2][2][4][2], const Unit& un, int wr, int wc, int fr, int fq) const {
        asm volatile("" : "+v"(fr), "+v"(fq));
        const int r0 = un.aux * BM + wr * 64 + fr, c0 = 256 * un.pn + 32 * wc + 8 * fq;
        bf16_t* y = (un.pm >> 5) ? y1 : y0;
#pragma unroll
        for (int ai = 0; ai < 2; ++ai)
#pragma unroll
            for (int m = 0; m < 4; ++m) { const int tok = stok[r0 + ai * HALF + m * 16];
                if (tok >= 0) { bf16_t* orow = y + (size_t)tok * DM + c0;
                    *(u32x4*)(orow) = pack8(acc[ai][0][m][0], acc[ai][0][m][1]); *(u32x4*)(orow + HALF) = pack8(acc[ai][1][m][0], acc[ai][1][m][1]); } }
    }
};
__device__ __forceinline__ void p10_combine(const Ptrs& P, Frame& F) {
    const int gw = F.vcu * NWAVES + F.wave, NGW = F.G * NWAVES;
    const bf16_t* dl = (const bf16_t*)(P.ws + WS_DELTA); const bf16_t* y0 = (const bf16_t*)(P.ws + WS_Y0); const bf16_t* y1 = (const bf16_t*)(P.ws + WS_Y1);
    for (int m = gw; m < M; m += NGW) {
        const float* gate = (const float*)(P.ws + WS_MOD) + (m / SEQ) * 6144 + 5120;
        const f32x4* xr = (const f32x4*)(P.x + (size_t)m * DM) + F.lane; f32x4* orow = (f32x4*)(P.out + (size_t)m * DM) + F.lane;
        const u32x2* dr = (const u32x2*)(dl + (size_t)m * DM) + F.lane; const u32x2* a0 = (const u32x2*)(y0 + (size_t)m * DM) + F.lane; const u32x2* a1 = (const u32x2*)(y1 + (size_t)m * DM) + F.lane;
        f32x4 xv[4]; u32x2 d[4], p[4], q[4];
#pragma unroll
        for (int j = 0; j < 4; ++j) { xv[j] = __builtin_nontemporal_load(xr + 64 * j); d[j] = __builtin_nontemporal_load(dr + 64 * j); p[j] = __builtin_nontemporal_load(a0 + 64 * j); q[j] = __builtin_nontemporal_load(a1 + 64 * j); }
#pragma unroll
        for (int j = 0; j < 4; ++j) { const f32x4 g = *(const f32x4*)(gate + 4 * F.lane + 256 * j);
            f32x4 o;
            o[0] = xv[j][0] + __uint_as_float(d[j].x << 16) + g[0] * (__uint_as_float(p[j].x << 16) + __uint_as_float(q[j].x << 16));
            o[1] = xv[j][1] + __uint_as_float(d[j].x & 0xffff0000u) + g[1] * (__uint_as_float(p[j].x & 0xffff0000u) + __uint_as_float(q[j].x & 0xffff0000u));
            o[2] = xv[j][2] + __uint_as_float(d[j].y << 16) + g[2] * (__uint_as_float(p[j].y << 16) + __uint_as_float(q[j].y << 16));
            o[3] = xv[j][3] + __uint_as_float(d[j].y & 0xffff0000u) + g[3] * (__uint_as_float(p[j].y & 0xffff0000u) + __uint_as_float(q[j].y & 0xffff0000u));
            __builtin_nontemporal_store(o, orow + 64 * j); }
    }
}
struct Args { Ptrs P; int ph_lo, ph_hi, li, pad; };
constexpr int N_PHASES = 11;

typedef const __attribute__((address_space(4))) Args* KArgs;
__device__ __forceinline__ KArgs kargs() {
#if defined(__HIP_DEVICE_COMPILE__)
    unsigned off = 0u; asm volatile("" : "+s"(off));
    return (KArgs)((const __attribute__((address_space(4))) char*)__builtin_amdgcn_kernarg_segment_ptr() + off);
#else
    return nullptr;
#endif
}
__device__ __forceinline__ Ptrs load_ptrs() {
    Ptrs P{};
#if defined(__HIP_DEVICE_COMPILE__)
    const __attribute__((address_space(4))) unsigned long long* src = (const __attribute__((address_space(4))) unsigned long long*)kargs();
    unsigned long long w[sizeof(Ptrs) / 8];
#pragma unroll
    for (unsigned i = 0; i < sizeof(Ptrs) / 8; ++i) w[i] = src[i];
    __builtin_memcpy(&P, w, sizeof(Ptrs));
#endif
    return P;
}
#define WSPTRS \
    unsigned char* ws = P.ws; bf16_t* hA = (bf16_t*)(ws + WS_A); bf16_t* uB = (bf16_t*)(ws + WS_B); bf16_t* gbB = uB + (size_t)M * DM; bf16_t* sgB = gbB + (size_t)M * DM; \
    bf16_t* latC = (bf16_t*)(ws + WS_C); bf16_t* Kd = (bf16_t*)(ws + WS_D); bf16_t* Vd = (bf16_t*)(ws + WS_D + 96 * MiB); bf16_t* Qo = (bf16_t*)P.out; \
    float* ssp = (float*)(ws + WS_SSP); const float2* cs = (const float2*)(ws + WS_CS); const float* mod = (const float*)(ws + WS_MOD); \
    const int* stok = (const int*)(ws + WS_STOK); const float* sw = (const float*)(ws + WS_SW); bf16_t* h2 = (bf16_t*)(ws + WS_H2); bf16_t* hact = (bf16_t*)(ws + WS_HACT); \
    (void)hA; (void)uB; (void)gbB; (void)sgB; (void)latC; (void)Kd; (void)Vd; (void)Qo; (void)ssp; (void)cs; (void)mod; (void)stok; (void)sw; (void)h2; (void)hact;

__global__ void __launch_bounds__(NWAVES * 64, 2) fwd(Args args_unused) {
    extern __shared__ __attribute__((aligned(16))) unsigned char lds_raw[];
    Frame F;
    F.lds = (LAS unsigned char*)lds_raw;
    F.MISC = (volatile LAS unsigned*)(F.lds + MISC_OFF);
    F.tid = threadIdx.x; F.lane = F.tid & 63; F.wave = __builtin_amdgcn_readfirstlane(F.tid >> 6);
    F.G = gridDim.x; { const int bx = blockIdx.x; F.vcu = (F.G % 8 == 0) ? (bx % 8) * (F.G / 8) + bx / 8 : bx; }
    F.ctl = (unsigned*)(args_unused.P.ws + WS_CTL);
    for (int u = F.tid; u < (LDS_BYTES - LDSCTL_OFF) / 4; u += NWAVES * 64) ((LAS unsigned*)(F.lds + LDSCTL_OFF))[u] = 0u;
    __syncthreads();
    const int lo = args_unused.ph_lo, hi = args_unused.ph_hi;
    XcdBarrier bar; bar.bar = F.ctl + CW_BAR + args_unused.li * XCD_BAR_WORDS; bar.x = 0; bar.st = nullptr;
    if (hi - lo > 1) bar = xcd_barrier_post(F.ctl + CW_BAR + args_unused.li * XCD_BAR_WORDS, F.MISC + 8);
#ifdef ONLY_PHASE
#define IN(k) ((k) == ONLY_PHASE && lo <= (k) && (k) < hi)
#else
#define IN(k) (lo <= (k) && (k) < hi)
#endif
#ifndef PROBE_REPEAT
#define PROBE_REPEAT -1
#endif
#define REPS(k) for (int rep_ = 0; rep_ < ((k) == PROBE_REPEAT ? 2 : 1); ++rep_)
#define SEAM(k) do { if (IN(k) && IN((k) + 1)) xcd_barrier(bar); } while (0)

    if (IN(0)) { const Ptrs P = args_unused.P; REPS(0) { p0_router_weights(P, F); p0_mod(P, F); } SEAM(0); }
    if (IN(1)) { const Ptrs P = args_unused.P; REPS(1) { p1_norm1(P, F); p0_weights_tables(P, F); } SEAM(1); }
    if (IN(2)) {
        const Ptrs P = args_unused.P; WSPTRS
        DenseSched S; S.init(hA, DM, (const bf16_t*)(ws + WS_WIN), DM, M, 5888, F.G, (int)blockIdx.x, true, true);
        EpiIn E{uB, gbB, sgB, latC, ssp, cs, P.k_g, (LAS float*)(F.lds + XCH_OFF)};
        gemm_phase<false>(F.lds + RING_OFF, DM, S, E);
        if (PROBE_REPEAT == 2) gemm_phase<false>(F.lds + RING_OFF, DM, S, E);
        SEAM(2);
    }
    if (IN(3)) {
        const Ptrs P = args_unused.P; WSPTRS
        { DenseSched S; S.init(latC, LATW, (const bf16_t*)(ws + WS_WQ), QL, M, 1536, F.G, (int)blockIdx.x);
          EpiPlain E{Qo, 1536, 255};
          gemm_phase<false>(F.lds + RING_OFF, QL, S, E);
          if (PROBE_REPEAT == 30) gemm_phase<false>(F.lds + RING_OFF, QL, S, E); }
        { DenseSched S; S.init(latC + 512, LATW, (const bf16_t*)(ws + WS_WKV), KVL, M, 2048, F.G, (int)blockIdx.x);
          EpiKV E{Kd, Vd, latC, ssp, P.k_g, (LAS float*)(F.lds + XCH_OFF)};
          gemm_phase<false>(F.lds + RING_OFF, KVL, S, E);
          if (PROBE_REPEAT == 31) gemm_phase<false>(F.lds + RING_OFF, KVL, S, E);
          if (PROBE_REPEAT == 32) { EpiPlain E2{hA, 1024, 3}; gemm_phase<false>(F.lds + RING_OFF, KVL, S, E2); } }
        SEAM(3);
    }
    if (IN(4)) {
        const Ptrs P = args_unused.P; WSPTRS
        att::AttnArgs T{Qo, Kd, Vd, ssp, cs, P.q_g, uB, gbB, sgB, P.conv_w, hA};
        if (F.G == 256) {
            const int bh = F.vcu >> 1, sel = F.vcu & 1;
#pragma unroll 1
            for (int i = 0; i < 4; ++i) { const int qb = sel ? (i == 0 ? 6 : i == 1 ? 1 : i == 2 ? 5 : 2) : (i == 0 ? 7 : i == 1 ? 0 : i == 2 ? 4 : 3);
                att::ATTN_UNIT<0>(T, bh >> 3, bh & 7, qb, (LAS char*)(F.lds + RING_OFF)); }
            if (PROBE_REPEAT == 4 || PROBE_REPEAT == 41 || PROBE_REPEAT == 42) {
#pragma unroll 1
                for (int i = 0; i < 4; ++i) { const int qb = sel ? (i == 0 ? 6 : i == 1 ? 1 : i == 2 ? 5 : 2) : (i == 0 ? 7 : i == 1 ? 0 : i == 2 ? 4 : 3);
                    att::ATTN_UNIT<(PROBE_REPEAT == 41 ? 1 : PROBE_REPEAT == 42 ? 2 : 0)>(T, bh >> 3, bh & 7, qb, (LAS char*)(F.lds + RING_OFF)); } }
        } else {
#pragma unroll 1
            for (int U = F.vcu; U < BATCH * NH * 8; U += F.G) { const int bh = U >> 3; att::ATTN_UNIT<0>(T, bh >> 3, bh & 7, U & 7, (LAS char*)(F.lds + RING_OFF)); }
        }
        SEAM(4);
    }
    if (IN(5)) {
        const Ptrs P = args_unused.P; WSPTRS
        DenseSched S; S.init(hA, DM, (const bf16_t*)(ws + WS_WO), DM, M, DM, F.G, (int)blockIdx.x);
        EpiDelta E{mod, (bf16_t*)(ws + WS_DELTA)};
        gemm_phase<false>(F.lds + RING_OFF, DM, S, E);
        if (PROBE_REPEAT == 5) gemm_phase<false>(F.lds + RING_OFF, DM, S, E);
        if (PROBE_REPEAT == 51) { EpiNull E0; gemm_phase<false>(F.lds + RING_OFF, DM, S, E0); }
        SEAM(5);
    }
    if (IN(6)) { const Ptrs P = args_unused.P; p6_rows<0>(P, F); if (PROBE_REPEAT == 6) p6_rows<0>(P, F); if (PROBE_REPEAT == 61) p6_rows<1>(P, F); SEAM(6); }
    if (IN(7)) { const Ptrs P = args_unused.P; p7_sort(P, F); if (PROBE_REPEAT == 7) p7_sort(P, F); SEAM(7); }
    if (IN(8)) {
        const Ptrs P = args_unused.P; WSPTRS
        const int T = __builtin_amdgcn_readfirstlane((int)F.ctl[CW_T]);
        MoeSched S{h2, (const bf16_t*)(ws + WS_EGU), DM, DM, stok, F.ctl + CW_TGRP, 0, T * 2, 2, F.G, F.vcu, (size_t)512 * DM * 2, true, true};
        EpiGU E{hact, sw};
        gemm_phase<true>(F.lds + RING_OFF, DM, S, E);
        if (PROBE_REPEAT == 8) gemm_phase<true>(F.lds + RING_OFF, DM, S, E);
        SEAM(8);
    }
    if (IN(9)) {
        const Ptrs P = args_unused.P; WSPTRS
        const int T = __builtin_amdgcn_readfirstlane((int)F.ctl[CW_T]);
        MoeSched S{hact, (const bf16_t*)(ws + WS_EDN), DEXP, DEXP, stok, F.ctl + CW_TGRP, 0, T * 4, 4, F.G, F.vcu, (size_t)DM * DEXP * 2, false, false};
        EpiDown E{(bf16_t*)(ws + WS_Y0), (bf16_t*)(ws + WS_Y1), stok};
        gemm_phase<false>(F.lds + RING_OFF, DEXP, S, E);
        if (PROBE_REPEAT == 9) gemm_phase<false>(F.lds + RING_OFF, DEXP, S, E);
        SEAM(9);
    }
    if (IN(10)) { const Ptrs P = args_unused.P; REPS(10) p10_combine(P, F); }
#undef IN
#undef SEAM
}
}
extern "C" void kernel_launch(void* const* d_in, const int* in_sizes, int n_in, void* d_out, int out_size, void* d_ws, size_t ws_size, hipStream_t stream) {
    if (n_in != 23 || out_size != M * DM || ws_size < WS_END) { fprintf(stderr, "kernel_launch: unexpected shapes (n_in %d out %d ws %zu)\n", n_in, out_size, ws_size); return; }
    static int grid = 0;
    if (grid == 0) {
        int dev = 0, cus = 0;
        if (hipGetDevice(&dev) != hipSuccess || hipDeviceGetAttribute(&cus, hipDeviceAttributeMultiprocessorCount, dev) != hipSuccess) { fprintf(stderr, "kernel_launch: device query failed\n"); grid = -1; return; }
        if (hipFuncSetAttribute((const void*)fk::fwd, hipFuncAttributeMaxDynamicSharedMemorySize, fk::LDS_BYTES) != hipSuccess) { fprintf(stderr, "kernel_launch: hipFuncSetAttribute failed\n"); grid = -1; return; }
        grid = cus;
    }
    if (grid < 0) return;
    Ptrs P{};
    P.x = (const float*)d_in[0]; P.c = (const float*)d_in[1]; P.pos = (const int*)d_in[2];
    P.w_ada = (const float*)d_in[3]; P.b_ada = (const float*)d_in[4]; P.norm1_g = (const float*)d_in[5]; P.w_in = (const float*)d_in[6]; P.conv_w = (const float*)d_in[7];
    P.q_a_g = (const float*)d_in[8]; P.w_q_b = (const float*)d_in[9]; P.kv_a_g = (const float*)d_in[10]; P.w_kv_b = (const float*)d_in[11]; P.q_g = (const float*)d_in[12]; P.k_g = (const float*)d_in[13];
    P.w_o = (const float*)d_in[14]; P.norm2_g = (const float*)d_in[15]; P.w_rg = (const float*)d_in[16]; P.b_rg = (const float*)d_in[17]; P.w_re = (const float*)d_in[18]; P.b_re = (const float*)d_in[19];
    P.w_gate = (const float*)d_in[20]; P.w_up = (const float*)d_in[21]; P.w_down = (const float*)d_in[22];
    P.out = (float*)d_out; P.ws = (unsigned char*)d_ws;
    (void)hipMemsetAsync((char*)d_ws + WS_CTL, 0, 1 * MiB, stream);
    fk::Args a{}; a.P = P; a.ph_lo = 0; a.ph_hi = fk::N_PHASES; a.li = 0;
    hipLaunchKernelGGL(fk::fwd, dim3(grid), dim3(fk::NWAVES * 64), fk::LDS_BYTES, stream, a);
}
```

```cpp
#define PROBE_REPEAT -1
#include <hip/hip_runtime.h>
#include <cstdio>
#include <cstdint>
#include <cmath>

constexpr int BATCH = 16, SEQ = 2048, DM = 1024, M = BATCH * SEQ;
constexpr int NH = 8, QKN = 128, QKR = 64, QKH = 192, VH = 128, QL = 384, KVL = 256;
constexpr int DIN = 5824, NEXP = 32, DEXP = 256;
constexpr int C_ZX = 0, C_ZB = 1024, C_ZC = 2048, C_QL = 3072, C_KVL = 3456, C_KR = 3712, C_GC = 3776, C_GM = 4800;
constexpr float EPS = 1e-6f;
constexpr int LATW = 768;

typedef unsigned short bf16_t;
typedef float f32x4 __attribute__((ext_vector_type(4)));

constexpr size_t MiB = 1u << 20;
constexpr size_t WS_CTL = 0;
constexpr size_t WS_MOD = 1 * MiB;
constexpr size_t WS_CS = 2 * MiB;
constexpr size_t WS_SSP = 10 * MiB;
constexpr size_t WS_RT = 12 * MiB;
constexpr size_t WS_WSMALL = 14 * MiB;
constexpr size_t WS_A = 32 * MiB;
constexpr size_t WS_B = 96 * MiB;
constexpr size_t WS_C = 288 * MiB;
constexpr size_t WS_D = 336 * MiB;
constexpr size_t WS_END = 496 * MiB;

__device__ __forceinline__ float bf2f(bf16_t v) { return __uint_as_float(((unsigned)v) << 16); }
__device__ __forceinline__ bf16_t f2bf(float f) { unsigned u = __float_as_uint(f); return (bf16_t)((u + 0x7fffu + ((u >> 16) & 1u)) >> 16); }

struct Ptrs {
    const float *x, *c; const int* pos;
    const float *w_ada, *b_ada, *norm1_g, *w_in, *conv_w, *q_a_g, *w_q_b, *kv_a_g, *w_kv_b, *q_g, *k_g, *w_o, *norm2_g;
    const float *w_rg, *b_rg, *w_re, *b_re, *w_gate, *w_up, *w_down;
    float* out; unsigned char* ws;
};

namespace fk {
#define LAS __attribute__((address_space(3)))
#define GAS __attribute__((address_space(1)))
typedef short bf16x8 __attribute__((ext_vector_type(8)));
typedef short s16x4 __attribute__((ext_vector_type(4)));
typedef unsigned u32x4 __attribute__((ext_vector_type(4)));
typedef unsigned u32x2 __attribute__((ext_vector_type(2)));
typedef float f32x2 __attribute__((ext_vector_type(2)));
typedef float f32x16 __attribute__((ext_vector_type(16)));
typedef GAS unsigned gu32;
#define RLX_AGENT __ATOMIC_RELAXED, __HIP_MEMORY_SCOPE_AGENT
constexpr int NWAVES = 8;
constexpr int BM = 256, BK = 64, HALF = 128, HTB = HALF * BK * 2, STAGE_BYTES = 8 * HTB, NXCD = 8, WGM = 8;
constexpr int RING_OFF = 0, RING_BYTES = 131072, XCH_OFF = 131072, XCH_BYTES = 8192, LDSCTL_OFF = XCH_OFF + XCH_BYTES, MISC_OFF = LDSCTL_OFF + 320, LDS_BYTES = 147456;
constexpr int CW_TMO = 0, CW_BAR = 4096;
constexpr int CW_HIST = 16384;
constexpr int CW_TILES = 40960;

typedef __bf16 bf16x2_t __attribute__((ext_vector_type(2)));
__device__ __forceinline__ unsigned cvt_pk_bf16(float lo, float hi) { f32x2 v = {lo, hi}; bf16x2_t b = __builtin_convertvector(v, bf16x2_t); return __builtin_bit_cast(unsigned, b); }
__device__ __forceinline__ float fsigmoid(float x) { return __builtin_amdgcn_rcpf(1.f + __expf(-x)); }

__host__ __device__ __forceinline__ int lds_byte(int r, int c) { const int st = (r >> 4) * 2 + (c >> 5), rr = r & 15, cc = c & 31, ob = rr * 64 + cc * 2; return st * 1024 + (ob ^ (((ob >> 9) & 1) << 5)); }
__host__ __device__ __forceinline__ void stage_rc(int b, int& R, int& C) { const int st = b / 1024, sb = b % 1024, swz = sb ^ (((sb >> 9) & 1) << 5); R = (st >> 1) * 16 + swz / 64; C = (st & 1) * 32 + (swz % 64) / 2; }
__host__ __device__ __forceinline__ int permL(int L) { return (L & 0xE0) | (((L >> 2) & 1) << 4) | (((L >> 3) & 3) << 2) | (L & 3); }

#define XB_TMO      128
#define XB_XCNT(j)  (256  + 64 * (j))
#define XB_XSUB(j)  (1280 + 64 * (j))
#define XB_XGEN(j)  (2304 + 64 * (j))
#define XB_TOP      3328
#define XB_TOPGEN   3392
#define XCD_BAR_WORDS 3456
#define XB_SPIN_CAP (1u << 18)
__device__ __forceinline__ unsigned xb_ld(unsigned* p)              { return __hip_atomic_load(p, __ATOMIC_RELAXED, __HIP_MEMORY_SCOPE_AGENT); }
__device__ __forceinline__ unsigned xb_add(unsigned* p, unsigned v) { return __hip_atomic_fetch_add(p, v, __ATOMIC_RELAXED, __HIP_MEMORY_SCOPE_AGENT); }
__device__ __forceinline__ unsigned xb_xcc_id() { return (unsigned)__builtin_amdgcn_s_getreg((3 << 11) | 20) & 0xFu; }
#define XB_SPIN(cond, bar) do { unsigned _sp = 0; while (cond) { __builtin_amdgcn_s_sleep(1); \
    if ((++_sp & 255u) == 0u) { if (xb_ld(&(bar)[XB_TMO])) break; if (_sp > XB_SPIN_CAP) { atomicAdd(&(bar)[XB_TMO], 1u); break; } } } } while (0)
struct XcdBarrier { unsigned* bar; unsigned x; volatile LAS unsigned* st; };
__device__ __forceinline__ XcdBarrier xcd_barrier_post(unsigned* bar, volatile LAS unsigned* st) {
    XcdBarrier b; b.bar = bar; b.x = xb_xcc_id(); b.st = st;
    if (threadIdx.x == 0) (void)xb_add(&bar[XB_XCNT(b.x)], 1u);
    return b;
}
__device__ __forceinline__ void xcd_barrier_complete(unsigned* bar, unsigned x, unsigned& nloc, unsigned& nx) {
    const unsigned G = gridDim.x * gridDim.y * gridDim.z;
    unsigned sum, cnt, mine, sp = 0u;
    for (;;) {
        sum = 0u; cnt = 0u; mine = 0u;
#pragma unroll
        for (unsigned j = 0; j < 16; ++j) { const unsigned c = xb_ld(&bar[XB_XCNT(j)]); sum += c; cnt += (c > 0u) ? 1u : 0u; mine = (j == x) ? c : mine; }
        if (sum == G) break;
        __builtin_amdgcn_s_sleep(1);
        if ((++sp & 255u) == 0u) { if (xb_ld(&bar[XB_TMO])) break; if (sp > XB_SPIN_CAP) { atomicAdd(&bar[XB_TMO], 1u); break; } }
    }
    nloc = mine > 0u ? mine : 1u; nx = cnt > 0u ? cnt : 1u;
}
__device__ __forceinline__ void xcd_barrier(const XcdBarrier& b) {
    asm volatile("s_waitcnt vmcnt(0)" ::: "memory");
    __syncthreads();
    if (threadIdx.x == 0) {
        unsigned* bar = b.bar;
        __builtin_amdgcn_s_waitcnt(0);
        unsigned nloc = b.st[0], nx = b.st[1];
        if (nloc == 0u) { xcd_barrier_complete(bar, b.x, nloc, nx); b.st[0] = nloc; b.st[1] = nx; }
        const unsigned old = xb_add(&bar[XB_XSUB(b.x)], 1u);
        const unsigned gen = old / nloc;
        if (old + 1u == (gen + 1u) * nloc) {
            __builtin_amdgcn_fence(__ATOMIC_RELEASE, "agent");
            asm volatile("s_waitcnt vmcnt(0)" ::: "memory");
            const unsigned og = xb_add(&bar[XB_TOP], 1u);
            const unsigned tg = og / nx;
            if (og + 1u == (tg + 1u) * nx) xb_add(&bar[XB_TOPGEN], 1u);
            else XB_SPIN(xb_ld(&bar[XB_TOPGEN]) == tg, bar);
            __builtin_amdgcn_fence(__ATOMIC_ACQUIRE, "agent");
            xb_add(&bar[XB_XGEN(b.x)], 1u);
            asm volatile("s_waitcnt vmcnt(0)" ::: "memory");
        } else {
            XB_SPIN(xb_ld(&bar[XB_XGEN(b.x)]) == gen, bar);
            __builtin_amdgcn_fence(__ATOMIC_ACQUIRE, "agent");
            asm volatile("s_waitcnt vmcnt(0)" ::: "memory");
        }
    }
    __syncthreads();
}

struct Unit { int pm, pn, aux, half; };
struct DenseSched {
    const bf16_t* A; const bf16_t* Bt; int lda, ldb; int nM, nN, nwg, G, c; bool split, pnflip;
    __device__ void init(const bf16_t* A_, int lda_, const bf16_t* Bt_, int ldb_, int M_, int N_, int G_, int c_, bool split_ = false, bool pnflip_ = false) {
        A = A_; Bt = Bt_; lda = lda_; ldb = ldb_; nM = M_ / BM; nN = N_ / BM; nwg = nM * nN; G = G_; c = c_; split = split_; pnflip = pnflip_; }
    __device__ bool next(int i, Unit& u) const {
        const int idx = i * G + c, nfull = (nwg / G) * G, tail = nwg - nfull; int L; u.half = 0;
        if (split && tail > 0 && 2 * tail <= G) { if (idx >= nfull + 2 * tail) return false; if (idx < nfull) L = idx; else { L = nfull + ((idx - nfull) >> 1); u.half = 1 + ((idx - nfull) & 1); } }
        else { if (idx >= nwg) return false; L = idx; }
        int wgid = L; { const int q = nwg / NXCD, r = nwg % NXCD, xcd = wgid % NXCD, off = wgid / NXCD; wgid = (xcd < r ? xcd * (q + 1) : r * (q + 1) + (xcd - r) * q) + off; }
        const int nig = WGM * nN, gid = wgid / nig, fm = gid * WGM, gsz = (nM - fm) < WGM ? (nM - fm) : WGM;
        u.pm = fm + ((wgid % nig) % gsz); u.pn = (wgid % nig) / gsz; if (pnflip) u.pn = nN - 1 - u.pn; u.aux = 0; return true;
    }
    __device__ __forceinline__ const char* abase(const Unit& u) const { return (const char*)A + (size_t)(u.pm * BM + (u.half == 2 ? HALF : 0)) * lda * 2; }
    __device__ __forceinline__ const char* bbase(const Unit& u) const { return (const char*)Bt + (size_t)u.pn * BM * ldb * 2; }
    __device__ __forceinline__ void avoff(const Unit& u, int R0, int C0, int R1, int C1, unsigned (&v0)[2], unsigned (&v1)[2]) const {
        v0[0] = (unsigned)(R0 * lda + C0) * 2u; v0[1] = (unsigned)(R1 * lda + C1) * 2u;
        const unsigned h1 = u.half ? 0u : (unsigned)(HALF * lda * 2);
        v1[0] = v0[0] + h1; v1[1] = v0[1] + h1; }
};

template <bool GATHER, class Epi, class Sched>
__device__ __forceinline__ void gemm_phase(LAS unsigned char* lds, const int K, const Sched& S, const Epi& E) {
    const int tid = threadIdx.x, wid = __builtin_amdgcn_readfirstlane(tid >> 6), lane = tid & 63, wr = wid >> 2, wc = wid & 3, fr = lane & 15, fq = lane >> 4;
    const int nt = K / BK;
    int R0, C0, R1, C1; stage_rc(tid * 16, R0, C0); stage_rc(tid * 16 + 8192, R1, C1);
    unsigned voffB[2]; voffB[0] = (unsigned)(R0 * S.ldb + C0) * 2u; voffB[1] = (unsigned)(R1 * S.ldb + C1) * 2u;
    const size_t kstep = (size_t)(BK * 2);
    const size_t hstepB = (size_t)HALF * S.ldb * 2;
    const unsigned ldsw = (unsigned)wid * 1024u;
    const int aoff = lds_byte(wr * 64 + fr, fq * 8), boff = lds_byte(wc * 32 + fr, fq * 8);
#define PG8_SA(b, h) (((b) * 2 + (h)) * HTB)
#define PG8_SB(b, h) ((4 + (b) * 2 + (h)) * HTB)
#define PG8_STAGE(bufoff, gbase, voff) do { _Pragma("unroll") for (int _i = 0; _i < 2; ++_i) \
        __builtin_amdgcn_global_load_lds((const unsigned*)((const char*)(gbase) + (voff)[_i]), (LAS unsigned*)(lds + (bufoff) + ldsw + _i * 8192), 16, 0, 0); } while (0)
#define PG8_LDA(dst, b, h) do { _Pragma("unroll") for (int m = 0; m < 4; ++m) _Pragma("unroll") for (int k = 0; k < 2; ++k) dst[m][k] = *(const LAS bf16x8*)(lds + PG8_SA(b, h) + aoff + m * 2048 + k * 1024); } while (0)
#define PG8_LDB(dst, b, h) do { _Pragma("unroll") for (int n = 0; n < 2; ++n) _Pragma("unroll") for (int k = 0; k < 2; ++k) dst[n][k] = *(const LAS bf16x8*)(lds + PG8_SB(b, h) + boff + n * 2048 + k * 1024); } while (0)
#define PG8_MMA(ai, bj, At, Bt) do { __builtin_amdgcn_s_setprio(1); _Pragma("unroll") for (int m = 0; m < 4; ++m) _Pragma("unroll") for (int n = 0; n < 2; ++n) _Pragma("unroll") for (int k = 0; k < 2; ++k) \
        acc[ai][bj][m][n] = __builtin_amdgcn_mfma_f32_16x16x32_bf16(Bt[n][k], At[m][k], acc[ai][bj][m][n], 0, 0, 0); __builtin_amdgcn_s_setprio(0); } while (0)
#define PG8_WAIT_V(n) asm volatile("s_waitcnt vmcnt(" #n ")" ::: "memory")
#define PG8_WAIT_L(n) asm volatile("s_waitcnt lgkmcnt(" #n ")" ::: "memory")
#define PG8_BAR __builtin_amdgcn_s_barrier()
#define PG8_SCHED __builtin_amdgcn_sched_barrier(0)
    Unit cur, nxt; int ui = 0;
    if (!S.next(0, cur)) return;
    f32x4 acc[2][2][4][2];
#pragma unroll
    for (int a = 0; a < 2; ++a)
#pragma unroll
        for (int b = 0; b < 2; ++b)
#pragma unroll
            for (int m = 0; m < 4; ++m)
#pragma unroll
                for (int n = 0; n < 2; ++n) acc[a][b][m][n] = (f32x4){0.f, 0.f, 0.f, 0.f};
    bf16x8 At[4][2], B0[2][2], B1[2][2];
    unsigned va0[2], va1[2], na0[2], na1[2];
    S.avoff(cur, R0, C0, R1, C1, va0, va1);
    na0[0] = va0[0]; na0[1] = va0[1]; na1[0] = va1[0]; na1[1] = va1[1];
    const char* cA = S.abase(cur); const char* cB = S.bbase(cur);
    PG8_STAGE(PG8_SB(0, 0), cB, voffB); PG8_STAGE(PG8_SB(0, 1), cB + hstepB, voffB); PG8_STAGE(PG8_SA(0, 0), cA, va0); PG8_STAGE(PG8_SA(0, 1), cA, va1);
    if (wr == 1) PG8_BAR;
    PG8_WAIT_V(2); PG8_BAR;
    PG8_STAGE(PG8_SB(1, 0), cB + kstep, voffB); PG8_STAGE(PG8_SA(1, 0), cA + kstep, va0); PG8_STAGE(PG8_SB(1, 1), cB + hstepB + kstep, voffB);
    PG8_WAIT_V(6); PG8_BAR;
    for (;;) {
        const bool has_next = S.next(ui + 1, nxt);
        const char* nA = has_next ? S.abase(nxt) : cA; const char* nB = has_next ? S.bbase(nxt) : cB;
        if (has_next) S.avoff(nxt, R0, C0, R1, C1, na0, na1);
        const bool hu = cur.half != 0;
#pragma unroll 1
        for (int t = 0; t < nt; t += 2) {
            const bool last = (t == nt - 2);
            const char* a1 = cA + (size_t)(t + 1) * kstep;
            const char* a2 = last ? nA : cA + (size_t)(t + 2) * kstep; const char* b2 = last ? nB : cB + (size_t)(t + 2) * kstep;
            const char* a3 = a2 + kstep; const char* b3 = b2 + kstep;
            unsigned x0[2], x1[2];
            x0[0] = last ? na0[0] : va0[0]; x0[1] = last ? na0[1] : va0[1]; x1[0] = last ? na1[0] : va1[0]; x1[1] = last ? na1[1] : va1[1];
            PG8_LDB(B0, 0, 0); PG8_LDB(B1, 0, 1); PG8_SCHED; PG8_LDA(At, 0, 0); PG8_STAGE(PG8_SA(1, 1), a1, va1);
            PG8_WAIT_V(8); PG8_WAIT_L(0); PG8_BAR; PG8_MMA(0, 0, At, B0); PG8_MMA(0, 1, At, B1); PG8_BAR; PG8_SCHED;
            if (!hu) PG8_LDA(At, 0, 1);
            PG8_STAGE(PG8_SB(0, 0), b2, voffB); PG8_STAGE(PG8_SB(0, 1), b2 + hstepB, voffB); PG8_STAGE(PG8_SA(0, 0), a2, x0);
            PG8_WAIT_V(8); PG8_WAIT_L(0); PG8_BAR; if (!hu) { PG8_MMA(1, 0, At, B0); PG8_MMA(1, 1, At, B1); } PG8_BAR; PG8_SCHED;
            PG8_LDB(B0, 1, 0); PG8_LDB(B1, 1, 1); PG8_SCHED; PG8_LDA(At, 1, 0); PG8_STAGE(PG8_SA(0, 1), a2, x1);
            PG8_WAIT_V(8); PG8_WAIT_L(0); PG8_BAR; PG8_MMA(0, 0, At, B0); PG8_MMA(0, 1, At, B1); PG8_BAR; PG8_SCHED;
            if (!hu) PG8_LDA(At, 1, 1);
            PG8_STAGE(PG8_SB(1, 0), b3, voffB); PG8_STAGE(PG8_SB(1, 1), b3 + hstepB, voffB); PG8_STAGE(PG8_SA(1, 0), a3, x0);
            PG8_WAIT_V(8); PG8_WAIT_L(0); PG8_BAR; if (!hu) { PG8_MMA(1, 0, At, B0); PG8_MMA(1, 1, At, B1); } PG8_BAR; PG8_SCHED;
        }
        if (wr == 0) PG8_BAR;
        E(acc, cur, wr, wc, fr, fq);
        if (!has_next) break;
#pragma unroll
        for (int a = 0; a < 2; ++a)
#pragma unroll
            for (int b = 0; b < 2; ++b)
#pragma unroll
                for (int m = 0; m < 4; ++m)
#pragma unroll
                    for (int n = 0; n < 2; ++n) acc[a][b][m][n] = (f32x4){0.f, 0.f, 0.f, 0.f};
        cur = nxt; cA = nA; cB = nB; ++ui;
        va0[0] = na0[0]; va0[1] = na0[1]; va1[0] = na1[0]; va1[1] = na1[1];
        if (wr == 1) PG8_BAR;
    }
    PG8_WAIT_V(0);
    PG8_BAR;
#undef PG8_SA
#undef PG8_SB
#undef PG8_STAGE
#undef PG8_LDA
#undef PG8_LDB
#undef PG8_MMA
#undef PG8_WAIT_V
#undef PG8_WAIT_L
#undef PG8_BAR
#undef PG8_SCHED
}

__device__ __forceinline__ u32x4 pack8(const f32x4 a, const f32x4 b) { u32x4 w; w.x = cvt_pk_bf16(a[0], a[1]); w.y = cvt_pk_bf16(a[2], a[3]); w.z = cvt_pk_bf16(b[0], b[1]); w.w = cvt_pk_bf16(b[2], b[3]); return w; }

struct EpiIn {
    bf16_t *u, *gb, *sg, *lat; float* rowstat; const float2* cs; const float* k_g; LAS float* xch;
    __device__ __forceinline__ void operator()(const f32x4 (&acc)[2][2][4][2], const Unit& un, int wr, int wc, int fr, int fq) const {
        asm volatile("" : "+v"(fr), "+v"(fq));
        const int row0 = un.pm * BM + wr * 64 + fr, pn = un.pn;
        if (pn < 16) {
            const int c0 = 128 * (pn & 7) + 32 * wc + 8 * fq; bf16_t* dst = pn < 8 ? u : gb; const int rh = row0 + (un.half == 2 ? HALF : 0);
#pragma unroll
            for (int ai = 0; ai < 2; ++ai)
#pragma unroll
                for (int m = 0; m < 4; ++m) { f32x4 r0, r1; if (ai == 1 && un.half) continue;
                    if (pn < 8) { r0 = acc[ai][0][m][0] * acc[ai][1][m][0]; r1 = acc[ai][0][m][1] * acc[ai][1][m][1]; }
                    else { const f32x4 g0 = acc[ai][1][m][0], g1 = acc[ai][1][m][1];
#pragma unroll
                        for (int i = 0; i < 4; ++i) { r0[i] = acc[ai][0][m][0][i] * fsigmoid(g0[i]); r1[i] = acc[ai][0][m][1][i] * fsigmoid(g1[i]); } }
                    __builtin_nontemporal_store(pack8(r0, r1), (u32x4*)(dst + (size_t)(rh + ai * HALF + m * 16) * DM + c0)); }
        } else if (pn < 20) {
            const int c0 = 256 * (pn - 16) + 32 * wc + 8 * fq;
#pragma unroll
            for (int ai = 0; ai < 2; ++ai)
#pragma unroll
                for (int m = 0; m < 4; ++m)
#pragma unroll
                    for (int bj = 0; bj < 2; ++bj) { f32x4 a = acc[ai][bj][m][0], b = acc[ai][bj][m][1];
#pragma unroll
                        for (int i = 0; i < 4; ++i) { a[i] = fsigmoid(a[i]); b[i] = fsigmoid(b[i]); }
                        __builtin_nontemporal_store(pack8(a, b), (u32x4*)(sg + (size_t)(row0 + ai * HALF + m * 16) * DM + c0 + bj * HALF)); }
        } else {
            const int c0 = 256 * (pn - 20) + 32 * wc + 8 * fq, rowt = wr * 64 + fr;
#pragma unroll
            for (int ai = 0; ai < 2; ++ai)
#pragma unroll
                for (int m = 0; m < 4; ++m) { const int rt = rowt + ai * HALF + m * 16, row = un.pm * BM + rt; float s0, s1;
                    { const f32x4 a = acc[ai][0][m][0], b = acc[ai][0][m][1]; *(u32x4*)(lat + (size_t)row * LATW + c0) = pack8(a, b);
                      s0 = (a[0] * a[0] + a[1] * a[1]) + (a[2] * a[2] + a[3] * a[3]) + (b[0] * b[0] + b[1] * b[1]) + (b[2] * b[2] + b[3] * b[3]); }
                    { const f32x4 a = acc[ai][1][m][0], b = acc[ai][1][m][1];
                      s1 = (a[0] * a[0] + a[1] * a[1]) + (a[2] * a[2] + a[3] * a[3]) + (b[0] * b[0] + b[1] * b[1]) + (b[2] * b[2] + b[3] * b[3]);
                      if (pn != 21) *(u32x4*)(lat + (size_t)row * LATW + c0 + HALF) = pack8(a, b);
                      else if (wc < 2) { const int j = 16 * wc + 4 * fq;
                          const f32x4 g1 = *(const f32x4*)(k_g + 128 + j), g2 = *(const f32x4*)(k_g + 160 + j);
                          const f32x4 cA = *(const f32x4*)((const float*)cs + ((size_t)row * 32 + j) * 2), cB = *(const f32x4*)((const float*)cs + ((size_t)row * 32 + j + 2) * 2);
                          const f32x4 x1 = a * g1, x2 = b * g2; f32x4 y1, y2;
                          y1[0] = x1[0] * cA[0] - x2[0] * cA[1]; y2[0] = x2[0] * cA[0] + x1[0] * cA[1]; y1[1] = x1[1] * cA[2] - x2[1] * cA[3]; y2[1] = x2[1] * cA[2] + x1[1] * cA[3];
                          y1[2] = x1[2] * cB[0] - x2[2] * cB[1]; y2[2] = x2[2] * cB[0] + x1[2] * cB[1]; y1[3] = x1[3] * cB[2] - x2[3] * cB[3]; y2[3] = x2[3] * cB[2] + x1[3] * cB[3];
                          u32x2 w1, w2; w1.x = cvt_pk_bf16(y1[0], y1[1]); w1.y = cvt_pk_bf16(y1[2], y1[3]); w2.x = cvt_pk_bf16(y2[0], y2[1]); w2.y = cvt_pk_bf16(y2[2], y2[3]);
                          *(u32x2*)(lat + (size_t)row * LATW + 384 + j) = w1; *(u32x2*)(lat + (size_t)row * LATW + 416 + j) = w2; } }
                    s0 += __shfl_xor(s0, 16); s0 += __shfl_xor(s0, 32); s1 += __shfl_xor(s1, 16); s1 += __shfl_xor(s1, 32);
                    if (fq == 0) { xch[rt * 8 + wc] = s0; xch[rt * 8 + 4 + wc] = s1; } }
            asm volatile("s_waitcnt lgkmcnt(0)" ::: "memory"); __builtin_amdgcn_s_barrier(); asm volatile("" ::: "memory");
            if (threadIdx.x < 256) { const int rt = threadIdx.x; const f32x4 p0 = *(const LAS f32x4*)(xch + rt * 8), p1 = *(const LAS f32x4*)(xch + rt * 8 + 4);
                const float S0 = (p0[0] + p0[1]) + (p0[2] + p0[3]), S1 = (p1[0] + p1[1]) + (p1[2] + p1[3]); float* st = rowstat + (size_t)(un.pm * BM + rt) * 4;
                if (pn == 20) st[0] = S0 + S1; else if (pn == 21) { st[1] = S0; st[2] = S1; } else st[3] = S0 + S1; }
        }
    }
};
struct EpiPlain {
    bf16_t* O; int ldc; int pnmask;
    __device__ __forceinline__ void operator()(const f32x4 (&acc)[2][2][4][2], const Unit& un, int wr, int wc, int fr, int fq) const {
        asm volatile("" : "+v"(fr), "+v"(fq));
        const int row0 = un.pm * BM + wr * 64 + fr, c0 = 256 * (un.pn & pnmask) + 32 * wc + 8 * fq;
#pragma unroll
        for (int ai = 0; ai < 2; ++ai)
#pragma unroll
            for (int m = 0; m < 4; ++m)
#pragma unroll
                for (int bj = 0; bj < 2; ++bj) __builtin_nontemporal_store(pack8(acc[ai][bj][m][0], acc[ai][bj][m][1]), (u32x4*)(O + (size_t)(row0 + ai * HALF + m * 16) * ldc + c0 + bj * HALF));
    }
};
struct EpiKV {
    bf16_t *Kb, *Vb; const bf16_t* lat; const float* rowstat; const float* k_g; LAS float* xch;
    __device__ __forceinline__ void operator()(const f32x4 (&acc)[2][2][4][2], const Unit& un, int wr, int wc, int fr, int fq) const {
        asm volatile("" : "+v"(fr), "+v"(fq));
        const int h = un.pn, rowt = wr * 64 + fr, b = (un.pm * BM) / SEQ, s0 = (un.pm * BM) % SEQ;
        f32x2 st[2][4];
        u32x4 rp[2][2];
#pragma unroll
        for (int ai = 0; ai < 2; ++ai) {
#pragma unroll
            for (int m = 0; m < 4; ++m) st[ai][m] = *(const f32x2*)(rowstat + (size_t)(un.pm * BM + rowt + ai * HALF + m * 16) * 4 + 2);
            const bf16_t* lr = lat + (size_t)(un.pm * BM + rowt + ai * HALF + wc * 16) * LATW + 384 + 16 * fq;
            rp[ai][0] = *(const u32x4*)lr; rp[ai][1] = *(const u32x4*)(lr + 8); }
#pragma unroll
        for (int ai = 0; ai < 2; ++ai)
#pragma unroll
            for (int m = 0; m < 4; ++m) {
                const f32x4 a = acc[ai][0][m][0], c = acc[ai][0][m][1];
                float ss = (a[0] * a[0] + a[1] * a[1]) + (a[2] * a[2] + a[3] * a[3]) + (c[0] * c[0] + c[1] * c[1]) + (c[2] * c[2] + c[3] * c[3]);
                ss += __shfl_xor(ss, 16); ss += __shfl_xor(ss, 32);
                if (fq == 0) xch[(rowt + ai * HALF + m * 16) * 4 + wc] = ss; }
        asm volatile("s_waitcnt lgkmcnt(0)" ::: "memory"); __builtin_amdgcn_s_barrier(); asm volatile("" ::: "memory");
        const int c8 = 32 * wc + 8 * fq;
        const f32x4 g0 = *(const f32x4*)(k_g + c8), g1 = *(const f32x4*)(k_g + c8 + 4);
#pragma unroll
        for (int ai = 0; ai < 2; ++ai)
#pragma unroll
            for (int m = 0; m < 4; ++m) { const int rt = rowt + ai * HALF + m * 16;
                const float rkv = __builtin_amdgcn_rsqf(st[ai][m][1] * (1.f / KVL) + EPS);
                const f32x4 t4 = *(const LAS f32x4*)(xch + rt * 4);
                const float rk = __builtin_amdgcn_rsqf((((t4[0] + t4[1]) + (t4[2] + t4[3])) * rkv * rkv + st[ai][m][0]) * (1.f / QKH) + EPS);
                const float sk = rkv * rk, sv = rkv;
                const size_t bhs = (size_t)(b * NH + h) * SEQ + s0 + rt;
                bf16_t* Kp = Kb + bhs * QKH; bf16_t* Vp = Vb + bhs * VH;
                *(u32x4*)(Kp + c8) = pack8(acc[ai][0][m][0] * sk * g0, acc[ai][0][m][1] * sk * g1);
                *(u32x4*)(Vp + c8) = pack8(acc[ai][1][m][0] * sv, acc[ai][1][m][1] * sv);
                if (m == wc) {
                    u32x4 o0, o1;
#pragma unroll
                    for (int e = 0; e < 4; ++e) { o0[e] = cvt_pk_bf16(__uint_as_float(rp[ai][0][e] << 16) * rk, __uint_as_float(rp[ai][0][e] & 0xffff0000u) * rk);
                                                  o1[e] = cvt_pk_bf16(__uint_as_float(rp[ai][1][e] << 16) * rk, __uint_as_float(rp[ai][1][e] & 0xffff0000u) * rk); }
                    *(u32x4*)(Kp + 128 + 16 * fq) = o0; *(u32x4*)(Kp + 128 + 16 * fq + 8) = o1; } }
    }
};
struct EpiNull {
    __device__ __forceinline__ void operator()(const f32x4 (&acc)[2][2][4][2], const Unit& un, int wr, int wc, int fr, int fq) const {
#pragma unroll
        for (int ai = 0; ai < 2; ++ai)
#pragma unroll
            for (int bj = 0; bj < 2; ++bj)
#pragma unroll
                for (int m = 0; m < 4; ++m) { f32x4 a = acc[ai][bj][m][0], b = acc[ai][bj][m][1]; asm volatile("" :: "v"(a), "v"(b)); }
    }
};
struct EpiDelta {
    const float* mod; bf16_t* delta;
    __device__ __forceinline__ void operator()(const f32x4 (&acc)[2][2][4][2], const Unit& un, int wr, int wc, int fr, int fq) const {
        asm volatile("" : "+v"(fr), "+v"(fq));
        const int row0 = un.pm * BM + wr * 64 + fr, b = (un.pm * BM) / SEQ, c0 = 256 * un.pn + 32 * wc + 8 * fq;
        const float* gate = mod + b * 6144 + 2048;
#pragma unroll
        for (int bj = 0; bj < 2; ++bj) { const f32x4 g0 = *(const f32x4*)(gate + c0 + bj * HALF), g1 = *(const f32x4*)(gate + c0 + bj * HALF + 4);
#pragma unroll
            for (int ai = 0; ai < 2; ++ai)
#pragma unroll
                for (int m = 0; m < 4; ++m) *(u32x4*)(delta + (size_t)(row0 + ai * HALF + m * 16) * DM + c0 + bj * HALF) = pack8(acc[ai][bj][m][0] * g0, acc[ai][bj][m][1] * g1); }
    }
};
namespace att {
constexpr int NW = 8, QBLK = 32, KVBLK = 64, KPITCH = 400;
constexpr int SHM_V = KVBLK * VH * 2, SHM_K = KVBLK * KPITCH;
constexpr int QRP = 144;
constexpr int OFF_V = 0, OFF_K = 2 * SHM_V, OFF_WS = OFF_K + 2 * SHM_K, OFF_QR = OFF_WS + NW * 64 * 4, ATT_LDS = OFF_QR + NW * 32 * QRP;
constexpr float SCALE = 0.07216878364870322f;
constexpr float THR = 8.f;
#define SBAR() __builtin_amdgcn_sched_barrier(0)
__device__ __forceinline__ int crow(int r, int hi) { return (r & 3) + 8 * (r >> 2) + 4 * hi; }
__device__ __forceinline__ void partialSM(f32x16& p0, f32x16& p1, float& m_reg, float& alpha) {
    constexpr float C = SCALE * 1.4426950408889634f;
    float pmax = p0[0];
#pragma unroll
    for (int r = 1; r < 16; ++r) pmax = fmaxf(pmax, p0[r]);
#pragma unroll
    for (int r = 0; r < 16; ++r) pmax = fmaxf(pmax, p1[r]);
    { auto rr = __builtin_amdgcn_permlane32_swap(__float_as_uint(pmax), __float_as_uint(pmax), false, false);
      pmax = fmaxf(__uint_as_float(rr[0]), __uint_as_float(rr[1])); }
    float mn;
    if (__builtin_expect(__all(pmax - m_reg <= THR / SCALE), 1)) { mn = m_reg; alpha = 1.f; }
    else { mn = fmaxf(m_reg, pmax); alpha = __builtin_amdgcn_exp2f((m_reg - mn) * C); m_reg = mn; }
    const float mnC = -mn * C;
#pragma unroll
    for (int r = 0; r < 16; ++r) p0[r] = fmaf(p0[r], C, mnC);
#pragma unroll
    for (int r = 0; r < 16; ++r) p1[r] = fmaf(p1[r], C, mnC);
#pragma unroll
    for (int r = 0; r < 16; ++r) p0[r] = __builtin_amdgcn_exp2f(p0[r]);
}
__device__ __forceinline__ void finishSM(f32x16& p0, f32x16& p1, float alpha, float& l_reg, bf16x8& pa0, bf16x8& pa1, bf16x8& pa2, bf16x8& pa3) {
#pragma unroll
    for (int r = 0; r < 16; ++r) p1[r] = __builtin_amdgcn_exp2f(p1[r]);
    float ps = 0;
#pragma unroll
    for (int r = 0; r < 16; ++r) ps += p0[r];
#pragma unroll
    for (int r = 0; r < 16; ++r) ps += p1[r];
    { auto rr = __builtin_amdgcn_permlane32_swap(__float_as_uint(ps), __float_as_uint(ps), false, false);
      ps = __uint_as_float(rr[0]) + __uint_as_float(rr[1]); }
    l_reg = l_reg * alpha + ps;
#define PK4(P, BASE, OUT) do { unsigned a0 = cvt_pk_bf16(P[BASE + 0], P[BASE + 1]), a1 = cvt_pk_bf16(P[BASE + 2], P[BASE + 3]);   \
    unsigned b0 = cvt_pk_bf16(P[BASE + 4], P[BASE + 5]), b1 = cvt_pk_bf16(P[BASE + 6], P[BASE + 7]);                              \
    auto r0 = __builtin_amdgcn_permlane32_swap(a0, b0, false, false); auto r1 = __builtin_amdgcn_permlane32_swap(a1, b1, false, false); \
    u32x4 w = {r0[0], r1[0], r0[1], r1[1]}; OUT = *reinterpret_cast<bf16x8*>(&w); } while (0)
    PK4(p0, 0, pa0); PK4(p0, 8, pa1); PK4(p1, 0, pa2); PK4(p1, 8, pa3);
#undef PK4
}
__device__ __forceinline__ void qkt(f32x16& p0, f32x16& p1, const LAS char* Ks, const bf16x8 (&qr)[8], const LAS char* qrope, int r32, int hi) {
    p0 = f32x16{}; p1 = f32x16{};
    const LAS char* k0 = Ks + r32 * KPITCH + hi * 16;
#pragma unroll
    for (int d0 = 0; d0 < 8; ++d0) {
        const bf16x8 b0 = *(const LAS bf16x8*)(k0 + d0 * 32);
        const bf16x8 b1 = *(const LAS bf16x8*)(k0 + 32 * KPITCH + d0 * 32);
        p0 = __builtin_amdgcn_mfma_f32_32x32x16_bf16(b0, qr[d0], p0, 0, 0, 0);
        p1 = __builtin_amdgcn_mfma_f32_32x32x16_bf16(b1, qr[d0], p1, 0, 0, 0); }
#pragma unroll
    for (int d0 = 8; d0 < 12; ++d0) {
        const bf16x8 b0 = *(const LAS bf16x8*)(k0 + d0 * 32);
        const bf16x8 b1 = *(const LAS bf16x8*)(k0 + 32 * KPITCH + d0 * 32);
        const bf16x8 qf = *(const LAS bf16x8*)(qrope + (d0 - 8) * 32);
        p0 = __builtin_amdgcn_mfma_f32_32x32x16_bf16(b0, qf, p0, 0, 0, 0);
        p1 = __builtin_amdgcn_mfma_f32_32x32x16_bf16(b1, qf, p1, 0, 0, 0); }
}
__device__ __forceinline__ int v_st(int k, int c) { const int kk = (k & ~0xC) | ((k & 4) << 1) | ((k & 8) >> 1); return ((kk >> 3) * 4 + (c >> 5)) * 512 + ((kk & 7) * 32 + (c & 31)) * 2; }
__device__ __forceinline__ int v_rd_base(int lane) { return ((lane & 3) << 3) | (((lane >> 2) & 3) << 6) | (((lane >> 4) & 1) << 5) | (((lane >> 5) & 1) << 8); }
constexpr int v_rd_off(int d0, int ks, int half) { return d0 * 512 + ks * 4096 + half * 2048; }
template <int OFF> __device__ __forceinline__ s16x4 tr_read(int vb) {
    s16x4 r; asm volatile("ds_read_b64_tr_b16 %0, %1 offset:%2" : "=&v"(r) : "v"(vb), "i"(OFF) : "memory"); return r;
}
template <int D0> __device__ __forceinline__ void pv_one(f32x16& od, int vb, bf16x8 pa0, bf16x8 pa1, bf16x8 pa2, bf16x8 pa3) {
    const s16x4 l0 = tr_read<v_rd_off(D0, 0, 0)>(vb), h0 = tr_read<v_rd_off(D0, 0, 1)>(vb), l1 = tr_read<v_rd_off(D0, 1, 0)>(vb), h1 = tr_read<v_rd_off(D0, 1, 1)>(vb);
    const s16x4 l2 = tr_read<v_rd_off(D0, 2, 0)>(vb), h2 = tr_read<v_rd_off(D0, 2, 1)>(vb), l3 = tr_read<v_rd_off(D0, 3, 0)>(vb), h3 = tr_read<v_rd_off(D0, 3, 1)>(vb);
    asm volatile("s_waitcnt lgkmcnt(0)" ::: "memory"); SBAR();
#define PK(L, H) (bf16x8){L[0], L[1], L[2], L[3], H[0], H[1], H[2], H[3]}
    od = __builtin_amdgcn_mfma_f32_32x32x16_bf16(pa0, PK(l0, h0), od, 0, 0, 0);
    od = __builtin_amdgcn_mfma_f32_32x32x16_bf16(pa1, PK(l1, h1), od, 0, 0, 0);
    od = __builtin_amdgcn_mfma_f32_32x32x16_bf16(pa2, PK(l2, h2), od, 0, 0, 0);
    od = __builtin_amdgcn_mfma_f32_32x32x16_bf16(pa3, PK(l3, h3), od, 0, 0, 0);
#undef PK
}
__device__ __forceinline__ void pv_d0(f32x16 (&o)[4], int vb, bf16x8 pa0, bf16x8 pa1, bf16x8 pa2, bf16x8 pa3) {
    pv_one<0>(o[0], vb, pa0, pa1, pa2, pa3); pv_one<1>(o[1], vb, pa0, pa1, pa2, pa3); pv_one<2>(o[2], vb, pa0, pa1, pa2, pa3); pv_one<3>(o[3], vb, pa0, pa1, pa2, pa3);
}
__device__ __forceinline__ float bflo(unsigned w) { return __uint_as_float(w << 16); }
__device__ __forceinline__ float bfhi(unsigned w) { return __uint_as_float(w & 0xffff0000u); }

struct AttnArgs { const bf16_t* Q; const bf16_t* Kb; const bf16_t* Vb; const float* ssp; const float2* cs; const float* q_g; const bf16_t *u, *gb, *sg; const float* conv_w; bf16_t* merged; };

template <int MODE> __device__ __forceinline__ void attn_unit(const AttnArgs& T, int b, int h, int qb, LAS char* lds) {
    int tid = threadIdx.x; asm volatile("" : "+v"(tid));
    const int lane = tid & 63, r32 = lane & 31, hi = lane >> 5; const int wid = __builtin_amdgcn_readfirstlane(tid >> 6);
    LAS char* V_lds = lds + OFF_V; LAS char* K_lds = lds + OFF_K;
    LAS float* ws = (LAS float*)(lds + OFF_WS) + wid * 64; LAS float* li_l = ws; LAS float* al_l = ws + 32;
    const int mrow = b * SEQ + qb * 256 + wid * QBLK + r32;
    const bf16_t* Kh = T.Kb + (size_t)(b * NH + h) * SEQ * QKH; const bf16_t* Vh = T.Vb + (size_t)(b * NH + h) * SEQ * VH;
    const int sr = tid >> 4, sc = (tid & 15) * 8, vst0 = v_st(sr, sc), vst1 = v_st(32 + sr, sc);
    const int kdst = (tid >> 3) * KPITCH + (tid & 7) * 48;
    const int vb0 = (int)(uintptr_t)V_lds + v_rd_base(lane);
    bf16x8 sk0, sk1, sk2, sv0, sv1;
#define SLOAD(t) do { const bf16_t* kp = Kh + (size_t)(t) * KVBLK * QKH + tid * 24; sk0 = *(const bf16x8*)kp; sk1 = *(const bf16x8*)(kp + 8); sk2 = *(const bf16x8*)(kp + 16); \
    const bf16_t* vp = Vh + (size_t)((t) * KVBLK + sr) * VH + sc; sv0 = *(const bf16x8*)vp; sv1 = *(const bf16x8*)(vp + 32 * VH); } while (0)
#define SWRITE(bf) do { *(LAS bf16x8*)(V_lds + (bf) * SHM_V + vst0) = sv0; *(LAS bf16x8*)(V_lds + (bf) * SHM_V + vst1) = sv1; \
    *(LAS bf16x8*)(K_lds + (bf) * SHM_K + kdst) = sk0; *(LAS bf16x8*)(K_lds + (bf) * SHM_K + kdst + 16) = sk1; *(LAS bf16x8*)(K_lds + (bf) * SHM_K + kdst + 32) = sk2; } while (0)
#define RESC(a) do { if (__any((a) < 1.f)) { if (hi == 0) al_l[r32] = (a); asm volatile("s_waitcnt lgkmcnt(0)" ::: "memory"); \
    _Pragma("unroll") for (int d = 0; d < 4; ++d) _Pragma("unroll") for (int r = 0; r < 16; ++r) o[d][r] *= al_l[crow(r, hi)]; } } while (0)
    SLOAD(0);
    bf16x8 qr[8];
    LAS char* qrope = lds + OFF_QR + wid * (32 * QRP) + r32 * QRP + hi * 16;
    {
        const bf16_t* Qw = T.Q + (size_t)mrow * 1536 + h * QKH + hi * 8;
        u32x4 raw[12];
#pragma unroll
        for (int d0 = 0; d0 < 12; ++d0) raw[d0] = *(const u32x4*)(Qw + d0 * 16);
        const f32x2 sq2 = *(const f32x2*)(T.ssp + (size_t)mrow * 4); const float ssq = sq2[0] + sq2[1];
        float ss = 0.f;
#pragma unroll
        for (int d0 = 0; d0 < 12; ++d0)
#pragma unroll
            for (int e = 0; e < 4; ++e) { const float a = bflo(raw[d0][e]), c = bfhi(raw[d0][e]); ss += a * a + c * c; }
        { auto rr = __builtin_amdgcn_permlane32_swap(__float_as_uint(ss), __float_as_uint(ss), false, false); ss = __uint_as_float(rr[0]) + __uint_as_float(rr[1]); }
        const float rq2 = 1.f / (ssq * (1.f / QL) + EPS);
        const float rn = 1.f / sqrtf(ss * rq2 * (1.f / QKH) + EPS) * sqrtf(rq2);
#pragma unroll
        for (int d0 = 0; d0 < 8; ++d0) { const f32x4 g0 = *(const f32x4*)(T.q_g + d0 * 16 + hi * 8), g1 = *(const f32x4*)(T.q_g + d0 * 16 + hi * 8 + 4);
            u32x4 w; w.x = cvt_pk_bf16(bflo(raw[d0].x) * rn * g0[0], bfhi(raw[d0].x) * rn * g0[1]); w.y = cvt_pk_bf16(bflo(raw[d0].y) * rn * g0[2], bfhi(raw[d0].y) * rn * g0[3]);
            w.z = cvt_pk_bf16(bflo(raw[d0].z) * rn * g1[0], bfhi(raw[d0].z) * rn * g1[1]); w.w = cvt_pk_bf16(bflo(raw[d0].w) * rn * g1[2], bfhi(raw[d0].w) * rn * g1[3]);
            qr[d0] = *reinterpret_cast<bf16x8*>(&w); }
#pragma unroll
        for (int p = 0; p < 2; ++p) {
            const int ib = 16 * p + 8 * hi;
            float x1[8], x2[8];
            const f32x4 ga = *(const f32x4*)(T.q_g + 128 + ib), gb_ = *(const f32x4*)(T.q_g + 128 + ib + 4), gc = *(const f32x4*)(T.q_g + 160 + ib), gd = *(const f32x4*)(T.q_g + 160 + ib + 4);
            const float g1v[8] = {ga[0], ga[1], ga[2], ga[3], gb_[0], gb_[1], gb_[2], gb_[3]}, g2v[8] = {gc[0], gc[1], gc[2], gc[3], gd[0], gd[1], gd[2], gd[3]};
#pragma unroll
            for (int e = 0; e < 4; ++e) { x1[2 * e] = bflo(raw[8 + p][e]) * rn * g1v[2 * e]; x1[2 * e + 1] = bfhi(raw[8 + p][e]) * rn * g1v[2 * e + 1];
                                          x2[2 * e] = bflo(raw[10 + p][e]) * rn * g2v[2 * e]; x2[2 * e + 1] = bfhi(raw[10 + p][e]) * rn * g2v[2 * e + 1]; }
            float y1[8], y2[8];
#pragma unroll
            for (int jj = 0; jj < 4; ++jj) { const f32x4 c2 = *(const f32x4*)((const float*)T.cs + ((size_t)mrow * 32 + ib + 2 * jj) * 2);
                y1[2 * jj] = x1[2 * jj] * c2[0] - x2[2 * jj] * c2[1]; y2[2 * jj] = x2[2 * jj] * c2[0] + x1[2 * jj] * c2[1];
                y1[2 * jj + 1] = x1[2 * jj + 1] * c2[2] - x2[2 * jj + 1] * c2[3]; y2[2 * jj + 1] = x2[2 * jj + 1] * c2[2] + x1[2 * jj + 1] * c2[3]; }
            u32x4 w1, w2; w1.x = cvt_pk_bf16(y1[0], y1[1]); w1.y = cvt_pk_bf16(y1[2], y1[3]); w1.z = cvt_pk_bf16(y1[4], y1[5]); w1.w = cvt_pk_bf16(y1[6], y1[7]);
            w2.x = cvt_pk_bf16(y2[0], y2[1]); w2.y = cvt_pk_bf16(y2[2], y2[3]); w2.z = cvt_pk_bf16(y2[4], y2[5]); w2.w = cvt_pk_bf16(y2[6], y2[7]);
            *(LAS u32x4*)(qrope + p * 32) = w1; *(LAS u32x4*)(qrope + (2 + p) * 32) = w2; }
        asm volatile("s_waitcnt lgkmcnt(0)" ::: "memory");
    }
    float m_reg = -1e30f, l_reg = 0.f; f32x16 o[4] = {};
    f32x16 pA0, pA1, pB0, pB1; float alA = 1.f, alB = 1.f; bf16x8 pa0, pa1, pa2, pa3;
    const int NT = 4 * qb + 4; const int wp = wid >> 1;
    const bool a1 = wp >= 1, a2 = wp >= 2, a3 = wp >= 3;
    const LAS char* K0 = K_lds; const LAS char* K1 = K_lds + SHM_K;
    asm volatile("s_waitcnt vmcnt(0)" ::: "memory"); SWRITE(0); __syncthreads();
    qkt(pA0, pA1, K0, qr, qrope, r32, hi); partialSM(pA0, pA1, m_reg, alA);
    SLOAD(1); asm volatile("s_waitcnt vmcnt(0)" ::: "memory"); SWRITE(1); __syncthreads();
    for (int j = 1; j + 3 < NT; j += 2) {
        SBAR(); qkt(pB0, pB1, K1, qr, qrope, r32, hi);
        finishSM(pA0, pA1, alA, l_reg, pa0, pa1, pa2, pa3); SBAR();
        SLOAD(j + 1); SBAR();
        pv_d0(o, vb0, pa0, pa1, pa2, pa3); partialSM(pB0, pB1, m_reg, alB);
        __syncthreads(); asm volatile("s_waitcnt vmcnt(0)" ::: "memory"); SWRITE(0);
        RESC(alB); __syncthreads();
        SBAR(); qkt(pA0, pA1, K0, qr, qrope, r32, hi);
        finishSM(pB0, pB1, alB, l_reg, pa0, pa1, pa2, pa3); SBAR();
        SLOAD(j + 2); SBAR();
        pv_d0(o, vb0 + SHM_V, pa0, pa1, pa2, pa3); partialSM(pA0, pA1, m_reg, alA);
        __syncthreads(); asm volatile("s_waitcnt vmcnt(0)" ::: "memory"); SWRITE(1);
        RESC(alA); __syncthreads();
    }
#define MASK(P0, P1, act) do { if (!(act)) { _Pragma("unroll") for (int r = 0; r < 16; ++r) { P0[r] = -INFINITY; P1[r] = -INFINITY; } } } while (0)
    {
        SBAR(); if (a1) qkt(pB0, pB1, K1, qr, qrope, r32, hi); MASK(pB0, pB1, a1);
        finishSM(pA0, pA1, alA, l_reg, pa0, pa1, pa2, pa3); SBAR();
        SLOAD(NT - 2); SBAR();
        pv_d0(o, vb0, pa0, pa1, pa2, pa3); partialSM(pB0, pB1, m_reg, alB);
        __syncthreads(); asm volatile("s_waitcnt vmcnt(0)" ::: "memory"); SWRITE(0);
        RESC(alB); __syncthreads();
        SBAR(); if (a2) qkt(pA0, pA1, K0, qr, qrope, r32, hi); MASK(pA0, pA1, a2);
        finishSM(pB0, pB1, alB, l_reg, pa0, pa1, pa2, pa3); SBAR();
        SLOAD(NT - 1); SBAR();
        pv_d0(o, vb0 + SHM_V, pa0, pa1, pa2, pa3); partialSM(pA0, pA1, m_reg, alA);
        __syncthreads(); asm volatile("s_waitcnt vmcnt(0)" ::: "memory"); SWRITE(1);
        RESC(alA); __syncthreads();
        SBAR(); if (a3) qkt(pB0, pB1, K1, qr, qrope, r32, hi); MASK(pB0, pB1, a3);
        finishSM(pA0, pA1, alA, l_reg, pa0, pa1, pa2, pa3); SBAR();
        pv_d0(o, vb0, pa0, pa1, pa2, pa3); partialSM(pB0, pB1, m_reg, alB);
        RESC(alB);
        finishSM(pB0, pB1, alB, l_reg, pa0, pa1, pa2, pa3); SBAR();
        pv_d0(o, vb0 + SHM_V, pa0, pa1, pa2, pa3);
    }
#undef MASK
    if (hi == 0) li_l[r32] = l_reg; asm volatile("s_waitcnt lgkmcnt(0)" ::: "memory");
    float rli[16];
#pragma unroll
    for (int r = 0; r < 16; ++r) rli[r] = __builtin_amdgcn_rcpf(li_l[crow(r, hi)]);
    __syncthreads();
    LAS bf16_t* stg = (LAS bf16_t*)(lds + wid * 8192);
#pragma unroll
    for (int r = 0; r < 16; ++r) { const int orow = crow(r, hi);
#pragma unroll
        for (int d0 = 0; d0 < 4; ++d0) stg[orow * 128 + d0 * 32 + r32] = f2bf(o[d0][r] * rli[r]); }
    asm volatile("s_waitcnt lgkmcnt(0)" ::: "memory");
    if (MODE != 1) {
        const int ch = lane & 15, c = h * VH + ch * 8;
        const f32x4 w0a = *(const f32x4*)(T.conv_w + c), w0b = *(const f32x4*)(T.conv_w + c + 4), w1a = *(const f32x4*)(T.conv_w + DM + c), w1b = *(const f32x4*)(T.conv_w + DM + c + 4),
              w2a = *(const f32x4*)(T.conv_w + 2 * DM + c), w2b = *(const f32x4*)(T.conv_w + 2 * DM + c + 4);
        const float cw0[8] = {w0a[0], w0a[1], w0a[2], w0a[3], w0b[0], w0b[1], w0b[2], w0b[3]}, cw1[8] = {w1a[0], w1a[1], w1a[2], w1a[3], w1b[0], w1b[1], w1b[2], w1b[3]},
                    cw2[8] = {w2a[0], w2a[1], w2a[2], w2a[3], w2b[0], w2b[1], w2b[2], w2b[3]};
#pragma unroll 4
        for (int i = 0; i < 8; ++i) { const int row = i * 4 + (lane >> 4); const int tt = qb * 256 + wid * QBLK + row; const size_t e = (size_t)(b * SEQ + tt) * DM + c;
            const u32x4 ov = *(const LAS u32x4*)(stg + row * 128 + ch * 8);
            const u32x4 u0 = *(const u32x4*)(T.u + e), gbv = *(const u32x4*)(T.gb + e), sgv = *(const u32x4*)(T.sg + e);
            u32x4 u1 = {0u, 0u, 0u, 0u}, u2 = {0u, 0u, 0u, 0u};
            if (tt >= 1) u1 = *(const u32x4*)(T.u + e - DM);
            if (tt >= 2) u2 = *(const u32x4*)(T.u + e - 2 * DM);
            u32x4 res;
#pragma unroll
            for (int q = 0; q < 4; ++q) {
                const float cl = cw0[2 * q] * bflo(u2[q]) + cw1[2 * q] * bflo(u1[q]) + cw2[2 * q] * bflo(u0[q]), chh = cw0[2 * q + 1] * bfhi(u2[q]) + cw1[2 * q + 1] * bfhi(u1[q]) + cw2[2 * q + 1] * bfhi(u0[q]);
                res[q] = cvt_pk_bf16(bflo(gbv[q]) * cl + bflo(sgv[q]) * bflo(ov[q]), bfhi(gbv[q]) * chh + bfhi(sgv[q]) * bfhi(ov[q])); }
            *(u32x4*)(T.merged + e) = res; }
    }
    asm volatile("s_waitcnt lgkmcnt(0)" ::: "memory");
    __syncthreads();
#undef SLOAD
#undef SWRITE
#undef RESC
}

constexpr int K2_BYTES = KVBLK * QKH * 2, V2_OFF = 0, K2_OFF = 3 * SHM_V, WS2_OFF = K2_OFF + 2 * K2_BYTES, ATT2_LDS = WS2_OFF + NW * 64 * 4;
__device__ __forceinline__ void qkt2(f32x16& p0, f32x16& p1, const LAS char* Krow, const int (&koff)[4], const bf16x8 (&qr)[12]) {
    p0 = f32x16{}; p1 = f32x16{};
    bf16x8 fa[4], fb[4];
#define KRD(dst, d0) do { const LAS char* a_ = Krow + ((d0) >> 2) * 128 + koff[(d0) & 3]; dst[0] = *(const LAS bf16x8*)a_; dst[1] = *(const LAS bf16x8*)(a_ + 32 * QKH * 2); \
                          const LAS char* c_ = Krow + (((d0) + 1) >> 2) * 128 + koff[((d0) + 1) & 3]; dst[2] = *(const LAS bf16x8*)c_; dst[3] = *(const LAS bf16x8*)(c_ + 32 * QKH * 2); } while (0)
#define KMM(src, d0) do { p0 = __builtin_amdgcn_mfma_f32_32x32x16_bf16(src[0], qr[d0], p0, 0, 0, 0); p1 = __builtin_amdgcn_mfma_f32_32x32x16_bf16(src[1], qr[d0], p1, 0, 0, 0); \
                          p0 = __builtin_amdgcn_mfma_f32_32x32x16_bf16(src[2], qr[(d0) + 1], p0, 0, 0, 0); p1 = __builtin_amdgcn_mfma_f32_32x32x16_bf16(src[3], qr[(d0) + 1], p1, 0, 0, 0); } while (0)
    KRD(fa, 0); KRD(fb, 2);
    KMM(fa, 0); KRD(fa, 4);
    KMM(fb, 2); KRD(fb, 6);
    KMM(fa, 4); KRD(fa, 8);
    KMM(fb, 6); KRD(fb, 10);
    KMM(fa, 8);
    KMM(fb, 10);
#undef KRD
#undef KMM
}
template <int MODE> __device__ __forceinline__ void attn_unit2(const AttnArgs& T, int b, int h, int qb, LAS char* lds) {
    int tid = threadIdx.x; asm volatile("" : "+v"(tid));
    const int lane = tid & 63, r32 = lane & 31, hi = lane >> 5; const int wid = __builtin_amdgcn_readfirstlane(tid >> 6);
    LAS char* V_lds = lds + V2_OFF; LAS char* K_lds = lds + K2_OFF;
    LAS float* ws = (LAS float*)(lds + WS2_OFF) + wid * 64; LAS float* li_l = ws; LAS float* al_l = ws + 32;
    const int mrow = b * SEQ + qb * 256 + wid * QBLK + r32;
    const char* Kh = (const char*)(T.Kb + (size_t)(b * NH + h) * SEQ * QKH); const char* Vh = (const char*)(T.Vb + (size_t)(b * NH + h) * SEQ * VH);
#define DMA_KV(t, kbuf, vbuf) do { const char* kt = Kh + (size_t)(t) * K2_BYTES; const char* vt = Vh + (size_t)(t) * SHM_V; int ln = lane; asm volatile("" : "+v"(ln)); \
    _Pragma("unroll") for (int _i = 0; _i < 3; ++_i) { const int q = (wid * 3 + _i) * 64 + ln, r = q / 24, cp = q - r * 24, c = (cp & ~7) | ((cp & 7) ^ ((r >> 1) & 7)); \
        __builtin_amdgcn_global_load_lds((const unsigned*)(kt + (unsigned)(r * 384 + c * 16)), (LAS unsigned*)(K_lds + (kbuf) * K2_BYTES + (wid * 3 + _i) * 1024), 16, 0, 0); } \
    _Pragma("unroll") for (int _i = 0; _i < 2; ++_i) { const int q = (wid * 2 + _i) * 64 + ln, sub = q >> 5, w = q & 31, kk = ((sub >> 2) << 3) | (w >> 2), k = (kk & ~0xC) | ((kk & 4) << 1) | ((kk & 8) >> 1), c = ((sub & 3) << 5) | ((w & 3) << 3); \
        __builtin_amdgcn_global_load_lds((const unsigned*)(vt + (unsigned)(k * 256 + c * 2)), (LAS unsigned*)(V_lds + (vbuf) * SHM_V + (wid * 2 + _i) * 1024), 16, 0, 0); } } while (0)
#define RESC(a) do { if (__any((a) < 1.f)) { if (hi == 0) al_l[r32] = (a); asm volatile("s_waitcnt lgkmcnt(0)" ::: "memory"); \
    _Pragma("unroll") for (int d = 0; d < 4; ++d) _Pragma("unroll") for (int r = 0; r < 16; ++r) o[d][r] *= al_l[crow(r, hi)]; } } while (0)
    DMA_KV(0, 0, 0);
    const int vb0 = (int)(uintptr_t)V_lds + v_rd_base(lane);
    const LAS char* Krow = K_lds + r32 * (QKH * 2);
    int koff[4];
    { const int sw = (r32 >> 1) & 7;
#pragma unroll
      for (int j = 0; j < 4; ++j) koff[j] = ((2 * j + hi) ^ sw) * 16; }
    bf16x8 qr[12];
    {
        const bf16_t* Qw = T.Q + (size_t)mrow * 1536 + h * QKH + hi * 8;
        u32x4 raw[12];
#pragma unroll
        for (int d0 = 0; d0 < 12; ++d0) raw[d0] = *(const u32x4*)(Qw + d0 * 16);
        const f32x2 sq2 = *(const f32x2*)(T.ssp + (size_t)mrow * 4); const float ssq = sq2[0] + sq2[1];
        float ss = 0.f;
#pragma unroll
        for (int d0 = 0; d0 < 12; ++d0)
#pragma unroll
            for (int e = 0; e < 4; ++e) { const float a = bflo(raw[d0][e]), c = bfhi(raw[d0][e]); ss += a * a + c * c; }
        { auto rr = __builtin_amdgcn_permlane32_swap(__float_as_uint(ss), __float_as_uint(ss), false, false); ss = __uint_as_float(rr[0]) + __uint_as_float(rr[1]); }
        const float rq2 = 1.f / (ssq * (1.f / QL) + EPS);
        const float rn = 1.f / sqrtf(ss * rq2 * (1.f / QKH) + EPS) * sqrtf(rq2);
#pragma unroll
        for (int d0 = 0; d0 < 8; ++d0) { const f32x4 g0 = *(const f32x4*)(T.q_g + d0 * 16 + hi * 8), g1 = *(const f32x4*)(T.q_g + d0 * 16 + hi * 8 + 4);
            u32x4 w; w.x = cvt_pk_bf16(bflo(raw[d0].x) * rn * g0[0], bfhi(raw[d0].x) * rn * g0[1]); w.y = cvt_pk_bf16(bflo(raw[d0].y) * rn * g0[2], bfhi(raw[d0].y) * rn * g0[3]);
            w.z = cvt_pk_bf16(bflo(raw[d0].z) * rn * g1[0], bfhi(raw[d0].z) * rn * g1[1]); w.w = cvt_pk_bf16(bflo(raw[d0].w) * rn * g1[2], bfhi(raw[d0].w) * rn * g1[3]);
            qr[d0] = *reinterpret_cast<bf16x8*>(&w); }
#pragma unroll
        for (int p = 0; p < 2; ++p) {
            const int ib = 16 * p + 8 * hi;
            float x1[8], x2[8];
            const f32x4 ga = *(const f32x4*)(T.q_g + 128 + ib), gb_ = *(const f32x4*)(T.q_g + 128 + ib + 4), gc = *(const f32x4*)(T.q_g + 160 + ib), gd = *(const f32x4*)(T.q_g + 160 + ib + 4);
            const float g1v[8] = {ga[0], ga[1], ga[2], ga[3], gb_[0], gb_[1], gb_[2], gb_[3]}, g2v[8] = {gc[0], gc[1], gc[2], gc[3], gd[0], gd[1], gd[2], gd[3]};
#pragma unroll
            for (int e = 0; e < 4; ++e) { x1[2 * e] = bflo(raw[8 + p][e]) * rn * g1v[2 * e]; x1[2 * e + 1] = bfhi(raw[8 + p][e]) * rn * g1v[2 * e + 1];
                                          x2[2 * e] = bflo(raw[10 + p][e]) * rn * g2v[2 * e]; x2[2 * e + 1] = bfhi(raw[10 + p][e]) * rn * g2v[2 * e + 1]; }
            float y1[8], y2[8];
#pragma unroll
            for (int jj = 0; jj < 4; ++jj) { const f32x4 c2 = *(const f32x4*)((const float*)T.cs + ((size_t)mrow * 32 + ib + 2 * jj) * 2);
                y1[2 * jj] = x1[2 * jj] * c2[0] - x2[2 * jj] * c2[1]; y2[2 * jj] = x2[2 * jj] * c2[0] + x1[2 * jj] * c2[1];
                y1[2 * jj + 1] = x1[2 * jj + 1] * c2[2] - x2[2 * jj + 1] * c2[3]; y2[2 * jj + 1] = x2[2 * jj + 1] * c2[2] + x1[2 * jj + 1] * c2[3]; }
            u32x4 w1, w2; w1.x = cvt_pk_bf16(y1[0], y1[1]); w1.y = cvt_pk_bf16(y1[2], y1[3]); w1.z = cvt_pk_bf16(y1[4], y1[5]); w1.w = cvt_pk_bf16(y1[6], y1[7]);
            w2.x = cvt_pk_bf16(y2[0], y2[1]); w2.y = cvt_pk_bf16(y2[2], y2[3]); w2.z = cvt_pk_bf16(y2[4], y2[5]); w2.w = cvt_pk_bf16(y2[6], y2[7]);
            qr[8 + p] = *reinterpret_cast<bf16x8*>(&w1); qr[10 + p] = *reinterpret_cast<bf16x8*>(&w2); }
    }
    float m_reg = -1e30f, l_reg = 0.f; f32x16 o[4] = {};
    f32x16 pA0, pA1, pB0, pB1; float alA = 1.f, alB = 1.f; bf16x8 pa0, pa1, pa2, pa3;
    const int NT = 4 * qb + 4; const int wp = wid >> 1;
    const bool a1 = wp >= 1, a2 = wp >= 2, a3 = wp >= 3;
#define MASK(P0, P1, act) do { if (!(act)) { _Pragma("unroll") for (int r = 0; r < 16; ++r) { P0[r] = -INFINITY; P1[r] = -INFINITY; } } } while (0)
#define INTERVAL(PN0, PN1, PO0, PO1, alN, alO, t, act, load) do { \
        if (load) DMA_KV((t) + 1, ((t) + 1) & 1, vnext); \
        SBAR(); if (act) qkt2(PN0, PN1, Krow + ((t) & 1) * K2_BYTES, koff, qr); MASK(PN0, PN1, act); \
        if (MODE == 2) { asm volatile("" : "+v"(PO0), "+v"(PO1)); pa0 = __builtin_bit_cast(bf16x8, (u32x4){__float_as_uint(PO0[0]), __float_as_uint(PO0[1]), __float_as_uint(PO0[2]), __float_as_uint(PO0[3])}); pa1 = pa0; pa2 = pa0; pa3 = pa0; } \
        else finishSM(PO0, PO1, alO, l_reg, pa0, pa1, pa2, pa3); \
        SBAR(); pv_d0(o, vb0 + vprev * SHM_V, pa0, pa1, pa2, pa3); if (MODE == 2) { asm volatile("" : "+v"(PN0), "+v"(PN1)); } else partialSM(PN0, PN1, m_reg, alN); \
        __syncthreads(); RESC(alN); \
        vprev = vcur; vcur = vnext; vnext = (vnext == 2) ? 0 : vnext + 1; } while (0)
    __syncthreads();
    int vprev = 0, vcur = 1, vnext = 2;
    DMA_KV(1, 1, 1);
    qkt2(pA0, pA1, Krow, koff, qr); partialSM(pA0, pA1, m_reg, alA);
    __syncthreads();
    for (int j = 1; j + 3 < NT; j += 2) {
        INTERVAL(pB0, pB1, pA0, pA1, alB, alA, j, true, true);
        INTERVAL(pA0, pA1, pB0, pB1, alA, alB, j + 1, true, true);
    }
    INTERVAL(pB0, pB1, pA0, pA1, alB, alA, NT - 3, a1, true);
    INTERVAL(pA0, pA1, pB0, pB1, alA, alB, NT - 2, a2, true);
    INTERVAL(pB0, pB1, pA0, pA1, alB, alA, NT - 1, a3, false);
    finishSM(pB0, pB1, alB, l_reg, pa0, pa1, pa2, pa3); SBAR();
    pv_d0(o, vb0 + vprev * SHM_V, pa0, pa1, pa2, pa3);
#undef INTERVAL
#undef MASK
    if (hi == 0) li_l[r32] = l_reg; asm volatile("s_waitcnt lgkmcnt(0)" ::: "memory");
    float rli[16];
#pragma unroll
    for (int r = 0; r < 16; ++r) rli[r] = __builtin_amdgcn_rcpf(li_l[crow(r, hi)]);
    __syncthreads();
    LAS bf16_t* stg = (LAS bf16_t*)(lds + wid * 8192);
#pragma unroll
    for (int r = 0; r < 16; ++r) { const int orow = crow(r, hi);
#pragma unroll
        for (int d0 = 0; d0 < 4; ++d0) stg[orow * 128 + d0 * 32 + r32] = f2bf(o[d0][r] * rli[r]); }
    asm volatile("s_waitcnt lgkmcnt(0)" ::: "memory");
    if (MODE == 0) {
        const int g = lane >> 4, ch = lane & 15, c = h * VH + ch * 8; const int t0 = qb * 256 + wid * QBLK;
        const size_t e0 = (size_t)(b * SEQ + t0) * DM + c;
        u32x4 uu[8], gv[8], sv[8];
#pragma unroll
        for (int i = 0; i < 8; ++i) { const size_t e = e0 + (size_t)(4 * i + g) * DM; uu[i] = *(const u32x4*)(T.u + e); gv[i] = __builtin_nontemporal_load((const u32x4*)(T.gb + e)); sv[i] = __builtin_nontemporal_load((const u32x4*)(T.sg + e)); }
        u32x4 uvirt = {0u, 0u, 0u, 0u};
        if (g >= 2 && t0 > 0) uvirt = *(const u32x4*)(T.u + e0 - (size_t)(4 - g) * DM);
        const f32x4 w0a = *(const f32x4*)(T.conv_w + c), w0b = *(const f32x4*)(T.conv_w + c + 4), w1a = *(const f32x4*)(T.conv_w + DM + c), w1b = *(const f32x4*)(T.conv_w + DM + c + 4),
              w2a = *(const f32x4*)(T.conv_w + 2 * DM + c), w2b = *(const f32x4*)(T.conv_w + 2 * DM + c + 4);
        const float cw0[8] = {w0a[0], w0a[1], w0a[2], w0a[3], w0b[0], w0b[1], w0b[2], w0b[3]}, cw1[8] = {w1a[0], w1a[1], w1a[2], w1a[3], w1b[0], w1b[1], w1b[2], w1b[3]},
                    cw2[8] = {w2a[0], w2a[1], w2a[2], w2a[3], w2b[0], w2b[1], w2b[2], w2b[3]};
        const int src1 = ((lane - 16) & 63) << 2, src2 = (lane ^ 32) << 2;
#pragma unroll
        for (int i = 0; i < 8; ++i) { const int row = i * 4 + g; const size_t e = e0 + (size_t)row * DM;
            const u32x4 ov = *(const LAS u32x4*)(stg + row * 128 + ch * 8);
            const u32x4 up = (i == 0) ? uvirt : uu[i > 0 ? i - 1 : 0];
            u32x4 u1, u2, res;
#pragma unroll
            for (int q = 0; q < 4; ++q) { const unsigned x1 = (g == 3) ? up[q] : uu[i][q], x2 = (g >= 2) ? up[q] : uu[i][q];
                u1[q] = (unsigned)__builtin_amdgcn_ds_bpermute(src1, (int)x1); u2[q] = (unsigned)__builtin_amdgcn_ds_bpermute(src2, (int)x2); }
#pragma unroll
            for (int q = 0; q < 4; ++q) {
                const float cl = cw0[2 * q] * bflo(u2[q]) + cw1[2 * q] * bflo(u1[q]) + cw2[2 * q] * bflo(uu[i][q]), chh = cw0[2 * q + 1] * bfhi(u2[q]) + cw1[2 * q + 1] * bfhi(u1[q]) + cw2[2 * q + 1] * bfhi(uu[i][q]);
                res[q] = cvt_pk_bf16(bflo(gv[i][q]) * cl + bflo(sv[i][q]) * bflo(ov[q]), bfhi(gv[i][q]) * chh + bfhi(sv[i][q]) * bfhi(ov[q])); }
            *(u32x4*)(T.merged + e) = res; }
    }
    asm volatile("s_waitcnt lgkmcnt(0)" ::: "memory");
    __syncthreads();
#undef DMA_KV
#undef RESC
}
#undef SBAR
}
#ifndef ATTN_UNIT
#define ATTN_UNIT attn_unit2
#endif
struct Frame {
    LAS unsigned char* lds; volatile LAS unsigned* MISC; unsigned* ctl;
    int tid, lane, wave, vcu, G;
};
__device__ __forceinline__ float wave_sum(float v) {
#pragma unroll
    for (int o = 1; o < 64; o <<= 1) v += __shfl_xor(v, o);
    return v;
}
__device__ __forceinline__ int tcc(int bj, int ch128) { return (bj << 7) | (ch128 & 0x60) | (((ch128 >> 2) & 1) << 4) | (((ch128 >> 3) & 3) << 2) | (ch128 & 3); }
struct MapIn { __device__ __forceinline__ int operator()(int c) const {
    if (c < C_ZB) return 256 * (c >> 7) + tcc(0, c & 127);
    if (c < C_ZC) { const int ch = c - C_ZB; return 256 * (8 + (ch >> 7)) + tcc(0, ch & 127); }
    if (c < C_QL) { const int ch = c - C_ZC; return 256 * (ch >> 7) + tcc(1, ch & 127); }
    if (c < C_KVL) { const int j = c - C_QL; return j < 256 ? 256 * 20 + permL(j) : 256 * 21 + permL(j - 256); }
    if (c < C_KR) return 256 * 22 + permL(c - C_KVL);
    if (c < C_GC) { const int j = c - C_KR, jj = j & 31; return 256 * 21 + 128 + ((jj >> 4) << 5) + ((j >> 5) << 4) + (((jj >> 2) & 3) << 2) + (jj & 3); }
    if (c < C_GM) { const int ch = c - C_GC; return 256 * (8 + (ch >> 7)) + tcc(1, ch & 127); }
    { const int j = c - C_GM; return 256 * (16 + (j >> 8)) + permL(j & 255); } } };
struct MapPerm { __device__ __forceinline__ int operator()(int c) const { return (c & ~255) | permL(c & 255); } };
struct MapId { __device__ __forceinline__ int operator()(int c) const { return c; } };
struct MapGU { int n; __device__ __forceinline__ int operator()(int f) const { const int r = f & 127; return 256 * (f >> 7) + ((((r >> 2) & 1) << 7) | ((r >> 5) << 5) | (n << 4) | (((r >> 3) & 3) << 2) | (r & 3)); } };

template <class RowMap>
__device__ __forceinline__ void transpose_item(const float* W, int N, bf16_t* WT, int ldt, const float* kscale, LAS float* scr, int item, int lane, const RowMap& rm) {
    const int nblk = N / 32, kb = item / nblk, nb = item % nblk, k0 = 64 * kb, n0 = 32 * nb;
    float wv[32];
#pragma unroll
    for (int i = 0; i < 32; ++i) wv[i] = __builtin_nontemporal_load(W + (size_t)(k0 + 2 * i + (lane >> 5)) * N + n0 + (lane & 31));
#pragma unroll
    for (int i = 0; i < 32; ++i) { const int kk = 2 * i + (lane >> 5); const float sc = kscale ? kscale[k0 + kk] : 1.f; scr[kk * 33 + (lane & 31)] = wv[i] * sc; }
    asm volatile("s_waitcnt lgkmcnt(0)" ::: "memory");
    const int c = lane & 7;
#pragma unroll
    for (int j = 0; j < 4; ++j) { const int n = (lane >> 3) + 8 * j; const LAS float* s = scr + (8 * c) * 33 + n;
        u32x4 o; o.x = cvt_pk_bf16(s[0 * 33], s[1 * 33]); o.y = cvt_pk_bf16(s[2 * 33], s[3 * 33]); o.z = cvt_pk_bf16(s[4 * 33], s[5 * 33]); o.w = cvt_pk_bf16(s[6 * 33], s[7 * 33]);
        *(u32x4*)(WT + (size_t)rm(n0 + n) * ldt + k0 + 8 * c) = o; }
    asm volatile("s_waitcnt lgkmcnt(0)" ::: "memory");
}
constexpr size_t WS_WIN = WS_WSMALL, WS_WQ = WS_WIN + (size_t)5888 * 1024 * 2, WS_WKV = WS_WQ + (size_t)1536 * 384 * 2, WS_WO = WS_WKV + (size_t)2048 * 256 * 2;
static_assert(WS_WO + (size_t)1024 * 1024 * 2 <= WS_A, "small weights fit below region A");
constexpr size_t WS_EGU = WS_C, WS_EDN = WS_C + (size_t)NEXP * 512 * 1024 * 2;
static_assert(WS_EDN + (size_t)NEXP * 1024 * 256 * 2 <= WS_D, "expert weights fit region C");

__device__ __forceinline__ void p0_weights_tables(const Ptrs& P, Frame& F) {
    LAS float* scr = (LAS float*)(F.lds + RING_OFF + F.wave * 16384);
    const int gw = F.vcu * NWAVES + F.wave, NGW = F.G * NWAVES;
    constexpr int I_IN = (DM / 64) * (DIN / 32), I_Q = (QL / 64) * (1536 / 32), I_KV = (KVL / 64) * (2048 / 32), I_O = (DM / 64) * (DM / 32);
    for (int it = gw; it < I_IN + I_Q + I_KV + I_O; it += NGW) {
        int r = it;
        if (r < I_IN) { transpose_item(P.w_in, DIN, (bf16_t*)(P.ws + WS_WIN), DM, (const float*)nullptr, scr, r, F.lane, MapIn{}); continue; } r -= I_IN;
        if (r < I_Q) { transpose_item(P.w_q_b, 1536, (bf16_t*)(P.ws + WS_WQ), QL, P.q_a_g, scr, r, F.lane, MapPerm{}); continue; } r -= I_Q;
        if (r < I_KV) { transpose_item(P.w_kv_b, 2048, (bf16_t*)(P.ws + WS_WKV), KVL, P.kv_a_g, scr, r, F.lane, MapPerm{}); continue; } r -= I_KV;
        transpose_item(P.w_o, DM, (bf16_t*)(P.ws + WS_WO), DM, (const float*)nullptr, scr, r, F.lane, MapPerm{});
    }
    {
        const int gt = F.vcu * 512 + F.tid;
        if (gt < 64 * 128) { const int rr = 192 + (gt >> 7), ch = gt & 127; *(u32x4*)((bf16_t*)(P.ws + WS_WIN) + (size_t)(256 * 21 + rr) * DM + ch * 8) = (u32x4){0u, 0u, 0u, 0u}; } }
    {
        float2* cs = (float2*)(P.ws + WS_CS);
        for (int idx = F.vcu * 512 + F.tid; idx < M * 32; idx += F.G * 512) { const int m = idx >> 5, i = idx & 31;
            const double inv = exp2(-(double)(2 * i) * (13.287712379549449 / 64.0));
            const double ang = (double)P.pos[m] * inv; float2 v; v.x = (float)cos(ang); v.y = (float)sin(ang); cs[idx] = v; } }
    asm volatile("s_waitcnt vmcnt(0) lgkmcnt(0)" ::: "memory"); __syncthreads();
}
__device__ __forceinline__ void p0_mod(const Ptrs& P, Frame& F) {
    if (F.vcu < 192) {
        LAS float* cact = (LAS float*)(F.lds + RING_OFF); LAS float* red = (LAS float*)(F.lds + RING_OFF + 65536);
        for (int idx = F.tid; idx < BATCH * DM; idx += 512) { const float cv = P.c[idx]; cact[idx] = cv / (1.f + __expf(-cv)); }
        __syncthreads();
        const int n0 = 32 * F.vcu, kl = F.lane >> 3, c4 = F.lane & 7;
        f32x4 acc[16];
#pragma unroll
        for (int b = 0; b < 16; ++b) acc[b] = (f32x4){0.f, 0.f, 0.f, 0.f};
        for (int it = 0; it < 16; ++it) { const int k = 128 * F.wave + 8 * it + kl;
            const f32x4 wv = __builtin_nontemporal_load((const f32x4*)(P.w_ada + (size_t)k * 6144 + n0 + 4 * c4));
#pragma unroll
            for (int b = 0; b < 16; ++b) acc[b] += cact[b * DM + k] * wv; }
#pragma unroll
        for (int b = 0; b < 16; ++b)
#pragma unroll
            for (int e = 0; e < 4; ++e) { float v = acc[b][e]; v += __shfl_xor(v, 8); v += __shfl_xor(v, 16); v += __shfl_xor(v, 32); if (kl == 0) red[(F.wave * 16 + b) * 32 + 4 * c4 + e] = v; }
        __syncthreads();
        { const int b = F.tid >> 5, cc = F.tid & 31; float s = P.b_ada[n0 + cc];
#pragma unroll
          for (int w = 0; w < 8; ++w) s += red[(w * 16 + b) * 32 + cc];
          ((float*)(P.ws + WS_MOD))[b * 6144 + n0 + cc] = s; }
        __syncthreads();
    }
}
__device__ __forceinline__ void expert_weight_items(const Ptrs& P, Frame& F, int w, int nw, int k_lo, int k_hi) {
    LAS float* scr = (LAS float*)(F.lds + RING_OFF + F.wave * 16384);
    constexpr int I_G = (DM / 64) * (DEXP / 32), I_D = (DEXP / 64) * (DM / 32);
    for (int k = k_lo; k < k_hi; ++k) { const int it = w + k * nw; if (it >= NEXP * (2 * I_G + I_D)) break;
        const int e = it / (2 * I_G + I_D); int r = it % (2 * I_G + I_D);
        bf16_t* gu = (bf16_t*)(P.ws + WS_EGU) + (size_t)e * 512 * DM; bf16_t* dn = (bf16_t*)(P.ws + WS_EDN) + (size_t)e * DM * DEXP;
        if (r < I_G) { transpose_item(P.w_gate + (size_t)e * DM * DEXP, DEXP, gu, DM, (const float*)nullptr, scr, r, F.lane, MapGU{0}); continue; } r -= I_G;
        if (r < I_G) { transpose_item(P.w_up + (size_t)e * DM * DEXP, DEXP, gu, DM, (const float*)nullptr, scr, r, F.lane, MapGU{1}); continue; } r -= I_G;
        transpose_item(P.w_down + (size_t)e * DEXP * DM, DM, dn, DEXP, (const float*)nullptr, scr, r, F.lane, MapPerm{});
    }
}
__device__ __forceinline__ void p1_norm1(const Ptrs& P, Frame& F) {
    const int gw = F.vcu * NWAVES + F.wave, NGW = F.G * NWAVES;
    bf16_t* h = (bf16_t*)(P.ws + WS_A);
    for (int m0 = gw; m0 < M; m0 += 4 * NGW) {
        f32x4 v[4][4]; float s[4];
#pragma unroll
        for (int r = 0; r < 4; ++r) { const int mr = (m0 + r * NGW < M) ? m0 + r * NGW : m0; const f32x4* xr = (const f32x4*)(P.x + (size_t)mr * DM) + F.lane;
#pragma unroll
            for (int j = 0; j < 4; ++j) v[r][j] = __builtin_nontemporal_load(xr + 64 * j); }
#pragma unroll
        for (int r = 0; r < 4; ++r) { float a = 0.f;
#pragma unroll
            for (int j = 0; j < 4; ++j) a += (v[r][j][0] * v[r][j][0] + v[r][j][1] * v[r][j][1]) + (v[r][j][2] * v[r][j][2] + v[r][j][3] * v[r][j][3]);
            s[r] = 1.f / sqrtf(wave_sum(a) * (1.f / DM) + EPS); }
#pragma unroll
        for (int r = 0; r < 4; ++r) { const int m = m0 + r * NGW; if (m >= M) continue; const float* mod = (const float*)(P.ws + WS_MOD) + (m / SEQ) * 6144;
            unsigned long long* o8 = (unsigned long long*)(h + (size_t)m * DM) + F.lane;
#pragma unroll
            for (int j = 0; j < 4; ++j) { const int d = 4 * F.lane + 256 * j;
                const f32x4 g = *(const f32x4*)(P.norm1_g + d), sc = *(const f32x4*)(mod + 1024 + d), sh = *(const f32x4*)(mod + d);
                const f32x4 rr = v[r][j] * s[r] * g * (sc + 1.f) + sh;
                o8[64 * j] = (unsigned long long)cvt_pk_bf16(rr[0], rr[1]) | ((unsigned long long)cvt_pk_bf16(rr[2], rr[3]) << 32); } }
    }
}

constexpr size_t WS_WR = 30 * MiB;
constexpr size_t WS_STOK = WS_RT + 512 * 1024, WS_SW = WS_STOK + 320 * 1024;
constexpr int MAXROWS = 81920, MAXTILES = 320;
constexpr size_t WS_H2 = WS_B, WS_HACT = WS_B + 64 * MiB;
constexpr size_t WS_X1B = WS_B + 128 * MiB;
constexpr size_t WS_DELTA = WS_D, WS_Y0 = WS_A, WS_Y1 = WS_D + 64 * MiB;
constexpr int CW_T = CW_TILES, CW_T0 = CW_TILES + 1, CW_TGRP = CW_TILES + 64;

__device__ __forceinline__ void p0_router_weights(const Ptrs& P, Frame& F) {
    bf16_t* hi = (bf16_t*)(P.ws + WS_WR); bf16_t* lo = hi + 48 * DM;
    for (int idx = F.vcu * 512 + F.tid; idx < 48 * DM; idx += F.G * 512) { const int o = idx >> 10, k = idx & 1023;
        const float v = o < 4 ? P.w_rg[k * 4 + o] : (o < 36 ? P.w_re[k * 32 + o - 4] : 0.f);
        const bf16_t h = f2bf(v); hi[idx] = h; lo[idx] = f2bf(v - bf2f(h)); }
}
template <int MODE> __device__ __forceinline__ void p6_rows(const Ptrs& P, Frame& F) {
    LAS unsigned char* tile = F.lds + RING_OFF + F.wave * 8192;
    LAS float* lg = (LAS float*)(F.lds + RING_OFF + 65536 + F.wave * 1536);
    LAS unsigned char* wch = F.lds + RING_OFF + 77824;
    LAS float* gms = (LAS float*)(F.lds + XCH_OFF);
    LAS unsigned* hist = (LAS unsigned*)(F.lds + LDSCTL_OFF + 1024);
    const bf16_t* WrHi = (const bf16_t*)(P.ws + WS_WR); const bf16_t* WrLo = WrHi + 48 * DM;
    bf16_t* h2 = (bf16_t*)(P.ws + WS_H2); const bf16_t* dl = (const bf16_t*)(P.ws + WS_DELTA); bf16_t* x1b = (bf16_t*)(P.ws + WS_X1B);
    int2* rte = (int2*)(P.ws + WS_RT); float2* rtw = (float2*)(P.ws + WS_RT + 256 * 1024);
    const int t = F.lane & 15, q = F.lane >> 4;
    u32x4 wreg[6];
#pragma unroll
    for (int j = 0; j < 6; ++j) { const int id = F.tid + 512 * j, arr = id / 1536, rem = id - arr * 1536, row = rem >> 5, ch = rem & 31; wreg[j] = *(const u32x4*)((arr ? WrLo : WrHi) + (size_t)row * DM + 8 * ch); }
    for (int rb = F.vcu; rb < M / 128; rb += F.G) {
        const int m0 = rb * 128 + F.wave * 16, b = m0 / SEQ;
        const float* mod = (const float*)(P.ws + WS_MOD) + b * 6144;
        __syncthreads();
        if (F.tid < 64) hist[F.tid] = 0u;
        for (int k = F.tid; k < DM; k += 512) { gms[k] = P.norm2_g[k] * (1.f + mod[4096 + k]); gms[DM + k] = mod[3072 + k]; }
        __syncthreads();
#pragma unroll 1
        for (int hb = 0; hb < 2; ++hb) {
            const int mb = m0 + 8 * hb;
            f32x4 xv[8][4]; float rstd[8];
#pragma unroll
            for (int r = 0; r < 8; ++r) { const f32x4* xr = (const f32x4*)(P.x + (size_t)(mb + r) * DM) + F.lane; const u32x2* dr = (const u32x2*)(dl + (size_t)(mb + r) * DM) + F.lane;
#pragma unroll
                for (int c = 0; c < 4; ++c) { const f32x4 x4 = __builtin_nontemporal_load(xr + 64 * c); const u32x2 d = __builtin_nontemporal_load(dr + 64 * c);
                    xv[r][c][0] = x4[0] + __uint_as_float(d.x << 16); xv[r][c][1] = x4[1] + __uint_as_float(d.x & 0xffff0000u); xv[r][c][2] = x4[2] + __uint_as_float(d.y << 16); xv[r][c][3] = x4[3] + __uint_as_float(d.y & 0xffff0000u); } }
#pragma unroll
            for (int r = 0; r < 8; ++r) { float s = 0.f;
#pragma unroll
                for (int c = 0; c < 4; ++c) s += (xv[r][c][0] * xv[r][c][0] + xv[r][c][1] * xv[r][c][1]) + (xv[r][c][2] * xv[r][c][2] + xv[r][c][3] * xv[r][c][3]);
                rstd[r] = 1.f / sqrtf(wave_sum(s) * (1.f / DM) + EPS); }
            f32x4 acc[3];
#pragma unroll
            for (int cb = 0; cb < 3; ++cb) acc[cb] = (f32x4){0.f, 0.f, 0.f, 0.f};
#pragma unroll
            for (int c = 0; c < 4; ++c) {
                const int k0 = 256 * c + 4 * F.lane;
                __syncthreads();
#pragma unroll
                for (int j = 0; j < 6; ++j) { const int id = F.tid + 512 * j, arr = id / 1536, rem = id - arr * 1536, row = rem >> 5, ch = rem & 31;
                    *(LAS u32x4*)(wch + arr * 24576 + row * 512 + ((ch ^ (row & 15)) << 4)) = wreg[j]; }
#pragma unroll
                for (int j = 0; j < 6; ++j) { const int id = F.tid + 512 * j, arr = id / 1536, rem = id - arr * 1536, row = rem >> 5, ch = rem & 31;
                    wreg[j] = *(const u32x4*)((arr ? WrLo : WrHi) + (size_t)row * DM + 256 * ((c + 1) & 3) + 8 * ch); }
                const f32x4 gm = *(const LAS f32x4*)(gms + k0), sh = *(const LAS f32x4*)(gms + DM + k0);
#pragma unroll
                for (int r = 0; r < 8; ++r) { const f32x4 h = xv[r][c] * rstd[r] * gm + sh;
                    u32x2 hi; hi.x = cvt_pk_bf16(h[0], h[1]); hi.y = cvt_pk_bf16(h[2], h[3]);
                    u32x2 lo; lo.x = cvt_pk_bf16(h[0] - __uint_as_float(hi.x << 16), h[1] - __uint_as_float(hi.x & 0xffff0000u)); lo.y = cvt_pk_bf16(h[2] - __uint_as_float(hi.y << 16), h[3] - __uint_as_float(hi.y & 0xffff0000u));
                    *(u32x2*)(h2 + (size_t)(mb + r) * DM + k0) = hi;
                    const int off = r * 512 + ((((F.lane >> 1) ^ r) & 31) << 4) + ((F.lane & 1) << 3);
                    *(LAS u32x2*)(tile + off) = hi; *(LAS u32x2*)(tile + 4096 + off) = lo; }
                asm volatile("s_waitcnt lgkmcnt(0)" ::: "memory");
                __syncthreads();
#pragma unroll 2
                for (int ks = 0; ks < (MODE == 1 ? 0 : 8); ++ks) { const int tr = t & 7;
                    const int off = tr * 512 + ((((4 * ks + q) ^ tr) & 31) << 4);
                    const bf16x8 bh = *(const LAS bf16x8*)(tile + off), bl = *(const LAS bf16x8*)(tile + 4096 + off);
#pragma unroll
                    for (int cb = 0; cb < 3; ++cb) { const int woff = (16 * cb + t) * 512 + ((((4 * ks + q) ^ t) & 31) << 4);
                        const bf16x8 wh = *(const LAS bf16x8*)(wch + woff), wl = *(const LAS bf16x8*)(wch + 24576 + woff);
                        acc[cb] = __builtin_amdgcn_mfma_f32_16x16x32_bf16(wh, bh, acc[cb], 0, 0, 0);
                        acc[cb] = __builtin_amdgcn_mfma_f32_16x16x32_bf16(wh, bl, acc[cb], 0, 0, 0);
                        acc[cb] = __builtin_amdgcn_mfma_f32_16x16x32_bf16(wl, bh, acc[cb], 0, 0, 0); } }
                asm volatile("s_waitcnt lgkmcnt(0)" ::: "memory");
            }
            if (t < 8) {
#pragma unroll
                for (int cb = 0; cb < 3; ++cb)
#pragma unroll
                    for (int r = 0; r < 4; ++r) lg[t * 48 + 16 * cb + 4 * q + r] = acc[cb][r]; }
            asm volatile("s_waitcnt lgkmcnt(0)" ::: "memory");
            if (MODE != 1 && q == 0 && t < 8) {
                const int m = mb + t;
                const LAS float* l = lg + t * 48;
                float gl[4];
#pragma unroll
                for (int i = 0; i < 4; ++i) gl[i] = l[i] + P.b_rg[i];
                int g = 0; float gmx = gl[0];
#pragma unroll
                for (int i = 1; i < 4; ++i) if (gl[i] > gmx) { gmx = gl[i]; g = i; }
                float se = 0.f;
#pragma unroll
                for (int i = 0; i < 4; ++i) se += __expf(gl[i] - gmx);
                const float pg = 1.f / se;
                float e0v = -3.0e38f, e1v = -3.0e38f; int i0 = 0, i1 = 0;
#pragma unroll
                for (int i = 0; i < 8; ++i) { const float v = l[4 + g * 8 + i] + P.b_re[g * 8 + i];
                    if (v > e0v) { e1v = e0v; i1 = i0; e0v = v; i0 = i; } else if (v > e1v) { e1v = v; i1 = i; } }
                const float p1 = __expf(e1v - e0v), w0 = 1.f / (1.f + p1), w1 = p1 * w0;
                int2 e; e.x = g * 8 + i0; e.y = g * 8 + i1; float2 w; w.x = w0 * pg; w.y = w1 * pg;
                rte[m] = e; rtw[m] = w;
                __hip_atomic_fetch_add(&hist[e.x], 1u, __ATOMIC_RELAXED, __HIP_MEMORY_SCOPE_WORKGROUP); __hip_atomic_fetch_add(&hist[32 + e.y], 1u, __ATOMIC_RELAXED, __HIP_MEMORY_SCOPE_WORKGROUP);
            }
            asm volatile("s_waitcnt lgkmcnt(0)" ::: "memory");
        }
        __syncthreads();
        if (MODE != 1 && F.tid < 64) F.ctl[CW_HIST + rb * 64 + F.tid] = hist[F.tid];
    }
    __syncthreads();
}
__device__ __forceinline__ void p7_sort(const Ptrs& P, Frame& F) {
    LAS unsigned* tot = (LAS unsigned*)(F.lds + RING_OFF);
    LAS unsigned* pre = tot + 64;
    LAS unsigned* rbase = pre + 64;
    LAS unsigned* cnt = rbase + 64;
    LAS unsigned* misc = cnt + 64;
    int* stok = (int*)(P.ws + WS_STOK); float* sw = (float*)(P.ws + WS_SW);
    const int2* rte = (const int2*)(P.ws + WS_RT); const float2* rtw = (const float2*)(P.ws + WS_RT + 256 * 1024);
    const int cw = F.vcu * 7 + F.wave - 1, cnw = F.G * 7; bool first = true;
    for (int rb = F.vcu; rb < M / 128; rb += F.G) {
        __syncthreads();
        {
            LAS unsigned* ptot = misc + 8; LAS unsigned* ppre = ptot + 512;
            const int g = F.tid & 63, pt = F.tid >> 6; unsigned hv[32];
#pragma unroll
            for (int k = 0; k < 32; ++k) hv[k] = F.ctl[CW_HIST + (32 * pt + k) * 64 + g];
            unsigned s = 0u, p = 0u;
#pragma unroll
            for (int k = 0; k < 32; ++k) { if (32 * pt + k == rb) p = s; s += hv[k]; }
            if (rb >= 32 * pt + 32) p = s;
            ptot[pt * 64 + g] = s; ppre[pt * 64 + g] = p;
        }
        __syncthreads();
        if (F.tid < 64) { unsigned s = 0u, p = 0u;
#pragma unroll
            for (int pt = 0; pt < 8; ++pt) { s += misc[8 + pt * 64 + F.tid]; p += misc[8 + 512 + pt * 64 + F.tid]; }
            tot[F.tid] = s; pre[F.tid] = p; cnt[F.tid] = 0u; }
        if (first && F.wave > 0) expert_weight_items(P, F, cw, cnw, 0, 2);
        __syncthreads();
        if (first && F.wave > 0) expert_weight_items(P, F, cw, cnw, 2, 4);
        if (F.tid == 0) { unsigned tb = 0u;
            for (int g = 0; g < 64; ++g) { if (g == 32) misc[1] = tb; rbase[g] = tb * 256u; const unsigned nt = (tot[g] + 255u) >> 8;
                if (rb == 0) for (unsigned k = 0; k < nt; ++k) F.ctl[CW_TGRP + tb + k] = (unsigned)g;
                tb += nt; }
            misc[0] = tb; if (rb == 0) { F.ctl[CW_T] = tb; F.ctl[CW_T0] = misc[1]; } }
        __syncthreads();
        if (F.wave == 0) {
            const unsigned long long ltmask = (1ull << F.lane) - 1ull;
            for (int ch = 0; ch < 2; ++ch) { const int m = rb * 128 + ch * 64 + F.lane; const int2 e = rte[m]; const float2 w = rtw[m];
                for (int j = 0; j < 2; ++j) { const int ex = j ? e.y : e.x; const float wj = j ? w.y : w.x; unsigned rank = 0u, gsz = 0u;
                    for (int x = 0; x < 32; ++x) { const unsigned long long mk = __ballot(ex == x); if (ex == x) { rank = (unsigned)__popcll(mk & ltmask); gsz = (unsigned)__popcll(mk); } }
                    const int g = j * 32 + ex; const unsigned pos = rbase[g] + pre[g] + cnt[g] + rank;
                    stok[pos] = m; sw[pos] = wj;
                    asm volatile("s_waitcnt lgkmcnt(0)" ::: "memory");
                    if (rank == 0u) cnt[g] += gsz;
                    asm volatile("s_waitcnt lgkmcnt(0)" ::: "memory"); } } }
        if (rb < 64) { const unsigned n = tot[rb], padn = (((n + 255u) >> 8) << 8) - n;
            if ((unsigned)F.tid < padn) { stok[rbase[rb] + n + F.tid] = -1; sw[rbase[rb] + n + F.tid] = 0.f; } }
        if (first && F.wave > 0) expert_weight_items(P, F, cw, cnw, 4, 1 << 20);
        first = false;
    }
}
struct MoeSched {
    const bf16_t* A; const bf16_t* W; int lda, ldb; const int* stok; const unsigned* tgrp; int t_lo, nun, npn, G, c; size_t wstride; bool gather, split;
    __device__ bool next(int i, Unit& u) const {
        const int idx = i * G + c, nfull = (nun / G) * G, tail = nun - nfull; int U; u.half = 0;
        if (split && tail > 0 && 2 * tail <= G) { if (idx >= nfull + 2 * tail) return false; if (idx < nfull) U = idx; else { U = nfull + ((idx - nfull) >> 1); u.half = 1 + ((idx - nfull) & 1); } }
        else { if (idx >= nun) return false; U = idx; }
        u.aux = t_lo + U / npn; u.pn = U % npn; u.pm = (int)tgrp[u.aux]; return true; }
    __device__ __forceinline__ const char* abase(const Unit& u) const { return gather ? (const char*)A : (const char*)A + (size_t)(u.aux * BM + (u.half == 2 ? HALF : 0)) * lda * 2; }
    __device__ __forceinline__ const char* bbase(const Unit& u) const { return (const char*)W + (size_t)(u.pm & 31) * wstride + (size_t)u.pn * BM * ldb * 2; }
    __device__ __forceinline__ void avoff(const Unit& u, int R0, int C0, int R1, int C1, unsigned (&v0)[2], unsigned (&v1)[2]) const {
        if (gather) { const int* tk = stok + u.aux * BM + (u.half == 2 ? HALF : 0); const int o1 = u.half ? 0 : HALF; int a = tk[R0], b = tk[R1], c2 = tk[o1 + R0], d = tk[o1 + R1];
            a = a < 0 ? 0 : a; b = b < 0 ? 0 : b; c2 = c2 < 0 ? 0 : c2; d = d < 0 ? 0 : d;
            v0[0] = (unsigned)(a * lda + C0) * 2u; v0[1] = (unsigned)(b * lda + C1) * 2u; v1[0] = (unsigned)(c2 * lda + C0) * 2u; v1[1] = (unsigned)(d * lda + C1) * 2u; }
        else { v0[0] = (unsigned)(R0 * lda + C0) * 2u; v0[1] = (unsigned)(R1 * lda + C1) * 2u; const unsigned h1 = u.half ? 0u : (unsigned)(HALF * lda * 2); v1[0] = v0[0] + h1; v1[1] = v0[1] + h1; } }
};
struct EpiGU {
    bf16_t* hact; const float* sw;
    __device__ __forceinline__ void operator()(const f32x4 (&acc)[2][2][4][2], const Unit& un, int wr, int wc, int fr, int fq) const {
        asm volatile("" : "+v"(fr), "+v"(fq));
        const int r0 = un.aux * BM + (un.half == 2 ? HALF : 0) + wr * 64 + fr, c0 = 128 * un.pn + 32 * wc + 8 * fq;
#pragma unroll
        for (int ai = 0; ai < 2; ++ai)
#pragma unroll
            for (int m = 0; m < 4; ++m) { if (ai == 1 && un.half) continue; const int row = r0 + ai * HALF + m * 16; const float w = sw[row];
                f32x4 a, b;
#pragma unroll
                for (int i = 0; i < 4; ++i) { const float g0 = acc[ai][0][m][0][i], g1 = acc[ai][1][m][0][i];
                    a[i] = g0 * fsigmoid(g0) * acc[ai][0][m][1][i] * w; b[i] = g1 * fsigmoid(g1) * acc[ai][1][m][1][i] * w; }
                *(u32x4*)(hact + (size_t)row * DEXP + c0) = pack8(a, b); }
    }
};
struct EpiDown {
    bf16_t* y0; bf16_t* y1; const int* stok;
    __device__ __forceinline__ void operator()(const f32x4 (&acc)[2][2][4][2], const Unit& un, int wr, int wc, int fr, int fq) const {
        asm volatile("" : "+v"(fr), "+v"(fq));
        const int r0 = un.aux * BM + wr * 64 + fr, c0 = 256 * un.pn + 32 * wc + 8 * fq;
        bf16_t* y = (un.pm >> 5) ? y1 : y0;
#pragma unroll
        for (int ai = 0; ai < 2; ++ai)
#pragma unroll
            for (int m = 0; m < 4; ++m) { const int tok = stok[r0 + ai * HALF + m * 16];
                if (tok >= 0) { bf16_t* orow = y + (size_t)tok * DM + c0;
                    *(u32x4*)(orow) = pack8(acc[ai][0][m][0], acc[ai][0][m][1]); *(u32x4*)(orow + HALF) = pack8(acc[ai][1][m][0], acc[ai][1][m][1]); } }
    }
};
__device__ __forceinline__ void p10_combine(const Ptrs& P, Frame& F) {
    const int gw = F.vcu * NWAVES + F.wave, NGW = F.G * NWAVES;
    const bf16_t* dl = (const bf16_t*)(P.ws + WS_DELTA); const bf16_t* y0 = (const bf16_t*)(P.ws + WS_Y0); const bf16_t* y1 = (const bf16_t*)(P.ws + WS_Y1);
    for (int m = gw; m < M; m += NGW) {
        const float* gate = (const float*)(P.ws + WS_MOD) + (m / SEQ) * 6144 + 5120;
        const f32x4* xr = (const f32x4*)(P.x + (size_t)m * DM) + F.lane; f32x4* orow = (f32x4*)(P.out + (size_t)m * DM) + F.lane;
        const u32x2* dr = (const u32x2*)(dl + (size_t)m * DM) + F.lane; const u32x2* a0 = (const u32x2*)(y0 + (size_t)m * DM) + F.lane; const u32x2* a1 = (const u32x2*)(y1 + (size_t)m * DM) + F.lane;
        f32x4 xv[4]; u32x2 d[4], p[4], q[4];
#pragma unroll
        for (int j = 0; j < 4; ++j) { xv[j] = __builtin_nontemporal_load(xr + 64 * j); d[j] = __builtin_nontemporal_load(dr + 64 * j); p[j] = __builtin_nontemporal_load(a0 + 64 * j); q[j] = __builtin_nontemporal_load(a1 + 64 * j); }
#pragma unroll
        for (int j = 0; j < 4; ++j) { const f32x4 g = *(const f32x4*)(gate + 4 * F.lane + 256 * j);
            f32x4 o;
            o[0] = xv[j][0] + __uint_as_float(d[j].x << 16) + g[0] * (__uint_as_float(p[j].x << 16) + __uint_as_float(q[j].x << 16));
            o[1] = xv[j][1] + __uint_as_float(d[j].x & 0xffff0000u) + g[1] * (__uint_as_float(p[j].x & 0xffff0000u) + __uint_as_float(q[j].x & 0xffff0000u));
            o[2] = xv[j][2] + __uint_as_float(d[j].y << 16) + g[2] * (__uint_as_float(p[j].y << 16) + __uint_as_float(q[j].y << 16));
            o[3] = xv[j][3] + __uint_as_float(d[j].y & 0xffff0000u) + g[3] * (__uint_as_float(p[j].y & 0xffff0000u) + __uint_as_float(q[j].y & 0xffff0000u));
            __builtin_nontemporal_store(o, orow + 64 * j); }
    }
}
struct Args { Ptrs P; int ph_lo, ph_hi, li, pad; };
constexpr int N_PHASES = 11;

typedef const __attribute__((address_space(4))) Args* KArgs;
__device__ __forceinline__ KArgs kargs() {
#if defined(__HIP_DEVICE_COMPILE__)
    unsigned off = 0u; asm volatile("" : "+s"(off));
    return (KArgs)((const __attribute__((address_space(4))) char*)__builtin_amdgcn_kernarg_segment_ptr() + off);
#else
    return nullptr;
#endif
}
__device__ __forceinline__ Ptrs load_ptrs() {
    Ptrs P{};
#if defined(__HIP_DEVICE_COMPILE__)
    const __attribute__((address_space(4))) unsigned long long* src = (const __attribute__((address_space(4))) unsigned long long*)kargs();
    unsigned long long w[sizeof(Ptrs) / 8];
#pragma unroll
    for (unsigned i = 0; i < sizeof(Ptrs) / 8; ++i) w[i] = src[i];
    __builtin_memcpy(&P, w, sizeof(Ptrs));
#endif
    return P;
}
#define WSPTRS \
    unsigned char* ws = P.ws; bf16_t* hA = (bf16_t*)(ws + WS_A); bf16_t* uB = (bf16_t*)(ws + WS_B); bf16_t* gbB = uB + (size_t)M * DM; bf16_t* sgB = gbB + (size_t)M * DM; \
    bf16_t* latC = (bf16_t*)(ws + WS_C); bf16_t* Kd = (bf16_t*)(ws + WS_D); bf16_t* Vd = (bf16_t*)(ws + WS_D + 96 * MiB); bf16_t* Qo = (bf16_t*)P.out; \
    float* ssp = (float*)(ws + WS_SSP); const float2* cs = (const float2*)(ws + WS_CS); const float* mod = (const float*)(ws + WS_MOD); \
    const int* stok = (const int*)(ws + WS_STOK); const float* sw = (const float*)(ws + WS_SW); bf16_t* h2 = (bf16_t*)(ws + WS_H2); bf16_t* hact = (bf16_t*)(ws + WS_HACT); \
    (void)hA; (void)uB; (void)gbB; (void)sgB; (void)latC; (void)Kd; (void)Vd; (void)Qo; (void)ssp; (void)cs; (void)mod; (void)stok; (void)sw; (void)h2; (void)hact;

__global__ void __launch_bounds__(NWAVES * 64, 2) fwd(Args args_unused) {
    extern __shared__ __attribute__((aligned(16))) unsigned char lds_raw[];
    Frame F;
    F.lds = (LAS unsigned char*)lds_raw;
    F.MISC = (volatile LAS unsigned*)(F.lds + MISC_OFF);
    F.tid = threadIdx.x; F.lane = F.tid & 63; F.wave = __builtin_amdgcn_readfirstlane(F.tid >> 6);
    F.G = gridDim.x; { const int bx = blockIdx.x; F.vcu = (F.G % 8 == 0) ? (bx % 8) * (F.G / 8) + bx / 8 : bx; }
    F.ctl = (unsigned*)(args_unused.P.ws + WS_CTL);
    for (int u = F.tid; u < (LDS_BYTES - LDSCTL_OFF) / 4; u += NWAVES * 64) ((LAS unsigned*)(F.lds + LDSCTL_OFF))[u] = 0u;
    __syncthreads();
    const int lo = args_unused.ph_lo, hi = args_unused.ph_hi;
    XcdBarrier bar; bar.bar = F.ctl + CW_BAR + args_unused.li * XCD_BAR_WORDS; bar.x = 0; bar.st = nullptr;
    if (hi - lo > 1) bar = xcd_barrier_post(F.ctl + CW_BAR + args_unused.li * XCD_BAR_WORDS, F.MISC + 8);
#ifdef ONLY_PHASE
#define IN(k) ((k) == ONLY_PHASE && lo <= (k) && (k) < hi)
#else
#define IN(k) (lo <= (k) && (k) < hi)
#endif
#ifndef PROBE_REPEAT
#define PROBE_REPEAT -1
#endif
#define REPS(k) for (int rep_ = 0; rep_ < ((k) == PROBE_REPEAT ? 2 : 1); ++rep_)
#define SEAM(k) do { if (IN(k) && IN((k) + 1)) xcd_barrier(bar); } while (0)

    if (IN(0)) { const Ptrs P = args_unused.P; REPS(0) { p0_router_weights(P, F); p0_mod(P, F); } SEAM(0); }
    if (IN(1)) { const Ptrs P = args_unused.P; REPS(1) { p1_norm1(P, F); p0_weights_tables(P, F); } SEAM(1); }
    if (IN(2)) {
        const Ptrs P = args_unused.P; WSPTRS
        DenseSched S; S.init(hA, DM, (const bf16_t*)(ws + WS_WIN), DM, M, 5888, F.G, (int)blockIdx.x, true, true);
        EpiIn E{uB, gbB, sgB, latC, ssp, cs, P.k_g, (LAS float*)(F.lds + XCH_OFF)};
        gemm_phase<false>(F.lds + RING_OFF, DM, S, E);
        if (PROBE_REPEAT == 2) gemm_phase<false>(F.lds + RING_OFF, DM, S, E);
        SEAM(2);
    }
    if (IN(3)) {
        const Ptrs P = args_unused.P; WSPTRS
        { DenseSched S; S.init(latC, LATW, (const bf16_t*)(ws + WS_WQ), QL, M, 1536, F.G, (int)blockIdx.x);
          EpiPlain E{Qo, 1536, 255};
          gemm_phase<false>(F.lds + RING_OFF, QL, S, E);
          if (PROBE_REPEAT == 30) gemm_phase<false>(F.lds + RING_OFF, QL, S, E); }
        { DenseSched S; S.init(latC + 512, LATW, (const bf16_t*)(ws + WS_WKV), KVL, M, 2048, F.G, (int)blockIdx.x);
          EpiKV E{Kd, Vd, latC, ssp, P.k_g, (LAS float*)(F.lds + XCH_OFF)};
          gemm_phase<false>(F.lds + RING_OFF, KVL, S, E);
          if (PROBE_REPEAT == 31) gemm_phase<false>(F.lds + RING_OFF, KVL, S, E);
          if (PROBE_REPEAT == 32) { EpiPlain E2{hA, 1024, 3}; gemm_phase<false>(F.lds + RING_OFF, KVL, S, E2); } }
        SEAM(3);
    }
    if (IN(4)) {
        const Ptrs P = args_unused.P; WSPTRS
        att::AttnArgs T{Qo, Kd, Vd, ssp, cs, P.q_g, uB, gbB, sgB, P.conv_w, hA};
        if (F.G == 256) {
            const int bh = F.vcu >> 1, sel = F.vcu & 1;
#pragma unroll 1
            for (int i = 0; i < 4; ++i) { const int qb = sel ? (i == 0 ? 6 : i == 1 ? 1 : i == 2 ? 5 : 2) : (i == 0 ? 7 : i == 1 ? 0 : i == 2 ? 4 : 3);
                att::ATTN_UNIT<0>(T, bh >> 3, bh & 7, qb, (LAS char*)(F.lds + RING_OFF)); }
            if (PROBE_REPEAT == 4 || PROBE_REPEAT == 41 || PROBE_REPEAT == 42) {
#pragma unroll 1
                for (int i = 0; i < 4; ++i) { const int qb = sel ? (i == 0 ? 6 : i == 1 ? 1 : i == 2 ? 5 : 2) : (i == 0 ? 7 : i == 1 ? 0 : i == 2 ? 4 : 3);
                    att::ATTN_UNIT<(PROBE_REPEAT == 41 ? 1 : PROBE_REPEAT == 42 ? 2 : 0)>(T, bh >> 3, bh & 7, qb, (LAS char*)(F.lds + RING_OFF)); } }
        } else {
#pragma unroll 1
            for (int U = F.vcu; U < BATCH * NH * 8; U += F.G) { const int bh = U >> 3; att::ATTN_UNIT<0>(T, bh >> 3, bh & 7, U & 7, (LAS char*)(F.lds + RING_OFF)); }
        }
        SEAM(4);
    }
    if (IN(5)) {
        const Ptrs P = args_unused.P; WSPTRS
        DenseSched S; S.init(hA, DM, (const bf16_t*)(ws + WS_WO), DM, M, DM, F.G, (int)blockIdx.x);
        EpiDelta E{mod, (bf16_t*)(ws + WS_DELTA)};
        gemm_phase<false>(F.lds + RING_OFF, DM, S, E);
        if (PROBE_REPEAT == 5) gemm_phase<false>(F.lds + RING_OFF, DM, S, E);
        if (PROBE_REPEAT == 51) { EpiNull E0; gemm_phase<false>(F.lds + RING_OFF, DM, S, E0); }
        SEAM(5);
    }
    if (IN(6)) { const Ptrs P = args_unused.P; p6_rows<0>(P, F); if (PROBE_REPEAT == 6) p6_rows<0>(P, F); if (PROBE_REPEAT == 61) p6_rows<1>(P, F); SEAM(6); }
    if (IN(7)) { const Ptrs P = args_unused.P; p7_sort(P, F); if (PROBE_REPEAT == 7) p7_sort(P, F); SEAM(7); }
    if (IN(8)) {
        const Ptrs P = args_unused.P; WSPTRS
        const int T = __builtin_amdgcn_readfirstlane((int)F.ctl[CW_T]);
        MoeSched S{h2, (const bf16_t*)(ws + WS_EGU), DM, DM, stok, F.ctl + CW_TGRP, 0, T * 2, 2, F.G, F.vcu, (size_t)512 * DM * 2, true, true};
        EpiGU E{hact, sw};
        gemm_phase<true>(F.lds + RING_OFF, DM, S, E);
        if (PROBE_REPEAT == 8) gemm_phase<true>(F.lds + RING_OFF, DM, S, E);
        SEAM(8);
    }
    if (IN(9)) {
        const Ptrs P = args_unused.P; WSPTRS
        const int T = __builtin_amdgcn_readfirstlane((int)F.ctl[CW_T]);
        MoeSched S{hact, (const bf16_t*)(ws + WS_EDN), DEXP, DEXP, stok, F.ctl + CW_TGRP, 0, T * 4, 4, F.G, F.vcu, (size_t)DM * DEXP * 2, false, false};
        EpiDown E{(bf16_t*)(ws + WS_Y0), (bf16_t*)(ws + WS_Y1), stok};
        gemm_phase<false>(F.lds + RING_OFF, DEXP, S, E);
        if (PROBE_REPEAT == 9) gemm_phase<false>(F.lds + RING_OFF, DEXP, S, E);
        SEAM(9);
    }
    if (IN(10)) { const Ptrs P = args_unused.P; REPS(10) p10_combine(P, F); }
#undef IN
#undef SEAM
}
}
extern "C" void kernel_launch(void* const* d_in, const int* in_sizes, int n_in, void* d_out, int out_size, void* d_ws, size_t ws_size, hipStream_t stream) {
    if (n_in != 23 || out_size != M * DM || ws_size < WS_END) { fprintf(stderr, "kernel_launch: unexpected shapes (n_in %d out %d ws %zu)\n", n_in, out_size, ws_size); return; }
    static int grid = 0;
    if (grid == 0) {
        int dev = 0, cus = 0;
        if (hipGetDevice(&dev) != hipSuccess || hipDeviceGetAttribute(&cus, hipDeviceAttributeMultiprocessorCount, dev) != hipSuccess) { fprintf(stderr, "kernel_launch: device query failed\n"); grid = -1; return; }
        if (hipFuncSetAttribute((const void*)fk::fwd, hipFuncAttributeMaxDynamicSharedMemorySize, fk::LDS_BYTES) != hipSuccess) { fprintf(stderr, "kernel_launch: hipFuncSetAttribute failed\n"); grid = -1; return; }
        grid = cus;
    }
    if (grid < 0) return;
    Ptrs P{};
    P.x = (const float*)d_in[0]; P.c = (const float*)d_in[1]; P.pos = (const int*)d_in[2];
    P.w_ada = (const float*)d_in[3]; P.b_ada = (const float*)d_in[4]; P.norm1_g = (const float*)d_in[5]; P.w_in = (const float*)d_in[6]; P.conv_w = (const float*)d_in[7];
    P.q_a_g = (const float*)d_in[8]; P.w_q_b = (const float*)d_in[9]; P.kv_a_g = (const float*)d_in[10]; P.w_kv_b = (const float*)d_in[11]; P.q_g = (const float*)d_in[12]; P.k_g = (const float*)d_in[13];
    P.w_o = (const float*)d_in[14]; P.norm2_g = (const float*)d_in[15]; P.w_rg = (const float*)d_in[16]; P.b_rg = (const float*)d_in[17]; P.w_re = (const float*)d_in[18]; P.b_re = (const float*)d_in[19];
    P.w_gate = (const float*)d_in[20]; P.w_up = (const float*)d_in[21]; P.w_down = (const float*)d_in[22];
    P.out = (float*)d_out; P.ws = (unsigned char*)d_ws;
    (void)hipMemsetAsync((char*)d_ws + WS_CTL, 0, 1 * MiB, stream);
    fk::Args a{}; a.P = P; a.ph_lo = 0; a.ph_hi = fk::N_PHASES; a.li = 0;
    hipLaunchKernelGGL(fk::fwd, dim3(grid), dim3(fk::NWAVES * 64), fk::LDS_BYTES, stream, a);
}
```

```cpp
#define PROBE_REPEAT -1
#include <hip/hip_runtime.h>
#include <cstdio>
#include <cstdint>
#include <cmath>

constexpr int BATCH = 16, SEQ = 2048, DM = 1024, M = BATCH * SEQ;
constexpr int NH = 8, QKN = 128, QKR = 64, QKH = 192, VH = 128, QL = 384, KVL = 256;
constexpr int DIN = 5824, NEXP = 32, DEXP = 256;
constexpr int C_ZX = 0, C_ZB = 1024, C_ZC = 2048, C_QL = 3072, C_KVL = 3456, C_KR = 3712, C_GC = 3776, C_GM = 4800;
constexpr float EPS = 1e-6f;
constexpr int LATW = 768;

typedef unsigned short bf16_t;
typedef float f32x4 __attribute__((ext_vector_type(4)));

constexpr size_t MiB = 1u << 20;
constexpr size_t WS_CTL = 0;
constexpr size_t WS_MOD = 1 * MiB;
constexpr size_t WS_CS = 2 * MiB;
constexpr size_t WS_SSP = 10 * MiB;
constexpr size_t WS_RT = 12 * MiB;
constexpr size_t WS_WSMALL = 14 * MiB;
constexpr size_t WS_A = 32 * MiB;
constexpr size_t WS_B = 96 * MiB;
constexpr size_t WS_C = 288 * MiB;
constexpr size_t WS_D = 336 * MiB;
constexpr size_t WS_END = 496 * MiB;

__device__ __forceinline__ float bf2f(bf16_t v) { return __uint_as_float(((unsigned)v) << 16); }
__device__ __forceinline__ bf16_t f2bf(float f) { unsigned u = __float_as_uint(f); return (bf16_t)((u + 0x7fffu + ((u >> 16) & 1u)) >> 16); }

struct Ptrs {
    const float *x, *c; const int* pos;
    const float *w_ada, *b_ada, *norm1_g, *w_in, *conv_w, *q_a_g, *w_q_b, *kv_a_g, *w_kv_b, *q_g, *k_g, *w_o, *norm2_g;
    const float *w_rg, *b_rg, *w_re, *b_re, *w_gate, *w_up, *w_down;
    float* out; unsigned char* ws;
};

namespace fk {
#define LAS __attribute__((address_space(3)))
#define GAS __attribute__((address_space(1)))
typedef short bf16x8 __attribute__((ext_vector_type(8)));
typedef short s16x4 __attribute__((ext_vector_type(4)));
typedef unsigned u32x4 __attribute__((ext_vector_type(4)));
typedef unsigned u32x2 __attribute__((ext_vector_type(2)));
typedef float f32x2 __attribute__((ext_vector_type(2)));
typedef float f32x16 __attribute__((ext_vector_type(16)));
typedef GAS unsigned gu32;
#define RLX_AGENT __ATOMIC_RELAXED, __HIP_MEMORY_SCOPE_AGENT
constexpr int NWAVES = 8;
constexpr int BM = 256, BK = 64, HALF = 128, HTB = HALF * BK * 2, STAGE_BYTES = 8 * HTB, NXCD = 8, WGM = 8;
constexpr int RING_OFF = 0, RING_BYTES = 131072, XCH_OFF = 131072, XCH_BYTES = 8192, LDSCTL_OFF = XCH_OFF + XCH_BYTES, MISC_OFF = LDSCTL_OFF + 320, LDS_BYTES = 147456;
constexpr int CW_TMO = 0, CW_BAR = 4096;
constexpr int CW_HIST = 16384;
constexpr int CW_TILES = 40960;

typedef __bf16 bf16x2_t __attribute__((ext_vector_type(2)));
__device__ __forceinline__ unsigned cvt_pk_bf16(float lo, float hi) { f32x2 v = {lo, hi}; bf16x2_t b = __builtin_convertvector(v, bf16x2_t); return __builtin_bit_cast(unsigned, b); }
__device__ __forceinline__ float fsigmoid(float x) { return __builtin_amdgcn_rcpf(1.f + __expf(-x)); }

__host__ __device__ __forceinline__ int lds_byte(int r, int c) { const int st = (r >> 4) * 2 + (c >> 5), rr = r & 15, cc = c & 31, ob = rr * 64 + cc * 2; return st * 1024 + (ob ^ (((ob >> 9) & 1) << 5)); }
__host__ __device__ __forceinline__ void stage_rc(int b, int& R, int& C) { const int st = b / 1024, sb = b % 1024, swz = sb ^ (((sb >> 9) & 1) << 5); R = (st >> 1) * 16 + swz / 64; C = (st & 1) * 32 + (swz % 64) / 2; }
__host__ __device__ __forceinline__ int permL(int L) { return (L & 0xE0) | (((L >> 2) & 1) << 4) | (((L >> 3) & 3) << 2) | (L & 3); }

#define XB_TMO      128
#define XB_XCNT(j)  (256  + 64 * (j))
#define XB_XSUB(j)  (1280 + 64 * (j))
#define XB_XGEN(j)  (2304 + 64 * (j))
#define XB_TOP      3328
#define XB_TOPGEN   3392
#define XCD_BAR_WORDS 3456
#define XB_SPIN_CAP (1u << 18)
__device__ __forceinline__ unsigned xb_ld(unsigned* p)              { return __hip_atomic_load(p, __ATOMIC_RELAXED, __HIP_MEMORY_SCOPE_AGENT); }
__device__ __forceinline__ unsigned xb_add(unsigned* p, unsigned v) { return __hip_atomic_fetch_add(p, v, __ATOMIC_RELAXED, __HIP_MEMORY_SCOPE_AGENT); }
__device__ __forceinline__ unsigned xb_xcc_id() { return (unsigned)__builtin_amdgcn_s_getreg((3 << 11) | 20) & 0xFu; }
#define XB_SPIN(cond, bar) do { unsigned _sp = 0; while (cond) { __builtin_amdgcn_s_sleep(1); \
    if ((++_sp & 255u) == 0u) { if (xb_ld(&(bar)[XB_TMO])) break; if (_sp > XB_SPIN_CAP) { atomicAdd(&(bar)[XB_TMO], 1u); break; } } } } while (0)
struct XcdBarrier { unsigned* bar; unsigned x; volatile LAS unsigned* st; };
__device__ __forceinline__ XcdBarrier xcd_barrier_post(unsigned* bar, volatile LAS unsigned* st) {
    XcdBarrier b; b.bar = bar; b.x = xb_xcc_id(); b.st = st;
    if (threadIdx.x == 0) (void)xb_add(&bar[XB_XCNT(b.x)], 1u);
    return b;
}
__device__ __forceinline__ void xcd_barrier_complete(unsigned* bar, unsigned x, unsigned& nloc, unsigned& nx) {
    const unsigned G = gridDim.x * gridDim.y * gridDim.z;
    unsigned sum, cnt, mine, sp = 0u;
    for (;;) {
        sum = 0u; cnt = 0u; mine = 0u;
#pragma unroll
        for (unsigned j = 0; j < 16; ++j) { const unsigned c = xb_ld(&bar[XB_XCNT(j)]); sum += c; cnt += (c > 0u) ? 1u : 0u; mine = (j == x) ? c : mine; }
        if (sum == G) break;
        __builtin_amdgcn_s_sleep(1);
        if ((++sp & 255u) == 0u) { if (xb_ld(&bar[XB_TMO])) break; if (sp > XB_SPIN_CAP) { atomicAdd(&bar[XB_TMO], 1u); break; } }
    }
    nloc = mine > 0u ? mine : 1u; nx = cnt > 0u ? cnt : 1u;
}
__device__ __forceinline__ void xcd_barrier(const XcdBarrier& b) {
    asm volatile("s_waitcnt vmcnt(0)" ::: "memory");
    __syncthreads();
    if (threadIdx.x == 0) {
        unsigned* bar = b.bar;
        __builtin_amdgcn_s_waitcnt(0);
        unsigned nloc = b.st[0], nx = b.st[1];
        if (nloc == 0u) { xcd_barrier_complete(bar, b.x, nloc, nx); b.st[0] = nloc; b.st[1] = nx; }
        const unsigned old = xb_add(&bar[XB_XSUB(b.x)], 1u);
        const unsigned gen = old / nloc;
        if (old + 1u == (gen + 1u) * nloc) {
            __builtin_amdgcn_fence(__ATOMIC_RELEASE, "agent");
            asm volatile("s_waitcnt vmcnt(0)" ::: "memory");
            const unsigned og = xb_add(&bar[XB_TOP], 1u);
            const unsigned tg = og / nx;
            if (og + 1u == (tg + 1u) * nx) xb_add(&bar[XB_TOPGEN], 1u);
            else XB_SPIN(xb_ld(&bar[XB_TOPGEN]) == tg, bar);
            __builtin_amdgcn_fence(__ATOMIC_ACQUIRE, "agent");
            xb_add(&bar[XB_XGEN(b.x)], 1u);
            asm volatile("s_waitcnt vmcnt(0)" ::: "memory");
        } else {
            XB_SPIN(xb_ld(&bar[XB_XGEN(b.x)]) == gen, bar);
            __builtin_amdgcn_fence(__ATOMIC_ACQUIRE, "agent");
            asm volatile("s_waitcnt vmcnt(0)" ::: "memory");
        }
    }
    __syncthreads();
}

struct Unit { int pm, pn, aux, half; };
struct DenseSched {
    const bf16_t* A; const bf16_t* Bt; int lda, ldb; int nM, nN, nwg, G, c; bool split, pnflip;
    __device__ void init(const bf16_t* A_, int lda_, const bf16_t* Bt_, int ldb_, int M_, int N_, int G_, int c_, bool split_ = false, bool pnflip_ = false) {
        A = A_; Bt = Bt_; lda = lda_; ldb = ldb_; nM = M_ / BM; nN = N_ / BM; nwg = nM * nN; G = G_; c = c_; split = split_; pnflip = pnflip_; }
    __device__ bool next(int i, Unit& u) const {
        const int idx = i * G + c, nfull = (nwg / G) * G, tail = nwg - nfull; int L; u.half = 0;
        if (split && tail > 0 && 2 * tail <= G) { if (idx >= nfull + 2 * tail) return false; if (idx < nfull) L = idx; else { L = nfull + ((idx - nfull) >> 1); u.half = 1 + ((idx - nfull) & 1); } }
        else { if (idx >= nwg) return false; L = idx; }
        int wgid = L; { const int q = nwg / NXCD, r = nwg % NXCD, xcd = wgid % NXCD, off = wgid / NXCD; wgid = (xcd < r ? xcd * (q + 1) : r * (q + 1) + (xcd - r) * q) + off; }
        const int nig = WGM * nN, gid = wgid / nig, fm = gid * WGM, gsz = (nM - fm) < WGM ? (nM - fm) : WGM;
        u.pm = fm + ((wgid % nig) % gsz); u.pn = (wgid % nig) / gsz; if (pnflip) u.pn = nN - 1 - u.pn; u.aux = 0; return true;
    }
    __device__ __forceinline__ const char* abase(const Unit& u) const { return (const char*)A + (size_t)(u.pm * BM + (u.half == 2 ? HALF : 0)) * lda * 2; }
    __device__ __forceinline__ const char* bbase(const Unit& u) const { return (const char*)Bt + (size_t)u.pn * BM * ldb * 2; }
    __device__ __forceinline__ void avoff(const Unit& u, int R0, int C0, int R1, int C1, unsigned (&v0)[2], unsigned (&v1)[2]) const {
        v0[0] = (unsigned)(R0 * lda + C0) * 2u; v0[1] = (unsigned)(R1 * lda + C1) * 2u;
        const unsigned h1 = u.half ? 0u : (unsigned)(HALF * lda * 2);
        v1[0] = v0[0] + h1; v1[1] = v0[1] + h1; }
};

template <bool GATHER, class Epi, class Sched>
__device__ __forceinline__ void gemm_phase(LAS unsigned char* lds, const int K, const Sched& S, const Epi& E) {
    const int tid = threadIdx.x, wid = __builtin_amdgcn_readfirstlane(tid >> 6), lane = tid & 63, wr = wid >> 2, wc = wid & 3, fr = lane & 15, fq = lane >> 4;
    const int nt = K / BK;
    int R0, C0, R1, C1; stage_rc(tid * 16, R0, C0); stage_rc(tid * 16 + 8192, R1, C1);
    unsigned voffB[2]; voffB[0] = (unsigned)(R0 * S.ldb + C0) * 2u; voffB[1] = (unsigned)(R1 * S.ldb + C1) * 2u;
    const size_t kstep = (size_t)(BK * 2);
    const size_t hstepB = (size_t)HALF * S.ldb * 2;
    const unsigned ldsw = (unsigned)wid * 1024u;
    const int aoff = lds_byte(wr * 64 + fr, fq * 8), boff = lds_byte(wc * 32 + fr, fq * 8);
#define PG8_SA(b, h) (((b) * 2 + (h)) * HTB)
#define PG8_SB(b, h) ((4 + (b) * 2 + (h)) * HTB)
#define PG8_STAGE(bufoff, gbase, voff) do { _Pragma("unroll") for (int _i = 0; _i < 2; ++_i) \
        __builtin_amdgcn_global_load_lds((const unsigned*)((const char*)(gbase) + (voff)[_i]), (LAS unsigned*)(lds + (bufoff) + ldsw + _i * 8192), 16, 0, 0); } while (0)
#define PG8_LDA(dst, b, h) do { _Pragma("unroll") for (int m = 0; m < 4; ++m) _Pragma("unroll") for (int k = 0; k < 2; ++k) dst[m][k] = *(const LAS bf16x8*)(lds + PG8_SA(b, h) + aoff + m * 2048 + k * 1024); } while (0)
#define PG8_LDB(dst, b, h) do { _Pragma("unroll") for (int n = 0; n < 2; ++n) _Pragma("unroll") for (int k = 0; k < 2; ++k) dst[n][k] = *(const LAS bf16x8*)(lds + PG8_SB(b, h) + boff + n * 2048 + k * 1024); } while (0)
#define PG8_MMA(ai, bj, At, Bt) do { __builtin_amdgcn_s_setprio(1); _Pragma("unroll") for (int m = 0; m < 4; ++m) _Pragma("unroll") for (int n = 0; n < 2; ++n) _Pragma("unroll") for (int k = 0; k < 2; ++k) \
        acc[ai][bj][m][n] = __builtin_amdgcn_mfma_f32_16x16x32_bf16(Bt[n][k], At[m][k], acc[ai][bj][m][n], 0, 0, 0); __builtin_amdgcn_s_setprio(0); } while (0)
#define PG8_WAIT_V(n) asm volatile("s_waitcnt vmcnt(" #n ")" ::: "memory")
#define PG8_WAIT_L(n) asm volatile("s_waitcnt lgkmcnt(" #n ")" ::: "memory")
#define PG8_BAR __builtin_amdgcn_s_barrier()
#define PG8_SCHED __builtin_amdgcn_sched_barrier(0)
    Unit cur, nxt; int ui = 0;
    if (!S.next(0, cur)) return;
    f32x4 acc[2][2][4][2];
#pragma unroll
    for (int a = 0; a < 2; ++a)
#pragma unroll
        for (int b = 0; b < 2; ++b)
#pragma unroll
            for (int m = 0; m < 4; ++m)
#pragma unroll
                for (int n = 0; n < 2; ++n) acc[a][b][m][n] = (f32x4){0.f, 0.f, 0.f, 0.f};
    bf16x8 At[4][2], B0[2][2], B1[2][2];
    unsigned va0[2], va1[2], na0[2], na1[2];
    S.avoff(cur, R0, C0, R1, C1, va0, va1);
    na0[0] = va0[0]; na0[1] = va0[1]; na1[0] = va1[0]; na1[1] = va1[1];
    const char* cA = S.abase(cur); const char* cB = S.bbase(cur);
    PG8_STAGE(PG8_SB(0, 0), cB, voffB); PG8_STAGE(PG8_SB(0, 1), cB + hstepB, voffB); PG8_STAGE(PG8_SA(0, 0), cA, va0); PG8_STAGE(PG8_SA(0, 1), cA, va1);
    if (wr == 1) PG8_BAR;
    PG8_WAIT_V(2); PG8_BAR;
    PG8_STAGE(PG8_SB(1, 0), cB + kstep, voffB); PG8_STAGE(PG8_SA(1, 0), cA + kstep, va0); PG8_STAGE(PG8_SB(1, 1), cB + hstepB + kstep, voffB);
    PG8_WAIT_V(6); PG8_BAR;
    for (;;) {
        const bool has_next = S.next(ui + 1, nxt);
        const char* nA = has_next ? S.abase(nxt) : cA; const char* nB = has_next ? S.bbase(nxt) : cB;
        if (has_next) S.avoff(nxt, R0, C0, R1, C1, na0, na1);
        const bool hu = cur.half != 0;
#pragma unroll 1
        for (int t = 0; t < nt; t += 2) {
            const bool last = (t == nt - 2);
            const char* a1 = cA + (size_t)(t + 1) * kstep;
            const char* a2 = last ? nA : cA + (size_t)(t + 2) * kstep; const char* b2 = last ? nB : cB + (size_t)(t + 2) * kstep;
            const char* a3 = a2 + kstep; const char* b3 = b2 + kstep;
            unsigned x0[2], x1[2];
            x0[0] = last ? na0[0] : va0[0]; x0[1] = last ? na0[1] : va0[1]; x1[0] = last ? na1[0] : va1[0]; x1[1] = last ? na1[1] : va1[1];
            PG8_LDB(B0, 0, 0); PG8_LDB(B1, 0, 1); PG8_SCHED; PG8_LDA(At, 0, 0); PG8_STAGE(PG8_SA(1, 1), a1, va1);
            PG8_WAIT_V(8); PG8_WAIT_L(0); PG8_BAR; PG8_MMA(0, 0, At, B0); PG8_MMA(0, 1, At, B1); PG8_BAR; PG8_SCHED;
            if (!hu) PG8_LDA(At, 0, 1);
            PG8_STAGE(PG8_SB(0, 0), b2, voffB); PG8_STAGE(PG8_SB(0, 1), b2 + hstepB, voffB); PG8_STAGE(PG8_SA(0, 0), a2, x0);
            PG8_WAIT_V(8); PG8_WAIT_L(0); PG8_BAR; if (!hu) { PG8_MMA(1, 0, At, B0); PG8_MMA(1, 1, At, B1); } PG8_BAR; PG8_SCHED;
            PG8_LDB(B0, 1, 0); PG8_LDB(B1, 1, 1); PG8_SCHED; PG8_LDA(At, 1, 0); PG8_STAGE(PG8_SA(0, 1), a2, x1);
            PG8_WAIT_V(8); PG8_WAIT_L(0); PG8_BAR; PG8_MMA(0, 0, At, B0); PG8_MMA(0, 1, At, B1); PG8_BAR; PG8_SCHED;
            if (!hu) PG8_LDA(At, 1, 1);
            PG8_STAGE(PG8_SB(1, 0), b3, voffB); PG8_STAGE(PG8_SB(1, 1), b3 + hstepB, voffB); PG8_STAGE(PG8_SA(1, 0), a3, x0);
            PG8_WAIT_V(8); PG8_WAIT_L(0); PG8_BAR; if (!hu) { PG8_MMA(1, 0, At, B0); PG8_MMA(1, 1, At, B1); } PG8_BAR; PG8_SCHED;
        }
        if (wr == 0) PG8_BAR;
        E(acc, cur, wr, wc, fr, fq);
        if (!has_next) break;
#pragma unroll
        for (int a = 0; a < 2; ++a)
#pragma unroll
            for (int b = 0; b < 2; ++b)
#pragma unroll
                for (int m = 0; m < 4; ++m)
#pragma unroll
                    for (int n = 0; n < 2; ++n) acc[a][b][m][n] = (f32x4){0.f, 0.f, 0.f, 0.f};
        cur = nxt; cA = nA; cB = nB; ++ui;
        va0[0] = na0[0]; va0[1] = na0[1]; va1[0] = na1[0]; va1[1] = na1[1];
        if (wr == 1) PG8_BAR;
    }
    PG8_WAIT_V(0);
    PG8_BAR;
#undef PG8_SA
#undef PG8_SB
#undef PG8_STAGE
#undef PG8_LDA
#undef PG8_LDB
#undef PG8_MMA
#undef PG8_WAIT_V
#undef PG8_WAIT_L
#undef PG8_BAR
#undef PG8_SCHED
}

__device__ __forceinline__ u32x4 pack8(const f32x4 a, const f32x4 b) { u32x4 w; w.x = cvt_pk_bf16(a[0], a[1]); w.y = cvt_pk_bf16(a[2], a[3]); w.z = cvt_pk_bf16(b[0], b[1]); w.w = cvt_pk_bf16(b[2], b[3]); return w; }

struct EpiIn {
    bf16_t *u, *gb, *sg, *lat; float* rowstat; const float2* cs; const float* k_g; LAS float* xch;
    __device__ __forceinline__ void operator()(const f32x4 (&acc)[2][2][4][2], const Unit& un, int wr, int wc, int fr, int fq) const {
        asm volatile("" : "+v"(fr), "+v"(fq));
        const int row0 = un.pm * BM + wr * 64 + fr, pn = un.pn;
        if (pn < 16) {
            const int c0 = 128 * (pn & 7) + 32 * wc + 8 * fq; bf16_t* dst = pn < 8 ? u : gb; const int rh = row0 + (un.half == 2 ? HALF : 0);
#pragma unroll
            for (int ai = 0; ai < 2; ++ai)
#pragma unroll
                for (int m = 0; m < 4; ++m) { f32x4 r0, r1; if (ai == 1 && un.half) continue;
                    if (pn < 8) { r0 = acc[ai][0][m][0] * acc[ai][1][m][0]; r1 = acc[ai][0][m][1] * acc[ai][1][m][1]; }
                    else { const f32x4 g0 = acc[ai][1][m][0], g1 = acc[ai][1][m][1];
#pragma unroll
                        for (int i = 0; i < 4; ++i) { r0[i] = acc[ai][0][m][0][i] * fsigmoid(g0[i]); r1[i] = acc[ai][0][m][1][i] * fsigmoid(g1[i]); } }
                    __builtin_nontemporal_store(pack8(r0, r1), (u32x4*)(dst + (size_t)(rh + ai * HALF + m * 16) * DM + c0)); }
        } else if (pn < 20) {
            const int c0 = 256 * (pn - 16) + 32 * wc + 8 * fq;
#pragma unroll
            for (int ai = 0; ai < 2; ++ai)
#pragma unroll
                for (int m = 0; m < 4; ++m)
#pragma unroll
                    for (int bj = 0; bj < 2; ++bj) { f32x4 a = acc[ai][bj][m][0], b = acc[ai][bj][m][1];
#pragma unroll
                        for (int i = 0; i < 4; ++i) { a[i] = fsigmoid(a[i]); b[i] = fsigmoid(b[i]); }
                        __builtin_nontemporal_store(pack8(a, b), (u32x4*)(sg + (size_t)(row0 + ai * HALF + m * 16) * DM + c0 + bj * HALF)); }
        } else {
            const int c0 = 256 * (pn - 20) + 32 * wc + 8 * fq, rowt = wr * 64 + fr;
#pragma unroll
            for (int ai = 0; ai < 2; ++ai)
#pragma unroll
                for (int m = 0; m < 4; ++m) { const int rt = rowt + ai * HALF + m * 16, row = un.pm * BM + rt; float s0, s1;
                    { const f32x4 a = acc[ai][0][m][0], b = acc[ai][0][m][1]; *(u32x4*)(lat + (size_t)row * LATW + c0) = pack8(a, b);
                      s0 = (a[0] * a[0] + a[1] * a[1]) + (a[2] * a[2] + a[3] * a[3]) + (b[0] * b[0] + b[1] * b[1]) + (b[2] * b[2] + b[3] * b[3]); }
                    { const f32x4 a = acc[ai][1][m][0], b = acc[ai][1][m][1];
                      s1 = (a[0] * a[0] + a[1] * a[1]) + (a[2] * a[2] + a[3] * a[3]) + (b[0] * b[0] + b[1] * b[1]) + (b[2] * b[2] + b[3] * b[3]);
                      if (pn != 21) *(u32x4*)(lat + (size_t)row * LATW + c0 + HALF) = pack8(a, b);
                      else if (wc < 2) { const int j = 16 * wc + 4 * fq;
                          const f32x4 g1 = *(const f32x4*)(k_g + 128 + j), g2 = *(const f32x4*)(k_g + 160 + j);
                          const f32x4 cA = *(const f32x4*)((const float*)cs + ((size_t)row * 32 + j) * 2), cB = *(const f32x4*)((const float*)cs + ((size_t)row * 32 + j + 2) * 2);
                          const f32x4 x1 = a * g1, x2 = b * g2; f32x4 y1, y2;
                          y1[0] = x1[0] * cA[0] - x2[0] * cA[1]; y2[0] = x2[0] * cA[0] + x1[0] * cA[1]; y1[1] = x1[1] * cA[2] - x2[1] * cA[3]; y2[1] = x2[1] * cA[2] + x1[1] * cA[3];
                          y1[2] = x1[2] * cB[0] - x2[2] * cB[1]; y2[2] = x2[2] * cB[0] + x1[2] * cB[1]; y1[3] = x1[3] * cB[2] - x2[3] * cB[3]; y2[3] = x2[3] * cB[2] + x1[3] * cB[3];
                          u32x2 w1, w2; w1.x = cvt_pk_bf16(y1[0], y1[1]); w1.y = cvt_pk_bf16(y1[2], y1[3]); w2.x = cvt_pk_bf16(y2[0], y2[1]); w2.y = cvt_pk_bf16(y2[2], y2[3]);
                          *(u32x2*)(lat + (size_t)row * LATW + 384 + j) = w1; *(u32x2*)(lat + (size_t)row * LATW + 416 + j) = w2; } }
                    s0 += __shfl_xor(s0, 16); s0 += __shfl_xor(s0, 32); s1 += __shfl_xor(s1, 16); s1 += __shfl_xor(s1, 32);
                    if (fq == 0) { xch[rt * 8 + wc] = s0; xch[rt * 8 + 4 + wc] = s1; } }
            asm volatile("s_waitcnt lgkmcnt(0)" ::: "memory"); __builtin_amdgcn_s_barrier(); asm volatile("" ::: "memory");
            if (threadIdx.x < 256) { const int rt = threadIdx.x; const f32x4 p0 = *(const LAS f32x4*)(xch + rt * 8), p1 = *(const LAS f32x4*)(xch + rt * 8 + 4);
                const float S0 = (p0[0] + p0[1]) + (p0[2] + p0[3]), S1 = (p1[0] + p1[1]) + (p1[2] + p1[3]); float* st = rowstat + (size_t)(un.pm * BM + rt) * 4;
                if (pn == 20) st[0] = S0 + S1; else if (pn == 21) { st[1] = S0; st[2] = S1; } else st[3] = S0 + S1; }
        }
    }
};
struct EpiPlain {
    bf16_t* O; int ldc; int pnmask;
    __device__ __forceinline__ void operator()(const f32x4 (&acc)[2][2][4][2], const Unit& un, int wr, int wc, int fr, int fq) const {
        asm volatile("" : "+v"(fr), "+v"(fq));
        const int row0 = un.pm * BM + wr * 64 + fr, c0 = 256 * (un.pn & pnmask) + 32 * wc + 8 * fq;
#pragma unroll
        for (int ai = 0; ai < 2; ++ai)
#pragma unroll
            for (int m = 0; m < 4; ++m)
#pragma unroll
                for (int bj = 0; bj < 2; ++bj) __builtin_nontemporal_store(pack8(acc[ai][bj][m][0], acc[ai][bj][m][1]), (u32x4*)(O + (size_t)(row0 + ai * HALF + m * 16) * ldc + c0 + bj * HALF));
    }
};
struct EpiKV {
    bf16_t *Kb, *Vb; const bf16_t* lat; const float* rowstat; const float* k_g; LAS float* xch;
    __device__ __forceinline__ void operator()(const f32x4 (&acc)[2][2][4][2], const Unit& un, int wr, int wc, int fr, int fq) const {
        asm volatile("" : "+v"(fr), "+v"(fq));
        const int h = un.pn, rowt = wr * 64 + fr, b = (un.pm * BM) / SEQ, s0 = (un.pm * BM) % SEQ;
        f32x2 st[2][4];
        u32x4 rp[2][2];
#pragma unroll
        for (int ai = 0; ai < 2; ++ai) {
#pragma unroll
            for (int m = 0; m < 4; ++m) st[ai][m] = *(const f32x2*)(rowstat + (size_t)(un.pm * BM + rowt + ai * HALF + m * 16) * 4 + 2);
            const bf16_t* lr = lat + (size_t)(un.pm * BM + rowt + ai * HALF + wc * 16) * LATW + 384 + 16 * fq;
            rp[ai][0] = *(const u32x4*)lr; rp[ai][1] = *(const u32x4*)(lr + 8); }
#pragma unroll
        for (int ai = 0; ai < 2; ++ai)
#pragma unroll
            for (int m = 0; m < 4; ++m) {
                const f32x4 a = acc[ai][0][m][0], c = acc[ai][0][m][1];
                float ss = (a[0] * a[0] + a[1] * a[1]) + (a[2] * a[2] + a[3] * a[3]) + (c[0] * c[0] + c[1] * c[1]) + (c[2] * c[2] + c[3] * c[3]);
                ss += __shfl_xor(ss, 16); ss += __shfl_xor(ss, 32);
                if (fq == 0) xch[(rowt + ai * HALF + m * 16) * 4 + wc] = ss; }
        asm volatile("s_waitcnt lgkmcnt(0)" ::: "memory"); __builtin_amdgcn_s_barrier(); asm volatile("" ::: "memory");
        const int c8 = 32 * wc + 8 * fq;
        const f32x4 g0 = *(const f32x4*)(k_g + c8), g1 = *(const f32x4*)(k_g + c8 + 4);
#pragma unroll
        for (int ai = 0; ai < 2; ++ai)
#pragma unroll
            for (int m = 0; m < 4; ++m) { const int rt = rowt + ai * HALF + m * 16;
                const float rkv = __builtin_amdgcn_rsqf(st[ai][m][1] * (1.f / KVL) + EPS);
                const f32x4 t4 = *(const LAS f32x4*)(xch + rt * 4);
                const float rk = __builtin_amdgcn_rsqf((((t4[0] + t4[1]) + (t4[2] + t4[3])) * rkv * rkv + st[ai][m][0]) * (1.f / QKH) + EPS);
                const float sk = rkv * rk, sv = rkv;
                const size_t bhs = (size_t)(b * NH + h) * SEQ + s0 + rt;
                bf16_t* Kp = Kb + bhs * QKH; bf16_t* Vp = Vb + bhs * VH;
                *(u32x4*)(Kp + c8) = pack8(acc[ai][0][m][0] * sk * g0, acc[ai][0][m][1] * sk * g1);
                *(u32x4*)(Vp + c8) = pack8(acc[ai][1][m][0] * sv, acc[ai][1][m][1] * sv);
                if (m == wc) {
                    u32x4 o0, o1;
#pragma unroll
                    for (int e = 0; e < 4; ++e) { o0[e] = cvt_pk_bf16(__uint_as_float(rp[ai][0][e] << 16) * rk, __uint_as_float(rp[ai][0][e] & 0xffff0000u) * rk);
                                                  o1[e] = cvt_pk_bf16(__uint_as_float(rp[ai][1][e] << 16) * rk, __uint_as_float(rp[ai][1][e] & 0xffff0000u) * rk); }
                    *(u32x4*)(Kp + 128 + 16 * fq) = o0; *(u32x4*)(Kp + 128 + 16 * fq + 8) = o1; } }
    }
};
struct EpiNull {
    __device__ __forceinline__ void operator()(const f32x4 (&acc)[2][2][4][2], const Unit& un, int wr, int wc, int fr, int fq) const {
#pragma unroll
        for (int ai = 0; ai < 2; ++ai)
#pragma unroll
            for (int bj = 0; bj < 2; ++bj)
#pragma unroll
                for (int m = 0; m < 4; ++m) { f32x4 a = acc[ai][bj][m][0], b = acc[ai][bj][m][1]; asm volatile("" :: "v"(a), "v"(b)); }
    }
};
struct EpiDelta {
    const float* mod; bf16_t* delta;
    __device__ __forceinline__ void operator()(const f32x4 (&acc)[2][2][4][2], const Unit& un, int wr, int wc, int fr, int fq) const {
        asm volatile("" : "+v"(fr), "+v"(fq));
        const int row0 = un.pm * BM + wr * 64 + fr, b = (un.pm * BM) / SEQ, c0 = 256 * un.pn + 32 * wc + 8 * fq;
        const float* gate = mod + b * 6144 + 2048;
#pragma unroll
        for (int bj = 0; bj < 2; ++bj) { const f32x4 g0 = *(const f32x4*)(gate + c0 + bj * HALF), g1 = *(const f32x4*)(gate + c0 + bj * HALF + 4);
#pragma unroll
            for (int ai = 0; ai < 2; ++ai)
#pragma unroll
                for (int m = 0; m < 4; ++m) *(u32x4*)(delta + (size_t)(row0 + ai * HALF + m * 16) * DM + c0 + bj * HALF) = pack8(acc[ai][bj][m][0] * g0, acc[ai][bj][m][1] * g1); }
    }
};
namespace att {
constexpr int NW = 8, QBLK = 32, KVBLK = 64, KPITCH = 400;
constexpr int SHM_V = KVBLK * VH * 2, SHM_K = KVBLK * KPITCH;
constexpr int QRP = 144;
constexpr int OFF_V = 0, OFF_K = 2 * SHM_V, OFF_WS = OFF_K + 2 * SHM_K, OFF_QR = OFF_WS + NW * 64 * 4, ATT_LDS = OFF_QR + NW * 32 * QRP;
constexpr float SCALE = 0.07216878364870322f;
constexpr float THR = 8.f;
#define SBAR() __builtin_amdgcn_sched_barrier(0)
__device__ __forceinline__ int crow(int r, int hi) { return (r & 3) + 8 * (r >> 2) + 4 * hi; }
__device__ __forceinline__ void partialSM(f32x16& p0, f32x16& p1, float& m_reg, float& alpha) {
    constexpr float C = SCALE * 1.4426950408889634f;
    float pmax = p0[0];
#pragma unroll
    for (int r = 1; r < 16; ++r) pmax = fmaxf(pmax, p0[r]);
#pragma unroll
    for (int r = 0; r < 16; ++r) pmax = fmaxf(pmax, p1[r]);
    { auto rr = __builtin_amdgcn_permlane32_swap(__float_as_uint(pmax), __float_as_uint(pmax), false, false);
      pmax = fmaxf(__uint_as_float(rr[0]), __uint_as_float(rr[1])); }
    float mn;
    if (__builtin_expect(__all(pmax - m_reg <= THR / SCALE), 1)) { mn = m_reg; alpha = 1.f; }
    else { mn = fmaxf(m_reg, pmax); alpha = __builtin_amdgcn_exp2f((m_reg - mn) * C); m_reg = mn; }
    const float mnC = -mn * C;
#pragma unroll
    for (int r = 0; r < 16; ++r) p0[r] = fmaf(p0[r], C, mnC);
#pragma unroll
    for (int r = 0; r < 16; ++r) p1[r] = fmaf(p1[r], C, mnC);
#pragma unroll
    for (int r = 0; r < 16; ++r) p0[r] = __builtin_amdgcn_exp2f(p0[r]);
}
__device__ __forceinline__ void finishSM(f32x16& p0, f32x16& p1, float alpha, float& l_reg, bf16x8& pa0, bf16x8& pa1, bf16x8& pa2, bf16x8& pa3) {
#pragma unroll
    for (int r = 0; r < 16; ++r) p1[r] = __builtin_amdgcn_exp2f(p1[r]);
    float ps = 0;
#pragma unroll
    for (int r = 0; r < 16; ++r) ps += p0[r];
#pragma unroll
    for (int r = 0; r < 16; ++r) ps += p1[r];
    { auto rr = __builtin_amdgcn_permlane32_swap(__float_as_uint(ps), __float_as_uint(ps), false, false);
      ps = __uint_as_float(rr[0]) + __uint_as_float(rr[1]); }
    l_reg = l_reg * alpha + ps;
#define PK4(P, BASE, OUT) do { unsigned a0 = cvt_pk_bf16(P[BASE + 0], P[BASE + 1]), a1 = cvt_pk_bf16(P[BASE + 2], P[BASE + 3]);   \
    unsigned b0 = cvt_pk_bf16(P[BASE + 4], P[BASE + 5]), b1 = cvt_pk_bf16(P[BASE + 6], P[BASE + 7]);                              \
    auto r0 = __builtin_amdgcn_permlane32_swap(a0, b0, false, false); auto r1 = __builtin_amdgcn_permlane32_swap(a1, b1, false, false); \
    u32x4 w = {r0[0], r1[0], r0[1], r1[1]}; OUT = *reinterpret_cast<bf16x8*>(&w); } while (0)
    PK4(p0, 0, pa0); PK4(p0, 8, pa1); PK4(p1, 0, pa2); PK4(p1, 8, pa3);
#undef PK4
}
__device__ __forceinline__ void qkt(f32x16& p0, f32x16& p1, const LAS char* Ks, const bf16x8 (&qr)[8], const LAS char* qrope, int r32, int hi) {
    p0 = f32x16{}; p1 = f32x16{};
    const LAS char* k0 = Ks + r32 * KPITCH + hi * 16;
#pragma unroll
    for (int d0 = 0; d0 < 8; ++d0) {
        const bf16x8 b0 = *(const LAS bf16x8*)(k0 + d0 * 32);
        const bf16x8 b1 = *(const LAS bf16x8*)(k0 + 32 * KPITCH + d0 * 32);
        p0 = __builtin_amdgcn_mfma_f32_32x32x16_bf16(b0, qr[d0], p0, 0, 0, 0);
        p1 = __builtin_amdgcn_mfma_f32_32x32x16_bf16(b1, qr[d0], p1, 0, 0, 0); }
#pragma unroll
    for (int d0 = 8; d0 < 12; ++d0) {
        const bf16x8 b0 = *(const LAS bf16x8*)(k0 + d0 * 32);
        const bf16x8 b1 = *(const LAS bf16x8*)(k0 + 32 * KPITCH + d0 * 32);
        const bf16x8 qf = *(const LAS bf16x8*)(qrope + (d0 - 8) * 32);
        p0 = __builtin_amdgcn_mfma_f32_32x32x16_bf16(b0, qf, p0, 0, 0, 0);
        p1 = __builtin_amdgcn_mfma_f32_32x32x16_bf16(b1, qf, p1, 0, 0, 0); }
}
__device__ __forceinline__ int v_st(int k, int c) { const int kk = (k & ~0xC) | ((k & 4) << 1) | ((k & 8) >> 1); return ((kk >> 3) * 4 + (c >> 5)) * 512 + ((kk & 7) * 32 + (c & 31)) * 2; }
__device__ __forceinline__ int v_rd_base(int lane) { return ((lane & 3) << 3) | (((lane >> 2) & 3) << 6) | (((lane >> 4) & 1) << 5) | (((lane >> 5) & 1) << 8); }
constexpr int v_rd_off(int d0, int ks, int half) { return d0 * 512 + ks * 4096 + half * 2048; }
template <int OFF> __device__ __forceinline__ s16x4 tr_read(int vb) {
    s16x4 r; asm volatile("ds_read_b64_tr_b16 %0, %1 offset:%2" : "=&v"(r) : "v"(vb), "i"(OFF) : "memory"); return r;
}
template <int D0> __device__ __forceinline__ void pv_one(f32x16& od, int vb, bf16x8 pa0, bf16x8 pa1, bf16x8 pa2, bf16x8 pa3) {
    const s16x4 l0 = tr_read<v_rd_off(D0, 0, 0)>(vb), h0 = tr_read<v_rd_off(D0, 0, 1)>(vb), l1 = tr_read<v_rd_off(D0, 1, 0)>(vb), h1 = tr_read<v_rd_off(D0, 1, 1)>(vb);
    const s16x4 l2 = tr_read<v_rd_off(D0, 2, 0)>(vb), h2 = tr_read<v_rd_off(D0, 2, 1)>(vb), l3 = tr_read<v_rd_off(D0, 3, 0)>(vb), h3 = tr_read<v_rd_off(D0, 3, 1)>(vb);
    asm volatile("s_waitcnt lgkmcnt(0)" ::: "memory"); SBAR();
#define PK(L, H) (bf16x8){L[0], L[1], L[2], L[3], H[0], H[1], H[2], H[3]}
    od = __builtin_amdgcn_mfma_f32_32x32x16_bf16(pa0, PK(l0, h0), od, 0, 0, 0);
    od = __builtin_amdgcn_mfma_f32_32x32x16_bf16(pa1, PK(l1, h1), od, 0, 0, 0);
    od = __builtin_amdgcn_mfma_f32_32x32x16_bf16(pa2, PK(l2, h2), od, 0, 0, 0);
    od = __builtin_amdgcn_mfma_f32_32x32x16_bf16(pa3, PK(l3, h3), od, 0, 0, 0);
#undef PK
}
__device__ __forceinline__ void pv_d0(f32x16 (&o)[4], int vb, bf16x8 pa0, bf16x8 pa1, bf16x8 pa2, bf16x8 pa3) {
    pv_one<0>(o[0], vb, pa0, pa1, pa2, pa3); pv_one<1>(o[1], vb, pa0, pa1, pa2, pa3); pv_one<2>(o[2], vb, pa0, pa1, pa2, pa3); pv_one<3>(o[3], vb, pa0, pa1, pa2, pa3);
}
__device__ __forceinline__ float bflo(unsigned w) { return __uint_as_float(w << 16); }
__device__ __forceinline__ float bfhi(unsigned w) { return __uint_as_float(w & 0xffff0000u); }

struct AttnArgs { const bf16_t* lat; const bf16_t* wqn; const bf16_t* Q; const bf16_t* Kb; const bf16_t* Vb; const float* ssp; const float2* cs; const float* q_g; const bf16_t *u, *gb, *sg; const float* conv_w; bf16_t* merged; };

template <int MODE> __device__ __forceinline__ void attn_unit(const AttnArgs& T, int b, int h, int qb, LAS char* lds) {
    int tid = threadIdx.x; asm volatile("" : "+v"(tid));
    const int lane = tid & 63, r32 = lane & 31, hi = lane >> 5; const int wid = __builtin_amdgcn_readfirstlane(tid >> 6);
    LAS char* V_lds = lds + OFF_V; LAS char* K_lds = lds + OFF_K;
    LAS float* ws = (LAS float*)(lds + OFF_WS) + wid * 64; LAS float* li_l = ws; LAS float* al_l = ws + 32;
    const int mrow = b * SEQ + qb * 256 + wid * QBLK + r32;
    const bf16_t* Kh = T.Kb + (size_t)(b * NH + h) * SEQ * QKH; const bf16_t* Vh = T.Vb + (size_t)(b * NH + h) * SEQ * VH;
    const int sr = tid >> 4, sc = (tid & 15) * 8, vst0 = v_st(sr, sc), vst1 = v_st(32 + sr, sc);
    const int kdst = (tid >> 3) * KPITCH + (tid & 7) * 48;
    const int vb0 = (int)(uintptr_t)V_lds + v_rd_base(lane);
    bf16x8 sk0, sk1, sk2, sv0, sv1;
#define SLOAD(t) do { const bf16_t* kp = Kh + (size_t)(t) * KVBLK * QKH + tid * 24; sk0 = *(const bf16x8*)kp; sk1 = *(const bf16x8*)(kp + 8); sk2 = *(const bf16x8*)(kp + 16); \
    const bf16_t* vp = Vh + (size_t)((t) * KVBLK + sr) * VH + sc; sv0 = *(const bf16x8*)vp; sv1 = *(const bf16x8*)(vp + 32 * VH); } while (0)
#define SWRITE(bf) do { *(LAS bf16x8*)(V_lds + (bf) * SHM_V + vst0) = sv0; *(LAS bf16x8*)(V_lds + (bf) * SHM_V + vst1) = sv1; \
    *(LAS bf16x8*)(K_lds + (bf) * SHM_K + kdst) = sk0; *(LAS bf16x8*)(K_lds + (bf) * SHM_K + kdst + 16) = sk1; *(LAS bf16x8*)(K_lds + (bf) * SHM_K + kdst + 32) = sk2; } while (0)
#define RESC(a) do { if (__any((a) < 1.f)) { if (hi == 0) al_l[r32] = (a); asm volatile("s_waitcnt lgkmcnt(0)" ::: "memory"); \
    _Pragma("unroll") for (int d = 0; d < 4; ++d) _Pragma("unroll") for (int r = 0; r < 16; ++r) o[d][r] *= al_l[crow(r, hi)]; } } while (0)
    SLOAD(0);
    bf16x8 qr[8];
    LAS char* qrope = lds + OFF_QR + wid * (32 * QRP) + r32 * QRP + hi * 16;
    {
        const bf16_t* Qw = T.Q + (size_t)mrow * 1536 + h * QKH + hi * 8;
        u32x4 raw[12];
#pragma unroll
        for (int d0 = 0; d0 < 12; ++d0) raw[d0] = *(const u32x4*)(Qw + d0 * 16);
        const f32x2 sq2 = *(const f32x2*)(T.ssp + (size_t)mrow * 4); const float ssq = sq2[0] + sq2[1];
        float ss = 0.f;
#pragma unroll
        for (int d0 = 0; d0 < 12; ++d0)
#pragma unroll
            for (int e = 0; e < 4; ++e) { const float a = bflo(raw[d0][e]), c = bfhi(raw[d0][e]); ss += a * a + c * c; }
        { auto rr = __builtin_amdgcn_permlane32_swap(__float_as_uint(ss), __float_as_uint(ss), false, false); ss = __uint_as_float(rr[0]) + __uint_as_float(rr[1]); }
        const float rq2 = 1.f / (ssq * (1.f / QL) + EPS);
        const float rn = 1.f / sqrtf(ss * rq2 * (1.f / QKH) + EPS) * sqrtf(rq2);
#pragma unroll
        for (int d0 = 0; d0 < 8; ++d0) { const f32x4 g0 = *(const f32x4*)(T.q_g + d0 * 16 + hi * 8), g1 = *(const f32x4*)(T.q_g + d0 * 16 + hi * 8 + 4);
            u32x4 w; w.x = cvt_pk_bf16(bflo(raw[d0].x) * rn * g0[0], bfhi(raw[d0].x) * rn * g0[1]); w.y = cvt_pk_bf16(bflo(raw[d0].y) * rn * g0[2], bfhi(raw[d0].y) * rn * g0[3]);
            w.z = cvt_pk_bf16(bflo(raw[d0].z) * rn * g1[0], bfhi(raw[d0].z) * rn * g1[1]); w.w = cvt_pk_bf16(bflo(raw[d0].w) * rn * g1[2], bfhi(raw[d0].w) * rn * g1[3]);
            qr[d0] = *reinterpret_cast<bf16x8*>(&w); }
#pragma unroll
        for (int p = 0; p < 2; ++p) {
            const int ib = 16 * p + 8 * hi;
            float x1[8], x2[8];
            const f32x4 ga = *(const f32x4*)(T.q_g + 128 + ib), gb_ = *(const f32x4*)(T.q_g + 128 + ib + 4), gc = *(const f32x4*)(T.q_g + 160 + ib), gd = *(const f32x4*)(T.q_g + 160 + ib + 4);
            const float g1v[8] = {ga[0], ga[1], ga[2], ga[3], gb_[0], gb_[1], gb_[2], gb_[3]}, g2v[8] = {gc[0], gc[1], gc[2], gc[3], gd[0], gd[1], gd[2], gd[3]};
#pragma unroll
            for (int e = 0; e < 4; ++e) { x1[2 * e] = bflo(raw[8 + p][e]) * rn * g1v[2 * e]; x1[2 * e + 1] = bfhi(raw[8 + p][e]) * rn * g1v[2 * e + 1];
                                          x2[2 * e] = bflo(raw[10 + p][e]) * rn * g2v[2 * e]; x2[2 * e + 1] = bfhi(raw[10 + p][e]) * rn * g2v[2 * e + 1]; }
            float y1[8], y2[8];
#pragma unroll
            for (int jj = 0; jj < 4; ++jj) { const f32x4 c2 = *(const f32x4*)((const float*)T.cs + ((size_t)mrow * 32 + ib + 2 * jj) * 2);
                y1[2 * jj] = x1[2 * jj] * c2[0] - x2[2 * jj] * c2[1]; y2[2 * jj] = x2[2 * jj] * c2[0] + x1[2 * jj] * c2[1];
                y1[2 * jj + 1] = x1[2 * jj + 1] * c2[2] - x2[2 * jj + 1] * c2[3]; y2[2 * jj + 1] = x2[2 * jj + 1] * c2[2] + x1[2 * jj + 1] * c2[3]; }
            u32x4 w1, w2; w1.x = cvt_pk_bf16(y1[0], y1[1]); w1.y = cvt_pk_bf16(y1[2], y1[3]); w1.z = cvt_pk_bf16(y1[4], y1[5]); w1.w = cvt_pk_bf16(y1[6], y1[7]);
            w2.x = cvt_pk_bf16(y2[0], y2[1]); w2.y = cvt_pk_bf16(y2[2], y2[3]); w2.z = cvt_pk_bf16(y2[4], y2[5]); w2.w = cvt_pk_bf16(y2[6], y2[7]);
            *(LAS u32x4*)(qrope + p * 32) = w1; *(LAS u32x4*)(qrope + (2 + p) * 32) = w2; }
        asm volatile("s_waitcnt lgkmcnt(0)" ::: "memory");
    }
    float m_reg = -1e30f, l_reg = 0.f; f32x16 o[4] = {};
    f32x16 pA0, pA1, pB0, pB1; float alA = 1.f, alB = 1.f; bf16x8 pa0, pa1, pa2, pa3;
    const int NT = 4 * qb + 4; const int wp = wid >> 1;
    const bool a1 = wp >= 1, a2 = wp >= 2, a3 = wp >= 3;
    const LAS char* K0 = K_lds; const LAS char* K1 = K_lds + SHM_K;
    asm volatile("s_waitcnt vmcnt(0)" ::: "memory"); SWRITE(0); __syncthreads();
    qkt(pA0, pA1, K0, qr, qrope, r32, hi); partialSM(pA0, pA1, m_reg, alA);
    SLOAD(1); asm volatile("s_waitcnt vmcnt(0)" ::: "memory"); SWRITE(1); __syncthreads();
    for (int j = 1; j + 3 < NT; j += 2) {
        SBAR(); qkt(pB0, pB1, K1, qr, qrope, r32, hi);
        finishSM(pA0, pA1, alA, l_reg, pa0, pa1, pa2, pa3); SBAR();
        SLOAD(j + 1); SBAR();
        pv_d0(o, vb0, pa0, pa1, pa2, pa3); partialSM(pB0, pB1, m_reg, alB);
        __syncthreads(); asm volatile("s_waitcnt vmcnt(0)" ::: "memory"); SWRITE(0);
        RESC(alB); __syncthreads();
        SBAR(); qkt(pA0, pA1, K0, qr, qrope, r32, hi);
        finishSM(pB0, pB1, alB, l_reg, pa0, pa1, pa2, pa3); SBAR();
        SLOAD(j + 2); SBAR();
        pv_d0(o, vb0 + SHM_V, pa0, pa1, pa2, pa3); partialSM(pA0, pA1, m_reg, alA);
        __syncthreads(); asm volatile("s_waitcnt vmcnt(0)" ::: "memory"); SWRITE(1);
        RESC(alA); __syncthreads();
    }
#define MASK(P0, P1, act) do { if (!(act)) { _Pragma("unroll") for (int r = 0; r < 16; ++r) { P0[r] = -INFINITY; P1[r] = -INFINITY; } } } while (0)
    {
        SBAR(); if (a1) qkt(pB0, pB1, K1, qr, qrope, r32, hi); MASK(pB0, pB1, a1);
        finishSM(pA0, pA1, alA, l_reg, pa0, pa1, pa2, pa3); SBAR();
        SLOAD(NT - 2); SBAR();
        pv_d0(o, vb0, pa0, pa1, pa2, pa3); partialSM(pB0, pB1, m_reg, alB);
        __syncthreads(); asm volatile("s_waitcnt vmcnt(0)" ::: "memory"); SWRITE(0);
        RESC(alB); __syncthreads();
        SBAR(); if (a2) qkt(pA0, pA1, K0, qr, qrope, r32, hi); MASK(pA0, pA1, a2);
        finishSM(pB0, pB1, alB, l_reg, pa0, pa1, pa2, pa3); SBAR();
        SLOAD(NT - 1); SBAR();
        pv_d0(o, vb0 + SHM_V, pa0, pa1, pa2, pa3); partialSM(pA0, pA1, m_reg, alA);
        __syncthreads(); asm volatile("s_waitcnt vmcnt(0)" ::: "memory"); SWRITE(1);
        RESC(alA); __syncthreads();
        SBAR(); if (a3) qkt(pB0, pB1, K1, qr, qrope, r32, hi); MASK(pB0, pB1, a3);
        finishSM(pA0, pA1, alA, l_reg, pa0, pa1, pa2, pa3); SBAR();
        pv_d0(o, vb0, pa0, pa1, pa2, pa3); partialSM(pB0, pB1, m_reg, alB);
        RESC(alB);
        finishSM(pB0, pB1, alB, l_reg, pa0, pa1, pa2, pa3); SBAR();
        pv_d0(o, vb0 + SHM_V, pa0, pa1, pa2, pa3);
    }
#undef MASK
    if (hi == 0) li_l[r32] = l_reg; asm volatile("s_waitcnt lgkmcnt(0)" ::: "memory");
    float rli[16];
#pragma unroll
    for (int r = 0; r < 16; ++r) rli[r] = __builtin_amdgcn_rcpf(li_l[crow(r, hi)]);
    __syncthreads();
    LAS bf16_t* stg = (LAS bf16_t*)(lds + wid * 8192);
#pragma unroll
    for (int r = 0; r < 16; ++r) { const int orow = crow(r, hi);
#pragma unroll
        for (int d0 = 0; d0 < 4; ++d0) stg[orow * 128 + d0 * 32 + r32] = f2bf(o[d0][r] * rli[r]); }
    asm volatile("s_waitcnt lgkmcnt(0)" ::: "memory");
    if (MODE != 1) {
        const int ch = lane & 15, c = h * VH + ch * 8;
        const f32x4 w0a = *(const f32x4*)(T.conv_w + c), w0b = *(const f32x4*)(T.conv_w + c + 4), w1a = *(const f32x4*)(T.conv_w + DM + c), w1b = *(const f32x4*)(T.conv_w + DM + c + 4),
              w2a = *(const f32x4*)(T.conv_w + 2 * DM + c), w2b = *(const f32x4*)(T.conv_w + 2 * DM + c + 4);
        const float cw0[8] = {w0a[0], w0a[1], w0a[2], w0a[3], w0b[0], w0b[1], w0b[2], w0b[3]}, cw1[8] = {w1a[0], w1a[1], w1a[2], w1a[3], w1b[0], w1b[1], w1b[2], w1b[3]},
                    cw2[8] = {w2a[0], w2a[1], w2a[2], w2a[3], w2b[0], w2b[1], w2b[2], w2b[3]};
#pragma unroll 4
        for (int i = 0; i < 8; ++i) { const int row = i * 4 + (lane >> 4); const int tt = qb * 256 + wid * QBLK + row; const size_t e = (size_t)(b * SEQ + tt) * DM + c;
            const u32x4 ov = *(const LAS u32x4*)(stg + row * 128 + ch * 8);
            const u32x4 u0 = *(const u32x4*)(T.u + e), gbv = *(const u32x4*)(T.gb + e), sgv = *(const u32x4*)(T.sg + e);
            u32x4 u1 = {0u, 0u, 0u, 0u}, u2 = {0u, 0u, 0u, 0u};
            if (tt >= 1) u1 = *(const u32x4*)(T.u + e - DM);
            if (tt >= 2) u2 = *(const u32x4*)(T.u + e - 2 * DM);
            u32x4 res;
#pragma unroll
            for (int q = 0; q < 4; ++q) {
                const float cl = cw0[2 * q] * bflo(u2[q]) + cw1[2 * q] * bflo(u1[q]) + cw2[2 * q] * bflo(u0[q]), chh = cw0[2 * q + 1] * bfhi(u2[q]) + cw1[2 * q + 1] * bfhi(u1[q]) + cw2[2 * q + 1] * bfhi(u0[q]);
                res[q] = cvt_pk_bf16(bflo(gbv[q]) * cl + bflo(sgv[q]) * bflo(ov[q]), bfhi(gbv[q]) * chh + bfhi(sgv[q]) * bfhi(ov[q])); }
            *(u32x4*)(T.merged + e) = res; }
    }
    asm volatile("s_waitcnt lgkmcnt(0)" ::: "memory");
    __syncthreads();
#undef SLOAD
#undef SWRITE
#undef RESC
}

constexpr int K2_BYTES = KVBLK * QKH * 2, V2_OFF = 0, K2_OFF = 3 * SHM_V, WS2_OFF = K2_OFF + 2 * K2_BYTES, ATT2_LDS = WS2_OFF + NW * 64 * 4;
__device__ __forceinline__ void qkt2(f32x16& p0, f32x16& p1, const LAS char* Krow, const int (&koff)[4], const bf16x8 (&qr)[12]) {
    p0 = f32x16{}; p1 = f32x16{};
    bf16x8 fa[4], fb[4];
#define KRD(dst, d0) do { const LAS char* a_ = Krow + ((d0) >> 2) * 128 + koff[(d0) & 3]; dst[0] = *(const LAS bf16x8*)a_; dst[1] = *(const LAS bf16x8*)(a_ + 32 * QKH * 2); \
                          const LAS char* c_ = Krow + (((d0) + 1) >> 2) * 128 + koff[((d0) + 1) & 3]; dst[2] = *(const LAS bf16x8*)c_; dst[3] = *(const LAS bf16x8*)(c_ + 32 * QKH * 2); } while (0)
#define KMM(src, d0) do { p0 = __builtin_amdgcn_mfma_f32_32x32x16_bf16(src[0], qr[d0], p0, 0, 0, 0); p1 = __builtin_amdgcn_mfma_f32_32x32x16_bf16(src[1], qr[d0], p1, 0, 0, 0); \
                          p0 = __builtin_amdgcn_mfma_f32_32x32x16_bf16(src[2], qr[(d0) + 1], p0, 0, 0, 0); p1 = __builtin_amdgcn_mfma_f32_32x32x16_bf16(src[3], qr[(d0) + 1], p1, 0, 0, 0); } while (0)
    KRD(fa, 0); KRD(fb, 2);
    KMM(fa, 0); KRD(fa, 4);
    KMM(fb, 2); KRD(fb, 6);
    KMM(fa, 4); KRD(fa, 8);
    KMM(fb, 6); KRD(fb, 10);
    KMM(fa, 8);
    KMM(fb, 10);
#undef KRD
#undef KMM
}
template <int MODE> __device__ __forceinline__ void attn_unit2(const AttnArgs& T, int b, int h, int qb, LAS char* lds) {
    int tid = threadIdx.x; asm volatile("" : "+v"(tid));
    const int lane = tid & 63, r32 = lane & 31, hi = lane >> 5; const int wid = __builtin_amdgcn_readfirstlane(tid >> 6);
    LAS char* V_lds = lds + V2_OFF; LAS char* K_lds = lds + K2_OFF;
    LAS float* ws = (LAS float*)(lds + WS2_OFF) + wid * 64; LAS float* li_l = ws; LAS float* al_l = ws + 32;
    const int mrow = b * SEQ + qb * 256 + wid * QBLK + r32;
    const char* Kh = (const char*)(T.Kb + (size_t)(b * NH + h) * SEQ * QKH); const char* Vh = (const char*)(T.Vb + (size_t)(b * NH + h) * SEQ * VH);
#define DMA_KV(t, kbuf, vbuf) do { const char* kt = Kh + (size_t)(t) * K2_BYTES; const char* vt = Vh + (size_t)(t) * SHM_V; int ln = lane; asm volatile("" : "+v"(ln)); \
    _Pragma("unroll") for (int _i = 0; _i < 3; ++_i) { const int q = (wid * 3 + _i) * 64 + ln, r = q / 24, cp = q - r * 24, c = (cp & ~7) | ((cp & 7) ^ ((r >> 1) & 7)); \
        __builtin_amdgcn_global_load_lds((const unsigned*)(kt + (unsigned)(r * 384 + c * 16)), (LAS unsigned*)(K_lds + (kbuf) * K2_BYTES + (wid * 3 + _i) * 1024), 16, 0, 0); } \
    _Pragma("unroll") for (int _i = 0; _i < 2; ++_i) { const int q = (wid * 2 + _i) * 64 + ln, sub = q >> 5, w = q & 31, kk = ((sub >> 2) << 3) | (w >> 2), k = (kk & ~0xC) | ((kk & 4) << 1) | ((kk & 8) >> 1), c = ((sub & 3) << 5) | ((w & 3) << 3); \
        __builtin_amdgcn_global_load_lds((const unsigned*)(vt + (unsigned)(k * 256 + c * 2)), (LAS unsigned*)(V_lds + (vbuf) * SHM_V + (wid * 2 + _i) * 1024), 16, 0, 0); } } while (0)
#define RESC(a) do { if (__any((a) < 1.f)) { if (hi == 0) al_l[r32] = (a); asm volatile("s_waitcnt lgkmcnt(0)" ::: "memory"); \
    _Pragma("unroll") for (int d = 0; d < 4; ++d) _Pragma("unroll") for (int r = 0; r < 16; ++r) o[d][r] *= al_l[crow(r, hi)]; } } while (0)
    DMA_KV(0, 0, 0);
    const int vb0 = (int)(uintptr_t)V_lds + v_rd_base(lane);
    const LAS char* Krow = K_lds + r32 * (QKH * 2);
    int koff[4];
    { const int sw = (r32 >> 1) & 7;
#pragma unroll
      for (int j = 0; j < 4; ++j) koff[j] = ((2 * j + hi) ^ sw) * 16; }
    bf16x8 qr[12];
    {
        const bf16_t* Qw = T.Q + (size_t)mrow * 1536 + h * QKH + hi * 8;
        u32x4 raw[12];
#pragma unroll
        for (int d0 = 0; d0 < 12; ++d0) raw[d0] = *(const u32x4*)(Qw + d0 * 16);
        const f32x2 sq2 = *(const f32x2*)(T.ssp + (size_t)mrow * 4); const float ssq = sq2[0] + sq2[1];
        float ss = 0.f;
#pragma unroll
        for (int d0 = 0; d0 < 12; ++d0)
#pragma unroll
            for (int e = 0; e < 4; ++e) { const float a = bflo(raw[d0][e]), c = bfhi(raw[d0][e]); ss += a * a + c * c; }
        { auto rr = __builtin_amdgcn_permlane32_swap(__float_as_uint(ss), __float_as_uint(ss), false, false); ss = __uint_as_float(rr[0]) + __uint_as_float(rr[1]); }
        const float rq2 = 1.f / (ssq * (1.f / QL) + EPS);
        const float rn = 1.f / sqrtf(ss * rq2 * (1.f / QKH) + EPS) * sqrtf(rq2);
#pragma unroll
        for (int d0 = 0; d0 < 8; ++d0) { const f32x4 g0 = *(const f32x4*)(T.q_g + d0 * 16 + hi * 8), g1 = *(const f32x4*)(T.q_g + d0 * 16 + hi * 8 + 4);
            u32x4 w; w.x = cvt_pk_bf16(bflo(raw[d0].x) * rn * g0[0], bfhi(raw[d0].x) * rn * g0[1]); w.y = cvt_pk_bf16(bflo(raw[d0].y) * rn * g0[2], bfhi(raw[d0].y) * rn * g0[3]);
            w.z = cvt_pk_bf16(bflo(raw[d0].z) * rn * g1[0], bfhi(raw[d0].z) * rn * g1[1]); w.w = cvt_pk_bf16(bflo(raw[d0].w) * rn * g1[2], bfhi(raw[d0].w) * rn * g1[3]);
            qr[d0] = *reinterpret_cast<bf16x8*>(&w); }
#pragma unroll
        for (int p = 0; p < 2; ++p) {
            const int ib = 16 * p + 8 * hi;
            float x1[8], x2[8];
            const f32x4 ga = *(const f32x4*)(T.q_g + 128 + ib), gb_ = *(const f32x4*)(T.q_g + 128 + ib + 4), gc = *(const f32x4*)(T.q_g + 160 + ib), gd = *(const f32x4*)(T.q_g + 160 + ib + 4);
            const float g1v[8] = {ga[0], ga[1], ga[2], ga[3], gb_[0], gb_[1], gb_[2], gb_[3]}, g2v[8] = {gc[0], gc[1], gc[2], gc[3], gd[0], gd[1], gd[2], gd[3]};
#pragma unroll
            for (int e = 0; e < 4; ++e) { x1[2 * e] = bflo(raw[8 + p][e]) * rn * g1v[2 * e]; x1[2 * e + 1] = bfhi(raw[8 + p][e]) * rn * g1v[2 * e + 1];
                                          x2[2 * e] = bflo(raw[10 + p][e]) * rn * g2v[2 * e]; x2[2 * e + 1] = bfhi(raw[10 + p][e]) * rn * g2v[2 * e + 1]; }
            float y1[8], y2[8];
#pragma unroll
            for (int jj = 0; jj < 4; ++jj) { const f32x4 c2 = *(const f32x4*)((const float*)T.cs + ((size_t)mrow * 32 + ib + 2 * jj) * 2);
                y1[2 * jj] = x1[2 * jj] * c2[0] - x2[2 * jj] * c2[1]; y2[2 * jj] = x2[2 * jj] * c2[0] + x1[2 * jj] * c2[1];
                y1[2 * jj + 1] = x1[2 * jj + 1] * c2[2] - x2[2 * jj + 1] * c2[3]; y2[2 * jj + 1] = x2[2 * jj + 1] * c2[2] + x1[2 * jj + 1] * c2[3]; }
            u32x4 w1, w2; w1.x = cvt_pk_bf16(y1[0], y1[1]); w1.y = cvt_pk_bf16(y1[2], y1[3]); w1.z = cvt_pk_bf16(y1[4], y1[5]); w1.w = cvt_pk_bf16(y1[6], y1[7]);
            w2.x = cvt_pk_bf16(y2[0], y2[1]); w2.y = cvt_pk_bf16(y2[2], y2[3]); w2.z = cvt_pk_bf16(y2[4], y2[5]); w2.w = cvt_pk_bf16(y2[6], y2[7]);
            qr[8 + p] = *reinterpret_cast<bf16x8*>(&w1); qr[10 + p] = *reinterpret_cast<bf16x8*>(&w2); }
    }
    float m_reg = -1e30f, l_reg = 0.f; f32x16 o[4] = {};
    f32x16 pA0, pA1, pB0, pB1; float alA = 1.f, alB = 1.f; bf16x8 pa0, pa1, pa2, pa3;
    const int NT = 4 * qb + 4; const int wp = wid >> 1;
    const bool a1 = wp >= 1, a2 = wp >= 2, a3 = wp >= 3;
#define MASK(P0, P1, act) do { if (!(act)) { _Pragma("unroll") for (int r = 0; r < 16; ++r) { P0[r] = -INFINITY; P1[r] = -INFINITY; } } } while (0)
#define INTERVAL(PN0, PN1, PO0, PO1, alN, alO, t, act, load) do { \
        if (load) DMA_KV((t) + 1, ((t) + 1) & 1, vnext); \
        SBAR(); if (act) qkt2(PN0, PN1, Krow + ((t) & 1) * K2_BYTES, koff, qr); MASK(PN0, PN1, act); \
        if (MODE == 2) { asm volatile("" : "+v"(PO0), "+v"(PO1)); pa0 = __builtin_bit_cast(bf16x8, (u32x4){__float_as_uint(PO0[0]), __float_as_uint(PO0[1]), __float_as_uint(PO0[2]), __float_as_uint(PO0[3])}); pa1 = pa0; pa2 = pa0; pa3 = pa0; } \
        else finishSM(PO0, PO1, alO, l_reg, pa0, pa1, pa2, pa3); \
        SBAR(); pv_d0(o, vb0 + vprev * SHM_V, pa0, pa1, pa2, pa3); if (MODE == 2) { asm volatile("" : "+v"(PN0), "+v"(PN1)); } else partialSM(PN0, PN1, m_reg, alN); \
        __syncthreads(); RESC(alN); \
        vprev = vcur; vcur = vnext; vnext = (vnext == 2) ? 0 : vnext + 1; } while (0)
    __syncthreads();
    int vprev = 0, vcur = 1, vnext = 2;
    DMA_KV(1, 1, 1);
    qkt2(pA0, pA1, Krow, koff, qr); partialSM(pA0, pA1, m_reg, alA);
    __syncthreads();
    for (int j = 1; j + 3 < NT; j += 2) {
        INTERVAL(pB0, pB1, pA0, pA1, alB, alA, j, true, true);
        INTERVAL(pA0, pA1, pB0, pB1, alA, alB, j + 1, true, true);
    }
    INTERVAL(pB0, pB1, pA0, pA1, alB, alA, NT - 3, a1, true);
    INTERVAL(pA0, pA1, pB0, pB1, alA, alB, NT - 2, a2, true);
    INTERVAL(pB0, pB1, pA0, pA1, alB, alA, NT - 1, a3, false);
    finishSM(pB0, pB1, alB, l_reg, pa0, pa1, pa2, pa3); SBAR();
    pv_d0(o, vb0 + vprev * SHM_V, pa0, pa1, pa2, pa3);
#undef INTERVAL
#undef MASK
    if (hi == 0) li_l[r32] = l_reg; asm volatile("s_waitcnt lgkmcnt(0)" ::: "memory");
    float rli[16];
#pragma unroll
    for (int r = 0; r < 16; ++r) rli[r] = __builtin_amdgcn_rcpf(li_l[crow(r, hi)]);
    __syncthreads();
    LAS bf16_t* stg = (LAS bf16_t*)(lds + wid * 8192);
#pragma unroll
    for (int r = 0; r < 16; ++r) { const int orow = crow(r, hi);
#pragma unroll
        for (int d0 = 0; d0 < 4; ++d0) stg[orow * 128 + d0 * 32 + r32] = f2bf(o[d0][r] * rli[r]); }
    asm volatile("s_waitcnt lgkmcnt(0)" ::: "memory");
    if (MODE == 0) {
        const int g = lane >> 4, ch = lane & 15, c = h * VH + ch * 8; const int t0 = qb * 256 + wid * QBLK;
        const size_t e0 = (size_t)(b * SEQ + t0) * DM + c;
        u32x4 uu[8], gv[8], sv[8];
#pragma unroll
        for (int i = 0; i < 8; ++i) { const size_t e = e0 + (size_t)(4 * i + g) * DM; uu[i] = *(const u32x4*)(T.u + e); gv[i] = __builtin_nontemporal_load((const u32x4*)(T.gb + e)); sv[i] = __builtin_nontemporal_load((const u32x4*)(T.sg + e)); }
        u32x4 uvirt = {0u, 0u, 0u, 0u};
        if (g >= 2 && t0 > 0) uvirt = *(const u32x4*)(T.u + e0 - (size_t)(4 - g) * DM);
        const f32x4 w0a = *(const f32x4*)(T.conv_w + c), w0b = *(const f32x4*)(T.conv_w + c + 4), w1a = *(const f32x4*)(T.conv_w + DM + c), w1b = *(const f32x4*)(T.conv_w + DM + c + 4),
              w2a = *(const f32x4*)(T.conv_w + 2 * DM + c), w2b = *(const f32x4*)(T.conv_w + 2 * DM + c + 4);
        const float cw0[8] = {w0a[0], w0a[1], w0a[2], w0a[3], w0b[0], w0b[1], w0b[2], w0b[3]}, cw1[8] = {w1a[0], w1a[1], w1a[2], w1a[3], w1b[0], w1b[1], w1b[2], w1b[3]},
                    cw2[8] = {w2a[0], w2a[1], w2a[2], w2a[3], w2b[0], w2b[1], w2b[2], w2b[3]};
        const int src1 = ((lane - 16) & 63) << 2, src2 = (lane ^ 32) << 2;
#pragma unroll
        for (int i = 0; i < 8; ++i) { const int row = i * 4 + g; const size_t e = e0 + (size_t)row * DM;
            const u32x4 ov = *(const LAS u32x4*)(stg + row * 128 + ch * 8);
            const u32x4 up = (i == 0) ? uvirt : uu[i > 0 ? i - 1 : 0];
            u32x4 u1, u2, res;
#pragma unroll
            for (int q = 0; q < 4; ++q) { const unsigned x1 = (g == 3) ? up[q] : uu[i][q], x2 = (g >= 2) ? up[q] : uu[i][q];
                u1[q] = (unsigned)__builtin_amdgcn_ds_bpermute(src1, (int)x1); u2[q] = (unsigned)__builtin_amdgcn_ds_bpermute(src2, (int)x2); }
#pragma unroll
            for (int q = 0; q < 4; ++q) {
                const float cl = cw0[2 * q] * bflo(u2[q]) + cw1[2 * q] * bflo(u1[q]) + cw2[2 * q] * bflo(uu[i][q]), chh = cw0[2 * q + 1] * bfhi(u2[q]) + cw1[2 * q + 1] * bfhi(u1[q]) + cw2[2 * q + 1] * bfhi(uu[i][q]);
                res[q] = cvt_pk_bf16(bflo(gv[i][q]) * cl + bflo(sv[i][q]) * bflo(ov[q]), bfhi(gv[i][q]) * chh + bfhi(sv[i][q]) * bfhi(ov[q])); }
            *(u32x4*)(T.merged + e) = res; }
    }
    asm volatile("s_waitcnt lgkmcnt(0)" ::: "memory");
    __syncthreads();
#undef DMA_KV
#undef RESC
}
template <int MODE> __device__ __forceinline__ void attn_unit3(const AttnArgs& T, int b, int h, int qb, LAS char* lds) {
    int tid = threadIdx.x; asm volatile("" : "+v"(tid));
    const int lane = tid & 63, r32 = lane & 31, hi = lane >> 5; const int wid = __builtin_amdgcn_readfirstlane(tid >> 6);
    LAS char* V_lds = lds + V2_OFF; LAS char* K_lds = lds + K2_OFF;
    LAS float* ws = (LAS float*)(lds + WS2_OFF) + wid * 64; LAS float* li_l = ws; LAS float* al_l = ws + 32;
    const int mrow = b * SEQ + qb * 256 + wid * QBLK + r32;
    const char* Kh = (const char*)(T.Kb + (size_t)(b * NH + h) * SEQ * QKH); const char* Vh = (const char*)(T.Vb + (size_t)(b * NH + h) * SEQ * VH);
#define DMA_KV(t, kbuf, vbuf) do { const char* kt = Kh + (size_t)(t) * K2_BYTES; const char* vt = Vh + (size_t)(t) * SHM_V; int ln = lane; asm volatile("" : "+v"(ln)); \
    _Pragma("unroll") for (int _i = 0; _i < 3; ++_i) { const int q = (wid * 3 + _i) * 64 + ln, r = q / 24, cp = q - r * 24, c = (cp & ~7) | ((cp & 7) ^ ((r >> 1) & 7)); \
        __builtin_amdgcn_global_load_lds((const unsigned*)(kt + (unsigned)(r * 384 + c * 16)), (LAS unsigned*)(K_lds + (kbuf) * K2_BYTES + (wid * 3 + _i) * 1024), 16, 0, 0); } \
    _Pragma("unroll") for (int _i = 0; _i < 2; ++_i) { const int q = (wid * 2 + _i) * 64 + ln, sub = q >> 5, w = q & 31, kk = ((sub >> 2) << 3) | (w >> 2), k = (kk & ~0xC) | ((kk & 4) << 1) | ((kk & 8) >> 1), c = ((sub & 3) << 5) | ((w & 3) << 3); \
        __builtin_amdgcn_global_load_lds((const unsigned*)(vt + (unsigned)(k * 256 + c * 2)), (LAS unsigned*)(V_lds + (vbuf) * SHM_V + (wid * 2 + _i) * 1024), 16, 0, 0); } } while (0)
#define RESC(a) do { if (__any((a) < 1.f)) { if (hi == 0) al_l[r32] = (a); asm volatile("s_waitcnt lgkmcnt(0)" ::: "memory"); \
    _Pragma("unroll") for (int d = 0; d < 4; ++d) _Pragma("unroll") for (int r = 0; r < 16; ++r) o[d][r] *= al_l[crow(r, hi)]; } } while (0)
    DMA_KV(0, 0, 0);
    const int vb0 = (int)(uintptr_t)V_lds + v_rd_base(lane);
    const LAS char* Krow = K_lds + r32 * (QKH * 2);
    int koff[4];
    { const int sw = (r32 >> 1) & 7;
#pragma unroll
      for (int j = 0; j < 4; ++j) koff[j] = ((2 * j + hi) ^ sw) * 16; }
    bf16x8 qr[12];
    {
        f32x16 X[6];
#pragma unroll
        for (int blk = 0; blk < 6; ++blk) X[blk] = f32x16{};
        const bf16_t* latq = T.lat + (size_t)mrow * LATW + hi * 8;
        const char* wq = (const char*)(T.wqn + (size_t)h * QKH * QL);
        LAS char* wbuf0 = lds + ATT2_LDS; LAS char* wbuf1 = lds + K2_OFF + K2_BYTES; LAS char* wbuf2 = lds + V2_OFF + SHM_V;
        const int sg_ = (r32 & ~0xC) | ((r32 & 4) << 1) | ((r32 & 8) >> 1);
        const int wsw = (sg_ >> 1) & 7;
        int woff[4];
#pragma unroll
        for (int j = 0; j < 4; ++j) woff[j] = sg_ * 128 + (((2 * j + hi) ^ wsw) << 4);
#define DMA_W(c, buf) do { int ln = lane; asm volatile("" : "+v"(ln)); \
    _Pragma("unroll") for (int _i = 0; _i < 3; ++_i) { const int q_ = (wid * 3 + _i) * 64 + ln, row_ = q_ >> 3, cp_ = q_ & 7, cc_ = cp_ ^ ((row_ >> 1) & 7); \
        __builtin_amdgcn_global_load_lds((const unsigned*)(wq + (size_t)row_ * (QL * 2) + (c) * 128 + cc_ * 16), (LAS unsigned*)((buf) + (wid * 3 + _i) * 1024), 16, 0, 0); } } while (0)
#define WBUF(c) (((c) % 3) == 0 ? wbuf0 : ((c) % 3) == 1 ? wbuf1 : wbuf2)
        DMA_W(0, wbuf0); DMA_W(1, wbuf1);
        bf16x8 lf[4];
#pragma unroll
        for (int s4 = 0; s4 < 4; ++s4) lf[s4] = *(const bf16x8*)(latq + 16 * s4);
        __syncthreads();
#pragma unroll
        for (int c = 0; c < 6; ++c) {
            LAS char* wb = WBUF(c);
            if (c < 4) DMA_W(c + 2, WBUF(c + 2));
            bf16x8 ln_[4];
            if (c < 5) {
#pragma unroll
                for (int s4 = 0; s4 < 4; ++s4) ln_[s4] = *(const bf16x8*)(latq + 64 * (c + 1) + 16 * s4); }
#pragma unroll
            for (int blk = 0; blk < 6; ++blk)
#pragma unroll
                for (int s4 = 0; s4 < 4; ++s4) { const bf16x8 wf = *(const LAS bf16x8*)(wb + blk * 4096 + woff[s4]);
                    X[blk] = __builtin_amdgcn_mfma_f32_32x32x16_bf16(wf, lf[s4], X[blk], 0, 0, 0); }
            if (c < 4) asm volatile("s_waitcnt vmcnt(7)" ::: "memory"); else asm volatile("s_waitcnt vmcnt(0)" ::: "memory");
            asm volatile("s_waitcnt lgkmcnt(0)" ::: "memory"); __builtin_amdgcn_s_barrier(); asm volatile("" ::: "memory");
            if (c < 5) {
#pragma unroll
                for (int s4 = 0; s4 < 4; ++s4) lf[s4] = ln_[s4]; }
        }
#undef WBUF
#undef DMA_W
        const f32x2 sq2 = *(const f32x2*)(T.ssp + (size_t)mrow * 4); const float ssq = sq2[0] + sq2[1];
        float ss = 0.f;
#pragma unroll
        for (int blk = 0; blk < 6; ++blk)
#pragma unroll
            for (int r = 0; r < 16; ++r) ss += X[blk][r] * X[blk][r];
        { auto rr = __builtin_amdgcn_permlane32_swap(__float_as_uint(ss), __float_as_uint(ss), false, false); ss = __uint_as_float(rr[0]) + __uint_as_float(rr[1]); }
        const float rq2 = 1.f / (ssq * (1.f / QL) + EPS);
        const float rn = 1.f / sqrtf(ss * rq2 * (1.f / QKH) + EPS) * sqrtf(rq2);
#pragma unroll
        for (int blk = 0; blk < 4; ++blk)
#pragma unroll
            for (int s = 0; s < 2; ++s) { const f32x4 g0 = *(const f32x4*)(T.q_g + 32 * blk + 16 * s + 8 * hi), g1 = *(const f32x4*)(T.q_g + 32 * blk + 16 * s + 8 * hi + 4);
                u32x4 w; w.x = cvt_pk_bf16(X[blk][8 * s + 0] * rn * g0[0], X[blk][8 * s + 1] * rn * g0[1]); w.y = cvt_pk_bf16(X[blk][8 * s + 2] * rn * g0[2], X[blk][8 * s + 3] * rn * g0[3]);
                w.z = cvt_pk_bf16(X[blk][8 * s + 4] * rn * g1[0], X[blk][8 * s + 5] * rn * g1[1]); w.w = cvt_pk_bf16(X[blk][8 * s + 6] * rn * g1[2], X[blk][8 * s + 7] * rn * g1[3]);
                qr[2 * blk + s] = *reinterpret_cast<bf16x8*>(&w); }
#pragma unroll
        for (int s = 0; s < 2; ++s) {
            const int ib = 16 * s + 8 * hi;
            const f32x4 ga = *(const f32x4*)(T.q_g + 128 + ib), gb_ = *(const f32x4*)(T.q_g + 128 + ib + 4), gc = *(const f32x4*)(T.q_g + 160 + ib), gd = *(const f32x4*)(T.q_g + 160 + ib + 4);
            const float g1v[8] = {ga[0], ga[1], ga[2], ga[3], gb_[0], gb_[1], gb_[2], gb_[3]}, g2v[8] = {gc[0], gc[1], gc[2], gc[3], gd[0], gd[1], gd[2], gd[3]};
            float y1[8], y2[8];
#pragma unroll
            for (int jj = 0; jj < 4; ++jj) { const f32x4 c2 = *(const f32x4*)((const float*)T.cs + ((size_t)mrow * 32 + ib + 2 * jj) * 2);
                const float xa = X[4][8 * s + 2 * jj] * rn * g1v[2 * jj], xb = X[5][8 * s + 2 * jj] * rn * g2v[2 * jj], xc = X[4][8 * s + 2 * jj + 1] * rn * g1v[2 * jj + 1], xd = X[5][8 * s + 2 * jj + 1] * rn * g2v[2 * jj + 1];
                y1[2 * jj] = xa * c2[0] - xb * c2[1]; y2[2 * jj] = xb * c2[0] + xa * c2[1];
                y1[2 * jj + 1] = xc * c2[2] - xd * c2[3]; y2[2 * jj + 1] = xd * c2[2] + xc * c2[3]; }
            u32x4 w1, w2; w1.x = cvt_pk_bf16(y1[0], y1[1]); w1.y = cvt_pk_bf16(y1[2], y1[3]); w1.z = cvt_pk_bf16(y1[4], y1[5]); w1.w = cvt_pk_bf16(y1[6], y1[7]);
            w2.x = cvt_pk_bf16(y2[0], y2[1]); w2.y = cvt_pk_bf16(y2[2], y2[3]); w2.z = cvt_pk_bf16(y2[4], y2[5]); w2.w = cvt_pk_bf16(y2[6], y2[7]);
            qr[8 + s] = *reinterpret_cast<bf16x8*>(&w1); qr[10 + s] = *reinterpret_cast<bf16x8*>(&w2); }
    }
    float m_reg = -1e30f, l_reg = 0.f; f32x16 o[4] = {};
    f32x16 pA0, pA1, pB0, pB1; float alA = 1.f, alB = 1.f; bf16x8 pa0, pa1, pa2, pa3;
    const int NT = 4 * qb + 4; const int wp = wid >> 1;
    const bool a1 = wp >= 1, a2 = wp >= 2, a3 = wp >= 3;
#define MASK(P0, P1, act) do { if (!(act)) { _Pragma("unroll") for (int r = 0; r < 16; ++r) { P0[r] = -INFINITY; P1[r] = -INFINITY; } } } while (0)
#define INTERVAL(PN0, PN1, PO0, PO1, alN, alO, t, act, load) do { \
        if (load) DMA_KV((t) + 1, ((t) + 1) & 1, vnext); \
        SBAR(); if (act) qkt2(PN0, PN1, Krow + ((t) & 1) * K2_BYTES, koff, qr); MASK(PN0, PN1, act); \
        if (MODE == 2) { asm volatile("" : "+v"(PO0), "+v"(PO1)); pa0 = __builtin_bit_cast(bf16x8, (u32x4){__float_as_uint(PO0[0]), __float_as_uint(PO0[1]), __float_as_uint(PO0[2]), __float_as_uint(PO0[3])}); pa1 = pa0; pa2 = pa0; pa3 = pa0; } \
        else finishSM(PO0, PO1, alO, l_reg, pa0, pa1, pa2, pa3); \
        SBAR(); pv_d0(o, vb0 + vprev * SHM_V, pa0, pa1, pa2, pa3); if (MODE == 2) { asm volatile("" : "+v"(PN0), "+v"(PN1)); } else partialSM(PN0, PN1, m_reg, alN); \
        __syncthreads(); RESC(alN); \
        vprev = vcur; vcur = vnext; vnext = (vnext == 2) ? 0 : vnext + 1; } while (0)
    __syncthreads();
    int vprev = 0, vcur = 1, vnext = 2;
    DMA_KV(1, 1, 1);
    qkt2(pA0, pA1, Krow, koff, qr); partialSM(pA0, pA1, m_reg, alA);
    __syncthreads();
    for (int j = 1; j + 3 < NT; j += 2) {
        INTERVAL(pB0, pB1, pA0, pA1, alB, alA, j, true, true);
        INTERVAL(pA0, pA1, pB0, pB1, alA, alB, j + 1, true, true);
    }
    INTERVAL(pB0, pB1, pA0, pA1, alB, alA, NT - 3, a1, true);
    INTERVAL(pA0, pA1, pB0, pB1, alA, alB, NT - 2, a2, true);
    INTERVAL(pB0, pB1, pA0, pA1, alB, alA, NT - 1, a3, false);
    finishSM(pB0, pB1, alB, l_reg, pa0, pa1, pa2, pa3); SBAR();
    pv_d0(o, vb0 + vprev * SHM_V, pa0, pa1, pa2, pa3);
#undef INTERVAL
#undef MASK
    if (hi == 0) li_l[r32] = l_reg; asm volatile("s_waitcnt lgkmcnt(0)" ::: "memory");
    float rli[16];
#pragma unroll
    for (int r = 0; r < 16; ++r) rli[r] = __builtin_amdgcn_rcpf(li_l[crow(r, hi)]);
    __syncthreads();
    LAS bf16_t* stg = (LAS bf16_t*)(lds + wid * 8192);
#pragma unroll
    for (int r = 0; r < 16; ++r) { const int orow = crow(r, hi);
#pragma unroll
        for (int d0 = 0; d0 < 4; ++d0) stg[orow * 128 + d0 * 32 + r32] = f2bf(o[d0][r] * rli[r]); }
    asm volatile("s_waitcnt lgkmcnt(0)" ::: "memory");
    if (MODE == 0) {
        const int g = lane >> 4, ch = lane & 15, c = h * VH + ch * 8; const int t0 = qb * 256 + wid * QBLK;
        const size_t e0 = (size_t)(b * SEQ + t0) * DM + c;
        u32x4 uu[8], gv[8], sv[8];
#pragma unroll
        for (int i = 0; i < 8; ++i) { const size_t e = e0 + (size_t)(4 * i + g) * DM; uu[i] = *(const u32x4*)(T.u + e); gv[i] = __builtin_nontemporal_load((const u32x4*)(T.gb + e)); sv[i] = __builtin_nontemporal_load((const u32x4*)(T.sg + e)); }
        u32x4 uvirt = {0u, 0u, 0u, 0u};
        if (g >= 2 && t0 > 0) uvirt = *(const u32x4*)(T.u + e0 - (size_t)(4 - g) * DM);
        const f32x4 w0a = *(const f32x4*)(T.conv_w + c), w0b = *(const f32x4*)(T.conv_w + c + 4), w1a = *(const f32x4*)(T.conv_w + DM + c), w1b = *(const f32x4*)(T.conv_w + DM + c + 4),
              w2a = *(const f32x4*)(T.conv_w + 2 * DM + c), w2b = *(const f32x4*)(T.conv_w + 2 * DM + c + 4);
        const float cw0[8] = {w0a[0], w0a[1], w0a[2], w0a[3], w0b[0], w0b[1], w0b[2], w0b[3]}, cw1[8] = {w1a[0], w1a[1], w1a[2], w1a[3], w1b[0], w1b[1], w1b[2], w1b[3]},
                    cw2[8] = {w2a[0], w2a[1], w2a[2], w2a[3], w2b[0], w2b[1], w2b[2], w2b[3]};
        const int src1 = ((lane - 16) & 63) << 2, src2 = (lane ^ 32) << 2;
#pragma unroll
        for (int i = 0; i < 8; ++i) { const int row = i * 4 + g; const size_t e = e0 + (size_t)row * DM;
            const u32x4 ov = *(const LAS u32x4*)(stg + row * 128 + ch * 8);
            const u32x4 up = (i == 0) ? uvirt : uu[i > 0 ? i - 1 : 0];
            u32x4 u1, u2, res;
#pragma unroll
            for (int q = 0; q < 4; ++q) { const unsigned x1 = (g == 3) ? up[q] : uu[i][q], x2 = (g >= 2) ? up[q] : uu[i][q];
                u1[q] = (unsigned)__builtin_amdgcn_ds_bpermute(src1, (int)x1); u2[q] = (unsigned)__builtin_amdgcn_ds_bpermute(src2, (int)x2); }
#pragma unroll
            for (int q = 0; q < 4; ++q) {
                const float cl = cw0[2 * q] * bflo(u2[q]) + cw1[2 * q] * bflo(u1[q]) + cw2[2 * q] * bflo(uu[i][q]), chh = cw0[2 * q + 1] * bfhi(u2[q]) + cw1[2 * q + 1] * bfhi(u1[q]) + cw2[2 * q + 1] * bfhi(uu[i][q]);
                res[q] = cvt_pk_bf16(bflo(gv[i][q]) * cl + bflo(sv[i][q]) * bflo(ov[q]), bfhi(gv[i][q]) * chh + bfhi(sv[i][q]) * bfhi(ov[q])); }
            *(u32x4*)(T.merged + e) = res; }
    }
    asm volatile("s_waitcnt lgkmcnt(0)" ::: "memory");
    __syncthreads();
#undef DMA_KV
#undef RESC
}
#undef SBAR
}
#ifndef ATTN_UNIT
#define ATTN_UNIT attn_unit3
#endif
struct Frame {
    LAS unsigned char* lds; volatile LAS unsigned* MISC; unsigned* ctl;
    int tid, lane, wave, vcu, G;
};
__device__ __forceinline__ float wave_sum(float v) {
#pragma unroll
    for (int o = 1; o < 64; o <<= 1) v += __shfl_xor(v, o);
    return v;
}
__device__ __forceinline__ int tcc(int bj, int ch128) { return (bj << 7) | (ch128 & 0x60) | (((ch128 >> 2) & 1) << 4) | (((ch128 >> 3) & 3) << 2) | (ch128 & 3); }
struct MapIn { __device__ __forceinline__ int operator()(int c) const {
    if (c < C_ZB) return 256 * (c >> 7) + tcc(0, c & 127);
    if (c < C_ZC) { const int ch = c - C_ZB; return 256 * (8 + (ch >> 7)) + tcc(0, ch & 127); }
    if (c < C_QL) { const int ch = c - C_ZC; return 256 * (ch >> 7) + tcc(1, ch & 127); }
    if (c < C_KVL) { const int j = c - C_QL; return j < 256 ? 256 * 20 + permL(j) : 256 * 21 + permL(j - 256); }
    if (c < C_KR) return 256 * 22 + permL(c - C_KVL);
    if (c < C_GC) { const int j = c - C_KR, jj = j & 31; return 256 * 21 + 128 + ((jj >> 4) << 5) + ((j >> 5) << 4) + (((jj >> 2) & 3) << 2) + (jj & 3); }
    if (c < C_GM) { const int ch = c - C_GC; return 256 * (8 + (ch >> 7)) + tcc(1, ch & 127); }
    { const int j = c - C_GM; return 256 * (16 + (j >> 8)) + permL(j & 255); } } };
struct MapPerm { __device__ __forceinline__ int operator()(int c) const { return (c & ~255) | permL(c & 255); } };
struct MapId { __device__ __forceinline__ int operator()(int c) const { return c; } };
struct MapGU { int n; __device__ __forceinline__ int operator()(int f) const { const int r = f & 127; return 256 * (f >> 7) + ((((r >> 2) & 1) << 7) | ((r >> 5) << 5) | (n << 4) | (((r >> 3) & 3) << 2) | (r & 3)); } };

template <class RowMap>
__device__ __forceinline__ void transpose_item(const float* W, int N, bf16_t* WT, int ldt, const float* kscale, LAS float* scr, int item, int lane, const RowMap& rm) {
    const int nblk = N / 32, kb = item / nblk, nb = item % nblk, k0 = 64 * kb, n0 = 32 * nb;
    float wv[32];
#pragma unroll
    for (int i = 0; i < 32; ++i) wv[i] = __builtin_nontemporal_load(W + (size_t)(k0 + 2 * i + (lane >> 5)) * N + n0 + (lane & 31));
#pragma unroll
    for (int i = 0; i < 32; ++i) { const int kk = 2 * i + (lane >> 5); const float sc = kscale ? kscale[k0 + kk] : 1.f; scr[kk * 33 + (lane & 31)] = wv[i] * sc; }
    asm volatile("s_waitcnt lgkmcnt(0)" ::: "memory");
    const int c = lane & 7;
#pragma unroll
    for (int j = 0; j < 4; ++j) { const int n = (lane >> 3) + 8 * j; const LAS float* s = scr + (8 * c) * 33 + n;
        u32x4 o; o.x = cvt_pk_bf16(s[0 * 33], s[1 * 33]); o.y = cvt_pk_bf16(s[2 * 33], s[3 * 33]); o.z = cvt_pk_bf16(s[4 * 33], s[5 * 33]); o.w = cvt_pk_bf16(s[6 * 33], s[7 * 33]);
        *(u32x4*)(WT + (size_t)rm(n0 + n) * ldt + k0 + 8 * c) = o; }
    asm volatile("s_waitcnt lgkmcnt(0)" ::: "memory");
}
constexpr size_t WS_WIN = WS_WSMALL, WS_WQ = WS_WIN + (size_t)5888 * 1024 * 2, WS_WKV = WS_WQ + (size_t)1536 * 384 * 2, WS_WO = WS_WKV + (size_t)2048 * 256 * 2;
static_assert(WS_WO + (size_t)1024 * 1024 * 2 <= WS_A, "small weights fit below region A");
constexpr size_t WS_EGU = WS_C, WS_EDN = WS_C + (size_t)NEXP * 512 * 1024 * 2;
static_assert(WS_EDN + (size_t)NEXP * 1024 * 256 * 2 <= WS_D, "expert weights fit region C");

__device__ __forceinline__ void p0_weights_tables(const Ptrs& P, Frame& F) {
    LAS float* scr = (LAS float*)(F.lds + RING_OFF + F.wave * 16384);
    const int gw = F.vcu * NWAVES + F.wave, NGW = F.G * NWAVES;
    constexpr int I_IN = (DM / 64) * (DIN / 32), I_Q = (QL / 64) * (1536 / 32), I_KV = (KVL / 64) * (2048 / 32), I_O = (DM / 64) * (DM / 32);
    for (int it = gw; it < I_IN + I_Q + I_KV + I_O; it += NGW) {
        int r = it;
        if (r < I_IN) { transpose_item(P.w_in, DIN, (bf16_t*)(P.ws + WS_WIN), DM, (const float*)nullptr, scr, r, F.lane, MapIn{}); continue; } r -= I_IN;
        if (r < I_Q) { transpose_item(P.w_q_b, 1536, (bf16_t*)(P.ws + WS_WQ), QL, P.q_a_g, scr, r, F.lane, MapId{}); continue; } r -= I_Q;
        if (r < I_KV) { transpose_item(P.w_kv_b, 2048, (bf16_t*)(P.ws + WS_WKV), KVL, P.kv_a_g, scr, r, F.lane, MapPerm{}); continue; } r -= I_KV;
        transpose_item(P.w_o, DM, (bf16_t*)(P.ws + WS_WO), DM, (const float*)nullptr, scr, r, F.lane, MapPerm{});
    }
    {
        const int gt = F.vcu * 512 + F.tid;
        if (gt < 64 * 128) { const int rr = 192 + (gt >> 7), ch = gt & 127; *(u32x4*)((bf16_t*)(P.ws + WS_WIN) + (size_t)(256 * 21 + rr) * DM + ch * 8) = (u32x4){0u, 0u, 0u, 0u}; } }
    {
        float2* cs = (float2*)(P.ws + WS_CS);
        for (int idx = F.vcu * 512 + F.tid; idx < M * 32; idx += F.G * 512) { const int m = idx >> 5, i = idx & 31;
            const double inv = exp2(-(double)(2 * i) * (13.287712379549449 / 64.0));
            const double ang = (double)P.pos[m] * inv; float2 v; v.x = (float)cos(ang); v.y = (float)sin(ang); cs[idx] = v; } }
    asm volatile("s_waitcnt vmcnt(0) lgkmcnt(0)" ::: "memory"); __syncthreads();
}
__device__ __forceinline__ void p0_mod(const Ptrs& P, Frame& F) {
    if (F.vcu < 192) {
        LAS float* cact = (LAS float*)(F.lds + RING_OFF); LAS float* red = (LAS float*)(F.lds + RING_OFF + 65536);
        for (int idx = F.tid; idx < BATCH * DM; idx += 512) { const float cv = P.c[idx]; cact[idx] = cv / (1.f + __expf(-cv)); }
        __syncthreads();
        const int n0 = 32 * F.vcu, kl = F.lane >> 3, c4 = F.lane & 7;
        f32x4 acc[16];
#pragma unroll
        for (int b = 0; b < 16; ++b) acc[b] = (f32x4){0.f, 0.f, 0.f, 0.f};
        for (int it = 0; it < 16; ++it) { const int k = 128 * F.wave + 8 * it + kl;
            const f32x4 wv = __builtin_nontemporal_load((const f32x4*)(P.w_ada + (size_t)k * 6144 + n0 + 4 * c4));
#pragma unroll
            for (int b = 0; b < 16; ++b) acc[b] += cact[b * DM + k] * wv; }
#pragma unroll
        for (int b = 0; b < 16; ++b)
#pragma unroll
            for (int e = 0; e < 4; ++e) { float v = acc[b][e]; v += __shfl_xor(v, 8); v += __shfl_xor(v, 16); v += __shfl_xor(v, 32); if (kl == 0) red[(F.wave * 16 + b) * 32 + 4 * c4 + e] = v; }
        __syncthreads();
        { const int b = F.tid >> 5, cc = F.tid & 31; float s = P.b_ada[n0 + cc];
#pragma unroll
          for (int w = 0; w < 8; ++w) s += red[(w * 16 + b) * 32 + cc];
          ((float*)(P.ws + WS_MOD))[b * 6144 + n0 + cc] = s; }
        __syncthreads();
    }
}
__device__ __forceinline__ void expert_weight_items(const Ptrs& P, Frame& F, int w, int nw, int k_lo, int k_hi) {
    LAS float* scr = (LAS float*)(F.lds + RING_OFF + F.wave * 16384);
    constexpr int I_G = (DM / 64) * (DEXP / 32), I_D = (DEXP / 64) * (DM / 32);
    for (int k = k_lo; k < k_hi; ++k) { const int it = w + k * nw; if (it >= NEXP * (2 * I_G + I_D)) break;
        const int e = it / (2 * I_G + I_D); int r = it % (2 * I_G + I_D);
        bf16_t* gu = (bf16_t*)(P.ws + WS_EGU) + (size_t)e * 512 * DM; bf16_t* dn = (bf16_t*)(P.ws + WS_EDN) + (size_t)e * DM * DEXP;
        if (r < I_G) { transpose_item(P.w_gate + (size_t)e * DM * DEXP, DEXP, gu, DM, (const float*)nullptr, scr, r, F.lane, MapGU{0}); continue; } r -= I_G;
        if (r < I_G) { transpose_item(P.w_up + (size_t)e * DM * DEXP, DEXP, gu, DM, (const float*)nullptr, scr, r, F.lane, MapGU{1}); continue; } r -= I_G;
        transpose_item(P.w_down + (size_t)e * DEXP * DM, DM, dn, DEXP, (const float*)nullptr, scr, r, F.lane, MapPerm{});
    }
}
__device__ __forceinline__ void p1_norm1(const Ptrs& P, Frame& F) {
    const int gw = F.vcu * NWAVES + F.wave, NGW = F.G * NWAVES;
    bf16_t* h = (bf16_t*)(P.ws + WS_A);
    for (int m0 = gw; m0 < M; m0 += 4 * NGW) {
        f32x4 v[4][4]; float s[4];
#pragma unroll
        for (int r = 0; r < 4; ++r) { const int mr = (m0 + r * NGW < M) ? m0 + r * NGW : m0; const f32x4* xr = (const f32x4*)(P.x + (size_t)mr * DM) + F.lane;
#pragma unroll
            for (int j = 0; j < 4; ++j) v[r][j] = __builtin_nontemporal_load(xr + 64 * j); }
#pragma unroll
        for (int r = 0; r < 4; ++r) { float a = 0.f;
#pragma unroll
            for (int j = 0; j < 4; ++j) a += (v[r][j][0] * v[r][j][0] + v[r][j][1] * v[r][j][1]) + (v[r][j][2] * v[r][j][2] + v[r][j][3] * v[r][j][3]);
            s[r] = 1.f / sqrtf(wave_sum(a) * (1.f / DM) + EPS); }
#pragma unroll
        for (int r = 0; r < 4; ++r) { const int m = m0 + r * NGW; if (m >= M) continue; const float* mod = (const float*)(P.ws + WS_MOD) + (m / SEQ) * 6144;
            unsigned long long* o8 = (unsigned long long*)(h + (size_t)m * DM) + F.lane;
#pragma unroll
            for (int j = 0; j < 4; ++j) { const int d = 4 * F.lane + 256 * j;
                const f32x4 g = *(const f32x4*)(P.norm1_g + d), sc = *(const f32x4*)(mod + 1024 + d), sh = *(const f32x4*)(mod + d);
                const f32x4 rr = v[r][j] * s[r] * g * (sc + 1.f) + sh;
                o8[64 * j] = (unsigned long long)cvt_pk_bf16(rr[0], rr[1]) | ((unsigned long long)cvt_pk_bf16(rr[2], rr[3]) << 32); } }
    }
}

constexpr size_t WS_WR = 30 * MiB;
constexpr size_t WS_STOK = WS_RT + 512 * 1024, WS_SW = WS_STOK + 320 * 1024;
constexpr int MAXROWS = 81920, MAXTILES = 320;
constexpr size_t WS_H2 = WS_B, WS_HACT = WS_B + 64 * MiB;
constexpr size_t WS_X1B = WS_B + 128 * MiB;
constexpr size_t WS_DELTA = WS_D, WS_Y0 = WS_A, WS_Y1 = WS_D + 64 * MiB;
constexpr int CW_T = CW_TILES, CW_T0 = CW_TILES + 1, CW_TGRP = CW_TILES + 64;

__device__ __forceinline__ void p0_router_weights(const Ptrs& P, Frame& F) {
    bf16_t* hi = (bf16_t*)(P.ws + WS_WR); bf16_t* lo = hi + 48 * DM;
    for (int idx = F.vcu * 512 + F.tid; idx < 48 * DM; idx += F.G * 512) { const int o = idx >> 10, k = idx & 1023;
        const float v = o < 4 ? P.w_rg[k * 4 + o] : (o < 36 ? P.w_re[k * 32 + o - 4] : 0.f);
        const bf16_t h = f2bf(v); hi[idx] = h; lo[idx] = f2bf(v - bf2f(h)); }
}
template <int MODE> __device__ __forceinline__ void p6_rows(const Ptrs& P, Frame& F) {
    LAS unsigned char* tile = F.lds + RING_OFF + F.wave * 8192;
    LAS float* lg = (LAS float*)(F.lds + RING_OFF + 65536 + F.wave * 1536);
    LAS unsigned char* wch = F.lds + RING_OFF + 77824;
    LAS float* gms = (LAS float*)(F.lds + XCH_OFF);
    LAS unsigned* hist = (LAS unsigned*)(F.lds + LDSCTL_OFF + 1024);
    const bf16_t* WrHi = (const bf16_t*)(P.ws + WS_WR); const bf16_t* WrLo = WrHi + 48 * DM;
    bf16_t* h2 = (bf16_t*)(P.ws + WS_H2); const bf16_t* dl = (const bf16_t*)(P.ws + WS_DELTA); bf16_t* x1b = (bf16_t*)(P.ws + WS_X1B);
    int2* rte = (int2*)(P.ws + WS_RT); float2* rtw = (float2*)(P.ws + WS_RT + 256 * 1024);
    const int t = F.lane & 15, q = F.lane >> 4;
    u32x4 wreg[6];
#pragma unroll
    for (int j = 0; j < 6; ++j) { const int id = F.tid + 512 * j, arr = id / 1536, rem = id - arr * 1536, row = rem >> 5, ch = rem & 31; wreg[j] = *(const u32x4*)((arr ? WrLo : WrHi) + (size_t)row * DM + 8 * ch); }
    for (int rb = F.vcu; rb < M / 128; rb += F.G) {
        const int m0 = rb * 128 + F.wave * 16, b = m0 / SEQ;
        const float* mod = (const float*)(P.ws + WS_MOD) + b * 6144;
        __syncthreads();
        if (F.tid < 64) hist[F.tid] = 0u;
        for (int k = F.tid; k < DM; k += 512) { gms[k] = P.norm2_g[k] * (1.f + mod[4096 + k]); gms[DM + k] = mod[3072 + k]; }
        __syncthreads();
#pragma unroll 1
        for (int hb = 0; hb < 2; ++hb) {
            const int mb = m0 + 8 * hb;
            f32x4 xv[8][4]; float rstd[8];
#pragma unroll
            for (int r = 0; r < 8; ++r) { const f32x4* xr = (const f32x4*)(P.x + (size_t)(mb + r) * DM) + F.lane; const u32x2* dr = (const u32x2*)(dl + (size_t)(mb + r) * DM) + F.lane;
#pragma unroll
                for (int c = 0; c < 4; ++c) { const f32x4 x4 = __builtin_nontemporal_load(xr + 64 * c); const u32x2 d = __builtin_nontemporal_load(dr + 64 * c);
                    xv[r][c][0] = x4[0] + __uint_as_float(d.x << 16); xv[r][c][1] = x4[1] + __uint_as_float(d.x & 0xffff0000u); xv[r][c][2] = x4[2] + __uint_as_float(d.y << 16); xv[r][c][3] = x4[3] + __uint_as_float(d.y & 0xffff0000u); } }
#pragma unroll
            for (int r = 0; r < 8; ++r) { float s = 0.f;
#pragma unroll
                for (int c = 0; c < 4; ++c) s += (xv[r][c][0] * xv[r][c][0] + xv[r][c][1] * xv[r][c][1]) + (xv[r][c][2] * xv[r][c][2] + xv[r][c][3] * xv[r][c][3]);
                rstd[r] = 1.f / sqrtf(wave_sum(s) * (1.f / DM) + EPS); }
            f32x4 acc[3];
#pragma unroll
            for (int cb = 0; cb < 3; ++cb) acc[cb] = (f32x4){0.f, 0.f, 0.f, 0.f};
#pragma unroll
            for (int c = 0; c < 4; ++c) {
                const int k0 = 256 * c + 4 * F.lane;
                __syncthreads();
#pragma unroll
                for (int j = 0; j < 6; ++j) { const int id = F.tid + 512 * j, arr = id / 1536, rem = id - arr * 1536, row = rem >> 5, ch = rem & 31;
                    *(LAS u32x4*)(wch + arr * 24576 + row * 512 + ((ch ^ (row & 15)) << 4)) = wreg[j]; }
#pragma unroll
                for (int j = 0; j < 6; ++j) { const int id = F.tid + 512 * j, arr = id / 1536, rem = id - arr * 1536, row = rem >> 5, ch = rem & 31;
                    wreg[j] = *(const u32x4*)((arr ? WrLo : WrHi) + (size_t)row * DM + 256 * ((c + 1) & 3) + 8 * ch); }
                const f32x4 gm = *(const LAS f32x4*)(gms + k0), sh = *(const LAS f32x4*)(gms + DM + k0);
#pragma unroll
                for (int r = 0; r < 8; ++r) { const f32x4 h = xv[r][c] * rstd[r] * gm + sh;
                    u32x2 hi; hi.x = cvt_pk_bf16(h[0], h[1]); hi.y = cvt_pk_bf16(h[2], h[3]);
                    u32x2 lo; lo.x = cvt_pk_bf16(h[0] - __uint_as_float(hi.x << 16), h[1] - __uint_as_float(hi.x & 0xffff0000u)); lo.y = cvt_pk_bf16(h[2] - __uint_as_float(hi.y << 16), h[3] - __uint_as_float(hi.y & 0xffff0000u));
                    *(u32x2*)(h2 + (size_t)(mb + r) * DM + k0) = hi;
                    const int off = r * 512 + ((((F.lane >> 1) ^ r) & 31) << 4) + ((F.lane & 1) << 3);
                    *(LAS u32x2*)(tile + off) = hi; *(LAS u32x2*)(tile + 4096 + off) = lo; }
                asm volatile("s_waitcnt lgkmcnt(0)" ::: "memory");
                __syncthreads();
#pragma unroll 2
                for (int ks = 0; ks < (MODE == 1 ? 0 : 8); ++ks) { const int tr = t & 7;
                    const int off = tr * 512 + ((((4 * ks + q) ^ tr) & 31) << 4);
                    const bf16x8 bh = *(const LAS bf16x8*)(tile + off), bl = *(const LAS bf16x8*)(tile + 4096 + off);
#pragma unroll
                    for (int cb = 0; cb < 3; ++cb) { const int woff = (16 * cb + t) * 512 + ((((4 * ks + q) ^ t) & 31) << 4);
                        const bf16x8 wh = *(const LAS bf16x8*)(wch + woff), wl = *(const LAS bf16x8*)(wch + 24576 + woff);
                        acc[cb] = __builtin_amdgcn_mfma_f32_16x16x32_bf16(wh, bh, acc[cb], 0, 0, 0);
                        acc[cb] = __builtin_amdgcn_mfma_f32_16x16x32_bf16(wh, bl, acc[cb], 0, 0, 0);
                        acc[cb] = __builtin_amdgcn_mfma_f32_16x16x32_bf16(wl, bh, acc[cb], 0, 0, 0); } }
                asm volatile("s_waitcnt lgkmcnt(0)" ::: "memory");
            }
            if (t < 8) {
#pragma unroll
                for (int cb = 0; cb < 3; ++cb)
#pragma unroll
                    for (int r = 0; r < 4; ++r) lg[t * 48 + 16 * cb + 4 * q + r] = acc[cb][r]; }
            asm volatile("s_waitcnt lgkmcnt(0)" ::: "memory");
            if (MODE != 1 && q == 0 && t < 8) {
                const int m = mb + t;
                const LAS float* l = lg + t * 48;
                float gl[4];
#pragma unroll
                for (int i = 0; i < 4; ++i) gl[i] = l[i] + P.b_rg[i];
                int g = 0; float gmx = gl[0];
#pragma unroll
                for (int i = 1; i < 4; ++i) if (gl[i] > gmx) { gmx = gl[i]; g = i; }
                float se = 0.f;
#pragma unroll
                for (int i = 0; i < 4; ++i) se += __expf(gl[i] - gmx);
                const float pg = 1.f / se;
                float e0v = -3.0e38f, e1v = -3.0e38f; int i0 = 0, i1 = 0;
#pragma unroll
                for (int i = 0; i < 8; ++i) { const float v = l[4 + g * 8 + i] + P.b_re[g * 8 + i];
                    if (v > e0v) { e1v = e0v; i1 = i0; e0v = v; i0 = i; } else if (v > e1v) { e1v = v; i1 = i; } }
                const float p1 = __expf(e1v - e0v), w0 = 1.f / (1.f + p1), w1 = p1 * w0;
                int2 e; e.x = g * 8 + i0; e.y = g * 8 + i1; float2 w; w.x = w0 * pg; w.y = w1 * pg;
                rte[m] = e; rtw[m] = w;
                __hip_atomic_fetch_add(&hist[e.x], 1u, __ATOMIC_RELAXED, __HIP_MEMORY_SCOPE_WORKGROUP); __hip_atomic_fetch_add(&hist[32 + e.y], 1u, __ATOMIC_RELAXED, __HIP_MEMORY_SCOPE_WORKGROUP);
            }
            asm volatile("s_waitcnt lgkmcnt(0)" ::: "memory");
        }
        __syncthreads();
        if (MODE != 1 && F.tid < 64) F.ctl[CW_HIST + rb * 64 + F.tid] = hist[F.tid];
    }
    __syncthreads();
}
__device__ __forceinline__ void p7_sort(const Ptrs& P, Frame& F) {
    LAS unsigned* tot = (LAS unsigned*)(F.lds + RING_OFF);
    LAS unsigned* pre = tot + 64;
    LAS unsigned* rbase = pre + 64;
    LAS unsigned* cnt = rbase + 64;
    LAS unsigned* misc = cnt + 64;
    int* stok = (int*)(P.ws + WS_STOK); float* sw = (float*)(P.ws + WS_SW);
    const int2* rte = (const int2*)(P.ws + WS_RT); const float2* rtw = (const float2*)(P.ws + WS_RT + 256 * 1024);
    const int cw = F.vcu * 7 + F.wave - 1, cnw = F.G * 7; bool first = true;
    for (int rb = F.vcu; rb < M / 128; rb += F.G) {
        __syncthreads();
        {
            LAS unsigned* ptot = misc + 8; LAS unsigned* ppre = ptot + 512;
            const int g = F.tid & 63, pt = F.tid >> 6; unsigned hv[32];
#pragma unroll
            for (int k = 0; k < 32; ++k) hv[k] = F.ctl[CW_HIST + (32 * pt + k) * 64 + g];
            unsigned s = 0u, p = 0u;
#pragma unroll
            for (int k = 0; k < 32; ++k) { if (32 * pt + k == rb) p = s; s += hv[k]; }
            if (rb >= 32 * pt + 32) p = s;
            ptot[pt * 64 + g] = s; ppre[pt * 64 + g] = p;
        }
        __syncthreads();
        if (F.tid < 64) { unsigned s = 0u, p = 0u;
#pragma unroll
            for (int pt = 0; pt < 8; ++pt) { s += misc[8 + pt * 64 + F.tid]; p += misc[8 + 512 + pt * 64 + F.tid]; }
            tot[F.tid] = s; pre[F.tid] = p; cnt[F.tid] = 0u; }
        if (first && F.wave > 0) expert_weight_items(P, F, cw, cnw, 0, 2);
        __syncthreads();
        if (first && F.wave > 0) expert_weight_items(P, F, cw, cnw, 2, 4);
        if (F.tid == 0) { unsigned tb = 0u;
            for (int g = 0; g < 64; ++g) { if (g == 32) misc[1] = tb; rbase[g] = tb * 256u; const unsigned nt = (tot[g] + 255u) >> 8;
                if (rb == 0) for (unsigned k = 0; k < nt; ++k) F.ctl[CW_TGRP + tb + k] = (unsigned)g;
                tb += nt; }
            misc[0] = tb; if (rb == 0) { F.ctl[CW_T] = tb; F.ctl[CW_T0] = misc[1]; } }
        __syncthreads();
        if (F.wave == 0) {
            const unsigned long long ltmask = (1ull << F.lane) - 1ull;
            for (int ch = 0; ch < 2; ++ch) { const int m = rb * 128 + ch * 64 + F.lane; const int2 e = rte[m]; const float2 w = rtw[m];
                for (int j = 0; j < 2; ++j) { const int ex = j ? e.y : e.x; const float wj = j ? w.y : w.x; unsigned rank = 0u, gsz = 0u;
                    for (int x = 0; x < 32; ++x) { const unsigned long long mk = __ballot(ex == x); if (ex == x) { rank = (unsigned)__popcll(mk & ltmask); gsz = (unsigned)__popcll(mk); } }
                    const int g = j * 32 + ex; const unsigned pos = rbase[g] + pre[g] + cnt[g] + rank;
                    stok[pos] = m; sw[pos] = wj;
                    asm volatile("s_waitcnt lgkmcnt(0)" ::: "memory");
                    if (rank == 0u) cnt[g] += gsz;
                    asm volatile("s_waitcnt lgkmcnt(0)" ::: "memory"); } } }
        if (rb < 64) { const unsigned n = tot[rb], padn = (((n + 255u) >> 8) << 8) - n;
            if ((unsigned)F.tid < padn) { stok[rbase[rb] + n + F.tid] = -1; sw[rbase[rb] + n + F.tid] = 0.f; } }
        if (first && F.wave > 0) expert_weight_items(P, F, cw, cnw, 4, 1 << 20);
        first = false;
    }
}
struct MoeSched {
    const bf16_t* A; const bf16_t* W; int lda, ldb; const int* stok; const unsigned* tgrp; int t_lo, nun, npn, G, c; size_t wstride; bool gather, split;
    __device__ bool next(int i, Unit& u) const {
        const int idx = i * G + c, nfull = (nun / G) * G, tail = nun - nfull; int U; u.half = 0;
        if (split && tail > 0 && 2 * tail <= G) { if (idx >= nfull + 2 * tail) return false; if (idx < nfull) U = idx; else { U = nfull + ((idx - nfull) >> 1); u.half = 1 + ((idx - nfull) & 1); } }
        else { if (idx >= nun) return false; U = idx; }
        u.aux = t_lo + U / npn; u.pn = U % npn; u.pm = (int)tgrp[u.aux]; return true; }
    __device__ __forceinline__ const char* abase(const Unit& u) const { return gather ? (const char*)A : (const char*)A + (size_t)(u.aux * BM + (u.half == 2 ? HALF : 0)) * lda * 2; }
    __device__ __forceinline__ const char* bbase(const Unit& u) const { return (const char*)W + (size_t)(u.pm & 31) * wstride + (size_t)u.pn * BM * ldb * 2; }
    __device__ __forceinline__ void avoff(const Unit& u, int R0, int C0, int R1, int C1, unsigned (&v0)[2], unsigned (&v1)[2]) const {
        if (gather) { const int* tk = stok + u.aux * BM + (u.half == 2 ? HALF : 0); const int o1 = u.half ? 0 : HALF; int a = tk[R0], b = tk[R1], c2 = tk[o1 + R0], d = tk[o1 + R1];
            a = a < 0 ? 0 : a; b = b < 0 ? 0 : b; c2 = c2 < 0 ? 0 : c2; d = d < 0 ? 0 : d;
            v0[0] = (unsigned)(a * lda + C0) * 2u; v0[1] = (unsigned)(b * lda + C1) * 2u; v1[0] = (unsigned)(c2 * lda + C0) * 2u; v1[1] = (unsigned)(d * lda + C1) * 2u; }
        else { v0[0] = (unsigned)(R0 * lda + C0) * 2u; v0[1] = (unsigned)(R1 * lda + C1) * 2u; const unsigned h1 = u.half ? 0u : (unsigned)(HALF * lda * 2); v1[0] = v0[0] + h1; v1[1] = v0[1] + h1; } }
};
struct EpiGU {
    bf16_t* hact; const float* sw;
    __device__ __forceinline__ void operator()(const f32x4 (&acc)[2][2][4][2], const Unit& un, int wr, int wc, int fr, int fq) const {
        asm volatile("" : "+v"(fr), "+v"(fq));
        const int r0 = un.aux * BM + (un.half == 2 ? HALF : 0) + wr * 64 + fr, c0 = 128 * un.pn + 32 * wc + 8 * fq;
#pragma unroll
        for (int ai = 0; ai < 2; ++ai)
#pragma unroll
            for (int m = 0; m < 4; ++m) { if (ai == 1 && un.half) continue; const int row = r0 + ai * HALF + m * 16; const float w = sw[row];
                f32x4 a, b;
#pragma unroll
                for (int i = 0; i < 4; ++i) { const float g0 = acc[ai][0][m][0][i], g1 = acc[ai][1][m][0][i];
                    a[i] = g0 * fsigmoid(g0) * acc[ai][0][m][1][i] * w; b[i] = g1 * fsigmoid(g1) * acc[ai][1][m][1][i] * w; }
                *(u32x4*)(hact + (size_t)row * DEXP + c0) = pack8(a, b); }
    }
};
struct EpiDown {
    bf16_t* y0; bf16_t* y1; const int* stok;
    __device__ __forceinline__ void operator()(const f32x4 (&acc)[2][2][4][2], const Unit& un, int wr, int wc, int fr, int fq) const {
        asm volatile("" : "+v"(fr), "+v"(fq));
        const int r0 = un.aux * BM + wr * 64 + fr, c0 = 256 * un.pn + 32 * wc + 8 * fq;
        bf16_t* y = (un.pm >> 5) ? y1 : y0;
#pragma unroll
        for (int ai = 0; ai < 2; ++ai)
#pragma unroll
            for (int m = 0; m < 4; ++m) { const int tok = stok[r0 + ai * HALF + m * 16];
                if (tok >= 0) { bf16_t* orow = y + (size_t)tok * DM + c0;
                    *(u32x4*)(orow) = pack8(acc[ai][0][m][0], acc[ai][0][m][1]); *(u32x4*)(orow + HALF) = pack8(acc[ai][1][m][0], acc[ai][1][m][1]); } }
    }
};
__device__ __forceinline__ void p10_combine(const Ptrs& P, Frame& F) {
    const int gw = F.vcu * NWAVES + F.wave, NGW = F.G * NWAVES;
    const bf16_t* dl = (const bf16_t*)(P.ws + WS_DELTA); const bf16_t* y0 = (const bf16_t*)(P.ws + WS_Y0); const bf16_t* y1 = (const bf16_t*)(P.ws + WS_Y1);
    for (int m = gw; m < M; m += NGW) {
        const float* gate = (const float*)(P.ws + WS_MOD) + (m / SEQ) * 6144 + 5120;
        const f32x4* xr = (const f32x4*)(P.x + (size_t)m * DM) + F.lane; f32x4* orow = (f32x4*)(P.out + (size_t)m * DM) + F.lane;
        const u32x2* dr = (const u32x2*)(dl + (size_t)m * DM) + F.lane; const u32x2* a0 = (const u32x2*)(y0 + (size_t)m * DM) + F.lane; const u32x2* a1 = (const u32x2*)(y1 + (size_t)m * DM) + F.lane;
        f32x4 xv[4]; u32x2 d[4], p[4], q[4];
#pragma unroll
        for (int j = 0; j < 4; ++j) { xv[j] = __builtin_nontemporal_load(xr + 64 * j); d[j] = __builtin_nontemporal_load(dr + 64 * j); p[j] = __builtin_nontemporal_load(a0 + 64 * j); q[j] = __builtin_nontemporal_load(a1 + 64 * j); }
#pragma unroll
        for (int j = 0; j < 4; ++j) { const f32x4 g = *(const f32x4*)(gate + 4 * F.lane + 256 * j);
            f32x4 o;
            o[0] = xv[j][0] + __uint_as_float(d[j].x << 16) + g[0] * (__uint_as_float(p[j].x << 16) + __uint_as_float(q[j].x << 16));
            o[1] = xv[j][1] + __uint_as_float(d[j].x & 0xffff0000u) + g[1] * (__uint_as_float(p[j].x & 0xffff0000u) + __uint_as_float(q[j].x & 0xffff0000u));
            o[2] = xv[j][2] + __uint_as_float(d[j].y << 16) + g[2] * (__uint_as_float(p[j].y << 16) + __uint_as_float(q[j].y << 16));
            o[3] = xv[j][3] + __uint_as_float(d[j].y & 0xffff0000u) + g[3] * (__uint_as_float(p[j].y & 0xffff0000u) + __uint_as_float(q[j].y & 0xffff0000u));
            __builtin_nontemporal_store(o, orow + 64 * j); }
    }
}
struct Args { Ptrs P; int ph_lo, ph_hi, li, pad; };
constexpr int N_PHASES = 11;

typedef const __attribute__((address_space(4))) Args* KArgs;
__device__ __forceinline__ KArgs kargs() {
#if defined(__HIP_DEVICE_COMPILE__)
    unsigned off = 0u; asm volatile("" : "+s"(off));
    return (KArgs)((const __attribute__((address_space(4))) char*)__builtin_amdgcn_kernarg_segment_ptr() + off);
#else
    return nullptr;
#endif
}
__device__ __forceinline__ Ptrs load_ptrs() {
    Ptrs P{};
#if defined(__HIP_DEVICE_COMPILE__)
    const __attribute__((address_space(4))) unsigned long long* src = (const __attribute__((address_space(4))) unsigned long long*)kargs();
    unsigned long long w[sizeof(Ptrs) / 8];
#pragma unroll
    for (unsigned i = 0; i < sizeof(Ptrs) / 8; ++i) w[i] = src[i];
    __builtin_memcpy(&P, w, sizeof(Ptrs));
#endif
    return P;
}
#define WSPTRS \
    unsigned char* ws = P.ws; bf16_t* hA = (bf16_t*)(ws + WS_A); bf16_t* uB = (bf16_t*)(ws + WS_B); bf16_t* gbB = uB + (size_t)M * DM; bf16_t* sgB = gbB + (size_t)M * DM; \
    bf16_t* latC = (bf16_t*)(ws + WS_C); bf16_t* Kd = (bf16_t*)(ws + WS_D); bf16_t* Vd = (bf16_t*)(ws + WS_D + 96 * MiB); bf16_t* Qo = (bf16_t*)P.out; \
    float* ssp = (float*)(ws + WS_SSP); const float2* cs = (const float2*)(ws + WS_CS); const float* mod = (const float*)(ws + WS_MOD); \
    const int* stok = (const int*)(ws + WS_STOK); const float* sw = (const float*)(ws + WS_SW); bf16_t* h2 = (bf16_t*)(ws + WS_H2); bf16_t* hact = (bf16_t*)(ws + WS_HACT); \
    (void)hA; (void)uB; (void)gbB; (void)sgB; (void)latC; (void)Kd; (void)Vd; (void)Qo; (void)ssp; (void)cs; (void)mod; (void)stok; (void)sw; (void)h2; (void)hact;

__global__ void __launch_bounds__(NWAVES * 64, 2) fwd(Args args_unused) {
    extern __shared__ __attribute__((aligned(16))) unsigned char lds_raw[];
    Frame F;
    F.lds = (LAS unsigned char*)lds_raw;
    F.MISC = (volatile LAS unsigned*)(F.lds + MISC_OFF);
    F.tid = threadIdx.x; F.lane = F.tid & 63; F.wave = __builtin_amdgcn_readfirstlane(F.tid >> 6);
    F.G = gridDim.x; { const int bx = blockIdx.x; F.vcu = (F.G % 8 == 0) ? (bx % 8) * (F.G / 8) + bx / 8 : bx; }
    F.ctl = (unsigned*)(args_unused.P.ws + WS_CTL);
    for (int u = F.tid; u < (LDS_BYTES - LDSCTL_OFF) / 4; u += NWAVES * 64) ((LAS unsigned*)(F.lds + LDSCTL_OFF))[u] = 0u;
    __syncthreads();
    const int lo = args_unused.ph_lo, hi = args_unused.ph_hi;
    XcdBarrier bar; bar.bar = F.ctl + CW_BAR + args_unused.li * XCD_BAR_WORDS; bar.x = 0; bar.st = nullptr;
    if (hi - lo > 1) bar = xcd_barrier_post(F.ctl + CW_BAR + args_unused.li * XCD_BAR_WORDS, F.MISC + 8);
#ifdef ONLY_PHASE
#define IN(k) ((k) == ONLY_PHASE && lo <= (k) && (k) < hi)
#else
#define IN(k) (lo <= (k) && (k) < hi)
#endif
#ifndef PROBE_REPEAT
#define PROBE_REPEAT -1
#endif
#define REPS(k) for (int rep_ = 0; rep_ < ((k) == PROBE_REPEAT ? 2 : 1); ++rep_)
#define SEAM(k) do { if (IN(k) && IN((k) + 1)) xcd_barrier(bar); } while (0)

    if (IN(0)) { const Ptrs P = args_unused.P; REPS(0) { p0_router_weights(P, F); p0_mod(P, F); } SEAM(0); }
    if (IN(1)) { const Ptrs P = args_unused.P; REPS(1) { p1_norm1(P, F); p0_weights_tables(P, F); } SEAM(1); }
    if (IN(2)) {
        const Ptrs P = args_unused.P; WSPTRS
        DenseSched S; S.init(hA, DM, (const bf16_t*)(ws + WS_WIN), DM, M, 5888, F.G, (int)blockIdx.x, true, true);
        EpiIn E{uB, gbB, sgB, latC, ssp, cs, P.k_g, (LAS float*)(F.lds + XCH_OFF)};
        gemm_phase<false>(F.lds + RING_OFF, DM, S, E);
        if (PROBE_REPEAT == 2) gemm_phase<false>(F.lds + RING_OFF, DM, S, E);
        SEAM(2);
    }
    if (IN(3)) {
        const Ptrs P = args_unused.P; WSPTRS
        { DenseSched S; S.init(latC + 512, LATW, (const bf16_t*)(ws + WS_WKV), KVL, M, 2048, F.G, (int)blockIdx.x);
          EpiKV E{Kd, Vd, latC, ssp, P.k_g, (LAS float*)(F.lds + XCH_OFF)};
          gemm_phase<false>(F.lds + RING_OFF, KVL, S, E);
          if (PROBE_REPEAT == 31) gemm_phase<false>(F.lds + RING_OFF, KVL, S, E);
          if (PROBE_REPEAT == 32) { EpiPlain E2{hA, 1024, 3}; gemm_phase<false>(F.lds + RING_OFF, KVL, S, E2); } }
        SEAM(3);
    }
    if (IN(4)) {
        const Ptrs P = args_unused.P; WSPTRS
        att::AttnArgs T{latC, (const bf16_t*)(ws + WS_WQ), Qo, Kd, Vd, ssp, cs, P.q_g, uB, gbB, sgB, P.conv_w, hA};
        if (F.G == 256) {
            const int bh = F.vcu >> 1, sel = F.vcu & 1;
#pragma unroll 1
            for (int i = 0; i < 4; ++i) { const int qb = sel ? (i == 0 ? 6 : i == 1 ? 1 : i == 2 ? 5 : 2) : (i == 0 ? 7 : i == 1 ? 0 : i == 2 ? 4 : 3);
                att::ATTN_UNIT<0>(T, bh >> 3, bh & 7, qb, (LAS char*)(F.lds + RING_OFF)); }
            if (PROBE_REPEAT == 4 || PROBE_REPEAT == 41 || PROBE_REPEAT == 42) {
#pragma unroll 1
                for (int i = 0; i < 4; ++i) { const int qb = sel ? (i == 0 ? 6 : i == 1 ? 1 : i == 2 ? 5 : 2) : (i == 0 ? 7 : i == 1 ? 0 : i == 2 ? 4 : 3);
                    att::ATTN_UNIT<(PROBE_REPEAT == 41 ? 1 : PROBE_REPEAT == 42 ? 2 : 0)>(T, bh >> 3, bh & 7, qb, (LAS char*)(F.lds + RING_OFF)); } }
        } else {
#pragma unroll 1
            for (int U = F.vcu; U < BATCH * NH * 8; U += F.G) { const int bh = U >> 3; att::ATTN_UNIT<0>(T, bh >> 3, bh & 7, U & 7, (LAS char*)(F.lds + RING_OFF)); }
        }
        SEAM(4);
    }
    if (IN(5)) {
        const Ptrs P = args_unused.P; WSPTRS
        DenseSched S; S.init(hA, DM, (const bf16_t*)(ws + WS_WO), DM, M, DM, F.G, (int)blockIdx.x);
        EpiDelta E{mod, (bf16_t*)(ws + WS_DELTA)};
        gemm_phase<false>(F.lds + RING_OFF, DM, S, E);
        if (PROBE_REPEAT == 5) gemm_phase<false>(F.lds + RING_OFF, DM, S, E);
        if (PROBE_REPEAT == 51) { EpiNull E0; gemm_phase<false>(F.lds + RING_OFF, DM, S, E0); }
        SEAM(5);
    }
    if (IN(6)) { const Ptrs P = args_unused.P; p6_rows<0>(P, F); if (PROBE_REPEAT == 6) p6_rows<0>(P, F); if (PROBE_REPEAT == 61) p6_rows<1>(P, F); SEAM(6); }
    if (IN(7)) { const Ptrs P = args_unused.P; p7_sort(P, F); if (PROBE_REPEAT == 7) p7_sort(P, F); SEAM(7); }
    if (IN(8)) {
        const Ptrs P = args_unused.P; WSPTRS
        const int T = __builtin_amdgcn_readfirstlane((int)F.ctl[CW_T]);
        MoeSched S{h2, (const bf16_t*)(ws + WS_EGU), DM, DM, stok, F.ctl + CW_TGRP, 0, T * 2, 2, F.G, F.vcu, (size_t)512 * DM * 2, true, true};
        EpiGU E{hact, sw};
        gemm_phase<true>(F.lds + RING_OFF, DM, S, E);
        if (PROBE_REPEAT == 8) gemm_phase<true>(F.lds + RING_OFF, DM, S, E);
        SEAM(8);
    }
    if (IN(9)) {
        const Ptrs P = args_unused.P; WSPTRS
        const int T = __builtin_amdgcn_readfirstlane((int)F.ctl[CW_T]);
        MoeSched S{hact, (const bf16_t*)(ws + WS_EDN), DEXP, DEXP, stok, F.ctl + CW_TGRP, 0, T * 4, 4, F.G, F.vcu, (size_t)DM * DEXP * 2, false, false};
        EpiDown E{(bf16_t*)(ws + WS_Y0), (bf16_t*)(ws + WS_Y1), stok};
        gemm_phase<false>(F.lds + RING_OFF, DEXP, S, E);
        if (PROBE_REPEAT == 9) gemm_phase<false>(F.lds + RING_OFF, DEXP, S, E);
        SEAM(9);
    }
    if (IN(10)) { const Ptrs P = args_unused.P; REPS(10) p10_combine(P, F); }
#undef IN
#undef SEAM
}
}
extern "C" void kernel_launch(void* const* d_in, const int* in_sizes, int n_in, void* d_out, int out_size, void* d_ws, size_t ws_size, hipStream_t stream) {
    if (n_in != 23 || out_size != M * DM || ws_size < WS_END) { fprintf(stderr, "kernel_launch: unexpected shapes (n_in %d out %d ws %zu)\n", n_in, out_size, ws_size); return; }
    static int grid = 0;
    if (grid == 0) {
        int dev = 0, cus = 0;
        if (hipGetDevice(&dev) != hipSuccess || hipDeviceGetAttribute(&cus, hipDeviceAttributeMultiprocessorCount, dev) != hipSuccess) { fprintf(stderr, "kernel_launch: device query failed\n"); grid = -1; return; }
        if (hipFuncSetAttribute((const void*)fk::fwd, hipFuncAttributeMaxDynamicSharedMemorySize, fk::LDS_BYTES) != hipSuccess) { fprintf(stderr, "kernel_launch: hipFuncSetAttribute failed\n"); grid = -1; return; }
        grid = cus;
    }
    if (grid < 0) return;
    Ptrs P{};
    P.x = (const float*)d_in[0]; P.c = (const float*)d_in[1]; P.pos = (const int*)d_in[2];
    P.w_ada = (const float*)d_in[3]; P.b_ada = (const float*)d_in[4]; P.norm1_g = (const float*)d_in[5]; P.w_in = (const float*)d_in[6]; P.conv_w = (const float*)d_in[7];
    P.q_a_g = (const float*)d_in[8]; P.w_q_b = (const float*)d_in[9]; P.kv_a_g = (const float*)d_in[10]; P.w_kv_b = (const float*)d_in[11]; P.q_g = (const float*)d_in[12]; P.k_g = (const float*)d_in[13];
    P.w_o = (const float*)d_in[14]; P.norm2_g = (const float*)d_in[15]; P.w_rg = (const float*)d_in[16]; P.b_rg = (const float*)d_in[17]; P.w_re = (const float*)d_in[18]; P.b_re = (const float*)d_in[19];
    P.w_gate = (const float*)d_in[20]; P.w_up = (const float*)d_in[21]; P.w_down = (const float*)d_in[22];
    P.out = (float*)d_out; P.ws = (unsigned char*)d_ws;
    (void)hipMemsetAsync((char*)d_ws + WS_CTL, 0, 1 * MiB, stream);
    fk::Args a{}; a.P = P; a.ph_lo = 0; a.ph_hi = fk::N_PHASES; a.li = 0;
    hipLaunchKernelGGL(fk::fwd, dim3(grid), dim3(fk::NWAVES * 64), fk::LDS_BYTES, stream, a);
}
```

```cpp
#define PROBE_REPEAT -1
#include <hip/hip_runtime.h>
#include <cstdio>
#include <cstdint>
#include <cmath>

constexpr int BATCH = 16, SEQ = 2048, DM = 1024, M = BATCH * SEQ;
constexpr int NH = 8, QKN = 128, QKR = 64, QKH = 192, VH = 128, QL = 384, KVL = 256;
constexpr int DIN = 5824, NEXP = 32, DEXP = 256;
constexpr int C_ZX = 0, C_ZB = 1024, C_ZC = 2048, C_QL = 3072, C_KVL = 3456, C_KR = 3712, C_GC = 3776, C_GM = 4800;
constexpr float EPS = 1e-6f;
constexpr int LATW = 768;

typedef unsigned short bf16_t;
typedef float f32x4 __attribute__((ext_vector_type(4)));

constexpr size_t MiB = 1u << 20;
constexpr size_t WS_CTL = 0;
constexpr size_t WS_MOD = 1 * MiB;
constexpr size_t WS_CS = 2 * MiB;
constexpr size_t WS_SSP = 10 * MiB;
constexpr size_t WS_RT = 12 * MiB;
constexpr size_t WS_WSMALL = 14 * MiB;
constexpr size_t WS_A = 32 * MiB;
constexpr size_t WS_B = 96 * MiB;
constexpr size_t WS_C = 288 * MiB;
constexpr size_t WS_D = 336 * MiB;
constexpr size_t WS_END = 496 * MiB;

__device__ __forceinline__ float bf2f(bf16_t v) { return __uint_as_float(((unsigned)v) << 16); }
__device__ __forceinline__ bf16_t f2bf(float f) { unsigned u = __float_as_uint(f); return (bf16_t)((u + 0x7fffu + ((u >> 16) & 1u)) >> 16); }

struct Ptrs {
    const float *x, *c; const int* pos;
    const float *w_ada, *b_ada, *norm1_g, *w_in, *conv_w, *q_a_g, *w_q_b, *kv_a_g, *w_kv_b, *q_g, *k_g, *w_o, *norm2_g;
    const float *w_rg, *b_rg, *w_re, *b_re, *w_gate, *w_up, *w_down;
    float* out; unsigned char* ws;
};

namespace fk {
#define LAS __attribute__((address_space(3)))
#define GAS __attribute__((address_space(1)))
typedef short bf16x8 __attribute__((ext_vector_type(8)));
typedef short s16x4 __attribute__((ext_vector_type(4)));
typedef unsigned u32x4 __attribute__((ext_vector_type(4)));
typedef unsigned u32x2 __attribute__((ext_vector_type(2)));
typedef float f32x2 __attribute__((ext_vector_type(2)));
typedef float f32x16 __attribute__((ext_vector_type(16)));
typedef GAS unsigned gu32;
#define RLX_AGENT __ATOMIC_RELAXED, __HIP_MEMORY_SCOPE_AGENT
constexpr int NWAVES = 8;
constexpr int BM = 256, BK = 64, HALF = 128, HTB = HALF * BK * 2, STAGE_BYTES = 8 * HTB, NXCD = 8, WGM = 8;
constexpr int RING_OFF = 0, RING_BYTES = 131072, XCH_OFF = 131072, XCH_BYTES = 8192, LDSCTL_OFF = XCH_OFF + XCH_BYTES, MISC_OFF = LDSCTL_OFF + 320, GX_OFF = 147456, LDS_BYTES = 155648;
constexpr int CW_TMO = 0, CW_BAR = 4096;
constexpr int CW_HIST = 16384;
constexpr int CW_TILES = 40960;

typedef __bf16 bf16x2_t __attribute__((ext_vector_type(2)));
__device__ __forceinline__ unsigned cvt_pk_bf16(float lo, float hi) { f32x2 v = {lo, hi}; bf16x2_t b = __builtin_convertvector(v, bf16x2_t); return __builtin_bit_cast(unsigned, b); }
__device__ __forceinline__ float fsigmoid(float x) { return __builtin_amdgcn_rcpf(1.f + __expf(-x)); }

__host__ __device__ __forceinline__ int lds_byte(int r, int c) { const int st = (r >> 4) * 2 + (c >> 5), rr = r & 15, cc = c & 31, ob = rr * 64 + cc * 2; return st * 1024 + (ob ^ (((ob >> 9) & 1) << 5)); }
__host__ __device__ __forceinline__ void stage_rc(int b, int& R, int& C) { const int st = b / 1024, sb = b % 1024, swz = sb ^ (((sb >> 9) & 1) << 5); R = (st >> 1) * 16 + swz / 64; C = (st & 1) * 32 + (swz % 64) / 2; }
__host__ __device__ __forceinline__ int permL(int L) { return (L & 0xE0) | (((L >> 2) & 1) << 4) | (((L >> 3) & 3) << 2) | (L & 3); }

#define XB_TMO      128
#define XB_XCNT(j)  (256  + 64 * (j))
#define XB_XSUB(j)  (1280 + 64 * (j))
#define XB_XGEN(j)  (2304 + 64 * (j))
#define XB_TOP      3328
#define XB_TOPGEN   3392
#define XCD_BAR_WORDS 3456
#define XB_SPIN_CAP (1u << 18)
__device__ __forceinline__ unsigned xb_ld(unsigned* p)              { return __hip_atomic_load(p, __ATOMIC_RELAXED, __HIP_MEMORY_SCOPE_AGENT); }
__device__ __forceinline__ unsigned xb_add(unsigned* p, unsigned v) { return __hip_atomic_fetch_add(p, v, __ATOMIC_RELAXED, __HIP_MEMORY_SCOPE_AGENT); }
__device__ __forceinline__ unsigned xb_xcc_id() { return (unsigned)__builtin_amdgcn_s_getreg((3 << 11) | 20) & 0xFu; }
#define XB_SPIN(cond, bar) do { unsigned _sp = 0; while (cond) { __builtin_amdgcn_s_sleep(1); \
    if ((++_sp & 255u) == 0u) { if (xb_ld(&(bar)[XB_TMO])) break; if (_sp > XB_SPIN_CAP) { atomicAdd(&(bar)[XB_TMO], 1u); break; } } } } while (0)
struct XcdBarrier { unsigned* bar; unsigned x; volatile LAS unsigned* st; };
__device__ __forceinline__ XcdBarrier xcd_barrier_post(unsigned* bar, volatile LAS unsigned* st) {
    XcdBarrier b; b.bar = bar; b.x = xb_xcc_id(); b.st = st;
    if (threadIdx.x == 0) (void)xb_add(&bar[XB_XCNT(b.x)], 1u);
    return b;
}
__device__ __forceinline__ void xcd_barrier_complete(unsigned* bar, unsigned x, unsigned& nloc, unsigned& nx) {
    const unsigned G = gridDim.x * gridDim.y * gridDim.z;
    unsigned sum, cnt, mine, sp = 0u;
    for (;;) {
        sum = 0u; cnt = 0u; mine = 0u;
#pragma unroll
        for (unsigned j = 0; j < 16; ++j) { const unsigned c = xb_ld(&bar[XB_XCNT(j)]); sum += c; cnt += (c > 0u) ? 1u : 0u; mine = (j == x) ? c : mine; }
        if (sum == G) break;
        __builtin_amdgcn_s_sleep(1);
        if ((++sp & 255u) == 0u) { if (xb_ld(&bar[XB_TMO])) break; if (sp > XB_SPIN_CAP) { atomicAdd(&bar[XB_TMO], 1u); break; } }
    }
    nloc = mine > 0u ? mine : 1u; nx = cnt > 0u ? cnt : 1u;
}
__device__ __forceinline__ void xcd_barrier(const XcdBarrier& b) {
    asm volatile("s_waitcnt vmcnt(0)" ::: "memory");
    __syncthreads();
    if (threadIdx.x == 0) {
        unsigned* bar = b.bar;
        __builtin_amdgcn_s_waitcnt(0);
        unsigned nloc = b.st[0], nx = b.st[1];
        if (nloc == 0u) { xcd_barrier_complete(bar, b.x, nloc, nx); b.st[0] = nloc; b.st[1] = nx; }
        const unsigned old = xb_add(&bar[XB_XSUB(b.x)], 1u);
        const unsigned gen = old / nloc;
        if (old + 1u == (gen + 1u) * nloc) {
            __builtin_amdgcn_fence(__ATOMIC_RELEASE, "agent");
            asm volatile("s_waitcnt vmcnt(0)" ::: "memory");
            const unsigned og = xb_add(&bar[XB_TOP], 1u);
            const unsigned tg = og / nx;
            if (og + 1u == (tg + 1u) * nx) xb_add(&bar[XB_TOPGEN], 1u);
            else XB_SPIN(xb_ld(&bar[XB_TOPGEN]) == tg, bar);
            __builtin_amdgcn_fence(__ATOMIC_ACQUIRE, "agent");
            xb_add(&bar[XB_XGEN(b.x)], 1u);
            asm volatile("s_waitcnt vmcnt(0)" ::: "memory");
        } else {
            XB_SPIN(xb_ld(&bar[XB_XGEN(b.x)]) == gen, bar);
            __builtin_amdgcn_fence(__ATOMIC_ACQUIRE, "agent");
            asm volatile("s_waitcnt vmcnt(0)" ::: "memory");
        }
    }
    __syncthreads();
}

struct Unit { int pm, pn, aux, half; };
struct DenseSched {
    const bf16_t* A; const bf16_t* Bt; int lda, ldb; int nM, nN, nwg, G, c; bool split, pnflip;
    __device__ void init(const bf16_t* A_, int lda_, const bf16_t* Bt_, int ldb_, int M_, int N_, int G_, int c_, bool split_ = false, bool pnflip_ = false) {
        A = A_; Bt = Bt_; lda = lda_; ldb = ldb_; nM = M_ / BM; nN = N_ / BM; nwg = nM * nN; G = G_; c = c_; split = split_; pnflip = pnflip_; }
    __device__ bool next(int i, Unit& u) const {
        const int idx = i * G + c, nfull = (nwg / G) * G, tail = nwg - nfull; int L; u.half = 0;
        if (split && tail > 0 && 2 * tail <= G) { if (idx >= nfull + 2 * tail) return false; if (idx < nfull) L = idx; else { L = nfull + ((idx - nfull) >> 1); u.half = 1 + ((idx - nfull) & 1); } }
        else { if (idx >= nwg) return false; L = idx; }
        int wgid = L; { const int q = nwg / NXCD, r = nwg % NXCD, xcd = wgid % NXCD, off = wgid / NXCD; wgid = (xcd < r ? xcd * (q + 1) : r * (q + 1) + (xcd - r) * q) + off; }
        const int nig = WGM * nN, gid = wgid / nig, fm = gid * WGM, gsz = (nM - fm) < WGM ? (nM - fm) : WGM;
        u.pm = fm + ((wgid % nig) % gsz); u.pn = (wgid % nig) / gsz; if (pnflip) u.pn = nN - 1 - u.pn; u.aux = 0; return true;
    }
    __device__ __forceinline__ const char* abase(const Unit& u) const { return (const char*)A + (size_t)(u.pm * BM + (u.half == 2 ? HALF : 0)) * lda * 2; }
    __device__ __forceinline__ const char* bbase(const Unit& u) const { return (const char*)Bt + (size_t)u.pn * BM * ldb * 2; }
    __device__ __forceinline__ void avoff(const Unit& u, int R0, int C0, int R1, int C1, unsigned (&v0)[2], unsigned (&v1)[2]) const {
        v0[0] = (unsigned)(R0 * lda + C0) * 2u; v0[1] = (unsigned)(R1 * lda + C1) * 2u;
        const unsigned h1 = u.half ? 0u : (unsigned)(HALF * lda * 2);
        v1[0] = v0[0] + h1; v1[1] = v0[1] + h1; }
};

template <bool GATHER, bool PAIR = false, class Epi, class Sched>
__device__ __forceinline__ void gemm_phase(LAS unsigned char* lds, const int K, const Sched& S, const Epi& E) {
    const int tid = threadIdx.x, wid = __builtin_amdgcn_readfirstlane(tid >> 6), lane = tid & 63, wr = wid >> 2, wc = wid & 3, fr = lane & 15, fq = lane >> 4;
    const int nt = K / BK;
    int R0, C0, R1, C1; stage_rc(tid * 16, R0, C0); stage_rc(tid * 16 + 8192, R1, C1);
    unsigned voffB[2]; voffB[0] = (unsigned)(R0 * S.ldb + C0) * 2u; voffB[1] = (unsigned)(R1 * S.ldb + C1) * 2u;
    const size_t kstep = (size_t)(BK * 2);
    const size_t hstepB = (size_t)HALF * S.ldb * 2;
    const unsigned ldsw = (unsigned)wid * 1024u;
    const int aoff = lds_byte(wr * 64 + fr, fq * 8), boff = lds_byte(wc * 32 + fr, fq * 8);
#define PG8_SA(b, h) (((b) * 2 + (h)) * HTB)
#define PG8_SB(b, h) ((4 + (b) * 2 + (h)) * HTB)
#define PG8_STAGE(bufoff, gbase, voff) do { _Pragma("unroll") for (int _i = 0; _i < 2; ++_i) \
        __builtin_amdgcn_global_load_lds((const unsigned*)((const char*)(gbase) + (voff)[_i]), (LAS unsigned*)(lds + (bufoff) + ldsw + _i * 8192), 16, 0, 0); } while (0)
#define PG8_LDA(dst, b, h) do { _Pragma("unroll") for (int m = 0; m < 4; ++m) _Pragma("unroll") for (int k = 0; k < 2; ++k) dst[m][k] = *(const LAS bf16x8*)(lds + PG8_SA(b, h) + aoff + m * 2048 + k * 1024); } while (0)
#define PG8_LDB(dst, b, h) do { _Pragma("unroll") for (int n = 0; n < 2; ++n) _Pragma("unroll") for (int k = 0; k < 2; ++k) dst[n][k] = *(const LAS bf16x8*)(lds + PG8_SB(b, h) + boff + n * 2048 + k * 1024); } while (0)
#define PG8_MMA(ai, bj, At, Bt) do { __builtin_amdgcn_s_setprio(1); _Pragma("unroll") for (int m = 0; m < 4; ++m) _Pragma("unroll") for (int n = 0; n < 2; ++n) _Pragma("unroll") for (int k = 0; k < 2; ++k) \
        acc[ai][bj][m][n] = __builtin_amdgcn_mfma_f32_16x16x32_bf16(Bt[n][k], At[m][k], acc[ai][bj][m][n], 0, 0, 0); __builtin_amdgcn_s_setprio(0); } while (0)
#define PG8_WAIT_V(n) asm volatile("s_waitcnt vmcnt(" #n ")" ::: "memory")
#define PG8_WAIT_L(n) asm volatile("s_waitcnt lgkmcnt(" #n ")" ::: "memory")
#define PG8_BAR __builtin_amdgcn_s_barrier()
#define PG8_SCHED __builtin_amdgcn_sched_barrier(0)
    Unit cur, nxt; int ui = 0;
    if (!S.next(0, cur)) return;
    f32x4 acc[2][2][4][2];
#pragma unroll
    for (int a = 0; a < 2; ++a)
#pragma unroll
        for (int b = 0; b < 2; ++b)
#pragma unroll
            for (int m = 0; m < 4; ++m)
#pragma unroll
                for (int n = 0; n < 2; ++n) acc[a][b][m][n] = (f32x4){0.f, 0.f, 0.f, 0.f};
    bf16x8 At[4][2], B0[2][2], B1[2][2];
    unsigned va0[2], va1[2], na0[2], na1[2];
    S.avoff(cur, R0, C0, R1, C1, va0, va1);
    na0[0] = va0[0]; na0[1] = va0[1]; na1[0] = va1[0]; na1[1] = va1[1];
    const char* cA = S.abase(cur); const char* cB = S.bbase(cur); const char* cB2 = cB; if constexpr (PAIR) cB2 = S.bbase2(cur);
    PG8_STAGE(PG8_SB(0, 0), cB, voffB); PG8_STAGE(PG8_SB(0, 1), cB + hstepB, voffB); PG8_STAGE(PG8_SA(0, 0), cA, va0); PG8_STAGE(PG8_SA(0, 1), cA, va1);
    if (wr == 1) PG8_BAR;
    PG8_WAIT_V(2); PG8_BAR;
    PG8_STAGE(PG8_SB(1, 0), cB + kstep, voffB); PG8_STAGE(PG8_SA(1, 0), cA + kstep, va0); PG8_STAGE(PG8_SB(1, 1), cB + hstepB + kstep, voffB);
    PG8_WAIT_V(6); PG8_BAR;
    for (;;) {
        const bool has_next = S.next(ui + 1, nxt);
        const char* nA = has_next ? S.abase(nxt) : cA; const char* nB = has_next ? S.bbase(nxt) : cB; const char* nB2 = nB; if constexpr (PAIR) nB2 = has_next ? S.bbase2(nxt) : cB2;
        if (has_next) S.avoff(nxt, R0, C0, R1, C1, na0, na1);
        const bool hu = cur.half != 0;
#pragma unroll 1
        for (int t = 0; t < nt; t += 2) {
            const bool last = (t == nt - 2);
            const char* a1 = cA + (size_t)(t + 1) * kstep;
            const char* a2 = last ? nA : cA + (size_t)(t + 2) * kstep;
            const char* b2 = last ? nB : (PAIR && 2 * (t + 2) >= nt) ? cB2 + (size_t)(t + 2 - (nt >> 1)) * kstep : cB + (size_t)(t + 2) * kstep;
            const char* a3 = a2 + kstep; const char* b3 = b2 + kstep;
            unsigned x0[2], x1[2];
            x0[0] = last ? na0[0] : va0[0]; x0[1] = last ? na0[1] : va0[1]; x1[0] = last ? na1[0] : va1[0]; x1[1] = last ? na1[1] : va1[1];
            PG8_LDB(B0, 0, 0); PG8_LDB(B1, 0, 1); PG8_SCHED; PG8_LDA(At, 0, 0); PG8_STAGE(PG8_SA(1, 1), a1, va1);
            PG8_WAIT_V(8); PG8_WAIT_L(0); PG8_BAR; PG8_MMA(0, 0, At, B0); PG8_MMA(0, 1, At, B1); PG8_BAR; PG8_SCHED;
            if (!hu) PG8_LDA(At, 0, 1);
            PG8_STAGE(PG8_SB(0, 0), b2, voffB); PG8_STAGE(PG8_SB(0, 1), b2 + hstepB, voffB); PG8_STAGE(PG8_SA(0, 0), a2, x0);
            PG8_WAIT_V(8); PG8_WAIT_L(0); PG8_BAR; if (!hu) { PG8_MMA(1, 0, At, B0); PG8_MMA(1, 1, At, B1); } PG8_BAR; PG8_SCHED;
            PG8_LDB(B0, 1, 0); PG8_LDB(B1, 1, 1); PG8_SCHED; PG8_LDA(At, 1, 0); PG8_STAGE(PG8_SA(0, 1), a2, x1);
            PG8_WAIT_V(8); PG8_WAIT_L(0); PG8_BAR; PG8_MMA(0, 0, At, B0); PG8_MMA(0, 1, At, B1); PG8_BAR; PG8_SCHED;
            if (!hu) PG8_LDA(At, 1, 1);
            PG8_STAGE(PG8_SB(1, 0), b3, voffB); PG8_STAGE(PG8_SB(1, 1), b3 + hstepB, voffB); PG8_STAGE(PG8_SA(1, 0), a3, x0);
            PG8_WAIT_V(8); PG8_WAIT_L(0); PG8_BAR; if (!hu) { PG8_MMA(1, 0, At, B0); PG8_MMA(1, 1, At, B1); } PG8_BAR; PG8_SCHED;
        }
        if (wr == 0) PG8_BAR;
        E(acc, cur, wr, wc, fr, fq);
        if (!has_next) break;
#pragma unroll
        for (int a = 0; a < 2; ++a)
#pragma unroll
            for (int b = 0; b < 2; ++b)
#pragma unroll
                for (int m = 0; m < 4; ++m)
#pragma unroll
                    for (int n = 0; n < 2; ++n) acc[a][b][m][n] = (f32x4){0.f, 0.f, 0.f, 0.f};
        cur = nxt; cA = nA; cB = nB; cB2 = nB2; ++ui;
        va0[0] = na0[0]; va0[1] = na0[1]; va1[0] = na1[0]; va1[1] = na1[1];
        if (wr == 1) PG8_BAR;
    }
    PG8_WAIT_V(0);
    PG8_BAR;
#undef PG8_SA
#undef PG8_SB
#undef PG8_STAGE
#undef PG8_LDA
#undef PG8_LDB
#undef PG8_MMA
#undef PG8_WAIT_V
#undef PG8_WAIT_L
#undef PG8_BAR
#undef PG8_SCHED
}

__device__ __forceinline__ u32x4 pack8(const f32x4 a, const f32x4 b) { u32x4 w; w.x = cvt_pk_bf16(a[0], a[1]); w.y = cvt_pk_bf16(a[2], a[3]); w.z = cvt_pk_bf16(b[0], b[1]); w.w = cvt_pk_bf16(b[2], b[3]); return w; }

struct EpiIn {
    bf16_t *u, *gb, *sg, *lat; float* rowstat; const float2* cs; const float* k_g; LAS float* xch;
    __device__ __forceinline__ void operator()(const f32x4 (&acc)[2][2][4][2], const Unit& un, int wr, int wc, int fr, int fq) const {
        asm volatile("" : "+v"(fr), "+v"(fq));
        const int row0 = un.pm * BM + wr * 64 + fr, pn = un.pn;
        if (pn < 16) {
            const int c0 = 128 * (pn & 7) + 32 * wc + 8 * fq; bf16_t* dst = pn < 8 ? u : gb; const int rh = row0 + (un.half == 2 ? HALF : 0);
#pragma unroll
            for (int ai = 0; ai < 2; ++ai)
#pragma unroll
                for (int m = 0; m < 4; ++m) { f32x4 r0, r1; if (ai == 1 && un.half) continue;
                    if (pn < 8) { r0 = acc[ai][0][m][0] * acc[ai][1][m][0]; r1 = acc[ai][0][m][1] * acc[ai][1][m][1]; }
                    else { const f32x4 g0 = acc[ai][1][m][0], g1 = acc[ai][1][m][1];
#pragma unroll
                        for (int i = 0; i < 4; ++i) { r0[i] = acc[ai][0][m][0][i] * fsigmoid(g0[i]); r1[i] = acc[ai][0][m][1][i] * fsigmoid(g1[i]); } }
                    __builtin_nontemporal_store(pack8(r0, r1), (u32x4*)(dst + (size_t)(rh + ai * HALF + m * 16) * DM + c0)); }
        } else if (pn < 20) {
            const int c0 = 256 * (pn - 16) + 32 * wc + 8 * fq;
#pragma unroll
            for (int ai = 0; ai < 2; ++ai)
#pragma unroll
                for (int m = 0; m < 4; ++m)
#pragma unroll
                    for (int bj = 0; bj < 2; ++bj) { f32x4 a = acc[ai][bj][m][0], b = acc[ai][bj][m][1];
#pragma unroll
                        for (int i = 0; i < 4; ++i) { a[i] = fsigmoid(a[i]); b[i] = fsigmoid(b[i]); }
                        __builtin_nontemporal_store(pack8(a, b), (u32x4*)(sg + (size_t)(row0 + ai * HALF + m * 16) * DM + c0 + bj * HALF)); }
        } else {
            const int c0 = 256 * (pn - 20) + 32 * wc + 8 * fq, rowt = wr * 64 + fr;
#pragma unroll
            for (int ai = 0; ai < 2; ++ai)
#pragma unroll
                for (int m = 0; m < 4; ++m) { const int rt = rowt + ai * HALF + m * 16, row = un.pm * BM + rt; float s0, s1;
                    { const f32x4 a = acc[ai][0][m][0], b = acc[ai][0][m][1]; *(u32x4*)(lat + (size_t)row * LATW + c0) = pack8(a, b);
                      s0 = (a[0] * a[0] + a[1] * a[1]) + (a[2] * a[2] + a[3] * a[3]) + (b[0] * b[0] + b[1] * b[1]) + (b[2] * b[2] + b[3] * b[3]); }
                    { const f32x4 a = acc[ai][1][m][0], b = acc[ai][1][m][1];
                      s1 = (a[0] * a[0] + a[1] * a[1]) + (a[2] * a[2] + a[3] * a[3]) + (b[0] * b[0] + b[1] * b[1]) + (b[2] * b[2] + b[3] * b[3]);
                      if (pn != 21) *(u32x4*)(lat + (size_t)row * LATW + c0 + HALF) = pack8(a, b);
                      else if (wc < 2) { const int j = 16 * wc + 4 * fq;
                          const f32x4 g1 = *(const f32x4*)(k_g + 128 + j), g2 = *(const f32x4*)(k_g + 160 + j);
                          const f32x4 cA = *(const f32x4*)((const float*)cs + ((size_t)row * 32 + j) * 2), cB = *(const f32x4*)((const float*)cs + ((size_t)row * 32 + j + 2) * 2);
                          const f32x4 x1 = a * g1, x2 = b * g2; f32x4 y1, y2;
                          y1[0] = x1[0] * cA[0] - x2[0] * cA[1]; y2[0] = x2[0] * cA[0] + x1[0] * cA[1]; y1[1] = x1[1] * cA[2] - x2[1] * cA[3]; y2[1] = x2[1] * cA[2] + x1[1] * cA[3];
                          y1[2] = x1[2] * cB[0] - x2[2] * cB[1]; y2[2] = x2[2] * cB[0] + x1[2] * cB[1]; y1[3] = x1[3] * cB[2] - x2[3] * cB[3]; y2[3] = x2[3] * cB[2] + x1[3] * cB[3];
                          u32x2 w1, w2; w1.x = cvt_pk_bf16(y1[0], y1[1]); w1.y = cvt_pk_bf16(y1[2], y1[3]); w2.x = cvt_pk_bf16(y2[0], y2[1]); w2.y = cvt_pk_bf16(y2[2], y2[3]);
                          *(u32x2*)(lat + (size_t)row * LATW + 384 + j) = w1; *(u32x2*)(lat + (size_t)row * LATW + 416 + j) = w2; } }
                    s0 += __shfl_xor(s0, 16); s0 += __shfl_xor(s0, 32); s1 += __shfl_xor(s1, 16); s1 += __shfl_xor(s1, 32);
                    if (fq == 0) { xch[rt * 8 + wc] = s0; xch[rt * 8 + 4 + wc] = s1; } }
            asm volatile("s_waitcnt lgkmcnt(0)" ::: "memory"); __builtin_amdgcn_s_barrier(); asm volatile("" ::: "memory");
            if (threadIdx.x < 256) { const int rt = threadIdx.x; const f32x4 p0 = *(const LAS f32x4*)(xch + rt * 8), p1 = *(const LAS f32x4*)(xch + rt * 8 + 4);
                const float S0 = (p0[0] + p0[1]) + (p0[2] + p0[3]), S1 = (p1[0] + p1[1]) + (p1[2] + p1[3]); float* st = rowstat + (size_t)(un.pm * BM + rt) * 4;
                if (pn == 20) st[0] = S0 + S1; else if (pn == 21) { st[1] = S0; st[2] = S1; } else st[3] = S0 + S1; }
        }
    }
};
struct EpiPlain {
    bf16_t* O; int ldc; int pnmask;
    __device__ __forceinline__ void operator()(const f32x4 (&acc)[2][2][4][2], const Unit& un, int wr, int wc, int fr, int fq) const {
        asm volatile("" : "+v"(fr), "+v"(fq));
        const int row0 = un.pm * BM + wr * 64 + fr, c0 = 256 * (un.pn & pnmask) + 32 * wc + 8 * fq;
#pragma unroll
        for (int ai = 0; ai < 2; ++ai)
#pragma unroll
            for (int m = 0; m < 4; ++m)
#pragma unroll
                for (int bj = 0; bj < 2; ++bj) __builtin_nontemporal_store(pack8(acc[ai][bj][m][0], acc[ai][bj][m][1]), (u32x4*)(O + (size_t)(row0 + ai * HALF + m * 16) * ldc + c0 + bj * HALF));
    }
};
struct EpiKV {
    bf16_t *Kb, *Vb; const bf16_t* lat; const float* rowstat; const float* k_g; LAS float* xch;
    __device__ __forceinline__ void operator()(const f32x4 (&acc)[2][2][4][2], const Unit& un, int wr, int wc, int fr, int fq) const {
        asm volatile("" : "+v"(fr), "+v"(fq));
        const int h = un.pn, rowt = wr * 64 + fr, b = (un.pm * BM) / SEQ, s0 = (un.pm * BM) % SEQ;
        f32x2 st[2][4];
        u32x4 rp[2][2];
#pragma unroll
        for (int ai = 0; ai < 2; ++ai) {
#pragma unroll
            for (int m = 0; m < 4; ++m) st[ai][m] = *(const f32x2*)(rowstat + (size_t)(un.pm * BM + rowt + ai * HALF + m * 16) * 4 + 2);
            const bf16_t* lr = lat + (size_t)(un.pm * BM + rowt + ai * HALF + wc * 16) * LATW + 384 + 16 * fq;
            rp[ai][0] = *(const u32x4*)lr; rp[ai][1] = *(const u32x4*)(lr + 8); }
#pragma unroll
        for (int ai = 0; ai < 2; ++ai)
#pragma unroll
            for (int m = 0; m < 4; ++m) {
                const f32x4 a = acc[ai][0][m][0], c = acc[ai][0][m][1];
                float ss = (a[0] * a[0] + a[1] * a[1]) + (a[2] * a[2] + a[3] * a[3]) + (c[0] * c[0] + c[1] * c[1]) + (c[2] * c[2] + c[3] * c[3]);
                ss += __shfl_xor(ss, 16); ss += __shfl_xor(ss, 32);
                if (fq == 0) xch[(rowt + ai * HALF + m * 16) * 4 + wc] = ss; }
        asm volatile("s_waitcnt lgkmcnt(0)" ::: "memory"); __builtin_amdgcn_s_barrier(); asm volatile("" ::: "memory");
        const int c8 = 32 * wc + 8 * fq;
        const f32x4 g0 = *(const f32x4*)(k_g + c8), g1 = *(const f32x4*)(k_g + c8 + 4);
#pragma unroll
        for (int ai = 0; ai < 2; ++ai)
#pragma unroll
            for (int m = 0; m < 4; ++m) { const int rt = rowt + ai * HALF + m * 16;
                const float rkv = __builtin_amdgcn_rsqf(st[ai][m][1] * (1.f / KVL) + EPS);
                const f32x4 t4 = *(const LAS f32x4*)(xch + rt * 4);
                const float rk = __builtin_amdgcn_rsqf((((t4[0] + t4[1]) + (t4[2] + t4[3])) * rkv * rkv + st[ai][m][0]) * (1.f / QKH) + EPS);
                const float sk = rkv * rk, sv = rkv;
                const size_t bhs = (size_t)(b * NH + h) * SEQ + s0 + rt;
                bf16_t* Kp = Kb + bhs * QKH; bf16_t* Vp = Vb + bhs * VH;
                *(u32x4*)(Kp + c8) = pack8(acc[ai][0][m][0] * sk * g0, acc[ai][0][m][1] * sk * g1);
                *(u32x4*)(Vp + c8) = pack8(acc[ai][1][m][0] * sv, acc[ai][1][m][1] * sv);
                if (m == wc) {
                    u32x4 o0, o1;
#pragma unroll
                    for (int e = 0; e < 4; ++e) { o0[e] = cvt_pk_bf16(__uint_as_float(rp[ai][0][e] << 16) * rk, __uint_as_float(rp[ai][0][e] & 0xffff0000u) * rk);
                                                  o1[e] = cvt_pk_bf16(__uint_as_float(rp[ai][1][e] << 16) * rk, __uint_as_float(rp[ai][1][e] & 0xffff0000u) * rk); }
                    *(u32x4*)(Kp + 128 + 16 * fq) = o0; *(u32x4*)(Kp + 128 + 16 * fq + 8) = o1; } }
    }
};
struct EpiNull {
    __device__ __forceinline__ void operator()(const f32x4 (&acc)[2][2][4][2], const Unit& un, int wr, int wc, int fr, int fq) const {
#pragma unroll
        for (int ai = 0; ai < 2; ++ai)
#pragma unroll
            for (int bj = 0; bj < 2; ++bj)
#pragma unroll
                for (int m = 0; m < 4; ++m) { f32x4 a = acc[ai][bj][m][0], b = acc[ai][bj][m][1]; asm volatile("" :: "v"(a), "v"(b)); }
    }
};
struct EpiDelta {
    const float* mod; bf16_t* delta;
    __device__ __forceinline__ void operator()(const f32x4 (&acc)[2][2][4][2], const Unit& un, int wr, int wc, int fr, int fq) const {
        asm volatile("" : "+v"(fr), "+v"(fq));
        const int row0 = un.pm * BM + wr * 64 + fr, b = (un.pm * BM) / SEQ, c0 = 256 * un.pn + 32 * wc + 8 * fq;
        const float* gate = mod + b * 6144 + 2048;
#pragma unroll
        for (int bj = 0; bj < 2; ++bj) { const f32x4 g0 = *(const f32x4*)(gate + c0 + bj * HALF), g1 = *(const f32x4*)(gate + c0 + bj * HALF + 4);
#pragma unroll
            for (int ai = 0; ai < 2; ++ai)
#pragma unroll
                for (int m = 0; m < 4; ++m) *(u32x4*)(delta + (size_t)(row0 + ai * HALF + m * 16) * DM + c0 + bj * HALF) = pack8(acc[ai][bj][m][0] * g0, acc[ai][bj][m][1] * g1); }
    }
};
namespace att {
constexpr int NW = 8, QBLK = 32, KVBLK = 64, KPITCH = 400;
constexpr int SHM_V = KVBLK * VH * 2, SHM_K = KVBLK * KPITCH;
constexpr int QRP = 144;
constexpr int OFF_V = 0, OFF_K = 2 * SHM_V, OFF_WS = OFF_K + 2 * SHM_K, OFF_QR = OFF_WS + NW * 64 * 4, ATT_LDS = OFF_QR + NW * 32 * QRP;
constexpr float SCALE = 0.07216878364870322f;
constexpr float THR = 8.f;
#define SBAR() __builtin_amdgcn_sched_barrier(0)
__device__ __forceinline__ int crow(int r, int hi) { return (r & 3) + 8 * (r >> 2) + 4 * hi; }
__device__ __forceinline__ void partialSM(f32x16& p0, f32x16& p1, float& m_reg, float& alpha) {
    constexpr float C = SCALE * 1.4426950408889634f;
    float pmax = p0[0];
#pragma unroll
    for (int r = 1; r < 16; ++r) pmax = fmaxf(pmax, p0[r]);
#pragma unroll
    for (int r = 0; r < 16; ++r) pmax = fmaxf(pmax, p1[r]);
    { auto rr = __builtin_amdgcn_permlane32_swap(__float_as_uint(pmax), __float_as_uint(pmax), false, false);
      pmax = fmaxf(__uint_as_float(rr[0]), __uint_as_float(rr[1])); }
    float mn;
    if (__builtin_expect(__all(pmax - m_reg <= THR / SCALE), 1)) { mn = m_reg; alpha = 1.f; }
    else { mn = fmaxf(m_reg, pmax); alpha = __builtin_amdgcn_exp2f((m_reg - mn) * C); m_reg = mn; }
    const float mnC = -mn * C;
#pragma unroll
    for (int r = 0; r < 16; ++r) p0[r] = fmaf(p0[r], C, mnC);
#pragma unroll
    for (int r = 0; r < 16; ++r) p1[r] = fmaf(p1[r], C, mnC);
#pragma unroll
    for (int r = 0; r < 16; ++r) p0[r] = __builtin_amdgcn_exp2f(p0[r]);
}
__device__ __forceinline__ void finishSM(f32x16& p0, f32x16& p1, float alpha, float& l_reg, bf16x8& pa0, bf16x8& pa1, bf16x8& pa2, bf16x8& pa3) {
#pragma unroll
    for (int r = 0; r < 16; ++r) p1[r] = __builtin_amdgcn_exp2f(p1[r]);
    float ps = 0;
#pragma unroll
    for (int r = 0; r < 16; ++r) ps += p0[r];
#pragma unroll
    for (int r = 0; r < 16; ++r) ps += p1[r];
    { auto rr = __builtin_amdgcn_permlane32_swap(__float_as_uint(ps), __float_as_uint(ps), false, false);
      ps = __uint_as_float(rr[0]) + __uint_as_float(rr[1]); }
    l_reg = l_reg * alpha + ps;
#define PK4(P, BASE, OUT) do { unsigned a0 = cvt_pk_bf16(P[BASE + 0], P[BASE + 1]), a1 = cvt_pk_bf16(P[BASE + 2], P[BASE + 3]);   \
    unsigned b0 = cvt_pk_bf16(P[BASE + 4], P[BASE + 5]), b1 = cvt_pk_bf16(P[BASE + 6], P[BASE + 7]);                              \
    auto r0 = __builtin_amdgcn_permlane32_swap(a0, b0, false, false); auto r1 = __builtin_amdgcn_permlane32_swap(a1, b1, false, false); \
    u32x4 w = {r0[0], r1[0], r0[1], r1[1]}; OUT = *reinterpret_cast<bf16x8*>(&w); } while (0)
    PK4(p0, 0, pa0); PK4(p0, 8, pa1); PK4(p1, 0, pa2); PK4(p1, 8, pa3);
#undef PK4
}
__device__ __forceinline__ void qkt(f32x16& p0, f32x16& p1, const LAS char* Ks, const bf16x8 (&qr)[8], const LAS char* qrope, int r32, int hi) {
    p0 = f32x16{}; p1 = f32x16{};
    const LAS char* k0 = Ks + r32 * KPITCH + hi * 16;
#pragma unroll
    for (int d0 = 0; d0 < 8; ++d0) {
        const bf16x8 b0 = *(const LAS bf16x8*)(k0 + d0 * 32);
        const bf16x8 b1 = *(const LAS bf16x8*)(k0 + 32 * KPITCH + d0 * 32);
        p0 = __builtin_amdgcn_mfma_f32_32x32x16_bf16(b0, qr[d0], p0, 0, 0, 0);
        p1 = __builtin_amdgcn_mfma_f32_32x32x16_bf16(b1, qr[d0], p1, 0, 0, 0); }
#pragma unroll
    for (int d0 = 8; d0 < 12; ++d0) {
        const bf16x8 b0 = *(const LAS bf16x8*)(k0 + d0 * 32);
        const bf16x8 b1 = *(const LAS bf16x8*)(k0 + 32 * KPITCH + d0 * 32);
        const bf16x8 qf = *(const LAS bf16x8*)(qrope + (d0 - 8) * 32);
        p0 = __builtin_amdgcn_mfma_f32_32x32x16_bf16(b0, qf, p0, 0, 0, 0);
        p1 = __builtin_amdgcn_mfma_f32_32x32x16_bf16(b1, qf, p1, 0, 0, 0); }
}
__device__ __forceinline__ int v_st(int k, int c) { const int kk = (k & ~0xC) | ((k & 4) << 1) | ((k & 8) >> 1); return ((kk >> 3) * 4 + (c >> 5)) * 512 + ((kk & 7) * 32 + (c & 31)) * 2; }
__device__ __forceinline__ int v_rd_base(int lane) { return ((lane & 3) << 3) | (((lane >> 2) & 3) << 6) | (((lane >> 4) & 1) << 5) | (((lane >> 5) & 1) << 8); }
constexpr int v_rd_off(int d0, int ks, int half) { return d0 * 512 + ks * 4096 + half * 2048; }
template <int OFF> __device__ __forceinline__ s16x4 tr_read(int vb) {
    s16x4 r; asm volatile("ds_read_b64_tr_b16 %0, %1 offset:%2" : "=&v"(r) : "v"(vb), "i"(OFF) : "memory"); return r;
}
template <int D0> __device__ __forceinline__ void pv_one(f32x16& od, int vb, bf16x8 pa0, bf16x8 pa1, bf16x8 pa2, bf16x8 pa3) {
    const s16x4 l0 = tr_read<v_rd_off(D0, 0, 0)>(vb), h0 = tr_read<v_rd_off(D0, 0, 1)>(vb), l1 = tr_read<v_rd_off(D0, 1, 0)>(vb), h1 = tr_read<v_rd_off(D0, 1, 1)>(vb);
    const s16x4 l2 = tr_read<v_rd_off(D0, 2, 0)>(vb), h2 = tr_read<v_rd_off(D0, 2, 1)>(vb), l3 = tr_read<v_rd_off(D0, 3, 0)>(vb), h3 = tr_read<v_rd_off(D0, 3, 1)>(vb);
    asm volatile("s_waitcnt lgkmcnt(0)" ::: "memory"); SBAR();
#define PK(L, H) (bf16x8){L[0], L[1], L[2], L[3], H[0], H[1], H[2], H[3]}
    od = __builtin_amdgcn_mfma_f32_32x32x16_bf16(pa0, PK(l0, h0), od, 0, 0, 0);
    od = __builtin_amdgcn_mfma_f32_32x32x16_bf16(pa1, PK(l1, h1), od, 0, 0, 0);
    od = __builtin_amdgcn_mfma_f32_32x32x16_bf16(pa2, PK(l2, h2), od, 0, 0, 0);
    od = __builtin_amdgcn_mfma_f32_32x32x16_bf16(pa3, PK(l3, h3), od, 0, 0, 0);
#undef PK
}
__device__ __forceinline__ void pv_d0(f32x16 (&o)[4], int vb, bf16x8 pa0, bf16x8 pa1, bf16x8 pa2, bf16x8 pa3) {
    pv_one<0>(o[0], vb, pa0, pa1, pa2, pa3); pv_one<1>(o[1], vb, pa0, pa1, pa2, pa3); pv_one<2>(o[2], vb, pa0, pa1, pa2, pa3); pv_one<3>(o[3], vb, pa0, pa1, pa2, pa3);
}
__device__ __forceinline__ float bflo(unsigned w) { return __uint_as_float(w << 16); }
__device__ __forceinline__ float bfhi(unsigned w) { return __uint_as_float(w & 0xffff0000u); }

struct AttnArgs { const bf16_t* lat; const bf16_t* wqn; const bf16_t* Q; const bf16_t* Kb; const bf16_t* Vb; const float* ssp; const float2* cs; const float* q_g; const bf16_t *u, *gb, *sg; const float* conv_w; bf16_t* merged; };

template <int MODE> __device__ __forceinline__ void attn_unit(const AttnArgs& T, int b, int h, int qb, LAS char* lds) {
    int tid = threadIdx.x; asm volatile("" : "+v"(tid));
    const int lane = tid & 63, r32 = lane & 31, hi = lane >> 5; const int wid = __builtin_amdgcn_readfirstlane(tid >> 6);
    LAS char* V_lds = lds + OFF_V; LAS char* K_lds = lds + OFF_K;
    LAS float* ws = (LAS float*)(lds + OFF_WS) + wid * 64; LAS float* li_l = ws; LAS float* al_l = ws + 32;
    const int mrow = b * SEQ + qb * 256 + wid * QBLK + r32;
    const bf16_t* Kh = T.Kb + (size_t)(b * NH + h) * SEQ * QKH; const bf16_t* Vh = T.Vb + (size_t)(b * NH + h) * SEQ * VH;
    const int sr = tid >> 4, sc = (tid & 15) * 8, vst0 = v_st(sr, sc), vst1 = v_st(32 + sr, sc);
    const int kdst = (tid >> 3) * KPITCH + (tid & 7) * 48;
    const int vb0 = (int)(uintptr_t)V_lds + v_rd_base(lane);
    bf16x8 sk0, sk1, sk2, sv0, sv1;
#define SLOAD(t) do { const bf16_t* kp = Kh + (size_t)(t) * KVBLK * QKH + tid * 24; sk0 = *(const bf16x8*)kp; sk1 = *(const bf16x8*)(kp + 8); sk2 = *(const bf16x8*)(kp + 16); \
    const bf16_t* vp = Vh + (size_t)((t) * KVBLK + sr) * VH + sc; sv0 = *(const bf16x8*)vp; sv1 = *(const bf16x8*)(vp + 32 * VH); } while (0)
#define SWRITE(bf) do { *(LAS bf16x8*)(V_lds + (bf) * SHM_V + vst0) = sv0; *(LAS bf16x8*)(V_lds + (bf) * SHM_V + vst1) = sv1; \
    *(LAS bf16x8*)(K_lds + (bf) * SHM_K + kdst) = sk0; *(LAS bf16x8*)(K_lds + (bf) * SHM_K + kdst + 16) = sk1; *(LAS bf16x8*)(K_lds + (bf) * SHM_K + kdst + 32) = sk2; } while (0)
#define RESC(a) do { if (__any((a) < 1.f)) { if (hi == 0) al_l[r32] = (a); asm volatile("s_waitcnt lgkmcnt(0)" ::: "memory"); \
    _Pragma("unroll") for (int d = 0; d < 4; ++d) _Pragma("unroll") for (int r = 0; r < 16; ++r) o[d][r] *= al_l[crow(r, hi)]; } } while (0)
    SLOAD(0);
    bf16x8 qr[8];
    LAS char* qrope = lds + OFF_QR + wid * (32 * QRP) + r32 * QRP + hi * 16;
    {
        const bf16_t* Qw = T.Q + (size_t)mrow * 1536 + h * QKH + hi * 8;
        u32x4 raw[12];
#pragma unroll
        for (int d0 = 0; d0 < 12; ++d0) raw[d0] = *(const u32x4*)(Qw + d0 * 16);
        const f32x2 sq2 = *(const f32x2*)(T.ssp + (size_t)mrow * 4); const float ssq = sq2[0] + sq2[1];
        float ss = 0.f;
#pragma unroll
        for (int d0 = 0; d0 < 12; ++d0)
#pragma unroll
            for (int e = 0; e < 4; ++e) { const float a = bflo(raw[d0][e]), c = bfhi(raw[d0][e]); ss += a * a + c * c; }
        { auto rr = __builtin_amdgcn_permlane32_swap(__float_as_uint(ss), __float_as_uint(ss), false, false); ss = __uint_as_float(rr[0]) + __uint_as_float(rr[1]); }
        const float rq2 = 1.f / (ssq * (1.f / QL) + EPS);
        const float rn = 1.f / sqrtf(ss * rq2 * (1.f / QKH) + EPS) * sqrtf(rq2);
#pragma unroll
        for (int d0 = 0; d0 < 8; ++d0) { const f32x4 g0 = *(const f32x4*)(T.q_g + d0 * 16 + hi * 8), g1 = *(const f32x4*)(T.q_g + d0 * 16 + hi * 8 + 4);
            u32x4 w; w.x = cvt_pk_bf16(bflo(raw[d0].x) * rn * g0[0], bfhi(raw[d0].x) * rn * g0[1]); w.y = cvt_pk_bf16(bflo(raw[d0].y) * rn * g0[2], bfhi(raw[d0].y) * rn * g0[3]);
            w.z = cvt_pk_bf16(bflo(raw[d0].z) * rn * g1[0], bfhi(raw[d0].z) * rn * g1[1]); w.w = cvt_pk_bf16(bflo(raw[d0].w) * rn * g1[2], bfhi(raw[d0].w) * rn * g1[3]);
            qr[d0] = *reinterpret_cast<bf16x8*>(&w); }
#pragma unroll
        for (int p = 0; p < 2; ++p) {
            const int ib = 16 * p + 8 * hi;
            float x1[8], x2[8];
            const f32x4 ga = *(const f32x4*)(T.q_g + 128 + ib), gb_ = *(const f32x4*)(T.q_g + 128 + ib + 4), gc = *(const f32x4*)(T.q_g + 160 + ib), gd = *(const f32x4*)(T.q_g + 160 + ib + 4);
            const float g1v[8] = {ga[0], ga[1], ga[2], ga[3], gb_[0], gb_[1], gb_[2], gb_[3]}, g2v[8] = {gc[0], gc[1], gc[2], gc[3], gd[0], gd[1], gd[2], gd[3]};
#pragma unroll
            for (int e = 0; e < 4; ++e) { x1[2 * e] = bflo(raw[8 + p][e]) * rn * g1v[2 * e]; x1[2 * e + 1] = bfhi(raw[8 + p][e]) * rn * g1v[2 * e + 1];
                                          x2[2 * e] = bflo(raw[10 + p][e]) * rn * g2v[2 * e]; x2[2 * e + 1] = bfhi(raw[10 + p][e]) * rn * g2v[2 * e + 1]; }
            float y1[8], y2[8];
#pragma unroll
            for (int jj = 0; jj < 4; ++jj) { const f32x4 c2 = *(const f32x4*)((const float*)T.cs + ((size_t)mrow * 32 + ib + 2 * jj) * 2);
                y1[2 * jj] = x1[2 * jj] * c2[0] - x2[2 * jj] * c2[1]; y2[2 * jj] = x2[2 * jj] * c2[0] + x1[2 * jj] * c2[1];
                y1[2 * jj + 1] = x1[2 * jj + 1] * c2[2] - x2[2 * jj + 1] * c2[3]; y2[2 * jj + 1] = x2[2 * jj + 1] * c2[2] + x1[2 * jj + 1] * c2[3]; }
            u32x4 w1, w2; w1.x = cvt_pk_bf16(y1[0], y1[1]); w1.y = cvt_pk_bf16(y1[2], y1[3]); w1.z = cvt_pk_bf16(y1[4], y1[5]); w1.w = cvt_pk_bf16(y1[6], y1[7]);
            w2.x = cvt_pk_bf16(y2[0], y2[1]); w2.y = cvt_pk_bf16(y2[2], y2[3]); w2.z = cvt_pk_bf16(y2[4], y2[5]); w2.w = cvt_pk_bf16(y2[6], y2[7]);
            *(LAS u32x4*)(qrope + p * 32) = w1; *(LAS u32x4*)(qrope + (2 + p) * 32) = w2; }
        asm volatile("s_waitcnt lgkmcnt(0)" ::: "memory");
    }
    float m_reg = -1e30f, l_reg = 0.f; f32x16 o[4] = {};
    f32x16 pA0, pA1, pB0, pB1; float alA = 1.f, alB = 1.f; bf16x8 pa0, pa1, pa2, pa3;
    const int NT = 4 * qb + 4; const int wp = wid >> 1;
    const bool a1 = wp >= 1, a2 = wp >= 2, a3 = wp >= 3;
    const LAS char* K0 = K_lds; const LAS char* K1 = K_lds + SHM_K;
    asm volatile("s_waitcnt vmcnt(0)" ::: "memory"); SWRITE(0); __syncthreads();
    qkt(pA0, pA1, K0, qr, qrope, r32, hi); partialSM(pA0, pA1, m_reg, alA);
    SLOAD(1); asm volatile("s_waitcnt vmcnt(0)" ::: "memory"); SWRITE(1); __syncthreads();
    for (int j = 1; j + 3 < NT; j += 2) {
        SBAR(); qkt(pB0, pB1, K1, qr, qrope, r32, hi);
        finishSM(pA0, pA1, alA, l_reg, pa0, pa1, pa2, pa3); SBAR();
        SLOAD(j + 1); SBAR();
        pv_d0(o, vb0, pa0, pa1, pa2, pa3); partialSM(pB0, pB1, m_reg, alB);
        __syncthreads(); asm volatile("s_waitcnt vmcnt(0)" ::: "memory"); SWRITE(0);
        RESC(alB); __syncthreads();
        SBAR(); qkt(pA0, pA1, K0, qr, qrope, r32, hi);
        finishSM(pB0, pB1, alB, l_reg, pa0, pa1, pa2, pa3); SBAR();
        SLOAD(j + 2); SBAR();
        pv_d0(o, vb0 + SHM_V, pa0, pa1, pa2, pa3); partialSM(pA0, pA1, m_reg, alA);
        __syncthreads(); asm volatile("s_waitcnt vmcnt(0)" ::: "memory"); SWRITE(1);
        RESC(alA); __syncthreads();
    }
#define MASK(P0, P1, act) do { if (!(act)) { _Pragma("unroll") for (int r = 0; r < 16; ++r) { P0[r] = -INFINITY; P1[r] = -INFINITY; } } } while (0)
    {
        SBAR(); if (a1) qkt(pB0, pB1, K1, qr, qrope, r32, hi); MASK(pB0, pB1, a1);
        finishSM(pA0, pA1, alA, l_reg, pa0, pa1, pa2, pa3); SBAR();
        SLOAD(NT - 2); SBAR();
        pv_d0(o, vb0, pa0, pa1, pa2, pa3); partialSM(pB0, pB1, m_reg, alB);
        __syncthreads(); asm volatile("s_waitcnt vmcnt(0)" ::: "memory"); SWRITE(0);
        RESC(alB); __syncthreads();
        SBAR(); if (a2) qkt(pA0, pA1, K0, qr, qrope, r32, hi); MASK(pA0, pA1, a2);
        finishSM(pB0, pB1, alB, l_reg, pa0, pa1, pa2, pa3); SBAR();
        SLOAD(NT - 1); SBAR();
        pv_d0(o, vb0 + SHM_V, pa0, pa1, pa2, pa3); partialSM(pA0, pA1, m_reg, alA);
        __syncthreads(); asm volatile("s_waitcnt vmcnt(0)" ::: "memory"); SWRITE(1);
        RESC(alA); __syncthreads();
        SBAR(); if (a3) qkt(pB0, pB1, K1, qr, qrope, r32, hi); MASK(pB0, pB1, a3);
        finishSM(pA0, pA1, alA, l_reg, pa0, pa1, pa2, pa3); SBAR();
        pv_d0(o, vb0, pa0, pa1, pa2, pa3); partialSM(pB0, pB1, m_reg, alB);
        RESC(alB);
        finishSM(pB0, pB1, alB, l_reg, pa0, pa1, pa2, pa3); SBAR();
        pv_d0(o, vb0 + SHM_V, pa0, pa1, pa2, pa3);
    }
#undef MASK
    if (hi == 0) li_l[r32] = l_reg; asm volatile("s_waitcnt lgkmcnt(0)" ::: "memory");
    float rli[16];
#pragma unroll
    for (int r = 0; r < 16; ++r) rli[r] = __builtin_amdgcn_rcpf(li_l[crow(r, hi)]);
    __syncthreads();
    LAS bf16_t* stg = (LAS bf16_t*)(lds + wid * 8192);
#pragma unroll
    for (int r = 0; r < 16; ++r) { const int orow = crow(r, hi);
#pragma unroll
        for (int d0 = 0; d0 < 4; ++d0) stg[orow * 128 + d0 * 32 + r32] = f2bf(o[d0][r] * rli[r]); }
    asm volatile("s_waitcnt lgkmcnt(0)" ::: "memory");
    if (MODE != 1) {
        const int ch = lane & 15, c = h * VH + ch * 8;
        const f32x4 w0a = *(const f32x4*)(T.conv_w + c), w0b = *(const f32x4*)(T.conv_w + c + 4), w1a = *(const f32x4*)(T.conv_w + DM + c), w1b = *(const f32x4*)(T.conv_w + DM + c + 4),
              w2a = *(const f32x4*)(T.conv_w + 2 * DM + c), w2b = *(const f32x4*)(T.conv_w + 2 * DM + c + 4);
        const float cw0[8] = {w0a[0], w0a[1], w0a[2], w0a[3], w0b[0], w0b[1], w0b[2], w0b[3]}, cw1[8] = {w1a[0], w1a[1], w1a[2], w1a[3], w1b[0], w1b[1], w1b[2], w1b[3]},
                    cw2[8] = {w2a[0], w2a[1], w2a[2], w2a[3], w2b[0], w2b[1], w2b[2], w2b[3]};
#pragma unroll 4
        for (int i = 0; i < 8; ++i) { const int row = i * 4 + (lane >> 4); const int tt = qb * 256 + wid * QBLK + row; const size_t e = (size_t)(b * SEQ + tt) * DM + c;
            const u32x4 ov = *(const LAS u32x4*)(stg + row * 128 + ch * 8);
            const u32x4 u0 = *(const u32x4*)(T.u + e), gbv = *(const u32x4*)(T.gb + e), sgv = *(const u32x4*)(T.sg + e);
            u32x4 u1 = {0u, 0u, 0u, 0u}, u2 = {0u, 0u, 0u, 0u};
            if (tt >= 1) u1 = *(const u32x4*)(T.u + e - DM);
            if (tt >= 2) u2 = *(const u32x4*)(T.u + e - 2 * DM);
            u32x4 res;
#pragma unroll
            for (int q = 0; q < 4; ++q) {
                const float cl = cw0[2 * q] * bflo(u2[q]) + cw1[2 * q] * bflo(u1[q]) + cw2[2 * q] * bflo(u0[q]), chh = cw0[2 * q + 1] * bfhi(u2[q]) + cw1[2 * q + 1] * bfhi(u1[q]) + cw2[2 * q + 1] * bfhi(u0[q]);
                res[q] = cvt_pk_bf16(bflo(gbv[q]) * cl + bflo(sgv[q]) * bflo(ov[q]), bfhi(gbv[q]) * chh + bfhi(sgv[q]) * bfhi(ov[q])); }
            *(u32x4*)(T.merged + e) = res; }
    }
    asm volatile("s_waitcnt lgkmcnt(0)" ::: "memory");
    __syncthreads();
#undef SLOAD
#undef SWRITE
#undef RESC
}

constexpr int K2_BYTES = KVBLK * QKH * 2, V2_OFF = 0, K2_OFF = 3 * SHM_V, WS2_OFF = K2_OFF + 2 * K2_BYTES, ATT2_LDS = WS2_OFF + NW * 64 * 4;
__device__ __forceinline__ void qkt2(f32x16& p0, f32x16& p1, const LAS char* Krow, const int (&koff)[4], const bf16x8 (&qr)[12]) {
    p0 = f32x16{}; p1 = f32x16{};
    bf16x8 fa[4], fb[4];
#define KRD(dst, d0) do { const LAS char* a_ = Krow + ((d0) >> 2) * 128 + koff[(d0) & 3]; dst[0] = *(const LAS bf16x8*)a_; dst[1] = *(const LAS bf16x8*)(a_ + 32 * QKH * 2); \
                          const LAS char* c_ = Krow + (((d0) + 1) >> 2) * 128 + koff[((d0) + 1) & 3]; dst[2] = *(const LAS bf16x8*)c_; dst[3] = *(const LAS bf16x8*)(c_ + 32 * QKH * 2); } while (0)
#define KMM(src, d0) do { p0 = __builtin_amdgcn_mfma_f32_32x32x16_bf16(src[0], qr[d0], p0, 0, 0, 0); p1 = __builtin_amdgcn_mfma_f32_32x32x16_bf16(src[1], qr[d0], p1, 0, 0, 0); \
                          p0 = __builtin_amdgcn_mfma_f32_32x32x16_bf16(src[2], qr[(d0) + 1], p0, 0, 0, 0); p1 = __builtin_amdgcn_mfma_f32_32x32x16_bf16(src[3], qr[(d0) + 1], p1, 0, 0, 0); } while (0)
    KRD(fa, 0); KRD(fb, 2);
    KMM(fa, 0); KRD(fa, 4);
    KMM(fb, 2); KRD(fb, 6);
    KMM(fa, 4); KRD(fa, 8);
    KMM(fb, 6); KRD(fb, 10);
    KMM(fa, 8);
    KMM(fb, 10);
#undef KRD
#undef KMM
}
template <int MODE> __device__ __forceinline__ void attn_unit2(const AttnArgs& T, int b, int h, int qb, LAS char* lds) {
    int tid = threadIdx.x; asm volatile("" : "+v"(tid));
    const int lane = tid & 63, r32 = lane & 31, hi = lane >> 5; const int wid = __builtin_amdgcn_readfirstlane(tid >> 6);
    LAS char* V_lds = lds + V2_OFF; LAS char* K_lds = lds + K2_OFF;
    LAS float* ws = (LAS float*)(lds + WS2_OFF) + wid * 64; LAS float* li_l = ws; LAS float* al_l = ws + 32;
    const int mrow = b * SEQ + qb * 256 + wid * QBLK + r32;
    const char* Kh = (const char*)(T.Kb + (size_t)(b * NH + h) * SEQ * QKH); const char* Vh = (const char*)(T.Vb + (size_t)(b * NH + h) * SEQ * VH);
#define DMA_KV(t, kbuf, vbuf) do { const char* kt = Kh + (size_t)(t) * K2_BYTES; const char* vt = Vh + (size_t)(t) * SHM_V; int ln = lane; asm volatile("" : "+v"(ln)); \
    _Pragma("unroll") for (int _i = 0; _i < 3; ++_i) { const int q = (wid * 3 + _i) * 64 + ln, r = q / 24, cp = q - r * 24, c = (cp & ~7) | ((cp & 7) ^ ((r >> 1) & 7)); \
        __builtin_amdgcn_global_load_lds((const unsigned*)(kt + (unsigned)(r * 384 + c * 16)), (LAS unsigned*)(K_lds + (kbuf) * K2_BYTES + (wid * 3 + _i) * 1024), 16, 0, 0); } \
    _Pragma("unroll") for (int _i = 0; _i < 2; ++_i) { const int q = (wid * 2 + _i) * 64 + ln, sub = q >> 5, w = q & 31, kk = ((sub >> 2) << 3) | (w >> 2), k = (kk & ~0xC) | ((kk & 4) << 1) | ((kk & 8) >> 1), c = ((sub & 3) << 5) | ((w & 3) << 3); \
        __builtin_amdgcn_global_load_lds((const unsigned*)(vt + (unsigned)(k * 256 + c * 2)), (LAS unsigned*)(V_lds + (vbuf) * SHM_V + (wid * 2 + _i) * 1024), 16, 0, 0); } } while (0)
#define RESC(a) do { if (__any((a) < 1.f)) { if (hi == 0) al_l[r32] = (a); asm volatile("s_waitcnt lgkmcnt(0)" ::: "memory"); \
    _Pragma("unroll") for (int d = 0; d < 4; ++d) _Pragma("unroll") for (int r = 0; r < 16; ++r) o[d][r] *= al_l[crow(r, hi)]; } } while (0)
    DMA_KV(0, 0, 0);
    const int vb0 = (int)(uintptr_t)V_lds + v_rd_base(lane);
    const LAS char* Krow = K_lds + r32 * (QKH * 2);
    int koff[4];
    { const int sw = (r32 >> 1) & 7;
#pragma unroll
      for (int j = 0; j < 4; ++j) koff[j] = ((2 * j + hi) ^ sw) * 16; }
    bf16x8 qr[12];
    {
        const bf16_t* Qw = T.Q + (size_t)mrow * 1536 + h * QKH + hi * 8;
        u32x4 raw[12];
#pragma unroll
        for (int d0 = 0; d0 < 12; ++d0) raw[d0] = *(const u32x4*)(Qw + d0 * 16);
        const f32x2 sq2 = *(const f32x2*)(T.ssp + (size_t)mrow * 4); const float ssq = sq2[0] + sq2[1];
        float ss = 0.f;
#pragma unroll
        for (int d0 = 0; d0 < 12; ++d0)
#pragma unroll
            for (int e = 0; e < 4; ++e) { const float a = bflo(raw[d0][e]), c = bfhi(raw[d0][e]); ss += a * a + c * c; }
        { auto rr = __builtin_amdgcn_permlane32_swap(__float_as_uint(ss), __float_as_uint(ss), false, false); ss = __uint_as_float(rr[0]) + __uint_as_float(rr[1]); }
        const float rq2 = 1.f / (ssq * (1.f / QL) + EPS);
        const float rn = 1.f / sqrtf(ss * rq2 * (1.f / QKH) + EPS) * sqrtf(rq2);
#pragma unroll
        for (int d0 = 0; d0 < 8; ++d0) { const f32x4 g0 = *(const f32x4*)(T.q_g + d0 * 16 + hi * 8), g1 = *(const f32x4*)(T.q_g + d0 * 16 + hi * 8 + 4);
            u32x4 w; w.x = cvt_pk_bf16(bflo(raw[d0].x) * rn * g0[0], bfhi(raw[d0].x) * rn * g0[1]); w.y = cvt_pk_bf16(bflo(raw[d0].y) * rn * g0[2], bfhi(raw[d0].y) * rn * g0[3]);
            w.z = cvt_pk_bf16(bflo(raw[d0].z) * rn * g1[0], bfhi(raw[d0].z) * rn * g1[1]); w.w = cvt_pk_bf16(bflo(raw[d0].w) * rn * g1[2], bfhi(raw[d0].w) * rn * g1[3]);
            qr[d0] = *reinterpret_cast<bf16x8*>(&w); }
#pragma unroll
        for (int p = 0; p < 2; ++p) {
            const int ib = 16 * p + 8 * hi;
            float x1[8], x2[8];
            const f32x4 ga = *(const f32x4*)(T.q_g + 128 + ib), gb_ = *(const f32x4*)(T.q_g + 128 + ib + 4), gc = *(const f32x4*)(T.q_g + 160 + ib), gd = *(const f32x4*)(T.q_g + 160 + ib + 4);
            const float g1v[8] = {ga[0], ga[1], ga[2], ga[3], gb_[0], gb_[1], gb_[2], gb_[3]}, g2v[8] = {gc[0], gc[1], gc[2], gc[3], gd[0], gd[1], gd[2], gd[3]};
#pragma unroll
            for (int e = 0; e < 4; ++e) { x1[2 * e] = bflo(raw[8 + p][e]) * rn * g1v[2 * e]; x1[2 * e + 1] = bfhi(raw[8 + p][e]) * rn * g1v[2 * e + 1];
                                          x2[2 * e] = bflo(raw[10 + p][e]) * rn * g2v[2 * e]; x2[2 * e + 1] = bfhi(raw[10 + p][e]) * rn * g2v[2 * e + 1]; }
            float y1[8], y2[8];
#pragma unroll
            for (int jj = 0; jj < 4; ++jj) { const f32x4 c2 = *(const f32x4*)((const float*)T.cs + ((size_t)mrow * 32 + ib + 2 * jj) * 2);
                y1[2 * jj] = x1[2 * jj] * c2[0] - x2[2 * jj] * c2[1]; y2[2 * jj] = x2[2 * jj] * c2[0] + x1[2 * jj] * c2[1];
                y1[2 * jj + 1] = x1[2 * jj + 1] * c2[2] - x2[2 * jj + 1] * c2[3]; y2[2 * jj + 1] = x2[2 * jj + 1] * c2[2] + x1[2 * jj + 1] * c2[3]; }
            u32x4 w1, w2; w1.x = cvt_pk_bf16(y1[0], y1[1]); w1.y = cvt_pk_bf16(y1[2], y1[3]); w1.z = cvt_pk_bf16(y1[4], y1[5]); w1.w = cvt_pk_bf16(y1[6], y1[7]);
            w2.x = cvt_pk_bf16(y2[0], y2[1]); w2.y = cvt_pk_bf16(y2[2], y2[3]); w2.z = cvt_pk_bf16(y2[4], y2[5]); w2.w = cvt_pk_bf16(y2[6], y2[7]);
            qr[8 + p] = *reinterpret_cast<bf16x8*>(&w1); qr[10 + p] = *reinterpret_cast<bf16x8*>(&w2); }
    }
    float m_reg = -1e30f, l_reg = 0.f; f32x16 o[4] = {};
    f32x16 pA0, pA1, pB0, pB1; float alA = 1.f, alB = 1.f; bf16x8 pa0, pa1, pa2, pa3;
    const int NT = 4 * qb + 4; const int wp = wid >> 1;
    const bool a1 = wp >= 1, a2 = wp >= 2, a3 = wp >= 3;
#define MASK(P0, P1, act) do { if (!(act)) { _Pragma("unroll") for (int r = 0; r < 16; ++r) { P0[r] = -INFINITY; P1[r] = -INFINITY; } } } while (0)
#define INTERVAL(PN0, PN1, PO0, PO1, alN, alO, t, act, load) do { \
        if (load) DMA_KV((t) + 1, ((t) + 1) & 1, vnext); \
        SBAR(); if (act) qkt2(PN0, PN1, Krow + ((t) & 1) * K2_BYTES, koff, qr); MASK(PN0, PN1, act); \
        if (MODE == 2) { asm volatile("" : "+v"(PO0), "+v"(PO1)); pa0 = __builtin_bit_cast(bf16x8, (u32x4){__float_as_uint(PO0[0]), __float_as_uint(PO0[1]), __float_as_uint(PO0[2]), __float_as_uint(PO0[3])}); pa1 = pa0; pa2 = pa0; pa3 = pa0; } \
        else finishSM(PO0, PO1, alO, l_reg, pa0, pa1, pa2, pa3); \
        SBAR(); pv_d0(o, vb0 + vprev * SHM_V, pa0, pa1, pa2, pa3); if (MODE == 2) { asm volatile("" : "+v"(PN0), "+v"(PN1)); } else partialSM(PN0, PN1, m_reg, alN); \
        __syncthreads(); RESC(alN); \
        vprev = vcur; vcur = vnext; vnext = (vnext == 2) ? 0 : vnext + 1; } while (0)
    __syncthreads();
    int vprev = 0, vcur = 1, vnext = 2;
    DMA_KV(1, 1, 1);
    qkt2(pA0, pA1, Krow, koff, qr); partialSM(pA0, pA1, m_reg, alA);
    __syncthreads();
    for (int j = 1; j + 3 < NT; j += 2) {
        INTERVAL(pB0, pB1, pA0, pA1, alB, alA, j, true, true);
        INTERVAL(pA0, pA1, pB0, pB1, alA, alB, j + 1, true, true);
    }
    INTERVAL(pB0, pB1, pA0, pA1, alB, alA, NT - 3, a1, true);
    INTERVAL(pA0, pA1, pB0, pB1, alA, alB, NT - 2, a2, true);
    INTERVAL(pB0, pB1, pA0, pA1, alB, alA, NT - 1, a3, false);
    finishSM(pB0, pB1, alB, l_reg, pa0, pa1, pa2, pa3); SBAR();
    pv_d0(o, vb0 + vprev * SHM_V, pa0, pa1, pa2, pa3);
#undef INTERVAL
#undef MASK
    if (hi == 0) li_l[r32] = l_reg; asm volatile("s_waitcnt lgkmcnt(0)" ::: "memory");
    float rli[16];
#pragma unroll
    for (int r = 0; r < 16; ++r) rli[r] = __builtin_amdgcn_rcpf(li_l[crow(r, hi)]);
    __syncthreads();
    LAS bf16_t* stg = (LAS bf16_t*)(lds + wid * 8192);
#pragma unroll
    for (int r = 0; r < 16; ++r) { const int orow = crow(r, hi);
#pragma unroll
        for (int d0 = 0; d0 < 4; ++d0) stg[orow * 128 + d0 * 32 + r32] = f2bf(o[d0][r] * rli[r]); }
    asm volatile("s_waitcnt lgkmcnt(0)" ::: "memory");
    if (MODE == 0) {
        const int g = lane >> 4, ch = lane & 15, c = h * VH + ch * 8; const int t0 = qb * 256 + wid * QBLK;
        const size_t e0 = (size_t)(b * SEQ + t0) * DM + c;
        u32x4 uu[8], gv[8], sv[8];
#pragma unroll
        for (int i = 0; i < 8; ++i) { const size_t e = e0 + (size_t)(4 * i + g) * DM; uu[i] = *(const u32x4*)(T.u + e); gv[i] = __builtin_nontemporal_load((const u32x4*)(T.gb + e)); sv[i] = __builtin_nontemporal_load((const u32x4*)(T.sg + e)); }
        u32x4 uvirt = {0u, 0u, 0u, 0u};
        if (g >= 2 && t0 > 0) uvirt = *(const u32x4*)(T.u + e0 - (size_t)(4 - g) * DM);
        const f32x4 w0a = *(const f32x4*)(T.conv_w + c), w0b = *(const f32x4*)(T.conv_w + c + 4), w1a = *(const f32x4*)(T.conv_w + DM + c), w1b = *(const f32x4*)(T.conv_w + DM + c + 4),
              w2a = *(const f32x4*)(T.conv_w + 2 * DM + c), w2b = *(const f32x4*)(T.conv_w + 2 * DM + c + 4);
        const float cw0[8] = {w0a[0], w0a[1], w0a[2], w0a[3], w0b[0], w0b[1], w0b[2], w0b[3]}, cw1[8] = {w1a[0], w1a[1], w1a[2], w1a[3], w1b[0], w1b[1], w1b[2], w1b[3]},
                    cw2[8] = {w2a[0], w2a[1], w2a[2], w2a[3], w2b[0], w2b[1], w2b[2], w2b[3]};
        const int src1 = ((lane - 16) & 63) << 2, src2 = (lane ^ 32) << 2;
#pragma unroll
        for (int i = 0; i < 8; ++i) { const int row = i * 4 + g; const size_t e = e0 + (size_t)row * DM;
            const u32x4 ov = *(const LAS u32x4*)(stg + row * 128 + ch * 8);
            const u32x4 up = (i == 0) ? uvirt : uu[i > 0 ? i - 1 : 0];
            u32x4 u1, u2, res;
#pragma unroll
            for (int q = 0; q < 4; ++q) { const unsigned x1 = (g == 3) ? up[q] : uu[i][q], x2 = (g >= 2) ? up[q] : uu[i][q];
                u1[q] = (unsigned)__builtin_amdgcn_ds_bpermute(src1, (int)x1); u2[q] = (unsigned)__builtin_amdgcn_ds_bpermute(src2, (int)x2); }
#pragma unroll
            for (int q = 0; q < 4; ++q) {
                const float cl = cw0[2 * q] * bflo(u2[q]) + cw1[2 * q] * bflo(u1[q]) + cw2[2 * q] * bflo(uu[i][q]), chh = cw0[2 * q + 1] * bfhi(u2[q]) + cw1[2 * q + 1] * bfhi(u1[q]) + cw2[2 * q + 1] * bfhi(uu[i][q]);
                res[q] = cvt_pk_bf16(bflo(gv[i][q]) * cl + bflo(sv[i][q]) * bflo(ov[q]), bfhi(gv[i][q]) * chh + bfhi(sv[i][q]) * bfhi(ov[q])); }
            *(u32x4*)(T.merged + e) = res; }
    }
    asm volatile("s_waitcnt lgkmcnt(0)" ::: "memory");
    __syncthreads();
#undef DMA_KV
#undef RESC
}
template <int MODE> __device__ __forceinline__ void attn_unit3(const AttnArgs& T, int b, int h, int qb, LAS char* lds) {
    int tid = threadIdx.x; asm volatile("" : "+v"(tid));
    const int lane = tid & 63, r32 = lane & 31, hi = lane >> 5; const int wid = __builtin_amdgcn_readfirstlane(tid >> 6);
    LAS char* V_lds = lds + V2_OFF; LAS char* K_lds = lds + K2_OFF;
    LAS float* ws = (LAS float*)(lds + WS2_OFF) + wid * 64; LAS float* li_l = ws; LAS float* al_l = ws + 32;
    const int mrow = b * SEQ + qb * 256 + wid * QBLK + r32;
    const char* Kh = (const char*)(T.Kb + (size_t)(b * NH + h) * SEQ * QKH); const char* Vh = (const char*)(T.Vb + (size_t)(b * NH + h) * SEQ * VH);
#define DMA_KV(t, kbuf, vbuf) do { const char* kt = Kh + (size_t)(t) * K2_BYTES; const char* vt = Vh + (size_t)(t) * SHM_V; int ln = lane; asm volatile("" : "+v"(ln)); \
    _Pragma("unroll") for (int _i = 0; _i < 3; ++_i) { const int q = (wid * 3 + _i) * 64 + ln, r = q / 24, cp = q - r * 24, c = (cp & ~7) | ((cp & 7) ^ ((r >> 1) & 7)); \
        __builtin_amdgcn_global_load_lds((const unsigned*)(kt + (unsigned)(r * 384 + c * 16)), (LAS unsigned*)(K_lds + (kbuf) * K2_BYTES + (wid * 3 + _i) * 1024), 16, 0, 0); } \
    _Pragma("unroll") for (int _i = 0; _i < 2; ++_i) { const int q = (wid * 2 + _i) * 64 + ln, sub = q >> 5, w = q & 31, kk = ((sub >> 2) << 3) | (w >> 2), k = (kk & ~0xC) | ((kk & 4) << 1) | ((kk & 8) >> 1), c = ((sub & 3) << 5) | ((w & 3) << 3); \
        __builtin_amdgcn_global_load_lds((const unsigned*)(vt + (unsigned)(k * 256 + c * 2)), (LAS unsigned*)(V_lds + (vbuf) * SHM_V + (wid * 2 + _i) * 1024), 16, 0, 0); } } while (0)
#define RESC(a) do { if (__any((a) < 1.f)) { if (hi == 0) al_l[r32] = (a); asm volatile("s_waitcnt lgkmcnt(0)" ::: "memory"); \
    _Pragma("unroll") for (int d = 0; d < 4; ++d) _Pragma("unroll") for (int r = 0; r < 16; ++r) o[d][r] *= al_l[crow(r, hi)]; } } while (0)
    DMA_KV(0, 0, 0);
    const int vb0 = (int)(uintptr_t)V_lds + v_rd_base(lane);
    const LAS char* Krow = K_lds + r32 * (QKH * 2);
    int koff[4];
    { const int sw = (r32 >> 1) & 7;
#pragma unroll
      for (int j = 0; j < 4; ++j) koff[j] = ((2 * j + hi) ^ sw) * 16; }
    bf16x8 qr[12];
    {
        f32x16 X[6];
#pragma unroll
        for (int blk = 0; blk < 6; ++blk) X[blk] = f32x16{};
        const bf16_t* latq = T.lat + (size_t)mrow * LATW + hi * 8;
        const char* wq = (const char*)(T.wqn + (size_t)h * QKH * QL);
        LAS char* wbuf0 = lds + ATT2_LDS; LAS char* wbuf1 = lds + K2_OFF + K2_BYTES; LAS char* wbuf2 = lds + V2_OFF + SHM_V;
        const int sg_ = (r32 & ~0xC) | ((r32 & 4) << 1) | ((r32 & 8) >> 1);
        const int wsw = (sg_ >> 1) & 7;
        int woff[4];
#pragma unroll
        for (int j = 0; j < 4; ++j) woff[j] = sg_ * 128 + (((2 * j + hi) ^ wsw) << 4);
#define DMA_W(c, buf) do { int ln = lane; asm volatile("" : "+v"(ln)); \
    _Pragma("unroll") for (int _i = 0; _i < 3; ++_i) { const int q_ = (wid * 3 + _i) * 64 + ln, row_ = q_ >> 3, cp_ = q_ & 7, cc_ = cp_ ^ ((row_ >> 1) & 7); \
        __builtin_amdgcn_global_load_lds((const unsigned*)(wq + (size_t)row_ * (QL * 2) + (c) * 128 + cc_ * 16), (LAS unsigned*)((buf) + (wid * 3 + _i) * 1024), 16, 0, 0); } } while (0)
#define WBUF(c) (((c) % 3) == 0 ? wbuf0 : ((c) % 3) == 1 ? wbuf1 : wbuf2)
        DMA_W(0, wbuf0); DMA_W(1, wbuf1);
        bf16x8 lf[4];
#pragma unroll
        for (int s4 = 0; s4 < 4; ++s4) lf[s4] = *(const bf16x8*)(latq + 16 * s4);
        __syncthreads();
#pragma unroll
        for (int c = 0; c < 6; ++c) {
            LAS char* wb = WBUF(c);
            if (c < 4) DMA_W(c + 2, WBUF(c + 2));
            bf16x8 ln_[4];
            if (c < 5) {
#pragma unroll
                for (int s4 = 0; s4 < 4; ++s4) ln_[s4] = *(const bf16x8*)(latq + 64 * (c + 1) + 16 * s4); }
#pragma unroll
            for (int blk = 0; blk < 6; ++blk)
#pragma unroll
                for (int s4 = 0; s4 < 4; ++s4) { const bf16x8 wf = *(const LAS bf16x8*)(wb + blk * 4096 + woff[s4]);
                    X[blk] = __builtin_amdgcn_mfma_f32_32x32x16_bf16(wf, lf[s4], X[blk], 0, 0, 0); }
            if (c < 4) asm volatile("s_waitcnt vmcnt(7)" ::: "memory"); else asm volatile("s_waitcnt vmcnt(0)" ::: "memory");
            asm volatile("s_waitcnt lgkmcnt(0)" ::: "memory"); __builtin_amdgcn_s_barrier(); asm volatile("" ::: "memory");
            if (c < 5) {
#pragma unroll
                for (int s4 = 0; s4 < 4; ++s4) lf[s4] = ln_[s4]; }
        }
#undef WBUF
#undef DMA_W
        const f32x2 sq2 = *(const f32x2*)(T.ssp + (size_t)mrow * 4); const float ssq = sq2[0] + sq2[1];
        float ss = 0.f;
#pragma unroll
        for (int blk = 0; blk < 6; ++blk)
#pragma unroll
            for (int r = 0; r < 16; ++r) ss += X[blk][r] * X[blk][r];
        { auto rr = __builtin_amdgcn_permlane32_swap(__float_as_uint(ss), __float_as_uint(ss), false, false); ss = __uint_as_float(rr[0]) + __uint_as_float(rr[1]); }
        const float rq2 = 1.f / (ssq * (1.f / QL) + EPS);
        const float rn = 1.f / sqrtf(ss * rq2 * (1.f / QKH) + EPS) * sqrtf(rq2);
#pragma unroll
        for (int blk = 0; blk < 4; ++blk)
#pragma unroll
            for (int s = 0; s < 2; ++s) { const f32x4 g0 = *(const f32x4*)(T.q_g + 32 * blk + 16 * s + 8 * hi), g1 = *(const f32x4*)(T.q_g + 32 * blk + 16 * s + 8 * hi + 4);
                u32x4 w; w.x = cvt_pk_bf16(X[blk][8 * s + 0] * rn * g0[0], X[blk][8 * s + 1] * rn * g0[1]); w.y = cvt_pk_bf16(X[blk][8 * s + 2] * rn * g0[2], X[blk][8 * s + 3] * rn * g0[3]);
                w.z = cvt_pk_bf16(X[blk][8 * s + 4] * rn * g1[0], X[blk][8 * s + 5] * rn * g1[1]); w.w = cvt_pk_bf16(X[blk][8 * s + 6] * rn * g1[2], X[blk][8 * s + 7] * rn * g1[3]);
                qr[2 * blk + s] = *reinterpret_cast<bf16x8*>(&w); }
#pragma unroll
        for (int s = 0; s < 2; ++s) {
            const int ib = 16 * s + 8 * hi;
            const f32x4 ga = *(const f32x4*)(T.q_g + 128 + ib), gb_ = *(const f32x4*)(T.q_g + 128 + ib + 4), gc = *(const f32x4*)(T.q_g + 160 + ib), gd = *(const f32x4*)(T.q_g + 160 + ib + 4);
            const float g1v[8] = {ga[0], ga[1], ga[2], ga[3], gb_[0], gb_[1], gb_[2], gb_[3]}, g2v[8] = {gc[0], gc[1], gc[2], gc[3], gd[0], gd[1], gd[2], gd[3]};
            float y1[8], y2[8];
#pragma unroll
            for (int jj = 0; jj < 4; ++jj) { const f32x4 c2 = *(const f32x4*)((const float*)T.cs + ((size_t)mrow * 32 + ib + 2 * jj) * 2);
                const float xa = X[4][8 * s + 2 * jj] * rn * g1v[2 * jj], xb = X[5][8 * s + 2 * jj] * rn * g2v[2 * jj], xc = X[4][8 * s + 2 * jj + 1] * rn * g1v[2 * jj + 1], xd = X[5][8 * s + 2 * jj + 1] * rn * g2v[2 * jj + 1];
                y1[2 * jj] = xa * c2[0] - xb * c2[1]; y2[2 * jj] = xb * c2[0] + xa * c2[1];
                y1[2 * jj + 1] = xc * c2[2] - xd * c2[3]; y2[2 * jj + 1] = xd * c2[2] + xc * c2[3]; }
            u32x4 w1, w2; w1.x = cvt_pk_bf16(y1[0], y1[1]); w1.y = cvt_pk_bf16(y1[2], y1[3]); w1.z = cvt_pk_bf16(y1[4], y1[5]); w1.w = cvt_pk_bf16(y1[6], y1[7]);
            w2.x = cvt_pk_bf16(y2[0], y2[1]); w2.y = cvt_pk_bf16(y2[2], y2[3]); w2.z = cvt_pk_bf16(y2[4], y2[5]); w2.w = cvt_pk_bf16(y2[6], y2[7]);
            qr[8 + s] = *reinterpret_cast<bf16x8*>(&w1); qr[10 + s] = *reinterpret_cast<bf16x8*>(&w2); }
    }
    float m_reg = -1e30f, l_reg = 0.f; f32x16 o[4] = {};
    f32x16 pA0, pA1, pB0, pB1; float alA = 1.f, alB = 1.f; bf16x8 pa0, pa1, pa2, pa3;
    const int NT = 4 * qb + 4; const int wp = wid >> 1;
    const bool a1 = wp >= 1, a2 = wp >= 2, a3 = wp >= 3;
#define MASK(P0, P1, act) do { if (!(act)) { _Pragma("unroll") for (int r = 0; r < 16; ++r) { P0[r] = -INFINITY; P1[r] = -INFINITY; } } } while (0)
#define INTERVAL(PN0, PN1, PO0, PO1, alN, alO, t, act, load) do { \
        if (load) DMA_KV((t) + 1, ((t) + 1) & 1, vnext); \
        SBAR(); if (act) qkt2(PN0, PN1, Krow + ((t) & 1) * K2_BYTES, koff, qr); MASK(PN0, PN1, act); \
        if (MODE == 2) { asm volatile("" : "+v"(PO0), "+v"(PO1)); pa0 = __builtin_bit_cast(bf16x8, (u32x4){__float_as_uint(PO0[0]), __float_as_uint(PO0[1]), __float_as_uint(PO0[2]), __float_as_uint(PO0[3])}); pa1 = pa0; pa2 = pa0; pa3 = pa0; } \
        else finishSM(PO0, PO1, alO, l_reg, pa0, pa1, pa2, pa3); \
        SBAR(); pv_d0(o, vb0 + vprev * SHM_V, pa0, pa1, pa2, pa3); if (MODE == 2) { asm volatile("" : "+v"(PN0), "+v"(PN1)); } else partialSM(PN0, PN1, m_reg, alN); \
        __syncthreads(); RESC(alN); \
        vprev = vcur; vcur = vnext; vnext = (vnext == 2) ? 0 : vnext + 1; } while (0)
    __syncthreads();
    int vprev = 0, vcur = 1, vnext = 2;
    DMA_KV(1, 1, 1);
    qkt2(pA0, pA1, Krow, koff, qr); partialSM(pA0, pA1, m_reg, alA);
    __syncthreads();
    for (int j = 1; j + 3 < NT; j += 2) {
        INTERVAL(pB0, pB1, pA0, pA1, alB, alA, j, true, true);
        INTERVAL(pA0, pA1, pB0, pB1, alA, alB, j + 1, true, true);
    }
    INTERVAL(pB0, pB1, pA0, pA1, alB, alA, NT - 3, a1, true);
    INTERVAL(pA0, pA1, pB0, pB1, alA, alB, NT - 2, a2, true);
    INTERVAL(pB0, pB1, pA0, pA1, alB, alA, NT - 1, a3, false);
    finishSM(pB0, pB1, alB, l_reg, pa0, pa1, pa2, pa3); SBAR();
    pv_d0(o, vb0 + vprev * SHM_V, pa0, pa1, pa2, pa3);
#undef INTERVAL
#undef MASK
    if (hi == 0) li_l[r32] = l_reg; asm volatile("s_waitcnt lgkmcnt(0)" ::: "memory");
    float rli[16];
#pragma unroll
    for (int r = 0; r < 16; ++r) rli[r] = __builtin_amdgcn_rcpf(li_l[crow(r, hi)]);
    __syncthreads();
    LAS bf16_t* stg = (LAS bf16_t*)(lds + wid * 8192);
#pragma unroll
    for (int r = 0; r < 16; ++r) { const int orow = crow(r, hi);
#pragma unroll
        for (int d0 = 0; d0 < 4; ++d0) stg[orow * 128 + d0 * 32 + r32] = f2bf(o[d0][r] * rli[r]); }
    asm volatile("s_waitcnt lgkmcnt(0)" ::: "memory");
    if (MODE == 0) {
        const int g = lane >> 4, ch = lane & 15, c = h * VH + ch * 8; const int t0 = qb * 256 + wid * QBLK;
        const size_t e0 = (size_t)(b * SEQ + t0) * DM + c;
        u32x4 uu[8], gv[8], sv[8];
#pragma unroll
        for (int i = 0; i < 8; ++i) { const size_t e = e0 + (size_t)(4 * i + g) * DM; uu[i] = *(const u32x4*)(T.u + e); gv[i] = __builtin_nontemporal_load((const u32x4*)(T.gb + e)); sv[i] = __builtin_nontemporal_load((const u32x4*)(T.sg + e)); }
        u32x4 uvirt = {0u, 0u, 0u, 0u};
        if (g >= 2 && t0 > 0) uvirt = *(const u32x4*)(T.u + e0 - (size_t)(4 - g) * DM);
        const f32x4 w0a = *(const f32x4*)(T.conv_w + c), w0b = *(const f32x4*)(T.conv_w + c + 4), w1a = *(const f32x4*)(T.conv_w + DM + c), w1b = *(const f32x4*)(T.conv_w + DM + c + 4),
              w2a = *(const f32x4*)(T.conv_w + 2 * DM + c), w2b = *(const f32x4*)(T.conv_w + 2 * DM + c + 4);
        const float cw0[8] = {w0a[0], w0a[1], w0a[2], w0a[3], w0b[0], w0b[1], w0b[2], w0b[3]}, cw1[8] = {w1a[0], w1a[1], w1a[2], w1a[3], w1b[0], w1b[1], w1b[2], w1b[3]},
                    cw2[8] = {w2a[0], w2a[1], w2a[2], w2a[3], w2b[0], w2b[1], w2b[2], w2b[3]};
        const int src1 = ((lane - 16) & 63) << 2, src2 = (lane ^ 32) << 2;
#pragma unroll
        for (int i = 0; i < 8; ++i) { const int row = i * 4 + g; const size_t e = e0 + (size_t)row * DM;
            const u32x4 ov = *(const LAS u32x4*)(stg + row * 128 + ch * 8);
            const u32x4 up = (i == 0) ? uvirt : uu[i > 0 ? i - 1 : 0];
            u32x4 u1, u2, res;
#pragma unroll
            for (int q = 0; q < 4; ++q) { const unsigned x1 = (g == 3) ? up[q] : uu[i][q], x2 = (g >= 2) ? up[q] : uu[i][q];
                u1[q] = (unsigned)__builtin_amdgcn_ds_bpermute(src1, (int)x1); u2[q] = (unsigned)__builtin_amdgcn_ds_bpermute(src2, (int)x2); }
#pragma unroll
            for (int q = 0; q < 4; ++q) {
                const float cl = cw0[2 * q] * bflo(u2[q]) + cw1[2 * q] * bflo(u1[q]) + cw2[2 * q] * bflo(uu[i][q]), chh = cw0[2 * q + 1] * bfhi(u2[q]) + cw1[2 * q + 1] * bfhi(u1[q]) + cw2[2 * q + 1] * bfhi(uu[i][q]);
                res[q] = cvt_pk_bf16(bflo(gv[i][q]) * cl + bflo(sv[i][q]) * bflo(ov[q]), bfhi(gv[i][q]) * chh + bfhi(sv[i][q]) * bfhi(ov[q])); }
            *(u32x4*)(T.merged + e) = res; }
    }
    asm volatile("s_waitcnt lgkmcnt(0)" ::: "memory");
    __syncthreads();
#undef DMA_KV
#undef RESC
}
#undef SBAR
}
#ifndef ATTN_UNIT
#define ATTN_UNIT attn_unit3
#endif
struct Frame {
    LAS unsigned char* lds; volatile LAS unsigned* MISC; unsigned* ctl;
    int tid, lane, wave, vcu, G;
};
__device__ __forceinline__ float wave_sum(float v) {
#pragma unroll
    for (int o = 1; o < 64; o <<= 1) v += __shfl_xor(v, o);
    return v;
}
__device__ __forceinline__ int tcc(int bj, int ch128) { return (bj << 7) | (ch128 & 0x60) | (((ch128 >> 2) & 1) << 4) | (((ch128 >> 3) & 3) << 2) | (ch128 & 3); }
struct MapIn { __device__ __forceinline__ int operator()(int c) const {
    if (c < C_ZB) return 256 * (c >> 7) + tcc(0, c & 127);
    if (c < C_ZC) { const int ch = c - C_ZB; return 256 * (8 + (ch >> 7)) + tcc(0, ch & 127); }
    if (c < C_QL) { const int ch = c - C_ZC; return 256 * (ch >> 7) + tcc(1, ch & 127); }
    if (c < C_KVL) { const int j = c - C_QL; return j < 256 ? 256 * 20 + permL(j) : 256 * 21 + permL(j - 256); }
    if (c < C_KR) return 256 * 22 + permL(c - C_KVL);
    if (c < C_GC) { const int j = c - C_KR, jj = j & 31; return 256 * 21 + 128 + ((jj >> 4) << 5) + ((j >> 5) << 4) + (((jj >> 2) & 3) << 2) + (jj & 3); }
    if (c < C_GM) { const int ch = c - C_GC; return 256 * (8 + (ch >> 7)) + tcc(1, ch & 127); }
    { const int j = c - C_GM; return 256 * (16 + (j >> 8)) + permL(j & 255); } } };
struct MapPerm { __device__ __forceinline__ int operator()(int c) const { return (c & ~255) | permL(c & 255); } };
struct MapId { __device__ __forceinline__ int operator()(int c) const { return c; } };
struct MapOut { __device__ __forceinline__ int operator()(int c) const { return (c & ~255) | (((c >> 5) & 1) << 7) | (((c >> 6) & 3) << 5) | (c & 31); } };
struct MapGU { int n; __device__ __forceinline__ int operator()(int f) const { const int r = f & 127; return 256 * (f >> 7) + ((((r >> 2) & 1) << 7) | ((r >> 5) << 5) | (n << 4) | (((r >> 3) & 3) << 2) | (r & 3)); } };

template <class RowMap>
__device__ __forceinline__ void transpose_item(const float* W, int N, bf16_t* WT, int ldt, const float* kscale, LAS float* scr, int item, int lane, const RowMap& rm) {
    const int nblk = N / 32, kb = item / nblk, nb = item % nblk, k0 = 64 * kb, n0 = 32 * nb;
    float wv[32];
#pragma unroll
    for (int i = 0; i < 32; ++i) wv[i] = __builtin_nontemporal_load(W + (size_t)(k0 + 2 * i + (lane >> 5)) * N + n0 + (lane & 31));
#pragma unroll
    for (int i = 0; i < 32; ++i) { const int kk = 2 * i + (lane >> 5); const float sc = kscale ? kscale[k0 + kk] : 1.f; scr[kk * 33 + (lane & 31)] = wv[i] * sc; }
    asm volatile("s_waitcnt lgkmcnt(0)" ::: "memory");
    const int c = lane & 7;
#pragma unroll
    for (int j = 0; j < 4; ++j) { const int n = (lane >> 3) + 8 * j; const LAS float* s = scr + (8 * c) * 33 + n;
        u32x4 o; o.x = cvt_pk_bf16(s[0 * 33], s[1 * 33]); o.y = cvt_pk_bf16(s[2 * 33], s[3 * 33]); o.z = cvt_pk_bf16(s[4 * 33], s[5 * 33]); o.w = cvt_pk_bf16(s[6 * 33], s[7 * 33]);
        *(u32x4*)(WT + (size_t)rm(n0 + n) * ldt + k0 + 8 * c) = o; }
    asm volatile("s_waitcnt lgkmcnt(0)" ::: "memory");
}
constexpr size_t WS_WIN = WS_WSMALL, WS_WQ = WS_WIN + (size_t)5888 * 1024 * 2, WS_WKV = WS_WQ + (size_t)1536 * 384 * 2, WS_WO = WS_WKV + (size_t)2048 * 256 * 2;
static_assert(WS_WO + (size_t)1024 * 1024 * 2 <= WS_A, "small weights fit below region A");
constexpr size_t WS_EGU = WS_C, WS_EDN = WS_C + (size_t)NEXP * 512 * 1024 * 2;
static_assert(WS_EDN + (size_t)NEXP * 1024 * 256 * 2 <= WS_D, "expert weights fit region C");

__device__ __forceinline__ void p0_weights_tables(const Ptrs& P, Frame& F) {
    LAS float* scr = (LAS float*)(F.lds + RING_OFF + F.wave * 16384);
    const int gw = F.vcu * NWAVES + F.wave, NGW = F.G * NWAVES;
    constexpr int I_IN = (DM / 64) * (DIN / 32), I_Q = (QL / 64) * (1536 / 32), I_KV = (KVL / 64) * (2048 / 32), I_O = (DM / 64) * (DM / 32);
    for (int it = gw; it < I_IN + I_Q + I_KV + I_O; it += NGW) {
        int r = it;
        if (r < I_IN) { transpose_item(P.w_in, DIN, (bf16_t*)(P.ws + WS_WIN), DM, (const float*)nullptr, scr, r, F.lane, MapIn{}); continue; } r -= I_IN;
        if (r < I_Q) { transpose_item(P.w_q_b, 1536, (bf16_t*)(P.ws + WS_WQ), QL, P.q_a_g, scr, r, F.lane, MapId{}); continue; } r -= I_Q;
        if (r < I_KV) { transpose_item(P.w_kv_b, 2048, (bf16_t*)(P.ws + WS_WKV), KVL, P.kv_a_g, scr, r, F.lane, MapPerm{}); continue; } r -= I_KV;
        transpose_item(P.w_o, DM, (bf16_t*)(P.ws + WS_WO), DM, (const float*)nullptr, scr, r, F.lane, MapPerm{});
    }
    {
        const int gt = F.vcu * 512 + F.tid;
        if (gt < 64 * 128) { const int rr = 192 + (gt >> 7), ch = gt & 127; *(u32x4*)((bf16_t*)(P.ws + WS_WIN) + (size_t)(256 * 21 + rr) * DM + ch * 8) = (u32x4){0u, 0u, 0u, 0u}; } }
    {
        float2* cs = (float2*)(P.ws + WS_CS);
        for (int idx = F.vcu * 512 + F.tid; idx < M * 32; idx += F.G * 512) { const int m = idx >> 5, i = idx & 31;
            const double inv = exp2(-(double)(2 * i) * (13.287712379549449 / 64.0));
            const double ang = (double)P.pos[m] * inv; float2 v; v.x = (float)cos(ang); v.y = (float)sin(ang); cs[idx] = v; } }
    asm volatile("s_waitcnt vmcnt(0) lgkmcnt(0)" ::: "memory"); __syncthreads();
}
__device__ __forceinline__ void p0_mod(const Ptrs& P, Frame& F) {
    if (F.vcu < 192) {
        LAS float* cact = (LAS float*)(F.lds + RING_OFF); LAS float* red = (LAS float*)(F.lds + RING_OFF + 65536);
        for (int idx = F.tid; idx < BATCH * DM; idx += 512) { const float cv = P.c[idx]; cact[idx] = cv / (1.f + __expf(-cv)); }
        __syncthreads();
        const int n0 = 32 * F.vcu, kl = F.lane >> 3, c4 = F.lane & 7;
        f32x4 acc[16];
#pragma unroll
        for (int b = 0; b < 16; ++b) acc[b] = (f32x4){0.f, 0.f, 0.f, 0.f};
        for (int it = 0; it < 16; ++it) { const int k = 128 * F.wave + 8 * it + kl;
            const f32x4 wv = __builtin_nontemporal_load((const f32x4*)(P.w_ada + (size_t)k * 6144 + n0 + 4 * c4));
#pragma unroll
            for (int b = 0; b < 16; ++b) acc[b] += cact[b * DM + k] * wv; }
#pragma unroll
        for (int b = 0; b < 16; ++b)
#pragma unroll
            for (int e = 0; e < 4; ++e) { float v = acc[b][e]; v += __shfl_xor(v, 8); v += __shfl_xor(v, 16); v += __shfl_xor(v, 32); if (kl == 0) red[(F.wave * 16 + b) * 32 + 4 * c4 + e] = v; }
        __syncthreads();
        { const int b = F.tid >> 5, cc = F.tid & 31; float s = P.b_ada[n0 + cc];
#pragma unroll
          for (int w = 0; w < 8; ++w) s += red[(w * 16 + b) * 32 + cc];
          ((float*)(P.ws + WS_MOD))[b * 6144 + n0 + cc] = s; }
        __syncthreads();
    }
}
__device__ __forceinline__ void expert_weight_items(const Ptrs& P, Frame& F, int w, int nw, int k_lo, int k_hi) {
    LAS float* scr = (LAS float*)(F.lds + RING_OFF + F.wave * 16384);
    constexpr int I_G = (DM / 64) * (DEXP / 32), I_D = (DEXP / 64) * (DM / 32);
    for (int k = k_lo; k < k_hi; ++k) { const int it = w + k * nw; if (it >= NEXP * (2 * I_G + I_D)) break;
        const int e = it / (2 * I_G + I_D); int r = it % (2 * I_G + I_D);
        bf16_t* gu = (bf16_t*)(P.ws + WS_EGU) + (size_t)e * 512 * DM; bf16_t* dn = (bf16_t*)(P.ws + WS_EDN) + (size_t)e * DM * DEXP;
        if (r < I_G) { transpose_item(P.w_gate + (size_t)e * DM * DEXP, DEXP, gu, DM, (const float*)nullptr, scr, r, F.lane, MapGU{0}); continue; } r -= I_G;
        if (r < I_G) { transpose_item(P.w_up + (size_t)e * DM * DEXP, DEXP, gu, DM, (const float*)nullptr, scr, r, F.lane, MapGU{1}); continue; } r -= I_G;
        transpose_item(P.w_down + (size_t)e * DEXP * DM, DM, dn, DEXP, (const float*)nullptr, scr, r, F.lane, MapOut{});
    }
}
__device__ __forceinline__ void p1_norm1(const Ptrs& P, Frame& F) {
    const int gw = F.vcu * NWAVES + F.wave, NGW = F.G * NWAVES;
    bf16_t* h = (bf16_t*)(P.ws + WS_A);
    for (int m0 = gw; m0 < M; m0 += 4 * NGW) {
        f32x4 v[4][4]; float s[4];
#pragma unroll
        for (int r = 0; r < 4; ++r) { const int mr = (m0 + r * NGW < M) ? m0 + r * NGW : m0; const f32x4* xr = (const f32x4*)(P.x + (size_t)mr * DM) + F.lane;
#pragma unroll
            for (int j = 0; j < 4; ++j) v[r][j] = __builtin_nontemporal_load(xr + 64 * j); }
#pragma unroll
        for (int r = 0; r < 4; ++r) { float a = 0.f;
#pragma unroll
            for (int j = 0; j < 4; ++j) a += (v[r][j][0] * v[r][j][0] + v[r][j][1] * v[r][j][1]) + (v[r][j][2] * v[r][j][2] + v[r][j][3] * v[r][j][3]);
            s[r] = 1.f / sqrtf(wave_sum(a) * (1.f / DM) + EPS); }
#pragma unroll
        for (int r = 0; r < 4; ++r) { const int m = m0 + r * NGW; if (m >= M) continue; const float* mod = (const float*)(P.ws + WS_MOD) + (m / SEQ) * 6144;
            unsigned long long* o8 = (unsigned long long*)(h + (size_t)m * DM) + F.lane;
#pragma unroll
            for (int j = 0; j < 4; ++j) { const int d = 4 * F.lane + 256 * j;
                const f32x4 g = *(const f32x4*)(P.norm1_g + d), sc = *(const f32x4*)(mod + 1024 + d), sh = *(const f32x4*)(mod + d);
                const f32x4 rr = v[r][j] * s[r] * g * (sc + 1.f) + sh;
                o8[64 * j] = (unsigned long long)cvt_pk_bf16(rr[0], rr[1]) | ((unsigned long long)cvt_pk_bf16(rr[2], rr[3]) << 32); } }
    }
}

constexpr size_t WS_WR = 30 * MiB;
constexpr size_t WS_STOK = WS_RT + 512 * 1024, WS_SW = WS_STOK + 320 * 1024;
constexpr int MAXROWS = 81920, MAXTILES = 320;
constexpr int NPB = 112, MAXTILES2 = 240, MAXROWS2 = MAXTILES2 * 256;
constexpr size_t WS_SDST = WS_SW + 320 * 1024, WS_PTOK = WS_SDST + 320 * 1024;
static_assert(WS_PTOK + (size_t)MAXROWS2 * 4 <= WS_WSMALL, "routing lists fit their region");
constexpr size_t WS_H2 = WS_B, WS_HACT = WS_B + 128 * MiB;
constexpr int H2P = 2 * DM;
constexpr size_t WS_DELTA = WS_D;
constexpr size_t WS_X1B = WS_B + (size_t)DM * 2;
constexpr int CW_T = CW_TILES, CW_T0 = CW_TILES + 1, CW_T2 = CW_TILES + 2, CW_TGRP = CW_TILES + 64, CW_TGRP2 = CW_TILES + 512;
constexpr int CW_HIST2 = 65536;

__device__ __forceinline__ void p0_router_weights(const Ptrs& P, Frame& F) {
    bf16_t* hi = (bf16_t*)(P.ws + WS_WR); bf16_t* lo = hi + 48 * DM;
    for (int idx = F.vcu * 512 + F.tid; idx < 48 * DM; idx += F.G * 512) { const int o = idx >> 10, k = idx & 1023;
        const float v = o < 4 ? P.w_rg[k * 4 + o] : (o < 36 ? P.w_re[k * 32 + o - 4] : 0.f);
        const bf16_t h = f2bf(v); hi[idx] = h; lo[idx] = f2bf(v - bf2f(h)); }
}
template <int MODE> __device__ __forceinline__ void p6_rows(const Ptrs& P, Frame& F) {
    LAS unsigned char* tile = F.lds + RING_OFF + F.wave * 8192;
    LAS float* lg = (LAS float*)(F.lds + RING_OFF + 65536 + F.wave * 1536);
    LAS unsigned char* wch = F.lds + RING_OFF + 77824;
    LAS float* gms = (LAS float*)(F.lds + XCH_OFF);
    LAS unsigned* hist = (LAS unsigned*)(F.lds + LDSCTL_OFF + 1024);
    const bf16_t* WrHi = (const bf16_t*)(P.ws + WS_WR); const bf16_t* WrLo = WrHi + 48 * DM;
    bf16_t* h2 = (bf16_t*)(P.ws + WS_H2); const bf16_t* dl = (const bf16_t*)(P.ws + WS_DELTA);
    int2* rte = (int2*)(P.ws + WS_RT); float2* rtw = (float2*)(P.ws + WS_RT + 256 * 1024);
    const int t = F.lane & 15, q = F.lane >> 4;
    u32x4 wreg[6];
#pragma unroll
    for (int j = 0; j < 6; ++j) { const int id = F.tid + 512 * j, arr = id / 1536, rem = id - arr * 1536, row = rem >> 5, ch = rem & 31; wreg[j] = *(const u32x4*)((arr ? WrLo : WrHi) + (size_t)row * DM + 8 * ch); }
    for (int rb = F.vcu; rb < M / 128; rb += F.G) {
        const int m0 = rb * 128 + F.wave * 16, b = m0 / SEQ;
        const float* mod = (const float*)(P.ws + WS_MOD) + b * 6144;
        __syncthreads();
        if (F.tid < 192) hist[F.tid] = 0u;
        for (int k = F.tid; k < DM; k += 512) { gms[k] = P.norm2_g[k] * (1.f + mod[4096 + k]); gms[DM + k] = mod[3072 + k]; }
        __syncthreads();
#pragma unroll 1
        for (int hb = 0; hb < 2; ++hb) {
            const int mb = m0 + 8 * hb;
            f32x4 xv[8][4]; float rstd[8];
#pragma unroll
            for (int r = 0; r < 8; ++r) { const f32x4* xr = (const f32x4*)(P.x + (size_t)(mb + r) * DM) + F.lane; const u32x2* dr = (const u32x2*)(dl + (size_t)(mb + r) * DM) + F.lane;
#pragma unroll
                for (int c = 0; c < 4; ++c) { const f32x4 x4 = __builtin_nontemporal_load(xr + 64 * c); const u32x2 d = __builtin_nontemporal_load(dr + 64 * c);
                    xv[r][c][0] = x4[0] + __uint_as_float(d.x << 16); xv[r][c][1] = x4[1] + __uint_as_float(d.x & 0xffff0000u); xv[r][c][2] = x4[2] + __uint_as_float(d.y << 16); xv[r][c][3] = x4[3] + __uint_as_float(d.y & 0xffff0000u); } }
#pragma unroll
            for (int r = 0; r < 8; ++r) { float s = 0.f;
#pragma unroll
                for (int c = 0; c < 4; ++c) s += (xv[r][c][0] * xv[r][c][0] + xv[r][c][1] * xv[r][c][1]) + (xv[r][c][2] * xv[r][c][2] + xv[r][c][3] * xv[r][c][3]);
                rstd[r] = 1.f / sqrtf(wave_sum(s) * (1.f / DM) + EPS); }
#pragma unroll
            for (int r = 0; r < 8; ++r)
#pragma unroll
                for (int c = 0; c < 4; ++c) { u32x2 xb_; xb_.x = cvt_pk_bf16(xv[r][c][0], xv[r][c][1]); xb_.y = cvt_pk_bf16(xv[r][c][2], xv[r][c][3]); *(u32x2*)(h2 + (size_t)(mb + r) * H2P + DM + 256 * c + 4 * F.lane) = xb_; }
            f32x4 acc[3];
#pragma unroll
            for (int cb = 0; cb < 3; ++cb) acc[cb] = (f32x4){0.f, 0.f, 0.f, 0.f};
#pragma unroll
            for (int c = 0; c < 4; ++c) {
                const int k0 = 256 * c + 4 * F.lane;
                __syncthreads();
#pragma unroll
                for (int j = 0; j < 6; ++j) { const int id = F.tid + 512 * j, arr = id / 1536, rem = id - arr * 1536, row = rem >> 5, ch = rem & 31;
                    *(LAS u32x4*)(wch + arr * 24576 + row * 512 + ((ch ^ (row & 15)) << 4)) = wreg[j]; }
#pragma unroll
                for (int j = 0; j < 6; ++j) { const int id = F.tid + 512 * j, arr = id / 1536, rem = id - arr * 1536, row = rem >> 5, ch = rem & 31;
                    wreg[j] = *(const u32x4*)((arr ? WrLo : WrHi) + (size_t)row * DM + 256 * ((c + 1) & 3) + 8 * ch); }
                const f32x4 gm = *(const LAS f32x4*)(gms + k0), sh = *(const LAS f32x4*)(gms + DM + k0);
#pragma unroll
                for (int r = 0; r < 8; ++r) { const f32x4 h = xv[r][c] * rstd[r] * gm + sh;
                    u32x2 hi; hi.x = cvt_pk_bf16(h[0], h[1]); hi.y = cvt_pk_bf16(h[2], h[3]);
                    u32x2 lo; lo.x = cvt_pk_bf16(h[0] - __uint_as_float(hi.x << 16), h[1] - __uint_as_float(hi.x & 0xffff0000u)); lo.y = cvt_pk_bf16(h[2] - __uint_as_float(hi.y << 16), h[3] - __uint_as_float(hi.y & 0xffff0000u));
                    *(u32x2*)(h2 + (size_t)(mb + r) * H2P + k0) = hi;
                    const int off = r * 512 + ((((F.lane >> 1) ^ r) & 31) << 4) + ((F.lane & 1) << 3);
                    *(LAS u32x2*)(tile + off) = hi; *(LAS u32x2*)(tile + 4096 + off) = lo; }
                asm volatile("s_waitcnt lgkmcnt(0)" ::: "memory");
                __syncthreads();
#pragma unroll 2
                for (int ks = 0; ks < (MODE == 1 ? 0 : 8); ++ks) { const int tr = t & 7;
                    const int off = tr * 512 + ((((4 * ks + q) ^ tr) & 31) << 4);
                    const bf16x8 bh = *(const LAS bf16x8*)(tile + off), bl = *(const LAS bf16x8*)(tile + 4096 + off);
#pragma unroll
                    for (int cb = 0; cb < 3; ++cb) { const int woff = (16 * cb + t) * 512 + ((((4 * ks + q) ^ t) & 31) << 4);
                        const bf16x8 wh = *(const LAS bf16x8*)(wch + woff), wl = *(const LAS bf16x8*)(wch + 24576 + woff);
                        acc[cb] = __builtin_amdgcn_mfma_f32_16x16x32_bf16(wh, bh, acc[cb], 0, 0, 0);
                        acc[cb] = __builtin_amdgcn_mfma_f32_16x16x32_bf16(wh, bl, acc[cb], 0, 0, 0);
                        acc[cb] = __builtin_amdgcn_mfma_f32_16x16x32_bf16(wl, bh, acc[cb], 0, 0, 0); } }
                asm volatile("s_waitcnt lgkmcnt(0)" ::: "memory");
            }
            if (t < 8) {
#pragma unroll
                for (int cb = 0; cb < 3; ++cb)
#pragma unroll
                    for (int r = 0; r < 4; ++r) lg[t * 48 + 16 * cb + 4 * q + r] = acc[cb][r]; }
            asm volatile("s_waitcnt lgkmcnt(0)" ::: "memory");
            if (MODE != 1 && q == 0 && t < 8) {
                const int m = mb + t;
                const LAS float* l = lg + t * 48;
                float gl[4];
#pragma unroll
                for (int i = 0; i < 4; ++i) gl[i] = l[i] + P.b_rg[i];
                int g = 0; float gmx = gl[0];
#pragma unroll
                for (int i = 1; i < 4; ++i) if (gl[i] > gmx) { gmx = gl[i]; g = i; }
                float se = 0.f;
#pragma unroll
                for (int i = 0; i < 4; ++i) se += __expf(gl[i] - gmx);
                const float pg = 1.f / se;
                float e0v = -3.0e38f, e1v = -3.0e38f; int i0 = 0, i1 = 0;
#pragma unroll
                for (int i = 0; i < 8; ++i) { const float v = l[4 + g * 8 + i] + P.b_re[g * 8 + i];
                    if (v > e0v) { e1v = e0v; i1 = i0; e0v = v; i0 = i; } else if (v > e1v) { e1v = v; i1 = i; } }
                const float p1 = __expf(e1v - e0v), w0 = 1.f / (1.f + p1), w1 = p1 * w0;
                int2 e; e.x = g * 8 + i0; e.y = g * 8 + i1; float2 w; w.x = w0 * pg; w.y = w1 * pg;
                rte[m] = e; rtw[m] = w;
                __hip_atomic_fetch_add(&hist[e.x], 1u, __ATOMIC_RELAXED, __HIP_MEMORY_SCOPE_WORKGROUP); __hip_atomic_fetch_add(&hist[32 + e.y], 1u, __ATOMIC_RELAXED, __HIP_MEMORY_SCOPE_WORKGROUP);
                { const int lo = i0 < i1 ? i0 : i1, hi = i0 < i1 ? i1 : i0;
                  __hip_atomic_fetch_add(&hist[64 + g * 28 + ((lo * (15 - lo)) >> 1) + (hi - lo - 1)], 1u, __ATOMIC_RELAXED, __HIP_MEMORY_SCOPE_WORKGROUP); }
            }
            asm volatile("s_waitcnt lgkmcnt(0)" ::: "memory");
        }
        __syncthreads();
        if (MODE != 1 && F.tid < 64) F.ctl[CW_HIST + rb * 64 + F.tid] = hist[F.tid];
        else if (MODE != 1 && F.tid < 192) F.ctl[CW_HIST2 + rb * 128 + F.tid - 64] = hist[F.tid];
    }
    __syncthreads();
}
__device__ __forceinline__ void p7_sort(const Ptrs& P, Frame& F) {
    LAS unsigned* tot = (LAS unsigned*)(F.lds + RING_OFF);
    LAS unsigned* pre = tot + 64;
    LAS unsigned* rbase = pre + 64;
    LAS unsigned* cnt = rbase + 64;
    LAS unsigned* misc = cnt + 64;
    LAS unsigned* tot2 = tot + 1536; LAS unsigned* pre2 = tot2 + 128; LAS unsigned* rbase2 = pre2 + 128; LAS unsigned* cnt2 = rbase2 + 128;
    LAS unsigned* ptot2 = cnt2 + 128; LAS unsigned* ppre2 = ptot2 + 512;
    int* stok = (int*)(P.ws + WS_STOK); float* sw = (float*)(P.ws + WS_SW); int* sdst = (int*)(P.ws + WS_SDST); int* ptok = (int*)(P.ws + WS_PTOK);
    const int2* rte = (const int2*)(P.ws + WS_RT); const float2* rtw = (const float2*)(P.ws + WS_RT + 256 * 1024);
    const int cw = F.vcu * 7 + F.wave - 1, cnw = F.G * 7; bool first = true;
    for (int rb = F.vcu; rb < M / 128; rb += F.G) {
        __syncthreads();
        {
            LAS unsigned* ptot = misc + 8; LAS unsigned* ppre = ptot + 512;
            const int g = F.tid & 63, pt = F.tid >> 6; unsigned hv[32];
#pragma unroll
            for (int k = 0; k < 32; ++k) hv[k] = F.ctl[CW_HIST + (32 * pt + k) * 64 + g];
            unsigned s = 0u, p = 0u;
#pragma unroll
            for (int k = 0; k < 32; ++k) { if (32 * pt + k == rb) p = s; s += hv[k]; }
            if (rb >= 32 * pt + 32) p = s;
            ptot[pt * 64 + g] = s; ppre[pt * 64 + g] = p;
        }
        {
            const int g2 = F.tid & 127, pt2 = F.tid >> 7; unsigned s = 0u, p = 0u;
            asm volatile("" ::: "memory");
#pragma unroll 1
            for (int kb = 0; kb < 2; ++kb) { unsigned hv[32];
#pragma unroll
                for (int k = 0; k < 32; ++k) hv[k] = F.ctl[CW_HIST2 + (64 * pt2 + 32 * kb + k) * 128 + g2];
#pragma unroll
                for (int k = 0; k < 32; ++k) { if (64 * pt2 + 32 * kb + k == rb) p = s; s += hv[k]; } }
            if (rb >= 64 * pt2 + 64) p = s;
            ptot2[pt2 * 128 + g2] = s; ppre2[pt2 * 128 + g2] = p;
        }
        __syncthreads();
        if (F.tid < 64) { unsigned s = 0u, p = 0u;
#pragma unroll
            for (int pt = 0; pt < 8; ++pt) { s += misc[8 + pt * 64 + F.tid]; p += misc[8 + 512 + pt * 64 + F.tid]; }
            tot[F.tid] = s; pre[F.tid] = p; cnt[F.tid] = 0u; }
        else if (F.tid < 192) { const int g2 = F.tid - 64; unsigned s = 0u, p = 0u;
#pragma unroll
            for (int pt = 0; pt < 4; ++pt) { s += ptot2[pt * 128 + g2]; p += ppre2[pt * 128 + g2]; }
            tot2[g2] = s; pre2[g2] = p; cnt2[g2] = 0u; }
        if (first && F.wave > 0) expert_weight_items(P, F, cw, cnw, 0, 2);
        __syncthreads();
        if (first && F.wave > 0) expert_weight_items(P, F, cw, cnw, 2, 4);
        if (F.wave == 0) {
            const int l = F.lane;
            { const unsigned nt = (tot[l] + 255u) >> 8; unsigned inc = nt;
#pragma unroll
              for (int o = 1; o < 64; o <<= 1) { const unsigned v = __shfl_up(inc, o); if (l >= o) inc += v; }
              const unsigned tb = inc - nt; rbase[l] = tb * 256u;
              const unsigned T = __shfl(inc, 63), T0 = __shfl(inc, 31);
              if (rb == 0) { for (unsigned k = 0; k < nt; ++k) F.ctl[CW_TGRP + tb + k] = (unsigned)l; if (l == 0) { F.ctl[CW_T] = T; F.ctl[CW_T0] = T0; } } }
            unsigned base2 = 0u;
#pragma unroll
            for (int hh = 0; hh < 2; ++hh) { const int bin = 64 * hh + l; const unsigned nt = bin < NPB ? (tot2[bin] + 255u) >> 8 : 0u; unsigned inc = nt;
#pragma unroll
                for (int o = 1; o < 64; o <<= 1) { const unsigned v = __shfl_up(inc, o); if (l >= o) inc += v; }
                const unsigned tb = base2 + inc - nt; rbase2[bin] = tb * 256u;
                if (rb == 0 && bin < NPB) { const int g = bin / 28; int c = bin - g * 28, lo = 0; while (c >= 7 - lo) { c -= 7 - lo; ++lo; } const int hi = lo + 1 + c;
                    for (unsigned k = 0; k < nt; ++k) F.ctl[CW_TGRP2 + tb + k] = (unsigned)(g * 8 + lo) | ((unsigned)(g * 8 + hi) << 8); }
                base2 += __shfl(inc, 63); }
            if (rb == 0 && l == 0) F.ctl[CW_T2] = base2;
            asm volatile("s_waitcnt lgkmcnt(0)" ::: "memory");
        }
        __syncthreads();
        if (F.wave == 0) {
            const unsigned long long ltmask = (1ull << F.lane) - 1ull;
            for (int ch = 0; ch < 2; ++ch) { const int m = rb * 128 + ch * 64 + F.lane; const int2 e = rte[m]; const float2 w = rtw[m];
                const int pg = e.x >> 3, pa = e.x & 7, pb = e.y & 7, plo = pa < pb ? pa : pb, phi = pa < pb ? pb : pa, pbin = pg * 28 + ((plo * (15 - plo)) >> 1) + (phi - plo - 1);
                const unsigned r2 = __hip_atomic_fetch_add(&cnt2[pbin], 1u, __ATOMIC_RELAXED, __HIP_MEMORY_SCOPE_WORKGROUP);
                const unsigned pos2 = rbase2[pbin] + pre2[pbin] + r2;
                ptok[pos2] = m;
                for (int j = 0; j < 2; ++j) { const int ex = j ? e.y : e.x; const float wj = j ? w.y : w.x; unsigned rank = 0u, gsz = 0u;
                    for (int x = 0; x < 32; ++x) { const unsigned long long mk = __ballot(ex == x); if (ex == x) { rank = (unsigned)__popcll(mk & ltmask); gsz = (unsigned)__popcll(mk); } }
                    const int g = j * 32 + ex; const unsigned pos = rbase[g] + pre[g] + cnt[g] + rank;
                    stok[pos] = m; sw[pos] = wj; sdst[pos] = (int)(pos2 * 2u + ((ex & 7) == phi ? 1u : 0u));
                    asm volatile("s_waitcnt lgkmcnt(0)" ::: "memory");
                    if (rank == 0u) cnt[g] += gsz;
                    asm volatile("s_waitcnt lgkmcnt(0)" ::: "memory"); } } }
        if (rb < 64) { const unsigned n = tot[rb], padn = (((n + 255u) >> 8) << 8) - n;
            if ((unsigned)F.tid < padn) { stok[rbase[rb] + n + F.tid] = -1; sw[rbase[rb] + n + F.tid] = 0.f; sdst[rbase[rb] + n + F.tid] = -1; } }
        if (rb < NPB) { const unsigned n = tot2[rb], padn = (((n + 255u) >> 8) << 8) - n;
            if ((unsigned)F.tid < padn) ptok[rbase2[rb] + n + F.tid] = -1; }
        if (first && F.wave > 0) expert_weight_items(P, F, cw, cnw, 4, 1 << 20);
        first = false;
    }
}
struct MoeSched {
    const bf16_t* A; const bf16_t* W; int lda, ldb; const int* stok; const unsigned* tgrp; int t_lo, nun, npn, G, c; size_t wstride; bool gather, split;
    __device__ bool next(int i, Unit& u) const {
        const int idx = i * G + c, nfull = (nun / G) * G, tail = nun - nfull; int U; u.half = 0;
        if (split && tail > 0 && 2 * tail <= G) { if (idx >= nfull + 2 * tail) return false; if (idx < nfull) U = idx; else { U = nfull + ((idx - nfull) >> 1); u.half = 1 + ((idx - nfull) & 1); } }
        else { if (idx >= nun) return false; U = idx; }
        u.aux = t_lo + U / npn; u.pn = U % npn; u.pm = (int)tgrp[u.aux]; return true; }
    __device__ __forceinline__ const char* abase(const Unit& u) const { return gather ? (const char*)A : (const char*)A + (size_t)(u.aux * BM + (u.half == 2 ? HALF : 0)) * lda * 2; }
    __device__ __forceinline__ const char* bbase(const Unit& u) const { return (const char*)W + (size_t)(u.pm & 31) * wstride + (size_t)u.pn * BM * ldb * 2; }
    __device__ __forceinline__ void avoff(const Unit& u, int R0, int C0, int R1, int C1, unsigned (&v0)[2], unsigned (&v1)[2]) const {
        if (gather) { const int* tk = stok + u.aux * BM + (u.half == 2 ? HALF : 0); const int o1 = u.half ? 0 : HALF; int a = tk[R0], b = tk[R1], c2 = tk[o1 + R0], d = tk[o1 + R1];
            a = a < 0 ? 0 : a; b = b < 0 ? 0 : b; c2 = c2 < 0 ? 0 : c2; d = d < 0 ? 0 : d;
            v0[0] = (unsigned)(a * lda + C0) * 2u; v0[1] = (unsigned)(b * lda + C1) * 2u; v1[0] = (unsigned)(c2 * lda + C0) * 2u; v1[1] = (unsigned)(d * lda + C1) * 2u; }
        else { v0[0] = (unsigned)(R0 * lda + C0) * 2u; v0[1] = (unsigned)(R1 * lda + C1) * 2u; const unsigned h1 = u.half ? 0u : (unsigned)(HALF * lda * 2); v1[0] = v0[0] + h1; v1[1] = v0[1] + h1; } }
};
struct EpiGU {
    bf16_t* hact; const float* sw; const int* sdst;
    __device__ __forceinline__ void operator()(const f32x4 (&acc)[2][2][4][2], const Unit& un, int wr, int wc, int fr, int fq) const {
        asm volatile("" : "+v"(fr), "+v"(fq));
        const int r0 = un.aux * BM + (un.half == 2 ? HALF : 0) + wr * 64 + fr, c0 = 128 * un.pn + 32 * wc + 8 * fq;
#pragma unroll
        for (int ai = 0; ai < 2; ++ai)
#pragma unroll
            for (int m = 0; m < 4; ++m) { if (ai == 1 && un.half) continue; const int row = r0 + ai * HALF + m * 16; const float w = sw[row]; const int dst = sdst[row];
                f32x4 a, b;
#pragma unroll
                for (int i = 0; i < 4; ++i) { const float g0 = acc[ai][0][m][0][i], g1 = acc[ai][1][m][0][i];
                    a[i] = g0 * fsigmoid(g0) * acc[ai][0][m][1][i] * w; b[i] = g1 * fsigmoid(g1) * acc[ai][1][m][1][i] * w; }
                if (dst >= 0) *(u32x4*)(hact + (size_t)(dst >> 1) * 512 + (dst & 1) * 256 + c0) = pack8(a, b); }
    }
};
struct PairSched {
    const bf16_t* A; const bf16_t* W; int lda, ldb; const unsigned* tgrp; int nun, npn, G, c; size_t wstride; bool split;
    __device__ bool next(int i, Unit& u) const {
        const int idx = i * G + c, nfull = (nun / G) * G, tail = nun - nfull; int U; u.half = 0;
        if (split && tail > 0 && 2 * tail <= G) { if (idx >= nfull + 2 * tail) return false; if (idx < nfull) U = idx; else { U = nfull + ((idx - nfull) >> 1); u.half = 1 + ((idx - nfull) & 1); } }
        else { if (idx >= nun) return false; U = idx; }
        u.aux = U / npn; u.pn = U % npn; u.pm = (int)tgrp[u.aux]; return true; }
    __device__ __forceinline__ const char* abase(const Unit& u) const { return (const char*)A + (size_t)(u.aux * BM + (u.half == 2 ? HALF : 0)) * lda * 2; }
    __device__ __forceinline__ const char* bbase(const Unit& u) const { return (const char*)W + (size_t)(u.pm & 255) * wstride + (size_t)u.pn * BM * ldb * 2; }
    __device__ __forceinline__ const char* bbase2(const Unit& u) const { return (const char*)W + (size_t)(u.pm >> 8) * wstride + (size_t)u.pn * BM * ldb * 2; }
    __device__ __forceinline__ void avoff(const Unit& u, int R0, int C0, int R1, int C1, unsigned (&v0)[2], unsigned (&v1)[2]) const {
        v0[0] = (unsigned)(R0 * lda + C0) * 2u; v0[1] = (unsigned)(R1 * lda + C1) * 2u; const unsigned h1 = u.half ? 0u : (unsigned)(HALF * lda * 2); v1[0] = v0[0] + h1; v1[1] = v0[1] + h1; }
};
struct EpiOut {
    const bf16_t* x1b; const float* mod; float* out; const int* ptok; LAS float* g0t; LAS float* g1t; int skip;
    __device__ __forceinline__ void operator()(const f32x4 (&acc)[2][2][4][2], const Unit& un, int wr, int wc, int fr, int fq) const {
        asm volatile("" : "+v"(fr), "+v"(fq));
        if (skip) {
#pragma unroll
            for (int ai = 0; ai < 2; ++ai)
#pragma unroll
                for (int bj = 0; bj < 2; ++bj)
#pragma unroll
                    for (int m = 0; m < 4; ++m) { f32x4 a = acc[ai][bj][m][0], b = acc[ai][bj][m][1]; asm volatile("" :: "v"(a), "v"(b)); }
            return; }
        const int r0 = un.aux * BM + (un.half == 2 ? HALF : 0) + wr * 64 + fr, c0 = 256 * un.pn + 64 * wc + 4 * fq;
        const int ns = un.half ? 8 : 16;
        int tk[2][4];
#pragma unroll
        for (int ai = 0; ai < 2; ++ai)
#pragma unroll
            for (int m = 0; m < 4; ++m) tk[ai][m] = (ai == 1 && un.half) ? -1 : ptok[r0 + ai * HALF + m * 16];
        unsigned vm = 0u;
#pragma unroll
        for (int ai = 0; ai < 2; ++ai)
#pragma unroll
            for (int m = 0; m < 4; ++m) if (__any(tk[ai][m] >= 0)) vm |= 1u << (4 * ai + m);
        vm = (unsigned)__builtin_amdgcn_readfirstlane((int)vm);
        { const int lane = fq * 16 + fr; f32x4 gv[4];
#pragma unroll
          for (int j = 0; j < 4; ++j) { const int idx = j * 64 + lane, b = idx >> 4, q4 = idx & 15; gv[j] = *(const f32x4*)(mod + b * 6144 + 5120 + 256 * un.pn + 64 * wc + 4 * q4); }
#pragma unroll
          for (int j = 0; j < 4; ++j) { const int idx = j * 64 + lane, b = idx >> 4, q4 = idx & 15; *(LAS f32x4*)((b < 8 ? g0t : g1t) + wc * 512 + (b & 7) * 64 + 4 * q4) = gv[j]; } }
        constexpr int PD = 6;
        u32x2 dd[16][2];
#define EO_X(s) do { if (!((vm >> ((s) >> 1)) & 1u)) break; const int tok_ = tk[(s) >> 3][((s) >> 1) & 3], tc_ = tok_ < 0 ? 0 : tok_; const size_t e_ = (size_t)tc_ * H2P + c0 + ((s) & 1) * 32; \
        dd[s][0] = *(const u32x2*)(x1b + e_); dd[s][1] = *(const u32x2*)(x1b + e_ + 16); } while (0)
#pragma unroll
        for (int s = 0; s < PD; ++s) EO_X(s);
#pragma unroll
        for (int s = 0; s < 16; ++s) {
            if (s + PD < 16 && s + PD < ns) EO_X(s + PD < 16 ? s + PD : 15);
            if (s < ns && ((vm >> (s >> 1)) & 1u)) {
                const int ai = s >> 3, m = (s >> 1) & 3, bj = s & 1, tok = tk[ai][m], tc = tok < 0 ? 0 : tok, b = tc / SEQ;
                const LAS float* gt = (b < 8 ? g0t : g1t) + wc * 512 + (b & 7) * 64 + bj * 32 + 4 * fq;
                const f32x4 ga = *(const LAS f32x4*)gt, gb = *(const LAS f32x4*)(gt + 16);
                const f32x4 a0 = acc[ai][bj][m][0], a1 = acc[ai][bj][m][1]; f32x4 oa, ob;
                oa[0] = __uint_as_float(dd[s][0].x << 16) + ga[0] * a0[0]; oa[1] = __uint_as_float(dd[s][0].x & 0xffff0000u) + ga[1] * a0[1];
                oa[2] = __uint_as_float(dd[s][0].y << 16) + ga[2] * a0[2]; oa[3] = __uint_as_float(dd[s][0].y & 0xffff0000u) + ga[3] * a0[3];
                ob[0] = __uint_as_float(dd[s][1].x << 16) + gb[0] * a1[0]; ob[1] = __uint_as_float(dd[s][1].x & 0xffff0000u) + gb[1] * a1[1];
                ob[2] = __uint_as_float(dd[s][1].y << 16) + gb[2] * a1[2]; ob[3] = __uint_as_float(dd[s][1].y & 0xffff0000u) + gb[3] * a1[3];
                if (tok >= 0) { float* o_ = out + (size_t)tok * DM + c0 + bj * 32; *(f32x4*)o_ = oa; *(f32x4*)(o_ + 16) = ob; }
            }
        }
#undef EO_X
    }
};
struct Args { Ptrs P; int ph_lo, ph_hi, li, pad; };
constexpr int N_PHASES = 10;

typedef const __attribute__((address_space(4))) Args* KArgs;
__device__ __forceinline__ KArgs kargs() {
#if defined(__HIP_DEVICE_COMPILE__)
    unsigned off = 0u; asm volatile("" : "+s"(off));
    return (KArgs)((const __attribute__((address_space(4))) char*)__builtin_amdgcn_kernarg_segment_ptr() + off);
#else
    return nullptr;
#endif
}
__device__ __forceinline__ Ptrs load_ptrs() {
    Ptrs P{};
#if defined(__HIP_DEVICE_COMPILE__)
    const __attribute__((address_space(4))) unsigned long long* src = (const __attribute__((address_space(4))) unsigned long long*)kargs();
    unsigned long long w[sizeof(Ptrs) / 8];
#pragma unroll
    for (unsigned i = 0; i < sizeof(Ptrs) / 8; ++i) w[i] = src[i];
    __builtin_memcpy(&P, w, sizeof(Ptrs));
#endif
    return P;
}
#define WSPTRS \
    unsigned char* ws = P.ws; bf16_t* hA = (bf16_t*)(ws + WS_A); bf16_t* uB = (bf16_t*)(ws + WS_B); bf16_t* gbB = uB + (size_t)M * DM; bf16_t* sgB = gbB + (size_t)M * DM; \
    bf16_t* latC = (bf16_t*)(ws + WS_C); bf16_t* Kd = (bf16_t*)(ws + WS_D); bf16_t* Vd = (bf16_t*)(ws + WS_D + 96 * MiB); bf16_t* Qo = (bf16_t*)P.out; \
    float* ssp = (float*)(ws + WS_SSP); const float2* cs = (const float2*)(ws + WS_CS); const float* mod = (const float*)(ws + WS_MOD); \
    const int* stok = (const int*)(ws + WS_STOK); const float* sw = (const float*)(ws + WS_SW); bf16_t* h2 = (bf16_t*)(ws + WS_H2); bf16_t* hact = (bf16_t*)(ws + WS_HACT); \
    (void)hA; (void)uB; (void)gbB; (void)sgB; (void)latC; (void)Kd; (void)Vd; (void)Qo; (void)ssp; (void)cs; (void)mod; (void)stok; (void)sw; (void)h2; (void)hact;

__global__ void __launch_bounds__(NWAVES * 64, 2) fwd(Args args_unused) {
    extern __shared__ __attribute__((aligned(16))) unsigned char lds_raw[];
    Frame F;
    F.lds = (LAS unsigned char*)lds_raw;
    F.MISC = (volatile LAS unsigned*)(F.lds + MISC_OFF);
    F.tid = threadIdx.x; F.lane = F.tid & 63; F.wave = __builtin_amdgcn_readfirstlane(F.tid >> 6);
    F.G = gridDim.x; { const int bx = blockIdx.x; F.vcu = (F.G % 8 == 0) ? (bx % 8) * (F.G / 8) + bx / 8 : bx; }
    F.ctl = (unsigned*)(args_unused.P.ws + WS_CTL);
    for (int u = F.tid; u < (LDS_BYTES - LDSCTL_OFF) / 4; u += NWAVES * 64) ((LAS unsigned*)(F.lds + LDSCTL_OFF))[u] = 0u;
    __syncthreads();
    const int lo = args_unused.ph_lo, hi = args_unused.ph_hi;
    XcdBarrier bar; bar.bar = F.ctl + CW_BAR + args_unused.li * XCD_BAR_WORDS; bar.x = 0; bar.st = nullptr;
    if (hi - lo > 1) bar = xcd_barrier_post(F.ctl + CW_BAR + args_unused.li * XCD_BAR_WORDS, F.MISC + 8);
#ifdef ONLY_PHASE
#define IN(k) ((k) == ONLY_PHASE && lo <= (k) && (k) < hi)
#else
#define IN(k) (lo <= (k) && (k) < hi)
#endif
#ifndef PROBE_REPEAT
#define PROBE_REPEAT -1
#endif
#define REPS(k) for (int rep_ = 0; rep_ < ((k) == PROBE_REPEAT ? 2 : 1); ++rep_)
#define SEAM(k) do { if (IN(k) && IN((k) + 1)) xcd_barrier(bar); } while (0)

    if (IN(0)) { const Ptrs P = args_unused.P; REPS(0) { p0_router_weights(P, F); p0_mod(P, F); } SEAM(0); }
    if (IN(1)) { const Ptrs P = args_unused.P; REPS(1) { p1_norm1(P, F); p0_weights_tables(P, F); } SEAM(1); }
    if (IN(2)) {
        const Ptrs P = args_unused.P; WSPTRS
        DenseSched S; S.init(hA, DM, (const bf16_t*)(ws + WS_WIN), DM, M, 5888, F.G, (int)blockIdx.x, true, true);
        EpiIn E{uB, gbB, sgB, latC, ssp, cs, P.k_g, (LAS float*)(F.lds + XCH_OFF)};
        gemm_phase<false>(F.lds + RING_OFF, DM, S, E);
        if (PROBE_REPEAT == 2) gemm_phase<false>(F.lds + RING_OFF, DM, S, E);
        SEAM(2);
    }
    if (IN(3)) {
        const Ptrs P = args_unused.P; WSPTRS
        { DenseSched S; S.init(latC + 512, LATW, (const bf16_t*)(ws + WS_WKV), KVL, M, 2048, F.G, (int)blockIdx.x);
          EpiKV E{Kd, Vd, latC, ssp, P.k_g, (LAS float*)(F.lds + XCH_OFF)};
          gemm_phase<false>(F.lds + RING_OFF, KVL, S, E);
          if (PROBE_REPEAT == 31) gemm_phase<false>(F.lds + RING_OFF, KVL, S, E);
          if (PROBE_REPEAT == 32) { EpiPlain E2{hA, 1024, 3}; gemm_phase<false>(F.lds + RING_OFF, KVL, S, E2); } }
        SEAM(3);
    }
    if (IN(4)) {
        const Ptrs P = args_unused.P; WSPTRS
        att::AttnArgs T{latC, (const bf16_t*)(ws + WS_WQ), Qo, Kd, Vd, ssp, cs, P.q_g, uB, gbB, sgB, P.conv_w, hA};
        if (F.G == 256) {
            const int bh = F.vcu >> 1, sel = F.vcu & 1;
#pragma unroll 1
            for (int i = 0; i < 4; ++i) { const int qb = sel ? (i == 0 ? 6 : i == 1 ? 1 : i == 2 ? 5 : 2) : (i == 0 ? 7 : i == 1 ? 0 : i == 2 ? 4 : 3);
                att::ATTN_UNIT<0>(T, bh >> 3, bh & 7, qb, (LAS char*)(F.lds + RING_OFF)); }
            if (PROBE_REPEAT == 4 || PROBE_REPEAT == 41 || PROBE_REPEAT == 42) {
#pragma unroll 1
                for (int i = 0; i < 4; ++i) { const int qb = sel ? (i == 0 ? 6 : i == 1 ? 1 : i == 2 ? 5 : 2) : (i == 0 ? 7 : i == 1 ? 0 : i == 2 ? 4 : 3);
                    att::ATTN_UNIT<(PROBE_REPEAT == 41 ? 1 : PROBE_REPEAT == 42 ? 2 : 0)>(T, bh >> 3, bh & 7, qb, (LAS char*)(F.lds + RING_OFF)); } }
        } else {
#pragma unroll 1
            for (int U = F.vcu; U < BATCH * NH * 8; U += F.G) { const int bh = U >> 3; att::ATTN_UNIT<0>(T, bh >> 3, bh & 7, U & 7, (LAS char*)(F.lds + RING_OFF)); }
        }
        SEAM(4);
    }
    if (IN(5)) {
        const Ptrs P = args_unused.P; WSPTRS
        DenseSched S; S.init(hA, DM, (const bf16_t*)(ws + WS_WO), DM, M, DM, F.G, (int)blockIdx.x);
        EpiDelta E{mod, (bf16_t*)(ws + WS_DELTA)};
        gemm_phase<false>(F.lds + RING_OFF, DM, S, E);
        if (PROBE_REPEAT == 5) gemm_phase<false>(F.lds + RING_OFF, DM, S, E);
        if (PROBE_REPEAT == 51) { EpiNull E0; gemm_phase<false>(F.lds + RING_OFF, DM, S, E0); }
        SEAM(5);
    }
    if (IN(6)) { const Ptrs P = args_unused.P; p6_rows<0>(P, F); if (PROBE_REPEAT == 6) p6_rows<0>(P, F); if (PROBE_REPEAT == 61) p6_rows<1>(P, F); SEAM(6); }
    if (IN(7)) { const Ptrs P = args_unused.P; p7_sort(P, F); if (PROBE_REPEAT == 7) p7_sort(P, F); SEAM(7); }
    if (IN(8)) {
        const Ptrs P = args_unused.P; WSPTRS
        const int T = __builtin_amdgcn_readfirstlane((int)F.ctl[CW_T]);
        MoeSched S{h2, (const bf16_t*)(ws + WS_EGU), H2P, DM, stok, F.ctl + CW_TGRP, 0, T * 2, 2, F.G, F.vcu, (size_t)512 * DM * 2, true, true};
        EpiGU E{hact, sw, (const int*)(ws + WS_SDST)};
        gemm_phase<true>(F.lds + RING_OFF, DM, S, E);
        if (PROBE_REPEAT == 8) gemm_phase<true>(F.lds + RING_OFF, DM, S, E);
        SEAM(8);
    }
    if (IN(9)) {
        const Ptrs P = args_unused.P; WSPTRS
        const int T2 = __builtin_amdgcn_readfirstlane((int)F.ctl[CW_T2]);
        PairSched S{hact, (const bf16_t*)(ws + WS_EDN), 2 * DEXP, DEXP, F.ctl + CW_TGRP2, T2 * 4, 4, F.G, F.vcu, (size_t)DM * DEXP * 2, true};
        EpiOut E{(const bf16_t*)(ws + WS_X1B), mod, P.out, (const int*)(ws + WS_PTOK), (LAS float*)(F.lds + XCH_OFF), (LAS float*)(F.lds + GX_OFF), args_unused.li};
#pragma unroll 1
        REPS(9) gemm_phase<false, true>(F.lds + RING_OFF, 2 * DEXP, S, E);
        if (PROBE_REPEAT == 91) { EpiNull E0; gemm_phase<false, true>(F.lds + RING_OFF, 2 * DEXP, S, E0); }
    }
#undef IN
#undef SEAM
}
}
extern "C" void kernel_launch(void* const* d_in, const int* in_sizes, int n_in, void* d_out, int out_size, void* d_ws, size_t ws_size, hipStream_t stream) {
    if (n_in != 23 || out_size != M * DM || ws_size < WS_END) { fprintf(stderr, "kernel_launch: unexpected shapes (n_in %d out %d ws %zu)\n", n_in, out_size, ws_size); return; }
    static int grid = 0;
    if (grid == 0) {
        int dev = 0, cus = 0;
        if (hipGetDevice(&dev) != hipSuccess || hipDeviceGetAttribute(&cus, hipDeviceAttributeMultiprocessorCount, dev) != hipSuccess) { fprintf(stderr, "kernel_launch: device query failed\n"); grid = -1; return; }
        if (hipFuncSetAttribute((const void*)fk::fwd, hipFuncAttributeMaxDynamicSharedMemorySize, fk::LDS_BYTES) != hipSuccess) { fprintf(stderr, "kernel_launch: hipFuncSetAttribute failed\n"); grid = -1; return; }
        grid = cus;
    }
    if (grid < 0) return;
    Ptrs P{};
    P.x = (const float*)d_in[0]; P.c = (const float*)d_in[1]; P.pos = (const int*)d_in[2];
    P.w_ada = (const float*)d_in[3]; P.b_ada = (const float*)d_in[4]; P.norm1_g = (const float*)d_in[5]; P.w_in = (const float*)d_in[6]; P.conv_w = (const float*)d_in[7];
    P.q_a_g = (const float*)d_in[8]; P.w_q_b = (const float*)d_in[9]; P.kv_a_g = (const float*)d_in[10]; P.w_kv_b = (const float*)d_in[11]; P.q_g = (const float*)d_in[12]; P.k_g = (const float*)d_in[13];
    P.w_o = (const float*)d_in[14]; P.norm2_g = (const float*)d_in[15]; P.w_rg = (const float*)d_in[16]; P.b_rg = (const float*)d_in[17]; P.w_re = (const float*)d_in[18]; P.b_re = (const float*)d_in[19];
    P.w_gate = (const float*)d_in[20]; P.w_up = (const float*)d_in[21]; P.w_down = (const float*)d_in[22];
    P.out = (float*)d_out; P.ws = (unsigned char*)d_ws;
    (void)hipMemsetAsync((char*)d_ws + WS_CTL, 0, 1 * MiB, stream);
    fk::Args a{}; a.P = P; a.ph_lo = 0; a.ph_hi = fk::N_PHASES; a.li = 0;
    hipLaunchKernelGGL(fk::fwd, dim3(grid), dim3(fk::NWAVES * 64), fk::LDS_BYTES, stream, a);
#ifdef PROBE_PHASE
    { fk::Args b2{}; b2.P = P; b2.ph_lo = PROBE_PHASE; b2.ph_hi = PROBE_PHASE + 1; b2.li = 1; hipLaunchKernelGGL(fk::fwd, dim3(grid), dim3(fk::NWAVES * 64), fk::LDS_BYTES, stream, b2); }
#endif
}
```

```cpp
#define PROBE_REPEAT -1
#include <hip/hip_runtime.h>
#include <cstdio>
#include <cstdint>
#include <cmath>

constexpr int BATCH = 16, SEQ = 2048, DM = 1024, M = BATCH * SEQ;
constexpr int NH = 8, QKN = 128, QKR = 64, QKH = 192, VH = 128, QL = 384, KVL = 256;
constexpr int DIN = 5824, NEXP = 32, DEXP = 256;
constexpr int C_ZX = 0, C_ZB = 1024, C_ZC = 2048, C_QL = 3072, C_KVL = 3456, C_KR = 3712, C_GC = 3776, C_GM = 4800;
constexpr float EPS = 1e-6f;
constexpr int LATW = 768;

typedef unsigned short bf16_t;
typedef float f32x4 __attribute__((ext_vector_type(4)));

constexpr size_t MiB = 1u << 20;
constexpr size_t WS_CTL = 0;
constexpr size_t WS_MOD = 1 * MiB;
constexpr size_t WS_CS = 2 * MiB;
constexpr size_t WS_SSP = 10 * MiB;
constexpr size_t WS_RT = 12 * MiB;
constexpr size_t WS_WSMALL = 14 * MiB;
constexpr size_t WS_A = 32 * MiB;
constexpr size_t WS_B = 96 * MiB;
constexpr size_t WS_C = 288 * MiB;
constexpr size_t WS_D = 336 * MiB;
constexpr size_t WS_END = 496 * MiB;

__device__ __forceinline__ float bf2f(bf16_t v) { return __uint_as_float(((unsigned)v) << 16); }
__device__ __forceinline__ bf16_t f2bf(float f) { unsigned u = __float_as_uint(f); return (bf16_t)((u + 0x7fffu + ((u >> 16) & 1u)) >> 16); }

struct Ptrs {
    const float *x, *c; const int* pos;
    const float *w_ada, *b_ada, *norm1_g, *w_in, *conv_w, *q_a_g, *w_q_b, *kv_a_g, *w_kv_b, *q_g, *k_g, *w_o, *norm2_g;
    const float *w_rg, *b_rg, *w_re, *b_re, *w_gate, *w_up, *w_down;
    float* out; unsigned char* ws;
};

namespace fk {
#define LAS __attribute__((address_space(3)))
#define GAS __attribute__((address_space(1)))
typedef short bf16x8 __attribute__((ext_vector_type(8)));
typedef short s16x4 __attribute__((ext_vector_type(4)));
typedef unsigned u32x4 __attribute__((ext_vector_type(4)));
typedef unsigned u32x2 __attribute__((ext_vector_type(2)));
typedef float f32x2 __attribute__((ext_vector_type(2)));
typedef float f32x16 __attribute__((ext_vector_type(16)));
typedef GAS unsigned gu32;
#define RLX_AGENT __ATOMIC_RELAXED, __HIP_MEMORY_SCOPE_AGENT
constexpr int NWAVES = 8;
constexpr int BM = 256, BK = 64, HALF = 128, HTB = HALF * BK * 2, STAGE_BYTES = 8 * HTB, NXCD = 8, WGM = 8;
constexpr int RING_OFF = 0, RING_BYTES = 131072, XCH_OFF = 131072, XCH_BYTES = 8192, LDSCTL_OFF = XCH_OFF + XCH_BYTES, MISC_OFF = LDSCTL_OFF + 320, GX_OFF = 147456, LDS_BYTES = 155648;
constexpr int CW_TMO = 0, CW_BAR = 4096;
constexpr int CW_HIST = 16384;
constexpr int CW_TILES = 40960;

typedef __bf16 bf16x2_t __attribute__((ext_vector_type(2)));
__device__ __forceinline__ unsigned cvt_pk_bf16(float lo, float hi) { f32x2 v = {lo, hi}; bf16x2_t b = __builtin_convertvector(v, bf16x2_t); return __builtin_bit_cast(unsigned, b); }
__device__ __forceinline__ float fsigmoid(float x) { return __builtin_amdgcn_rcpf(1.f + __expf(-x)); }

__host__ __device__ __forceinline__ int lds_byte(int r, int c) { const int st = (r >> 4) * 2 + (c >> 5), rr = r & 15, cc = c & 31, ob = rr * 64 + cc * 2; return st * 1024 + (ob ^ (((ob >> 9) & 1) << 5)); }
__host__ __device__ __forceinline__ void stage_rc(int b, int& R, int& C) { const int st = b / 1024, sb = b % 1024, swz = sb ^ (((sb >> 9) & 1) << 5); R = (st >> 1) * 16 + swz / 64; C = (st & 1) * 32 + (swz % 64) / 2; }
__host__ __device__ __forceinline__ int permL(int L) { return (L & 0xE0) | (((L >> 2) & 1) << 4) | (((L >> 3) & 3) << 2) | (L & 3); }

#define XB_TMO      128
#define XB_XCNT(j)  (256  + 64 * (j))
#define XB_XSUB(j)  (1280 + 64 * (j))
#define XB_XGEN(j)  (2304 + 64 * (j))
#define XB_TOP      3328
#define XB_TOPGEN   3392
#define XCD_BAR_WORDS 3456
#define XB_SPIN_CAP (1u << 18)
__device__ __forceinline__ unsigned xb_ld(unsigned* p)              { return __hip_atomic_load(p, __ATOMIC_RELAXED, __HIP_MEMORY_SCOPE_AGENT); }
__device__ __forceinline__ unsigned xb_add(unsigned* p, unsigned v) { return __hip_atomic_fetch_add(p, v, __ATOMIC_RELAXED, __HIP_MEMORY_SCOPE_AGENT); }
__device__ __forceinline__ unsigned xb_xcc_id() { return (unsigned)__builtin_amdgcn_s_getreg((3 << 11) | 20) & 0xFu; }
#define XB_SPIN(cond, bar) do { unsigned _sp = 0; while (cond) { __builtin_amdgcn_s_sleep(1); \
    if ((++_sp & 255u) == 0u) { if (xb_ld(&(bar)[XB_TMO])) break; if (_sp > XB_SPIN_CAP) { atomicAdd(&(bar)[XB_TMO], 1u); break; } } } } while (0)
struct XcdBarrier { unsigned* bar; unsigned x; volatile LAS unsigned* st; };
__device__ __forceinline__ XcdBarrier xcd_barrier_post(unsigned* bar, volatile LAS unsigned* st) {
    XcdBarrier b; b.bar = bar; b.x = xb_xcc_id(); b.st = st;
    if (threadIdx.x == 0) (void)xb_add(&bar[XB_XCNT(b.x)], 1u);
    return b;
}
__device__ __forceinline__ void xcd_barrier_complete(unsigned* bar, unsigned x, unsigned& nloc, unsigned& nx) {
    const unsigned G = gridDim.x * gridDim.y * gridDim.z;
    unsigned sum, cnt, mine, sp = 0u;
    for (;;) {
        sum = 0u; cnt = 0u; mine = 0u;
#pragma unroll
        for (unsigned j = 0; j < 16; ++j) { const unsigned c = xb_ld(&bar[XB_XCNT(j)]); sum += c; cnt += (c > 0u) ? 1u : 0u; mine = (j == x) ? c : mine; }
        if (sum == G) break;
        __builtin_amdgcn_s_sleep(1);
        if ((++sp & 255u) == 0u) { if (xb_ld(&bar[XB_TMO])) break; if (sp > XB_SPIN_CAP) { atomicAdd(&bar[XB_TMO], 1u); break; } }
    }
    nloc = mine > 0u ? mine : 1u; nx = cnt > 0u ? cnt : 1u;
}
__device__ __forceinline__ void xcd_barrier(const XcdBarrier& b) {
    asm volatile("s_waitcnt vmcnt(0)" ::: "memory");
    __syncthreads();
    if (threadIdx.x == 0) {
        unsigned* bar = b.bar;
        __builtin_amdgcn_s_waitcnt(0);
        unsigned nloc = b.st[0], nx = b.st[1];
        if (nloc == 0u) { xcd_barrier_complete(bar, b.x, nloc, nx); b.st[0] = nloc; b.st[1] = nx; }
        const unsigned old = xb_add(&bar[XB_XSUB(b.x)], 1u);
        const unsigned gen = old / nloc;
        if (old + 1u == (gen + 1u) * nloc) {
            __builtin_amdgcn_fence(__ATOMIC_RELEASE, "agent");
            asm volatile("s_waitcnt vmcnt(0)" ::: "memory");
            const unsigned og = xb_add(&bar[XB_TOP], 1u);
            const unsigned tg = og / nx;
            if (og + 1u == (tg + 1u) * nx) xb_add(&bar[XB_TOPGEN], 1u);
            else XB_SPIN(xb_ld(&bar[XB_TOPGEN]) == tg, bar);
            __builtin_amdgcn_fence(__ATOMIC_ACQUIRE, "agent");
            xb_add(&bar[XB_XGEN(b.x)], 1u);
            asm volatile("s_waitcnt vmcnt(0)" ::: "memory");
        } else {
            XB_SPIN(xb_ld(&bar[XB_XGEN(b.x)]) == gen, bar);
            __builtin_amdgcn_fence(__ATOMIC_ACQUIRE, "agent");
            asm volatile("s_waitcnt vmcnt(0)" ::: "memory");
        }
    }
    __syncthreads();
}

struct Unit { int pm, pn, aux, half; };
struct DenseSched {
    const bf16_t* A; const bf16_t* Bt; int lda, ldb; int nM, nN, nwg, G, c; bool split, pnflip;
    __device__ void init(const bf16_t* A_, int lda_, const bf16_t* Bt_, int ldb_, int M_, int N_, int G_, int c_, bool split_ = false, bool pnflip_ = false) {
        A = A_; Bt = Bt_; lda = lda_; ldb = ldb_; nM = M_ / BM; nN = N_ / BM; nwg = nM * nN; G = G_; c = c_; split = split_; pnflip = pnflip_; }
    __device__ __forceinline__ bool next(int i, Unit& u) const {
        const int idx = i * G + c, nfull = (nwg / G) * G, tail = nwg - nfull; int L; u.half = 0;
        if (split && tail > 0 && 2 * tail <= G) { if (idx >= nfull + 2 * tail) return false; if (idx < nfull) L = idx; else { L = nfull + ((idx - nfull) >> 1); u.half = 1 + ((idx - nfull) & 1); } }
        else { if (idx >= nwg) return false; L = idx; }
        int wgid = L; { const int q = nwg / NXCD, r = nwg % NXCD, xcd = wgid % NXCD, off = wgid / NXCD; wgid = (xcd < r ? xcd * (q + 1) : r * (q + 1) + (xcd - r) * q) + off; }
        const int nig = WGM * nN, gid = wgid / nig, fm = gid * WGM, gsz = (nM - fm) < WGM ? (nM - fm) : WGM;
        u.pm = fm + ((wgid % nig) % gsz); u.pn = (wgid % nig) / gsz; if (pnflip) u.pn = nN - 1 - u.pn; u.aux = 0; return true;
    }
    __device__ __forceinline__ const char* abase(const Unit& u) const { return (const char*)A + (size_t)(u.pm * BM + (u.half == 2 ? HALF : 0)) * lda * 2; }
    __device__ __forceinline__ const char* bbase(const Unit& u) const { return (const char*)Bt + (size_t)u.pn * BM * ldb * 2; }
    __device__ __forceinline__ void avoff(const Unit& u, int R0, int C0, int R1, int C1, unsigned (&v0)[2], unsigned (&v1)[2]) const {
        v0[0] = (unsigned)(R0 * lda + C0) * 2u; v0[1] = (unsigned)(R1 * lda + C1) * 2u;
        const unsigned h1 = u.half ? 0u : (unsigned)(HALF * lda * 2);
        v1[0] = v0[0] + h1; v1[1] = v0[1] + h1; }
};

template <bool GATHER, bool PAIR = false, class Epi, class Sched>
__device__ __forceinline__ void gemm_phase(LAS unsigned char* lds, const int K, const Sched& S, const Epi& E) {
    const int tid = threadIdx.x, wid = __builtin_amdgcn_readfirstlane(tid >> 6), lane = tid & 63, wr = wid >> 2, wc = wid & 3, fr = lane & 15, fq = lane >> 4;
    const int nt = K / BK;
    int R0, C0, R1, C1; stage_rc(tid * 16, R0, C0); stage_rc(tid * 16 + 8192, R1, C1);
    unsigned voffB[2]; voffB[0] = (unsigned)(R0 * S.ldb + C0) * 2u; voffB[1] = (unsigned)(R1 * S.ldb + C1) * 2u;
    const size_t kstep = (size_t)(BK * 2);
    const size_t hstepB = (size_t)HALF * S.ldb * 2;
    const unsigned ldsw = (unsigned)wid * 1024u;
    const int aoff = lds_byte(wr * 64 + fr, fq * 8), boff = lds_byte(wc * 32 + fr, fq * 8);
#define PG8_SA(b, h) (((b) * 2 + (h)) * HTB)
#define PG8_SB(b, h) ((4 + (b) * 2 + (h)) * HTB)
#define PG8_STAGE(bufoff, gbase, voff) do { _Pragma("unroll") for (int _i = 0; _i < 2; ++_i) \
        __builtin_amdgcn_global_load_lds((const unsigned*)((const char*)(gbase) + (voff)[_i]), (LAS unsigned*)(lds + (bufoff) + ldsw + _i * 8192), 16, 0, 0); } while (0)
#define PG8_LDA(dst, b, h) do { _Pragma("unroll") for (int m = 0; m < 4; ++m) _Pragma("unroll") for (int k = 0; k < 2; ++k) dst[m][k] = *(const LAS bf16x8*)(lds + PG8_SA(b, h) + aoff + m * 2048 + k * 1024); } while (0)
#define PG8_LDB(dst, b, h) do { _Pragma("unroll") for (int n = 0; n < 2; ++n) _Pragma("unroll") for (int k = 0; k < 2; ++k) dst[n][k] = *(const LAS bf16x8*)(lds + PG8_SB(b, h) + boff + n * 2048 + k * 1024); } while (0)
#define PG8_MMA(ai, bj, At, Bt) do { __builtin_amdgcn_s_setprio(1); _Pragma("unroll") for (int m = 0; m < 4; ++m) _Pragma("unroll") for (int n = 0; n < 2; ++n) _Pragma("unroll") for (int k = 0; k < 2; ++k) \
        acc[ai][bj][m][n] = __builtin_amdgcn_mfma_f32_16x16x32_bf16(Bt[n][k], At[m][k], acc[ai][bj][m][n], 0, 0, 0); __builtin_amdgcn_s_setprio(0); } while (0)
#define PG8_WAIT_V(n) asm volatile("s_waitcnt vmcnt(" #n ")" ::: "memory")
#define PG8_WAIT_L(n) asm volatile("s_waitcnt lgkmcnt(" #n ")" ::: "memory")
#define PG8_BAR __builtin_amdgcn_s_barrier()
#define PG8_SCHED __builtin_amdgcn_sched_barrier(0)
    Unit cur, nxt; int ui = 0;
    if (!S.next(0, cur)) return;
    f32x4 acc[2][2][4][2];
#pragma unroll
    for (int a = 0; a < 2; ++a)
#pragma unroll
        for (int b = 0; b < 2; ++b)
#pragma unroll
            for (int m = 0; m < 4; ++m)
#pragma unroll
                for (int n = 0; n < 2; ++n) acc[a][b][m][n] = (f32x4){0.f, 0.f, 0.f, 0.f};
    bf16x8 At[4][2], B0[2][2], B1[2][2];
    unsigned va0[2], va1[2], na0[2], na1[2];
    S.avoff(cur, R0, C0, R1, C1, va0, va1);
    na0[0] = va0[0]; na0[1] = va0[1]; na1[0] = va1[0]; na1[1] = va1[1];
    const char* cA = S.abase(cur); const char* cB = S.bbase(cur); const char* cB2 = cB; if constexpr (PAIR) cB2 = S.bbase2(cur);
    PG8_STAGE(PG8_SB(0, 0), cB, voffB); PG8_STAGE(PG8_SB(0, 1), cB + hstepB, voffB); PG8_STAGE(PG8_SA(0, 0), cA, va0); PG8_STAGE(PG8_SA(0, 1), cA, va1);
    if (wr == 1) PG8_BAR;
    PG8_WAIT_V(2); PG8_BAR;
    PG8_STAGE(PG8_SB(1, 0), cB + kstep, voffB); PG8_STAGE(PG8_SA(1, 0), cA + kstep, va0); PG8_STAGE(PG8_SB(1, 1), cB + hstepB + kstep, voffB);
    PG8_WAIT_V(6); PG8_BAR;
    for (;;) {
        const bool has_next = S.next(ui + 1, nxt);
        const char* nA = has_next ? S.abase(nxt) : cA; const char* nB = has_next ? S.bbase(nxt) : cB; const char* nB2 = nB; if constexpr (PAIR) nB2 = has_next ? S.bbase2(nxt) : cB2;
        if (has_next) S.avoff(nxt, R0, C0, R1, C1, na0, na1);
        const bool hu = cur.half != 0;
#pragma unroll 1
        for (int t = 0; t < nt; t += 2) {
            const bool last = (t == nt - 2);
            const char* a1 = cA + (size_t)(t + 1) * kstep;
            const char* a2 = last ? nA : cA + (size_t)(t + 2) * kstep;
            const char* b2 = last ? nB : (PAIR && 2 * (t + 2) >= nt) ? cB2 + (size_t)(t + 2 - (nt >> 1)) * kstep : cB + (size_t)(t + 2) * kstep;
            const char* a3 = a2 + kstep; const char* b3 = b2 + kstep;
            unsigned x0[2], x1[2];
            x0[0] = last ? na0[0] : va0[0]; x0[1] = last ? na0[1] : va0[1]; x1[0] = last ? na1[0] : va1[0]; x1[1] = last ? na1[1] : va1[1];
            PG8_LDB(B0, 0, 0); PG8_LDB(B1, 0, 1); PG8_SCHED; PG8_LDA(At, 0, 0); PG8_STAGE(PG8_SA(1, 1), a1, va1);
            PG8_WAIT_V(8); PG8_WAIT_L(0); PG8_BAR; PG8_MMA(0, 0, At, B0); PG8_MMA(0, 1, At, B1); PG8_BAR; PG8_SCHED;
            if (!hu) PG8_LDA(At, 0, 1);
            PG8_STAGE(PG8_SB(0, 0), b2, voffB); PG8_STAGE(PG8_SB(0, 1), b2 + hstepB, voffB); PG8_STAGE(PG8_SA(0, 0), a2, x0);
            PG8_WAIT_V(8); PG8_WAIT_L(0); PG8_BAR; if (!hu) { PG8_MMA(1, 0, At, B0); PG8_MMA(1, 1, At, B1); } PG8_BAR; PG8_SCHED;
            PG8_LDB(B0, 1, 0); PG8_LDB(B1, 1, 1); PG8_SCHED; PG8_LDA(At, 1, 0); PG8_STAGE(PG8_SA(0, 1), a2, x1);
            PG8_WAIT_V(8); PG8_WAIT_L(0); PG8_BAR; PG8_MMA(0, 0, At, B0); PG8_MMA(0, 1, At, B1); PG8_BAR; PG8_SCHED;
            if (!hu) PG8_LDA(At, 1, 1);
            PG8_STAGE(PG8_SB(1, 0), b3, voffB); PG8_STAGE(PG8_SB(1, 1), b3 + hstepB, voffB); PG8_STAGE(PG8_SA(1, 0), a3, x0);
            PG8_WAIT_V(8); PG8_WAIT_L(0); PG8_BAR; if (!hu) { PG8_MMA(1, 0, At, B0); PG8_MMA(1, 1, At, B1); } PG8_BAR; PG8_SCHED;
        }
        if (wr == 0) PG8_BAR;
        E(acc, cur, wr, wc, fr, fq);
        if (!has_next) break;
#pragma unroll
        for (int a = 0; a < 2; ++a)
#pragma unroll
            for (int b = 0; b < 2; ++b)
#pragma unroll
                for (int m = 0; m < 4; ++m)
#pragma unroll
                    for (int n = 0; n < 2; ++n) acc[a][b][m][n] = (f32x4){0.f, 0.f, 0.f, 0.f};
        cur = nxt; cA = nA; cB = nB; cB2 = nB2; ++ui;
        va0[0] = na0[0]; va0[1] = na0[1]; va1[0] = na1[0]; va1[1] = na1[1];
        if (wr == 1) PG8_BAR;
    }
    PG8_WAIT_V(0);
    PG8_BAR;
#undef PG8_SA
#undef PG8_SB
#undef PG8_STAGE
#undef PG8_LDA
#undef PG8_LDB
#undef PG8_MMA
#undef PG8_WAIT_V
#undef PG8_WAIT_L
#undef PG8_BAR
#undef PG8_SCHED
}

__device__ __forceinline__ u32x4 pack8(const f32x4 a, const f32x4 b) { u32x4 w; w.x = cvt_pk_bf16(a[0], a[1]); w.y = cvt_pk_bf16(a[2], a[3]); w.z = cvt_pk_bf16(b[0], b[1]); w.w = cvt_pk_bf16(b[2], b[3]); return w; }

struct EpiIn {
    bf16_t *u, *gb, *sg, *lat; float* rowstat; const float2* cs; const float* k_g; LAS float* xch;
    __device__ __forceinline__ void operator()(const f32x4 (&acc)[2][2][4][2], const Unit& un, int wr, int wc, int fr, int fq) const {
        asm volatile("" : "+v"(fr), "+v"(fq));
        const int row0 = un.pm * BM + wr * 64 + fr, pn = un.pn;
        if (pn < 16) {
            const int c0 = 128 * (pn & 7) + 32 * wc + 8 * fq; bf16_t* dst = pn < 8 ? u : gb; const int rh = row0 + (un.half == 2 ? HALF : 0);
#pragma unroll
            for (int ai = 0; ai < 2; ++ai)
#pragma unroll
                for (int m = 0; m < 4; ++m) { f32x4 r0, r1; if (ai == 1 && un.half) continue;
                    if (pn < 8) { r0 = acc[ai][0][m][0] * acc[ai][1][m][0]; r1 = acc[ai][0][m][1] * acc[ai][1][m][1]; }
                    else { const f32x4 g0 = acc[ai][1][m][0], g1 = acc[ai][1][m][1];
#pragma unroll
                        for (int i = 0; i < 4; ++i) { r0[i] = acc[ai][0][m][0][i] * fsigmoid(g0[i]); r1[i] = acc[ai][0][m][1][i] * fsigmoid(g1[i]); } }
                    __builtin_nontemporal_store(pack8(r0, r1), (u32x4*)(dst + (size_t)(rh + ai * HALF + m * 16) * DM + c0)); }
        } else if (pn < 20) {
            const int c0 = 256 * (pn - 16) + 32 * wc + 8 * fq;
#pragma unroll
            for (int ai = 0; ai < 2; ++ai)
#pragma unroll
                for (int m = 0; m < 4; ++m)
#pragma unroll
                    for (int bj = 0; bj < 2; ++bj) { f32x4 a = acc[ai][bj][m][0], b = acc[ai][bj][m][1];
#pragma unroll
                        for (int i = 0; i < 4; ++i) { a[i] = fsigmoid(a[i]); b[i] = fsigmoid(b[i]); }
                        __builtin_nontemporal_store(pack8(a, b), (u32x4*)(sg + (size_t)(row0 + ai * HALF + m * 16) * DM + c0 + bj * HALF)); }
        } else {
            const int c0 = 256 * (pn - 20) + 32 * wc + 8 * fq, rowt = wr * 64 + fr;
#pragma unroll
            for (int ai = 0; ai < 2; ++ai)
#pragma unroll
                for (int m = 0; m < 4; ++m) { const int rt = rowt + ai * HALF + m * 16, row = un.pm * BM + rt; float s0, s1;
                    { const f32x4 a = acc[ai][0][m][0], b = acc[ai][0][m][1]; *(u32x4*)(lat + (size_t)row * LATW + c0) = pack8(a, b);
                      s0 = (a[0] * a[0] + a[1] * a[1]) + (a[2] * a[2] + a[3] * a[3]) + (b[0] * b[0] + b[1] * b[1]) + (b[2] * b[2] + b[3] * b[3]); }
                    { const f32x4 a = acc[ai][1][m][0], b = acc[ai][1][m][1];
                      s1 = (a[0] * a[0] + a[1] * a[1]) + (a[2] * a[2] + a[3] * a[3]) + (b[0] * b[0] + b[1] * b[1]) + (b[2] * b[2] + b[3] * b[3]);
                      if (pn != 21) *(u32x4*)(lat + (size_t)row * LATW + c0 + HALF) = pack8(a, b);
                      else if (wc < 2) { const int j = 16 * wc + 4 * fq;
                          const f32x4 g1 = *(const f32x4*)(k_g + 128 + j), g2 = *(const f32x4*)(k_g + 160 + j);
                          const f32x4 cA = *(const f32x4*)((const float*)cs + ((size_t)row * 32 + j) * 2), cB = *(const f32x4*)((const float*)cs + ((size_t)row * 32 + j + 2) * 2);
                          const f32x4 x1 = a * g1, x2 = b * g2; f32x4 y1, y2;
                          y1[0] = x1[0] * cA[0] - x2[0] * cA[1]; y2[0] = x2[0] * cA[0] + x1[0] * cA[1]; y1[1] = x1[1] * cA[2] - x2[1] * cA[3]; y2[1] = x2[1] * cA[2] + x1[1] * cA[3];
                          y1[2] = x1[2] * cB[0] - x2[2] * cB[1]; y2[2] = x2[2] * cB[0] + x1[2] * cB[1]; y1[3] = x1[3] * cB[2] - x2[3] * cB[3]; y2[3] = x2[3] * cB[2] + x1[3] * cB[3];
                          u32x2 w1, w2; w1.x = cvt_pk_bf16(y1[0], y1[1]); w1.y = cvt_pk_bf16(y1[2], y1[3]); w2.x = cvt_pk_bf16(y2[0], y2[1]); w2.y = cvt_pk_bf16(y2[2], y2[3]);
                          *(u32x2*)(lat + (size_t)row * LATW + 384 + j) = w1; *(u32x2*)(lat + (size_t)row * LATW + 416 + j) = w2; } }
                    s0 += __shfl_xor(s0, 16); s0 += __shfl_xor(s0, 32); s1 += __shfl_xor(s1, 16); s1 += __shfl_xor(s1, 32);
                    if (fq == 0) { xch[rt * 8 + wc] = s0; xch[rt * 8 + 4 + wc] = s1; } }
            asm volatile("s_waitcnt lgkmcnt(0)" ::: "memory"); __builtin_amdgcn_s_barrier(); asm volatile("" ::: "memory");
            if (threadIdx.x < 256) { const int rt = threadIdx.x; const f32x4 p0 = *(const LAS f32x4*)(xch + rt * 8), p1 = *(const LAS f32x4*)(xch + rt * 8 + 4);
                const float S0 = (p0[0] + p0[1]) + (p0[2] + p0[3]), S1 = (p1[0] + p1[1]) + (p1[2] + p1[3]); float* st = rowstat + (size_t)(un.pm * BM + rt) * 4;
                if (pn == 20) st[0] = S0 + S1; else if (pn == 21) { st[1] = S0; st[2] = S1; } else st[3] = S0 + S1; }
        }
    }
};
struct EpiPlain {
    bf16_t* O; int ldc; int pnmask;
    __device__ __forceinline__ void operator()(const f32x4 (&acc)[2][2][4][2], const Unit& un, int wr, int wc, int fr, int fq) const {
        asm volatile("" : "+v"(fr), "+v"(fq));
        const int row0 = un.pm * BM + wr * 64 + fr, c0 = 256 * (un.pn & pnmask) + 32 * wc + 8 * fq;
#pragma unroll
        for (int ai = 0; ai < 2; ++ai)
#pragma unroll
            for (int m = 0; m < 4; ++m)
#pragma unroll
                for (int bj = 0; bj < 2; ++bj) __builtin_nontemporal_store(pack8(acc[ai][bj][m][0], acc[ai][bj][m][1]), (u32x4*)(O + (size_t)(row0 + ai * HALF + m * 16) * ldc + c0 + bj * HALF));
    }
};
struct EpiKV {
    bf16_t *Kb, *Vb; const bf16_t* lat; const float* rowstat; const float* k_g; LAS float* xch;
    __device__ __forceinline__ void operator()(const f32x4 (&acc)[2][2][4][2], const Unit& un, int wr, int wc, int fr, int fq) const {
        asm volatile("" : "+v"(fr), "+v"(fq));
        const int h = un.pn, rowt = wr * 64 + fr, b = (un.pm * BM) / SEQ, s0 = (un.pm * BM) % SEQ;
        f32x2 st[2][4];
        u32x4 rp[2][2];
#pragma unroll
        for (int ai = 0; ai < 2; ++ai) {
#pragma unroll
            for (int m = 0; m < 4; ++m) st[ai][m] = *(const f32x2*)(rowstat + (size_t)(un.pm * BM + rowt + ai * HALF + m * 16) * 4 + 2);
            const bf16_t* lr = lat + (size_t)(un.pm * BM + rowt + ai * HALF + wc * 16) * LATW + 384 + 16 * fq;
            rp[ai][0] = *(const u32x4*)lr; rp[ai][1] = *(const u32x4*)(lr + 8); }
#pragma unroll
        for (int ai = 0; ai < 2; ++ai)
#pragma unroll
            for (int m = 0; m < 4; ++m) {
                const f32x4 a = acc[ai][0][m][0], c = acc[ai][0][m][1];
                float ss = (a[0] * a[0] + a[1] * a[1]) + (a[2] * a[2] + a[3] * a[3]) + (c[0] * c[0] + c[1] * c[1]) + (c[2] * c[2] + c[3] * c[3]);
                ss += __shfl_xor(ss, 16); ss += __shfl_xor(ss, 32);
                if (fq == 0) xch[(rowt + ai * HALF + m * 16) * 4 + wc] = ss; }
        asm volatile("s_waitcnt lgkmcnt(0)" ::: "memory"); __builtin_amdgcn_s_barrier(); asm volatile("" ::: "memory");
        const int c8 = 32 * wc + 8 * fq;
        const f32x4 g0 = *(const f32x4*)(k_g + c8), g1 = *(const f32x4*)(k_g + c8 + 4);
#pragma unroll
        for (int ai = 0; ai < 2; ++ai)
#pragma unroll
            for (int m = 0; m < 4; ++m) { const int rt = rowt + ai * HALF + m * 16;
                const float rkv = __builtin_amdgcn_rsqf(st[ai][m][1] * (1.f / KVL) + EPS);
                const f32x4 t4 = *(const LAS f32x4*)(xch + rt * 4);
                const float rk = __builtin_amdgcn_rsqf((((t4[0] + t4[1]) + (t4[2] + t4[3])) * rkv * rkv + st[ai][m][0]) * (1.f / QKH) + EPS);
                const float sk = rkv * rk, sv = rkv;
                const size_t bhs = (size_t)(b * NH + h) * SEQ + s0 + rt;
                bf16_t* Kp = Kb + bhs * QKH; bf16_t* Vp = Vb + bhs * VH;
                *(u32x4*)(Kp + c8) = pack8(acc[ai][0][m][0] * sk * g0, acc[ai][0][m][1] * sk * g1);
                *(u32x4*)(Vp + c8) = pack8(acc[ai][1][m][0] * sv, acc[ai][1][m][1] * sv);
                if (m == wc) {
                    u32x4 o0, o1;
#pragma unroll
                    for (int e = 0; e < 4; ++e) { o0[e] = cvt_pk_bf16(__uint_as_float(rp[ai][0][e] << 16) * rk, __uint_as_float(rp[ai][0][e] & 0xffff0000u) * rk);
                                                  o1[e] = cvt_pk_bf16(__uint_as_float(rp[ai][1][e] << 16) * rk, __uint_as_float(rp[ai][1][e] & 0xffff0000u) * rk); }
                    *(u32x4*)(Kp + 128 + 16 * fq) = o0; *(u32x4*)(Kp + 128 + 16 * fq + 8) = o1; } }
    }
};
struct EpiNull {
    __device__ __forceinline__ void operator()(const f32x4 (&acc)[2][2][4][2], const Unit& un, int wr, int wc, int fr, int fq) const {
#pragma unroll
        for (int ai = 0; ai < 2; ++ai)
#pragma unroll
            for (int bj = 0; bj < 2; ++bj)
#pragma unroll
                for (int m = 0; m < 4; ++m) { f32x4 a = acc[ai][bj][m][0], b = acc[ai][bj][m][1]; asm volatile("" :: "v"(a), "v"(b)); }
    }
};
struct EpiDelta {
    const float* mod; bf16_t* delta;
    __device__ __forceinline__ void operator()(const f32x4 (&acc)[2][2][4][2], const Unit& un, int wr, int wc, int fr, int fq) const {
        asm volatile("" : "+v"(fr), "+v"(fq));
        const int row0 = un.pm * BM + wr * 64 + fr, b = (un.pm * BM) / SEQ, c0 = 256 * un.pn + 32 * wc + 8 * fq;
        const float* gate = mod + b * 6144 + 2048;
#pragma unroll
        for (int bj = 0; bj < 2; ++bj) { const f32x4 g0 = *(const f32x4*)(gate + c0 + bj * HALF), g1 = *(const f32x4*)(gate + c0 + bj * HALF + 4);
#pragma unroll
            for (int ai = 0; ai < 2; ++ai)
#pragma unroll
                for (int m = 0; m < 4; ++m) *(u32x4*)(delta + (size_t)(row0 + ai * HALF + m * 16) * DM + c0 + bj * HALF) = pack8(acc[ai][bj][m][0] * g0, acc[ai][bj][m][1] * g1); }
    }
};
namespace att {
constexpr int NW = 8, QBLK = 32, KVBLK = 64, KPITCH = 400;
constexpr int SHM_V = KVBLK * VH * 2, SHM_K = KVBLK * KPITCH;
constexpr int QRP = 144;
constexpr int OFF_V = 0, OFF_K = 2 * SHM_V, OFF_WS = OFF_K + 2 * SHM_K, OFF_QR = OFF_WS + NW * 64 * 4, ATT_LDS = OFF_QR + NW * 32 * QRP;
constexpr float SCALE = 0.07216878364870322f;
constexpr float THR = 8.f;
#define SBAR() __builtin_amdgcn_sched_barrier(0)
__device__ __forceinline__ int crow(int r, int hi) { return (r & 3) + 8 * (r >> 2) + 4 * hi; }
__device__ __forceinline__ void partialSM(f32x16& p0, f32x16& p1, float& m_reg, float& alpha) {
    constexpr float C = SCALE * 1.4426950408889634f;
    float pmax = p0[0];
#pragma unroll
    for (int r = 1; r < 16; ++r) pmax = fmaxf(pmax, p0[r]);
#pragma unroll
    for (int r = 0; r < 16; ++r) pmax = fmaxf(pmax, p1[r]);
    { auto rr = __builtin_amdgcn_permlane32_swap(__float_as_uint(pmax), __float_as_uint(pmax), false, false);
      pmax = fmaxf(__uint_as_float(rr[0]), __uint_as_float(rr[1])); }
    float mn;
    if (__builtin_expect(__all(pmax - m_reg <= THR / SCALE), 1)) { mn = m_reg; alpha = 1.f; }
    else { mn = fmaxf(m_reg, pmax); alpha = __builtin_amdgcn_exp2f((m_reg - mn) * C); m_reg = mn; }
    const float mnC = -mn * C;
#pragma unroll
    for (int r = 0; r < 16; ++r) p0[r] = fmaf(p0[r], C, mnC);
#pragma unroll
    for (int r = 0; r < 16; ++r) p1[r] = fmaf(p1[r], C, mnC);
#pragma unroll
    for (int r = 0; r < 16; ++r) p0[r] = __builtin_amdgcn_exp2f(p0[r]);
}
__device__ __forceinline__ void finishSM(f32x16& p0, f32x16& p1, float alpha, float& l_reg, bf16x8& pa0, bf16x8& pa1, bf16x8& pa2, bf16x8& pa3) {
#pragma unroll
    for (int r = 0; r < 16; ++r) p1[r] = __builtin_amdgcn_exp2f(p1[r]);
    float ps = 0;
#pragma unroll
    for (int r = 0; r < 16; ++r) ps += p0[r];
#pragma unroll
    for (int r = 0; r < 16; ++r) ps += p1[r];
    { auto rr = __builtin_amdgcn_permlane32_swap(__float_as_uint(ps), __float_as_uint(ps), false, false);
      ps = __uint_as_float(rr[0]) + __uint_as_float(rr[1]); }
    l_reg = l_reg * alpha + ps;
#define PK4(P, BASE, OUT) do { unsigned a0 = cvt_pk_bf16(P[BASE + 0], P[BASE + 1]), a1 = cvt_pk_bf16(P[BASE + 2], P[BASE + 3]);   \
    unsigned b0 = cvt_pk_bf16(P[BASE + 4], P[BASE + 5]), b1 = cvt_pk_bf16(P[BASE + 6], P[BASE + 7]);                              \
    auto r0 = __builtin_amdgcn_permlane32_swap(a0, b0, false, false); auto r1 = __builtin_amdgcn_permlane32_swap(a1, b1, false, false); \
    u32x4 w = {r0[0], r1[0], r0[1], r1[1]}; OUT = *reinterpret_cast<bf16x8*>(&w); } while (0)
    PK4(p0, 0, pa0); PK4(p0, 8, pa1); PK4(p1, 0, pa2); PK4(p1, 8, pa3);
#undef PK4
}
__device__ __forceinline__ void qkt(f32x16& p0, f32x16& p1, const LAS char* Ks, const bf16x8 (&qr)[8], const LAS char* qrope, int r32, int hi) {
    p0 = f32x16{}; p1 = f32x16{};
    const LAS char* k0 = Ks + r32 * KPITCH + hi * 16;
#pragma unroll
    for (int d0 = 0; d0 < 8; ++d0) {
        const bf16x8 b0 = *(const LAS bf16x8*)(k0 + d0 * 32);
        const bf16x8 b1 = *(const LAS bf16x8*)(k0 + 32 * KPITCH + d0 * 32);
        p0 = __builtin_amdgcn_mfma_f32_32x32x16_bf16(b0, qr[d0], p0, 0, 0, 0);
        p1 = __builtin_amdgcn_mfma_f32_32x32x16_bf16(b1, qr[d0], p1, 0, 0, 0); }
#pragma unroll
    for (int d0 = 8; d0 < 12; ++d0) {
        const bf16x8 b0 = *(const LAS bf16x8*)(k0 + d0 * 32);
        const bf16x8 b1 = *(const LAS bf16x8*)(k0 + 32 * KPITCH + d0 * 32);
        const bf16x8 qf = *(const LAS bf16x8*)(qrope + (d0 - 8) * 32);
        p0 = __builtin_amdgcn_mfma_f32_32x32x16_bf16(b0, qf, p0, 0, 0, 0);
        p1 = __builtin_amdgcn_mfma_f32_32x32x16_bf16(b1, qf, p1, 0, 0, 0); }
}
__device__ __forceinline__ int v_st(int k, int c) { const int kk = (k & ~0xC) | ((k & 4) << 1) | ((k & 8) >> 1); return ((kk >> 3) * 4 + (c >> 5)) * 512 + ((kk & 7) * 32 + (c & 31)) * 2; }
__device__ __forceinline__ int v_rd_base(int lane) { return ((lane & 3) << 3) | (((lane >> 2) & 3) << 6) | (((lane >> 4) & 1) << 5) | (((lane >> 5) & 1) << 8); }
constexpr int v_rd_off(int d0, int ks, int half) { return d0 * 512 + ks * 4096 + half * 2048; }
template <int OFF> __device__ __forceinline__ s16x4 tr_read(int vb) {
    s16x4 r; asm volatile("ds_read_b64_tr_b16 %0, %1 offset:%2" : "=&v"(r) : "v"(vb), "i"(OFF) : "memory"); return r;
}
template <int D0> __device__ __forceinline__ void pv_one(f32x16& od, int vb, bf16x8 pa0, bf16x8 pa1, bf16x8 pa2, bf16x8 pa3) {
    const s16x4 l0 = tr_read<v_rd_off(D0, 0, 0)>(vb), h0 = tr_read<v_rd_off(D0, 0, 1)>(vb), l1 = tr_read<v_rd_off(D0, 1, 0)>(vb), h1 = tr_read<v_rd_off(D0, 1, 1)>(vb);
    const s16x4 l2 = tr_read<v_rd_off(D0, 2, 0)>(vb), h2 = tr_read<v_rd_off(D0, 2, 1)>(vb), l3 = tr_read<v_rd_off(D0, 3, 0)>(vb), h3 = tr_read<v_rd_off(D0, 3, 1)>(vb);
    asm volatile("s_waitcnt lgkmcnt(0)" ::: "memory"); SBAR();
#define PK(L, H) (bf16x8){L[0], L[1], L[2], L[3], H[0], H[1], H[2], H[3]}
    od = __builtin_amdgcn_mfma_f32_32x32x16_bf16(pa0, PK(l0, h0), od, 0, 0, 0);
    od = __builtin_amdgcn_mfma_f32_32x32x16_bf16(pa1, PK(l1, h1), od, 0, 0, 0);
    od = __builtin_amdgcn_mfma_f32_32x32x16_bf16(pa2, PK(l2, h2), od, 0, 0, 0);
    od = __builtin_amdgcn_mfma_f32_32x32x16_bf16(pa3, PK(l3, h3), od, 0, 0, 0);
#undef PK
}
__device__ __forceinline__ void pv_d0(f32x16 (&o)[4], int vb, bf16x8 pa0, bf16x8 pa1, bf16x8 pa2, bf16x8 pa3) {
    pv_one<0>(o[0], vb, pa0, pa1, pa2, pa3); pv_one<1>(o[1], vb, pa0, pa1, pa2, pa3); pv_one<2>(o[2], vb, pa0, pa1, pa2, pa3); pv_one<3>(o[3], vb, pa0, pa1, pa2, pa3);
}
__device__ __forceinline__ float bflo(unsigned w) { return __uint_as_float(w << 16); }
__device__ __forceinline__ float bfhi(unsigned w) { return __uint_as_float(w & 0xffff0000u); }

struct AttnArgs { const bf16_t* lat; const bf16_t* wqn; const bf16_t* Q; const bf16_t* Kb; const bf16_t* Vb; const float* ssp; const float2* cs; const float* q_g; const bf16_t *u, *gb, *sg; const float* conv_w; bf16_t* merged; };

template <int MODE> __device__ __forceinline__ void attn_unit(const AttnArgs& T, int b, int h, int qb, LAS char* lds) {
    int tid = threadIdx.x; asm volatile("" : "+v"(tid));
    const int lane = tid & 63, r32 = lane & 31, hi = lane >> 5; const int wid = __builtin_amdgcn_readfirstlane(tid >> 6);
    LAS char* V_lds = lds + OFF_V; LAS char* K_lds = lds + OFF_K;
    LAS float* ws = (LAS float*)(lds + OFF_WS) + wid * 64; LAS float* li_l = ws; LAS float* al_l = ws + 32;
    const int mrow = b * SEQ + qb * 256 + wid * QBLK + r32;
    const bf16_t* Kh = T.Kb + (size_t)(b * NH + h) * SEQ * QKH; const bf16_t* Vh = T.Vb + (size_t)(b * NH + h) * SEQ * VH;
    const int sr = tid >> 4, sc = (tid & 15) * 8, vst0 = v_st(sr, sc), vst1 = v_st(32 + sr, sc);
    const int kdst = (tid >> 3) * KPITCH + (tid & 7) * 48;
    const int vb0 = (int)(uintptr_t)V_lds + v_rd_base(lane);
    bf16x8 sk0, sk1, sk2, sv0, sv1;
#define SLOAD(t) do { const bf16_t* kp = Kh + (size_t)(t) * KVBLK * QKH + tid * 24; sk0 = *(const bf16x8*)kp; sk1 = *(const bf16x8*)(kp + 8); sk2 = *(const bf16x8*)(kp + 16); \
    const bf16_t* vp = Vh + (size_t)((t) * KVBLK + sr) * VH + sc; sv0 = *(const bf16x8*)vp; sv1 = *(const bf16x8*)(vp + 32 * VH); } while (0)
#define SWRITE(bf) do { *(LAS bf16x8*)(V_lds + (bf) * SHM_V + vst0) = sv0; *(LAS bf16x8*)(V_lds + (bf) * SHM_V + vst1) = sv1; \
    *(LAS bf16x8*)(K_lds + (bf) * SHM_K + kdst) = sk0; *(LAS bf16x8*)(K_lds + (bf) * SHM_K + kdst + 16) = sk1; *(LAS bf16x8*)(K_lds + (bf) * SHM_K + kdst + 32) = sk2; } while (0)
#define RESC(a) do { if (__any((a) < 1.f)) { if (hi == 0) al_l[r32] = (a); asm volatile("s_waitcnt lgkmcnt(0)" ::: "memory"); \
    _Pragma("unroll") for (int d = 0; d < 4; ++d) _Pragma("unroll") for (int r = 0; r < 16; ++r) o[d][r] *= al_l[crow(r, hi)]; } } while (0)
    SLOAD(0);
    bf16x8 qr[8];
    LAS char* qrope = lds + OFF_QR + wid * (32 * QRP) + r32 * QRP + hi * 16;
    {
        const bf16_t* Qw = T.Q + (size_t)mrow * 1536 + h * QKH + hi * 8;
        u32x4 raw[12];
#pragma unroll
        for (int d0 = 0; d0 < 12; ++d0) raw[d0] = *(const u32x4*)(Qw + d0 * 16);
        const f32x2 sq2 = *(const f32x2*)(T.ssp + (size_t)mrow * 4); const float ssq = sq2[0] + sq2[1];
        float ss = 0.f;
#pragma unroll
        for (int d0 = 0; d0 < 12; ++d0)
#pragma unroll
            for (int e = 0; e < 4; ++e) { const float a = bflo(raw[d0][e]), c = bfhi(raw[d0][e]); ss += a * a + c * c; }
        { auto rr = __builtin_amdgcn_permlane32_swap(__float_as_uint(ss), __float_as_uint(ss), false, false); ss = __uint_as_float(rr[0]) + __uint_as_float(rr[1]); }
        const float rq2 = 1.f / (ssq * (1.f / QL) + EPS);
        const float rn = 1.f / sqrtf(ss * rq2 * (1.f / QKH) + EPS) * sqrtf(rq2);
#pragma unroll
        for (int d0 = 0; d0 < 8; ++d0) { const f32x4 g0 = *(const f32x4*)(T.q_g + d0 * 16 + hi * 8), g1 = *(const f32x4*)(T.q_g + d0 * 16 + hi * 8 + 4);
            u32x4 w; w.x = cvt_pk_bf16(bflo(raw[d0].x) * rn * g0[0], bfhi(raw[d0].x) * rn * g0[1]); w.y = cvt_pk_bf16(bflo(raw[d0].y) * rn * g0[2], bfhi(raw[d0].y) * rn * g0[3]);
            w.z = cvt_pk_bf16(bflo(raw[d0].z) * rn * g1[0], bfhi(raw[d0].z) * rn * g1[1]); w.w = cvt_pk_bf16(bflo(raw[d0].w) * rn * g1[2], bfhi(raw[d0].w) * rn * g1[3]);
            qr[d0] = *reinterpret_cast<bf16x8*>(&w); }
#pragma unroll
        for (int p = 0; p < 2; ++p) {
            const int ib = 16 * p + 8 * hi;
            float x1[8], x2[8];
            const f32x4 ga = *(const f32x4*)(T.q_g + 128 + ib), gb_ = *(const f32x4*)(T.q_g + 128 + ib + 4), gc = *(const f32x4*)(T.q_g + 160 + ib), gd = *(const f32x4*)(T.q_g + 160 + ib + 4);
            const float g1v[8] = {ga[0], ga[1], ga[2], ga[3], gb_[0], gb_[1], gb_[2], gb_[3]}, g2v[8] = {gc[0], gc[1], gc[2], gc[3], gd[0], gd[1], gd[2], gd[3]};
#pragma unroll
            for (int e = 0; e < 4; ++e) { x1[2 * e] = bflo(raw[8 + p][e]) * rn * g1v[2 * e]; x1[2 * e + 1] = bfhi(raw[8 + p][e]) * rn * g1v[2 * e + 1];
                                          x2[2 * e] = bflo(raw[10 + p][e]) * rn * g2v[2 * e]; x2[2 * e + 1] = bfhi(raw[10 + p][e]) * rn * g2v[2 * e + 1]; }
            float y1[8], y2[8];
#pragma unroll
            for (int jj = 0; jj < 4; ++jj) { const f32x4 c2 = *(const f32x4*)((const float*)T.cs + ((size_t)mrow * 32 + ib + 2 * jj) * 2);
                y1[2 * jj] = x1[2 * jj] * c2[0] - x2[2 * jj] * c2[1]; y2[2 * jj] = x2[2 * jj] * c2[0] + x1[2 * jj] * c2[1];
                y1[2 * jj + 1] = x1[2 * jj + 1] * c2[2] - x2[2 * jj + 1] * c2[3]; y2[2 * jj + 1] = x2[2 * jj + 1] * c2[2] + x1[2 * jj + 1] * c2[3]; }
            u32x4 w1, w2; w1.x = cvt_pk_bf16(y1[0], y1[1]); w1.y = cvt_pk_bf16(y1[2], y1[3]); w1.z = cvt_pk_bf16(y1[4], y1[5]); w1.w = cvt_pk_bf16(y1[6], y1[7]);
            w2.x = cvt_pk_bf16(y2[0], y2[1]); w2.y = cvt_pk_bf16(y2[2], y2[3]); w2.z = cvt_pk_bf16(y2[4], y2[5]); w2.w = cvt_pk_bf16(y2[6], y2[7]);
            *(LAS u32x4*)(qrope + p * 32) = w1; *(LAS u32x4*)(qrope + (2 + p) * 32) = w2; }
        asm volatile("s_waitcnt lgkmcnt(0)" ::: "memory");
    }
    float m_reg = -1e30f, l_reg = 0.f; f32x16 o[4] = {};
    f32x16 pA0, pA1, pB0, pB1; float alA = 1.f, alB = 1.f; bf16x8 pa0, pa1, pa2, pa3;
    const int NT = 4 * qb + 4; const int wp = wid >> 1;
    const bool a1 = wp >= 1, a2 = wp >= 2, a3 = wp >= 3;
    const LAS char* K0 = K_lds; const LAS char* K1 = K_lds + SHM_K;
    asm volatile("s_waitcnt vmcnt(0)" ::: "memory"); SWRITE(0); __syncthreads();
    qkt(pA0, pA1, K0, qr, qrope, r32, hi); partialSM(pA0, pA1, m_reg, alA);
    SLOAD(1); asm volatile("s_waitcnt vmcnt(0)" ::: "memory"); SWRITE(1); __syncthreads();
    for (int j = 1; j + 3 < NT; j += 2) {
        SBAR(); qkt(pB0, pB1, K1, qr, qrope, r32, hi);
        finishSM(pA0, pA1, alA, l_reg, pa0, pa1, pa2, pa3); SBAR();
        SLOAD(j + 1); SBAR();
        pv_d0(o, vb0, pa0, pa1, pa2, pa3); partialSM(pB0, pB1, m_reg, alB);
        __syncthreads(); asm volatile("s_waitcnt vmcnt(0)" ::: "memory"); SWRITE(0);
        RESC(alB); __syncthreads();
        SBAR(); qkt(pA0, pA1, K0, qr, qrope, r32, hi);
        finishSM(pB0, pB1, alB, l_reg, pa0, pa1, pa2, pa3); SBAR();
        SLOAD(j + 2); SBAR();
        pv_d0(o, vb0 + SHM_V, pa0, pa1, pa2, pa3); partialSM(pA0, pA1, m_reg, alA);
        __syncthreads(); asm volatile("s_waitcnt vmcnt(0)" ::: "memory"); SWRITE(1);
        RESC(alA); __syncthreads();
    }
#define MASK(P0, P1, act) do { if (!(act)) { _Pragma("unroll") for (int r = 0; r < 16; ++r) { P0[r] = -INFINITY; P1[r] = -INFINITY; } } } while (0)
    {
        SBAR(); if (a1) qkt(pB0, pB1, K1, qr, qrope, r32, hi); MASK(pB0, pB1, a1);
        finishSM(pA0, pA1, alA, l_reg, pa0, pa1, pa2, pa3); SBAR();
        SLOAD(NT - 2); SBAR();
        pv_d0(o, vb0, pa0, pa1, pa2, pa3); partialSM(pB0, pB1, m_reg, alB);
        __syncthreads(); asm volatile("s_waitcnt vmcnt(0)" ::: "memory"); SWRITE(0);
        RESC(alB); __syncthreads();
        SBAR(); if (a2) qkt(pA0, pA1, K0, qr, qrope, r32, hi); MASK(pA0, pA1, a2);
        finishSM(pB0, pB1, alB, l_reg, pa0, pa1, pa2, pa3); SBAR();
        SLOAD(NT - 1); SBAR();
        pv_d0(o, vb0 + SHM_V, pa0, pa1, pa2, pa3); partialSM(pA0, pA1, m_reg, alA);
        __syncthreads(); asm volatile("s_waitcnt vmcnt(0)" ::: "memory"); SWRITE(1);
        RESC(alA); __syncthreads();
        SBAR(); if (a3) qkt(pB0, pB1, K1, qr, qrope, r32, hi); MASK(pB0, pB1, a3);
        finishSM(pA0, pA1, alA, l_reg, pa0, pa1, pa2, pa3); SBAR();
        pv_d0(o, vb0, pa0, pa1, pa2, pa3); partialSM(pB0, pB1, m_reg, alB);
        RESC(alB);
        finishSM(pB0, pB1, alB, l_reg, pa0, pa1, pa2, pa3); SBAR();
        pv_d0(o, vb0 + SHM_V, pa0, pa1, pa2, pa3);
    }
#undef MASK
    if (hi == 0) li_l[r32] = l_reg; asm volatile("s_waitcnt lgkmcnt(0)" ::: "memory");
    float rli[16];
#pragma unroll
    for (int r = 0; r < 16; ++r) rli[r] = __builtin_amdgcn_rcpf(li_l[crow(r, hi)]);
    __syncthreads();
    LAS bf16_t* stg = (LAS bf16_t*)(lds + wid * 8192);
#pragma unroll
    for (int r = 0; r < 16; ++r) { const int orow = crow(r, hi);
#pragma unroll
        for (int d0 = 0; d0 < 4; ++d0) stg[orow * 128 + d0 * 32 + r32] = f2bf(o[d0][r] * rli[r]); }
    asm volatile("s_waitcnt lgkmcnt(0)" ::: "memory");
    if (MODE != 1) {
        const int ch = lane & 15, c = h * VH + ch * 8;
        const f32x4 w0a = *(const f32x4*)(T.conv_w + c), w0b = *(const f32x4*)(T.conv_w + c + 4), w1a = *(const f32x4*)(T.conv_w + DM + c), w1b = *(const f32x4*)(T.conv_w + DM + c + 4),
              w2a = *(const f32x4*)(T.conv_w + 2 * DM + c), w2b = *(const f32x4*)(T.conv_w + 2 * DM + c + 4);
        const float cw0[8] = {w0a[0], w0a[1], w0a[2], w0a[3], w0b[0], w0b[1], w0b[2], w0b[3]}, cw1[8] = {w1a[0], w1a[1], w1a[2], w1a[3], w1b[0], w1b[1], w1b[2], w1b[3]},
                    cw2[8] = {w2a[0], w2a[1], w2a[2], w2a[3], w2b[0], w2b[1], w2b[2], w2b[3]};
#pragma unroll 4
        for (int i = 0; i < 8; ++i) { const int row = i * 4 + (lane >> 4); const int tt = qb * 256 + wid * QBLK + row; const size_t e = (size_t)(b * SEQ + tt) * DM + c;
            const u32x4 ov = *(const LAS u32x4*)(stg + row * 128 + ch * 8);
            const u32x4 u0 = *(const u32x4*)(T.u + e), gbv = *(const u32x4*)(T.gb + e), sgv = *(const u32x4*)(T.sg + e);
            u32x4 u1 = {0u, 0u, 0u, 0u}, u2 = {0u, 0u, 0u, 0u};
            if (tt >= 1) u1 = *(const u32x4*)(T.u + e - DM);
            if (tt >= 2) u2 = *(const u32x4*)(T.u + e - 2 * DM);
            u32x4 res;
#pragma unroll
            for (int q = 0; q < 4; ++q) {
                const float cl = cw0[2 * q] * bflo(u2[q]) + cw1[2 * q] * bflo(u1[q]) + cw2[2 * q] * bflo(u0[q]), chh = cw0[2 * q + 1] * bfhi(u2[q]) + cw1[2 * q + 1] * bfhi(u1[q]) + cw2[2 * q + 1] * bfhi(u0[q]);
                res[q] = cvt_pk_bf16(bflo(gbv[q]) * cl + bflo(sgv[q]) * bflo(ov[q]), bfhi(gbv[q]) * chh + bfhi(sgv[q]) * bfhi(ov[q])); }
            *(u32x4*)(T.merged + e) = res; }
    }
    asm volatile("s_waitcnt lgkmcnt(0)" ::: "memory");
    __syncthreads();
#undef SLOAD
#undef SWRITE
#undef RESC
}

constexpr int K2_BYTES = KVBLK * QKH * 2, V2_OFF = 0, K2_OFF = 3 * SHM_V, WS2_OFF = K2_OFF + 2 * K2_BYTES, ATT2_LDS = WS2_OFF + NW * 64 * 4;
__device__ __forceinline__ void qkt2(f32x16& p0, f32x16& p1, const LAS char* Krow, const int (&koff)[4], const bf16x8 (&qr)[12]) {
    p0 = f32x16{}; p1 = f32x16{};
    bf16x8 fa[4], fb[4];
#define KRD(dst, d0) do { const LAS char* a_ = Krow + ((d0) >> 2) * 128 + koff[(d0) & 3]; dst[0] = *(const LAS bf16x8*)a_; dst[1] = *(const LAS bf16x8*)(a_ + 32 * QKH * 2); \
                          const LAS char* c_ = Krow + (((d0) + 1) >> 2) * 128 + koff[((d0) + 1) & 3]; dst[2] = *(const LAS bf16x8*)c_; dst[3] = *(const LAS bf16x8*)(c_ + 32 * QKH * 2); } while (0)
#define KMM(src, d0) do { p0 = __builtin_amdgcn_mfma_f32_32x32x16_bf16(src[0], qr[d0], p0, 0, 0, 0); p1 = __builtin_amdgcn_mfma_f32_32x32x16_bf16(src[1], qr[d0], p1, 0, 0, 0); \
                          p0 = __builtin_amdgcn_mfma_f32_32x32x16_bf16(src[2], qr[(d0) + 1], p0, 0, 0, 0); p1 = __builtin_amdgcn_mfma_f32_32x32x16_bf16(src[3], qr[(d0) + 1], p1, 0, 0, 0); } while (0)
    KRD(fa, 0); KRD(fb, 2);
    KMM(fa, 0); KRD(fa, 4);
    KMM(fb, 2); KRD(fb, 6);
    KMM(fa, 4); KRD(fa, 8);
    KMM(fb, 6); KRD(fb, 10);
    KMM(fa, 8);
    KMM(fb, 10);
#undef KRD
#undef KMM
}
template <int MODE> __device__ __forceinline__ void attn_unit2(const AttnArgs& T, int b, int h, int qb, LAS char* lds) {
    int tid = threadIdx.x; asm volatile("" : "+v"(tid));
    const int lane = tid & 63, r32 = lane & 31, hi = lane >> 5; const int wid = __builtin_amdgcn_readfirstlane(tid >> 6);
    LAS char* V_lds = lds + V2_OFF; LAS char* K_lds = lds + K2_OFF;
    LAS float* ws = (LAS float*)(lds + WS2_OFF) + wid * 64; LAS float* li_l = ws; LAS float* al_l = ws + 32;
    const int mrow = b * SEQ + qb * 256 + wid * QBLK + r32;
    const char* Kh = (const char*)(T.Kb + (size_t)(b * NH + h) * SEQ * QKH); const char* Vh = (const char*)(T.Vb + (size_t)(b * NH + h) * SEQ * VH);
#define DMA_KV(t, kbuf, vbuf) do { const char* kt = Kh + (size_t)(t) * K2_BYTES; const char* vt = Vh + (size_t)(t) * SHM_V; int ln = lane; asm volatile("" : "+v"(ln)); \
    _Pragma("unroll") for (int _i = 0; _i < 3; ++_i) { const int q = (wid * 3 + _i) * 64 + ln, r = q / 24, cp = q - r * 24, c = (cp & ~7) | ((cp & 7) ^ ((r >> 1) & 7)); \
        __builtin_amdgcn_global_load_lds((const unsigned*)(kt + (unsigned)(r * 384 + c * 16)), (LAS unsigned*)(K_lds + (kbuf) * K2_BYTES + (wid * 3 + _i) * 1024), 16, 0, 0); } \
    _Pragma("unroll") for (int _i = 0; _i < 2; ++_i) { const int q = (wid * 2 + _i) * 64 + ln, sub = q >> 5, w = q & 31, kk = ((sub >> 2) << 3) | (w >> 2), k = (kk & ~0xC) | ((kk & 4) << 1) | ((kk & 8) >> 1), c = ((sub & 3) << 5) | ((w & 3) << 3); \
        __builtin_amdgcn_global_load_lds((const unsigned*)(vt + (unsigned)(k * 256 + c * 2)), (LAS unsigned*)(V_lds + (vbuf) * SHM_V + (wid * 2 + _i) * 1024), 16, 0, 0); } } while (0)
#define RESC(a) do { if (__any((a) < 1.f)) { if (hi == 0) al_l[r32] = (a); asm volatile("s_waitcnt lgkmcnt(0)" ::: "memory"); \
    _Pragma("unroll") for (int d = 0; d < 4; ++d) _Pragma("unroll") for (int r = 0; r < 16; ++r) o[d][r] *= al_l[crow(r, hi)]; } } while (0)
    DMA_KV(0, 0, 0);
    const int vb0 = (int)(uintptr_t)V_lds + v_rd_base(lane);
    const LAS char* Krow = K_lds + r32 * (QKH * 2);
    int koff[4];
    { const int sw = (r32 >> 1) & 7;
#pragma unroll
      for (int j = 0; j < 4; ++j) koff[j] = ((2 * j + hi) ^ sw) * 16; }
    bf16x8 qr[12];
    {
        const bf16_t* Qw = T.Q + (size_t)mrow * 1536 + h * QKH + hi * 8;
        u32x4 raw[12];
#pragma unroll
        for (int d0 = 0; d0 < 12; ++d0) raw[d0] = *(const u32x4*)(Qw + d0 * 16);
        const f32x2 sq2 = *(const f32x2*)(T.ssp + (size_t)mrow * 4); const float ssq = sq2[0] + sq2[1];
        float ss = 0.f;
#pragma unroll
        for (int d0 = 0; d0 < 12; ++d0)
#pragma unroll
            for (int e = 0; e < 4; ++e) { const float a = bflo(raw[d0][e]), c = bfhi(raw[d0][e]); ss += a * a + c * c; }
        { auto rr = __builtin_amdgcn_permlane32_swap(__float_as_uint(ss), __float_as_uint(ss), false, false); ss = __uint_as_float(rr[0]) + __uint_as_float(rr[1]); }
        const float rq2 = 1.f / (ssq * (1.f / QL) + EPS);
        const float rn = 1.f / sqrtf(ss * rq2 * (1.f / QKH) + EPS) * sqrtf(rq2);
#pragma unroll
        for (int d0 = 0; d0 < 8; ++d0) { const f32x4 g0 = *(const f32x4*)(T.q_g + d0 * 16 + hi * 8), g1 = *(const f32x4*)(T.q_g + d0 * 16 + hi * 8 + 4);
            u32x4 w; w.x = cvt_pk_bf16(bflo(raw[d0].x) * rn * g0[0], bfhi(raw[d0].x) * rn * g0[1]); w.y = cvt_pk_bf16(bflo(raw[d0].y) * rn * g0[2], bfhi(raw[d0].y) * rn * g0[3]);
            w.z = cvt_pk_bf16(bflo(raw[d0].z) * rn * g1[0], bfhi(raw[d0].z) * rn * g1[1]); w.w = cvt_pk_bf16(bflo(raw[d0].w) * rn * g1[2], bfhi(raw[d0].w) * rn * g1[3]);
            qr[d0] = *reinterpret_cast<bf16x8*>(&w); }
#pragma unroll
        for (int p = 0; p < 2; ++p) {
            const int ib = 16 * p + 8 * hi;
            float x1[8], x2[8];
            const f32x4 ga = *(const f32x4*)(T.q_g + 128 + ib), gb_ = *(const f32x4*)(T.q_g + 128 + ib + 4), gc = *(const f32x4*)(T.q_g + 160 + ib), gd = *(const f32x4*)(T.q_g + 160 + ib + 4);
            const float g1v[8] = {ga[0], ga[1], ga[2], ga[3], gb_[0], gb_[1], gb_[2], gb_[3]}, g2v[8] = {gc[0], gc[1], gc[2], gc[3], gd[0], gd[1], gd[2], gd[3]};
#pragma unroll
            for (int e = 0; e < 4; ++e) { x1[2 * e] = bflo(raw[8 + p][e]) * rn * g1v[2 * e]; x1[2 * e + 1] = bfhi(raw[8 + p][e]) * rn * g1v[2 * e + 1];
                                          x2[2 * e] = bflo(raw[10 + p][e]) * rn * g2v[2 * e]; x2[2 * e + 1] = bfhi(raw[10 + p][e]) * rn * g2v[2 * e + 1]; }
            float y1[8], y2[8];
#pragma unroll
            for (int jj = 0; jj < 4; ++jj) { const f32x4 c2 = *(const f32x4*)((const float*)T.cs + ((size_t)mrow * 32 + ib + 2 * jj) * 2);
                y1[2 * jj] = x1[2 * jj] * c2[0] - x2[2 * jj] * c2[1]; y2[2 * jj] = x2[2 * jj] * c2[0] + x1[2 * jj] * c2[1];
                y1[2 * jj + 1] = x1[2 * jj + 1] * c2[2] - x2[2 * jj + 1] * c2[3]; y2[2 * jj + 1] = x2[2 * jj + 1] * c2[2] + x1[2 * jj + 1] * c2[3]; }
            u32x4 w1, w2; w1.x = cvt_pk_bf16(y1[0], y1[1]); w1.y = cvt_pk_bf16(y1[2], y1[3]); w1.z = cvt_pk_bf16(y1[4], y1[5]); w1.w = cvt_pk_bf16(y1[6], y1[7]);
            w2.x = cvt_pk_bf16(y2[0], y2[1]); w2.y = cvt_pk_bf16(y2[2], y2[3]); w2.z = cvt_pk_bf16(y2[4], y2[5]); w2.w = cvt_pk_bf16(y2[6], y2[7]);
            qr[8 + p] = *reinterpret_cast<bf16x8*>(&w1); qr[10 + p] = *reinterpret_cast<bf16x8*>(&w2); }
    }
    float m_reg = -1e30f, l_reg = 0.f; f32x16 o[4] = {};
    f32x16 pA0, pA1, pB0, pB1; float alA = 1.f, alB = 1.f; bf16x8 pa0, pa1, pa2, pa3;
    const int NT = 4 * qb + 4; const int wp = wid >> 1;
    const bool a1 = wp >= 1, a2 = wp >= 2, a3 = wp >= 3;
#define MASK(P0, P1, act) do { if (!(act)) { _Pragma("unroll") for (int r = 0; r < 16; ++r) { P0[r] = -INFINITY; P1[r] = -INFINITY; } } } while (0)
#define INTERVAL(PN0, PN1, PO0, PO1, alN, alO, t, act, load) do { \
        if (load) DMA_KV((t) + 1, ((t) + 1) & 1, vnext); \
        SBAR(); if (act) qkt2(PN0, PN1, Krow + ((t) & 1) * K2_BYTES, koff, qr); MASK(PN0, PN1, act); \
        if (MODE == 2) { asm volatile("" : "+v"(PO0), "+v"(PO1)); pa0 = __builtin_bit_cast(bf16x8, (u32x4){__float_as_uint(PO0[0]), __float_as_uint(PO0[1]), __float_as_uint(PO0[2]), __float_as_uint(PO0[3])}); pa1 = pa0; pa2 = pa0; pa3 = pa0; } \
        else finishSM(PO0, PO1, alO, l_reg, pa0, pa1, pa2, pa3); \
        SBAR(); pv_d0(o, vb0 + vprev * SHM_V, pa0, pa1, pa2, pa3); if (MODE == 2) { asm volatile("" : "+v"(PN0), "+v"(PN1)); } else partialSM(PN0, PN1, m_reg, alN); \
        __syncthreads(); RESC(alN); \
        vprev = vcur; vcur = vnext; vnext = (vnext == 2) ? 0 : vnext + 1; } while (0)
    __syncthreads();
    int vprev = 0, vcur = 1, vnext = 2;
    DMA_KV(1, 1, 1);
    qkt2(pA0, pA1, Krow, koff, qr); partialSM(pA0, pA1, m_reg, alA);
    __syncthreads();
    for (int j = 1; j + 3 < NT; j += 2) {
        INTERVAL(pB0, pB1, pA0, pA1, alB, alA, j, true, true);
        INTERVAL(pA0, pA1, pB0, pB1, alA, alB, j + 1, true, true);
    }
    INTERVAL(pB0, pB1, pA0, pA1, alB, alA, NT - 3, a1, true);
    INTERVAL(pA0, pA1, pB0, pB1, alA, alB, NT - 2, a2, true);
    INTERVAL(pB0, pB1, pA0, pA1, alB, alA, NT - 1, a3, false);
    finishSM(pB0, pB1, alB, l_reg, pa0, pa1, pa2, pa3); SBAR();
    pv_d0(o, vb0 + vprev * SHM_V, pa0, pa1, pa2, pa3);
#undef INTERVAL
#undef MASK
    if (hi == 0) li_l[r32] = l_reg; asm volatile("s_waitcnt lgkmcnt(0)" ::: "memory");
    float rli[16];
#pragma unroll
    for (int r = 0; r < 16; ++r) rli[r] = __builtin_amdgcn_rcpf(li_l[crow(r, hi)]);
    __syncthreads();
    LAS bf16_t* stg = (LAS bf16_t*)(lds + wid * 8192);
#pragma unroll
    for (int r = 0; r < 16; ++r) { const int orow = crow(r, hi);
#pragma unroll
        for (int d0 = 0; d0 < 4; ++d0) stg[orow * 128 + d0 * 32 + r32] = f2bf(o[d0][r] * rli[r]); }
    asm volatile("s_waitcnt lgkmcnt(0)" ::: "memory");
    if (MODE == 0) {
        const int g = lane >> 4, ch = lane & 15, c = h * VH + ch * 8; const int t0 = qb * 256 + wid * QBLK;
        const size_t e0 = (size_t)(b * SEQ + t0) * DM + c;
        u32x4 uu[8], gv[8], sv[8];
#pragma unroll
        for (int i = 0; i < 8; ++i) { const size_t e = e0 + (size_t)(4 * i + g) * DM; uu[i] = *(const u32x4*)(T.u + e); gv[i] = __builtin_nontemporal_load((const u32x4*)(T.gb + e)); sv[i] = __builtin_nontemporal_load((const u32x4*)(T.sg + e)); }
        u32x4 uvirt = {0u, 0u, 0u, 0u};
        if (g >= 2 && t0 > 0) uvirt = *(const u32x4*)(T.u + e0 - (size_t)(4 - g) * DM);
        const f32x4 w0a = *(const f32x4*)(T.conv_w + c), w0b = *(const f32x4*)(T.conv_w + c + 4), w1a = *(const f32x4*)(T.conv_w + DM + c), w1b = *(const f32x4*)(T.conv_w + DM + c + 4),
              w2a = *(const f32x4*)(T.conv_w + 2 * DM + c), w2b = *(const f32x4*)(T.conv_w + 2 * DM + c + 4);
        const float cw0[8] = {w0a[0], w0a[1], w0a[2], w0a[3], w0b[0], w0b[1], w0b[2], w0b[3]}, cw1[8] = {w1a[0], w1a[1], w1a[2], w1a[3], w1b[0], w1b[1], w1b[2], w1b[3]},
                    cw2[8] = {w2a[0], w2a[1], w2a[2], w2a[3], w2b[0], w2b[1], w2b[2], w2b[3]};
        const int src1 = ((lane - 16) & 63) << 2, src2 = (lane ^ 32) << 2;
#pragma unroll
        for (int i = 0; i < 8; ++i) { const int row = i * 4 + g; const size_t e = e0 + (size_t)row * DM;
            const u32x4 ov = *(const LAS u32x4*)(stg + row * 128 + ch * 8);
            const u32x4 up = (i == 0) ? uvirt : uu[i > 0 ? i - 1 : 0];
            u32x4 u1, u2, res;
#pragma unroll
            for (int q = 0; q < 4; ++q) { const unsigned x1 = (g == 3) ? up[q] : uu[i][q], x2 = (g >= 2) ? up[q] : uu[i][q];
                u1[q] = (unsigned)__builtin_amdgcn_ds_bpermute(src1, (int)x1); u2[q] = (unsigned)__builtin_amdgcn_ds_bpermute(src2, (int)x2); }
#pragma unroll
            for (int q = 0; q < 4; ++q) {
                const float cl = cw0[2 * q] * bflo(u2[q]) + cw1[2 * q] * bflo(u1[q]) + cw2[2 * q] * bflo(uu[i][q]), chh = cw0[2 * q + 1] * bfhi(u2[q]) + cw1[2 * q + 1] * bfhi(u1[q]) + cw2[2 * q + 1] * bfhi(uu[i][q]);
                res[q] = cvt_pk_bf16(bflo(gv[i][q]) * cl + bflo(sv[i][q]) * bflo(ov[q]), bfhi(gv[i][q]) * chh + bfhi(sv[i][q]) * bfhi(ov[q])); }
            *(u32x4*)(T.merged + e) = res; }
    }
    asm volatile("s_waitcnt lgkmcnt(0)" ::: "memory");
    __syncthreads();
#undef DMA_KV
#undef RESC
}
template <int MODE> __device__ __forceinline__ void attn_unit3(const AttnArgs& T, int b, int h, int qb, LAS char* lds) {
    int tid = threadIdx.x; asm volatile("" : "+v"(tid));
    const int lane = tid & 63, r32 = lane & 31, hi = lane >> 5; const int wid = __builtin_amdgcn_readfirstlane(tid >> 6);
    LAS char* V_lds = lds + V2_OFF; LAS char* K_lds = lds + K2_OFF;
    LAS float* ws = (LAS float*)(lds + WS2_OFF) + wid * 64; LAS float* li_l = ws; LAS float* al_l = ws + 32;
    const int mrow = b * SEQ + qb * 256 + wid * QBLK + r32;
    const char* Kh = (const char*)(T.Kb + (size_t)(b * NH + h) * SEQ * QKH); const char* Vh = (const char*)(T.Vb + (size_t)(b * NH + h) * SEQ * VH);
#define DMA_KV(t, kbuf, vbuf) do { const char* kt = Kh + (size_t)(t) * K2_BYTES; const char* vt = Vh + (size_t)(t) * SHM_V; int ln = lane; asm volatile("" : "+v"(ln)); \
    _Pragma("unroll") for (int _i = 0; _i < 3; ++_i) { const int q = (wid * 3 + _i) * 64 + ln, r = q / 24, cp = q - r * 24, c = (cp & ~7) | ((cp & 7) ^ ((r >> 1) & 7)); \
        __builtin_amdgcn_global_load_lds((const unsigned*)(kt + (unsigned)(r * 384 + c * 16)), (LAS unsigned*)(K_lds + (kbuf) * K2_BYTES + (wid * 3 + _i) * 1024), 16, 0, 0); } \
    _Pragma("unroll") for (int _i = 0; _i < 2; ++_i) { const int q = (wid * 2 + _i) * 64 + ln, sub = q >> 5, w = q & 31, kk = ((sub >> 2) << 3) | (w >> 2), k = (kk & ~0xC) | ((kk & 4) << 1) | ((kk & 8) >> 1), c = ((sub & 3) << 5) | ((w & 3) << 3); \
        __builtin_amdgcn_global_load_lds((const unsigned*)(vt + (unsigned)(k * 256 + c * 2)), (LAS unsigned*)(V_lds + (vbuf) * SHM_V + (wid * 2 + _i) * 1024), 16, 0, 0); } } while (0)
#define RESC(a) do { if (__any((a) < 1.f)) { if (hi == 0) al_l[r32] = (a); asm volatile("s_waitcnt lgkmcnt(0)" ::: "memory"); \
    _Pragma("unroll") for (int d = 0; d < 4; ++d) _Pragma("unroll") for (int r = 0; r < 16; ++r) o[d][r] *= al_l[crow(r, hi)]; } } while (0)
    DMA_KV(0, 0, 0);
    const int vb0 = (int)(uintptr_t)V_lds + v_rd_base(lane);
    const LAS char* Krow = K_lds + r32 * (QKH * 2);
    int koff[4];
    { const int sw = (r32 >> 1) & 7;
#pragma unroll
      for (int j = 0; j < 4; ++j) koff[j] = ((2 * j + hi) ^ sw) * 16; }
    bf16x8 qr[12];
    {
        f32x16 X[6];
#pragma unroll
        for (int blk = 0; blk < 6; ++blk) X[blk] = f32x16{};
        const bf16_t* latq = T.lat + (size_t)mrow * LATW + hi * 8;
        const char* wq = (const char*)(T.wqn + (size_t)h * QKH * QL);
        LAS char* wbuf0 = lds + ATT2_LDS; LAS char* wbuf1 = lds + K2_OFF + K2_BYTES; LAS char* wbuf2 = lds + V2_OFF + SHM_V;
        const int sg_ = (r32 & ~0xC) | ((r32 & 4) << 1) | ((r32 & 8) >> 1);
        const int wsw = (sg_ >> 1) & 7;
        int woff[4];
#pragma unroll
        for (int j = 0; j < 4; ++j) woff[j] = sg_ * 128 + (((2 * j + hi) ^ wsw) << 4);
#define DMA_W(c, buf) do { int ln = lane; asm volatile("" : "+v"(ln)); \
    _Pragma("unroll") for (int _i = 0; _i < 3; ++_i) { const int q_ = (wid * 3 + _i) * 64 + ln, row_ = q_ >> 3, cp_ = q_ & 7, cc_ = cp_ ^ ((row_ >> 1) & 7); \
        __builtin_amdgcn_global_load_lds((const unsigned*)(wq + (size_t)row_ * (QL * 2) + (c) * 128 + cc_ * 16), (LAS unsigned*)((buf) + (wid * 3 + _i) * 1024), 16, 0, 0); } } while (0)
#define WBUF(c) (((c) % 3) == 0 ? wbuf0 : ((c) % 3) == 1 ? wbuf1 : wbuf2)
        DMA_W(0, wbuf0); DMA_W(1, wbuf1);
        bf16x8 lf[4];
#pragma unroll
        for (int s4 = 0; s4 < 4; ++s4) lf[s4] = *(const bf16x8*)(latq + 16 * s4);
        __syncthreads();
#pragma unroll
        for (int c = 0; c < 6; ++c) {
            LAS char* wb = WBUF(c);
            if (c < 4) DMA_W(c + 2, WBUF(c + 2));
            bf16x8 ln_[4];
            if (c < 5) {
#pragma unroll
                for (int s4 = 0; s4 < 4; ++s4) ln_[s4] = *(const bf16x8*)(latq + 64 * (c + 1) + 16 * s4); }
#pragma unroll
            for (int blk = 0; blk < 6; ++blk)
#pragma unroll
                for (int s4 = 0; s4 < 4; ++s4) { const bf16x8 wf = *(const LAS bf16x8*)(wb + blk * 4096 + woff[s4]);
                    X[blk] = __builtin_amdgcn_mfma_f32_32x32x16_bf16(wf, lf[s4], X[blk], 0, 0, 0); }
            if (c < 4) asm volatile("s_waitcnt vmcnt(7)" ::: "memory"); else asm volatile("s_waitcnt vmcnt(0)" ::: "memory");
            asm volatile("s_waitcnt lgkmcnt(0)" ::: "memory"); __builtin_amdgcn_s_barrier(); asm volatile("" ::: "memory");
            if (c < 5) {
#pragma unroll
                for (int s4 = 0; s4 < 4; ++s4) lf[s4] = ln_[s4]; }
        }
#undef WBUF
#undef DMA_W
        const f32x2 sq2 = *(const f32x2*)(T.ssp + (size_t)mrow * 4); const float ssq = sq2[0] + sq2[1];
        float ss = 0.f;
#pragma unroll
        for (int blk = 0; blk < 6; ++blk)
#pragma unroll
            for (int r = 0; r < 16; ++r) ss += X[blk][r] * X[blk][r];
        { auto rr = __builtin_amdgcn_permlane32_swap(__float_as_uint(ss), __float_as_uint(ss), false, false); ss = __uint_as_float(rr[0]) + __uint_as_float(rr[1]); }
        const float rq2 = 1.f / (ssq * (1.f / QL) + EPS);
        const float rn = 1.f / sqrtf(ss * rq2 * (1.f / QKH) + EPS) * sqrtf(rq2);
#pragma unroll
        for (int blk = 0; blk < 4; ++blk)
#pragma unroll
            for (int s = 0; s < 2; ++s) { const f32x4 g0 = *(const f32x4*)(T.q_g + 32 * blk + 16 * s + 8 * hi), g1 = *(const f32x4*)(T.q_g + 32 * blk + 16 * s + 8 * hi + 4);
                u32x4 w; w.x = cvt_pk_bf16(X[blk][8 * s + 0] * rn * g0[0], X[blk][8 * s + 1] * rn * g0[1]); w.y = cvt_pk_bf16(X[blk][8 * s + 2] * rn * g0[2], X[blk][8 * s + 3] * rn * g0[3]);
                w.z = cvt_pk_bf16(X[blk][8 * s + 4] * rn * g1[0], X[blk][8 * s + 5] * rn * g1[1]); w.w = cvt_pk_bf16(X[blk][8 * s + 6] * rn * g1[2], X[blk][8 * s + 7] * rn * g1[3]);
                qr[2 * blk + s] = *reinterpret_cast<bf16x8*>(&w); }
#pragma unroll
        for (int s = 0; s < 2; ++s) {
            const int ib = 16 * s + 8 * hi;
            const f32x4 ga = *(const f32x4*)(T.q_g + 128 + ib), gb_ = *(const f32x4*)(T.q_g + 128 + ib + 4), gc = *(const f32x4*)(T.q_g + 160 + ib), gd = *(const f32x4*)(T.q_g + 160 + ib + 4);
            const float g1v[8] = {ga[0], ga[1], ga[2], ga[3], gb_[0], gb_[1], gb_[2], gb_[3]}, g2v[8] = {gc[0], gc[1], gc[2], gc[3], gd[0], gd[1], gd[2], gd[3]};
            float y1[8], y2[8];
#pragma unroll
            for (int jj = 0; jj < 4; ++jj) { const f32x4 c2 = *(const f32x4*)((const float*)T.cs + ((size_t)mrow * 32 + ib + 2 * jj) * 2);
                const float xa = X[4][8 * s + 2 * jj] * rn * g1v[2 * jj], xb = X[5][8 * s + 2 * jj] * rn * g2v[2 * jj], xc = X[4][8 * s + 2 * jj + 1] * rn * g1v[2 * jj + 1], xd = X[5][8 * s + 2 * jj + 1] * rn * g2v[2 * jj + 1];
                y1[2 * jj] = xa * c2[0] - xb * c2[1]; y2[2 * jj] = xb * c2[0] + xa * c2[1];
                y1[2 * jj + 1] = xc * c2[2] - xd * c2[3]; y2[2 * jj + 1] = xd * c2[2] + xc * c2[3]; }
            u32x4 w1, w2; w1.x = cvt_pk_bf16(y1[0], y1[1]); w1.y = cvt_pk_bf16(y1[2], y1[3]); w1.z = cvt_pk_bf16(y1[4], y1[5]); w1.w = cvt_pk_bf16(y1[6], y1[7]);
            w2.x = cvt_pk_bf16(y2[0], y2[1]); w2.y = cvt_pk_bf16(y2[2], y2[3]); w2.z = cvt_pk_bf16(y2[4], y2[5]); w2.w = cvt_pk_bf16(y2[6], y2[7]);
            qr[8 + s] = *reinterpret_cast<bf16x8*>(&w1); qr[10 + s] = *reinterpret_cast<bf16x8*>(&w2); }
    }
    float m_reg = -1e30f, l_reg = 0.f; f32x16 o[4] = {};
    f32x16 pA0, pA1, pB0, pB1; float alA = 1.f, alB = 1.f; bf16x8 pa0, pa1, pa2, pa3;
    const int NT = 4 * qb + 4; const int wp = wid >> 1;
    const bool a1 = wp >= 1, a2 = wp >= 2, a3 = wp >= 3;
#define MASK(P0, P1, act) do { if (!(act)) { _Pragma("unroll") for (int r = 0; r < 16; ++r) { P0[r] = -INFINITY; P1[r] = -INFINITY; } } } while (0)
#define INTERVAL(PN0, PN1, PO0, PO1, alN, alO, t, act, load) do { \
        if (load) DMA_KV((t) + 1, ((t) + 1) & 1, vnext); \
        SBAR(); if (act) qkt2(PN0, PN1, Krow + ((t) & 1) * K2_BYTES, koff, qr); MASK(PN0, PN1, act); \
        if (MODE == 2) { asm volatile("" : "+v"(PO0), "+v"(PO1)); pa0 = __builtin_bit_cast(bf16x8, (u32x4){__float_as_uint(PO0[0]), __float_as_uint(PO0[1]), __float_as_uint(PO0[2]), __float_as_uint(PO0[3])}); pa1 = pa0; pa2 = pa0; pa3 = pa0; } \
        else finishSM(PO0, PO1, alO, l_reg, pa0, pa1, pa2, pa3); \
        SBAR(); pv_d0(o, vb0 + vprev * SHM_V, pa0, pa1, pa2, pa3); if (MODE == 2) { asm volatile("" : "+v"(PN0), "+v"(PN1)); } else partialSM(PN0, PN1, m_reg, alN); \
        __syncthreads(); RESC(alN); \
        vprev = vcur; vcur = vnext; vnext = (vnext == 2) ? 0 : vnext + 1; } while (0)
    __syncthreads();
    int vprev = 0, vcur = 1, vnext = 2;
    DMA_KV(1, 1, 1);
    qkt2(pA0, pA1, Krow, koff, qr); partialSM(pA0, pA1, m_reg, alA);
    __syncthreads();
    for (int j = 1; j + 3 < NT; j += 2) {
        INTERVAL(pB0, pB1, pA0, pA1, alB, alA, j, true, true);
        INTERVAL(pA0, pA1, pB0, pB1, alA, alB, j + 1, true, true);
    }
    INTERVAL(pB0, pB1, pA0, pA1, alB, alA, NT - 3, a1, true);
    INTERVAL(pA0, pA1, pB0, pB1, alA, alB, NT - 2, a2, true);
    INTERVAL(pB0, pB1, pA0, pA1, alB, alA, NT - 1, a3, false);
    finishSM(pB0, pB1, alB, l_reg, pa0, pa1, pa2, pa3); SBAR();
    pv_d0(o, vb0 + vprev * SHM_V, pa0, pa1, pa2, pa3);
#undef INTERVAL
#undef MASK
    if (hi == 0) li_l[r32] = l_reg; asm volatile("s_waitcnt lgkmcnt(0)" ::: "memory");
    float rli[16];
#pragma unroll
    for (int r = 0; r < 16; ++r) rli[r] = __builtin_amdgcn_rcpf(li_l[crow(r, hi)]);
    __syncthreads();
    LAS bf16_t* stg = (LAS bf16_t*)(lds + wid * 8192);
#pragma unroll
    for (int r = 0; r < 16; ++r) { const int orow = crow(r, hi);
#pragma unroll
        for (int d0 = 0; d0 < 4; ++d0) stg[orow * 128 + d0 * 32 + r32] = f2bf(o[d0][r] * rli[r]); }
    asm volatile("s_waitcnt lgkmcnt(0)" ::: "memory");
    if (MODE == 0) {
        const int g = lane >> 4, ch = lane & 15, c = h * VH + ch * 8; const int t0 = qb * 256 + wid * QBLK;
        const size_t e0 = (size_t)(b * SEQ + t0) * DM + c;
        u32x4 uu[8], gv[8], sv[8];
#pragma unroll
        for (int i = 0; i < 8; ++i) { const size_t e = e0 + (size_t)(4 * i + g) * DM; uu[i] = *(const u32x4*)(T.u + e); gv[i] = __builtin_nontemporal_load((const u32x4*)(T.gb + e)); sv[i] = __builtin_nontemporal_load((const u32x4*)(T.sg + e)); }
        u32x4 uvirt = {0u, 0u, 0u, 0u};
        if (g >= 2 && t0 > 0) uvirt = *(const u32x4*)(T.u + e0 - (size_t)(4 - g) * DM);
        const f32x4 w0a = *(const f32x4*)(T.conv_w + c), w0b = *(const f32x4*)(T.conv_w + c + 4), w1a = *(const f32x4*)(T.conv_w + DM + c), w1b = *(const f32x4*)(T.conv_w + DM + c + 4),
              w2a = *(const f32x4*)(T.conv_w + 2 * DM + c), w2b = *(const f32x4*)(T.conv_w + 2 * DM + c + 4);
        const float cw0[8] = {w0a[0], w0a[1], w0a[2], w0a[3], w0b[0], w0b[1], w0b[2], w0b[3]}, cw1[8] = {w1a[0], w1a[1], w1a[2], w1a[3], w1b[0], w1b[1], w1b[2], w1b[3]},
                    cw2[8] = {w2a[0], w2a[1], w2a[2], w2a[3], w2b[0], w2b[1], w2b[2], w2b[3]};
        const int src1 = ((lane - 16) & 63) << 2, src2 = (lane ^ 32) << 2;
#pragma unroll
        for (int i = 0; i < 8; ++i) { const int row = i * 4 + g; const size_t e = e0 + (size_t)row * DM;
            const u32x4 ov = *(const LAS u32x4*)(stg + row * 128 + ch * 8);
            const u32x4 up = (i == 0) ? uvirt : uu[i > 0 ? i - 1 : 0];
            u32x4 u1, u2, res;
#pragma unroll
            for (int q = 0; q < 4; ++q) { const unsigned x1 = (g == 3) ? up[q] : uu[i][q], x2 = (g >= 2) ? up[q] : uu[i][q];
                u1[q] = (unsigned)__builtin_amdgcn_ds_bpermute(src1, (int)x1); u2[q] = (unsigned)__builtin_amdgcn_ds_bpermute(src2, (int)x2); }
#pragma unroll
            for (int q = 0; q < 4; ++q) {
                const float cl = cw0[2 * q] * bflo(u2[q]) + cw1[2 * q] * bflo(u1[q]) + cw2[2 * q] * bflo(uu[i][q]), chh = cw0[2 * q + 1] * bfhi(u2[q]) + cw1[2 * q + 1] * bfhi(u1[q]) + cw2[2 * q + 1] * bfhi(uu[i][q]);
                res[q] = cvt_pk_bf16(bflo(gv[i][q]) * cl + bflo(sv[i][q]) * bflo(ov[q]), bfhi(gv[i][q]) * chh + bfhi(sv[i][q]) * bfhi(ov[q])); }
            *(u32x4*)(T.merged + e) = res; }
    }
    asm volatile("s_waitcnt lgkmcnt(0)" ::: "memory");
    __syncthreads();
#undef DMA_KV
#undef RESC
}
#undef SBAR
}
#ifndef ATTN_UNIT
#define ATTN_UNIT attn_unit3
#endif
struct Frame {
    LAS unsigned char* lds; volatile LAS unsigned* MISC; unsigned* ctl;
    int tid, lane, wave, vcu, G;
};
__device__ __forceinline__ float wave_sum(float v) {
#pragma unroll
    for (int o = 1; o < 64; o <<= 1) v += __shfl_xor(v, o);
    return v;
}
__device__ __forceinline__ int tcc(int bj, int ch128) { return (bj << 7) | (ch128 & 0x60) | (((ch128 >> 2) & 1) << 4) | (((ch128 >> 3) & 3) << 2) | (ch128 & 3); }
struct MapIn { __device__ __forceinline__ int operator()(int c) const {
    if (c < C_ZB) return 256 * (c >> 7) + tcc(0, c & 127);
    if (c < C_ZC) { const int ch = c - C_ZB; return 256 * (8 + (ch >> 7)) + tcc(0, ch & 127); }
    if (c < C_QL) { const int ch = c - C_ZC; return 256 * (ch >> 7) + tcc(1, ch & 127); }
    if (c < C_KVL) { const int j = c - C_QL; return j < 256 ? 256 * 20 + permL(j) : 256 * 21 + permL(j - 256); }
    if (c < C_KR) return 256 * 22 + permL(c - C_KVL);
    if (c < C_GC) { const int j = c - C_KR, jj = j & 31; return 256 * 21 + 128 + ((jj >> 4) << 5) + ((j >> 5) << 4) + (((jj >> 2) & 3) << 2) + (jj & 3); }
    if (c < C_GM) { const int ch = c - C_GC; return 256 * (8 + (ch >> 7)) + tcc(1, ch & 127); }
    { const int j = c - C_GM; return 256 * (16 + (j >> 8)) + permL(j & 255); } } };
struct MapPerm { __device__ __forceinline__ int operator()(int c) const { return (c & ~255) | permL(c & 255); } };
struct MapId { __device__ __forceinline__ int operator()(int c) const { return c; } };
struct MapOut { __device__ __forceinline__ int operator()(int c) const { return (c & ~255) | (((c >> 5) & 1) << 7) | (((c >> 6) & 3) << 5) | (c & 31); } };
struct MapGU { int n; __device__ __forceinline__ int operator()(int f) const { const int r = f & 127; return 256 * (f >> 7) + ((((r >> 2) & 1) << 7) | ((r >> 5) << 5) | (n << 4) | (((r >> 3) & 3) << 2) | (r & 3)); } };

template <class RowMap>
__device__ __forceinline__ void transpose_item(const float* W, int N, bf16_t* WT, int ldt, const float* kscale, LAS float* scr, int item, int lane, const RowMap& rm) {
    const int nblk = N / 32, kb = item / nblk, nb = item % nblk, k0 = 64 * kb, n0 = 32 * nb;
    float wv[32];
#pragma unroll
    for (int i = 0; i < 32; ++i) wv[i] = __builtin_nontemporal_load(W + (size_t)(k0 + 2 * i + (lane >> 5)) * N + n0 + (lane & 31));
#pragma unroll
    for (int i = 0; i < 32; ++i) { const int kk = 2 * i + (lane >> 5); const float sc = kscale ? kscale[k0 + kk] : 1.f; scr[kk * 33 + (lane & 31)] = wv[i] * sc; }
    asm volatile("s_waitcnt lgkmcnt(0)" ::: "memory");
    const int c = lane & 7;
#pragma unroll
    for (int j = 0; j < 4; ++j) { const int n = (lane >> 3) + 8 * j; const LAS float* s = scr + (8 * c) * 33 + n;
        u32x4 o; o.x = cvt_pk_bf16(s[0 * 33], s[1 * 33]); o.y = cvt_pk_bf16(s[2 * 33], s[3 * 33]); o.z = cvt_pk_bf16(s[4 * 33], s[5 * 33]); o.w = cvt_pk_bf16(s[6 * 33], s[7 * 33]);
        *(u32x4*)(WT + (size_t)rm(n0 + n) * ldt + k0 + 8 * c) = o; }
    asm volatile("s_waitcnt lgkmcnt(0)" ::: "memory");
}
constexpr size_t WS_WIN = WS_WSMALL, WS_WQ = WS_WIN + (size_t)5888 * 1024 * 2, WS_WKV = WS_WQ + (size_t)1536 * 384 * 2, WS_WO = WS_WKV + (size_t)2048 * 256 * 2;
static_assert(WS_WO + (size_t)1024 * 1024 * 2 <= WS_A, "small weights fit below region A");
constexpr size_t WS_EGU = WS_C, WS_EDN = WS_C + (size_t)NEXP * 512 * 1024 * 2;
static_assert(WS_EDN + (size_t)NEXP * 1024 * 256 * 2 <= WS_D, "expert weights fit region C");

__device__ __forceinline__ void p0_weights_tables(const Ptrs& P, Frame& F) {
    LAS float* scr = (LAS float*)(F.lds + RING_OFF + F.wave * 16384);
    const int gw = F.vcu * NWAVES + F.wave, NGW = F.G * NWAVES;
    constexpr int I_IN = (DM / 64) * (DIN / 32), I_Q = (QL / 64) * (1536 / 32), I_KV = (KVL / 64) * (2048 / 32), I_O = (DM / 64) * (DM / 32);
    for (int it = gw; it < I_IN + I_Q + I_KV + I_O; it += NGW) {
        int r = it;
        if (r < I_IN) { transpose_item(P.w_in, DIN, (bf16_t*)(P.ws + WS_WIN), DM, (const float*)nullptr, scr, r, F.lane, MapIn{}); continue; } r -= I_IN;
        if (r < I_Q) { transpose_item(P.w_q_b, 1536, (bf16_t*)(P.ws + WS_WQ), QL, P.q_a_g, scr, r, F.lane, MapId{}); continue; } r -= I_Q;
        if (r < I_KV) { transpose_item(P.w_kv_b, 2048, (bf16_t*)(P.ws + WS_WKV), KVL, P.kv_a_g, scr, r, F.lane, MapPerm{}); continue; } r -= I_KV;
        transpose_item(P.w_o, DM, (bf16_t*)(P.ws + WS_WO), DM, (const float*)nullptr, scr, r, F.lane, MapPerm{});
    }
    {
        const int gt = F.vcu * 512 + F.tid;
        if (gt < 64 * 128) { const int rr = 192 + (gt >> 7), ch = gt & 127; *(u32x4*)((bf16_t*)(P.ws + WS_WIN) + (size_t)(256 * 21 + rr) * DM + ch * 8) = (u32x4){0u, 0u, 0u, 0u}; } }
    {
        float2* cs = (float2*)(P.ws + WS_CS);
        const int i = F.tid & 31;
        const double invrev = exp2(-(double)(2 * i) * (13.287712379549449 / 64.0)) * 0.15915494309189535;
        for (int idx = F.vcu * 512 + F.tid; idx < M * 32; idx += F.G * 512) { const int m = idx >> 5;
            const double t = (double)P.pos[m] * invrev; const float fr = (float)(t - rint(t));
            float2 v; v.x = __builtin_amdgcn_cosf(fr); v.y = __builtin_amdgcn_sinf(fr); cs[idx] = v; } }
    asm volatile("s_waitcnt vmcnt(0) lgkmcnt(0)" ::: "memory"); __syncthreads();
}
__device__ __forceinline__ void p0_mod(const Ptrs& P, Frame& F) {
    if (F.vcu < 192) {
        LAS float* cact = (LAS float*)(F.lds + RING_OFF); LAS float* red = (LAS float*)(F.lds + RING_OFF + 65536);
        for (int idx = F.tid; idx < BATCH * DM; idx += 512) { const float cv = P.c[idx]; cact[idx] = cv / (1.f + __expf(-cv)); }
        __syncthreads();
        const int n0 = 32 * F.vcu, kl = F.lane >> 3, c4 = F.lane & 7;
        f32x4 acc[16];
#pragma unroll
        for (int b = 0; b < 16; ++b) acc[b] = (f32x4){0.f, 0.f, 0.f, 0.f};
        for (int it = 0; it < 16; ++it) { const int k = 128 * F.wave + 8 * it + kl;
            const f32x4 wv = __builtin_nontemporal_load((const f32x4*)(P.w_ada + (size_t)k * 6144 + n0 + 4 * c4));
#pragma unroll
            for (int b = 0; b < 16; ++b) acc[b] += cact[b * DM + k] * wv; }
#pragma unroll
        for (int b = 0; b < 16; ++b)
#pragma unroll
            for (int e = 0; e < 4; ++e) { float v = acc[b][e]; v += __shfl_xor(v, 8); v += __shfl_xor(v, 16); v += __shfl_xor(v, 32); if (kl == 0) red[(F.wave * 16 + b) * 32 + 4 * c4 + e] = v; }
        __syncthreads();
        { const int b = F.tid >> 5, cc = F.tid & 31; float s = P.b_ada[n0 + cc];
#pragma unroll
          for (int w = 0; w < 8; ++w) s += red[(w * 16 + b) * 32 + cc];
          ((float*)(P.ws + WS_MOD))[b * 6144 + n0 + cc] = s; }
        __syncthreads();
    }
}
__device__ __forceinline__ void expert_weight_items(const Ptrs& P, Frame& F, int w, int nw, int k_lo, int k_hi) {
    LAS float* scr = (LAS float*)(F.lds + RING_OFF + F.wave * 16384);
    constexpr int I_G = (DM / 64) * (DEXP / 32), I_D = (DEXP / 64) * (DM / 32);
    for (int k = k_lo; k < k_hi; ++k) { const int it = w + k * nw; if (it >= NEXP * (2 * I_G + I_D)) break;
        const int e = it / (2 * I_G + I_D); int r = it % (2 * I_G + I_D);
        bf16_t* gu = (bf16_t*)(P.ws + WS_EGU) + (size_t)e * 512 * DM; bf16_t* dn = (bf16_t*)(P.ws + WS_EDN) + (size_t)e * DM * DEXP;
        if (r < I_G) { transpose_item(P.w_gate + (size_t)e * DM * DEXP, DEXP, gu, DM, (const float*)nullptr, scr, r, F.lane, MapGU{0}); continue; } r -= I_G;
        if (r < I_G) { transpose_item(P.w_up + (size_t)e * DM * DEXP, DEXP, gu, DM, (const float*)nullptr, scr, r, F.lane, MapGU{1}); continue; } r -= I_G;
        transpose_item(P.w_down + (size_t)e * DEXP * DM, DM, dn, DEXP, (const float*)nullptr, scr, r, F.lane, MapOut{});
    }
}
__device__ __forceinline__ void p1_norm1(const Ptrs& P, Frame& F) {
    const int gw = F.vcu * NWAVES + F.wave, NGW = F.G * NWAVES;
    bf16_t* h = (bf16_t*)(P.ws + WS_A);
    for (int m0 = gw; m0 < M; m0 += 4 * NGW) {
        f32x4 v[4][4]; float s[4];
#pragma unroll
        for (int r = 0; r < 4; ++r) { const int mr = (m0 + r * NGW < M) ? m0 + r * NGW : m0; const f32x4* xr = (const f32x4*)(P.x + (size_t)mr * DM) + F.lane;
#pragma unroll
            for (int j = 0; j < 4; ++j) v[r][j] = __builtin_nontemporal_load(xr + 64 * j); }
#pragma unroll
        for (int r = 0; r < 4; ++r) { float a = 0.f;
#pragma unroll
            for (int j = 0; j < 4; ++j) a += (v[r][j][0] * v[r][j][0] + v[r][j][1] * v[r][j][1]) + (v[r][j][2] * v[r][j][2] + v[r][j][3] * v[r][j][3]);
            s[r] = 1.f / sqrtf(wave_sum(a) * (1.f / DM) + EPS); }
#pragma unroll
        for (int r = 0; r < 4; ++r) { const int m = m0 + r * NGW; if (m >= M) continue; const float* mod = (const float*)(P.ws + WS_MOD) + (m / SEQ) * 6144;
            unsigned long long* o8 = (unsigned long long*)(h + (size_t)m * DM) + F.lane;
#pragma unroll
            for (int j = 0; j < 4; ++j) { const int d = 4 * F.lane + 256 * j;
                const f32x4 g = *(const f32x4*)(P.norm1_g + d), sc = *(const f32x4*)(mod + 1024 + d), sh = *(const f32x4*)(mod + d);
                const f32x4 rr = v[r][j] * s[r] * g * (sc + 1.f) + sh;
                o8[64 * j] = (unsigned long long)cvt_pk_bf16(rr[0], rr[1]) | ((unsigned long long)cvt_pk_bf16(rr[2], rr[3]) << 32); } }
    }
}

constexpr size_t WS_WR = 30 * MiB;
constexpr size_t WS_STOK = WS_RT + 512 * 1024, WS_SW = WS_STOK + 320 * 1024;
constexpr int MAXROWS = 81920, MAXTILES = 320;
constexpr int NPB = 112, MAXTILES2 = 240, MAXROWS2 = MAXTILES2 * 256;
constexpr size_t WS_SDST = WS_SW + 320 * 1024, WS_PTOK = WS_SDST + 320 * 1024;
static_assert(WS_PTOK + (size_t)MAXROWS2 * 4 <= WS_WSMALL, "routing lists fit their region");
constexpr size_t WS_H2 = WS_B, WS_HACT = WS_B + 128 * MiB;
constexpr int H2P = 2 * DM;
constexpr size_t WS_DELTA = WS_D;
constexpr size_t WS_X1B = WS_B + (size_t)DM * 2;
constexpr int CW_T = CW_TILES, CW_T0 = CW_TILES + 1, CW_T2 = CW_TILES + 2, CW_TGRP = CW_TILES + 64, CW_TGRP2 = CW_TILES + 512;
constexpr int CW_HIST2 = 65536;

__device__ __forceinline__ void p0_router_weights(const Ptrs& P, Frame& F) {
    bf16_t* hi = (bf16_t*)(P.ws + WS_WR); bf16_t* lo = hi + 48 * DM;
    for (int idx = F.vcu * 512 + F.tid; idx < 48 * DM; idx += F.G * 512) { const int o = idx >> 10, k = idx & 1023;
        const float v = o < 4 ? P.w_rg[k * 4 + o] : (o < 36 ? P.w_re[k * 32 + o - 4] : 0.f);
        const bf16_t h = f2bf(v); hi[idx] = h; lo[idx] = f2bf(v - bf2f(h)); }
}
template <int MODE> __device__ __forceinline__ void p6_rows(const Ptrs& P, Frame& F) {
    LAS unsigned char* tile = F.lds + RING_OFF + F.wave * 8192;
    LAS float* lg = (LAS float*)(F.lds + RING_OFF + 65536 + F.wave * 1536);
    LAS unsigned char* wch = F.lds + RING_OFF + 77824;
    LAS float* gms = (LAS float*)(F.lds + XCH_OFF);
    LAS unsigned* hist = (LAS unsigned*)(F.lds + LDSCTL_OFF + 1024);
    const bf16_t* WrHi = (const bf16_t*)(P.ws + WS_WR); const bf16_t* WrLo = WrHi + 48 * DM;
    bf16_t* h2 = (bf16_t*)(P.ws + WS_H2); const bf16_t* dl = (const bf16_t*)(P.ws + WS_DELTA);
    int2* rte = (int2*)(P.ws + WS_RT); float2* rtw = (float2*)(P.ws + WS_RT + 256 * 1024);
    const int t = F.lane & 15, q = F.lane >> 4;
    u32x4 wreg[6];
#pragma unroll
    for (int j = 0; j < 6; ++j) { const int id = F.tid + 512 * j, arr = id / 1536, rem = id - arr * 1536, row = rem >> 5, ch = rem & 31; wreg[j] = *(const u32x4*)((arr ? WrLo : WrHi) + (size_t)row * DM + 8 * ch); }
    for (int rb = F.vcu; rb < M / 128; rb += F.G) {
        const int m0 = rb * 128 + F.wave * 16, b = m0 / SEQ;
        const float* mod = (const float*)(P.ws + WS_MOD) + b * 6144;
        __syncthreads();
        if (F.tid < 192) hist[F.tid] = 0u;
        for (int k = F.tid; k < DM; k += 512) { gms[k] = P.norm2_g[k] * (1.f + mod[4096 + k]); gms[DM + k] = mod[3072 + k]; }
        __syncthreads();
#pragma unroll 1
        for (int hb = 0; hb < 2; ++hb) {
            const int mb = m0 + 8 * hb;
            f32x4 xv[8][4]; float rstd[8];
#pragma unroll
            for (int r = 0; r < 8; ++r) { const f32x4* xr = (const f32x4*)(P.x + (size_t)(mb + r) * DM) + F.lane; const u32x2* dr = (const u32x2*)(dl + (size_t)(mb + r) * DM) + F.lane;
#pragma unroll
                for (int c = 0; c < 4; ++c) { const f32x4 x4 = __builtin_nontemporal_load(xr + 64 * c); const u32x2 d = __builtin_nontemporal_load(dr + 64 * c);
                    xv[r][c][0] = x4[0] + __uint_as_float(d.x << 16); xv[r][c][1] = x4[1] + __uint_as_float(d.x & 0xffff0000u); xv[r][c][2] = x4[2] + __uint_as_float(d.y << 16); xv[r][c][3] = x4[3] + __uint_as_float(d.y & 0xffff0000u); } }
#pragma unroll
            for (int r = 0; r < 8; ++r) { float s = 0.f;
#pragma unroll
                for (int c = 0; c < 4; ++c) s += (xv[r][c][0] * xv[r][c][0] + xv[r][c][1] * xv[r][c][1]) + (xv[r][c][2] * xv[r][c][2] + xv[r][c][3] * xv[r][c][3]);
                rstd[r] = 1.f / sqrtf(wave_sum(s) * (1.f / DM) + EPS); }
#pragma unroll
            for (int r = 0; r < 8; ++r)
#pragma unroll
                for (int c = 0; c < 4; ++c) { u32x2 xb_; xb_.x = cvt_pk_bf16(xv[r][c][0], xv[r][c][1]); xb_.y = cvt_pk_bf16(xv[r][c][2], xv[r][c][3]); *(u32x2*)(h2 + (size_t)(mb + r) * H2P + DM + 256 * c + 4 * F.lane) = xb_; }
            f32x4 acc[3];
#pragma unroll
            for (int cb = 0; cb < 3; ++cb) acc[cb] = (f32x4){0.f, 0.f, 0.f, 0.f};
#pragma unroll
            for (int c = 0; c < 4; ++c) {
                const int k0 = 256 * c + 4 * F.lane;
                __syncthreads();
#pragma unroll
                for (int j = 0; j < 6; ++j) { const int id = F.tid + 512 * j, arr = id / 1536, rem = id - arr * 1536, row = rem >> 5, ch = rem & 31;
                    *(LAS u32x4*)(wch + arr * 24576 + row * 512 + ((ch ^ (row & 15)) << 4)) = wreg[j]; }
#pragma unroll
                for (int j = 0; j < 6; ++j) { const int id = F.tid + 512 * j, arr = id / 1536, rem = id - arr * 1536, row = rem >> 5, ch = rem & 31;
                    wreg[j] = *(const u32x4*)((arr ? WrLo : WrHi) + (size_t)row * DM + 256 * ((c + 1) & 3) + 8 * ch); }
                const f32x4 gm = *(const LAS f32x4*)(gms + k0), sh = *(const LAS f32x4*)(gms + DM + k0);
#pragma unroll
                for (int r = 0; r < 8; ++r) { const f32x4 h = xv[r][c] * rstd[r] * gm + sh;
                    u32x2 hi; hi.x = cvt_pk_bf16(h[0], h[1]); hi.y = cvt_pk_bf16(h[2], h[3]);
                    u32x2 lo; lo.x = cvt_pk_bf16(h[0] - __uint_as_float(hi.x << 16), h[1] - __uint_as_float(hi.x & 0xffff0000u)); lo.y = cvt_pk_bf16(h[2] - __uint_as_float(hi.y << 16), h[3] - __uint_as_float(hi.y & 0xffff0000u));
                    *(u32x2*)(h2 + (size_t)(mb + r) * H2P + k0) = hi;
                    const int off = r * 512 + ((((F.lane >> 1) ^ r) & 31) << 4) + ((F.lane & 1) << 3);
                    *(LAS u32x2*)(tile + off) = hi; *(LAS u32x2*)(tile + 4096 + off) = lo; }
                asm volatile("s_waitcnt lgkmcnt(0)" ::: "memory");
                __syncthreads();
#pragma unroll 2
                for (int ks = 0; ks < (MODE == 1 ? 0 : 8); ++ks) { const int tr = t & 7;
                    const int off = tr * 512 + ((((4 * ks + q) ^ tr) & 31) << 4);
                    const bf16x8 bh = *(const LAS bf16x8*)(tile + off), bl = *(const LAS bf16x8*)(tile + 4096 + off);
#pragma unroll
                    for (int cb = 0; cb < 3; ++cb) { const int woff = (16 * cb + t) * 512 + ((((4 * ks + q) ^ t) & 31) << 4);
                        const bf16x8 wh = *(const LAS bf16x8*)(wch + woff), wl = *(const LAS bf16x8*)(wch + 24576 + woff);
                        acc[cb] = __builtin_amdgcn_mfma_f32_16x16x32_bf16(wh, bh, acc[cb], 0, 0, 0);
                        acc[cb] = __builtin_amdgcn_mfma_f32_16x16x32_bf16(wh, bl, acc[cb], 0, 0, 0);
                        acc[cb] = __builtin_amdgcn_mfma_f32_16x16x32_bf16(wl, bh, acc[cb], 0, 0, 0); } }
                asm volatile("s_waitcnt lgkmcnt(0)" ::: "memory");
            }
            if (t < 8) {
#pragma unroll
                for (int cb = 0; cb < 3; ++cb)
#pragma unroll
                    for (int r = 0; r < 4; ++r) lg[t * 48 + 16 * cb + 4 * q + r] = acc[cb][r]; }
            asm volatile("s_waitcnt lgkmcnt(0)" ::: "memory");
            if (MODE != 1 && q == 0 && t < 8) {
                const int m = mb + t;
                const LAS float* l = lg + t * 48;
                float gl[4];
#pragma unroll
                for (int i = 0; i < 4; ++i) gl[i] = l[i] + P.b_rg[i];
                int g = 0; float gmx = gl[0];
#pragma unroll
                for (int i = 1; i < 4; ++i) if (gl[i] > gmx) { gmx = gl[i]; g = i; }
                float se = 0.f;
#pragma unroll
                for (int i = 0; i < 4; ++i) se += __expf(gl[i] - gmx);
                const float pg = 1.f / se;
                float e0v = -3.0e38f, e1v = -3.0e38f; int i0 = 0, i1 = 0;
#pragma unroll
                for (int i = 0; i < 8; ++i) { const float v = l[4 + g * 8 + i] + P.b_re[g * 8 + i];
                    if (v > e0v) { e1v = e0v; i1 = i0; e0v = v; i0 = i; } else if (v > e1v) { e1v = v; i1 = i; } }
                const float p1 = __expf(e1v - e0v), w0 = 1.f / (1.f + p1), w1 = p1 * w0;
                int2 e; e.x = g * 8 + i0; e.y = g * 8 + i1; float2 w; w.x = w0 * pg; w.y = w1 * pg;
                rte[m] = e; rtw[m] = w;
                __hip_atomic_fetch_add(&hist[e.x], 1u, __ATOMIC_RELAXED, __HIP_MEMORY_SCOPE_WORKGROUP); __hip_atomic_fetch_add(&hist[e.y], 1u, __ATOMIC_RELAXED, __HIP_MEMORY_SCOPE_WORKGROUP);
                { const int lo = i0 < i1 ? i0 : i1, hi = i0 < i1 ? i1 : i0;
                  __hip_atomic_fetch_add(&hist[64 + g * 28 + ((lo * (15 - lo)) >> 1) + (hi - lo - 1)], 1u, __ATOMIC_RELAXED, __HIP_MEMORY_SCOPE_WORKGROUP); }
            }
            asm volatile("s_waitcnt lgkmcnt(0)" ::: "memory");
        }
        __syncthreads();
        if (MODE != 1 && F.tid < 64) F.ctl[CW_HIST + rb * 64 + F.tid] = hist[F.tid];
        else if (MODE != 1 && F.tid < 192) F.ctl[CW_HIST2 + rb * 128 + F.tid - 64] = hist[F.tid];
    }
    __syncthreads();
}
__device__ __forceinline__ void p7_sort(const Ptrs& P, Frame& F) {
    LAS unsigned* tot = (LAS unsigned*)(F.lds + RING_OFF);
    LAS unsigned* pre = tot + 64;
    LAS unsigned* rbase = pre + 64;
    LAS unsigned* cnt = rbase + 64;
    LAS unsigned* misc = cnt + 64;
    LAS unsigned* tot2 = tot + 1536; LAS unsigned* pre2 = tot2 + 128; LAS unsigned* rbase2 = pre2 + 128; LAS unsigned* cnt2 = rbase2 + 128;
    LAS unsigned* ptot2 = cnt2 + 128; LAS unsigned* ppre2 = ptot2 + 512;
    int* stok = (int*)(P.ws + WS_STOK); float* sw = (float*)(P.ws + WS_SW); int* sdst = (int*)(P.ws + WS_SDST); int* ptok = (int*)(P.ws + WS_PTOK);
    const int2* rte = (const int2*)(P.ws + WS_RT); const float2* rtw = (const float2*)(P.ws + WS_RT + 256 * 1024);
    const int cw = F.vcu * 7 + F.wave - 1, cnw = F.G * 7; bool first = true;
    for (int rb = F.vcu; rb < M / 128; rb += F.G) {
        __syncthreads();
        {
            LAS unsigned* ptot = misc + 8; LAS unsigned* ppre = ptot + 512;
            const int g = F.tid & 63, pt = F.tid >> 6; unsigned hv[32];
#pragma unroll
            for (int k = 0; k < 32; ++k) hv[k] = F.ctl[CW_HIST + (32 * pt + k) * 64 + g];
            unsigned s = 0u, p = 0u;
#pragma unroll
            for (int k = 0; k < 32; ++k) { if (32 * pt + k == rb) p = s; s += hv[k]; }
            if (rb >= 32 * pt + 32) p = s;
            ptot[pt * 64 + g] = s; ppre[pt * 64 + g] = p;
        }
        {
            const int g2 = F.tid & 127, pt2 = F.tid >> 7; unsigned s = 0u, p = 0u;
            asm volatile("" ::: "memory");
#pragma unroll 1
            for (int kb = 0; kb < 2; ++kb) { unsigned hv[32];
#pragma unroll
                for (int k = 0; k < 32; ++k) hv[k] = F.ctl[CW_HIST2 + (64 * pt2 + 32 * kb + k) * 128 + g2];
#pragma unroll
                for (int k = 0; k < 32; ++k) { if (64 * pt2 + 32 * kb + k == rb) p = s; s += hv[k]; } }
            if (rb >= 64 * pt2 + 64) p = s;
            ptot2[pt2 * 128 + g2] = s; ppre2[pt2 * 128 + g2] = p;
        }
        __syncthreads();
        if (F.tid < 64) { unsigned s = 0u, p = 0u;
#pragma unroll
            for (int pt = 0; pt < 8; ++pt) { s += misc[8 + pt * 64 + F.tid]; p += misc[8 + 512 + pt * 64 + F.tid]; }
            tot[F.tid] = s; pre[F.tid] = p; cnt[F.tid] = 0u; }
        else if (F.tid < 192) { const int g2 = F.tid - 64; unsigned s = 0u, p = 0u;
#pragma unroll
            for (int pt = 0; pt < 4; ++pt) { s += ptot2[pt * 128 + g2]; p += ppre2[pt * 128 + g2]; }
            tot2[g2] = s; pre2[g2] = p; cnt2[g2] = 0u; }
        if (first && F.wave > 0) expert_weight_items(P, F, cw, cnw, 0, 2);
        __syncthreads();
        if (first && F.wave > 0) expert_weight_items(P, F, cw, cnw, 2, 4);
        if (F.wave == 0) {
            const int l = F.lane;
            { const unsigned nt = (tot[l] + 255u) >> 8; unsigned inc = nt;
#pragma unroll
              for (int o = 1; o < 64; o <<= 1) { const unsigned v = __shfl_up(inc, o); if (l >= o) inc += v; }
              const unsigned tb = inc - nt; rbase[l] = tb * 256u;
              const unsigned T = __shfl(inc, 63), T0 = __shfl(inc, 31);
              if (rb == 0) { for (unsigned k = 0; k < nt; ++k) F.ctl[CW_TGRP + tb + k] = (unsigned)l; if (l == 0) { F.ctl[CW_T] = T; F.ctl[CW_T0] = T0; } } }
            unsigned base2 = 0u;
#pragma unroll
            for (int hh = 0; hh < 2; ++hh) { const int bin = 64 * hh + l; const unsigned nt = bin < NPB ? (tot2[bin] + 255u) >> 8 : 0u; unsigned inc = nt;
#pragma unroll
                for (int o = 1; o < 64; o <<= 1) { const unsigned v = __shfl_up(inc, o); if (l >= o) inc += v; }
                const unsigned tb = base2 + inc - nt; rbase2[bin] = tb * 256u;
                if (rb == 0 && bin < NPB) { const int g = bin / 28; int c = bin - g * 28, lo = 0; while (c >= 7 - lo) { c -= 7 - lo; ++lo; } const int hi = lo + 1 + c;
                    for (unsigned k = 0; k < nt; ++k) F.ctl[CW_TGRP2 + tb + k] = (unsigned)(g * 8 + lo) | ((unsigned)(g * 8 + hi) << 8); }
                base2 += __shfl(inc, 63); }
            if (rb == 0 && l == 0) F.ctl[CW_T2] = base2;
            asm volatile("s_waitcnt lgkmcnt(0)" ::: "memory");
        }
        __syncthreads();
        if (F.wave == 0) {
            const unsigned long long ltmask = (1ull << F.lane) - 1ull;
            for (int ch = 0; ch < 2; ++ch) { const int m = rb * 128 + ch * 64 + F.lane; const int2 e = rte[m]; const float2 w = rtw[m];
                const int pg = e.x >> 3, pa = e.x & 7, pb = e.y & 7, plo = pa < pb ? pa : pb, phi = pa < pb ? pb : pa, pbin = pg * 28 + ((plo * (15 - plo)) >> 1) + (phi - plo - 1);
                const unsigned r2 = __hip_atomic_fetch_add(&cnt2[pbin], 1u, __ATOMIC_RELAXED, __HIP_MEMORY_SCOPE_WORKGROUP);
                const unsigned pos2 = rbase2[pbin] + pre2[pbin] + r2;
                ptok[pos2] = m;
                for (int j = 0; j < 2; ++j) { const int ex = j ? e.y : e.x; const float wj = j ? w.y : w.x; unsigned rank = 0u, gsz = 0u;
                    for (int x = 0; x < 32; ++x) { const unsigned long long mk = __ballot(ex == x); if (ex == x) { rank = (unsigned)__popcll(mk & ltmask); gsz = (unsigned)__popcll(mk); } }
                    const int g = ex; const unsigned pos = rbase[g] + pre[g] + cnt[g] + rank;
                    stok[pos] = m; sw[pos] = wj; sdst[pos] = (int)(pos2 * 2u + ((ex & 7) == phi ? 1u : 0u));
                    asm volatile("s_waitcnt lgkmcnt(0)" ::: "memory");
                    if (rank == 0u) cnt[g] += gsz;
                    asm volatile("s_waitcnt lgkmcnt(0)" ::: "memory"); } } }
        if (rb < 64) { const unsigned n = tot[rb], padn = (((n + 255u) >> 8) << 8) - n;
            if ((unsigned)F.tid < padn) { stok[rbase[rb] + n + F.tid] = -1; sw[rbase[rb] + n + F.tid] = 0.f; sdst[rbase[rb] + n + F.tid] = -1; } }
        if (rb < NPB) { const unsigned n = tot2[rb], padn = (((n + 255u) >> 8) << 8) - n;
            if ((unsigned)F.tid < padn) ptok[rbase2[rb] + n + F.tid] = -1; }
        if (first && F.wave > 0) expert_weight_items(P, F, cw, cnw, 4, 1 << 20);
        first = false;
    }
}
struct MoeSched {
    const bf16_t* A; const bf16_t* W; int lda, ldb; const int* stok; const unsigned* tgrp; int t_lo, nun, npn, G, c; size_t wstride; bool gather, split;
    __device__ __forceinline__ bool next(int i, Unit& u) const {
        const int idx = i * G + c, nfull = (nun / G) * G, tail = nun - nfull; int U; u.half = 0;
        if (split && tail > 0 && 2 * tail <= G) { if (idx >= nfull + 2 * tail) return false; if (idx < nfull) U = idx; else { U = nfull + ((idx - nfull) >> 1); u.half = 1 + ((idx - nfull) & 1); } }
        else { if (idx >= nun) return false; U = idx; }
        u.aux = t_lo + U / npn; u.pn = U % npn; u.pm = (int)tgrp[u.aux]; return true; }
    __device__ __forceinline__ const char* abase(const Unit& u) const { return gather ? (const char*)A : (const char*)A + (size_t)(u.aux * BM + (u.half == 2 ? HALF : 0)) * lda * 2; }
    __device__ __forceinline__ const char* bbase(const Unit& u) const { return (const char*)W + (size_t)(u.pm & 31) * wstride + (size_t)u.pn * BM * ldb * 2; }
    __device__ __forceinline__ void avoff(const Unit& u, int R0, int C0, int R1, int C1, unsigned (&v0)[2], unsigned (&v1)[2]) const {
        if (gather) { const int* tk = stok + u.aux * BM + (u.half == 2 ? HALF : 0); const int o1 = u.half ? 0 : HALF; int a = tk[R0], b = tk[R1], c2 = tk[o1 + R0], d = tk[o1 + R1];
            a = a < 0 ? 0 : a; b = b < 0 ? 0 : b; c2 = c2 < 0 ? 0 : c2; d = d < 0 ? 0 : d;
            v0[0] = (unsigned)(a * lda + C0) * 2u; v0[1] = (unsigned)(b * lda + C1) * 2u; v1[0] = (unsigned)(c2 * lda + C0) * 2u; v1[1] = (unsigned)(d * lda + C1) * 2u; }
        else { v0[0] = (unsigned)(R0 * lda + C0) * 2u; v0[1] = (unsigned)(R1 * lda + C1) * 2u; const unsigned h1 = u.half ? 0u : (unsigned)(HALF * lda * 2); v1[0] = v0[0] + h1; v1[1] = v0[1] + h1; } }
};
struct EpiGU {
    bf16_t* hact; const float* sw; const int* sdst;
    __device__ __forceinline__ void operator()(const f32x4 (&acc)[2][2][4][2], const Unit& un, int wr, int wc, int fr, int fq) const {
        asm volatile("" : "+v"(fr), "+v"(fq));
        const int r0 = un.aux * BM + (un.half == 2 ? HALF : 0) + wr * 64 + fr, c0 = 128 * un.pn + 32 * wc + 8 * fq;
#pragma unroll
        for (int ai = 0; ai < 2; ++ai)
#pragma unroll
            for (int m = 0; m < 4; ++m) { if (ai == 1 && un.half) continue; const int row = r0 + ai * HALF + m * 16; const float w = sw[row]; const int dst = sdst[row];
                f32x4 a, b;
#pragma unroll
                for (int i = 0; i < 4; ++i) { const float g0 = acc[ai][0][m][0][i], g1 = acc[ai][1][m][0][i];
                    a[i] = g0 * fsigmoid(g0) * acc[ai][0][m][1][i] * w; b[i] = g1 * fsigmoid(g1) * acc[ai][1][m][1][i] * w; }
                if (dst >= 0) *(u32x4*)(hact + (size_t)(dst >> 1) * 512 + (dst & 1) * 256 + c0) = pack8(a, b); }
    }
};
struct PairSched {
    const bf16_t* A; const bf16_t* W; int lda, ldb; const unsigned* tgrp; int nun, npn, G, c; size_t wstride; bool split;
    __device__ __forceinline__ bool next(int i, Unit& u) const {
        const int idx = i * G + c, nfull = (nun / G) * G, tail = nun - nfull; int U; u.half = 0;
        if (split && tail > 0 && 2 * tail <= G) { if (idx >= nfull + 2 * tail) return false; if (idx < nfull) U = idx; else { U = nfull + ((idx - nfull) >> 1); u.half = 1 + ((idx - nfull) & 1); } }
        else { if (idx >= nun) return false; U = idx; }
        u.aux = U / npn; u.pn = U % npn; u.pm = (int)tgrp[u.aux]; return true; }
    __device__ __forceinline__ const char* abase(const Unit& u) const { return (const char*)A + (size_t)(u.aux * BM + (u.half == 2 ? HALF : 0)) * lda * 2; }
    __device__ __forceinline__ const char* bbase(const Unit& u) const { return (const char*)W + (size_t)(u.pm & 255) * wstride + (size_t)u.pn * BM * ldb * 2; }
    __device__ __forceinline__ const char* bbase2(const Unit& u) const { return (const char*)W + (size_t)(u.pm >> 8) * wstride + (size_t)u.pn * BM * ldb * 2; }
    __device__ __forceinline__ void avoff(const Unit& u, int R0, int C0, int R1, int C1, unsigned (&v0)[2], unsigned (&v1)[2]) const {
        v0[0] = (unsigned)(R0 * lda + C0) * 2u; v0[1] = (unsigned)(R1 * lda + C1) * 2u; const unsigned h1 = u.half ? 0u : (unsigned)(HALF * lda * 2); v1[0] = v0[0] + h1; v1[1] = v0[1] + h1; }
};
struct EpiOut {
    const bf16_t* x1b; const float* mod; float* out; const int* ptok; LAS float* g0t; LAS float* g1t; int skip;
    __device__ __forceinline__ void operator()(const f32x4 (&acc)[2][2][4][2], const Unit& un, int wr, int wc, int fr, int fq) const {
        asm volatile("" : "+v"(fr), "+v"(fq));
        if (skip) {
#pragma unroll
            for (int ai = 0; ai < 2; ++ai)
#pragma unroll
                for (int bj = 0; bj < 2; ++bj)
#pragma unroll
                    for (int m = 0; m < 4; ++m) { f32x4 a = acc[ai][bj][m][0], b = acc[ai][bj][m][1]; asm volatile("" :: "v"(a), "v"(b)); }
            return; }
        const int r0 = un.aux * BM + (un.half == 2 ? HALF : 0) + wr * 64 + fr, c0 = 256 * un.pn + 64 * wc + 4 * fq;
        const int ns = un.half ? 8 : 16;
        int tk[2][4];
#pragma unroll
        for (int ai = 0; ai < 2; ++ai)
#pragma unroll
            for (int m = 0; m < 4; ++m) tk[ai][m] = (ai == 1 && un.half) ? -1 : ptok[r0 + ai * HALF + m * 16];
        unsigned vm = 0u;
#pragma unroll
        for (int ai = 0; ai < 2; ++ai)
#pragma unroll
            for (int m = 0; m < 4; ++m) if (__any(tk[ai][m] >= 0)) vm |= 1u << (4 * ai + m);
        vm = (unsigned)__builtin_amdgcn_readfirstlane((int)vm);
        { const int lane = fq * 16 + fr; f32x4 gv[4];
#pragma unroll
          for (int j = 0; j < 4; ++j) { const int idx = j * 64 + lane, b = idx >> 4, q4 = idx & 15; gv[j] = *(const f32x4*)(mod + b * 6144 + 5120 + 256 * un.pn + 64 * wc + 4 * q4); }
#pragma unroll
          for (int j = 0; j < 4; ++j) { const int idx = j * 64 + lane, b = idx >> 4, q4 = idx & 15; *(LAS f32x4*)((b < 8 ? g0t : g1t) + wc * 512 + (b & 7) * 64 + 4 * q4) = gv[j]; } }
        constexpr int PD = 6;
        u32x2 dd[16][2];
#define EO_X(s) do { if (!((vm >> ((s) >> 1)) & 1u)) break; const int tok_ = tk[(s) >> 3][((s) >> 1) & 3], tc_ = tok_ < 0 ? 0 : tok_; const size_t e_ = (size_t)tc_ * H2P + c0 + ((s) & 1) * 32; \
        dd[s][0] = *(const u32x2*)(x1b + e_); dd[s][1] = *(const u32x2*)(x1b + e_ + 16); } while (0)
#pragma unroll
        for (int s = 0; s < PD; ++s) EO_X(s);
#pragma unroll
        for (int s = 0; s < 16; ++s) {
            if (s + PD < 16 && s + PD < ns) EO_X(s + PD < 16 ? s + PD : 15);
            if (s < ns && ((vm >> (s >> 1)) & 1u)) {
                const int ai = s >> 3, m = (s >> 1) & 3, bj = s & 1, tok = tk[ai][m], tc = tok < 0 ? 0 : tok, b = tc / SEQ;
                const LAS float* gt = (b < 8 ? g0t : g1t) + wc * 512 + (b & 7) * 64 + bj * 32 + 4 * fq;
                const f32x4 ga = *(const LAS f32x4*)gt, gb = *(const LAS f32x4*)(gt + 16);
                const f32x4 a0 = acc[ai][bj][m][0], a1 = acc[ai][bj][m][1]; f32x4 oa, ob;
                oa[0] = __uint_as_float(dd[s][0].x << 16) + ga[0] * a0[0]; oa[1] = __uint_as_float(dd[s][0].x & 0xffff0000u) + ga[1] * a0[1];
                oa[2] = __uint_as_float(dd[s][0].y << 16) + ga[2] * a0[2]; oa[3] = __uint_as_float(dd[s][0].y & 0xffff0000u) + ga[3] * a0[3];
                ob[0] = __uint_as_float(dd[s][1].x << 16) + gb[0] * a1[0]; ob[1] = __uint_as_float(dd[s][1].x & 0xffff0000u) + gb[1] * a1[1];
                ob[2] = __uint_as_float(dd[s][1].y << 16) + gb[2] * a1[2]; ob[3] = __uint_as_float(dd[s][1].y & 0xffff0000u) + gb[3] * a1[3];
                if (tok >= 0) { float* o_ = out + (size_t)tok * DM + c0 + bj * 32; *(f32x4*)o_ = oa; *(f32x4*)(o_ + 16) = ob; }
            }
        }
#undef EO_X
    }
};
struct Args { Ptrs P; int ph_lo, ph_hi, li, pad; };
constexpr int N_PHASES = 10;

typedef const __attribute__((address_space(4))) Args* KArgs;
__device__ __forceinline__ KArgs kargs() {
#if defined(__HIP_DEVICE_COMPILE__)
    unsigned off = 0u; asm volatile("" : "+s"(off));
    return (KArgs)((const __attribute__((address_space(4))) char*)__builtin_amdgcn_kernarg_segment_ptr() + off);
#else
    return nullptr;
#endif
}
__device__ __forceinline__ Ptrs load_ptrs() {
    Ptrs P{};
#if defined(__HIP_DEVICE_COMPILE__)
    const __attribute__((address_space(4))) unsigned long long* src = (const __attribute__((address_space(4))) unsigned long long*)kargs();
    unsigned long long w[sizeof(Ptrs) / 8];
#pragma unroll
    for (unsigned i = 0; i < sizeof(Ptrs) / 8; ++i) w[i] = src[i];
    __builtin_memcpy(&P, w, sizeof(Ptrs));
#endif
    return P;
}
#define WSPTRS \
    unsigned char* ws = P.ws; bf16_t* hA = (bf16_t*)(ws + WS_A); bf16_t* uB = (bf16_t*)(ws + WS_B); bf16_t* gbB = uB + (size_t)M * DM; bf16_t* sgB = gbB + (size_t)M * DM; \
    bf16_t* latC = (bf16_t*)(ws + WS_C); bf16_t* Kd = (bf16_t*)(ws + WS_D); bf16_t* Vd = (bf16_t*)(ws + WS_D + 96 * MiB); bf16_t* Qo = (bf16_t*)P.out; \
    float* ssp = (float*)(ws + WS_SSP); const float2* cs = (const float2*)(ws + WS_CS); const float* mod = (const float*)(ws + WS_MOD); \
    const int* stok = (const int*)(ws + WS_STOK); const float* sw = (const float*)(ws + WS_SW); bf16_t* h2 = (bf16_t*)(ws + WS_H2); bf16_t* hact = (bf16_t*)(ws + WS_HACT); \
    (void)hA; (void)uB; (void)gbB; (void)sgB; (void)latC; (void)Kd; (void)Vd; (void)Qo; (void)ssp; (void)cs; (void)mod; (void)stok; (void)sw; (void)h2; (void)hact;

__global__ void __launch_bounds__(NWAVES * 64, 2) fwd(Args args_unused) {
    extern __shared__ __attribute__((aligned(16))) unsigned char lds_raw[];
    Frame F;
    F.lds = (LAS unsigned char*)lds_raw;
    F.MISC = (volatile LAS unsigned*)(F.lds + MISC_OFF);
    F.tid = threadIdx.x; F.lane = F.tid & 63; F.wave = __builtin_amdgcn_readfirstlane(F.tid >> 6);
    F.G = gridDim.x; { const int bx = blockIdx.x; F.vcu = (F.G % 8 == 0) ? (bx % 8) * (F.G / 8) + bx / 8 : bx; }
    F.ctl = (unsigned*)(args_unused.P.ws + WS_CTL);
    for (int u = F.tid; u < (LDS_BYTES - LDSCTL_OFF) / 4; u += NWAVES * 64) ((LAS unsigned*)(F.lds + LDSCTL_OFF))[u] = 0u;
    __syncthreads();
    const int lo = args_unused.ph_lo, hi = args_unused.ph_hi;
    XcdBarrier bar; bar.bar = F.ctl + CW_BAR + args_unused.li * XCD_BAR_WORDS; bar.x = 0; bar.st = nullptr;
    if (hi - lo > 1) bar = xcd_barrier_post(F.ctl + CW_BAR + args_unused.li * XCD_BAR_WORDS, F.MISC + 8);
#ifdef ONLY_PHASE
#define IN(k) ((k) == ONLY_PHASE && lo <= (k) && (k) < hi)
#else
#define IN(k) (lo <= (k) && (k) < hi)
#endif
#ifndef PROBE_REPEAT
#define PROBE_REPEAT -1
#endif
#define REPS(k) for (int rep_ = 0; rep_ < ((k) == PROBE_REPEAT ? 2 : 1); ++rep_)
#define SEAM(k) do { if (IN(k) && IN((k) + 1)) xcd_barrier(bar); } while (0)

    if (IN(0)) { const Ptrs P = args_unused.P; REPS(0) { p0_router_weights(P, F); p0_mod(P, F); } SEAM(0); }
    if (IN(1)) { const Ptrs P = args_unused.P; REPS(1) { p1_norm1(P, F); p0_weights_tables(P, F); } SEAM(1); }
    if (IN(2)) {
        const Ptrs P = args_unused.P; WSPTRS
        DenseSched S; S.init(hA, DM, (const bf16_t*)(ws + WS_WIN), DM, M, 5888, F.G, (int)blockIdx.x, true, true);
        EpiIn E{uB, gbB, sgB, latC, ssp, cs, P.k_g, (LAS float*)(F.lds + XCH_OFF)};
        gemm_phase<false>(F.lds + RING_OFF, DM, S, E);
        if (PROBE_REPEAT == 2) gemm_phase<false>(F.lds + RING_OFF, DM, S, E);
        SEAM(2);
    }
    if (IN(3)) {
        const Ptrs P = args_unused.P; WSPTRS
        { DenseSched S; S.init(latC + 512, LATW, (const bf16_t*)(ws + WS_WKV), KVL, M, 2048, F.G, (int)blockIdx.x);
          EpiKV E{Kd, Vd, latC, ssp, P.k_g, (LAS float*)(F.lds + XCH_OFF)};
          gemm_phase<false>(F.lds + RING_OFF, KVL, S, E);
          if (PROBE_REPEAT == 31) gemm_phase<false>(F.lds + RING_OFF, KVL, S, E);
          if (PROBE_REPEAT == 32) { EpiPlain E2{hA, 1024, 3}; gemm_phase<false>(F.lds + RING_OFF, KVL, S, E2); } }
        SEAM(3);
    }
    if (IN(4)) {
        const Ptrs P = args_unused.P; WSPTRS
        att::AttnArgs T{latC, (const bf16_t*)(ws + WS_WQ), Qo, Kd, Vd, ssp, cs, P.q_g, uB, gbB, sgB, P.conv_w, hA};
        if (F.G == 256) {
            const int bh = F.vcu >> 1, sel = F.vcu & 1;
#pragma unroll 1
            for (int i0 = 0; i0 < 4; ++i0) { const int i = (i0 + (bh & 3)) & 3;
                const int qb = sel ? (i == 0 ? 6 : i == 1 ? 1 : i == 2 ? 5 : 2) : (i == 0 ? 7 : i == 1 ? 0 : i == 2 ? 4 : 3);
                att::ATTN_UNIT<0>(T, bh >> 3, bh & 7, qb, (LAS char*)(F.lds + RING_OFF)); }
            if (PROBE_REPEAT == 4 || PROBE_REPEAT == 41 || PROBE_REPEAT == 42) {
#pragma unroll 1
                for (int i = 0; i < 4; ++i) { const int qb = sel ? (i == 0 ? 6 : i == 1 ? 1 : i == 2 ? 5 : 2) : (i == 0 ? 7 : i == 1 ? 0 : i == 2 ? 4 : 3);
                    att::ATTN_UNIT<(PROBE_REPEAT == 41 ? 1 : PROBE_REPEAT == 42 ? 2 : 0)>(T, bh >> 3, bh & 7, qb, (LAS char*)(F.lds + RING_OFF)); } }
        } else {
#pragma unroll 1
            for (int U = F.vcu; U < BATCH * NH * 8; U += F.G) { const int bh = U >> 3; att::ATTN_UNIT<0>(T, bh >> 3, bh & 7, U & 7, (LAS char*)(F.lds + RING_OFF)); }
        }
        SEAM(4);
    }
    if (IN(5)) {
        const Ptrs P = args_unused.P; WSPTRS
        DenseSched S; S.init(hA, DM, (const bf16_t*)(ws + WS_WO), DM, M, DM, F.G, (int)blockIdx.x);
        EpiDelta E{mod, (bf16_t*)(ws + WS_DELTA)};
        gemm_phase<false>(F.lds + RING_OFF, DM, S, E);
        if (PROBE_REPEAT == 5) gemm_phase<false>(F.lds + RING_OFF, DM, S, E);
        if (PROBE_REPEAT == 51) { EpiNull E0; gemm_phase<false>(F.lds + RING_OFF, DM, S, E0); }
        SEAM(5);
    }
    if (IN(6)) { const Ptrs P = args_unused.P; p6_rows<0>(P, F); if (PROBE_REPEAT == 6) p6_rows<0>(P, F); if (PROBE_REPEAT == 61) p6_rows<1>(P, F); SEAM(6); }
    if (IN(7)) { const Ptrs P = args_unused.P; p7_sort(P, F); if (PROBE_REPEAT == 7) p7_sort(P, F); SEAM(7); }
    if (IN(8)) {
        const Ptrs P = args_unused.P; WSPTRS
        const int T = __builtin_amdgcn_readfirstlane((int)F.ctl[CW_T]);
        MoeSched S{h2, (const bf16_t*)(ws + WS_EGU), H2P, DM, stok, F.ctl + CW_TGRP, 0, T * 2, 2, F.G, F.vcu, (size_t)512 * DM * 2, true, true};
        EpiGU E{hact, sw, (const int*)(ws + WS_SDST)};
        gemm_phase<true>(F.lds + RING_OFF, DM, S, E);
        if (PROBE_REPEAT == 8) gemm_phase<true>(F.lds + RING_OFF, DM, S, E);
        SEAM(8);
    }
    if (IN(9)) {
        const Ptrs P = args_unused.P; WSPTRS
        const int T2 = __builtin_amdgcn_readfirstlane((int)F.ctl[CW_T2]);
        PairSched S{hact, (const bf16_t*)(ws + WS_EDN), 2 * DEXP, DEXP, F.ctl + CW_TGRP2, T2 * 4, 4, F.G, F.vcu, (size_t)DM * DEXP * 2, true};
        EpiOut E{(const bf16_t*)(ws + WS_X1B), mod, P.out, (const int*)(ws + WS_PTOK), (LAS float*)(F.lds + XCH_OFF), (LAS float*)(F.lds + GX_OFF), args_unused.li};
#pragma unroll 1
        REPS(9) gemm_phase<false, true>(F.lds + RING_OFF, 2 * DEXP, S, E);
        if (PROBE_REPEAT == 91) { EpiNull E0; gemm_phase<false, true>(F.lds + RING_OFF, 2 * DEXP, S, E0); }
    }
#undef IN
#undef SEAM
}
}
extern "C" void kernel_launch(void* const* d_in, const int* in_sizes, int n_in, void* d_out, int out_size, void* d_ws, size_t ws_size, hipStream_t stream) {
    if (n_in != 23 || out_size != M * DM || ws_size < WS_END) { fprintf(stderr, "kernel_launch: unexpected shapes (n_in %d out %d ws %zu)\n", n_in, out_size, ws_size); return; }
    static int grid = 0;
    if (grid == 0) {
        int dev = 0, cus = 0;
        if (hipGetDevice(&dev) != hipSuccess || hipDeviceGetAttribute(&cus, hipDeviceAttributeMultiprocessorCount, dev) != hipSuccess) { fprintf(stderr, "kernel_launch: device query failed\n"); grid = -1; return; }
        if (hipFuncSetAttribute((const void*)fk::fwd, hipFuncAttributeMaxDynamicSharedMemorySize, fk::LDS_BYTES) != hipSuccess) { fprintf(stderr, "kernel_launch: hipFuncSetAttribute failed\n"); grid = -1; return; }
        grid = cus;
    }
    if (grid < 0) return;
    Ptrs P{};
    P.x = (const float*)d_in[0]; P.c = (const float*)d_in[1]; P.pos = (const int*)d_in[2];
    P.w_ada = (const float*)d_in[3]; P.b_ada = (const float*)d_in[4]; P.norm1_g = (const float*)d_in[5]; P.w_in = (const float*)d_in[6]; P.conv_w = (const float*)d_in[7];
    P.q_a_g = (const float*)d_in[8]; P.w_q_b = (const float*)d_in[9]; P.kv_a_g = (const float*)d_in[10]; P.w_kv_b = (const float*)d_in[11]; P.q_g = (const float*)d_in[12]; P.k_g = (const float*)d_in[13];
    P.w_o = (const float*)d_in[14]; P.norm2_g = (const float*)d_in[15]; P.w_rg = (const float*)d_in[16]; P.b_rg = (const float*)d_in[17]; P.w_re = (const float*)d_in[18]; P.b_re = (const float*)d_in[19];
    P.w_gate = (const float*)d_in[20]; P.w_up = (const float*)d_in[21]; P.w_down = (const float*)d_in[22];
    P.out = (float*)d_out; P.ws = (unsigned char*)d_ws;
    (void)hipMemsetAsync((char*)d_ws + WS_CTL, 0, 1 * MiB, stream);
    fk::Args a{}; a.P = P; a.ph_lo = 0; a.ph_hi = fk::N_PHASES; a.li = 0;
    hipLaunchKernelGGL(fk::fwd, dim3(grid), dim3(fk::NWAVES * 64), fk::LDS_BYTES, stream, a);
#ifdef PROBE_PHASE
    { fk::Args b2{}; b2.P = P; b2.ph_lo = PROBE_PHASE; b2.ph_hi = PROBE_PHASE + 1; b2.li = 1; hipLaunchKernelGGL(fk::fwd, dim3(grid), dim3(fk::NWAVES * 64), fk::LDS_BYTES, stream, b2); }
#endif
}
```
